# Optimizing an MI355X kernel written in HIP

```python
import math
import jax, jax.numpy as jnp
from jax import lax
import numpy as np

D_MODEL = 2048
BATCH = 2
SEQ = 4096
DEPTH = 2

GRID_W = 64
D_MIX = D_MODEL
N_MIXERS = 4
D_GROUP = D_MIX // N_MIXERS
HEAD_DIM = 64
N_NA_HEADS = D_GROUP // HEAD_DIM
N_RET_HEADS = D_GROUP // HEAD_DIM
N_FFT_GROUPS = 4
FFT_GROUP_DIM = D_GROUP // N_FFT_GROUPS
NA_KH_MAX = 8
NA_KW = 16
RET_CHUNK = 128
CONV_WIDTH = 31
ROPE_BASE = 10000.0
EPS = 1e-6
N_IN_PIECES = 13
D_IN = N_IN_PIECES * D_GROUP

kernel_name = "hybrid_parallel_fourier_natten_retnet_conformer"


def _rmsnorm(x, g):
    xf = x.astype(jnp.float32)
    ms = jnp.mean(xf * xf, axis=-1, keepdims=True)
    return (xf * lax.rsqrt(ms + EPS)).astype(x.dtype) * g


def _fourier_mix(u, w_fft):
    B, S, _ = u.shape
    uf = u.astype(jnp.float32).reshape(B, S, N_FFT_GROUPS, FFT_GROUP_DIM)
    y = jnp.real(jnp.fft.fft2(uf, axes=(1, 3), norm="ortho"))
    return y.reshape(B, S, D_GROUP).astype(u.dtype) @ w_fft


def _neighbourhood_attention(q, k, v, rel_bias):
    B, S, _ = q.shape
    rows = S // GRID_W
    kh = min(NA_KH_MAX, rows)

    def grid(t):
        return t.reshape(B, rows, GRID_W, N_NA_HEADS, HEAD_DIM)

    qg = grid(q) * (HEAD_DIM ** -0.5)
    kg, vg = grid(k), grid(v)
    r = jnp.arange(rows)
    row_start = jnp.clip(r - kh // 2, 0, rows - kh)
    key_rows = row_start[:, None] + jnp.arange(kh)[None, :]
    kb = kg[:, key_rows]
    vb = vg[:, key_rows]
    col = jnp.arange(GRID_W)
    col_start = jnp.clip(col - NA_KW // 2, 0, GRID_W - NA_KW)
    rel_c = col[None, :] - col_start[:, None]
    col_in = (rel_c >= 0) & (rel_c < NA_KW)
    dc = col[None, :] - col[:, None]
    dr = key_rows - r[:, None]
    bias = rel_bias[:, (dr + NA_KH_MAX - 1)[:, :, None, None],
                    jnp.clip(dc + NA_KW - 1, 0, 2 * NA_KW - 2)[None, None]]
    bias = bias.transpose(0, 1, 3, 2, 4)
    s = jnp.einsum('brqhd,brakhd->bhrqak', qg, kb).astype(jnp.float32)
    s = s + bias[None].astype(jnp.float32)
    s = jnp.where(col_in[:, None, :], s, -jnp.inf)
    p = jax.nn.softmax(s.reshape(B, N_NA_HEADS, rows, GRID_W, kh * GRID_W), axis=-1)
    p = p.reshape(B, N_NA_HEADS, rows, GRID_W, kh, GRID_W).astype(v.dtype)
    o = jnp.einsum('bhrqak,brakhd->brqhd', p, vb)
    return o.reshape(B, S, D_GROUP)


def _rotary(t):
    S = t.shape[2]
    half = HEAD_DIM // 2
    inv = ROPE_BASE ** (-jnp.arange(half, dtype=jnp.float32) / half)
    ang = jnp.arange(S, dtype=jnp.float32)[:, None] * inv[None, :]
    cos, sin = jnp.cos(ang), jnp.sin(ang)
    t1, t2 = t[..., :half], t[..., half:]
    return jnp.concatenate([t1 * cos - t2 * sin, t1 * sin + t2 * cos], axis=-1)


def _retention_direction(q, k, v, log_gamma, include_diag):
    B, H, S, Dh = q.shape
    C = RET_CHUNK
    n = S // C
    qc = q.reshape(B, H, n, C, Dh)
    kc = k.reshape(B, H, n, C, Dh)
    vc = v.reshape(B, H, n, C, Dh)
    idx = jnp.arange(C, dtype=jnp.float32)
    diff = idx[:, None] - idx[None, :]
    mask = (diff >= 0) if include_diag else (diff > 0)
    lg = log_gamma[:, None, None]
    d_intra = jnp.where(mask, jnp.exp(lg * jnp.where(mask, diff, 0.0)), 0.0)
    scores = jnp.einsum('bhnid,bhnjd->bhnij', qc, kc) * d_intra[None, :, None]
    o_intra = jnp.einsum('bhnij,bhnjd->bhnid', scores, vc)
    k_decay = jnp.exp(log_gamma[:, None] * (C - 1 - idx)[None, :])
    kv = jnp.einsum('bhnjd,bhnje->nbhde', kc * k_decay[None, :, None, :, None], vc)
    chunk_decay = jnp.exp(log_gamma * C)[None, :, None, None]

    def step(state, kv_n):
        return chunk_decay * state + kv_n, state

    _, prev = lax.scan(step, jnp.zeros((B, H, Dh, Dh), jnp.float32), kv)
    q_decay = jnp.exp(log_gamma[:, None] * (idx + 1.0)[None, :])
    o_cross = jnp.einsum('bhnid,nbhde->bhnie', qc * q_decay[None, :, None, :, None], prev)
    return (o_intra + o_cross).reshape(B, H, S, Dh)


def _retention(q, k, v, logit_fwd, logit_bwd):
    B, S, _ = q.shape

    def heads(t):
        return t.astype(jnp.float32).reshape(B, S, N_RET_HEADS, HEAD_DIM).transpose(0, 2, 1, 3)

    qh = _rotary(heads(q)) * (HEAD_DIM ** -0.5)
    kh = _rotary(heads(k))
    vh = heads(v)
    lf = jax.nn.log_sigmoid(logit_fwd.astype(jnp.float32))
    lb = jax.nn.log_sigmoid(logit_bwd.astype(jnp.float32))
    fwd = _retention_direction(qh, kh, vh, lf, True)
    bwd = _retention_direction(qh[:, :, ::-1], kh[:, :, ::-1], vh[:, :, ::-1], lb, False)[:, :, ::-1]
    o = fwd + bwd
    o = o * lax.rsqrt(jnp.mean(o * o, axis=-1, keepdims=True) + EPS)
    return o.transpose(0, 2, 1, 3).reshape(B, S, D_GROUP).astype(q.dtype)


def _conformer_conv(a, b, conv_w, conv_b, ln_g, ln_b, w_pw):
    u = a * jax.nn.sigmoid(b)
    y = lax.conv_general_dilated(
        u, conv_w[:, None, :].astype(u.dtype), window_strides=(1,),
        padding=[(CONV_WIDTH // 2, CONV_WIDTH // 2)],
        dimension_numbers=('NWC', 'WIO', 'NWC'), feature_group_count=D_GROUP) + conv_b
    yf = y.astype(jnp.float32)
    mu = jnp.mean(yf, axis=-1, keepdims=True)
    var = jnp.mean((yf - mu) ** 2, axis=-1, keepdims=True)
    y = ((yf - mu) * lax.rsqrt(var + EPS)).astype(u.dtype) * ln_g + ln_b
    return jax.nn.silu(y) @ w_pw


def setup_inputs(seed: int = 0) -> dict:
    key = jax.random.key(seed)
    ks = jax.random.split(key, 17)
    f32 = jnp.float32
    nrm = lambda k, shape, s: jax.random.normal(k, shape, f32) * s
    gam = 1.0 - 2.0 ** (-5.0 - jnp.arange(N_RET_HEADS, dtype=f32))
    ret_logit0 = jnp.log(gam) - jnp.log1p(-gam)
    return {
        "x": nrm(ks[0], (BATCH, SEQ, D_MODEL), 1.0),
        "c": nrm(ks[1], (BATCH, D_MODEL), 1.0),
        "norm_g": 1.0 + nrm(ks[2], (DEPTH, D_MODEL), 0.01),
        "w_ada": nrm(ks[3], (DEPTH, D_MODEL, 3 * D_MODEL), 0.5 * D_MODEL ** -0.5),
        "b_ada": nrm(ks[4], (DEPTH, 3 * D_MODEL), 0.01),
        "w_in": nrm(ks[5], (DEPTH, D_MODEL, D_IN), D_MODEL ** -0.5),
        "w_fft": nrm(ks[6], (DEPTH, D_GROUP, D_GROUP), D_GROUP ** -0.5),
        "na_rel_bias": nrm(ks[7], (DEPTH, N_NA_HEADS, 2 * NA_KH_MAX - 1, 2 * NA_KW - 1), 0.02),
        "ret_logit_fwd": ret_logit0[None] + nrm(ks[8], (DEPTH, N_RET_HEADS), 0.01),
        "ret_logit_bwd": ret_logit0[None] + nrm(ks[9], (DEPTH, N_RET_HEADS), 0.01),
        "conv_w": nrm(ks[10], (DEPTH, CONV_WIDTH, D_GROUP), CONV_WIDTH ** -0.5),
        "conv_b": nrm(ks[11], (DEPTH, D_GROUP), 0.01),
        "conv_ln_g": 1.0 + nrm(ks[12], (DEPTH, D_GROUP), 0.01),
        "conv_ln_b": nrm(ks[13], (DEPTH, D_GROUP), 0.01),
        "conv_w_pw": nrm(ks[14], (DEPTH, D_GROUP, D_GROUP), D_GROUP ** -0.5),
        "w_out": nrm(ks[15], (DEPTH, D_MIX, D_MODEL), D_MIX ** -0.5),
        "final_g": 1.0 + nrm(ks[16], (D_MODEL,), 0.01),
    }


def reference(x, c, norm_g, w_ada, b_ada, w_in, w_fft, na_rel_bias, ret_logit_fwd, ret_logit_bwd,
              conv_w, conv_b, conv_ln_g, conv_ln_b, conv_w_pw, w_out, final_g):
    c_act = jax.nn.silu(c)
    for l in range(DEPTH):
        mod = c_act @ w_ada[l] + b_ada[l]
        shift, scale, gate = jnp.split(mod, 3, axis=-1)
        h = _rmsnorm(x, norm_g[l]) * (1.0 + scale[:, None, :]) + shift[:, None, :]
        z = h @ w_in[l]
        (f_x, f_g, na_q, na_k, na_v, na_g, r_q, r_k, r_v, r_g,
         cv_a, cv_b, cv_g) = jnp.split(z, N_IN_PIECES, axis=-1)
        o_fft = _fourier_mix(f_x, w_fft[l]) * jax.nn.silu(f_g)
        o_na = _neighbourhood_attention(na_q, na_k, na_v, na_rel_bias[l]) * jax.nn.silu(na_g)
        o_ret = _retention(r_q, r_k, r_v, ret_logit_fwd[l], ret_logit_bwd[l]) * jax.nn.silu(r_g)
        o_cv = _conformer_conv(cv_a, cv_b, conv_w[l], conv_b[l], conv_ln_g[l], conv_ln_b[l],
                               conv_w_pw[l]) * jax.nn.silu(cv_g)
        y = jnp.concatenate([o_fft, o_na, o_ret, o_cv], axis=-1) @ w_out[l]
        x = x + gate[:, None, :] * y
    return _rmsnorm(x, final_g)
```

```cpp
#include <hip/hip_runtime.h>
#include <hip/hip_cooperative_groups.h>
#include <cstdio>
#include <cstdint>
namespace cg = cooperative_groups;

#ifndef ONE_LAUNCH
#define ONE_LAUNCH 1
#endif

__device__ __forceinline__ int otid() { int t; asm volatile("v_mov_b32 %0, %1" : "=v"(t) : "v"(threadIdx.x)); return t; }
namespace pg8 {
#define PG8_LAS __attribute__((address_space(3)))
typedef unsigned short bf16_t;
typedef short bf16x8 __attribute__((ext_vector_type(8)));
typedef float f32x4 __attribute__((ext_vector_type(4)));
typedef unsigned u32x4 __attribute__((ext_vector_type(4)));
constexpr int BM = 256, BK = 64, HALF = 128, HTB = HALF * BK * 2, STAGE_BYTES = 8 * HTB, NXCD = 8, WGM = 8;

__host__ __device__ __forceinline__ int lds_byte(int r, int c) { const int st = (r >> 4) * 2 + (c >> 5), rr = r & 15, cc = c & 31, ob = rr * 64 + cc * 2; return st * 1024 + (ob ^ (((ob >> 9) & 1) << 5)); }
__host__ __device__ __forceinline__ void stage_rc(int b, int& R, int& C) { const int st = b / 1024, sb = b % 1024, swz = sb ^ (((sb >> 9) & 1) << 5); R = (st >> 1) * 16 + swz / 64; C = (st & 1) * 32 + (swz % 64) / 2; }
__host__ __device__ __forceinline__ int perm32(int rho) { const int n = rho >> 4, i = rho & 15; return 8 * (i >> 2) + 4 * n + (i & 3); }

struct Unit { int pm, pn, aux, pad; const char* A; const char* B; };
struct Gemm { int lda, ldb, K; };

struct StaticOrder {
    int nM, nN, nwg, G, c;
    __host__ __device__ void init(int M, int N, int G_, int c_) { nM = M / BM; nN = N / BM; nwg = nM * nN; G = G_; c = c_; }
    __device__ bool next(int i, Unit& u) const {
        const long L = (long)i * G + c; if (L >= nwg) return false;
        int wgid = __builtin_amdgcn_readfirstlane((int)L); { const int q = nwg / NXCD, r = nwg % NXCD, xcd = wgid % NXCD, off = wgid / NXCD; wgid = (xcd < r ? xcd * (q + 1) : r * (q + 1) + (xcd - r) * q) + off; }
        const int nig = WGM * nN, gid = wgid / nig, fm = gid * WGM, gsz = (nM - fm) < WGM ? (nM - fm) : WGM;
        u.pm = __builtin_amdgcn_readfirstlane(fm + ((wgid % nig) % gsz)); u.pn = __builtin_amdgcn_readfirstlane((wgid % nig) / gsz); return true;
    }
};

__device__ __forceinline__ unsigned cvt_pk_bf16(float lo, float hi) { unsigned r; asm volatile("v_cvt_pk_bf16_f32 %0, %1, %2" : "=v"(r) : "v"(lo), "v"(hi)); return r; }

template <class Epi, class Sched, bool ALIGN_EPI>
__device__ __forceinline__ void gemm_phase(PG8_LAS unsigned char* lds, const Gemm g, const Sched& S, const Epi& E) {
    const int tid = otid(), wid = __builtin_amdgcn_readfirstlane(tid >> 6), lane = tid & 63, wr = wid >> 2, wc = wid & 3, fr = lane & 15, fq = lane >> 4;
    const int K = g.K, nt = K / BK;
    unsigned voffA[2], voffB[2];
#pragma unroll
    for (int i = 0; i < 2; ++i) { int R, C; stage_rc(tid * 16 + i * 8192, R, C); const int Rb = Epi::PERM ? ((R & ~31) + perm32(R & 31)) : R;
        voffA[i] = (unsigned)(R * g.lda + C) * 2u; voffB[i] = (unsigned)(Rb * g.ldb + C) * 2u; }
    const size_t kstep = (size_t)(BK * 2);
    const size_t hA = (size_t)HALF * g.lda * 2, hB = (size_t)HALF * g.ldb * 2;
    const unsigned ldsw = (unsigned)wid * 1024u;
    const int aoff = lds_byte(wr * 64 + fr, fq * 8), boff = lds_byte(wc * 32 + fr, fq * 8);
#define PG8_SA(b, h) (((b) * 2 + (h)) * HTB)
#define PG8_SB(b, h) ((4 + (b) * 2 + (h)) * HTB)
#define PG8_STAGE(bufoff, gbase, voff) do { _Pragma("unroll") for (int _i = 0; _i < 2; ++_i) \
        __builtin_amdgcn_global_load_lds((const unsigned*)((const char*)(gbase) + (voff)[_i]), (PG8_LAS unsigned*)(lds + (bufoff) + ldsw + _i * 8192), 16, 0, 0); } while (0)
#define PG8_LDA(dst, b, h) do { _Pragma("unroll") for (int m = 0; m < 4; ++m) _Pragma("unroll") for (int k = 0; k < 2; ++k) dst[m][k] = *(const PG8_LAS bf16x8*)(lds + PG8_SA(b, h) + aoff + m * 2048 + k * 1024); } while (0)
#define PG8_LDB(dst, b, h) do { _Pragma("unroll") for (int n = 0; n < 2; ++n) _Pragma("unroll") for (int k = 0; k < 2; ++k) dst[n][k] = *(const PG8_LAS bf16x8*)(lds + PG8_SB(b, h) + boff + n * 2048 + k * 1024); } while (0)
#define PG8_MMA(ai, bj, At, Bt) do { __builtin_amdgcn_s_setprio(1); _Pragma("unroll") for (int m = 0; m < 4; ++m) _Pragma("unroll") for (int n = 0; n < 2; ++n) _Pragma("unroll") for (int k = 0; k < 2; ++k) \
        acc[ai][bj][m][n] = __builtin_amdgcn_mfma_f32_16x16x32_bf16(Bt[n][k], At[m][k], acc[ai][bj][m][n], 0, 0, 0); __builtin_amdgcn_s_setprio(0); } while (0)
#define PG8_WAIT_V(n) asm volatile("s_waitcnt vmcnt(" #n ")" ::: "memory")
#define PG8_WAIT_L(n) asm volatile("s_waitcnt lgkmcnt(" #n ")" ::: "memory")
#define PG8_BAR __builtin_amdgcn_s_barrier()
#define PG8_SCHED __builtin_amdgcn_sched_barrier(0)
    Unit cur, nxt; int ui = 0;
    if (!S.next(0, cur)) return;
    f32x4 acc[2][2][4][2];
#pragma unroll
    for (int a = 0; a < 2; ++a)
#pragma unroll
        for (int b = 0; b < 2; ++b)
#pragma unroll
            for (int m = 0; m < 4; ++m)
#pragma unroll
                for (int n = 0; n < 2; ++n) acc[a][b][m][n] = (f32x4){0.f, 0.f, 0.f, 0.f};
    bf16x8 At[4][2], B0[2][2], B1[2][2];
    const char* cA = cur.A; const char* cB = cur.B;
    PG8_STAGE(PG8_SB(0, 0), cB, voffB); PG8_STAGE(PG8_SB(0, 1), cB + hB, voffB); PG8_STAGE(PG8_SA(0, 0), cA, voffA); PG8_STAGE(PG8_SA(0, 1), cA + hA, voffA);
    if (wr == 1) PG8_BAR;
    PG8_WAIT_V(2); PG8_BAR;
    PG8_STAGE(PG8_SB(1, 0), cB + kstep, voffB); PG8_STAGE(PG8_SA(1, 0), cA + kstep, voffA); PG8_STAGE(PG8_SB(1, 1), cB + hB + kstep, voffB);
    PG8_WAIT_V(6); PG8_BAR;
    for (;;) {
        const bool has_next = S.next(ui + 1, nxt);
        const char* nA = has_next ? nxt.A : cA; const char* nB = has_next ? nxt.B : cB;
        for (int t = 0; t < nt; t += 2) {
            const bool last = (t == nt - 2);
            const char* a1 = cA + (size_t)(t + 1) * kstep;
            const char* a2 = last ? nA : cA + (size_t)(t + 2) * kstep; const char* b2 = last ? nB : cB + (size_t)(t + 2) * kstep;
            const char* a3 = a2 + kstep; const char* b3 = b2 + kstep;
            PG8_LDB(B0, 0, 0); PG8_LDB(B1, 0, 1); PG8_SCHED; PG8_LDA(At, 0, 0); PG8_STAGE(PG8_SA(1, 1), a1 + hA, voffA);
            PG8_WAIT_V(8); PG8_WAIT_L(0); PG8_BAR; PG8_MMA(0, 0, At, B0); PG8_MMA(0, 1, At, B1); PG8_BAR; PG8_SCHED;
            PG8_LDA(At, 0, 1); PG8_STAGE(PG8_SB(0, 0), b2, voffB); PG8_STAGE(PG8_SB(0, 1), b2 + hB, voffB); PG8_STAGE(PG8_SA(0, 0), a2, voffA);
            PG8_WAIT_V(8); PG8_WAIT_L(0); PG8_BAR; PG8_MMA(1, 0, At, B0); PG8_MMA(1, 1, At, B1); PG8_BAR; PG8_SCHED;
            PG8_LDB(B0, 1, 0); PG8_LDB(B1, 1, 1); PG8_SCHED; PG8_LDA(At, 1, 0); PG8_STAGE(PG8_SA(0, 1), a2 + hA, voffA);
            PG8_WAIT_V(8); PG8_WAIT_L(0); PG8_BAR; PG8_MMA(0, 0, At, B0); PG8_MMA(0, 1, At, B1); PG8_BAR; PG8_SCHED;
            PG8_LDA(At, 1, 1); PG8_STAGE(PG8_SB(1, 0), b3, voffB); PG8_STAGE(PG8_SB(1, 1), b3 + hB, voffB); PG8_STAGE(PG8_SA(1, 0), a3, voffA);
            PG8_WAIT_V(8); PG8_WAIT_L(0); PG8_BAR; PG8_MMA(1, 0, At, B0); PG8_MMA(1, 1, At, B1); PG8_BAR; PG8_SCHED;
        }
        if constexpr (ALIGN_EPI) { if (wr == 0) PG8_BAR; }
        E(acc, cur, wr, wc, fr, fq);
        if (!has_next) break;
#pragma unroll
        for (int a = 0; a < 2; ++a)
#pragma unroll
            for (int b = 0; b < 2; ++b)
#pragma unroll
                for (int m = 0; m < 4; ++m)
#pragma unroll
                    for (int n = 0; n < 2; ++n) acc[a][b][m][n] = (f32x4){0.f, 0.f, 0.f, 0.f};
        cur = nxt; cA = nA; cB = nB; ++ui;
        if constexpr (ALIGN_EPI) { if (wr == 1) PG8_BAR; }
    }
    PG8_WAIT_V(0);
    if constexpr (!ALIGN_EPI) { if (wr == 0) PG8_BAR; }
    PG8_BAR;
#undef PG8_SA
#undef PG8_SB
#undef PG8_STAGE
#undef PG8_LDA
#undef PG8_LDB
#undef PG8_MMA
#undef PG8_WAIT_V
#undef PG8_WAIT_L
#undef PG8_BAR
#undef PG8_SCHED
}
}

typedef unsigned short bf16;
typedef float f32x4 __attribute__((ext_vector_type(4)));
typedef unsigned u32x4 __attribute__((ext_vector_type(4)));
typedef unsigned u32x2 __attribute__((ext_vector_type(2)));
constexpr int NB = 2, SEQ = 4096, DM = 2048, MTOK = NB * SEQ, DIN = 6656, DG = 512, NL = 2;
constexpr int LDS_BYTES = 147456;
constexpr int NTHR = 512;

constexpr size_t WS_WIN = 0;
constexpr size_t WS_WOUT = WS_WIN + (size_t)NL * DIN * DM * 2;
constexpr size_t WS_WFFT = WS_WOUT + (size_t)NL * DM * DM * 2;
constexpr size_t WS_WPW = WS_WFFT + (size_t)NL * DG * DG * 2;
constexpr size_t WS_DFT = WS_WPW + (size_t)NL * DG * DG * 2;
constexpr size_t WS_ROPE = WS_DFT + (size_t)SEQ * 2 * SEQ * 2;
constexpr size_t WS_MOD = WS_ROPE + (size_t)SEQ * 32 * 8;
constexpr size_t WS_U = WS_MOD + 131072;
constexpr size_t WS_Z = WS_U + (size_t)4 * MTOK * DG * 4;
constexpr size_t WS_PQT = WS_Z + (size_t)MTOK * DIN * 2;
constexpr size_t WS_Y = WS_PQT + (size_t)NB * DG * 2 * SEQ * 2;
constexpr size_t WS_CVH = WS_Y + (size_t)MTOK * DG * 2;
constexpr size_t WS_CAT = WS_CVH + (size_t)MTOK * DG * 2;
constexpr size_t WS_END = WS_CAT + (size_t)MTOK * DM * 2;

struct Params {
    const float* x; const float* c; const float* norm_g; const float* w_ada; const float* b_ada; const float* w_in; const float* w_fft; const float* na_bias;
    const float* rl_f; const float* rl_b; const float* conv_w; const float* conv_b; const float* ln_g; const float* ln_b; const float* w_pw; const float* w_out; const float* final_g;
    float* out; unsigned char* ws; int ph_lo, ph_hi;
};

__device__ __forceinline__ unsigned f2bf(float f) { unsigned u = __float_as_uint(f); return (u + 0x7fffu + ((u >> 16) & 1u)) >> 16; }
__device__ __forceinline__ unsigned pk2(float lo, float hi) { return f2bf(lo) | (f2bf(hi) << 16); }
__device__ __forceinline__ float bf2f(bf16 b) { return __uint_as_float((unsigned)b << 16); }
__device__ __forceinline__ float bflo(unsigned u) { return __uint_as_float(u << 16); }
__device__ __forceinline__ float bfhi(unsigned u) { return __uint_as_float(u & 0xffff0000u); }
__device__ __forceinline__ float silu_f(float v) { return v / (1.f + __expf(-v)); }
__device__ __forceinline__ float wave_sum(float v) {
#pragma unroll
    for (int o = 1; o < 64; o <<= 1) v += __shfl_xor(v, o);
    return v;
}
__device__ __forceinline__ float wave_max(float v) {
#pragma unroll
    for (int o = 1; o < 64; o <<= 1) v = fmaxf(v, __shfl_xor(v, o));
    return v;
}

struct SchedS {
    pg8::StaticOrder o; const char* A; const char* B; size_t ta, tb;
    __device__ __forceinline__ bool next(int i, pg8::Unit& u) const { if (!o.next(i, u)) return false; u.A = A + (size_t)u.pm * ta; u.B = B + (size_t)u.pn * tb; u.aux = 0; return true; }
};
__device__ __forceinline__ SchedS make_sched(const void* A, int lda, const void* B, int ldb, int M, int N) {
    SchedS s; s.o.init(M, N, (int)gridDim.x, (int)blockIdx.x); s.A = (const char*)A; s.B = (const char*)B; s.ta = (size_t)256 * lda * 2; s.tb = (size_t)256 * ldb * 2; return s;
}
struct SchedDFT {
    const char* A; const char* B; int G, c;
    __device__ __forceinline__ bool next(int i, pg8::Unit& u) const {
        const int L = __builtin_amdgcn_readfirstlane(i * G + c); if (L >= 256) return false;
        const int sub = L >> 5, t = L & 31; u.pm = t >> 1; u.pn = t & 1; u.aux = sub;
        u.A = A + (size_t)((u.pm << 22) + ((sub & 3) << 12)); u.B = B + (size_t)(((sub >> 2) << 23) + (u.pn << 22) + ((sub & 3) << 12)); return true;
    }
};

struct EpiZ {
    static constexpr bool PERM = true;
    bf16* O; int ldc;
    __device__ __forceinline__ void operator()(const pg8::f32x4 (&acc)[2][2][4][2], const pg8::Unit& u, int wr, int wc, int fr, int fq) const {
        const int row0 = u.pm * 256 + wr * 64 + fr, col0 = u.pn * 256 + wc * 32 + 8 * fq;
#pragma unroll
        for (int ai = 0; ai < 2; ++ai)
#pragma unroll
            for (int m = 0; m < 4; ++m) { bf16* rowp = O + (size_t)(row0 + ai * 128 + m * 16) * ldc + col0;
#pragma unroll
                for (int bj = 0; bj < 2; ++bj) { const pg8::f32x4 v0 = acc[ai][bj][m][0], v1 = acc[ai][bj][m][1]; u32x4 w;
                    w.x = pg8::cvt_pk_bf16(v0[0], v0[1]); w.y = pg8::cvt_pk_bf16(v0[2], v0[3]); w.z = pg8::cvt_pk_bf16(v1[0], v1[1]); w.w = pg8::cvt_pk_bf16(v1[2], v1[3]);
                    *(u32x4*)(rowp + bj * 128) = w; } }
    }
};
struct EpiGate {
    static constexpr bool PERM = true;
    bf16* O; const bf16* Z; int coff, goff;
    __device__ __forceinline__ void operator()(const pg8::f32x4 (&acc)[2][2][4][2], const pg8::Unit& u, int wr, int wc, int fr, int fq) const {
        const int row0 = u.pm * 256 + wr * 64 + fr, col0 = u.pn * 256 + wc * 32 + 8 * fq;
#pragma unroll
        for (int ai = 0; ai < 2; ++ai)
#pragma unroll
            for (int m = 0; m < 4; ++m) { const size_t row = (size_t)(row0 + ai * 128 + m * 16);
#pragma unroll
                for (int bj = 0; bj < 2; ++bj) { const pg8::f32x4 v0 = acc[ai][bj][m][0], v1 = acc[ai][bj][m][1];
                    const u32x4 gz = *(const u32x4*)(Z + row * DIN + goff + col0 + bj * 128); u32x4 w;
                    w.x = pg8::cvt_pk_bf16(v0[0] * silu_f(bflo(gz.x)), v0[1] * silu_f(bfhi(gz.x))); w.y = pg8::cvt_pk_bf16(v0[2] * silu_f(bflo(gz.y)), v0[3] * silu_f(bfhi(gz.y)));
                    w.z = pg8::cvt_pk_bf16(v1[0] * silu_f(bflo(gz.z)), v1[1] * silu_f(bfhi(gz.z))); w.w = pg8::cvt_pk_bf16(v1[2] * silu_f(bflo(gz.w)), v1[3] * silu_f(bfhi(gz.w)));
                    *(u32x4*)(O + row * DM + coff + col0 + bj * 128) = w; } }
    }
};
struct EpiPart {
    static constexpr bool PERM = false;
    float* P;
    __device__ __forceinline__ void operator()(const pg8::f32x4 (&acc)[2][2][4][2], const pg8::Unit& u, int wr, int wc, int fr, int fq) const {
        const int row0 = u.pm * 256 + wr * 64 + fr, col0 = u.pn * 256 + wc * 32 + 4 * fq;
        float* base = P + (size_t)u.aux * 4096 * 512;
#pragma unroll
        for (int ai = 0; ai < 2; ++ai)
#pragma unroll
            for (int m = 0; m < 4; ++m) { float* rowp = base + (size_t)(row0 + ai * 128 + m * 16) * 512 + col0;
#pragma unroll
                for (int bj = 0; bj < 2; ++bj)
#pragma unroll
                    for (int n = 0; n < 2; ++n) *(pg8::f32x4*)(rowp + bj * 128 + n * 16) = acc[ai][bj][m][n]; }
    }
};
struct EpiRes {
    static constexpr bool PERM = false;
    const float* xin; float* xout; const float* gate;
    __device__ __forceinline__ void operator()(const pg8::f32x4 (&acc)[2][2][4][2], const pg8::Unit& u, int wr, int wc, int fr, int fq) const {
        const int row0 = u.pm * 256 + wr * 64 + fr, col0 = u.pn * 256 + wc * 32 + 4 * fq;
        const float* gp = gate + (size_t)(u.pm >> 4) * 6144 + col0;
        pg8::f32x4 gv[2][2];
#pragma unroll
        for (int bj = 0; bj < 2; ++bj)
#pragma unroll
            for (int n = 0; n < 2; ++n) gv[bj][n] = *(const pg8::f32x4*)(gp + bj * 128 + n * 16);
#pragma unroll
        for (int ai = 0; ai < 2; ++ai)
#pragma unroll
            for (int m = 0; m < 4; ++m) { const size_t ro = (size_t)(row0 + ai * 128 + m * 16) * DM + col0;
#pragma unroll
                for (int bj = 0; bj < 2; ++bj)
#pragma unroll
                    for (int n = 0; n < 2; ++n) { const pg8::f32x4 xi = *(const pg8::f32x4*)(xin + ro + bj * 128 + n * 16);
                        *(pg8::f32x4*)(xout + ro + bj * 128 + n * 16) = xi + gv[bj][n] * acc[ai][bj][m][n]; } }
    }
};

__device__ __forceinline__ void transpose_tile(const float* W, int K, int N, bf16* WT, int item, float* scr) {
    const int tid = otid(), nb = N / 64, kb = item / nb, nbk = item % nb, k0 = kb * 64, n0 = nbk * 64;
#pragma unroll
    for (int i = 0; i < 2; ++i) { const int kk = (tid >> 4) + 32 * i, nn = (tid & 15) * 4;
        const f32x4 v = *(const f32x4*)(W + (size_t)(k0 + kk) * N + n0 + nn);
        scr[kk * 65 + nn] = v[0]; scr[kk * 65 + nn + 1] = v[1]; scr[kk * 65 + nn + 2] = v[2]; scr[kk * 65 + nn + 3] = v[3]; }
    __syncthreads();
    { const int n = tid >> 3, kc = (tid & 7) * 8; const float* s = scr + kc * 65 + n; u32x4 o;
      o.x = pk2(s[0], s[65]); o.y = pk2(s[2 * 65], s[3 * 65]); o.z = pk2(s[4 * 65], s[5 * 65]); o.w = pk2(s[6 * 65], s[7 * 65]);
      *(u32x4*)(WT + (size_t)(n0 + n) * K + k0 + kc) = o; }
    __syncthreads();
}

__device__ __forceinline__ void ph_prologue(const Params& p, unsigned char* lds) {
    const int tid = otid(), lane = tid & 63, wave = tid >> 6, G = gridDim.x, bid = blockIdx.x;
    float* scr = (float*)lds;
    bf16* Wt_in = (bf16*)(p.ws + WS_WIN); bf16* Wt_out = (bf16*)(p.ws + WS_WOUT); bf16* Wt_fft = (bf16*)(p.ws + WS_WFFT); bf16* Wt_pw = (bf16*)(p.ws + WS_WPW);
    constexpr int T_IN = 32 * 104, T_OUT = 32 * 32, T_S = 64, T_L = T_IN + T_OUT + 2 * T_S;
    for (int it = bid; it < NL * T_L; it += G) {
        const int l = it / T_L; int r = it % T_L;
        if (r < T_IN) { transpose_tile(p.w_in + (size_t)l * DM * DIN, DM, DIN, Wt_in + (size_t)l * DIN * DM, r, scr); continue; } r -= T_IN;
        if (r < T_OUT) { transpose_tile(p.w_out + (size_t)l * DM * DM, DM, DM, Wt_out + (size_t)l * DM * DM, r, scr); continue; } r -= T_OUT;
        if (r < T_S) { transpose_tile(p.w_fft + (size_t)l * DG * DG, DG, DG, Wt_fft + (size_t)l * DG * DG, r, scr); continue; } r -= T_S;
        transpose_tile(p.w_pw + (size_t)l * DG * DG, DG, DG, Wt_pw + (size_t)l * DG * DG, r, scr);
    }
    float* cosT = (float*)(lds + 32768); float* sinT = (float*)(lds + 49152); float* ca = (float*)(lds + 65536); float* red = (float*)(lds + 81920);
    for (int j = tid; j < 4096; j += NTHR) { cosT[j] = cospif((float)j * (1.f / 2048.f)); sinT[j] = sinpif((float)j * (1.f / 2048.f)); }
    for (int j = tid; j < 4096; j += NTHR) { const float cv = p.c[j]; ca[j] = cv / (1.f + expf(-cv)); }
    __syncthreads();
    bf16* DFT = (bf16*)(p.ws + WS_DFT);
    for (int k = bid; k < 4096; k += G) {
#pragma unroll
        for (int cc = 0; cc < 2; ++cc) { const int kk0 = (tid + cc * NTHR) * 8; float v[8];
#pragma unroll
            for (int j = 0; j < 8; ++j) { const int kk = kk0 + j, idx = (k * (kk & 4095)) & 4095; v[j] = (kk < 4096) ? cosT[idx] : -sinT[idx]; }
            u32x4 o; o.x = pk2(v[0], v[1]); o.y = pk2(v[2], v[3]); o.z = pk2(v[4], v[5]); o.w = pk2(v[6], v[7]);
            *(u32x4*)(DFT + (size_t)k * 8192 + kk0) = o; }
    }
    { float2* rope = (float2*)(p.ws + WS_ROPE);
      for (int e = bid * NTHR + tid; e < 4096 * 32; e += G * NTHR) { const int s = e >> 5, i = e & 31;
          const float inv = (float)pow(10000.0, -(double)i / 32.0); const float ang = (float)s * inv;
          double sn, cs; sincos((double)ang, &sn, &cs); rope[e] = make_float2((float)cs, (float)sn); } }
    float* mod = (float*)(p.ws + WS_MOD);
    for (int t = bid; t < 192; t += G) {
        const int l = t / 96, col = (t % 96) * 64 + lane; const float* W = p.w_ada + (size_t)l * DM * 6144 + col;
        float a0 = 0.f, a1 = 0.f;
#pragma unroll 8
        for (int k = wave * 256; k < wave * 256 + 256; ++k) { const float w = W[(size_t)k * 6144]; a0 += ca[k] * w; a1 += ca[2048 + k] * w; }
        red[(wave * 2 + 0) * 64 + lane] = a0; red[(wave * 2 + 1) * 64 + lane] = a1;
        __syncthreads();
        if (wave < 2) { float s = 0.f;
#pragma unroll
            for (int w = 0; w < 8; ++w) s += red[(w * 2 + wave) * 64 + lane];
            mod[(size_t)(l * 2 + wave) * 6144 + col] = s + p.b_ada[l * 6144 + col]; }
        __syncthreads();
    }
}

__device__ __forceinline__ void ph_norm(const Params& p, int l) {
    const int tid = otid(), lane = tid & 63, wave = tid >> 6;
    const float* xin = (l == 0) ? p.x : p.out; bf16* h = (bf16*)(p.ws + WS_U); const float* mod = (const float*)(p.ws + WS_MOD);
    for (int row = blockIdx.x * 8 + wave; row < MTOK; row += gridDim.x * 8) {
        const f32x4* xr = (const f32x4*)(xin + (size_t)row * DM) + lane; f32x4 v[8]; float ss = 0.f;
#pragma unroll
        for (int j = 0; j < 8; ++j) { v[j] = xr[64 * j]; ss += (v[j][0] * v[j][0] + v[j][1] * v[j][1]) + (v[j][2] * v[j][2] + v[j][3] * v[j][3]); }
        ss = wave_sum(ss); const float rstd = rsqrtf(ss * (1.f / DM) + 1e-6f);
        const float* md = mod + (size_t)(l * 2 + (row >> 12)) * 6144; const float* g = p.norm_g + l * DM;
#pragma unroll
        for (int j = 0; j < 8; ++j) { const int col = (64 * j + lane) * 4;
            const f32x4 g4 = *(const f32x4*)(g + col), sh = *(const f32x4*)(md + col), sc = *(const f32x4*)(md + 2048 + col);
            const f32x4 o = (v[j] * rstd * g4) * (sc + 1.f) + sh; u32x2 w; w.x = pk2(o[0], o[1]); w.y = pk2(o[2], o[3]);
            *(u32x2*)(h + (size_t)row * DM + col) = w; }
    }
}
__device__ __forceinline__ void ph_final(const Params& p) {
    const int tid = otid(), lane = tid & 63, wave = tid >> 6;
    for (int row = blockIdx.x * 8 + wave; row < MTOK; row += gridDim.x * 8) {
        f32x4* xr = (f32x4*)(p.out + (size_t)row * DM) + lane; f32x4 v[8]; float ss = 0.f;
#pragma unroll
        for (int j = 0; j < 8; ++j) { v[j] = xr[64 * j]; ss += (v[j][0] * v[j][0] + v[j][1] * v[j][1]) + (v[j][2] * v[j][2] + v[j][3] * v[j][3]); }
        ss = wave_sum(ss); const float rstd = rsqrtf(ss * (1.f / DM) + 1e-6f);
#pragma unroll
        for (int j = 0; j < 8; ++j) { const int col = (64 * j + lane) * 4; const f32x4 g4 = *(const f32x4*)(p.final_g + col); xr[64 * j] = v[j] * rstd * g4; }
    }
}

__device__ __forceinline__ void ret_task(const Params& p, int l, int task, unsigned char* lds) {
    const int tid = otid(), qt = task & 63, h = (task >> 6) & 7, b = task >> 9;
    float* Qs = (float*)lds; float* Ks = Qs + 64 * 68; float* Vs = Ks + 64 * 68; float* Ss = Vs + 64 * 68;
    const bf16* Z = (const bf16*)(p.ws + WS_Z); const float2* rope = (const float2*)(p.ws + WS_ROPE);
    const float xf = p.rl_f[l * 8 + h], xb = p.rl_b[l * 8 + h];
    const float l2f = -log1pf(expf(-xf)) * 1.4426950408889634f, l2b = -log1pf(expf(-xb)) * 1.4426950408889634f;
    const int i = tid >> 3, c8 = tid & 7;
    { const int s = qt * 64 + i; const bf16* zr = Z + (size_t)(b * SEQ + s) * DIN + 6 * DG + h * 64;
#pragma unroll
      for (int j = 0; j < 4; ++j) { const int dd = c8 * 4 + j; const float2 cs = rope[s * 32 + dd]; const float q1 = bf2f(zr[dd]), q2 = bf2f(zr[dd + 32]);
          Qs[i * 68 + dd] = (q1 * cs.x - q2 * cs.y) * 0.125f; Qs[i * 68 + dd + 32] = (q1 * cs.y + q2 * cs.x) * 0.125f; } }
    float o[8];
#pragma unroll
    for (int j = 0; j < 8; ++j) o[j] = 0.f;
    const int gi = qt * 64 + i;
    for (int kt = 0; kt < 64; ++kt) {
        { const int s = kt * 64 + i; const bf16* zr = Z + (size_t)(b * SEQ + s) * DIN + 7 * DG + h * 64;
#pragma unroll
          for (int j = 0; j < 4; ++j) { const int dd = c8 * 4 + j; const float2 cs = rope[s * 32 + dd]; const float k1 = bf2f(zr[dd]), k2 = bf2f(zr[dd + 32]);
              Ks[i * 68 + dd] = k1 * cs.x - k2 * cs.y; Ks[i * 68 + dd + 32] = k1 * cs.y + k2 * cs.x; }
          const u32x4 vv = *(const u32x4*)(zr + DG + c8 * 8); float* vd = Vs + i * 68 + c8 * 8;
          vd[0] = bflo(vv.x); vd[1] = bfhi(vv.x); vd[2] = bflo(vv.y); vd[3] = bfhi(vv.y); vd[4] = bflo(vv.z); vd[5] = bfhi(vv.z); vd[6] = bflo(vv.w); vd[7] = bfhi(vv.w); }
        __syncthreads();
        float sc[8];
#pragma unroll
        for (int j = 0; j < 8; ++j) sc[j] = 0.f;
#pragma unroll 4
        for (int d = 0; d < 64; d += 4) { const f32x4 q4 = *(const f32x4*)(Qs + i * 68 + d);
#pragma unroll
            for (int j = 0; j < 8; ++j) { const f32x4 k4 = *(const f32x4*)(Ks + (c8 * 8 + j) * 68 + d); sc[j] += (q4[0] * k4[0] + q4[1] * k4[1]) + (q4[2] * k4[2] + q4[3] * k4[3]); } }
#pragma unroll
        for (int j = 0; j < 8; ++j) { const int gj = kt * 64 + c8 * 8 + j; const float w = (gj <= gi) ? exp2f(l2f * (float)(gi - gj)) : exp2f(l2b * (float)(gj - gi)); Ss[i * 68 + c8 * 8 + j] = sc[j] * w; }
        __syncthreads();
#pragma unroll 4
        for (int jj = 0; jj < 64; jj += 4) { const f32x4 s4 = *(const f32x4*)(Ss + i * 68 + jj);
#pragma unroll
            for (int t = 0; t < 4; ++t) { const f32x4 va = *(const f32x4*)(Vs + (jj + t) * 68 + c8 * 8), vb = *(const f32x4*)(Vs + (jj + t) * 68 + c8 * 8 + 4);
                o[0] += s4[t] * va[0]; o[1] += s4[t] * va[1]; o[2] += s4[t] * va[2]; o[3] += s4[t] * va[3]; o[4] += s4[t] * vb[0]; o[5] += s4[t] * vb[1]; o[6] += s4[t] * vb[2]; o[7] += s4[t] * vb[3]; } }
        __syncthreads();
    }
    float ss = 0.f;
#pragma unroll
    for (int j = 0; j < 8; ++j) ss += o[j] * o[j];
    ss += __shfl_xor(ss, 1); ss += __shfl_xor(ss, 2); ss += __shfl_xor(ss, 4);
    const float rs = rsqrtf(ss * (1.f / 64.f) + 1e-6f);
    const size_t tok = (size_t)b * SEQ + gi;
    const u32x4 gz = *(const u32x4*)(Z + tok * DIN + 9 * DG + h * 64 + c8 * 8); u32x4 w;
    w.x = pk2(o[0] * rs * silu_f(bflo(gz.x)), o[1] * rs * silu_f(bfhi(gz.x))); w.y = pk2(o[2] * rs * silu_f(bflo(gz.y)), o[3] * rs * silu_f(bfhi(gz.y)));
    w.z = pk2(o[4] * rs * silu_f(bflo(gz.z)), o[5] * rs * silu_f(bfhi(gz.z))); w.w = pk2(o[6] * rs * silu_f(bflo(gz.w)), o[7] * rs * silu_f(bfhi(gz.w)));
    *(u32x4*)((bf16*)(p.ws + WS_CAT) + tok * DM + 1024 + h * 64 + c8 * 8) = w;
}

__device__ __forceinline__ void na_task(const Params& p, int l, int task) {
    const int tid = otid(), lane = tid & 63, h = tid >> 6;
    const int half = task & 1, r = (task >> 1) & 63, b = task >> 7;
    const bf16* Z = (const bf16*)(p.ws + WS_Z); bf16* CAT = (bf16*)(p.ws + WS_CAT);
    const int row_start = min(max(r - 4, 0), 56);
    const float* bias = p.na_bias + (size_t)(l * 8 + h) * 15 * 31;
    for (int c = half * 32; c < half * 32 + 32; ++c) {
        const int col_start = min(max(c - 8, 0), 48);
        const size_t qtok = (size_t)b * SEQ + r * 64 + c;
        const u32x4* qp = (const u32x4*)(Z + qtok * DIN + 2 * DG + h * 64);
        u32x4 q[8];
#pragma unroll
        for (int j = 0; j < 8; ++j) q[j] = qp[j];
        float sA, sB;
        const int a = lane >> 4, kc = col_start + (lane & 15);
#pragma unroll
        for (int hh = 0; hh < 2; ++hh) {
            const int krow = row_start + a + 4 * hh; const size_t ktok = (size_t)b * SEQ + krow * 64 + kc;
            const u32x4* kp = (const u32x4*)(Z + ktok * DIN + 3 * DG + h * 64); float dot = 0.f;
#pragma unroll
            for (int j = 0; j < 8; ++j) { const u32x4 kv = kp[j];
                dot += bflo(q[j].x) * bflo(kv.x) + bfhi(q[j].x) * bfhi(kv.x) + bflo(q[j].y) * bflo(kv.y) + bfhi(q[j].y) * bfhi(kv.y)
                     + bflo(q[j].z) * bflo(kv.z) + bfhi(q[j].z) * bfhi(kv.z) + bflo(q[j].w) * bflo(kv.w) + bfhi(q[j].w) * bfhi(kv.w); }
            const int dr = krow - r, dc = kc - c;
            const float s = dot * 0.125f + bias[(dr + 7) * 31 + min(max(dc + 15, 0), 30)];
            if (hh == 0) sA = s; else sB = s;
        }
        const float mx = wave_max(fmaxf(sA, sB));
        float pA = __expf(sA - mx), pB = __expf(sB - mx);
        const float inv = 1.f / wave_sum(pA + pB); pA *= inv; pB *= inv;
        float o = 0.f;
        for (int kk = 0; kk < 128; ++kk) {
            const float pv = __shfl((kk & 64) ? pB : pA, kk & 63);
            const int a2 = ((kk & 63) >> 4) + ((kk >> 6) << 2), kc2 = col_start + (kk & 15);
            const size_t vtok = (size_t)b * SEQ + (row_start + a2) * 64 + kc2;
            o += pv * bf2f(Z[vtok * DIN + 4 * DG + h * 64 + lane]);
        }
        const float g = bf2f(Z[qtok * DIN + 5 * DG + h * 64 + lane]);
        CAT[qtok * DM + 512 + h * 64 + lane] = (bf16)f2bf(o * silu_f(g));
    }
}

__device__ __forceinline__ void conv_task(const Params& p, int l, int task, unsigned char* lds) {
    const int tid = otid(), lane = tid & 63, wave = tid >> 6;
    float* us = (float*)lds; float* ys = us + 46 * 512;
    const bf16* Z = (const bf16*)(p.ws + WS_Z);
    const int b = task >> 8, t0 = (task & 255) * 16;
    for (int tt = 0; tt < 46; ++tt) { const int tok = t0 - 15 + tt; float u = 0.f;
        if (tok >= 0 && tok < SEQ) { const bf16* zr = Z + (size_t)(b * SEQ + tok) * DIN; const float a = bf2f(zr[10 * DG + tid]), g = bf2f(zr[11 * DG + tid]); u = a / (1.f + __expf(-g)); }
        us[tt * 512 + tid] = u; }
    float w[31];
#pragma unroll
    for (int k = 0; k < 31; ++k) w[k] = p.conv_w[(size_t)(l * 31 + k) * DG + tid];
    const float cb = p.conv_b[l * DG + tid];
    __syncthreads();
    for (int t = 0; t < 16; ++t) { float acc = cb;
#pragma unroll
        for (int k = 0; k < 31; ++k) acc += w[k] * us[(t + k) * 512 + tid];
        ys[t * 512 + tid] = acc; }
    __syncthreads();
#pragma unroll
    for (int tw = 0; tw < 2; ++tw) { const int t = wave + 8 * tw; float v[8]; float s = 0.f;
#pragma unroll
        for (int j = 0; j < 8; ++j) { v[j] = ys[t * 512 + lane + 64 * j]; s += v[j]; }
        const float mu = wave_sum(s) * (1.f / 512.f); float q = 0.f;
#pragma unroll
        for (int j = 0; j < 8; ++j) { v[j] -= mu; q += v[j] * v[j]; }
        const float rstd = rsqrtf(wave_sum(q) * (1.f / 512.f) + 1e-6f);
        bf16* orow = (bf16*)(p.ws + WS_CVH) + (size_t)(b * SEQ + t0 + t) * DG;
#pragma unroll
        for (int j = 0; j < 8; ++j) { const int ch = lane + 64 * j; const float y = v[j] * rstd * p.ln_g[l * DG + ch] + p.ln_b[l * DG + ch]; orow[ch] = (bf16)f2bf(silu_f(y)); } }
    __syncthreads();
}

__device__ __forceinline__ void f1_task(const Params& p, int task, unsigned char* lds) {
    const int tid = otid();
    float* us = (float*)lds; float* cs = us + 8 * 512; float* sn = cs + 128;
    const bf16* Z = (const bf16*)(p.ws + WS_Z);
    const int tok0 = task * 8, b = tok0 >> 12, s0 = tok0 & 4095;
    if (tid < 128) { cs[tid] = cospif((float)tid * (1.f / 64.f)); sn[tid] = sinpif((float)tid * (1.f / 64.f)); }
#pragma unroll
    for (int tk = 0; tk < 8; ++tk) us[tk * 512 + tid] = bf2f(Z[(size_t)(tok0 + tk) * DIN + tid]);
    __syncthreads();
    const int g = tid >> 7, m = tid & 127;
    float P[8], Q[8];
#pragma unroll
    for (int tk = 0; tk < 8; ++tk) { P[tk] = 0.f; Q[tk] = 0.f; }
    for (int c = 0; c < 128; ++c) { const int idx = (m * c) & 127; const float cv = cs[idx], sv = sn[idx];
#pragma unroll
        for (int tk = 0; tk < 8; ++tk) { const float u = us[tk * 512 + g * 128 + c]; P[tk] += u * cv; Q[tk] += u * sv; } }
    const float nrm = 0.0013810679320049757f;
    bf16* PQ = (bf16*)(p.ws + WS_PQT) + ((size_t)(b * 512 + tid) * 2) * 4096 + s0;
    u32x4 o; o.x = pk2(P[0] * nrm, P[1] * nrm); o.y = pk2(P[2] * nrm, P[3] * nrm); o.z = pk2(P[4] * nrm, P[5] * nrm); o.w = pk2(P[6] * nrm, P[7] * nrm);
    *(u32x4*)PQ = o;
    o.x = pk2(Q[0] * nrm, Q[1] * nrm); o.y = pk2(Q[2] * nrm, Q[3] * nrm); o.z = pk2(Q[4] * nrm, Q[5] * nrm); o.w = pk2(Q[6] * nrm, Q[7] * nrm);
    *(u32x4*)(PQ + 4096) = o;
    __syncthreads();
}

__device__ __forceinline__ void ph_mixA(const Params& p, int l, unsigned char* lds) {
    const int G = gridDim.x, bid = blockIdx.x;
    for (int t = bid; t < 1024; t += G) ret_task(p, l, t, lds);
    for (int t = bid; t < 256; t += G) na_task(p, l, t);
    __syncthreads();
    for (int t = bid; t < 512; t += G) conv_task(p, l, t, lds);
    for (int t = bid; t < 1024; t += G) f1_task(p, t, lds);
}

__device__ __forceinline__ void ph_combine(const Params& p) {
    const float* part = (const float*)(p.ws + WS_U); bf16* Y = (bf16*)(p.ws + WS_Y);
    for (int e = blockIdx.x * NTHR + threadIdx.x; e < MTOK * DG / 4; e += gridDim.x * NTHR) {
        const int row = e >> 7, c4 = (e & 127) * 4, b = row >> 12, k = row & 4095;
        f32x4 s = {0.f, 0.f, 0.f, 0.f};
#pragma unroll
        for (int ks = 0; ks < 4; ++ks) s += *(const f32x4*)(part + ((size_t)((b * 4 + ks) * 4096 + k)) * 512 + c4);
        u32x2 w; w.x = pk2(s[0], s[1]); w.y = pk2(s[2], s[3]);
        *(u32x2*)(Y + (size_t)row * DG + c4) = w;
    }
}

constexpr int NPH = 16;
__global__ void __launch_bounds__(NTHR) mega(Params p) {
    extern __shared__ __attribute__((aligned(16))) unsigned char lds[];
    cg::grid_group grid = cg::this_grid();
    PG8_LAS unsigned char* ldsl = (PG8_LAS unsigned char*)lds;
    const int lo = p.ph_lo, hi = p.ph_hi;
#define IN(k) (lo <= (k) && (k) < hi)
#define SEAM(k) do { if (IN(k) && IN((k) + 1)) { __threadfence(); grid.sync(); } } while (0)
    bf16* Zb = (bf16*)(p.ws + WS_Z); bf16* CAT = (bf16*)(p.ws + WS_CAT);
#ifndef T_NOPRO
    if (IN(0)) ph_prologue(p, lds);
#endif
    SEAM(0);
#pragma unroll
    for (int l = 0; l < NL; ++l) {
        const int pb = 1 + 7 * l;
#ifndef T_NONORM
        if (IN(pb)) ph_norm(p, l);
#endif
        SEAM(pb);
        if (IN(pb + 1)) {
            SchedS S = make_sched(p.ws + WS_U, DM, p.ws + WS_WIN + (size_t)l * DIN * DM * 2, DM, MTOK, DIN);
            EpiZ E{Zb, DIN};
            pg8::gemm_phase<EpiZ, SchedS, true>(ldsl, pg8::Gemm{DM, DM, DM}, S, E);
        }
        SEAM(pb + 1);
#ifndef T_NOMIX
        if (IN(pb + 2)) ph_mixA(p, l, lds);
#endif
        SEAM(pb + 2);
#ifndef T_ONEGEMM
        if (IN(pb + 3)) {
#ifndef T_NOG1
            { SchedDFT S{(const char*)(p.ws + WS_DFT), (const char*)(p.ws + WS_PQT), (int)gridDim.x, (int)blockIdx.x};
              EpiPart E{(float*)(p.ws + WS_U)};
              pg8::gemm_phase<EpiPart, SchedDFT, true>(ldsl, pg8::Gemm{8192, 8192, 2048}, S, E); }
#endif
#ifndef T_NOG2
            { SchedS S = make_sched(p.ws + WS_CVH, DG, p.ws + WS_WPW + (size_t)l * DG * DG * 2, DG, MTOK, DG);
              EpiGate E{CAT, Zb, 1536, 12 * DG};
              pg8::gemm_phase<EpiGate, SchedS, true>(ldsl, pg8::Gemm{DG, DG, DG}, S, E); }
#endif
        }
        SEAM(pb + 3);
        if (IN(pb + 4)) ph_combine(p);
        SEAM(pb + 4);
#ifndef T_NOG3
        if (IN(pb + 5)) {
            SchedS S = make_sched(p.ws + WS_Y, DG, p.ws + WS_WFFT + (size_t)l * DG * DG * 2, DG, MTOK, DG);
            EpiGate E{CAT, Zb, 0, 1 * DG};
            pg8::gemm_phase<EpiGate, SchedS, true>(ldsl, pg8::Gemm{DG, DG, DG}, S, E);
        }
#endif
        SEAM(pb + 5);
#ifndef T_NOG4
        if (IN(pb + 6)) {
            SchedS S = make_sched(CAT, DM, p.ws + WS_WOUT + (size_t)l * DM * DM * 2, DM, MTOK, DM);
            EpiRes E{(l == 0) ? p.x : p.out, p.out, (const float*)(p.ws + WS_MOD) + (size_t)l * 2 * 6144 + 4096};
            pg8::gemm_phase<EpiRes, SchedS, true>(ldsl, pg8::Gemm{DM, DM, DM}, S, E);
        }
#endif
        SEAM(pb + 6);
#endif
    }
    if (IN(NPH - 1)) ph_final(p);
#undef IN
#undef SEAM
}

extern "C" void kernel_launch(void* const* d_in, const int* in_sizes, int n_in, void* d_out, int out_size, void* d_ws, size_t ws_size, hipStream_t stream) {
    static int grid_blocks = 0;
    if (grid_blocks == 0) {
        if (n_in != 17 || ws_size < WS_END) { fprintf(stderr, "kernel_launch: n_in %d ws %zu (need %zu)\n", n_in, ws_size, (size_t)WS_END); grid_blocks = -1; return; }
        int dev = 0, cus = 0, per_cu = 0;
        hipGetDevice(&dev); hipDeviceGetAttribute(&cus, hipDeviceAttributeMultiprocessorCount, dev);
        if (hipFuncSetAttribute((const void*)mega, hipFuncAttributeMaxDynamicSharedMemorySize, LDS_BYTES) != hipSuccess) { fprintf(stderr, "hipFuncSetAttribute failed\n"); grid_blocks = -1; return; }
        if (hipOccupancyMaxActiveBlocksPerMultiprocessor(&per_cu, (const void*)mega, NTHR, LDS_BYTES) != hipSuccess || per_cu < 1) { fprintf(stderr, "occupancy query: %d\n", per_cu); per_cu = 1; }
        (void)hipGetLastError();
        grid_blocks = cus * 1;
    }
    if (grid_blocks < 0) return;
    Params p{};
    p.x = (const float*)d_in[0]; p.c = (const float*)d_in[1]; p.norm_g = (const float*)d_in[2]; p.w_ada = (const float*)d_in[3]; p.b_ada = (const float*)d_in[4];
    p.w_in = (const float*)d_in[5]; p.w_fft = (const float*)d_in[6]; p.na_bias = (const float*)d_in[7]; p.rl_f = (const float*)d_in[8]; p.rl_b = (const float*)d_in[9];
    p.conv_w = (const float*)d_in[10]; p.conv_b = (const float*)d_in[11]; p.ln_g = (const float*)d_in[12]; p.ln_b = (const float*)d_in[13]; p.w_pw = (const float*)d_in[14];
    p.w_out = (const float*)d_in[15]; p.final_g = (const float*)d_in[16];
    p.out = (float*)d_out; p.ws = (unsigned char*)d_ws;
#if ONE_LAUNCH
    p.ph_lo = 0; p.ph_hi = NPH;
    void* args[] = {&p};
    hipError_t e = hipLaunchCooperativeKernel((const void*)mega, dim3(grid_blocks), dim3(NTHR), args, LDS_BYTES, stream);
    if (e != hipSuccess) fprintf(stderr, "cooperative launch failed: %s (grid %d)\n", hipGetErrorString(e), grid_blocks);
#else
    for (int ph = 0; ph < NPH; ++ph) { p.ph_lo = ph; p.ph_hi = ph + 1; hipLaunchKernelGGL(mega, dim3(grid_blocks), dim3(NTHR), LDS_BYTES, stream, p); }
#endif
}
```

```cpp
#include <hip/hip_runtime.h>
#include <hip/hip_cooperative_groups.h>
#include <cstdio>
#include <cstdint>
namespace cg = cooperative_groups;

#ifndef ONE_LAUNCH
#define ONE_LAUNCH 1
#endif

__device__ __forceinline__ int otid() { int t; asm volatile("v_mov_b32 %0, %1" : "=v"(t) : "v"(threadIdx.x)); return t; }
namespace pg8 {
#define PG8_LAS __attribute__((address_space(3)))
typedef unsigned short bf16_t;
typedef short bf16x8 __attribute__((ext_vector_type(8)));
typedef float f32x4 __attribute__((ext_vector_type(4)));
typedef unsigned u32x4 __attribute__((ext_vector_type(4)));
constexpr int BM = 256, BK = 64, HALF = 128, HTB = HALF * BK * 2, STAGE_BYTES = 8 * HTB, NXCD = 8, WGM = 8;

__host__ __device__ __forceinline__ int lds_byte(int r, int c) { const int st = (r >> 4) * 2 + (c >> 5), rr = r & 15, cc = c & 31, ob = rr * 64 + cc * 2; return st * 1024 + (ob ^ (((ob >> 9) & 1) << 5)); }
__host__ __device__ __forceinline__ void stage_rc(int b, int& R, int& C) { const int st = b / 1024, sb = b % 1024, swz = sb ^ (((sb >> 9) & 1) << 5); R = (st >> 1) * 16 + swz / 64; C = (st & 1) * 32 + (swz % 64) / 2; }
__host__ __device__ __forceinline__ int perm32(int rho) { const int n = rho >> 4, i = rho & 15; return 8 * (i >> 2) + 4 * n + (i & 3); }

struct Unit { int pm, pn, aux, pad; const char* A; const char* B; };
struct Gemm { int lda, ldb, K; };

struct StaticOrder {
    int nM, nN, nwg, G, c;
    __host__ __device__ void init(int M, int N, int G_, int c_) { nM = M / BM; nN = N / BM; nwg = nM * nN; G = G_; c = c_; }
    __device__ bool next(int i, Unit& u) const {
        const long L = (long)i * G + c; if (L >= nwg) return false;
        int wgid = __builtin_amdgcn_readfirstlane((int)L); { const int q = nwg / NXCD, r = nwg % NXCD, xcd = wgid % NXCD, off = wgid / NXCD; wgid = (xcd < r ? xcd * (q + 1) : r * (q + 1) + (xcd - r) * q) + off; }
        const int nig = WGM * nN, gid = wgid / nig, fm = gid * WGM, gsz = (nM - fm) < WGM ? (nM - fm) : WGM;
        u.pm = __builtin_amdgcn_readfirstlane(fm + ((wgid % nig) % gsz)); u.pn = __builtin_amdgcn_readfirstlane((wgid % nig) / gsz); return true;
    }
};

__device__ __forceinline__ unsigned cvt_pk_bf16(float lo, float hi) { unsigned r; asm volatile("v_cvt_pk_bf16_f32 %0, %1, %2" : "=v"(r) : "v"(lo), "v"(hi)); return r; }

template <class Epi, class Sched, bool ALIGN_EPI>
__device__ __forceinline__ void gemm_phase(PG8_LAS unsigned char* lds, const Gemm g, const Sched& S, const Epi& E) {
    const int tid = otid(), wid = __builtin_amdgcn_readfirstlane(tid >> 6), lane = tid & 63, wr = wid >> 2, wc = wid & 3, fr = lane & 15, fq = lane >> 4;
    const int K = g.K, nt = K / BK;
    unsigned voffA[2], voffB[2];
#pragma unroll
    for (int i = 0; i < 2; ++i) { int R, C; stage_rc(tid * 16 + i * 8192, R, C); const int Rb = Epi::PERM ? ((R & ~31) + perm32(R & 31)) : R;
        voffA[i] = (unsigned)(R * g.lda + C) * 2u; voffB[i] = (unsigned)(Rb * g.ldb + C) * 2u; }
    const size_t kstep = (size_t)(BK * 2);
    const size_t hA = (size_t)HALF * g.lda * 2, hB = (size_t)HALF * g.ldb * 2;
    const unsigned ldsw = (unsigned)wid * 1024u;
    const int aoff = lds_byte(wr * 64 + fr, fq * 8), boff = lds_byte(wc * 32 + fr, fq * 8);
#define PG8_SA(b, h) (((b) * 2 + (h)) * HTB)
#define PG8_SB(b, h) ((4 + (b) * 2 + (h)) * HTB)
#define PG8_STAGE(bufoff, gbase, voff) do { _Pragma("unroll") for (int _i = 0; _i < 2; ++_i) \
        __builtin_amdgcn_global_load_lds((const unsigned*)((const char*)(gbase) + (voff)[_i]), (PG8_LAS unsigned*)(lds + (bufoff) + ldsw + _i * 8192), 16, 0, 0); } while (0)
#define PG8_LDA(dst, b, h) do { _Pragma("unroll") for (int m = 0; m < 4; ++m) _Pragma("unroll") for (int k = 0; k < 2; ++k) dst[m][k] = *(const PG8_LAS bf16x8*)(lds + PG8_SA(b, h) + aoff + m * 2048 + k * 1024); } while (0)
#define PG8_LDB(dst, b, h) do { _Pragma("unroll") for (int n = 0; n < 2; ++n) _Pragma("unroll") for (int k = 0; k < 2; ++k) dst[n][k] = *(const PG8_LAS bf16x8*)(lds + PG8_SB(b, h) + boff + n * 2048 + k * 1024); } while (0)
#define PG8_MMA(ai, bj, At, Bt) do { __builtin_amdgcn_s_setprio(1); _Pragma("unroll") for (int m = 0; m < 4; ++m) _Pragma("unroll") for (int n = 0; n < 2; ++n) _Pragma("unroll") for (int k = 0; k < 2; ++k) \
        acc[ai][bj][m][n] = __builtin_amdgcn_mfma_f32_16x16x32_bf16(Bt[n][k], At[m][k], acc[ai][bj][m][n], 0, 0, 0); __builtin_amdgcn_s_setprio(0); } while (0)
#define PG8_WAIT_V(n) asm volatile("s_waitcnt vmcnt(" #n ")" ::: "memory")
#define PG8_WAIT_L(n) asm volatile("s_waitcnt lgkmcnt(" #n ")" ::: "memory")
#define PG8_BAR __builtin_amdgcn_s_barrier()
#define PG8_SCHED __builtin_amdgcn_sched_barrier(0)
    Unit cur, nxt; int ui = 0;
    if (!S.next(0, cur)) return;
    f32x4 acc[2][2][4][2];
#pragma unroll
    for (int a = 0; a < 2; ++a)
#pragma unroll
        for (int b = 0; b < 2; ++b)
#pragma unroll
            for (int m = 0; m < 4; ++m)
#pragma unroll
                for (int n = 0; n < 2; ++n) acc[a][b][m][n] = (f32x4){0.f, 0.f, 0.f, 0.f};
    bf16x8 At[4][2], B0[2][2], B1[2][2];
    const char* cA = cur.A; const char* cB = cur.B;
    PG8_STAGE(PG8_SB(0, 0), cB, voffB); PG8_STAGE(PG8_SB(0, 1), cB + hB, voffB); PG8_STAGE(PG8_SA(0, 0), cA, voffA); PG8_STAGE(PG8_SA(0, 1), cA + hA, voffA);
    if (wr == 1) PG8_BAR;
    PG8_WAIT_V(2); PG8_BAR;
    PG8_STAGE(PG8_SB(1, 0), cB + kstep, voffB); PG8_STAGE(PG8_SA(1, 0), cA + kstep, voffA); PG8_STAGE(PG8_SB(1, 1), cB + hB + kstep, voffB);
    PG8_WAIT_V(6); PG8_BAR;
    for (;;) {
        const bool has_next = S.next(ui + 1, nxt);
        const char* nA = has_next ? nxt.A : cA; const char* nB = has_next ? nxt.B : cB;
        for (int t = 0; t < nt; t += 2) {
            const bool last = (t == nt - 2);
            const char* a1 = cA + (size_t)(t + 1) * kstep;
            const char* a2 = last ? nA : cA + (size_t)(t + 2) * kstep; const char* b2 = last ? nB : cB + (size_t)(t + 2) * kstep;
            const char* a3 = a2 + kstep; const char* b3 = b2 + kstep;
            PG8_LDB(B0, 0, 0); PG8_LDB(B1, 0, 1); PG8_SCHED; PG8_LDA(At, 0, 0); PG8_STAGE(PG8_SA(1, 1), a1 + hA, voffA);
            PG8_WAIT_V(8); PG8_WAIT_L(0); PG8_BAR; PG8_MMA(0, 0, At, B0); PG8_MMA(0, 1, At, B1); PG8_BAR; PG8_SCHED;
            PG8_LDA(At, 0, 1); PG8_STAGE(PG8_SB(0, 0), b2, voffB); PG8_STAGE(PG8_SB(0, 1), b2 + hB, voffB); PG8_STAGE(PG8_SA(0, 0), a2, voffA);
            PG8_WAIT_V(8); PG8_WAIT_L(0); PG8_BAR; PG8_MMA(1, 0, At, B0); PG8_MMA(1, 1, At, B1); PG8_BAR; PG8_SCHED;
            PG8_LDB(B0, 1, 0); PG8_LDB(B1, 1, 1); PG8_SCHED; PG8_LDA(At, 1, 0); PG8_STAGE(PG8_SA(0, 1), a2 + hA, voffA);
            PG8_WAIT_V(8); PG8_WAIT_L(0); PG8_BAR; PG8_MMA(0, 0, At, B0); PG8_MMA(0, 1, At, B1); PG8_BAR; PG8_SCHED;
            PG8_LDA(At, 1, 1); PG8_STAGE(PG8_SB(1, 0), b3, voffB); PG8_STAGE(PG8_SB(1, 1), b3 + hB, voffB); PG8_STAGE(PG8_SA(1, 0), a3, voffA);
            PG8_WAIT_V(8); PG8_WAIT_L(0); PG8_BAR; PG8_MMA(1, 0, At, B0); PG8_MMA(1, 1, At, B1); PG8_BAR; PG8_SCHED;
        }
        if constexpr (ALIGN_EPI) { if (wr == 0) PG8_BAR; }
        E(acc, cur, wr, wc, fr, fq);
        if (!has_next) break;
#pragma unroll
        for (int a = 0; a < 2; ++a)
#pragma unroll
            for (int b = 0; b < 2; ++b)
#pragma unroll
                for (int m = 0; m < 4; ++m)
#pragma unroll
                    for (int n = 0; n < 2; ++n) acc[a][b][m][n] = (f32x4){0.f, 0.f, 0.f, 0.f};
        cur = nxt; cA = nA; cB = nB; ++ui;
        if constexpr (ALIGN_EPI) { if (wr == 1) PG8_BAR; }
    }
    PG8_WAIT_V(0);
    if constexpr (!ALIGN_EPI) { if (wr == 0) PG8_BAR; }
    PG8_BAR;
#undef PG8_SA
#undef PG8_SB
#undef PG8_STAGE
#undef PG8_LDA
#undef PG8_LDB
#undef PG8_MMA
#undef PG8_WAIT_V
#undef PG8_WAIT_L
#undef PG8_BAR
#undef PG8_SCHED
}
}

typedef unsigned short bf16;
typedef float f32x4 __attribute__((ext_vector_type(4)));
typedef unsigned u32x4 __attribute__((ext_vector_type(4)));
typedef unsigned u32x2 __attribute__((ext_vector_type(2)));
constexpr int NB = 2, SEQ = 4096, DM = 2048, MTOK = NB * SEQ, DIN = 6656, DG = 512, NL = 2;
constexpr int LDS_BYTES = 147456;
constexpr int NTHR = 512;

constexpr size_t WS_WIN = 0;
constexpr size_t WS_WOUT = WS_WIN + (size_t)NL * DIN * DM * 2;
constexpr size_t WS_WFFT = WS_WOUT + (size_t)NL * DM * DM * 2;
constexpr size_t WS_WPW = WS_WFFT + (size_t)NL * DG * DG * 2;
constexpr size_t WS_DFT = WS_WPW + (size_t)NL * DG * DG * 2;
constexpr size_t WS_ROPE = WS_DFT + (size_t)SEQ * 2 * SEQ * 2;
constexpr size_t WS_MOD = WS_ROPE + (size_t)SEQ * 32 * 8;
constexpr size_t WS_U = WS_MOD + 131072;
constexpr size_t WS_Z = WS_U + (size_t)4 * MTOK * DG * 4;
constexpr size_t WS_PQT = WS_Z + (size_t)MTOK * DIN * 2;
constexpr size_t WS_Y = WS_PQT + (size_t)NB * DG * 2 * SEQ * 2;
constexpr size_t WS_CVH = WS_Y + (size_t)MTOK * DG * 2;
constexpr size_t WS_CAT = WS_CVH + (size_t)MTOK * DG * 2;
constexpr size_t WS_KV = WS_CAT + (size_t)MTOK * DM * 2;
constexpr size_t WS_END = WS_KV + (size_t)2 * NB * 8 * 32 * 4096 * 4;

struct Params {
    const float* x; const float* c; const float* norm_g; const float* w_ada; const float* b_ada; const float* w_in; const float* w_fft; const float* na_bias;
    const float* rl_f; const float* rl_b; const float* conv_w; const float* conv_b; const float* ln_g; const float* ln_b; const float* w_pw; const float* w_out; const float* final_g;
    float* out; unsigned char* ws; int ph_lo, ph_hi;
};

__device__ __forceinline__ unsigned f2bf(float f) { unsigned u = __float_as_uint(f); return (u + 0x7fffu + ((u >> 16) & 1u)) >> 16; }
__device__ __forceinline__ unsigned pk2(float lo, float hi) { return f2bf(lo) | (f2bf(hi) << 16); }
__device__ __forceinline__ float bf2f(bf16 b) { return __uint_as_float((unsigned)b << 16); }
__device__ __forceinline__ float bflo(unsigned u) { return __uint_as_float(u << 16); }
__device__ __forceinline__ float bfhi(unsigned u) { return __uint_as_float(u & 0xffff0000u); }
__device__ __forceinline__ float silu_f(float v) { return v / (1.f + __expf(-v)); }
__device__ __forceinline__ float wave_sum(float v) {
#pragma unroll
    for (int o = 1; o < 64; o <<= 1) v += __shfl_xor(v, o);
    return v;
}
__device__ __forceinline__ float wave_max(float v) {
#pragma unroll
    for (int o = 1; o < 64; o <<= 1) v = fmaxf(v, __shfl_xor(v, o));
    return v;
}

struct SchedS {
    pg8::StaticOrder o; const char* A; const char* B; size_t ta, tb;
    __device__ __forceinline__ bool next(int i, pg8::Unit& u) const { if (!o.next(i, u)) return false; u.A = A + (size_t)u.pm * ta; u.B = B + (size_t)u.pn * tb; u.aux = 0; return true; }
};
__device__ __forceinline__ SchedS make_sched(const void* A, int lda, const void* B, int ldb, int M, int N) {
    SchedS s; s.o.init(M, N, (int)gridDim.x, (int)blockIdx.x); s.A = (const char*)A; s.B = (const char*)B; s.ta = (size_t)256 * lda * 2; s.tb = (size_t)256 * ldb * 2; return s;
}
struct SchedDFT {
    const char* A; const char* B; int G, c;
    __device__ __forceinline__ bool next(int i, pg8::Unit& u) const {
        const int L = __builtin_amdgcn_readfirstlane(i * G + c); if (L >= 256) return false;
        const int sub = L >> 5, t = L & 31; u.pm = t >> 1; u.pn = t & 1; u.aux = sub;
        u.A = A + (size_t)((u.pm << 22) + ((sub & 3) << 12)); u.B = B + (size_t)(((sub >> 2) << 23) + (u.pn << 22) + ((sub & 3) << 12)); return true;
    }
};

struct EpiZ {
    static constexpr bool PERM = true;
    bf16* O; int ldc;
    __device__ __forceinline__ void operator()(const pg8::f32x4 (&acc)[2][2][4][2], const pg8::Unit& u, int wr, int wc, int fr, int fq) const {
        const int row0 = u.pm * 256 + wr * 64 + fr, col0 = u.pn * 256 + wc * 32 + 8 * fq;
#pragma unroll
        for (int ai = 0; ai < 2; ++ai)
#pragma unroll
            for (int m = 0; m < 4; ++m) { bf16* rowp = O + (size_t)(row0 + ai * 128 + m * 16) * ldc + col0;
#pragma unroll
                for (int bj = 0; bj < 2; ++bj) { const pg8::f32x4 v0 = acc[ai][bj][m][0], v1 = acc[ai][bj][m][1]; u32x4 w;
                    w.x = pg8::cvt_pk_bf16(v0[0], v0[1]); w.y = pg8::cvt_pk_bf16(v0[2], v0[3]); w.z = pg8::cvt_pk_bf16(v1[0], v1[1]); w.w = pg8::cvt_pk_bf16(v1[2], v1[3]);
                    *(u32x4*)(rowp + bj * 128) = w; } }
    }
};
struct EpiGate {
    static constexpr bool PERM = true;
    bf16* O; const bf16* Z; int coff, goff;
    __device__ __forceinline__ void operator()(const pg8::f32x4 (&acc)[2][2][4][2], const pg8::Unit& u, int wr, int wc, int fr, int fq) const {
        const int row0 = u.pm * 256 + wr * 64 + fr, col0 = u.pn * 256 + wc * 32 + 8 * fq;
#pragma unroll
        for (int ai = 0; ai < 2; ++ai)
#pragma unroll
            for (int m = 0; m < 4; ++m) { const size_t row = (size_t)(row0 + ai * 128 + m * 16);
#pragma unroll
                for (int bj = 0; bj < 2; ++bj) { const pg8::f32x4 v0 = acc[ai][bj][m][0], v1 = acc[ai][bj][m][1];
                    const u32x4 gz = *(const u32x4*)(Z + row * DIN + goff + col0 + bj * 128); u32x4 w;
                    w.x = pg8::cvt_pk_bf16(v0[0] * silu_f(bflo(gz.x)), v0[1] * silu_f(bfhi(gz.x))); w.y = pg8::cvt_pk_bf16(v0[2] * silu_f(bflo(gz.y)), v0[3] * silu_f(bfhi(gz.y)));
                    w.z = pg8::cvt_pk_bf16(v1[0] * silu_f(bflo(gz.z)), v1[1] * silu_f(bfhi(gz.z))); w.w = pg8::cvt_pk_bf16(v1[2] * silu_f(bflo(gz.w)), v1[3] * silu_f(bfhi(gz.w)));
                    *(u32x4*)(O + row * DM + coff + col0 + bj * 128) = w; } }
    }
};
struct EpiPart {
    static constexpr bool PERM = false;
    float* P;
    __device__ __forceinline__ void operator()(const pg8::f32x4 (&acc)[2][2][4][2], const pg8::Unit& u, int wr, int wc, int fr, int fq) const {
        const int row0 = u.pm * 256 + wr * 64 + fr, col0 = u.pn * 256 + wc * 32 + 4 * fq;
        float* base = P + (size_t)u.aux * 4096 * 512;
#pragma unroll
        for (int ai = 0; ai < 2; ++ai)
#pragma unroll
            for (int m = 0; m < 4; ++m) { float* rowp = base + (size_t)(row0 + ai * 128 + m * 16) * 512 + col0;
#pragma unroll
                for (int bj = 0; bj < 2; ++bj)
#pragma unroll
                    for (int n = 0; n < 2; ++n) *(pg8::f32x4*)(rowp + bj * 128 + n * 16) = acc[ai][bj][m][n]; }
    }
};
struct EpiRes {
    static constexpr bool PERM = false;
    const float* xin; float* xout; const float* gate;
    __device__ __forceinline__ void operator()(const pg8::f32x4 (&acc)[2][2][4][2], const pg8::Unit& u, int wr, int wc, int fr, int fq) const {
        const int row0 = u.pm * 256 + wr * 64 + fr, col0 = u.pn * 256 + wc * 32 + 4 * fq;
        const float* gp = gate + (size_t)(u.pm >> 4) * 6144 + col0;
        pg8::f32x4 gv[2][2];
#pragma unroll
        for (int bj = 0; bj < 2; ++bj)
#pragma unroll
            for (int n = 0; n < 2; ++n) gv[bj][n] = *(const pg8::f32x4*)(gp + bj * 128 + n * 16);
#pragma unroll
        for (int ai = 0; ai < 2; ++ai)
#pragma unroll
            for (int m = 0; m < 4; ++m) { const size_t ro = (size_t)(row0 + ai * 128 + m * 16) * DM + col0;
#pragma unroll
                for (int bj = 0; bj < 2; ++bj)
#pragma unroll
                    for (int n = 0; n < 2; ++n) { const pg8::f32x4 xi = *(const pg8::f32x4*)(xin + ro + bj * 128 + n * 16);
                        *(pg8::f32x4*)(xout + ro + bj * 128 + n * 16) = xi + gv[bj][n] * acc[ai][bj][m][n]; } }
    }
};

__device__ __forceinline__ void transpose_tile(const float* W, int K, int N, bf16* WT, int item, float* scr) {
    const int tid = otid(), nb = N / 64, kb = item / nb, nbk = item % nb, k0 = kb * 64, n0 = nbk * 64;
#pragma unroll
    for (int i = 0; i < 2; ++i) { const int kk = (tid >> 4) + 32 * i, nn = (tid & 15) * 4;
        const f32x4 v = *(const f32x4*)(W + (size_t)(k0 + kk) * N + n0 + nn);
        scr[kk * 65 + nn] = v[0]; scr[kk * 65 + nn + 1] = v[1]; scr[kk * 65 + nn + 2] = v[2]; scr[kk * 65 + nn + 3] = v[3]; }
    __syncthreads();
    { const int n = tid >> 3, kc = (tid & 7) * 8; const float* s = scr + kc * 65 + n; u32x4 o;
      o.x = pk2(s[0], s[65]); o.y = pk2(s[2 * 65], s[3 * 65]); o.z = pk2(s[4 * 65], s[5 * 65]); o.w = pk2(s[6 * 65], s[7 * 65]);
      *(u32x4*)(WT + (size_t)(n0 + n) * K + k0 + kc) = o; }
    __syncthreads();
}

__device__ __forceinline__ void ph_prologue(const Params& p, unsigned char* lds) {
    const int tid = otid(), lane = tid & 63, wave = tid >> 6, G = gridDim.x, bid = blockIdx.x;
    float* scr = (float*)lds;
    bf16* Wt_in = (bf16*)(p.ws + WS_WIN); bf16* Wt_out = (bf16*)(p.ws + WS_WOUT); bf16* Wt_fft = (bf16*)(p.ws + WS_WFFT); bf16* Wt_pw = (bf16*)(p.ws + WS_WPW);
    constexpr int T_IN = 32 * 104, T_OUT = 32 * 32, T_S = 64, T_L = T_IN + T_OUT + 2 * T_S;
    for (int it = bid; it < NL * T_L; it += G) {
        const int l = it / T_L; int r = it % T_L;
        if (r < T_IN) { transpose_tile(p.w_in + (size_t)l * DM * DIN, DM, DIN, Wt_in + (size_t)l * DIN * DM, r, scr); continue; } r -= T_IN;
        if (r < T_OUT) { transpose_tile(p.w_out + (size_t)l * DM * DM, DM, DM, Wt_out + (size_t)l * DM * DM, r, scr); continue; } r -= T_OUT;
        if (r < T_S) { transpose_tile(p.w_fft + (size_t)l * DG * DG, DG, DG, Wt_fft + (size_t)l * DG * DG, r, scr); continue; } r -= T_S;
        transpose_tile(p.w_pw + (size_t)l * DG * DG, DG, DG, Wt_pw + (size_t)l * DG * DG, r, scr);
    }
    float* cosT = (float*)(lds + 32768); float* sinT = (float*)(lds + 49152); float* ca = (float*)(lds + 65536); float* red = (float*)(lds + 81920);
    for (int j = tid; j < 4096; j += NTHR) { cosT[j] = cospif((float)j * (1.f / 2048.f)); sinT[j] = sinpif((float)j * (1.f / 2048.f)); }
    for (int j = tid; j < 4096; j += NTHR) { const float cv = p.c[j]; ca[j] = cv / (1.f + expf(-cv)); }
    __syncthreads();
    bf16* DFT = (bf16*)(p.ws + WS_DFT);
    for (int k = bid; k < 4096; k += G) {
#pragma unroll
        for (int cc = 0; cc < 2; ++cc) { const int kk0 = (tid + cc * NTHR) * 8; float v[8];
#pragma unroll
            for (int j = 0; j < 8; ++j) { const int kk = kk0 + j, idx = (k * (kk & 4095)) & 4095; v[j] = (kk < 4096) ? cosT[idx] : -sinT[idx]; }
            u32x4 o; o.x = pk2(v[0], v[1]); o.y = pk2(v[2], v[3]); o.z = pk2(v[4], v[5]); o.w = pk2(v[6], v[7]);
            *(u32x4*)(DFT + (size_t)k * 8192 + kk0) = o; }
    }
    { float2* rope = (float2*)(p.ws + WS_ROPE);
      for (int e = bid * NTHR + tid; e < 4096 * 32; e += G * NTHR) { const int s = e >> 5, i = e & 31;
          const float inv = (float)pow(10000.0, -(double)i / 32.0); const float ang = (float)s * inv;
          double sn, cs; sincos((double)ang, &sn, &cs); rope[e] = make_float2((float)cs, (float)sn); } }
    float* mod = (float*)(p.ws + WS_MOD);
    for (int t = bid; t < 192; t += G) {
        const int l = t / 96, col = (t % 96) * 64 + lane; const float* W = p.w_ada + (size_t)l * DM * 6144 + col;
        float a0 = 0.f, a1 = 0.f;
#pragma unroll 8
        for (int k = wave * 256; k < wave * 256 + 256; ++k) { const float w = W[(size_t)k * 6144]; a0 += ca[k] * w; a1 += ca[2048 + k] * w; }
        red[(wave * 2 + 0) * 64 + lane] = a0; red[(wave * 2 + 1) * 64 + lane] = a1;
        __syncthreads();
        if (wave < 2) { float s = 0.f;
#pragma unroll
            for (int w = 0; w < 8; ++w) s += red[(w * 2 + wave) * 64 + lane];
            mod[(size_t)(l * 2 + wave) * 6144 + col] = s + p.b_ada[l * 6144 + col]; }
        __syncthreads();
    }
}

__device__ __forceinline__ void ph_norm(const Params& p, int l) {
    const int tid = otid(), lane = tid & 63, wave = tid >> 6;
    const float* xin = (l == 0) ? p.x : p.out; bf16* h = (bf16*)(p.ws + WS_U); const float* mod = (const float*)(p.ws + WS_MOD);
    for (int row = blockIdx.x * 8 + wave; row < MTOK; row += gridDim.x * 8) {
        const f32x4* xr = (const f32x4*)(xin + (size_t)row * DM) + lane; f32x4 v[8]; float ss = 0.f;
#pragma unroll
        for (int j = 0; j < 8; ++j) { v[j] = xr[64 * j]; ss += (v[j][0] * v[j][0] + v[j][1] * v[j][1]) + (v[j][2] * v[j][2] + v[j][3] * v[j][3]); }
        ss = wave_sum(ss); const float rstd = rsqrtf(ss * (1.f / DM) + 1e-6f);
        const float* md = mod + (size_t)(l * 2 + (row >> 12)) * 6144; const float* g = p.norm_g + l * DM;
#pragma unroll
        for (int j = 0; j < 8; ++j) { const int col = (64 * j + lane) * 4;
            const f32x4 g4 = *(const f32x4*)(g + col), sh = *(const f32x4*)(md + col), sc = *(const f32x4*)(md + 2048 + col);
            const f32x4 o = (v[j] * rstd * g4) * (sc + 1.f) + sh; u32x2 w; w.x = pk2(o[0], o[1]); w.y = pk2(o[2], o[3]);
            *(u32x2*)(h + (size_t)row * DM + col) = w; }
    }
}
__device__ __forceinline__ void ph_final(const Params& p) {
    const int tid = otid(), lane = tid & 63, wave = tid >> 6;
    for (int row = blockIdx.x * 8 + wave; row < MTOK; row += gridDim.x * 8) {
        f32x4* xr = (f32x4*)(p.out + (size_t)row * DM) + lane; f32x4 v[8]; float ss = 0.f;
#pragma unroll
        for (int j = 0; j < 8; ++j) { v[j] = xr[64 * j]; ss += (v[j][0] * v[j][0] + v[j][1] * v[j][1]) + (v[j][2] * v[j][2] + v[j][3] * v[j][3]); }
        ss = wave_sum(ss); const float rstd = rsqrtf(ss * (1.f / DM) + 1e-6f);
#pragma unroll
        for (int j = 0; j < 8; ++j) { const int col = (64 * j + lane) * 4; const f32x4 g4 = *(const f32x4*)(p.final_g + col); xr[64 * j] = v[j] * rstd * g4; }
    }
}

typedef short bf16x8v __attribute__((ext_vector_type(8)));
__device__ __forceinline__ bf16x8v mk8(unsigned a, unsigned b, unsigned c, unsigned d) { u32x4 v = {a, b, c, d}; return __builtin_bit_cast(bf16x8v, v); }
#define MFMA16(a, b, c) __builtin_amdgcn_mfma_f32_16x16x32_bf16(a, b, c, 0, 0, 0)
constexpr int R_QS = 0, R_KS = 18432, R_VT = 36864, R_KTF = 54272, R_KTB = 71680, R_STF = 89088, R_STB = 98304;

template <bool R2>
__device__ __forceinline__ void ret_stage(const Params& p, int b, int h, int n, unsigned char* lds, float l2f, float l2b) {
    const int tid = otid(), j = tid >> 2, c4 = tid & 3, s = n * 128 + j;
    const bf16* Z = (const bf16*)(p.ws + WS_Z); const bf16* zr = Z + (size_t)(b * SEQ + s) * DIN;
    const f32x4* rp = (const f32x4*)((const float2*)(p.ws + WS_ROPE) + s * 32 + c4 * 8);
    float cs[8], sn[8];
#pragma unroll
    for (int i = 0; i < 4; ++i) { const f32x4 r = rp[i]; cs[2 * i] = r[0]; sn[2 * i] = r[1]; cs[2 * i + 1] = r[2]; sn[2 * i + 1] = r[3]; }
    bf16* KS = (bf16*)(lds + R_KS); bf16* VT = (bf16*)(lds + R_VT);
    { const u32x4 ka = *(const u32x4*)(zr + 7 * DG + h * 64 + c4 * 8), kb = *(const u32x4*)(zr + 7 * DG + h * 64 + 32 + c4 * 8);
      const unsigned kau[4] = {ka.x, ka.y, ka.z, ka.w}, kbu[4] = {kb.x, kb.y, kb.z, kb.w};
      float k1[8], k2[8];
#pragma unroll
      for (int i = 0; i < 4; ++i) { const float a0 = bflo(kau[i]), a1 = bfhi(kau[i]), b0 = bflo(kbu[i]), b1 = bfhi(kbu[i]);
          k1[2 * i] = a0 * cs[2 * i] - b0 * sn[2 * i]; k2[2 * i] = a0 * sn[2 * i] + b0 * cs[2 * i];
          k1[2 * i + 1] = a1 * cs[2 * i + 1] - b1 * sn[2 * i + 1]; k2[2 * i + 1] = a1 * sn[2 * i + 1] + b1 * cs[2 * i + 1]; }
      u32x4 o1, o2; o1.x = pk2(k1[0], k1[1]); o1.y = pk2(k1[2], k1[3]); o1.z = pk2(k1[4], k1[5]); o1.w = pk2(k1[6], k1[7]);
      o2.x = pk2(k2[0], k2[1]); o2.y = pk2(k2[2], k2[3]); o2.z = pk2(k2[4], k2[5]); o2.w = pk2(k2[6], k2[7]);
      *(u32x4*)(KS + j * 72 + c4 * 8) = o1; *(u32x4*)(KS + j * 72 + 32 + c4 * 8) = o2;
      if (!R2) { bf16* KTF = (bf16*)(lds + R_KTF); bf16* KTB = (bf16*)(lds + R_KTB);
          const float df = exp2f(l2f * (float)(127 - j)), db = exp2f(l2b * (float)j);
#pragma unroll
          for (int i = 0; i < 8; ++i) { KTF[(c4 * 8 + i) * 136 + j] = (bf16)f2bf(k1[i] * df); KTF[(32 + c4 * 8 + i) * 136 + j] = (bf16)f2bf(k2[i] * df);
              KTB[(c4 * 8 + i) * 136 + j] = (bf16)f2bf(k1[i] * db); KTB[(32 + c4 * 8 + i) * 136 + j] = (bf16)f2bf(k2[i] * db); } } }
    { const u32x4 va = *(const u32x4*)(zr + 8 * DG + h * 64 + c4 * 16), vb = *(const u32x4*)(zr + 8 * DG + h * 64 + c4 * 16 + 8);
      const unsigned vu[8] = {va.x, va.y, va.z, va.w, vb.x, vb.y, vb.z, vb.w};
#pragma unroll
      for (int i = 0; i < 8; ++i) { VT[(c4 * 16 + 2 * i) * 136 + j] = (bf16)(vu[i] & 0xffffu); VT[(c4 * 16 + 2 * i + 1) * 136 + j] = (bf16)(vu[i] >> 16); } }
    if (R2) { bf16* QS = (bf16*)(lds + R_QS);
      const u32x4 qa = *(const u32x4*)(zr + 6 * DG + h * 64 + c4 * 8), qb = *(const u32x4*)(zr + 6 * DG + h * 64 + 32 + c4 * 8);
      const unsigned qau[4] = {qa.x, qa.y, qa.z, qa.w}, qbu[4] = {qb.x, qb.y, qb.z, qb.w};
      float q1[8], q2[8];
#pragma unroll
      for (int i = 0; i < 4; ++i) { const float a0 = bflo(qau[i]), a1 = bfhi(qau[i]), b0 = bflo(qbu[i]), b1 = bfhi(qbu[i]);
          q1[2 * i] = (a0 * cs[2 * i] - b0 * sn[2 * i]) * 0.125f; q2[2 * i] = (a0 * sn[2 * i] + b0 * cs[2 * i]) * 0.125f;
          q1[2 * i + 1] = (a1 * cs[2 * i + 1] - b1 * sn[2 * i + 1]) * 0.125f; q2[2 * i + 1] = (a1 * sn[2 * i + 1] + b1 * cs[2 * i + 1]) * 0.125f; }
      u32x4 o1, o2; o1.x = pk2(q1[0], q1[1]); o1.y = pk2(q1[2], q1[3]); o1.z = pk2(q1[4], q1[5]); o1.w = pk2(q1[6], q1[7]);
      o2.x = pk2(q2[0], q2[1]); o2.y = pk2(q2[2], q2[3]); o2.z = pk2(q2[4], q2[5]); o2.w = pk2(q2[6], q2[7]);
      *(u32x4*)(QS + j * 72 + c4 * 8) = o1; *(u32x4*)(QS + j * 72 + 32 + c4 * 8) = o2; }
}

__device__ __forceinline__ void ret1_task(const Params& p, int l, int task, unsigned char* lds) {
    const int n = task & 31, h = (task >> 5) & 7, b = task >> 8;
    const float xf = p.rl_f[l * 8 + h], xb = p.rl_b[l * 8 + h];
    const float l2f = -log1pf(expf(-xf)) * 1.4426950408889634f, l2b = -log1pf(expf(-xb)) * 1.4426950408889634f;
    ret_stage<false>(p, b, h, n, lds, l2f, l2b);
    __syncthreads();
    const int tid = otid(), lane = tid & 63, w = tid >> 6, fr = lane & 15, fq = lane >> 4, dir = w >> 2, et = w & 3;
    const bf16* VT = (const bf16*)(lds + R_VT); const bf16* KT = (const bf16*)(lds + (dir ? R_KTB : R_KTF));
    bf16x8v a[4];
#pragma unroll
    for (int ks = 0; ks < 4; ++ks) a[ks] = *(const bf16x8v*)(VT + (16 * et + fr) * 136 + 32 * ks + 8 * fq);
    float* dst = (float*)(p.ws + WS_KV) + ((size_t)((dir * 2 + b) * 8 + h) * 32 + n) * 4096;
#pragma unroll
    for (int dt = 0; dt < 4; ++dt) { f32x4 acc = {0.f, 0.f, 0.f, 0.f};
#pragma unroll
        for (int ks = 0; ks < 4; ++ks) { const bf16x8v bfr = *(const bf16x8v*)(KT + (16 * dt + fr) * 136 + 32 * ks + 8 * fq); acc = MFMA16(a[ks], bfr, acc); }
#pragma unroll
        for (int r = 0; r < 4; ++r) dst[(16 * et + 4 * fq + r) * 64 + 16 * dt + fr] = acc[r]; }
    __syncthreads();
}

__device__ __forceinline__ void ret2_task(const Params& p, int l, int task, unsigned char* lds) {
    const int n = task & 31, h = (task >> 5) & 7, b = task >> 8;
    const float xf = p.rl_f[l * 8 + h], xb = p.rl_b[l * 8 + h];
    const float l2f = -log1pf(expf(-xf)) * 1.4426950408889634f, l2b = -log1pf(expf(-xb)) * 1.4426950408889634f;
    ret_stage<true>(p, b, h, n, lds, l2f, l2b);
    const int tid = otid(), lane = tid & 63, w = tid >> 6, fr = lane & 15, fq = lane >> 4;
    {
      const float gfC = exp2f(l2f * 128.f), gbC = exp2f(l2b * 128.f);
      const float* KVf = (const float*)(p.ws + WS_KV) + ((size_t)((0 * 2 + b) * 8 + h) * 32) * 4096 + tid * 8;
      const float* KVb = (const float*)(p.ws + WS_KV) + ((size_t)((1 * 2 + b) * 8 + h) * 32) * 4096 + tid * 8;
      f32x4 f0 = {0.f, 0.f, 0.f, 0.f}, f1 = f0, g0 = f0, g1 = f0; float cf = 1.f;
      for (int m = n - 1; m >= 0; --m) { const f32x4 x0 = *(const f32x4*)(KVf + (size_t)m * 4096), x1 = *(const f32x4*)(KVf + (size_t)m * 4096 + 4); f0 += x0 * cf; f1 += x1 * cf; cf *= gfC; }
      cf = 1.f;
      for (int m = n + 1; m < 32; ++m) { const f32x4 x0 = *(const f32x4*)(KVb + (size_t)m * 4096), x1 = *(const f32x4*)(KVb + (size_t)m * 4096 + 4); g0 += x0 * cf; g1 += x1 * cf; cf *= gbC; }
      const int e = tid >> 3, d0 = (tid & 7) * 8; u32x4 o;
      o.x = pk2(f0[0], f0[1]); o.y = pk2(f0[2], f0[3]); o.z = pk2(f1[0], f1[1]); o.w = pk2(f1[2], f1[3]); *(u32x4*)((bf16*)(lds + R_STF) + e * 72 + d0) = o;
      o.x = pk2(g0[0], g0[1]); o.y = pk2(g0[2], g0[3]); o.z = pk2(g1[0], g1[1]); o.w = pk2(g1[2], g1[3]); *(u32x4*)((bf16*)(lds + R_STB) + e * 72 + d0) = o; }
    __syncthreads();
    const bf16* QS = (const bf16*)(lds + R_QS); const bf16* KS = (const bf16*)(lds + R_KS); const bf16* VT = (const bf16*)(lds + R_VT);
    const bf16* STF = (const bf16*)(lds + R_STF); const bf16* STB = (const bf16*)(lds + R_STB);
    bf16x8v qf[2];
#pragma unroll
    for (int ks = 0; ks < 2; ++ks) qf[ks] = *(const bf16x8v*)(QS + (16 * w + fr) * 72 + 32 * ks + 8 * fq);
    const int ai = 16 * w + fr;
    unsigned pp[8][2];
#pragma unroll
    for (int jt = 0; jt < 8; ++jt) { f32x4 acc = {0.f, 0.f, 0.f, 0.f};
#pragma unroll
        for (int ks = 0; ks < 2; ++ks) { const bf16x8v kf = *(const bf16x8v*)(KS + (16 * jt + fr) * 72 + 32 * ks + 8 * fq); acc = MFMA16(kf, qf[ks], acc); }
        float sc[4];
#pragma unroll
        for (int r = 0; r < 4; ++r) { const int aj = 16 * jt + 4 * fq + r; const float wg = (aj <= ai) ? exp2f(l2f * (float)(ai - aj)) : exp2f(l2b * (float)(aj - ai)); sc[r] = acc[r] * wg; }
        pp[jt][0] = pk2(sc[0], sc[1]); pp[jt][1] = pk2(sc[2], sc[3]); }
    const float qdf = exp2f(l2f * (float)(ai + 1)), qdb = exp2f(l2b * (float)(128 - ai));
    f32x4 tot[4]; float ss = 0.f;
#pragma unroll
    for (int et = 0; et < 4; ++et) { f32x4 o = {0.f, 0.f, 0.f, 0.f}, cfa = o, cba = o;
#pragma unroll
        for (int t = 0; t < 4; ++t) { const u32x2 vlo = *(const u32x2*)(VT + (16 * et + fr) * 136 + 32 * t + 4 * fq), vhi = *(const u32x2*)(VT + (16 * et + fr) * 136 + 32 * t + 16 + 4 * fq);
            o = MFMA16(mk8(vlo.x, vlo.y, vhi.x, vhi.y), mk8(pp[2 * t][0], pp[2 * t][1], pp[2 * t + 1][0], pp[2 * t + 1][1]), o); }
#pragma unroll
        for (int ks = 0; ks < 2; ++ks) { const bf16x8v sf = *(const bf16x8v*)(STF + (16 * et + fr) * 72 + 32 * ks + 8 * fq), sb = *(const bf16x8v*)(STB + (16 * et + fr) * 72 + 32 * ks + 8 * fq);
            cfa = MFMA16(sf, qf[ks], cfa); cba = MFMA16(sb, qf[ks], cba); }
        tot[et] = o + cfa * qdf + cba * qdb;
        ss += (tot[et][0] * tot[et][0] + tot[et][1] * tot[et][1]) + (tot[et][2] * tot[et][2] + tot[et][3] * tot[et][3]); }
    ss += __shfl_xor(ss, 16); ss += __shfl_xor(ss, 32);
    const float rs = rsqrtf(ss * (1.f / 64.f) + 1e-6f);
    const size_t tok = (size_t)b * SEQ + n * 128 + ai;
    const bf16* Z = (const bf16*)(p.ws + WS_Z); bf16* CAT = (bf16*)(p.ws + WS_CAT);
#pragma unroll
    for (int et = 0; et < 4; ++et) { const u32x2 gz = *(const u32x2*)(Z + tok * DIN + 9 * DG + h * 64 + 16 * et + 4 * fq); u32x2 o;
        o.x = pk2(tot[et][0] * rs * silu_f(bflo(gz.x)), tot[et][1] * rs * silu_f(bfhi(gz.x))); o.y = pk2(tot[et][2] * rs * silu_f(bflo(gz.y)), tot[et][3] * rs * silu_f(bfhi(gz.y)));
        *(u32x2*)(CAT + tok * DM + 1024 + h * 64 + 16 * et + 4 * fq) = o; }
    __syncthreads();
}

__device__ __forceinline__ void na_task(const Params& p, int l, int task) {
    const int tid = otid(), lane = tid & 63, h = tid >> 6;
    const int half = task & 1, r = (task >> 1) & 63, b = task >> 7;
    const bf16* Z = (const bf16*)(p.ws + WS_Z); bf16* CAT = (bf16*)(p.ws + WS_CAT);
    const int row_start = min(max(r - 4, 0), 56);
    const float* bias = p.na_bias + (size_t)(l * 8 + h) * 15 * 31;
    for (int c = half * 32; c < half * 32 + 32; ++c) {
        const int col_start = min(max(c - 8, 0), 48);
        const size_t qtok = (size_t)b * SEQ + r * 64 + c;
        const u32x4* qp = (const u32x4*)(Z + qtok * DIN + 2 * DG + h * 64);
        u32x4 q[8];
#pragma unroll
        for (int j = 0; j < 8; ++j) q[j] = qp[j];
        float sA, sB;
        const int a = lane >> 4, kc = col_start + (lane & 15);
#pragma unroll
        for (int hh = 0; hh < 2; ++hh) {
            const int krow = row_start + a + 4 * hh; const size_t ktok = (size_t)b * SEQ + krow * 64 + kc;
            const u32x4* kp = (const u32x4*)(Z + ktok * DIN + 3 * DG + h * 64); float dot = 0.f;
#pragma unroll
            for (int j = 0; j < 8; ++j) { const u32x4 kv = kp[j];
                dot += bflo(q[j].x) * bflo(kv.x) + bfhi(q[j].x) * bfhi(kv.x) + bflo(q[j].y) * bflo(kv.y) + bfhi(q[j].y) * bfhi(kv.y)
                     + bflo(q[j].z) * bflo(kv.z) + bfhi(q[j].z) * bfhi(kv.z) + bflo(q[j].w) * bflo(kv.w) + bfhi(q[j].w) * bfhi(kv.w); }
            const int dr = krow - r, dc = kc - c;
            const float s = dot * 0.125f + bias[(dr + 7) * 31 + min(max(dc + 15, 0), 30)];
            if (hh == 0) sA = s; else sB = s;
        }
        const float mx = wave_max(fmaxf(sA, sB));
        float pA = __expf(sA - mx), pB = __expf(sB - mx);
        const float inv = 1.f / wave_sum(pA + pB); pA *= inv; pB *= inv;
        float o = 0.f;
        for (int kk = 0; kk < 128; ++kk) {
            const float pv = __shfl((kk & 64) ? pB : pA, kk & 63);
            const int a2 = ((kk & 63) >> 4) + ((kk >> 6) << 2), kc2 = col_start + (kk & 15);
            const size_t vtok = (size_t)b * SEQ + (row_start + a2) * 64 + kc2;
            o += pv * bf2f(Z[vtok * DIN + 4 * DG + h * 64 + lane]);
        }
        const float g = bf2f(Z[qtok * DIN + 5 * DG + h * 64 + lane]);
        CAT[qtok * DM + 512 + h * 64 + lane] = (bf16)f2bf(o * silu_f(g));
    }
}

__device__ __forceinline__ void conv_task(const Params& p, int l, int task, unsigned char* lds) {
    const int tid = otid(), lane = tid & 63, wave = tid >> 6;
    float* us = (float*)lds; float* ys = us + 46 * 512;
    const bf16* Z = (const bf16*)(p.ws + WS_Z);
    const int b = task >> 8, t0 = (task & 255) * 16;
    for (int tt = 0; tt < 46; ++tt) { const int tok = t0 - 15 + tt; float u = 0.f;
        if (tok >= 0 && tok < SEQ) { const bf16* zr = Z + (size_t)(b * SEQ + tok) * DIN; const float a = bf2f(zr[10 * DG + tid]), g = bf2f(zr[11 * DG + tid]); u = a / (1.f + __expf(-g)); }
        us[tt * 512 + tid] = u; }
    float w[31];
#pragma unroll
    for (int k = 0; k < 31; ++k) w[k] = p.conv_w[(size_t)(l * 31 + k) * DG + tid];
    const float cb = p.conv_b[l * DG + tid];
    __syncthreads();
    for (int t = 0; t < 16; ++t) { float acc = cb;
#pragma unroll
        for (int k = 0; k < 31; ++k) acc += w[k] * us[(t + k) * 512 + tid];
        ys[t * 512 + tid] = acc; }
    __syncthreads();
#pragma unroll
    for (int tw = 0; tw < 2; ++tw) { const int t = wave + 8 * tw; float v[8]; float s = 0.f;
#pragma unroll
        for (int j = 0; j < 8; ++j) { v[j] = ys[t * 512 + lane + 64 * j]; s += v[j]; }
        const float mu = wave_sum(s) * (1.f / 512.f); float q = 0.f;
#pragma unroll
        for (int j = 0; j < 8; ++j) { v[j] -= mu; q += v[j] * v[j]; }
        const float rstd = rsqrtf(wave_sum(q) * (1.f / 512.f) + 1e-6f);
        bf16* orow = (bf16*)(p.ws + WS_CVH) + (size_t)(b * SEQ + t0 + t) * DG;
#pragma unroll
        for (int j = 0; j < 8; ++j) { const int ch = lane + 64 * j; const float y = v[j] * rstd * p.ln_g[l * DG + ch] + p.ln_b[l * DG + ch]; orow[ch] = (bf16)f2bf(silu_f(y)); } }
    __syncthreads();
}

__device__ __forceinline__ void f1_task(const Params& p, int task, unsigned char* lds) {
    const int tid = otid();
    float* us = (float*)lds; float* cs = us + 8 * 512; float* sn = cs + 128;
    const bf16* Z = (const bf16*)(p.ws + WS_Z);
    const int tok0 = task * 8, b = tok0 >> 12, s0 = tok0 & 4095;
    if (tid < 128) { cs[tid] = cospif((float)tid * (1.f / 64.f)); sn[tid] = sinpif((float)tid * (1.f / 64.f)); }
#pragma unroll
    for (int tk = 0; tk < 8; ++tk) us[tk * 512 + tid] = bf2f(Z[(size_t)(tok0 + tk) * DIN + tid]);
    __syncthreads();
    const int g = tid >> 7, m = tid & 127;
    float P[8], Q[8];
#pragma unroll
    for (int tk = 0; tk < 8; ++tk) { P[tk] = 0.f; Q[tk] = 0.f; }
    for (int c = 0; c < 128; ++c) { const int idx = (m * c) & 127; const float cv = cs[idx], sv = sn[idx];
#pragma unroll
        for (int tk = 0; tk < 8; ++tk) { const float u = us[tk * 512 + g * 128 + c]; P[tk] += u * cv; Q[tk] += u * sv; } }
    const float nrm = 0.0013810679320049757f;
    bf16* PQ = (bf16*)(p.ws + WS_PQT) + ((size_t)(b * 512 + tid) * 2) * 4096 + s0;
    u32x4 o; o.x = pk2(P[0] * nrm, P[1] * nrm); o.y = pk2(P[2] * nrm, P[3] * nrm); o.z = pk2(P[4] * nrm, P[5] * nrm); o.w = pk2(P[6] * nrm, P[7] * nrm);
    *(u32x4*)PQ = o;
    o.x = pk2(Q[0] * nrm, Q[1] * nrm); o.y = pk2(Q[2] * nrm, Q[3] * nrm); o.z = pk2(Q[4] * nrm, Q[5] * nrm); o.w = pk2(Q[6] * nrm, Q[7] * nrm);
    *(u32x4*)(PQ + 4096) = o;
    __syncthreads();
}

__device__ __forceinline__ void ph_mixA(const Params& p, int l, unsigned char* lds) {
    const int G = gridDim.x, bid = blockIdx.x;
    for (int t = bid; t < 512; t += G) ret1_task(p, l, t, lds);
    for (int t = bid; t < 256; t += G) na_task(p, l, t);
    __syncthreads();
    for (int t = bid; t < 512; t += G) conv_task(p, l, t, lds);
    for (int t = bid; t < 1024; t += G) f1_task(p, t, lds);
}

__device__ __forceinline__ void ph_combine(const Params& p) {
    const float* part = (const float*)(p.ws + WS_U); bf16* Y = (bf16*)(p.ws + WS_Y);
    for (int e = blockIdx.x * NTHR + threadIdx.x; e < MTOK * DG / 4; e += gridDim.x * NTHR) {
        const int row = e >> 7, c4 = (e & 127) * 4, b = row >> 12, k = row & 4095;
        f32x4 s = {0.f, 0.f, 0.f, 0.f};
#pragma unroll
        for (int ks = 0; ks < 4; ++ks) s += *(const f32x4*)(part + ((size_t)((b * 4 + ks) * 4096 + k)) * 512 + c4);
        u32x2 w; w.x = pk2(s[0], s[1]); w.y = pk2(s[2], s[3]);
        *(u32x2*)(Y + (size_t)row * DG + c4) = w;
    }
}

constexpr int NPH = 16;
__global__ void __launch_bounds__(NTHR) mega(Params p) {
    extern __shared__ __attribute__((aligned(16))) unsigned char lds[];
    cg::grid_group grid = cg::this_grid();
    PG8_LAS unsigned char* ldsl = (PG8_LAS unsigned char*)lds;
    const int lo = p.ph_lo, hi = p.ph_hi;
#define IN(k) (lo <= (k) && (k) < hi)
#define SEAM(k) do { if (IN(k) && IN((k) + 1)) { __threadfence(); grid.sync(); } } while (0)
    bf16* Zb = (bf16*)(p.ws + WS_Z); bf16* CAT = (bf16*)(p.ws + WS_CAT);
#ifndef T_NOPRO
    if (IN(0)) ph_prologue(p, lds);
#endif
    SEAM(0);
#pragma unroll
    for (int l = 0; l < NL; ++l) {
        const int pb = 1 + 7 * l;
#ifndef T_NONORM
        if (IN(pb)) ph_norm(p, l);
#endif
        SEAM(pb);
        if (IN(pb + 1)) {
            SchedS S = make_sched(p.ws + WS_U, DM, p.ws + WS_WIN + (size_t)l * DIN * DM * 2, DM, MTOK, DIN);
            EpiZ E{Zb, DIN};
            pg8::gemm_phase<EpiZ, SchedS, true>(ldsl, pg8::Gemm{DM, DM, DM}, S, E);
        }
        SEAM(pb + 1);
#ifndef T_NOMIX
        if (IN(pb + 2)) ph_mixA(p, l, lds);
#endif
        SEAM(pb + 2);
#ifndef T_ONEGEMM
        if (IN(pb + 3)) {
#ifndef T_NOG1
            { SchedDFT S{(const char*)(p.ws + WS_DFT), (const char*)(p.ws + WS_PQT), (int)gridDim.x, (int)blockIdx.x};
              EpiPart E{(float*)(p.ws + WS_U)};
              pg8::gemm_phase<EpiPart, SchedDFT, true>(ldsl, pg8::Gemm{8192, 8192, 2048}, S, E); }
#endif
#ifndef T_NOG2
            { SchedS S = make_sched(p.ws + WS_CVH, DG, p.ws + WS_WPW + (size_t)l * DG * DG * 2, DG, MTOK, DG);
              EpiGate E{CAT, Zb, 1536, 12 * DG};
              pg8::gemm_phase<EpiGate, SchedS, true>(ldsl, pg8::Gemm{DG, DG, DG}, S, E); }
#endif
            for (int t = blockIdx.x; t < 512; t += gridDim.x) ret2_task(p, l, t, lds);
        }
        SEAM(pb + 3);
        if (IN(pb + 4)) ph_combine(p);
        SEAM(pb + 4);
#ifndef T_NOG3
        if (IN(pb + 5)) {
            SchedS S = make_sched(p.ws + WS_Y, DG, p.ws + WS_WFFT + (size_t)l * DG * DG * 2, DG, MTOK, DG);
            EpiGate E{CAT, Zb, 0, 1 * DG};
            pg8::gemm_phase<EpiGate, SchedS, true>(ldsl, pg8::Gemm{DG, DG, DG}, S, E);
        }
#endif
        SEAM(pb + 5);
#ifndef T_NOG4
        if (IN(pb + 6)) {
            SchedS S = make_sched(CAT, DM, p.ws + WS_WOUT + (size_t)l * DM * DM * 2, DM, MTOK, DM);
            EpiRes E{(l == 0) ? p.x : p.out, p.out, (const float*)(p.ws + WS_MOD) + (size_t)l * 2 * 6144 + 4096};
            pg8::gemm_phase<EpiRes, SchedS, true>(ldsl, pg8::Gemm{DM, DM, DM}, S, E);
        }
#endif
        SEAM(pb + 6);
#endif
    }
    if (IN(NPH - 1)) ph_final(p);
#undef IN
#undef SEAM
}

extern "C" void kernel_launch(void* const* d_in, const int* in_sizes, int n_in, void* d_out, int out_size, void* d_ws, size_t ws_size, hipStream_t stream) {
    static int grid_blocks = 0;
    if (grid_blocks == 0) {
        if (n_in != 17 || ws_size < WS_END) { fprintf(stderr, "kernel_launch: n_in %d ws %zu (need %zu)\n", n_in, ws_size, (size_t)WS_END); grid_blocks = -1; return; }
        int dev = 0, cus = 0, per_cu = 0;
        hipGetDevice(&dev); hipDeviceGetAttribute(&cus, hipDeviceAttributeMultiprocessorCount, dev);
        if (hipFuncSetAttribute((const void*)mega, hipFuncAttributeMaxDynamicSharedMemorySize, LDS_BYTES) != hipSuccess) { fprintf(stderr, "hipFuncSetAttribute failed\n"); grid_blocks = -1; return; }
        if (hipOccupancyMaxActiveBlocksPerMultiprocessor(&per_cu, (const void*)mega, NTHR, LDS_BYTES) != hipSuccess || per_cu < 1) { fprintf(stderr, "occupancy query: %d\n", per_cu); per_cu = 1; }
        (void)hipGetLastError();
        grid_blocks = cus * 1;
    }
    if (grid_blocks < 0) return;
    Params p{};
    p.x = (const float*)d_in[0]; p.c = (const float*)d_in[1]; p.norm_g = (const float*)d_in[2]; p.w_ada = (const float*)d_in[3]; p.b_ada = (const float*)d_in[4];
    p.w_in = (const float*)d_in[5]; p.w_fft = (const float*)d_in[6]; p.na_bias = (const float*)d_in[7]; p.rl_f = (const float*)d_in[8]; p.rl_b = (const float*)d_in[9];
    p.conv_w = (const float*)d_in[10]; p.conv_b = (const float*)d_in[11]; p.ln_g = (const float*)d_in[12]; p.ln_b = (const float*)d_in[13]; p.w_pw = (const float*)d_in[14];
    p.w_out = (const float*)d_in[15]; p.final_g = (const float*)d_in[16];
    p.out = (float*)d_out; p.ws = (unsigned char*)d_ws;
#if ONE_LAUNCH
    p.ph_lo = 0; p.ph_hi = NPH;
    void* args[] = {&p};
    hipError_t e = hipLaunchCooperativeKernel((const void*)mega, dim3(grid_blocks), dim3(NTHR), args, LDS_BYTES, stream);
    if (e != hipSuccess) fprintf(stderr, "cooperative launch failed: %s (grid %d)\n", hipGetErrorString(e), grid_blocks);
#else
    for (int ph = 0; ph < NPH; ++ph) { p.ph_lo = ph; p.ph_hi = ph + 1; hipLaunchKernelGGL(mega, dim3(grid_blocks), dim3(NTHR), LDS_BYTES, stream, p); }
#endif
}
```

```cpp
#include <hip/hip_runtime.h>
#include <hip/hip_cooperative_groups.h>
#include <cstdio>
#include <cstdint>
namespace cg = cooperative_groups;

#ifndef ONE_LAUNCH
#define ONE_LAUNCH 1
#endif

__device__ __forceinline__ int otid() { int t; asm volatile("v_mov_b32 %0, %1" : "=v"(t) : "v"(threadIdx.x)); return t; }
namespace pg8 {
#define PG8_LAS __attribute__((address_space(3)))
typedef unsigned short bf16_t;
typedef short bf16x8 __attribute__((ext_vector_type(8)));
typedef float f32x4 __attribute__((ext_vector_type(4)));
typedef unsigned u32x4 __attribute__((ext_vector_type(4)));
constexpr int BM = 256, BK = 64, HALF = 128, HTB = HALF * BK * 2, STAGE_BYTES = 8 * HTB, NXCD = 8, WGM = 8;

__host__ __device__ __forceinline__ int lds_byte(int r, int c) { const int st = (r >> 4) * 2 + (c >> 5), rr = r & 15, cc = c & 31, ob = rr * 64 + cc * 2; return st * 1024 + (ob ^ (((ob >> 9) & 1) << 5)); }
__host__ __device__ __forceinline__ void stage_rc(int b, int& R, int& C) { const int st = b / 1024, sb = b % 1024, swz = sb ^ (((sb >> 9) & 1) << 5); R = (st >> 1) * 16 + swz / 64; C = (st & 1) * 32 + (swz % 64) / 2; }
__host__ __device__ __forceinline__ int perm32(int rho) { const int n = rho >> 4, i = rho & 15; return 8 * (i >> 2) + 4 * n + (i & 3); }

struct Unit { int pm, pn, aux, pad; const char* A; const char* B; };
struct Gemm { int lda, ldb, K; };

struct StaticOrder {
    int nM, nN, nwg, G, c;
    __host__ __device__ void init(int M, int N, int G_, int c_) { nM = M / BM; nN = N / BM; nwg = nM * nN; G = G_; c = c_; }
    __device__ bool next(int i, Unit& u) const {
        const long L = (long)i * G + c; if (L >= nwg) return false;
        int wgid = __builtin_amdgcn_readfirstlane((int)L); { const int q = nwg / NXCD, r = nwg % NXCD, xcd = wgid % NXCD, off = wgid / NXCD; wgid = (xcd < r ? xcd * (q + 1) : r * (q + 1) + (xcd - r) * q) + off; }
        const int nig = WGM * nN, gid = wgid / nig, fm = gid * WGM, gsz = (nM - fm) < WGM ? (nM - fm) : WGM;
        u.pm = __builtin_amdgcn_readfirstlane(fm + ((wgid % nig) % gsz)); u.pn = __builtin_amdgcn_readfirstlane((wgid % nig) / gsz); return true;
    }
};

__device__ __forceinline__ unsigned cvt_pk_bf16(float lo, float hi) { unsigned r; asm volatile("v_cvt_pk_bf16_f32 %0, %1, %2" : "=v"(r) : "v"(lo), "v"(hi)); return r; }

template <class Epi, class Sched, bool ALIGN_EPI>
__device__ __forceinline__ void gemm_phase(PG8_LAS unsigned char* lds, const Gemm g, const Sched& S, const Epi& E) {
    const int tid = otid(), wid = __builtin_amdgcn_readfirstlane(tid >> 6), lane = tid & 63, wr = wid >> 2, wc = wid & 3, fr = lane & 15, fq = lane >> 4;
    const int K = g.K, nt = K / BK;
    unsigned voffA[2], voffB[2];
#pragma unroll
    for (int i = 0; i < 2; ++i) { int R, C; stage_rc(tid * 16 + i * 8192, R, C); const int Rb = Epi::PERM ? ((R & ~31) + perm32(R & 31)) : R;
        voffA[i] = (unsigned)(R * g.lda + C) * 2u; voffB[i] = (unsigned)(Rb * g.ldb + C) * 2u; }
    const size_t kstep = (size_t)(BK * 2);
    const size_t hA = (size_t)HALF * g.lda * 2, hB = (size_t)HALF * g.ldb * 2;
    const unsigned ldsw = (unsigned)wid * 1024u;
    const int aoff = lds_byte(wr * 64 + fr, fq * 8), boff = lds_byte(wc * 32 + fr, fq * 8);
#define PG8_SA(b, h) (((b) * 2 + (h)) * HTB)
#define PG8_SB(b, h) ((4 + (b) * 2 + (h)) * HTB)
#define PG8_STAGE(bufoff, gbase, voff) do { _Pragma("unroll") for (int _i = 0; _i < 2; ++_i) \
        __builtin_amdgcn_global_load_lds((const unsigned*)((const char*)(gbase) + (voff)[_i]), (PG8_LAS unsigned*)(lds + (bufoff) + ldsw + _i * 8192), 16, 0, 0); } while (0)
#define PG8_LDA(dst, b, h) do { _Pragma("unroll") for (int m = 0; m < 4; ++m) _Pragma("unroll") for (int k = 0; k < 2; ++k) dst[m][k] = *(const PG8_LAS bf16x8*)(lds + PG8_SA(b, h) + aoff + m * 2048 + k * 1024); } while (0)
#define PG8_LDB(dst, b, h) do { _Pragma("unroll") for (int n = 0; n < 2; ++n) _Pragma("unroll") for (int k = 0; k < 2; ++k) dst[n][k] = *(const PG8_LAS bf16x8*)(lds + PG8_SB(b, h) + boff + n * 2048 + k * 1024); } while (0)
#define PG8_MMA(ai, bj, At, Bt) do { __builtin_amdgcn_s_setprio(1); _Pragma("unroll") for (int m = 0; m < 4; ++m) _Pragma("unroll") for (int n = 0; n < 2; ++n) _Pragma("unroll") for (int k = 0; k < 2; ++k) \
        acc[ai][bj][m][n] = __builtin_amdgcn_mfma_f32_16x16x32_bf16(Bt[n][k], At[m][k], acc[ai][bj][m][n], 0, 0, 0); __builtin_amdgcn_s_setprio(0); } while (0)
#define PG8_WAIT_V(n) asm volatile("s_waitcnt vmcnt(" #n ")" ::: "memory")
#define PG8_WAIT_L(n) asm volatile("s_waitcnt lgkmcnt(" #n ")" ::: "memory")
#define PG8_BAR __builtin_amdgcn_s_barrier()
#define PG8_SCHED __builtin_amdgcn_sched_barrier(0)
    Unit cur, nxt; int ui = 0;
    if (!S.next(0, cur)) return;
    f32x4 acc[2][2][4][2];
#pragma unroll
    for (int a = 0; a < 2; ++a)
#pragma unroll
        for (int b = 0; b < 2; ++b)
#pragma unroll
            for (int m = 0; m < 4; ++m)
#pragma unroll
                for (int n = 0; n < 2; ++n) acc[a][b][m][n] = (f32x4){0.f, 0.f, 0.f, 0.f};
    bf16x8 At[4][2], B0[2][2], B1[2][2];
    const char* cA = cur.A; const char* cB = cur.B;
    PG8_STAGE(PG8_SB(0, 0), cB, voffB); PG8_STAGE(PG8_SB(0, 1), cB + hB, voffB); PG8_STAGE(PG8_SA(0, 0), cA, voffA); PG8_STAGE(PG8_SA(0, 1), cA + hA, voffA);
    if (wr == 1) PG8_BAR;
    PG8_WAIT_V(2); PG8_BAR;
    PG8_STAGE(PG8_SB(1, 0), cB + kstep, voffB); PG8_STAGE(PG8_SA(1, 0), cA + kstep, voffA); PG8_STAGE(PG8_SB(1, 1), cB + hB + kstep, voffB);
    PG8_WAIT_V(6); PG8_BAR;
    for (;;) {
        const bool has_next = S.next(ui + 1, nxt);
        const char* nA = has_next ? nxt.A : cA; const char* nB = has_next ? nxt.B : cB;
        for (int t = 0; t < nt; t += 2) {
            const bool last = (t == nt - 2);
            const char* a1 = cA + (size_t)(t + 1) * kstep;
            const char* a2 = last ? nA : cA + (size_t)(t + 2) * kstep; const char* b2 = last ? nB : cB + (size_t)(t + 2) * kstep;
            const char* a3 = a2 + kstep; const char* b3 = b2 + kstep;
            PG8_LDB(B0, 0, 0); PG8_LDB(B1, 0, 1); PG8_SCHED; PG8_LDA(At, 0, 0); PG8_STAGE(PG8_SA(1, 1), a1 + hA, voffA);
            PG8_WAIT_V(8); PG8_WAIT_L(0); PG8_BAR; PG8_MMA(0, 0, At, B0); PG8_MMA(0, 1, At, B1); PG8_BAR; PG8_SCHED;
            PG8_LDA(At, 0, 1); PG8_STAGE(PG8_SB(0, 0), b2, voffB); PG8_STAGE(PG8_SB(0, 1), b2 + hB, voffB); PG8_STAGE(PG8_SA(0, 0), a2, voffA);
            PG8_WAIT_V(8); PG8_WAIT_L(0); PG8_BAR; PG8_MMA(1, 0, At, B0); PG8_MMA(1, 1, At, B1); PG8_BAR; PG8_SCHED;
            PG8_LDB(B0, 1, 0); PG8_LDB(B1, 1, 1); PG8_SCHED; PG8_LDA(At, 1, 0); PG8_STAGE(PG8_SA(0, 1), a2 + hA, voffA);
            PG8_WAIT_V(8); PG8_WAIT_L(0); PG8_BAR; PG8_MMA(0, 0, At, B0); PG8_MMA(0, 1, At, B1); PG8_BAR; PG8_SCHED;
            PG8_LDA(At, 1, 1); PG8_STAGE(PG8_SB(1, 0), b3, voffB); PG8_STAGE(PG8_SB(1, 1), b3 + hB, voffB); PG8_STAGE(PG8_SA(1, 0), a3, voffA);
            PG8_WAIT_V(8); PG8_WAIT_L(0); PG8_BAR; PG8_MMA(1, 0, At, B0); PG8_MMA(1, 1, At, B1); PG8_BAR; PG8_SCHED;
        }
        if constexpr (ALIGN_EPI) { if (wr == 0) PG8_BAR; }
        E(acc, cur, wr, wc, fr, fq);
        if (!has_next) break;
#pragma unroll
        for (int a = 0; a < 2; ++a)
#pragma unroll
            for (int b = 0; b < 2; ++b)
#pragma unroll
                for (int m = 0; m < 4; ++m)
#pragma unroll
                    for (int n = 0; n < 2; ++n) acc[a][b][m][n] = (f32x4){0.f, 0.f, 0.f, 0.f};
        cur = nxt; cA = nA; cB = nB; ++ui;
        if constexpr (ALIGN_EPI) { if (wr == 1) PG8_BAR; }
    }
    PG8_WAIT_V(0);
    if constexpr (!ALIGN_EPI) { if (wr == 0) PG8_BAR; }
    PG8_BAR;
#undef PG8_SA
#undef PG8_SB
#undef PG8_STAGE
#undef PG8_LDA
#undef PG8_LDB
#undef PG8_MMA
#undef PG8_WAIT_V
#undef PG8_WAIT_L
#undef PG8_BAR
#undef PG8_SCHED
}
}

typedef unsigned short bf16;
typedef float f32x4 __attribute__((ext_vector_type(4)));
typedef unsigned u32x4 __attribute__((ext_vector_type(4)));
typedef unsigned u32x2 __attribute__((ext_vector_type(2)));
constexpr int NB = 2, SEQ = 4096, DM = 2048, MTOK = NB * SEQ, DIN = 6656, DG = 512, NL = 2;
constexpr int LDS_BYTES = 147456;
constexpr int NTHR = 512;

constexpr size_t WS_WIN = 0;
constexpr size_t WS_WOUT = WS_WIN + (size_t)NL * DIN * DM * 2;
constexpr size_t WS_WFFT = WS_WOUT + (size_t)NL * DM * DM * 2;
constexpr size_t WS_WPW = WS_WFFT + (size_t)NL * DG * DG * 2;
constexpr size_t WS_DFT = WS_WPW + (size_t)NL * DG * DG * 2;
constexpr size_t WS_ROPE = WS_DFT + (size_t)SEQ * 2 * SEQ * 2;
constexpr size_t WS_MOD = WS_ROPE + (size_t)SEQ * 32 * 8;
constexpr size_t WS_U = WS_MOD + 131072;
constexpr size_t WS_Z = WS_U + (size_t)4 * MTOK * DG * 4;
constexpr size_t WS_PQT = WS_Z + (size_t)MTOK * DIN * 2;
constexpr size_t WS_Y = WS_PQT + (size_t)NB * DG * 2 * SEQ * 2;
constexpr size_t WS_CVH = WS_Y + (size_t)MTOK * DG * 2;
constexpr size_t WS_CAT = WS_CVH + (size_t)MTOK * DG * 2;
constexpr size_t WS_KV = WS_CAT + (size_t)MTOK * DM * 2;
constexpr size_t WS_END = WS_KV + (size_t)2 * NB * 8 * 32 * 4096 * 4;

struct Params {
    const float* x; const float* c; const float* norm_g; const float* w_ada; const float* b_ada; const float* w_in; const float* w_fft; const float* na_bias;
    const float* rl_f; const float* rl_b; const float* conv_w; const float* conv_b; const float* ln_g; const float* ln_b; const float* w_pw; const float* w_out; const float* final_g;
    float* out; unsigned char* ws; int ph_lo, ph_hi;
};

__device__ __forceinline__ unsigned f2bf(float f) { unsigned u = __float_as_uint(f); return (u + 0x7fffu + ((u >> 16) & 1u)) >> 16; }
__device__ __forceinline__ unsigned pk2(float lo, float hi) { return f2bf(lo) | (f2bf(hi) << 16); }
__device__ __forceinline__ float bf2f(bf16 b) { return __uint_as_float((unsigned)b << 16); }
__device__ __forceinline__ float bflo(unsigned u) { return __uint_as_float(u << 16); }
__device__ __forceinline__ float bfhi(unsigned u) { return __uint_as_float(u & 0xffff0000u); }
__device__ __forceinline__ float silu_f(float v) { return v / (1.f + __expf(-v)); }
__device__ __forceinline__ float wave_sum(float v) {
#pragma unroll
    for (int o = 1; o < 64; o <<= 1) v += __shfl_xor(v, o);
    return v;
}
__device__ __forceinline__ float wave_max(float v) {
#pragma unroll
    for (int o = 1; o < 64; o <<= 1) v = fmaxf(v, __shfl_xor(v, o));
    return v;
}

struct SchedS {
    pg8::StaticOrder o; const char* A; const char* B; size_t ta, tb;
    __device__ __forceinline__ bool next(int i, pg8::Unit& u) const { if (!o.next(i, u)) return false; u.A = A + (size_t)u.pm * ta; u.B = B + (size_t)u.pn * tb; u.aux = 0; return true; }
};
__device__ __forceinline__ SchedS make_sched(const void* A, int lda, const void* B, int ldb, int M, int N) {
    SchedS s; s.o.init(M, N, (int)gridDim.x, (int)blockIdx.x); s.A = (const char*)A; s.B = (const char*)B; s.ta = (size_t)256 * lda * 2; s.tb = (size_t)256 * ldb * 2; return s;
}
struct SchedDFT {
    const char* A; const char* B; int G, c;
    __device__ __forceinline__ bool next(int i, pg8::Unit& u) const {
        const int L = __builtin_amdgcn_readfirstlane(i * G + c); if (L >= 256) return false;
        const int sub = L >> 5, t = L & 31; u.pm = t >> 1; u.pn = t & 1; u.aux = sub;
        u.A = A + (size_t)((u.pm << 22) + ((sub & 3) << 12)); u.B = B + (size_t)(((sub >> 2) << 23) + (u.pn << 22) + ((sub & 3) << 12)); return true;
    }
};

struct EpiZ {
    static constexpr bool PERM = true;
    bf16* O; int ldc;
    __device__ __forceinline__ void operator()(const pg8::f32x4 (&acc)[2][2][4][2], const pg8::Unit& u, int wr, int wc, int fr, int fq) const {
        const int row0 = u.pm * 256 + wr * 64 + fr, col0 = u.pn * 256 + wc * 32 + 8 * fq;
#pragma unroll
        for (int ai = 0; ai < 2; ++ai)
#pragma unroll
            for (int m = 0; m < 4; ++m) { bf16* rowp = O + (size_t)(row0 + ai * 128 + m * 16) * ldc + col0;
#pragma unroll
                for (int bj = 0; bj < 2; ++bj) { const pg8::f32x4 v0 = acc[ai][bj][m][0], v1 = acc[ai][bj][m][1]; u32x4 w;
                    w.x = pg8::cvt_pk_bf16(v0[0], v0[1]); w.y = pg8::cvt_pk_bf16(v0[2], v0[3]); w.z = pg8::cvt_pk_bf16(v1[0], v1[1]); w.w = pg8::cvt_pk_bf16(v1[2], v1[3]);
                    *(u32x4*)(rowp + bj * 128) = w; } }
    }
};
struct EpiGate {
    static constexpr bool PERM = true;
    bf16* O; const bf16* Z; int coff, goff;
    __device__ __forceinline__ void operator()(const pg8::f32x4 (&acc)[2][2][4][2], const pg8::Unit& u, int wr, int wc, int fr, int fq) const {
        const int row0 = u.pm * 256 + wr * 64 + fr, col0 = u.pn * 256 + wc * 32 + 8 * fq;
#pragma unroll
        for (int ai = 0; ai < 2; ++ai)
#pragma unroll
            for (int m = 0; m < 4; ++m) { const size_t row = (size_t)(row0 + ai * 128 + m * 16);
#pragma unroll
                for (int bj = 0; bj < 2; ++bj) { const pg8::f32x4 v0 = acc[ai][bj][m][0], v1 = acc[ai][bj][m][1];
                    const u32x4 gz = *(const u32x4*)(Z + row * DIN + goff + col0 + bj * 128); u32x4 w;
                    w.x = pg8::cvt_pk_bf16(v0[0] * silu_f(bflo(gz.x)), v0[1] * silu_f(bfhi(gz.x))); w.y = pg8::cvt_pk_bf16(v0[2] * silu_f(bflo(gz.y)), v0[3] * silu_f(bfhi(gz.y)));
                    w.z = pg8::cvt_pk_bf16(v1[0] * silu_f(bflo(gz.z)), v1[1] * silu_f(bfhi(gz.z))); w.w = pg8::cvt_pk_bf16(v1[2] * silu_f(bflo(gz.w)), v1[3] * silu_f(bfhi(gz.w)));
                    *(u32x4*)(O + row * DM + coff + col0 + bj * 128) = w; } }
    }
};
struct EpiPart {
    static constexpr bool PERM = false;
    float* P;
    __device__ __forceinline__ void operator()(const pg8::f32x4 (&acc)[2][2][4][2], const pg8::Unit& u, int wr, int wc, int fr, int fq) const {
        const int row0 = u.pm * 256 + wr * 64 + fr, col0 = u.pn * 256 + wc * 32 + 4 * fq;
        float* base = P + (size_t)u.aux * 4096 * 512;
#pragma unroll
        for (int ai = 0; ai < 2; ++ai)
#pragma unroll
            for (int m = 0; m < 4; ++m) { float* rowp = base + (size_t)(row0 + ai * 128 + m * 16) * 512 + col0;
#pragma unroll
                for (int bj = 0; bj < 2; ++bj)
#pragma unroll
                    for (int n = 0; n < 2; ++n) *(pg8::f32x4*)(rowp + bj * 128 + n * 16) = acc[ai][bj][m][n]; }
    }
};
struct EpiRes {
    static constexpr bool PERM = false;
    const float* xin; float* xout; const float* gate;
    __device__ __forceinline__ void operator()(const pg8::f32x4 (&acc)[2][2][4][2], const pg8::Unit& u, int wr, int wc, int fr, int fq) const {
        const int row0 = u.pm * 256 + wr * 64 + fr, col0 = u.pn * 256 + wc * 32 + 4 * fq;
        const float* gp = gate + (size_t)(u.pm >> 4) * 6144 + col0;
        pg8::f32x4 gv[2][2];
#pragma unroll
        for (int bj = 0; bj < 2; ++bj)
#pragma unroll
            for (int n = 0; n < 2; ++n) gv[bj][n] = *(const pg8::f32x4*)(gp + bj * 128 + n * 16);
#pragma unroll
        for (int ai = 0; ai < 2; ++ai)
#pragma unroll
            for (int m = 0; m < 4; ++m) { const size_t ro = (size_t)(row0 + ai * 128 + m * 16) * DM + col0;
#pragma unroll
                for (int bj = 0; bj < 2; ++bj)
#pragma unroll
                    for (int n = 0; n < 2; ++n) { const pg8::f32x4 xi = *(const pg8::f32x4*)(xin + ro + bj * 128 + n * 16);
                        *(pg8::f32x4*)(xout + ro + bj * 128 + n * 16) = xi + gv[bj][n] * acc[ai][bj][m][n]; } }
    }
};

__device__ __forceinline__ void transpose_tile(const float* W, int K, int N, bf16* WT, int item, float* scr) {
    const int tid = otid(), nb = N / 64, kb = item / nb, nbk = item % nb, k0 = kb * 64, n0 = nbk * 64;
#pragma unroll
    for (int i = 0; i < 2; ++i) { const int kk = (tid >> 4) + 32 * i, nn = (tid & 15) * 4;
        const f32x4 v = *(const f32x4*)(W + (size_t)(k0 + kk) * N + n0 + nn);
        scr[kk * 65 + nn] = v[0]; scr[kk * 65 + nn + 1] = v[1]; scr[kk * 65 + nn + 2] = v[2]; scr[kk * 65 + nn + 3] = v[3]; }
    __syncthreads();
    { const int n = tid >> 3, kc = (tid & 7) * 8; const float* s = scr + kc * 65 + n; u32x4 o;
      o.x = pk2(s[0], s[65]); o.y = pk2(s[2 * 65], s[3 * 65]); o.z = pk2(s[4 * 65], s[5 * 65]); o.w = pk2(s[6 * 65], s[7 * 65]);
      *(u32x4*)(WT + (size_t)(n0 + n) * K + k0 + kc) = o; }
    __syncthreads();
}

__device__ __forceinline__ void ph_prologue(const Params& p, unsigned char* lds) {
    const int tid = otid(), lane = tid & 63, wave = tid >> 6, G = gridDim.x, bid = blockIdx.x;
    float* scr = (float*)lds;
    bf16* Wt_in = (bf16*)(p.ws + WS_WIN); bf16* Wt_out = (bf16*)(p.ws + WS_WOUT); bf16* Wt_fft = (bf16*)(p.ws + WS_WFFT); bf16* Wt_pw = (bf16*)(p.ws + WS_WPW);
    constexpr int T_IN = 32 * 104, T_OUT = 32 * 32, T_S = 64, T_L = T_IN + T_OUT + 2 * T_S;
    for (int it = bid; it < NL * T_L; it += G) {
        const int l = it / T_L; int r = it % T_L;
        if (r < T_IN) { transpose_tile(p.w_in + (size_t)l * DM * DIN, DM, DIN, Wt_in + (size_t)l * DIN * DM, r, scr); continue; } r -= T_IN;
        if (r < T_OUT) { transpose_tile(p.w_out + (size_t)l * DM * DM, DM, DM, Wt_out + (size_t)l * DM * DM, r, scr); continue; } r -= T_OUT;
        if (r < T_S) { transpose_tile(p.w_fft + (size_t)l * DG * DG, DG, DG, Wt_fft + (size_t)l * DG * DG, r, scr); continue; } r -= T_S;
        transpose_tile(p.w_pw + (size_t)l * DG * DG, DG, DG, Wt_pw + (size_t)l * DG * DG, r, scr);
    }
    float* cosT = (float*)(lds + 32768); float* sinT = (float*)(lds + 49152); float* ca = (float*)(lds + 65536); float* red = (float*)(lds + 81920);
    for (int j = tid; j < 4096; j += NTHR) { cosT[j] = cospif((float)j * (1.f / 2048.f)); sinT[j] = sinpif((float)j * (1.f / 2048.f)); }
    for (int j = tid; j < 4096; j += NTHR) { const float cv = p.c[j]; ca[j] = cv / (1.f + expf(-cv)); }
    __syncthreads();
    bf16* DFT = (bf16*)(p.ws + WS_DFT);
    for (int k = bid; k < 4096; k += G) {
#pragma unroll
        for (int cc = 0; cc < 2; ++cc) { const int kk0 = (tid + cc * NTHR) * 8; float v[8];
#pragma unroll
            for (int j = 0; j < 8; ++j) { const int kk = kk0 + j, idx = (k * (kk & 4095)) & 4095; v[j] = (kk < 4096) ? cosT[idx] : -sinT[idx]; }
            u32x4 o; o.x = pk2(v[0], v[1]); o.y = pk2(v[2], v[3]); o.z = pk2(v[4], v[5]); o.w = pk2(v[6], v[7]);
            *(u32x4*)(DFT + (size_t)k * 8192 + kk0) = o; }
    }
    { float2* rope = (float2*)(p.ws + WS_ROPE);
      for (int e = bid * NTHR + tid; e < 4096 * 32; e += G * NTHR) { const int s = e >> 5, i = e & 31;
          const float inv = (float)pow(10000.0, -(double)i / 32.0); const float ang = (float)s * inv;
          double sn, cs; sincos((double)ang, &sn, &cs); rope[e] = make_float2((float)cs, (float)sn); } }
    float* mod = (float*)(p.ws + WS_MOD);
    for (int t = bid; t < 192; t += G) {
        const int l = t / 96, col = (t % 96) * 64 + lane; const float* W = p.w_ada + (size_t)l * DM * 6144 + col;
        float a0 = 0.f, a1 = 0.f;
#pragma unroll 8
        for (int k = wave * 256; k < wave * 256 + 256; ++k) { const float w = W[(size_t)k * 6144]; a0 += ca[k] * w; a1 += ca[2048 + k] * w; }
        red[(wave * 2 + 0) * 64 + lane] = a0; red[(wave * 2 + 1) * 64 + lane] = a1;
        __syncthreads();
        if (wave < 2) { float s = 0.f;
#pragma unroll
            for (int w = 0; w < 8; ++w) s += red[(w * 2 + wave) * 64 + lane];
            mod[(size_t)(l * 2 + wave) * 6144 + col] = s + p.b_ada[l * 6144 + col]; }
        __syncthreads();
    }
}

__device__ __forceinline__ void ph_norm(const Params& p, int l) {
    const int tid = otid(), lane = tid & 63, wave = tid >> 6;
    const float* xin = (l == 0) ? p.x : p.out; bf16* h = (bf16*)(p.ws + WS_U); const float* mod = (const float*)(p.ws + WS_MOD);
    for (int row = blockIdx.x * 8 + wave; row < MTOK; row += gridDim.x * 8) {
        const f32x4* xr = (const f32x4*)(xin + (size_t)row * DM) + lane; f32x4 v[8]; float ss = 0.f;
#pragma unroll
        for (int j = 0; j < 8; ++j) { v[j] = xr[64 * j]; ss += (v[j][0] * v[j][0] + v[j][1] * v[j][1]) + (v[j][2] * v[j][2] + v[j][3] * v[j][3]); }
        ss = wave_sum(ss); const float rstd = rsqrtf(ss * (1.f / DM) + 1e-6f);
        const float* md = mod + (size_t)(l * 2 + (row >> 12)) * 6144; const float* g = p.norm_g + l * DM;
#pragma unroll
        for (int j = 0; j < 8; ++j) { const int col = (64 * j + lane) * 4;
            const f32x4 g4 = *(const f32x4*)(g + col), sh = *(const f32x4*)(md + col), sc = *(const f32x4*)(md + 2048 + col);
            const f32x4 o = (v[j] * rstd * g4) * (sc + 1.f) + sh; u32x2 w; w.x = pk2(o[0], o[1]); w.y = pk2(o[2], o[3]);
            *(u32x2*)(h + (size_t)row * DM + col) = w; }
    }
}
__device__ __forceinline__ void ph_final(const Params& p) {
    const int tid = otid(), lane = tid & 63, wave = tid >> 6;
    for (int row = blockIdx.x * 8 + wave; row < MTOK; row += gridDim.x * 8) {
        f32x4* xr = (f32x4*)(p.out + (size_t)row * DM) + lane; f32x4 v[8]; float ss = 0.f;
#pragma unroll
        for (int j = 0; j < 8; ++j) { v[j] = xr[64 * j]; ss += (v[j][0] * v[j][0] + v[j][1] * v[j][1]) + (v[j][2] * v[j][2] + v[j][3] * v[j][3]); }
        ss = wave_sum(ss); const float rstd = rsqrtf(ss * (1.f / DM) + 1e-6f);
#pragma unroll
        for (int j = 0; j < 8; ++j) { const int col = (64 * j + lane) * 4; const f32x4 g4 = *(const f32x4*)(p.final_g + col); xr[64 * j] = v[j] * rstd * g4; }
    }
}

typedef short bf16x8v __attribute__((ext_vector_type(8)));
__device__ __forceinline__ bf16x8v mk8(unsigned a, unsigned b, unsigned c, unsigned d) { u32x4 v = {a, b, c, d}; return __builtin_bit_cast(bf16x8v, v); }
#define MFMA16(a, b, c) __builtin_amdgcn_mfma_f32_16x16x32_bf16(a, b, c, 0, 0, 0)
constexpr int R_QS = 0, R_KS = 18432, R_VT = 36864, R_KTF = 54272, R_KTB = 71680, R_STF = 89088, R_STB = 98304;

template <bool R2>
__device__ __forceinline__ void ret_stage(const Params& p, int b, int h, int n, unsigned char* lds, float l2f, float l2b) {
    const int tid = otid(), j = tid >> 2, c4 = tid & 3, s = n * 128 + j;
    const bf16* Z = (const bf16*)(p.ws + WS_Z); const bf16* zr = Z + (size_t)(b * SEQ + s) * DIN;
    const f32x4* rp = (const f32x4*)((const float2*)(p.ws + WS_ROPE) + s * 32 + c4 * 8);
    float cs[8], sn[8];
#pragma unroll
    for (int i = 0; i < 4; ++i) { const f32x4 r = rp[i]; cs[2 * i] = r[0]; sn[2 * i] = r[1]; cs[2 * i + 1] = r[2]; sn[2 * i + 1] = r[3]; }
    bf16* KS = (bf16*)(lds + R_KS); bf16* VT = (bf16*)(lds + R_VT);
    { const u32x4 ka = *(const u32x4*)(zr + 7 * DG + h * 64 + c4 * 8), kb = *(const u32x4*)(zr + 7 * DG + h * 64 + 32 + c4 * 8);
      const unsigned kau[4] = {ka.x, ka.y, ka.z, ka.w}, kbu[4] = {kb.x, kb.y, kb.z, kb.w};
      float k1[8], k2[8];
#pragma unroll
      for (int i = 0; i < 4; ++i) { const float a0 = bflo(kau[i]), a1 = bfhi(kau[i]), b0 = bflo(kbu[i]), b1 = bfhi(kbu[i]);
          k1[2 * i] = a0 * cs[2 * i] - b0 * sn[2 * i]; k2[2 * i] = a0 * sn[2 * i] + b0 * cs[2 * i];
          k1[2 * i + 1] = a1 * cs[2 * i + 1] - b1 * sn[2 * i + 1]; k2[2 * i + 1] = a1 * sn[2 * i + 1] + b1 * cs[2 * i + 1]; }
      u32x4 o1, o2; o1.x = pk2(k1[0], k1[1]); o1.y = pk2(k1[2], k1[3]); o1.z = pk2(k1[4], k1[5]); o1.w = pk2(k1[6], k1[7]);
      o2.x = pk2(k2[0], k2[1]); o2.y = pk2(k2[2], k2[3]); o2.z = pk2(k2[4], k2[5]); o2.w = pk2(k2[6], k2[7]);
      *(u32x4*)(KS + j * 72 + c4 * 8) = o1; *(u32x4*)(KS + j * 72 + 32 + c4 * 8) = o2;
      if (!R2) { bf16* KTF = (bf16*)(lds + R_KTF); bf16* KTB = (bf16*)(lds + R_KTB);
          const float df = exp2f(l2f * (float)(127 - j)), db = exp2f(l2b * (float)j);
#pragma unroll
          for (int i = 0; i < 8; ++i) { KTF[(c4 * 8 + i) * 136 + j] = (bf16)f2bf(k1[i] * df); KTF[(32 + c4 * 8 + i) * 136 + j] = (bf16)f2bf(k2[i] * df);
              KTB[(c4 * 8 + i) * 136 + j] = (bf16)f2bf(k1[i] * db); KTB[(32 + c4 * 8 + i) * 136 + j] = (bf16)f2bf(k2[i] * db); } } }
    { const u32x4 va = *(const u32x4*)(zr + 8 * DG + h * 64 + c4 * 16), vb = *(const u32x4*)(zr + 8 * DG + h * 64 + c4 * 16 + 8);
      const unsigned vu[8] = {va.x, va.y, va.z, va.w, vb.x, vb.y, vb.z, vb.w};
#pragma unroll
      for (int i = 0; i < 8; ++i) { VT[(c4 * 16 + 2 * i) * 136 + j] = (bf16)(vu[i] & 0xffffu); VT[(c4 * 16 + 2 * i + 1) * 136 + j] = (bf16)(vu[i] >> 16); } }
    if (R2) { bf16* QS = (bf16*)(lds + R_QS);
      const u32x4 qa = *(const u32x4*)(zr + 6 * DG + h * 64 + c4 * 8), qb = *(const u32x4*)(zr + 6 * DG + h * 64 + 32 + c4 * 8);
      const unsigned qau[4] = {qa.x, qa.y, qa.z, qa.w}, qbu[4] = {qb.x, qb.y, qb.z, qb.w};
      float q1[8], q2[8];
#pragma unroll
      for (int i = 0; i < 4; ++i) { const float a0 = bflo(qau[i]), a1 = bfhi(qau[i]), b0 = bflo(qbu[i]), b1 = bfhi(qbu[i]);
          q1[2 * i] = (a0 * cs[2 * i] - b0 * sn[2 * i]) * 0.125f; q2[2 * i] = (a0 * sn[2 * i] + b0 * cs[2 * i]) * 0.125f;
          q1[2 * i + 1] = (a1 * cs[2 * i + 1] - b1 * sn[2 * i + 1]) * 0.125f; q2[2 * i + 1] = (a1 * sn[2 * i + 1] + b1 * cs[2 * i + 1]) * 0.125f; }
      u32x4 o1, o2; o1.x = pk2(q1[0], q1[1]); o1.y = pk2(q1[2], q1[3]); o1.z = pk2(q1[4], q1[5]); o1.w = pk2(q1[6], q1[7]);
      o2.x = pk2(q2[0], q2[1]); o2.y = pk2(q2[2], q2[3]); o2.z = pk2(q2[4], q2[5]); o2.w = pk2(q2[6], q2[7]);
      *(u32x4*)(QS + j * 72 + c4 * 8) = o1; *(u32x4*)(QS + j * 72 + 32 + c4 * 8) = o2; }
}

__device__ __forceinline__ void ret1_task(const Params& p, int l, int task, unsigned char* lds) {
    const int n = task & 31, h = (task >> 5) & 7, b = task >> 8;
    const float xf = p.rl_f[l * 8 + h], xb = p.rl_b[l * 8 + h];
    const float l2f = -log1pf(expf(-xf)) * 1.4426950408889634f, l2b = -log1pf(expf(-xb)) * 1.4426950408889634f;
    ret_stage<false>(p, b, h, n, lds, l2f, l2b);
    __syncthreads();
    const int tid = otid(), lane = tid & 63, w = tid >> 6, fr = lane & 15, fq = lane >> 4, dir = w >> 2, et = w & 3;
    const bf16* VT = (const bf16*)(lds + R_VT); const bf16* KT = (const bf16*)(lds + (dir ? R_KTB : R_KTF));
    bf16x8v a[4];
#pragma unroll
    for (int ks = 0; ks < 4; ++ks) a[ks] = *(const bf16x8v*)(VT + (16 * et + fr) * 136 + 32 * ks + 8 * fq);
    float* dst = (float*)(p.ws + WS_KV) + ((size_t)((dir * 2 + b) * 8 + h) * 32 + n) * 4096;
#pragma unroll
    for (int dt = 0; dt < 4; ++dt) { f32x4 acc = {0.f, 0.f, 0.f, 0.f};
#pragma unroll
        for (int ks = 0; ks < 4; ++ks) { const bf16x8v bfr = *(const bf16x8v*)(KT + (16 * dt + fr) * 136 + 32 * ks + 8 * fq); acc = MFMA16(a[ks], bfr, acc); }
#pragma unroll
        for (int r = 0; r < 4; ++r) dst[(16 * et + 4 * fq + r) * 64 + 16 * dt + fr] = acc[r]; }
    __syncthreads();
}

__device__ __forceinline__ void ret2_task(const Params& p, int l, int task, unsigned char* lds) {
    const int n = task & 31, h = (task >> 5) & 7, b = task >> 8;
    const float xf = p.rl_f[l * 8 + h], xb = p.rl_b[l * 8 + h];
    const float l2f = -log1pf(expf(-xf)) * 1.4426950408889634f, l2b = -log1pf(expf(-xb)) * 1.4426950408889634f;
    ret_stage<true>(p, b, h, n, lds, l2f, l2b);
    const int tid = otid(), lane = tid & 63, w = tid >> 6, fr = lane & 15, fq = lane >> 4;
    {
      const float gfC = exp2f(l2f * 128.f), gbC = exp2f(l2b * 128.f);
      const float* KVf = (const float*)(p.ws + WS_KV) + ((size_t)((0 * 2 + b) * 8 + h) * 32) * 4096 + tid * 8;
      const float* KVb = (const float*)(p.ws + WS_KV) + ((size_t)((1 * 2 + b) * 8 + h) * 32) * 4096 + tid * 8;
      f32x4 f0 = {0.f, 0.f, 0.f, 0.f}, f1 = f0, g0 = f0, g1 = f0; float cf = 1.f;
      for (int m = n - 1; m >= 0; --m) { const f32x4 x0 = *(const f32x4*)(KVf + (size_t)m * 4096), x1 = *(const f32x4*)(KVf + (size_t)m * 4096 + 4); f0 += x0 * cf; f1 += x1 * cf; cf *= gfC; }
      cf = 1.f;
      for (int m = n + 1; m < 32; ++m) { const f32x4 x0 = *(const f32x4*)(KVb + (size_t)m * 4096), x1 = *(const f32x4*)(KVb + (size_t)m * 4096 + 4); g0 += x0 * cf; g1 += x1 * cf; cf *= gbC; }
      const int e = tid >> 3, d0 = (tid & 7) * 8; u32x4 o;
      o.x = pk2(f0[0], f0[1]); o.y = pk2(f0[2], f0[3]); o.z = pk2(f1[0], f1[1]); o.w = pk2(f1[2], f1[3]); *(u32x4*)((bf16*)(lds + R_STF) + e * 72 + d0) = o;
      o.x = pk2(g0[0], g0[1]); o.y = pk2(g0[2], g0[3]); o.z = pk2(g1[0], g1[1]); o.w = pk2(g1[2], g1[3]); *(u32x4*)((bf16*)(lds + R_STB) + e * 72 + d0) = o; }
    __syncthreads();
    const bf16* QS = (const bf16*)(lds + R_QS); const bf16* KS = (const bf16*)(lds + R_KS); const bf16* VT = (const bf16*)(lds + R_VT);
    const bf16* STF = (const bf16*)(lds + R_STF); const bf16* STB = (const bf16*)(lds + R_STB);
    bf16x8v qf[2];
#pragma unroll
    for (int ks = 0; ks < 2; ++ks) qf[ks] = *(const bf16x8v*)(QS + (16 * w + fr) * 72 + 32 * ks + 8 * fq);
    const int ai = 16 * w + fr;
    unsigned pp[8][2];
#pragma unroll
    for (int jt = 0; jt < 8; ++jt) { f32x4 acc = {0.f, 0.f, 0.f, 0.f};
#pragma unroll
        for (int ks = 0; ks < 2; ++ks) { const bf16x8v kf = *(const bf16x8v*)(KS + (16 * jt + fr) * 72 + 32 * ks + 8 * fq); acc = MFMA16(kf, qf[ks], acc); }
        float sc[4];
#pragma unroll
        for (int r = 0; r < 4; ++r) { const int aj = 16 * jt + 4 * fq + r; const float wg = (aj <= ai) ? exp2f(l2f * (float)(ai - aj)) : exp2f(l2b * (float)(aj - ai)); sc[r] = acc[r] * wg; }
        pp[jt][0] = pk2(sc[0], sc[1]); pp[jt][1] = pk2(sc[2], sc[3]); }
    const float qdf = exp2f(l2f * (float)(ai + 1)), qdb = exp2f(l2b * (float)(128 - ai));
    f32x4 tot[4]; float ss = 0.f;
#pragma unroll
    for (int et = 0; et < 4; ++et) { f32x4 o = {0.f, 0.f, 0.f, 0.f}, cfa = o, cba = o;
#pragma unroll
        for (int t = 0; t < 4; ++t) { const u32x2 vlo = *(const u32x2*)(VT + (16 * et + fr) * 136 + 32 * t + 4 * fq), vhi = *(const u32x2*)(VT + (16 * et + fr) * 136 + 32 * t + 16 + 4 * fq);
            o = MFMA16(mk8(vlo.x, vlo.y, vhi.x, vhi.y), mk8(pp[2 * t][0], pp[2 * t][1], pp[2 * t + 1][0], pp[2 * t + 1][1]), o); }
#pragma unroll
        for (int ks = 0; ks < 2; ++ks) { const bf16x8v sf = *(const bf16x8v*)(STF + (16 * et + fr) * 72 + 32 * ks + 8 * fq), sb = *(const bf16x8v*)(STB + (16 * et + fr) * 72 + 32 * ks + 8 * fq);
            cfa = MFMA16(sf, qf[ks], cfa); cba = MFMA16(sb, qf[ks], cba); }
        tot[et] = o + cfa * qdf + cba * qdb;
        ss += (tot[et][0] * tot[et][0] + tot[et][1] * tot[et][1]) + (tot[et][2] * tot[et][2] + tot[et][3] * tot[et][3]); }
    ss += __shfl_xor(ss, 16); ss += __shfl_xor(ss, 32);
    const float rs = rsqrtf(ss * (1.f / 64.f) + 1e-6f);
    const size_t tok = (size_t)b * SEQ + n * 128 + ai;
    const bf16* Z = (const bf16*)(p.ws + WS_Z); bf16* CAT = (bf16*)(p.ws + WS_CAT);
#pragma unroll
    for (int et = 0; et < 4; ++et) { const u32x2 gz = *(const u32x2*)(Z + tok * DIN + 9 * DG + h * 64 + 16 * et + 4 * fq); u32x2 o;
        o.x = pk2(tot[et][0] * rs * silu_f(bflo(gz.x)), tot[et][1] * rs * silu_f(bfhi(gz.x))); o.y = pk2(tot[et][2] * rs * silu_f(bflo(gz.y)), tot[et][3] * rs * silu_f(bfhi(gz.y)));
        *(u32x2*)(CAT + tok * DM + 1024 + h * 64 + 16 * et + 4 * fq) = o; }
    __syncthreads();
}

__device__ __forceinline__ void na2_task(const Params& p, int l, int task, unsigned char* lds) {
    const int tid = otid(), lane = tid & 63, w = tid >> 6, fr = lane & 15, fq = lane >> 4;
    const int hp = task & 3, rq = (task >> 2) & 63, b = task >> 8;
    const int row_start = min(max(rq - 4, 0), 56);
    const bf16* Z = (const bf16*)(p.ws + WS_Z); bf16* CAT = (bf16*)(p.ws + WS_CAT);
    bf16* VT = (bf16*)lds; float* BI = (float*)(lds + 133120);
    for (int i = tid; i < 930; i += NTHR) BI[i] = p.na_bias[(size_t)(l * 8 + hp * 2) * 465 + i];
    { const int pair = lane & 31, chunk = (lane >> 5) + 2 * (w & 3), hh = w >> 2, h = hp * 2 + hh;
      unsigned* VTd = (unsigned*)(VT + (size_t)hh * 64 * 520);
#pragma unroll 2
      for (int a = 0; a < 8; ++a) {
          const size_t tok = (size_t)b * SEQ + (row_start + a) * 64 + 2 * pair;
          const bf16* src = Z + tok * DIN + 4 * DG + h * 64 + chunk * 8;
          const u32x4 x = *(const u32x4*)src, y = *(const u32x4*)(src + DIN);
          const unsigned xu[4] = {x.x, x.y, x.z, x.w}, yu[4] = {y.x, y.y, y.z, y.w};
#pragma unroll
          for (int i = 0; i < 4; ++i) { VTd[(chunk * 8 + 2 * i) * 260 + a * 32 + pair] = (xu[i] & 0xffffu) | (yu[i] << 16);
              VTd[(chunk * 8 + 2 * i + 1) * 260 + a * 32 + pair] = (xu[i] >> 16) | (yu[i] & 0xffff0000u); } } }
    __syncthreads();
    const int hh = w >> 2, h = hp * 2 + hh, qb = w & 3, ct0 = (qb >= 2) ? 1 : 0;
    const int c = 16 * qb + fr; const size_t qtok = (size_t)b * SEQ + rq * 64 + c;
    bf16x8v qf[2];
#pragma unroll
    for (int ks = 0; ks < 2; ++ks) qf[ks] = *(const bf16x8v*)(Z + qtok * DIN + 2 * DG + h * 64 + 32 * ks + 8 * fq);
    const int col_start = min(max(c - 8, 0), 48);
    const float* bi = BI + hh * 465;
    float sc[24][4]; float mx = -1e30f;
#pragma unroll
    for (int a = 0; a < 8; ++a)
#pragma unroll
        for (int ci = 0; ci < 3; ++ci) { const int kt = a * 3 + ci;
            const size_t ktok = (size_t)b * SEQ + (row_start + a) * 64 + 16 * (ct0 + ci) + fr;
            f32x4 acc = {0.f, 0.f, 0.f, 0.f};
#pragma unroll
            for (int ks = 0; ks < 2; ++ks) { const bf16x8v kf = *(const bf16x8v*)(Z + ktok * DIN + 3 * DG + h * 64 + 32 * ks + 8 * fq); acc = MFMA16(kf, qf[ks], acc); }
            const int dr = row_start + a - rq;
#pragma unroll
            for (int r = 0; r < 4; ++r) { const int kc = 16 * (ct0 + ci) + 4 * fq + r, rel = kc - col_start, dc = kc - c;
                float v = acc[r] * 0.125f + bi[(dr + 7) * 31 + min(max(dc + 15, 0), 30)];
                v = (rel >= 0 && rel < 16) ? v : -1e30f; sc[kt][r] = v; mx = fmaxf(mx, v); } }
    mx = fmaxf(mx, __shfl_xor(mx, 16)); mx = fmaxf(mx, __shfl_xor(mx, 32));
    float sum = 0.f; unsigned pp[24][2];
#pragma unroll
    for (int kt = 0; kt < 24; ++kt) { const float e0 = __expf(sc[kt][0] - mx), e1 = __expf(sc[kt][1] - mx), e2 = __expf(sc[kt][2] - mx), e3 = __expf(sc[kt][3] - mx);
        sum += (e0 + e1) + (e2 + e3); pp[kt][0] = pk2(e0, e1); pp[kt][1] = pk2(e2, e3); }
    sum += __shfl_xor(sum, 16); sum += __shfl_xor(sum, 32);
    const float inv = 1.f / sum;
    const bf16* VTh = VT + (size_t)hh * 64 * 520;
#pragma unroll
    for (int dt = 0; dt < 4; ++dt) { f32x4 o = {0.f, 0.f, 0.f, 0.f};
#pragma unroll
        for (int t = 0; t < 12; ++t) { const int k0 = 2 * t, k1 = 2 * t + 1, a0 = k0 / 3, c0 = k0 % 3, a1 = k1 / 3, c1 = k1 % 3;
            const u32x2 vlo = *(const u32x2*)(VTh + (16 * dt + fr) * 520 + a0 * 64 + 16 * (ct0 + c0) + 4 * fq), vhi = *(const u32x2*)(VTh + (16 * dt + fr) * 520 + a1 * 64 + 16 * (ct0 + c1) + 4 * fq);
            o = MFMA16(mk8(vlo.x, vlo.y, vhi.x, vhi.y), mk8(pp[k0][0], pp[k0][1], pp[k1][0], pp[k1][1]), o); }
        const u32x2 gz = *(const u32x2*)(Z + qtok * DIN + 5 * DG + h * 64 + 16 * dt + 4 * fq); u32x2 ov;
        ov.x = pk2(o[0] * inv * silu_f(bflo(gz.x)), o[1] * inv * silu_f(bfhi(gz.x))); ov.y = pk2(o[2] * inv * silu_f(bflo(gz.y)), o[3] * inv * silu_f(bfhi(gz.y)));
        *(u32x2*)(CAT + qtok * DM + 512 + h * 64 + 16 * dt + 4 * fq) = ov; }
    __syncthreads();
}

__device__ __forceinline__ void conv_task(const Params& p, int l, int task, unsigned char* lds) {
    const int tid = otid(), lane = tid & 63, wave = tid >> 6;
    float* us = (float*)lds; float* ys = us + 46 * 512;
    const bf16* Z = (const bf16*)(p.ws + WS_Z);
    const int b = task >> 8, t0 = (task & 255) * 16;
    for (int tt = 0; tt < 46; ++tt) { const int tok = t0 - 15 + tt; float u = 0.f;
        if (tok >= 0 && tok < SEQ) { const bf16* zr = Z + (size_t)(b * SEQ + tok) * DIN; const float a = bf2f(zr[10 * DG + tid]), g = bf2f(zr[11 * DG + tid]); u = a / (1.f + __expf(-g)); }
        us[tt * 512 + tid] = u; }
    float w[31];
#pragma unroll
    for (int k = 0; k < 31; ++k) w[k] = p.conv_w[(size_t)(l * 31 + k) * DG + tid];
    const float cb = p.conv_b[l * DG + tid];
    __syncthreads();
    for (int t = 0; t < 16; ++t) { float acc = cb;
#pragma unroll
        for (int k = 0; k < 31; ++k) acc += w[k] * us[(t + k) * 512 + tid];
        ys[t * 512 + tid] = acc; }
    __syncthreads();
#pragma unroll
    for (int tw = 0; tw < 2; ++tw) { const int t = wave + 8 * tw; float v[8]; float s = 0.f;
#pragma unroll
        for (int j = 0; j < 8; ++j) { v[j] = ys[t * 512 + lane + 64 * j]; s += v[j]; }
        const float mu = wave_sum(s) * (1.f / 512.f); float q = 0.f;
#pragma unroll
        for (int j = 0; j < 8; ++j) { v[j] -= mu; q += v[j] * v[j]; }
        const float rstd = rsqrtf(wave_sum(q) * (1.f / 512.f) + 1e-6f);
        bf16* orow = (bf16*)(p.ws + WS_CVH) + (size_t)(b * SEQ + t0 + t) * DG;
#pragma unroll
        for (int j = 0; j < 8; ++j) { const int ch = lane + 64 * j; const float y = v[j] * rstd * p.ln_g[l * DG + ch] + p.ln_b[l * DG + ch]; orow[ch] = (bf16)f2bf(silu_f(y)); } }
    __syncthreads();
}

__device__ __forceinline__ void f1_task(const Params& p, int task, unsigned char* lds) {
    const int tid = otid();
    float* us = (float*)lds; float* cs = us + 8 * 512; float* sn = cs + 128;
    const bf16* Z = (const bf16*)(p.ws + WS_Z);
    const int tok0 = task * 8, b = tok0 >> 12, s0 = tok0 & 4095;
    if (tid < 128) { cs[tid] = cospif((float)tid * (1.f / 64.f)); sn[tid] = sinpif((float)tid * (1.f / 64.f)); }
#pragma unroll
    for (int tk = 0; tk < 8; ++tk) us[tk * 512 + tid] = bf2f(Z[(size_t)(tok0 + tk) * DIN + tid]);
    __syncthreads();
    const int g = tid >> 7, m = tid & 127;
    float P[8], Q[8];
#pragma unroll
    for (int tk = 0; tk < 8; ++tk) { P[tk] = 0.f; Q[tk] = 0.f; }
    for (int c = 0; c < 128; ++c) { const int idx = (m * c) & 127; const float cv = cs[idx], sv = sn[idx];
#pragma unroll
        for (int tk = 0; tk < 8; ++tk) { const float u = us[tk * 512 + g * 128 + c]; P[tk] += u * cv; Q[tk] += u * sv; } }
    const float nrm = 0.0013810679320049757f;
    bf16* PQ = (bf16*)(p.ws + WS_PQT) + ((size_t)(b * 512 + tid) * 2) * 4096 + s0;
    u32x4 o; o.x = pk2(P[0] * nrm, P[1] * nrm); o.y = pk2(P[2] * nrm, P[3] * nrm); o.z = pk2(P[4] * nrm, P[5] * nrm); o.w = pk2(P[6] * nrm, P[7] * nrm);
    *(u32x4*)PQ = o;
    o.x = pk2(Q[0] * nrm, Q[1] * nrm); o.y = pk2(Q[2] * nrm, Q[3] * nrm); o.z = pk2(Q[4] * nrm, Q[5] * nrm); o.w = pk2(Q[6] * nrm, Q[7] * nrm);
    *(u32x4*)(PQ + 4096) = o;
    __syncthreads();
}

__device__ __forceinline__ void ph_mixA(const Params& p, int l, unsigned char* lds) {
    const int G = gridDim.x, bid = blockIdx.x;
    for (int t = bid; t < 512; t += G) ret1_task(p, l, t, lds);
    for (int t = bid; t < 512; t += G) na2_task(p, l, t, lds);
    for (int t = bid; t < 512; t += G) conv_task(p, l, t, lds);
    for (int t = bid; t < 1024; t += G) f1_task(p, t, lds);
}

__device__ __forceinline__ void ph_combine(const Params& p) {
    const float* part = (const float*)(p.ws + WS_U); bf16* Y = (bf16*)(p.ws + WS_Y);
    for (int e = blockIdx.x * NTHR + threadIdx.x; e < MTOK * DG / 4; e += gridDim.x * NTHR) {
        const int row = e >> 7, c4 = (e & 127) * 4, b = row >> 12, k = row & 4095;
        f32x4 s = {0.f, 0.f, 0.f, 0.f};
#pragma unroll
        for (int ks = 0; ks < 4; ++ks) s += *(const f32x4*)(part + ((size_t)((b * 4 + ks) * 4096 + k)) * 512 + c4);
        u32x2 w; w.x = pk2(s[0], s[1]); w.y = pk2(s[2], s[3]);
        *(u32x2*)(Y + (size_t)row * DG + c4) = w;
    }
}

constexpr int NPH = 16;
__global__ void __launch_bounds__(NTHR) mega(Params p) {
    extern __shared__ __attribute__((aligned(16))) unsigned char lds[];
    cg::grid_group grid = cg::this_grid();
    PG8_LAS unsigned char* ldsl = (PG8_LAS unsigned char*)lds;
    const int lo = p.ph_lo, hi = p.ph_hi;
#define IN(k) (lo <= (k) && (k) < hi)
#define SEAM(k) do { if (IN(k) && IN((k) + 1)) { __threadfence(); grid.sync(); } } while (0)
    bf16* Zb = (bf16*)(p.ws + WS_Z); bf16* CAT = (bf16*)(p.ws + WS_CAT);
#ifndef T_NOPRO
    if (IN(0)) ph_prologue(p, lds);
#endif
    SEAM(0);
#pragma unroll
    for (int l = 0; l < NL; ++l) {
        const int pb = 1 + 7 * l;
#ifndef T_NONORM
        if (IN(pb)) ph_norm(p, l);
#endif
        SEAM(pb);
        if (IN(pb + 1)) {
            SchedS S = make_sched(p.ws + WS_U, DM, p.ws + WS_WIN + (size_t)l * DIN * DM * 2, DM, MTOK, DIN);
            EpiZ E{Zb, DIN};
            pg8::gemm_phase<EpiZ, SchedS, true>(ldsl, pg8::Gemm{DM, DM, DM}, S, E);
        }
        SEAM(pb + 1);
#ifndef T_NOMIX
        if (IN(pb + 2)) ph_mixA(p, l, lds);
#endif
        SEAM(pb + 2);
#ifndef T_ONEGEMM
        if (IN(pb + 3)) {
#ifndef T_NOG1
            { SchedDFT S{(const char*)(p.ws + WS_DFT), (const char*)(p.ws + WS_PQT), (int)gridDim.x, (int)blockIdx.x};
              EpiPart E{(float*)(p.ws + WS_U)};
              pg8::gemm_phase<EpiPart, SchedDFT, true>(ldsl, pg8::Gemm{8192, 8192, 2048}, S, E); }
#endif
#ifndef T_NOG2
            { SchedS S = make_sched(p.ws + WS_CVH, DG, p.ws + WS_WPW + (size_t)l * DG * DG * 2, DG, MTOK, DG);
              EpiGate E{CAT, Zb, 1536, 12 * DG};
              pg8::gemm_phase<EpiGate, SchedS, true>(ldsl, pg8::Gemm{DG, DG, DG}, S, E); }
#endif
            for (int t = blockIdx.x; t < 512; t += gridDim.x) ret2_task(p, l, t, lds);
        }
        SEAM(pb + 3);
        if (IN(pb + 4)) ph_combine(p);
        SEAM(pb + 4);
#ifndef T_NOG3
        if (IN(pb + 5)) {
            SchedS S = make_sched(p.ws + WS_Y, DG, p.ws + WS_WFFT + (size_t)l * DG * DG * 2, DG, MTOK, DG);
            EpiGate E{CAT, Zb, 0, 1 * DG};
            pg8::gemm_phase<EpiGate, SchedS, true>(ldsl, pg8::Gemm{DG, DG, DG}, S, E);
        }
#endif
        SEAM(pb + 5);
#ifndef T_NOG4
        if (IN(pb + 6)) {
            SchedS S = make_sched(CAT, DM, p.ws + WS_WOUT + (size_t)l * DM * DM * 2, DM, MTOK, DM);
            EpiRes E{(l == 0) ? p.x : p.out, p.out, (const float*)(p.ws + WS_MOD) + (size_t)l * 2 * 6144 + 4096};
            pg8::gemm_phase<EpiRes, SchedS, true>(ldsl, pg8::Gemm{DM, DM, DM}, S, E);
        }
#endif
        SEAM(pb + 6);
#endif
    }
    if (IN(NPH - 1)) ph_final(p);
#undef IN
#undef SEAM
}

extern "C" void kernel_launch(void* const* d_in, const int* in_sizes, int n_in, void* d_out, int out_size, void* d_ws, size_t ws_size, hipStream_t stream) {
    static int grid_blocks = 0;
    if (grid_blocks == 0) {
        if (n_in != 17 || ws_size < WS_END) { fprintf(stderr, "kernel_launch: n_in %d ws %zu (need %zu)\n", n_in, ws_size, (size_t)WS_END); grid_blocks = -1; return; }
        int dev = 0, cus = 0, per_cu = 0;
        hipGetDevice(&dev); hipDeviceGetAttribute(&cus, hipDeviceAttributeMultiprocessorCount, dev);
        if (hipFuncSetAttribute((const void*)mega, hipFuncAttributeMaxDynamicSharedMemorySize, LDS_BYTES) != hipSuccess) { fprintf(stderr, "hipFuncSetAttribute failed\n"); grid_blocks = -1; return; }
        if (hipOccupancyMaxActiveBlocksPerMultiprocessor(&per_cu, (const void*)mega, NTHR, LDS_BYTES) != hipSuccess || per_cu < 1) { fprintf(stderr, "occupancy query: %d\n", per_cu); per_cu = 1; }
        (void)hipGetLastError();
        grid_blocks = cus * 1;
    }
    if (grid_blocks < 0) return;
    Params p{};
    p.x = (const float*)d_in[0]; p.c = (const float*)d_in[1]; p.norm_g = (const float*)d_in[2]; p.w_ada = (const float*)d_in[3]; p.b_ada = (const float*)d_in[4];
    p.w_in = (const float*)d_in[5]; p.w_fft = (const float*)d_in[6]; p.na_bias = (const float*)d_in[7]; p.rl_f = (const float*)d_in[8]; p.rl_b = (const float*)d_in[9];
    p.conv_w = (const float*)d_in[10]; p.conv_b = (const float*)d_in[11]; p.ln_g = (const float*)d_in[12]; p.ln_b = (const float*)d_in[13]; p.w_pw = (const float*)d_in[14];
    p.w_out = (const float*)d_in[15]; p.final_g = (const float*)d_in[16];
    p.out = (float*)d_out; p.ws = (unsigned char*)d_ws;
#if ONE_LAUNCH
    p.ph_lo = 0; p.ph_hi = NPH;
    void* args[] = {&p};
    hipError_t e = hipLaunchCooperativeKernel((const void*)mega, dim3(grid_blocks), dim3(NTHR), args, LDS_BYTES, stream);
    if (e != hipSuccess) fprintf(stderr, "cooperative launch failed: %s (grid %d)\n", hipGetErrorString(e), grid_blocks);
#else
    for (int ph = 0; ph < NPH; ++ph) { p.ph_lo = ph; p.ph_hi = ph + 1; hipLaunchKernelGGL(mega, dim3(grid_blocks), dim3(NTHR), LDS_BYTES, stream, p); }
#endif
}
```

```cpp
#include <hip/hip_runtime.h>
#include <hip/hip_cooperative_groups.h>
#include <cstdio>
#include <cstdint>
namespace cg = cooperative_groups;

#ifndef ONE_LAUNCH
#define ONE_LAUNCH 1
#endif

__device__ __forceinline__ int otid() { int t; asm volatile("v_mov_b32 %0, %1" : "=v"(t) : "v"(threadIdx.x)); return t; }
namespace pg8 {
#define PG8_LAS __attribute__((address_space(3)))
typedef unsigned short bf16_t;
typedef short bf16x8 __attribute__((ext_vector_type(8)));
typedef float f32x4 __attribute__((ext_vector_type(4)));
typedef unsigned u32x4 __attribute__((ext_vector_type(4)));
constexpr int BM = 256, BK = 64, HALF = 128, HTB = HALF * BK * 2, STAGE_BYTES = 8 * HTB, NXCD = 8, WGM = 8;

__host__ __device__ __forceinline__ int lds_byte(int r, int c) { const int st = (r >> 4) * 2 + (c >> 5), rr = r & 15, cc = c & 31, ob = rr * 64 + cc * 2; return st * 1024 + (ob ^ (((ob >> 9) & 1) << 5)); }
__host__ __device__ __forceinline__ void stage_rc(int b, int& R, int& C) { const int st = b / 1024, sb = b % 1024, swz = sb ^ (((sb >> 9) & 1) << 5); R = (st >> 1) * 16 + swz / 64; C = (st & 1) * 32 + (swz % 64) / 2; }
__host__ __device__ __forceinline__ int perm32(int rho) { const int n = rho >> 4, i = rho & 15; return 8 * (i >> 2) + 4 * n + (i & 3); }

struct Unit { int pm, pn, aux, pad; const char* A; const char* B; };
struct Gemm { int lda, ldb, K; };

struct StaticOrder {
    int nM, nN, nwg, G, c;
    __host__ __device__ void init(int M, int N, int G_, int c_) { nM = M / BM; nN = N / BM; nwg = nM * nN; G = G_; c = c_; }
    __device__ bool next(int i, Unit& u) const {
        const long L = (long)i * G + c; if (L >= nwg) return false;
        int wgid = __builtin_amdgcn_readfirstlane((int)L); { const int q = nwg / NXCD, r = nwg % NXCD, xcd = wgid % NXCD, off = wgid / NXCD; wgid = (xcd < r ? xcd * (q + 1) : r * (q + 1) + (xcd - r) * q) + off; }
        const int nig = WGM * nN, gid = wgid / nig, fm = gid * WGM, gsz = (nM - fm) < WGM ? (nM - fm) : WGM;
        u.pm = __builtin_amdgcn_readfirstlane(fm + ((wgid % nig) % gsz)); u.pn = __builtin_amdgcn_readfirstlane((wgid % nig) / gsz); return true;
    }
};

__device__ __forceinline__ unsigned cvt_pk_bf16(float lo, float hi) { unsigned r; asm volatile("v_cvt_pk_bf16_f32 %0, %1, %2" : "=v"(r) : "v"(lo), "v"(hi)); return r; }

template <class Epi, class Sched, bool ALIGN_EPI>
__device__ __forceinline__ void gemm_phase(PG8_LAS unsigned char* lds, const Gemm g, const Sched& S, const Epi& E) {
    const int tid = otid(), wid = __builtin_amdgcn_readfirstlane(tid >> 6), lane = tid & 63, wr = wid >> 2, wc = wid & 3, fr = lane & 15, fq = lane >> 4;
    const int K = g.K, nt = K / BK;
    unsigned voffA[2], voffB[2];
#pragma unroll
    for (int i = 0; i < 2; ++i) { int R, C; stage_rc(tid * 16 + i * 8192, R, C); const int Rb = Epi::PERM ? ((R & ~31) + perm32(R & 31)) : R;
        voffA[i] = (unsigned)(R * g.lda + C) * 2u; voffB[i] = (unsigned)(Rb * g.ldb + C) * 2u; }
    const size_t kstep = (size_t)(BK * 2);
    const size_t hA = (size_t)HALF * g.lda * 2, hB = (size_t)HALF * g.ldb * 2;
    const unsigned ldsw = (unsigned)wid * 1024u;
    const int aoff = lds_byte(wr * 64 + fr, fq * 8), boff = lds_byte(wc * 32 + fr, fq * 8);
#define PG8_SA(b, h) (((b) * 2 + (h)) * HTB)
#define PG8_SB(b, h) ((4 + (b) * 2 + (h)) * HTB)
#define PG8_STAGE(bufoff, gbase, voff) do { _Pragma("unroll") for (int _i = 0; _i < 2; ++_i) \
        __builtin_amdgcn_global_load_lds((const unsigned*)((const char*)(gbase) + (voff)[_i]), (PG8_LAS unsigned*)(lds + (bufoff) + ldsw + _i * 8192), 16, 0, 0); } while (0)
#define PG8_LDA(dst, b, h) do { _Pragma("unroll") for (int m = 0; m < 4; ++m) _Pragma("unroll") for (int k = 0; k < 2; ++k) dst[m][k] = *(const PG8_LAS bf16x8*)(lds + PG8_SA(b, h) + aoff + m * 2048 + k * 1024); } while (0)
#define PG8_LDB(dst, b, h) do { _Pragma("unroll") for (int n = 0; n < 2; ++n) _Pragma("unroll") for (int k = 0; k < 2; ++k) dst[n][k] = *(const PG8_LAS bf16x8*)(lds + PG8_SB(b, h) + boff + n * 2048 + k * 1024); } while (0)
#define PG8_MMA(ai, bj, At, Bt) do { __builtin_amdgcn_s_setprio(1); _Pragma("unroll") for (int m = 0; m < 4; ++m) _Pragma("unroll") for (int n = 0; n < 2; ++n) _Pragma("unroll") for (int k = 0; k < 2; ++k) \
        acc[ai][bj][m][n] = __builtin_amdgcn_mfma_f32_16x16x32_bf16(Bt[n][k], At[m][k], acc[ai][bj][m][n], 0, 0, 0); __builtin_amdgcn_s_setprio(0); } while (0)
#define PG8_WAIT_V(n) asm volatile("s_waitcnt vmcnt(" #n ")" ::: "memory")
#define PG8_WAIT_L(n) asm volatile("s_waitcnt lgkmcnt(" #n ")" ::: "memory")
#define PG8_BAR __builtin_amdgcn_s_barrier()
#define PG8_SCHED __builtin_amdgcn_sched_barrier(0)
    Unit cur, nxt; int ui = 0;
    if (!S.next(0, cur)) return;
    f32x4 acc[2][2][4][2];
#pragma unroll
    for (int a = 0; a < 2; ++a)
#pragma unroll
        for (int b = 0; b < 2; ++b)
#pragma unroll
            for (int m = 0; m < 4; ++m)
#pragma unroll
                for (int n = 0; n < 2; ++n) acc[a][b][m][n] = (f32x4){0.f, 0.f, 0.f, 0.f};
    bf16x8 At[4][2], B0[2][2], B1[2][2];
    const char* cA = cur.A; const char* cB = cur.B;
    PG8_STAGE(PG8_SB(0, 0), cB, voffB); PG8_STAGE(PG8_SB(0, 1), cB + hB, voffB); PG8_STAGE(PG8_SA(0, 0), cA, voffA); PG8_STAGE(PG8_SA(0, 1), cA + hA, voffA);
    if (wr == 1) PG8_BAR;
    PG8_WAIT_V(2); PG8_BAR;
    PG8_STAGE(PG8_SB(1, 0), cB + kstep, voffB); PG8_STAGE(PG8_SA(1, 0), cA + kstep, voffA); PG8_STAGE(PG8_SB(1, 1), cB + hB + kstep, voffB);
    PG8_WAIT_V(6); PG8_BAR;
    for (;;) {
        const bool has_next = S.next(ui + 1, nxt);
        const char* nA = has_next ? nxt.A : cA; const char* nB = has_next ? nxt.B : cB;
        for (int t = 0; t < nt; t += 2) {
            const bool last = (t == nt - 2);
            const char* a1 = cA + (size_t)(t + 1) * kstep;
            const char* a2 = last ? nA : cA + (size_t)(t + 2) * kstep; const char* b2 = last ? nB : cB + (size_t)(t + 2) * kstep;
            const char* a3 = a2 + kstep; const char* b3 = b2 + kstep;
            PG8_LDB(B0, 0, 0); PG8_LDB(B1, 0, 1); PG8_SCHED; PG8_LDA(At, 0, 0); PG8_STAGE(PG8_SA(1, 1), a1 + hA, voffA);
            PG8_WAIT_V(8); PG8_WAIT_L(0); PG8_BAR; PG8_MMA(0, 0, At, B0); PG8_MMA(0, 1, At, B1); PG8_BAR; PG8_SCHED;
            PG8_LDA(At, 0, 1); PG8_STAGE(PG8_SB(0, 0), b2, voffB); PG8_STAGE(PG8_SB(0, 1), b2 + hB, voffB); PG8_STAGE(PG8_SA(0, 0), a2, voffA);
            PG8_WAIT_V(8); PG8_WAIT_L(0); PG8_BAR; PG8_MMA(1, 0, At, B0); PG8_MMA(1, 1, At, B1); PG8_BAR; PG8_SCHED;
            PG8_LDB(B0, 1, 0); PG8_LDB(B1, 1, 1); PG8_SCHED; PG8_LDA(At, 1, 0); PG8_STAGE(PG8_SA(0, 1), a2 + hA, voffA);
            PG8_WAIT_V(8); PG8_WAIT_L(0); PG8_BAR; PG8_MMA(0, 0, At, B0); PG8_MMA(0, 1, At, B1); PG8_BAR; PG8_SCHED;
            PG8_LDA(At, 1, 1); PG8_STAGE(PG8_SB(1, 0), b3, voffB); PG8_STAGE(PG8_SB(1, 1), b3 + hB, voffB); PG8_STAGE(PG8_SA(1, 0), a3, voffA);
            PG8_WAIT_V(8); PG8_WAIT_L(0); PG8_BAR; PG8_MMA(1, 0, At, B0); PG8_MMA(1, 1, At, B1); PG8_BAR; PG8_SCHED;
        }
        if constexpr (ALIGN_EPI) { if (wr == 0) PG8_BAR; }
        E(acc, cur, wr, wc, fr, fq);
        if (!has_next) break;
#pragma unroll
        for (int a = 0; a < 2; ++a)
#pragma unroll
            for (int b = 0; b < 2; ++b)
#pragma unroll
                for (int m = 0; m < 4; ++m)
#pragma unroll
                    for (int n = 0; n < 2; ++n) acc[a][b][m][n] = (f32x4){0.f, 0.f, 0.f, 0.f};
        cur = nxt; cA = nA; cB = nB; ++ui;
        if constexpr (ALIGN_EPI) { if (wr == 1) PG8_BAR; }
    }
    PG8_WAIT_V(0);
    if constexpr (!ALIGN_EPI) { if (wr == 0) PG8_BAR; }
    PG8_BAR;
#undef PG8_SA
#undef PG8_SB
#undef PG8_STAGE
#undef PG8_LDA
#undef PG8_LDB
#undef PG8_MMA
#undef PG8_WAIT_V
#undef PG8_WAIT_L
#undef PG8_BAR
#undef PG8_SCHED
}
}

typedef unsigned short bf16;
typedef float f32x4 __attribute__((ext_vector_type(4)));
typedef unsigned u32x4 __attribute__((ext_vector_type(4)));
typedef unsigned u32x2 __attribute__((ext_vector_type(2)));
constexpr int NB = 2, SEQ = 4096, DM = 2048, MTOK = NB * SEQ, DIN = 6656, DG = 512, NL = 2;
constexpr int LDS_BYTES = 147456;
constexpr int NTHR = 512;

constexpr size_t WS_WIN = 0;
constexpr size_t WS_WOUT = WS_WIN + (size_t)NL * DIN * DM * 2;
constexpr size_t WS_WFFT = WS_WOUT + (size_t)NL * DM * DM * 2;
constexpr size_t WS_WPW = WS_WFFT + (size_t)NL * DG * DG * 2;
constexpr size_t WS_DFT = WS_WPW + (size_t)NL * DG * DG * 2;
constexpr size_t WS_ROPE = WS_DFT + (size_t)SEQ * 2 * SEQ * 2;
constexpr size_t WS_MOD = WS_ROPE + (size_t)SEQ * 32 * 8;
constexpr size_t WS_U = WS_MOD + 131072;
constexpr size_t WS_Z = WS_U + (size_t)4 * MTOK * DG * 4;
constexpr size_t WS_PQT = WS_Z + (size_t)MTOK * DIN * 2;
constexpr size_t WS_Y = WS_PQT + (size_t)NB * DG * 2 * SEQ * 2;
constexpr size_t WS_CVH = WS_Y + (size_t)MTOK * DG * 2;
constexpr size_t WS_CAT = WS_CVH + (size_t)MTOK * DG * 2;
constexpr size_t WS_KV = WS_CAT + (size_t)MTOK * DM * 2;
constexpr size_t WS_BAR = WS_KV + (size_t)2 * NB * 8 * 32 * 4096 * 4;
constexpr size_t WS_END = WS_BAR + 4096;

struct Params {
    const float* x; const float* c; const float* norm_g; const float* w_ada; const float* b_ada; const float* w_in; const float* w_fft; const float* na_bias;
    const float* rl_f; const float* rl_b; const float* conv_w; const float* conv_b; const float* ln_g; const float* ln_b; const float* w_pw; const float* w_out; const float* final_g;
    float* out; unsigned char* ws; int ph_lo, ph_hi;
};

__device__ __forceinline__ unsigned f2bf(float f) { unsigned u = __float_as_uint(f); return (u + 0x7fffu + ((u >> 16) & 1u)) >> 16; }
__device__ __forceinline__ unsigned pk2(float lo, float hi) { return f2bf(lo) | (f2bf(hi) << 16); }
__device__ __forceinline__ float bf2f(bf16 b) { return __uint_as_float((unsigned)b << 16); }
__device__ __forceinline__ float bflo(unsigned u) { return __uint_as_float(u << 16); }
__device__ __forceinline__ float bfhi(unsigned u) { return __uint_as_float(u & 0xffff0000u); }
__device__ __forceinline__ float silu_f(float v) { return v / (1.f + __expf(-v)); }
__device__ __forceinline__ float wave_sum(float v) {
#pragma unroll
    for (int o = 1; o < 64; o <<= 1) v += __shfl_xor(v, o);
    return v;
}
__device__ __forceinline__ float wave_max(float v) {
#pragma unroll
    for (int o = 1; o < 64; o <<= 1) v = fmaxf(v, __shfl_xor(v, o));
    return v;
}

struct SchedS {
    pg8::StaticOrder o; const char* A; const char* B; size_t ta, tb;
    __device__ __forceinline__ bool next(int i, pg8::Unit& u) const { if (!o.next(i, u)) return false; u.A = A + (size_t)u.pm * ta; u.B = B + (size_t)u.pn * tb; u.aux = 0; return true; }
};
__device__ __forceinline__ SchedS make_sched(const void* A, int lda, const void* B, int ldb, int M, int N) {
    SchedS s; s.o.init(M, N, (int)gridDim.x, (int)blockIdx.x); s.A = (const char*)A; s.B = (const char*)B; s.ta = (size_t)256 * lda * 2; s.tb = (size_t)256 * ldb * 2; return s;
}
struct SchedDFT {
    const char* A; const char* B; int G, c;
    __device__ __forceinline__ bool next(int i, pg8::Unit& u) const {
        const int L = __builtin_amdgcn_readfirstlane(i * G + c); if (L >= 256) return false;
        const int sub = L >> 5, t = L & 31; u.pm = t >> 1; u.pn = t & 1; u.aux = sub;
        u.A = A + (size_t)((u.pm << 22) + ((sub & 3) << 12)); u.B = B + (size_t)(((sub >> 2) << 23) + (u.pn << 22) + ((sub & 3) << 12)); return true;
    }
};

struct EpiZ {
    static constexpr bool PERM = true;
    bf16* O; int ldc;
    __device__ __forceinline__ void operator()(const pg8::f32x4 (&acc)[2][2][4][2], const pg8::Unit& u, int wr, int wc, int fr, int fq) const {
        const int row0 = u.pm * 256 + wr * 64 + fr, col0 = u.pn * 256 + wc * 32 + 8 * fq;
#pragma unroll
        for (int ai = 0; ai < 2; ++ai)
#pragma unroll
            for (int m = 0; m < 4; ++m) { bf16* rowp = O + (size_t)(row0 + ai * 128 + m * 16) * ldc + col0;
#pragma unroll
                for (int bj = 0; bj < 2; ++bj) { const pg8::f32x4 v0 = acc[ai][bj][m][0], v1 = acc[ai][bj][m][1]; u32x4 w;
                    w.x = pg8::cvt_pk_bf16(v0[0], v0[1]); w.y = pg8::cvt_pk_bf16(v0[2], v0[3]); w.z = pg8::cvt_pk_bf16(v1[0], v1[1]); w.w = pg8::cvt_pk_bf16(v1[2], v1[3]);
                    *(u32x4*)(rowp + bj * 128) = w; } }
    }
};
struct EpiGate {
    static constexpr bool PERM = true;
    bf16* O; const bf16* Z; int coff, goff;
    __device__ __forceinline__ void operator()(const pg8::f32x4 (&acc)[2][2][4][2], const pg8::Unit& u, int wr, int wc, int fr, int fq) const {
        const int row0 = u.pm * 256 + wr * 64 + fr, col0 = u.pn * 256 + wc * 32 + 8 * fq;
#pragma unroll
        for (int ai = 0; ai < 2; ++ai)
#pragma unroll
            for (int m = 0; m < 4; ++m) { const size_t row = (size_t)(row0 + ai * 128 + m * 16);
#pragma unroll
                for (int bj = 0; bj < 2; ++bj) { const pg8::f32x4 v0 = acc[ai][bj][m][0], v1 = acc[ai][bj][m][1];
                    const u32x4 gz = *(const u32x4*)(Z + row * DIN + goff + col0 + bj * 128); u32x4 w;
                    w.x = pg8::cvt_pk_bf16(v0[0] * silu_f(bflo(gz.x)), v0[1] * silu_f(bfhi(gz.x))); w.y = pg8::cvt_pk_bf16(v0[2] * silu_f(bflo(gz.y)), v0[3] * silu_f(bfhi(gz.y)));
                    w.z = pg8::cvt_pk_bf16(v1[0] * silu_f(bflo(gz.z)), v1[1] * silu_f(bfhi(gz.z))); w.w = pg8::cvt_pk_bf16(v1[2] * silu_f(bflo(gz.w)), v1[3] * silu_f(bfhi(gz.w)));
                    *(u32x4*)(O + row * DM + coff + col0 + bj * 128) = w; } }
    }
};
struct EpiPart {
    static constexpr bool PERM = false;
    float* P;
    __device__ __forceinline__ void operator()(const pg8::f32x4 (&acc)[2][2][4][2], const pg8::Unit& u, int wr, int wc, int fr, int fq) const {
        const int row0 = u.pm * 256 + wr * 64 + fr, col0 = u.pn * 256 + wc * 32 + 4 * fq;
        float* base = P + (size_t)u.aux * 4096 * 512;
#pragma unroll
        for (int ai = 0; ai < 2; ++ai)
#pragma unroll
            for (int m = 0; m < 4; ++m) { float* rowp = base + (size_t)(row0 + ai * 128 + m * 16) * 512 + col0;
#pragma unroll
                for (int bj = 0; bj < 2; ++bj)
#pragma unroll
                    for (int n = 0; n < 2; ++n) *(pg8::f32x4*)(rowp + bj * 128 + n * 16) = acc[ai][bj][m][n]; }
    }
};
struct EpiRes {
    static constexpr bool PERM = false;
    const float* xin; float* xout; const float* gate;
    __device__ __forceinline__ void operator()(const pg8::f32x4 (&acc)[2][2][4][2], const pg8::Unit& u, int wr, int wc, int fr, int fq) const {
        const int row0 = u.pm * 256 + wr * 64 + fr, col0 = u.pn * 256 + wc * 32 + 4 * fq;
        const float* gp = gate + (size_t)(u.pm >> 4) * 6144 + col0;
        pg8::f32x4 gv[2][2];
#pragma unroll
        for (int bj = 0; bj < 2; ++bj)
#pragma unroll
            for (int n = 0; n < 2; ++n) gv[bj][n] = *(const pg8::f32x4*)(gp + bj * 128 + n * 16);
#pragma unroll
        for (int ai = 0; ai < 2; ++ai)
#pragma unroll
            for (int m = 0; m < 4; ++m) { const size_t ro = (size_t)(row0 + ai * 128 + m * 16) * DM + col0;
#pragma unroll
                for (int bj = 0; bj < 2; ++bj)
#pragma unroll
                    for (int n = 0; n < 2; ++n) { const pg8::f32x4 xi = *(const pg8::f32x4*)(xin + ro + bj * 128 + n * 16);
                        *(pg8::f32x4*)(xout + ro + bj * 128 + n * 16) = xi + gv[bj][n] * acc[ai][bj][m][n]; } }
    }
};

__device__ __forceinline__ void transpose_tile(const float* W, int K, int N, bf16* WT, int item, float* scr) {
    const int tid = otid(), nb = N / 64, kb = item / nb, nbk = item % nb, k0 = kb * 64, n0 = nbk * 64;
#pragma unroll
    for (int i = 0; i < 2; ++i) { const int kk = (tid >> 4) + 32 * i, nn = (tid & 15) * 4;
        const f32x4 v = *(const f32x4*)(W + (size_t)(k0 + kk) * N + n0 + nn);
        scr[kk * 65 + nn] = v[0]; scr[kk * 65 + nn + 1] = v[1]; scr[kk * 65 + nn + 2] = v[2]; scr[kk * 65 + nn + 3] = v[3]; }
    __syncthreads();
    { const int n = tid >> 3, kc = (tid & 7) * 8; const float* s = scr + kc * 65 + n; u32x4 o;
      o.x = pk2(s[0], s[65]); o.y = pk2(s[2 * 65], s[3 * 65]); o.z = pk2(s[4 * 65], s[5 * 65]); o.w = pk2(s[6 * 65], s[7 * 65]);
      *(u32x4*)(WT + (size_t)(n0 + n) * K + k0 + kc) = o; }
    __syncthreads();
}

__device__ __forceinline__ void ph_prologue(const Params& p, unsigned char* lds) {
    const int tid = otid(), lane = tid & 63, wave = tid >> 6, G = gridDim.x, bid = blockIdx.x;
    float* scr = (float*)lds;
    bf16* Wt_in = (bf16*)(p.ws + WS_WIN); bf16* Wt_out = (bf16*)(p.ws + WS_WOUT); bf16* Wt_fft = (bf16*)(p.ws + WS_WFFT); bf16* Wt_pw = (bf16*)(p.ws + WS_WPW);
    constexpr int T_IN = 32 * 104, T_OUT = 32 * 32, T_S = 64, T_L = T_IN + T_OUT + 2 * T_S;
    for (int it = bid; it < NL * T_L; it += G) {
        const int l = it / T_L; int r = it % T_L;
        if (r < T_IN) { transpose_tile(p.w_in + (size_t)l * DM * DIN, DM, DIN, Wt_in + (size_t)l * DIN * DM, r, scr); continue; } r -= T_IN;
        if (r < T_OUT) { transpose_tile(p.w_out + (size_t)l * DM * DM, DM, DM, Wt_out + (size_t)l * DM * DM, r, scr); continue; } r -= T_OUT;
        if (r < T_S) { transpose_tile(p.w_fft + (size_t)l * DG * DG, DG, DG, Wt_fft + (size_t)l * DG * DG, r, scr); continue; } r -= T_S;
        transpose_tile(p.w_pw + (size_t)l * DG * DG, DG, DG, Wt_pw + (size_t)l * DG * DG, r, scr);
    }
    float* cosT = (float*)(lds + 32768); float* sinT = (float*)(lds + 49152); float* ca = (float*)(lds + 65536); float* red = (float*)(lds + 81920);
    for (int j = tid; j < 4096; j += NTHR) { cosT[j] = cospif((float)j * (1.f / 2048.f)); sinT[j] = sinpif((float)j * (1.f / 2048.f)); }
    for (int j = tid; j < 4096; j += NTHR) { const float cv = p.c[j]; ca[j] = cv / (1.f + expf(-cv)); }
    __syncthreads();
    bf16* DFT = (bf16*)(p.ws + WS_DFT);
    for (int k = bid; k < 4096; k += G) {
#pragma unroll
        for (int cc = 0; cc < 2; ++cc) { const int kk0 = (tid + cc * NTHR) * 8; float v[8];
#pragma unroll
            for (int j = 0; j < 8; ++j) { const int kk = kk0 + j, idx = (k * (kk & 4095)) & 4095; v[j] = (kk < 4096) ? cosT[idx] : -sinT[idx]; }
            u32x4 o; o.x = pk2(v[0], v[1]); o.y = pk2(v[2], v[3]); o.z = pk2(v[4], v[5]); o.w = pk2(v[6], v[7]);
            *(u32x4*)(DFT + (size_t)k * 8192 + kk0) = o; }
    }
    { float2* rope = (float2*)(p.ws + WS_ROPE);
      for (int e = bid * NTHR + tid; e < 4096 * 32; e += G * NTHR) { const int s = e >> 5, i = e & 31;
          const float inv = (float)pow(10000.0, -(double)i / 32.0); const float ang = (float)s * inv;
          double sn, cs; sincos((double)ang, &sn, &cs); rope[e] = make_float2((float)cs, (float)sn); } }
    float* mod = (float*)(p.ws + WS_MOD);
    for (int t = bid; t < 192; t += G) {
        const int l = t / 96, col = (t % 96) * 64 + lane; const float* W = p.w_ada + (size_t)l * DM * 6144 + col;
        float a0 = 0.f, a1 = 0.f;
#pragma unroll 8
        for (int k = wave * 256; k < wave * 256 + 256; ++k) { const float w = W[(size_t)k * 6144]; a0 += ca[k] * w; a1 += ca[2048 + k] * w; }
        red[(wave * 2 + 0) * 64 + lane] = a0; red[(wave * 2 + 1) * 64 + lane] = a1;
        __syncthreads();
        if (wave < 2) { float s = 0.f;
#pragma unroll
            for (int w = 0; w < 8; ++w) s += red[(w * 2 + wave) * 64 + lane];
            mod[(size_t)(l * 2 + wave) * 6144 + col] = s + p.b_ada[l * 6144 + col]; }
        __syncthreads();
    }
}

__device__ __forceinline__ void ph_norm(const Params& p, int l) {
    const int tid = otid(), lane = tid & 63, wave = tid >> 6;
    const float* xin = (l == 0) ? p.x : p.out; bf16* h = (bf16*)(p.ws + WS_U); const float* mod = (const float*)(p.ws + WS_MOD);
    for (int row = blockIdx.x * 8 + wave; row < MTOK; row += gridDim.x * 8) {
        const f32x4* xr = (const f32x4*)(xin + (size_t)row * DM) + lane; f32x4 v[8]; float ss = 0.f;
#pragma unroll
        for (int j = 0; j < 8; ++j) { v[j] = xr[64 * j]; ss += (v[j][0] * v[j][0] + v[j][1] * v[j][1]) + (v[j][2] * v[j][2] + v[j][3] * v[j][3]); }
        ss = wave_sum(ss); const float rstd = rsqrtf(ss * (1.f / DM) + 1e-6f);
        const float* md = mod + (size_t)(l * 2 + (row >> 12)) * 6144; const float* g = p.norm_g + l * DM;
#pragma unroll
        for (int j = 0; j < 8; ++j) { const int col = (64 * j + lane) * 4;
            const f32x4 g4 = *(const f32x4*)(g + col), sh = *(const f32x4*)(md + col), sc = *(const f32x4*)(md + 2048 + col);
            const f32x4 o = (v[j] * rstd * g4) * (sc + 1.f) + sh; u32x2 w; w.x = pk2(o[0], o[1]); w.y = pk2(o[2], o[3]);
            *(u32x2*)(h + (size_t)row * DM + col) = w; }
    }
}
__device__ __forceinline__ void ph_final(const Params& p) {
    const int tid = otid(), lane = tid & 63, wave = tid >> 6;
    for (int row = blockIdx.x * 8 + wave; row < MTOK; row += gridDim.x * 8) {
        f32x4* xr = (f32x4*)(p.out + (size_t)row * DM) + lane; f32x4 v[8]; float ss = 0.f;
#pragma unroll
        for (int j = 0; j < 8; ++j) { v[j] = xr[64 * j]; ss += (v[j][0] * v[j][0] + v[j][1] * v[j][1]) + (v[j][2] * v[j][2] + v[j][3] * v[j][3]); }
        ss = wave_sum(ss); const float rstd = rsqrtf(ss * (1.f / DM) + 1e-6f);
#pragma unroll
        for (int j = 0; j < 8; ++j) { const int col = (64 * j + lane) * 4; const f32x4 g4 = *(const f32x4*)(p.final_g + col); xr[64 * j] = v[j] * rstd * g4; }
    }
}

typedef short bf16x8v __attribute__((ext_vector_type(8)));
__device__ __forceinline__ bf16x8v mk8(unsigned a, unsigned b, unsigned c, unsigned d) { u32x4 v = {a, b, c, d}; return __builtin_bit_cast(bf16x8v, v); }
#define MFMA16(a, b, c) __builtin_amdgcn_mfma_f32_16x16x32_bf16(a, b, c, 0, 0, 0)
constexpr int R_QS = 0, R_KS = 18432, R_VT = 36864, R_KTF = 54272, R_KTB = 71680, R_STF = 89088, R_STB = 98304;

template <bool R2>
__device__ __forceinline__ void ret_stage(const Params& p, int b, int h, int n, unsigned char* lds, float l2f, float l2b) {
    const int tid = otid(), j = tid >> 2, c4 = tid & 3, s = n * 128 + j;
    const bf16* Z = (const bf16*)(p.ws + WS_Z); const bf16* zr = Z + (size_t)(b * SEQ + s) * DIN;
    const f32x4* rp = (const f32x4*)((const float2*)(p.ws + WS_ROPE) + s * 32 + c4 * 8);
    float cs[8], sn[8];
#pragma unroll
    for (int i = 0; i < 4; ++i) { const f32x4 r = rp[i]; cs[2 * i] = r[0]; sn[2 * i] = r[1]; cs[2 * i + 1] = r[2]; sn[2 * i + 1] = r[3]; }
    bf16* KS = (bf16*)(lds + R_KS); bf16* VT = (bf16*)(lds + R_VT);
    { const u32x4 ka = *(const u32x4*)(zr + 7 * DG + h * 64 + c4 * 8), kb = *(const u32x4*)(zr + 7 * DG + h * 64 + 32 + c4 * 8);
      const unsigned kau[4] = {ka.x, ka.y, ka.z, ka.w}, kbu[4] = {kb.x, kb.y, kb.z, kb.w};
      float k1[8], k2[8];
#pragma unroll
      for (int i = 0; i < 4; ++i) { const float a0 = bflo(kau[i]), a1 = bfhi(kau[i]), b0 = bflo(kbu[i]), b1 = bfhi(kbu[i]);
          k1[2 * i] = a0 * cs[2 * i] - b0 * sn[2 * i]; k2[2 * i] = a0 * sn[2 * i] + b0 * cs[2 * i];
          k1[2 * i + 1] = a1 * cs[2 * i + 1] - b1 * sn[2 * i + 1]; k2[2 * i + 1] = a1 * sn[2 * i + 1] + b1 * cs[2 * i + 1]; }
      u32x4 o1, o2; o1.x = pk2(k1[0], k1[1]); o1.y = pk2(k1[2], k1[3]); o1.z = pk2(k1[4], k1[5]); o1.w = pk2(k1[6], k1[7]);
      o2.x = pk2(k2[0], k2[1]); o2.y = pk2(k2[2], k2[3]); o2.z = pk2(k2[4], k2[5]); o2.w = pk2(k2[6], k2[7]);
      *(u32x4*)(KS + j * 72 + c4 * 8) = o1; *(u32x4*)(KS + j * 72 + 32 + c4 * 8) = o2;
      if (!R2) { bf16* KTF = (bf16*)(lds + R_KTF); bf16* KTB = (bf16*)(lds + R_KTB);
          const float df = exp2f(l2f * (float)(127 - j)), db = exp2f(l2b * (float)j);
#pragma unroll
          for (int i = 0; i < 8; ++i) { KTF[(c4 * 8 + i) * 136 + j] = (bf16)f2bf(k1[i] * df); KTF[(32 + c4 * 8 + i) * 136 + j] = (bf16)f2bf(k2[i] * df);
              KTB[(c4 * 8 + i) * 136 + j] = (bf16)f2bf(k1[i] * db); KTB[(32 + c4 * 8 + i) * 136 + j] = (bf16)f2bf(k2[i] * db); } } }
    { const u32x4 va = *(const u32x4*)(zr + 8 * DG + h * 64 + c4 * 16), vb = *(const u32x4*)(zr + 8 * DG + h * 64 + c4 * 16 + 8);
      const unsigned vu[8] = {va.x, va.y, va.z, va.w, vb.x, vb.y, vb.z, vb.w};
#pragma unroll
      for (int i = 0; i < 8; ++i) { VT[(c4 * 16 + 2 * i) * 136 + j] = (bf16)(vu[i] & 0xffffu); VT[(c4 * 16 + 2 * i + 1) * 136 + j] = (bf16)(vu[i] >> 16); } }
    if (R2) { bf16* QS = (bf16*)(lds + R_QS);
      const u32x4 qa = *(const u32x4*)(zr + 6 * DG + h * 64 + c4 * 8), qb = *(const u32x4*)(zr + 6 * DG + h * 64 + 32 + c4 * 8);
      const unsigned qau[4] = {qa.x, qa.y, qa.z, qa.w}, qbu[4] = {qb.x, qb.y, qb.z, qb.w};
      float q1[8], q2[8];
#pragma unroll
      for (int i = 0; i < 4; ++i) { const float a0 = bflo(qau[i]), a1 = bfhi(qau[i]), b0 = bflo(qbu[i]), b1 = bfhi(qbu[i]);
          q1[2 * i] = (a0 * cs[2 * i] - b0 * sn[2 * i]) * 0.125f; q2[2 * i] = (a0 * sn[2 * i] + b0 * cs[2 * i]) * 0.125f;
          q1[2 * i + 1] = (a1 * cs[2 * i + 1] - b1 * sn[2 * i + 1]) * 0.125f; q2[2 * i + 1] = (a1 * sn[2 * i + 1] + b1 * cs[2 * i + 1]) * 0.125f; }
      u32x4 o1, o2; o1.x = pk2(q1[0], q1[1]); o1.y = pk2(q1[2], q1[3]); o1.z = pk2(q1[4], q1[5]); o1.w = pk2(q1[6], q1[7]);
      o2.x = pk2(q2[0], q2[1]); o2.y = pk2(q2[2], q2[3]); o2.z = pk2(q2[4], q2[5]); o2.w = pk2(q2[6], q2[7]);
      *(u32x4*)(QS + j * 72 + c4 * 8) = o1; *(u32x4*)(QS + j * 72 + 32 + c4 * 8) = o2; }
}

__device__ __forceinline__ void ret1_task(const Params& p, int l, int task, unsigned char* lds) {
    const int n = task & 31, h = (task >> 5) & 7, b = task >> 8;
    const float xf = p.rl_f[l * 8 + h], xb = p.rl_b[l * 8 + h];
    const float l2f = -log1pf(expf(-xf)) * 1.4426950408889634f, l2b = -log1pf(expf(-xb)) * 1.4426950408889634f;
    ret_stage<false>(p, b, h, n, lds, l2f, l2b);
    __syncthreads();
    const int tid = otid(), lane = tid & 63, w = tid >> 6, fr = lane & 15, fq = lane >> 4, dir = w >> 2, et = w & 3;
    const bf16* VT = (const bf16*)(lds + R_VT); const bf16* KT = (const bf16*)(lds + (dir ? R_KTB : R_KTF));
    bf16x8v a[4];
#pragma unroll
    for (int ks = 0; ks < 4; ++ks) a[ks] = *(const bf16x8v*)(VT + (16 * et + fr) * 136 + 32 * ks + 8 * fq);
    float* dst = (float*)(p.ws + WS_KV) + ((size_t)((dir * 2 + b) * 8 + h) * 32 + n) * 4096;
#pragma unroll
    for (int dt = 0; dt < 4; ++dt) { f32x4 acc = {0.f, 0.f, 0.f, 0.f};
#pragma unroll
        for (int ks = 0; ks < 4; ++ks) { const bf16x8v bfr = *(const bf16x8v*)(KT + (16 * dt + fr) * 136 + 32 * ks + 8 * fq); acc = MFMA16(a[ks], bfr, acc); }
#pragma unroll
        for (int r = 0; r < 4; ++r) dst[(16 * et + 4 * fq + r) * 64 + 16 * dt + fr] = acc[r]; }
    __syncthreads();
}

__device__ __forceinline__ void ret2_task(const Params& p, int l, int task, unsigned char* lds) {
    const int n = task & 31, h = (task >> 5) & 7, b = task >> 8;
    const float xf = p.rl_f[l * 8 + h], xb = p.rl_b[l * 8 + h];
    const float l2f = -log1pf(expf(-xf)) * 1.4426950408889634f, l2b = -log1pf(expf(-xb)) * 1.4426950408889634f;
    ret_stage<true>(p, b, h, n, lds, l2f, l2b);
    const int tid = otid(), lane = tid & 63, w = tid >> 6, fr = lane & 15, fq = lane >> 4;
    {
      const float gfC = exp2f(l2f * 128.f), gbC = exp2f(l2b * 128.f);
      const float* KVf = (const float*)(p.ws + WS_KV) + ((size_t)((0 * 2 + b) * 8 + h) * 32) * 4096 + tid * 8;
      const float* KVb = (const float*)(p.ws + WS_KV) + ((size_t)((1 * 2 + b) * 8 + h) * 32) * 4096 + tid * 8;
      f32x4 f0 = {0.f, 0.f, 0.f, 0.f}, f1 = f0, g0 = f0, g1 = f0; float cf = 1.f;
      for (int m = n - 1; m >= 0; --m) { const f32x4 x0 = *(const f32x4*)(KVf + (size_t)m * 4096), x1 = *(const f32x4*)(KVf + (size_t)m * 4096 + 4); f0 += x0 * cf; f1 += x1 * cf; cf *= gfC; }
      cf = 1.f;
      for (int m = n + 1; m < 32; ++m) { const f32x4 x0 = *(const f32x4*)(KVb + (size_t)m * 4096), x1 = *(const f32x4*)(KVb + (size_t)m * 4096 + 4); g0 += x0 * cf; g1 += x1 * cf; cf *= gbC; }
      const int e = tid >> 3, d0 = (tid & 7) * 8; u32x4 o;
      o.x = pk2(f0[0], f0[1]); o.y = pk2(f0[2], f0[3]); o.z = pk2(f1[0], f1[1]); o.w = pk2(f1[2], f1[3]); *(u32x4*)((bf16*)(lds + R_STF) + e * 72 + d0) = o;
      o.x = pk2(g0[0], g0[1]); o.y = pk2(g0[2], g0[3]); o.z = pk2(g1[0], g1[1]); o.w = pk2(g1[2], g1[3]); *(u32x4*)((bf16*)(lds + R_STB) + e * 72 + d0) = o; }
    __syncthreads();
    const bf16* QS = (const bf16*)(lds + R_QS); const bf16* KS = (const bf16*)(lds + R_KS); const bf16* VT = (const bf16*)(lds + R_VT);
    const bf16* STF = (const bf16*)(lds + R_STF); const bf16* STB = (const bf16*)(lds + R_STB);
    bf16x8v qf[2];
#pragma unroll
    for (int ks = 0; ks < 2; ++ks) qf[ks] = *(const bf16x8v*)(QS + (16 * w + fr) * 72 + 32 * ks + 8 * fq);
    const int ai = 16 * w + fr;
    unsigned pp[8][2];
#pragma unroll
    for (int jt = 0; jt < 8; ++jt) { f32x4 acc = {0.f, 0.f, 0.f, 0.f};
#pragma unroll
        for (int ks = 0; ks < 2; ++ks) { const bf16x8v kf = *(const bf16x8v*)(KS + (16 * jt + fr) * 72 + 32 * ks + 8 * fq); acc = MFMA16(kf, qf[ks], acc); }
        float sc[4];
#pragma unroll
        for (int r = 0; r < 4; ++r) { const int aj = 16 * jt + 4 * fq + r; const float wg = (aj <= ai) ? exp2f(l2f * (float)(ai - aj)) : exp2f(l2b * (float)(aj - ai)); sc[r] = acc[r] * wg; }
        pp[jt][0] = pk2(sc[0], sc[1]); pp[jt][1] = pk2(sc[2], sc[3]); }
    const float qdf = exp2f(l2f * (float)(ai + 1)), qdb = exp2f(l2b * (float)(128 - ai));
    f32x4 tot[4]; float ss = 0.f;
#pragma unroll
    for (int et = 0; et < 4; ++et) { f32x4 o = {0.f, 0.f, 0.f, 0.f}, cfa = o, cba = o;
#pragma unroll
        for (int t = 0; t < 4; ++t) { const u32x2 vlo = *(const u32x2*)(VT + (16 * et + fr) * 136 + 32 * t + 4 * fq), vhi = *(const u32x2*)(VT + (16 * et + fr) * 136 + 32 * t + 16 + 4 * fq);
            o = MFMA16(mk8(vlo.x, vlo.y, vhi.x, vhi.y), mk8(pp[2 * t][0], pp[2 * t][1], pp[2 * t + 1][0], pp[2 * t + 1][1]), o); }
#pragma unroll
        for (int ks = 0; ks < 2; ++ks) { const bf16x8v sf = *(const bf16x8v*)(STF + (16 * et + fr) * 72 + 32 * ks + 8 * fq), sb = *(const bf16x8v*)(STB + (16 * et + fr) * 72 + 32 * ks + 8 * fq);
            cfa = MFMA16(sf, qf[ks], cfa); cba = MFMA16(sb, qf[ks], cba); }
        tot[et] = o + cfa * qdf + cba * qdb;
        ss += (tot[et][0] * tot[et][0] + tot[et][1] * tot[et][1]) + (tot[et][2] * tot[et][2] + tot[et][3] * tot[et][3]); }
    ss += __shfl_xor(ss, 16); ss += __shfl_xor(ss, 32);
    const float rs = rsqrtf(ss * (1.f / 64.f) + 1e-6f);
    const size_t tok = (size_t)b * SEQ + n * 128 + ai;
    const bf16* Z = (const bf16*)(p.ws + WS_Z); bf16* CAT = (bf16*)(p.ws + WS_CAT);
#pragma unroll
    for (int et = 0; et < 4; ++et) { const u32x2 gz = *(const u32x2*)(Z + tok * DIN + 9 * DG + h * 64 + 16 * et + 4 * fq); u32x2 o;
        o.x = pk2(tot[et][0] * rs * silu_f(bflo(gz.x)), tot[et][1] * rs * silu_f(bfhi(gz.x))); o.y = pk2(tot[et][2] * rs * silu_f(bflo(gz.y)), tot[et][3] * rs * silu_f(bfhi(gz.y)));
        *(u32x2*)(CAT + tok * DM + 1024 + h * 64 + 16 * et + 4 * fq) = o; }
    __syncthreads();
}

__device__ __forceinline__ void na2_task(const Params& p, int l, int task, unsigned char* lds) {
    const int tid = otid(), lane = tid & 63, w = tid >> 6, fr = lane & 15, fq = lane >> 4;
    const int hp = task & 3, rq = (task >> 2) & 63, b = task >> 8;
    const int row_start = min(max(rq - 4, 0), 56);
    const bf16* Z = (const bf16*)(p.ws + WS_Z); bf16* CAT = (bf16*)(p.ws + WS_CAT);
    bf16* VT = (bf16*)lds; float* BI = (float*)(lds + 133120);
    for (int i = tid; i < 930; i += NTHR) BI[i] = p.na_bias[(size_t)(l * 8 + hp * 2) * 465 + i];
    { const int pair = lane & 31, chunk = (lane >> 5) + 2 * (w & 3), hh = w >> 2, h = hp * 2 + hh;
      unsigned* VTd = (unsigned*)(VT + (size_t)hh * 64 * 520);
#pragma unroll 2
      for (int a = 0; a < 8; ++a) {
          const size_t tok = (size_t)b * SEQ + (row_start + a) * 64 + 2 * pair;
          const bf16* src = Z + tok * DIN + 4 * DG + h * 64 + chunk * 8;
          const u32x4 x = *(const u32x4*)src, y = *(const u32x4*)(src + DIN);
          const unsigned xu[4] = {x.x, x.y, x.z, x.w}, yu[4] = {y.x, y.y, y.z, y.w};
#pragma unroll
          for (int i = 0; i < 4; ++i) { VTd[(chunk * 8 + 2 * i) * 260 + a * 32 + pair] = (xu[i] & 0xffffu) | (yu[i] << 16);
              VTd[(chunk * 8 + 2 * i + 1) * 260 + a * 32 + pair] = (xu[i] >> 16) | (yu[i] & 0xffff0000u); } } }
    __syncthreads();
    const int hh = w >> 2, h = hp * 2 + hh, qb = w & 3, ct0 = (qb >= 2) ? 1 : 0;
    const int c = 16 * qb + fr; const size_t qtok = (size_t)b * SEQ + rq * 64 + c;
    bf16x8v qf[2];
#pragma unroll
    for (int ks = 0; ks < 2; ++ks) qf[ks] = *(const bf16x8v*)(Z + qtok * DIN + 2 * DG + h * 64 + 32 * ks + 8 * fq);
    const int col_start = min(max(c - 8, 0), 48);
    const float* bi = BI + hh * 465;
    float sc[24][4]; float mx = -1e30f;
#pragma unroll
    for (int a = 0; a < 8; ++a)
#pragma unroll
        for (int ci = 0; ci < 3; ++ci) { const int kt = a * 3 + ci;
            const size_t ktok = (size_t)b * SEQ + (row_start + a) * 64 + 16 * (ct0 + ci) + fr;
            f32x4 acc = {0.f, 0.f, 0.f, 0.f};
#pragma unroll
            for (int ks = 0; ks < 2; ++ks) { const bf16x8v kf = *(const bf16x8v*)(Z + ktok * DIN + 3 * DG + h * 64 + 32 * ks + 8 * fq); acc = MFMA16(kf, qf[ks], acc); }
            const int dr = row_start + a - rq;
#pragma unroll
            for (int r = 0; r < 4; ++r) { const int kc = 16 * (ct0 + ci) + 4 * fq + r, rel = kc - col_start, dc = kc - c;
                float v = acc[r] * 0.125f + bi[(dr + 7) * 31 + min(max(dc + 15, 0), 30)];
                v = (rel >= 0 && rel < 16) ? v : -1e30f; sc[kt][r] = v; mx = fmaxf(mx, v); } }
    mx = fmaxf(mx, __shfl_xor(mx, 16)); mx = fmaxf(mx, __shfl_xor(mx, 32));
    float sum = 0.f; unsigned pp[24][2];
#pragma unroll
    for (int kt = 0; kt < 24; ++kt) { const float e0 = __expf(sc[kt][0] - mx), e1 = __expf(sc[kt][1] - mx), e2 = __expf(sc[kt][2] - mx), e3 = __expf(sc[kt][3] - mx);
        sum += (e0 + e1) + (e2 + e3); pp[kt][0] = pk2(e0, e1); pp[kt][1] = pk2(e2, e3); }
    sum += __shfl_xor(sum, 16); sum += __shfl_xor(sum, 32);
    const float inv = 1.f / sum;
    const bf16* VTh = VT + (size_t)hh * 64 * 520;
#pragma unroll
    for (int dt = 0; dt < 4; ++dt) { f32x4 o = {0.f, 0.f, 0.f, 0.f};
#pragma unroll
        for (int t = 0; t < 12; ++t) { const int k0 = 2 * t, k1 = 2 * t + 1, a0 = k0 / 3, c0 = k0 % 3, a1 = k1 / 3, c1 = k1 % 3;
            const u32x2 vlo = *(const u32x2*)(VTh + (16 * dt + fr) * 520 + a0 * 64 + 16 * (ct0 + c0) + 4 * fq), vhi = *(const u32x2*)(VTh + (16 * dt + fr) * 520 + a1 * 64 + 16 * (ct0 + c1) + 4 * fq);
            o = MFMA16(mk8(vlo.x, vlo.y, vhi.x, vhi.y), mk8(pp[k0][0], pp[k0][1], pp[k1][0], pp[k1][1]), o); }
        const u32x2 gz = *(const u32x2*)(Z + qtok * DIN + 5 * DG + h * 64 + 16 * dt + 4 * fq); u32x2 ov;
        ov.x = pk2(o[0] * inv * silu_f(bflo(gz.x)), o[1] * inv * silu_f(bfhi(gz.x))); ov.y = pk2(o[2] * inv * silu_f(bflo(gz.y)), o[3] * inv * silu_f(bfhi(gz.y)));
        *(u32x2*)(CAT + qtok * DM + 512 + h * 64 + 16 * dt + 4 * fq) = ov; }
    __syncthreads();
}

__device__ __forceinline__ void conv_task(const Params& p, int l, int task, unsigned char* lds) {
    const int tid = otid(), lane = tid & 63, wave = tid >> 6;
    float* us = (float*)lds; float* ys = us + 46 * 512;
    const bf16* Z = (const bf16*)(p.ws + WS_Z);
    const int b = task >> 8, t0 = (task & 255) * 16;
    for (int tt = 0; tt < 46; ++tt) { const int tok = t0 - 15 + tt; float u = 0.f;
        if (tok >= 0 && tok < SEQ) { const bf16* zr = Z + (size_t)(b * SEQ + tok) * DIN; const float a = bf2f(zr[10 * DG + tid]), g = bf2f(zr[11 * DG + tid]); u = a / (1.f + __expf(-g)); }
        us[tt * 512 + tid] = u; }
    float w[31];
#pragma unroll
    for (int k = 0; k < 31; ++k) w[k] = p.conv_w[(size_t)(l * 31 + k) * DG + tid];
    const float cb = p.conv_b[l * DG + tid];
    __syncthreads();
    for (int t = 0; t < 16; ++t) { float acc = cb;
#pragma unroll
        for (int k = 0; k < 31; ++k) acc += w[k] * us[(t + k) * 512 + tid];
        ys[t * 512 + tid] = acc; }
    __syncthreads();
#pragma unroll
    for (int tw = 0; tw < 2; ++tw) { const int t = wave + 8 * tw; float v[8]; float s = 0.f;
#pragma unroll
        for (int j = 0; j < 8; ++j) { v[j] = ys[t * 512 + lane + 64 * j]; s += v[j]; }
        const float mu = wave_sum(s) * (1.f / 512.f); float q = 0.f;
#pragma unroll
        for (int j = 0; j < 8; ++j) { v[j] -= mu; q += v[j] * v[j]; }
        const float rstd = rsqrtf(wave_sum(q) * (1.f / 512.f) + 1e-6f);
        bf16* orow = (bf16*)(p.ws + WS_CVH) + (size_t)(b * SEQ + t0 + t) * DG;
#pragma unroll
        for (int j = 0; j < 8; ++j) { const int ch = lane + 64 * j; const float y = v[j] * rstd * p.ln_g[l * DG + ch] + p.ln_b[l * DG + ch]; orow[ch] = (bf16)f2bf(silu_f(y)); } }
    __syncthreads();
}

__device__ __forceinline__ void f1_task(const Params& p, int task, unsigned char* lds) {
    const int tid = otid();
    float* us = (float*)lds; float* cs = us + 8 * 512; float* sn = cs + 128;
    const bf16* Z = (const bf16*)(p.ws + WS_Z);
    const int tok0 = task * 8, b = tok0 >> 12, s0 = tok0 & 4095;
    if (tid < 128) { cs[tid] = cospif((float)tid * (1.f / 64.f)); sn[tid] = sinpif((float)tid * (1.f / 64.f)); }
#pragma unroll
    for (int tk = 0; tk < 8; ++tk) us[tk * 512 + tid] = bf2f(Z[(size_t)(tok0 + tk) * DIN + tid]);
    __syncthreads();
    const int g = tid >> 7, m = tid & 127;
    float P[8], Q[8];
#pragma unroll
    for (int tk = 0; tk < 8; ++tk) { P[tk] = 0.f; Q[tk] = 0.f; }
    for (int c = 0; c < 128; ++c) { const int idx = (m * c) & 127; const float cv = cs[idx], sv = sn[idx];
#pragma unroll
        for (int tk = 0; tk < 8; ++tk) { const float u = us[tk * 512 + g * 128 + c]; P[tk] += u * cv; Q[tk] += u * sv; } }
    const float nrm = 0.0013810679320049757f;
    bf16* PQ = (bf16*)(p.ws + WS_PQT) + ((size_t)(b * 512 + tid) * 2) * 4096 + s0;
    u32x4 o; o.x = pk2(P[0] * nrm, P[1] * nrm); o.y = pk2(P[2] * nrm, P[3] * nrm); o.z = pk2(P[4] * nrm, P[5] * nrm); o.w = pk2(P[6] * nrm, P[7] * nrm);
    *(u32x4*)PQ = o;
    o.x = pk2(Q[0] * nrm, Q[1] * nrm); o.y = pk2(Q[2] * nrm, Q[3] * nrm); o.z = pk2(Q[4] * nrm, Q[5] * nrm); o.w = pk2(Q[6] * nrm, Q[7] * nrm);
    *(u32x4*)(PQ + 4096) = o;
    __syncthreads();
}

__device__ __forceinline__ void ph_mixA(const Params& p, int l, unsigned char* lds) {
    const int G = gridDim.x, bid = blockIdx.x;
    for (int t = bid; t < 512; t += G) ret1_task(p, l, t, lds);
    for (int t = bid; t < 512; t += G) na2_task(p, l, t, lds);
    for (int t = bid; t < 512; t += G) conv_task(p, l, t, lds);
    for (int t = bid; t < 1024; t += G) f1_task(p, t, lds);
}

__device__ __forceinline__ void ph_combine(const Params& p) {
    const float* part = (const float*)(p.ws + WS_U); bf16* Y = (bf16*)(p.ws + WS_Y);
    for (int e = blockIdx.x * NTHR + threadIdx.x; e < MTOK * DG / 4; e += gridDim.x * NTHR) {
        const int row = e >> 7, c4 = (e & 127) * 4, b = row >> 12, k = row & 4095;
        f32x4 s = {0.f, 0.f, 0.f, 0.f};
#pragma unroll
        for (int ks = 0; ks < 4; ++ks) s += *(const f32x4*)(part + ((size_t)((b * 4 + ks) * 4096 + k)) * 512 + c4);
        u32x2 w; w.x = pk2(s[0], s[1]); w.y = pk2(s[2], s[3]);
        *(u32x2*)(Y + (size_t)row * DG + c4) = w;
    }
}

#ifndef REP_PRO
#define REP_PRO 1
#endif
#ifndef REP_NORM
#define REP_NORM 1
#endif
#ifndef REP_Z
#define REP_Z 1
#endif
#ifndef REP_MIX
#define REP_MIX 1
#endif
#ifndef REP_P3
#define REP_P3 1
#endif
#ifndef REP_R2
#define REP_R2 1
#endif
#ifndef REP_CMB
#define REP_CMB 1
#endif
#ifndef REP_FFT
#define REP_FFT 1
#endif
#ifndef REP_OUT
#define REP_OUT 1
#endif
#ifndef REP_SUB
#define REP_SUB 1
#endif

__device__ __forceinline__ void grid_bar(unsigned* bar, unsigned& epoch) {
    asm volatile("s_waitcnt vmcnt(0) lgkmcnt(0)" ::: "memory");
    __syncthreads();
    epoch += 1;
    if (threadIdx.x == 0) {
        __builtin_amdgcn_fence(__ATOMIC_RELEASE, "agent");
        __hip_atomic_fetch_add(bar, 1u, __ATOMIC_RELAXED, __HIP_MEMORY_SCOPE_AGENT);
        const unsigned target = epoch * gridDim.x;
        while (__hip_atomic_load(bar, __ATOMIC_RELAXED, __HIP_MEMORY_SCOPE_AGENT) < target) __builtin_amdgcn_s_sleep(2);
        __builtin_amdgcn_fence(__ATOMIC_ACQUIRE, "agent");
    }
    __syncthreads();
    __builtin_amdgcn_fence(__ATOMIC_ACQUIRE, "agent");
}
constexpr int NPH = 16;
__global__ void __launch_bounds__(NTHR) mega(Params p) {
    extern __shared__ __attribute__((aligned(16))) unsigned char lds[];
    cg::grid_group grid = cg::this_grid();
    PG8_LAS unsigned char* ldsl = (PG8_LAS unsigned char*)lds;
    const int lo = p.ph_lo, hi = p.ph_hi;
#define IN(k) (lo <= (k) && (k) < hi)
#define SEAM(k) do { if (IN(k) && IN((k) + 1)) { if ((k) == 0) { __threadfence(); grid.sync(); } else grid_bar(gbar, epoch); } } while (0)
#define REPEAT(n) for (int rep_ = 0; rep_ < (n); ++rep_)
    bf16* Zb = (bf16*)(p.ws + WS_Z); bf16* CAT = (bf16*)(p.ws + WS_CAT);
    unsigned* gbar = (unsigned*)(p.ws + WS_BAR); unsigned epoch = 0;
    if (IN(0)) REPEAT(REP_PRO) { ph_prologue(p, lds); __syncthreads(); }
    SEAM(0);
    if (IN(0) && IN(1)) for (int r_ = 1; r_ < REP_SUB; ++r_) grid_bar(gbar, epoch);
#pragma unroll
    for (int l = 0; l < NL; ++l) {
        const int pb = 1 + 7 * l;
        if (IN(pb)) REPEAT(REP_NORM) ph_norm(p, l);
        SEAM(pb);
        if (IN(pb + 1)) REPEAT(REP_Z) {
            SchedS S = make_sched(p.ws + WS_U, DM, p.ws + WS_WIN + (size_t)l * DIN * DM * 2, DM, MTOK, DIN);
            EpiZ E{Zb, DIN};
            pg8::gemm_phase<EpiZ, SchedS, true>(ldsl, pg8::Gemm{DM, DM, DM}, S, E);
        }
        SEAM(pb + 1);
        if (IN(pb + 2)) REPEAT(REP_MIX) ph_mixA(p, l, lds);
        SEAM(pb + 2);
        if (IN(pb + 3)) REPEAT(REP_P3) {
            { SchedDFT S{(const char*)(p.ws + WS_DFT), (const char*)(p.ws + WS_PQT), (int)gridDim.x, (int)blockIdx.x};
              EpiPart E{(float*)(p.ws + WS_U)};
              pg8::gemm_phase<EpiPart, SchedDFT, true>(ldsl, pg8::Gemm{8192, 8192, 2048}, S, E); }
            { SchedS S = make_sched(p.ws + WS_CVH, DG, p.ws + WS_WPW + (size_t)l * DG * DG * 2, DG, MTOK, DG);
              EpiGate E{CAT, Zb, 1536, 12 * DG};
              pg8::gemm_phase<EpiGate, SchedS, true>(ldsl, pg8::Gemm{DG, DG, DG}, S, E); }
            REPEAT(REP_R2) for (int t = blockIdx.x; t < 512; t += gridDim.x) ret2_task(p, l, t, lds);
        }
        SEAM(pb + 3);
        if (IN(pb + 4)) REPEAT(REP_CMB) ph_combine(p);
        SEAM(pb + 4);
        if (IN(pb + 5)) REPEAT(REP_FFT) {
            SchedS S = make_sched(p.ws + WS_Y, DG, p.ws + WS_WFFT + (size_t)l * DG * DG * 2, DG, MTOK, DG);
            EpiGate E{CAT, Zb, 0, 1 * DG};
            pg8::gemm_phase<EpiGate, SchedS, true>(ldsl, pg8::Gemm{DG, DG, DG}, S, E);
        }
        SEAM(pb + 5);
        if (IN(pb + 6)) REPEAT(l == 0 ? REP_OUT : 1) {
            SchedS S = make_sched(CAT, DM, p.ws + WS_WOUT + (size_t)l * DM * DM * 2, DM, MTOK, DM);
            EpiRes E{(l == 0) ? p.x : p.out, p.out, (const float*)(p.ws + WS_MOD) + (size_t)l * 2 * 6144 + 4096};
            pg8::gemm_phase<EpiRes, SchedS, true>(ldsl, pg8::Gemm{DM, DM, DM}, S, E);
        }
        SEAM(pb + 6);
    }
    if (IN(NPH - 1)) ph_final(p);
#undef IN
#undef SEAM
}

extern "C" void kernel_launch(void* const* d_in, const int* in_sizes, int n_in, void* d_out, int out_size, void* d_ws, size_t ws_size, hipStream_t stream) {
    static int grid_blocks = 0;
    if (grid_blocks == 0) {
        if (n_in != 17 || ws_size < WS_END) { fprintf(stderr, "kernel_launch: n_in %d ws %zu (need %zu)\n", n_in, ws_size, (size_t)WS_END); grid_blocks = -1; return; }
        int dev = 0, cus = 0, per_cu = 0;
        hipGetDevice(&dev); hipDeviceGetAttribute(&cus, hipDeviceAttributeMultiprocessorCount, dev);
        if (hipFuncSetAttribute((const void*)mega, hipFuncAttributeMaxDynamicSharedMemorySize, LDS_BYTES) != hipSuccess) { fprintf(stderr, "hipFuncSetAttribute failed\n"); grid_blocks = -1; return; }
        if (hipOccupancyMaxActiveBlocksPerMultiprocessor(&per_cu, (const void*)mega, NTHR, LDS_BYTES) != hipSuccess || per_cu < 1) { fprintf(stderr, "occupancy query: %d\n", per_cu); per_cu = 1; }
        (void)hipGetLastError();
        grid_blocks = cus * 1;
    }
    if (grid_blocks < 0) return;
    Params p{};
    p.x = (const float*)d_in[0]; p.c = (const float*)d_in[1]; p.norm_g = (const float*)d_in[2]; p.w_ada = (const float*)d_in[3]; p.b_ada = (const float*)d_in[4];
    p.w_in = (const float*)d_in[5]; p.w_fft = (const float*)d_in[6]; p.na_bias = (const float*)d_in[7]; p.rl_f = (const float*)d_in[8]; p.rl_b = (const float*)d_in[9];
    p.conv_w = (const float*)d_in[10]; p.conv_b = (const float*)d_in[11]; p.ln_g = (const float*)d_in[12]; p.ln_b = (const float*)d_in[13]; p.w_pw = (const float*)d_in[14];
    p.w_out = (const float*)d_in[15]; p.final_g = (const float*)d_in[16];
    p.out = (float*)d_out; p.ws = (unsigned char*)d_ws;
#if ONE_LAUNCH
    if (hipMemsetAsync((char*)d_ws + WS_BAR, 0, 4096, stream) != hipSuccess) { fprintf(stderr, "memset of the barrier words failed\n"); return; }
    p.ph_lo = 0; p.ph_hi = NPH;
    void* args[] = {&p};
    hipError_t e = hipLaunchCooperativeKernel((const void*)mega, dim3(grid_blocks), dim3(NTHR), args, LDS_BYTES, stream);
    if (e != hipSuccess) fprintf(stderr, "cooperative launch failed: %s (grid %d)\n", hipGetErrorString(e), grid_blocks);
#else
    for (int ph = 0; ph < NPH; ++ph) { p.ph_lo = ph; p.ph_hi = ph + 1; hipLaunchKernelGGL(mega, dim3(grid_blocks), dim3(NTHR), LDS_BYTES, stream, p); }
#endif
}
```

```cpp
#include <hip/hip_runtime.h>
#include <hip/hip_cooperative_groups.h>
#include <cstdio>
#include <cstdint>
namespace cg = cooperative_groups;

#ifndef ONE_LAUNCH
#define ONE_LAUNCH 1
#endif

__device__ __forceinline__ int otid() { int t; asm volatile("v_mov_b32 %0, %1" : "=v"(t) : "v"(threadIdx.x)); return t; }
namespace pg8 {
#define PG8_LAS __attribute__((address_space(3)))
typedef unsigned short bf16_t;
typedef short bf16x8 __attribute__((ext_vector_type(8)));
typedef float f32x4 __attribute__((ext_vector_type(4)));
typedef unsigned u32x4 __attribute__((ext_vector_type(4)));
constexpr int BM = 256, BK = 64, HALF = 128, HTB = HALF * BK * 2, STAGE_BYTES = 8 * HTB, NXCD = 8, WGM = 8;

__host__ __device__ __forceinline__ int lds_byte(int r, int c) { const int st = (r >> 4) * 2 + (c >> 5), rr = r & 15, cc = c & 31, ob = rr * 64 + cc * 2; return st * 1024 + (ob ^ (((ob >> 9) & 1) << 5)); }
__host__ __device__ __forceinline__ void stage_rc(int b, int& R, int& C) { const int st = b / 1024, sb = b % 1024, swz = sb ^ (((sb >> 9) & 1) << 5); R = (st >> 1) * 16 + swz / 64; C = (st & 1) * 32 + (swz % 64) / 2; }
__host__ __device__ __forceinline__ int perm32(int rho) { const int n = rho >> 4, i = rho & 15; return 8 * (i >> 2) + 4 * n + (i & 3); }

struct Unit { int pm, pn, aux, pad; const char* A; const char* B; };
struct Gemm { int lda, ldb, K; };

struct StaticOrder {
    int nM, nN, nwg, G, c;
    __host__ __device__ void init(int M, int N, int G_, int c_) { nM = M / BM; nN = N / BM; nwg = nM * nN; G = G_; c = c_; }
    __device__ bool next(int i, Unit& u) const {
        const long L = (long)i * G + c; if (L >= nwg) return false;
        int wgid = __builtin_amdgcn_readfirstlane((int)L); { const int q = nwg / NXCD, r = nwg % NXCD, xcd = wgid % NXCD, off = wgid / NXCD; wgid = (xcd < r ? xcd * (q + 1) : r * (q + 1) + (xcd - r) * q) + off; }
        const int nig = WGM * nN, gid = wgid / nig, fm = gid * WGM, gsz = (nM - fm) < WGM ? (nM - fm) : WGM;
        u.pm = __builtin_amdgcn_readfirstlane(fm + ((wgid % nig) % gsz)); u.pn = __builtin_amdgcn_readfirstlane((wgid % nig) / gsz); return true;
    }
};

__device__ __forceinline__ unsigned cvt_pk_bf16(float lo, float hi) { unsigned r; asm volatile("v_cvt_pk_bf16_f32 %0, %1, %2" : "=v"(r) : "v"(lo), "v"(hi)); return r; }

template <class Epi, class Sched, bool ALIGN_EPI>
__device__ __forceinline__ void gemm_phase(PG8_LAS unsigned char* lds, const Gemm g, const Sched& S, const Epi& E) {
    const int tid = otid(), wid = __builtin_amdgcn_readfirstlane(tid >> 6), lane = tid & 63, wr = wid >> 2, wc = wid & 3, fr = lane & 15, fq = lane >> 4;
    const int K = g.K, nt = K / BK;
    unsigned voffA[2], voffB[2];
#pragma unroll
    for (int i = 0; i < 2; ++i) { int R, C; stage_rc(tid * 16 + i * 8192, R, C); const int Rb = Epi::PERM ? ((R & ~31) + perm32(R & 31)) : R;
        voffA[i] = (unsigned)(R * g.lda + C) * 2u; voffB[i] = (unsigned)(Rb * g.ldb + C) * 2u; }
    const size_t kstep = (size_t)(BK * 2);
    const size_t hA = (size_t)HALF * g.lda * 2, hB = (size_t)HALF * g.ldb * 2;
    const unsigned ldsw = (unsigned)wid * 1024u;
    const int aoff = lds_byte(wr * 64 + fr, fq * 8), boff = lds_byte(wc * 32 + fr, fq * 8);
#define PG8_SA(b, h) (((b) * 2 + (h)) * HTB)
#define PG8_SB(b, h) ((4 + (b) * 2 + (h)) * HTB)
#define PG8_STAGE(bufoff, gbase, voff) do { _Pragma("unroll") for (int _i = 0; _i < 2; ++_i) \
        __builtin_amdgcn_global_load_lds((const unsigned*)((const char*)(gbase) + (voff)[_i]), (PG8_LAS unsigned*)(lds + (bufoff) + ldsw + _i * 8192), 16, 0, 0); } while (0)
#define PG8_LDA(dst, b, h) do { _Pragma("unroll") for (int m = 0; m < 4; ++m) _Pragma("unroll") for (int k = 0; k < 2; ++k) dst[m][k] = *(const PG8_LAS bf16x8*)(lds + PG8_SA(b, h) + aoff + m * 2048 + k * 1024); } while (0)
#define PG8_LDB(dst, b, h) do { _Pragma("unroll") for (int n = 0; n < 2; ++n) _Pragma("unroll") for (int k = 0; k < 2; ++k) dst[n][k] = *(const PG8_LAS bf16x8*)(lds + PG8_SB(b, h) + boff + n * 2048 + k * 1024); } while (0)
#define PG8_MMA(ai, bj, At, Bt) do { __builtin_amdgcn_s_setprio(1); _Pragma("unroll") for (int m = 0; m < 4; ++m) _Pragma("unroll") for (int n = 0; n < 2; ++n) _Pragma("unroll") for (int k = 0; k < 2; ++k) \
        acc[ai][bj][m][n] = __builtin_amdgcn_mfma_f32_16x16x32_bf16(Bt[n][k], At[m][k], acc[ai][bj][m][n], 0, 0, 0); __builtin_amdgcn_s_setprio(0); } while (0)
#define PG8_WAIT_V(n) asm volatile("s_waitcnt vmcnt(" #n ")" ::: "memory")
#define PG8_WAIT_L(n) asm volatile("s_waitcnt lgkmcnt(" #n ")" ::: "memory")
#define PG8_BAR __builtin_amdgcn_s_barrier()
#define PG8_SCHED __builtin_amdgcn_sched_barrier(0)
    Unit cur, nxt; int ui = 0;
    if (!S.next(0, cur)) return;
    f32x4 acc[2][2][4][2];
#pragma unroll
    for (int a = 0; a < 2; ++a)
#pragma unroll
        for (int b = 0; b < 2; ++b)
#pragma unroll
            for (int m = 0; m < 4; ++m)
#pragma unroll
                for (int n = 0; n < 2; ++n) acc[a][b][m][n] = (f32x4){0.f, 0.f, 0.f, 0.f};
    bf16x8 At[4][2], B0[2][2], B1[2][2];
    const char* cA = cur.A; const char* cB = cur.B;
    PG8_STAGE(PG8_SB(0, 0), cB, voffB); PG8_STAGE(PG8_SB(0, 1), cB + hB, voffB); PG8_STAGE(PG8_SA(0, 0), cA, voffA); PG8_STAGE(PG8_SA(0, 1), cA + hA, voffA);
    if (wr == 1) PG8_BAR;
    PG8_WAIT_V(2); PG8_BAR;
    PG8_STAGE(PG8_SB(1, 0), cB + kstep, voffB); PG8_STAGE(PG8_SA(1, 0), cA + kstep, voffA); PG8_STAGE(PG8_SB(1, 1), cB + hB + kstep, voffB);
    PG8_WAIT_V(6); PG8_BAR;
    for (;;) {
        const bool has_next = S.next(ui + 1, nxt);
        const char* nA = has_next ? nxt.A : cA; const char* nB = has_next ? nxt.B : cB;
        for (int t = 0; t < nt; t += 2) {
            const bool last = (t == nt - 2);
            const char* a1 = cA + (size_t)(t + 1) * kstep;
            const char* a2 = last ? nA : cA + (size_t)(t + 2) * kstep; const char* b2 = last ? nB : cB + (size_t)(t + 2) * kstep;
            const char* a3 = a2 + kstep; const char* b3 = b2 + kstep;
            PG8_LDB(B0, 0, 0); PG8_LDB(B1, 0, 1); PG8_SCHED; PG8_LDA(At, 0, 0); PG8_STAGE(PG8_SA(1, 1), a1 + hA, voffA);
            PG8_WAIT_V(8); PG8_WAIT_L(0); PG8_BAR; PG8_MMA(0, 0, At, B0); PG8_MMA(0, 1, At, B1); PG8_BAR; PG8_SCHED;
            PG8_LDA(At, 0, 1); PG8_STAGE(PG8_SB(0, 0), b2, voffB); PG8_STAGE(PG8_SB(0, 1), b2 + hB, voffB); PG8_STAGE(PG8_SA(0, 0), a2, voffA);
            PG8_WAIT_V(8); PG8_WAIT_L(0); PG8_BAR; PG8_MMA(1, 0, At, B0); PG8_MMA(1, 1, At, B1); PG8_BAR; PG8_SCHED;
            PG8_LDB(B0, 1, 0); PG8_LDB(B1, 1, 1); PG8_SCHED; PG8_LDA(At, 1, 0); PG8_STAGE(PG8_SA(0, 1), a2 + hA, voffA);
            PG8_WAIT_V(8); PG8_WAIT_L(0); PG8_BAR; PG8_MMA(0, 0, At, B0); PG8_MMA(0, 1, At, B1); PG8_BAR; PG8_SCHED;
            PG8_LDA(At, 1, 1); PG8_STAGE(PG8_SB(1, 0), b3, voffB); PG8_STAGE(PG8_SB(1, 1), b3 + hB, voffB); PG8_STAGE(PG8_SA(1, 0), a3, voffA);
            PG8_WAIT_V(8); PG8_WAIT_L(0); PG8_BAR; PG8_MMA(1, 0, At, B0); PG8_MMA(1, 1, At, B1); PG8_BAR; PG8_SCHED;
        }
        if constexpr (ALIGN_EPI) { if (wr == 0) PG8_BAR; }
        E(acc, cur, wr, wc, fr, fq);
        if (!has_next) break;
#pragma unroll
        for (int a = 0; a < 2; ++a)
#pragma unroll
            for (int b = 0; b < 2; ++b)
#pragma unroll
                for (int m = 0; m < 4; ++m)
#pragma unroll
                    for (int n = 0; n < 2; ++n) acc[a][b][m][n] = (f32x4){0.f, 0.f, 0.f, 0.f};
        cur = nxt; cA = nA; cB = nB; ++ui;
        if constexpr (ALIGN_EPI) { if (wr == 1) PG8_BAR; }
    }
    PG8_WAIT_V(0);
    if constexpr (!ALIGN_EPI) { if (wr == 0) PG8_BAR; }
    PG8_BAR;
#undef PG8_SA
#undef PG8_SB
#undef PG8_STAGE
#undef PG8_LDA
#undef PG8_LDB
#undef PG8_MMA
#undef PG8_WAIT_V
#undef PG8_WAIT_L
#undef PG8_BAR
#undef PG8_SCHED
}
}

typedef unsigned short bf16;
typedef float f32x4 __attribute__((ext_vector_type(4)));
typedef unsigned u32x4 __attribute__((ext_vector_type(4)));
typedef unsigned u32x2 __attribute__((ext_vector_type(2)));
constexpr int NB = 2, SEQ = 4096, DM = 2048, MTOK = NB * SEQ, DIN = 6656, DG = 512, NL = 2;
constexpr int LDS_BYTES = 147456;
constexpr int NTHR = 512;

constexpr size_t WS_WIN = 0;
constexpr size_t WS_WOUT = WS_WIN + (size_t)NL * DIN * DM * 2;
constexpr size_t WS_WFFT = WS_WOUT + (size_t)NL * DM * DM * 2;
constexpr size_t WS_WPW = WS_WFFT + (size_t)NL * DG * DG * 2;
constexpr size_t WS_DFT = WS_WPW + (size_t)NL * DG * DG * 2;
constexpr size_t WS_ROPE = WS_DFT + (size_t)SEQ * 2 * SEQ * 2;
constexpr size_t WS_MOD = WS_ROPE + (size_t)SEQ * 32 * 8;
constexpr size_t WS_U = WS_MOD + 131072;
constexpr size_t WS_Z = WS_U + (size_t)4 * MTOK * DG * 4;
constexpr size_t WS_PQT = WS_Z + (size_t)MTOK * DIN * 2;
constexpr size_t WS_Y = WS_PQT + (size_t)NB * DG * 2 * SEQ * 2;
constexpr size_t WS_CVH = WS_Y + (size_t)MTOK * DG * 2;
constexpr size_t WS_CAT = WS_CVH + (size_t)MTOK * DG * 2;
constexpr size_t WS_KV = WS_CAT + (size_t)MTOK * DM * 2;
constexpr size_t WS_BAR = WS_KV + (size_t)2 * NB * 8 * 32 * 4096 * 4;
constexpr size_t WS_END = WS_BAR + 4096;

struct Params {
    const float* x; const float* c; const float* norm_g; const float* w_ada; const float* b_ada; const float* w_in; const float* w_fft; const float* na_bias;
    const float* rl_f; const float* rl_b; const float* conv_w; const float* conv_b; const float* ln_g; const float* ln_b; const float* w_pw; const float* w_out; const float* final_g;
    float* out; unsigned char* ws; int ph_lo, ph_hi;
};

__device__ __forceinline__ unsigned f2bf(float f) { unsigned u = __float_as_uint(f); return (u + 0x7fffu + ((u >> 16) & 1u)) >> 16; }
__device__ __forceinline__ unsigned pk2(float lo, float hi) { return f2bf(lo) | (f2bf(hi) << 16); }
__device__ __forceinline__ float bf2f(bf16 b) { return __uint_as_float((unsigned)b << 16); }
__device__ __forceinline__ float bflo(unsigned u) { return __uint_as_float(u << 16); }
__device__ __forceinline__ float bfhi(unsigned u) { return __uint_as_float(u & 0xffff0000u); }
__device__ __forceinline__ float silu_f(float v) { return v / (1.f + __expf(-v)); }
__device__ __forceinline__ float wave_sum(float v) {
#pragma unroll
    for (int o = 1; o < 64; o <<= 1) v += __shfl_xor(v, o);
    return v;
}
__device__ __forceinline__ float wave_max(float v) {
#pragma unroll
    for (int o = 1; o < 64; o <<= 1) v = fmaxf(v, __shfl_xor(v, o));
    return v;
}

struct SchedS {
    pg8::StaticOrder o; const char* A; const char* B; size_t ta, tb;
    __device__ __forceinline__ bool next(int i, pg8::Unit& u) const { if (!o.next(i, u)) return false; u.A = A + (size_t)u.pm * ta; u.B = B + (size_t)u.pn * tb; u.aux = 0; return true; }
};
__device__ __forceinline__ SchedS make_sched(const void* A, int lda, const void* B, int ldb, int M, int N) {
    SchedS s; s.o.init(M, N, (int)gridDim.x, (int)blockIdx.x); s.A = (const char*)A; s.B = (const char*)B; s.ta = (size_t)256 * lda * 2; s.tb = (size_t)256 * ldb * 2; return s;
}
struct SchedDFT {
    const char* A; const char* B; int G, c;
    __device__ __forceinline__ bool next(int i, pg8::Unit& u) const {
        const int L = __builtin_amdgcn_readfirstlane(i * G + c); if (L >= 256) return false;
        const int sub = L >> 5, t = L & 31; u.pm = t >> 1; u.pn = t & 1; u.aux = sub;
        u.A = A + (size_t)((u.pm << 22) + ((sub & 3) << 12)); u.B = B + (size_t)(((sub >> 2) << 23) + (u.pn << 22) + ((sub & 3) << 12)); return true;
    }
};

struct EpiZ {
    static constexpr bool PERM = true;
    bf16* O; int ldc;
    __device__ __forceinline__ void operator()(const pg8::f32x4 (&acc)[2][2][4][2], const pg8::Unit& u, int wr, int wc, int fr, int fq) const {
        const int row0 = u.pm * 256 + wr * 64 + fr, col0 = u.pn * 256 + wc * 32 + 8 * fq;
#pragma unroll
        for (int ai = 0; ai < 2; ++ai)
#pragma unroll
            for (int m = 0; m < 4; ++m) { bf16* rowp = O + (size_t)(row0 + ai * 128 + m * 16) * ldc + col0;
#pragma unroll
                for (int bj = 0; bj < 2; ++bj) { const pg8::f32x4 v0 = acc[ai][bj][m][0], v1 = acc[ai][bj][m][1]; u32x4 w;
                    w.x = pg8::cvt_pk_bf16(v0[0], v0[1]); w.y = pg8::cvt_pk_bf16(v0[2], v0[3]); w.z = pg8::cvt_pk_bf16(v1[0], v1[1]); w.w = pg8::cvt_pk_bf16(v1[2], v1[3]);
                    *(u32x4*)(rowp + bj * 128) = w; } }
    }
};
struct EpiGate {
    static constexpr bool PERM = true;
    bf16* O; const bf16* Z; int coff, goff;
    __device__ __forceinline__ void operator()(const pg8::f32x4 (&acc)[2][2][4][2], const pg8::Unit& u, int wr, int wc, int fr, int fq) const {
        const int row0 = u.pm * 256 + wr * 64 + fr, col0 = u.pn * 256 + wc * 32 + 8 * fq;
#pragma unroll
        for (int ai = 0; ai < 2; ++ai)
#pragma unroll
            for (int m = 0; m < 4; ++m) { const size_t row = (size_t)(row0 + ai * 128 + m * 16);
#pragma unroll
                for (int bj = 0; bj < 2; ++bj) { const pg8::f32x4 v0 = acc[ai][bj][m][0], v1 = acc[ai][bj][m][1];
                    const u32x4 gz = *(const u32x4*)(Z + row * DIN + goff + col0 + bj * 128); u32x4 w;
                    w.x = pg8::cvt_pk_bf16(v0[0] * silu_f(bflo(gz.x)), v0[1] * silu_f(bfhi(gz.x))); w.y = pg8::cvt_pk_bf16(v0[2] * silu_f(bflo(gz.y)), v0[3] * silu_f(bfhi(gz.y)));
                    w.z = pg8::cvt_pk_bf16(v1[0] * silu_f(bflo(gz.z)), v1[1] * silu_f(bfhi(gz.z))); w.w = pg8::cvt_pk_bf16(v1[2] * silu_f(bflo(gz.w)), v1[3] * silu_f(bfhi(gz.w)));
                    *(u32x4*)(O + row * DM + coff + col0 + bj * 128) = w; } }
    }
};
struct EpiPart {
    static constexpr bool PERM = false;
    float* P;
    __device__ __forceinline__ void operator()(const pg8::f32x4 (&acc)[2][2][4][2], const pg8::Unit& u, int wr, int wc, int fr, int fq) const {
        const int row0 = u.pm * 256 + wr * 64 + fr, col0 = u.pn * 256 + wc * 32 + 4 * fq;
        float* base = P + (size_t)u.aux * 4096 * 512;
#pragma unroll
        for (int ai = 0; ai < 2; ++ai)
#pragma unroll
            for (int m = 0; m < 4; ++m) { float* rowp = base + (size_t)(row0 + ai * 128 + m * 16) * 512 + col0;
#pragma unroll
                for (int bj = 0; bj < 2; ++bj)
#pragma unroll
                    for (int n = 0; n < 2; ++n) *(pg8::f32x4*)(rowp + bj * 128 + n * 16) = acc[ai][bj][m][n]; }
    }
};
struct EpiRes {
    static constexpr bool PERM = false;
    const float* xin; float* xout; const float* gate;
    __device__ __forceinline__ void operator()(const pg8::f32x4 (&acc)[2][2][4][2], const pg8::Unit& u, int wr, int wc, int fr, int fq) const {
        const int row0 = u.pm * 256 + wr * 64 + fr, col0 = u.pn * 256 + wc * 32 + 4 * fq;
        const float* gp = gate + (size_t)(u.pm >> 4) * 6144 + col0;
        pg8::f32x4 gv[2][2];
#pragma unroll
        for (int bj = 0; bj < 2; ++bj)
#pragma unroll
            for (int n = 0; n < 2; ++n) gv[bj][n] = *(const pg8::f32x4*)(gp + bj * 128 + n * 16);
#pragma unroll
        for (int ai = 0; ai < 2; ++ai)
#pragma unroll
            for (int m = 0; m < 4; ++m) { const size_t ro = (size_t)(row0 + ai * 128 + m * 16) * DM + col0;
#pragma unroll
                for (int bj = 0; bj < 2; ++bj)
#pragma unroll
                    for (int n = 0; n < 2; ++n) { const pg8::f32x4 xi = *(const pg8::f32x4*)(xin + ro + bj * 128 + n * 16);
                        *(pg8::f32x4*)(xout + ro + bj * 128 + n * 16) = xi + gv[bj][n] * acc[ai][bj][m][n]; } }
    }
};

__device__ __forceinline__ void transpose_tile(const float* W, int K, int N, bf16* WT, int item, float* scr) {
    const int tid = otid(), nb = N / 64, kb = item / nb, nbk = item % nb, k0 = kb * 64, n0 = nbk * 64;
#pragma unroll
    for (int i = 0; i < 2; ++i) { const int kk = (tid >> 4) + 32 * i, nn = (tid & 15) * 4;
        const f32x4 v = *(const f32x4*)(W + (size_t)(k0 + kk) * N + n0 + nn);
        scr[kk * 65 + nn] = v[0]; scr[kk * 65 + nn + 1] = v[1]; scr[kk * 65 + nn + 2] = v[2]; scr[kk * 65 + nn + 3] = v[3]; }
    __syncthreads();
    { const int n = tid >> 3, kc = (tid & 7) * 8; const float* s = scr + kc * 65 + n; u32x4 o;
      o.x = pk2(s[0], s[65]); o.y = pk2(s[2 * 65], s[3 * 65]); o.z = pk2(s[4 * 65], s[5 * 65]); o.w = pk2(s[6 * 65], s[7 * 65]);
      *(u32x4*)(WT + (size_t)(n0 + n) * K + k0 + kc) = o; }
    __syncthreads();
}

__device__ __forceinline__ void ph_prologue(const Params& p, unsigned char* lds) {
    const int tid = otid(), lane = tid & 63, wave = tid >> 6, G = gridDim.x, bid = blockIdx.x;
    float* scr = (float*)lds;
    bf16* Wt_in = (bf16*)(p.ws + WS_WIN); bf16* Wt_out = (bf16*)(p.ws + WS_WOUT); bf16* Wt_fft = (bf16*)(p.ws + WS_WFFT); bf16* Wt_pw = (bf16*)(p.ws + WS_WPW);
    constexpr int T_IN = 32 * 104, T_OUT = 32 * 32, T_S = 64, T_L = T_IN + T_OUT + 2 * T_S;
    for (int it = bid; it < NL * T_L; it += G) {
        const int l = it / T_L; int r = it % T_L;
        if (r < T_IN) { transpose_tile(p.w_in + (size_t)l * DM * DIN, DM, DIN, Wt_in + (size_t)l * DIN * DM, r, scr); continue; } r -= T_IN;
        if (r < T_OUT) { transpose_tile(p.w_out + (size_t)l * DM * DM, DM, DM, Wt_out + (size_t)l * DM * DM, r, scr); continue; } r -= T_OUT;
        if (r < T_S) { transpose_tile(p.w_fft + (size_t)l * DG * DG, DG, DG, Wt_fft + (size_t)l * DG * DG, r, scr); continue; } r -= T_S;
        transpose_tile(p.w_pw + (size_t)l * DG * DG, DG, DG, Wt_pw + (size_t)l * DG * DG, r, scr);
    }
    float* cosT = (float*)(lds + 32768); float* sinT = (float*)(lds + 49152); float* ca = (float*)(lds + 65536); float* red = (float*)(lds + 81920);
    for (int j = tid; j < 4096; j += NTHR) { cosT[j] = cospif((float)j * (1.f / 2048.f)); sinT[j] = sinpif((float)j * (1.f / 2048.f)); }
    for (int j = tid; j < 4096; j += NTHR) { const float cv = p.c[j]; ca[j] = cv / (1.f + expf(-cv)); }
    __syncthreads();
    bf16* DFT = (bf16*)(p.ws + WS_DFT);
    for (int k = bid; k < 4096; k += G) {
#pragma unroll
        for (int cc = 0; cc < 2; ++cc) { const int kk0 = (tid + cc * NTHR) * 8; float v[8];
#pragma unroll
            for (int j = 0; j < 8; ++j) { const int kk = kk0 + j, idx = (k * (kk & 4095)) & 4095; v[j] = (kk < 4096) ? cosT[idx] : -sinT[idx]; }
            u32x4 o; o.x = pk2(v[0], v[1]); o.y = pk2(v[2], v[3]); o.z = pk2(v[4], v[5]); o.w = pk2(v[6], v[7]);
            *(u32x4*)(DFT + (size_t)k * 8192 + kk0) = o; }
    }
    { float2* rope = (float2*)(p.ws + WS_ROPE);
      for (int e = bid * NTHR + tid; e < 4096 * 32; e += G * NTHR) { const int s = e >> 5, i = e & 31;
          const float inv = (float)pow(10000.0, -(double)i / 32.0); const float ang = (float)s * inv;
          double sn, cs; sincos((double)ang, &sn, &cs); rope[e] = make_float2((float)cs, (float)sn); } }
    float* mod = (float*)(p.ws + WS_MOD);
    for (int t = bid; t < 192; t += G) {
        const int l = t / 96, col = (t % 96) * 64 + lane; const float* W = p.w_ada + (size_t)l * DM * 6144 + col;
        float a0 = 0.f, a1 = 0.f;
#pragma unroll 8
        for (int k = wave * 256; k < wave * 256 + 256; ++k) { const float w = W[(size_t)k * 6144]; a0 += ca[k] * w; a1 += ca[2048 + k] * w; }
        red[(wave * 2 + 0) * 64 + lane] = a0; red[(wave * 2 + 1) * 64 + lane] = a1;
        __syncthreads();
        if (wave < 2) { float s = 0.f;
#pragma unroll
            for (int w = 0; w < 8; ++w) s += red[(w * 2 + wave) * 64 + lane];
            mod[(size_t)(l * 2 + wave) * 6144 + col] = s + p.b_ada[l * 6144 + col]; }
        __syncthreads();
    }
}

__device__ __forceinline__ void ph_norm(const Params& p, int l) {
    const int tid = otid(), lane = tid & 63, wave = tid >> 6;
    const float* xin = (l == 0) ? p.x : p.out; bf16* h = (bf16*)(p.ws + WS_U); const float* mod = (const float*)(p.ws + WS_MOD);
    for (int row = blockIdx.x * 8 + wave; row < MTOK; row += gridDim.x * 8) {
        const f32x4* xr = (const f32x4*)(xin + (size_t)row * DM) + lane; f32x4 v[8]; float ss = 0.f;
#pragma unroll
        for (int j = 0; j < 8; ++j) { v[j] = xr[64 * j]; ss += (v[j][0] * v[j][0] + v[j][1] * v[j][1]) + (v[j][2] * v[j][2] + v[j][3] * v[j][3]); }
        ss = wave_sum(ss); const float rstd = rsqrtf(ss * (1.f / DM) + 1e-6f);
        const float* md = mod + (size_t)(l * 2 + (row >> 12)) * 6144; const float* g = p.norm_g + l * DM;
#pragma unroll
        for (int j = 0; j < 8; ++j) { const int col = (64 * j + lane) * 4;
            const f32x4 g4 = *(const f32x4*)(g + col), sh = *(const f32x4*)(md + col), sc = *(const f32x4*)(md + 2048 + col);
            const f32x4 o = (v[j] * rstd * g4) * (sc + 1.f) + sh; u32x2 w; w.x = pk2(o[0], o[1]); w.y = pk2(o[2], o[3]);
            *(u32x2*)(h + (size_t)row * DM + col) = w; }
    }
}
__device__ __forceinline__ void ph_final(const Params& p) {
    const int tid = otid(), lane = tid & 63, wave = tid >> 6;
    for (int row = blockIdx.x * 8 + wave; row < MTOK; row += gridDim.x * 8) {
        f32x4* xr = (f32x4*)(p.out + (size_t)row * DM) + lane; f32x4 v[8]; float ss = 0.f;
#pragma unroll
        for (int j = 0; j < 8; ++j) { v[j] = xr[64 * j]; ss += (v[j][0] * v[j][0] + v[j][1] * v[j][1]) + (v[j][2] * v[j][2] + v[j][3] * v[j][3]); }
        ss = wave_sum(ss); const float rstd = rsqrtf(ss * (1.f / DM) + 1e-6f);
#pragma unroll
        for (int j = 0; j < 8; ++j) { const int col = (64 * j + lane) * 4; const f32x4 g4 = *(const f32x4*)(p.final_g + col); xr[64 * j] = v[j] * rstd * g4; }
    }
}

typedef short bf16x8v __attribute__((ext_vector_type(8)));
__device__ __forceinline__ bf16x8v mk8(unsigned a, unsigned b, unsigned c, unsigned d) { u32x4 v = {a, b, c, d}; return __builtin_bit_cast(bf16x8v, v); }
#define MFMA16(a, b, c) __builtin_amdgcn_mfma_f32_16x16x32_bf16(a, b, c, 0, 0, 0)
constexpr int R_QS = 0, R_KS = 18432, R_VT = 36864, R_KTF = 54272, R_KTB = 71680, R_STF = 89088, R_STB = 98304;

template <bool R2>
__device__ __forceinline__ void ret_stage(const Params& p, int b, int h, int n, unsigned char* lds, float l2f, float l2b) {
    const int tid = otid(), j = tid >> 2, c4 = tid & 3, s = n * 128 + j;
    const bf16* Z = (const bf16*)(p.ws + WS_Z); const bf16* zr = Z + (size_t)(b * SEQ + s) * DIN;
    const f32x4* rp = (const f32x4*)((const float2*)(p.ws + WS_ROPE) + s * 32 + c4 * 8);
    float cs[8], sn[8];
#pragma unroll
    for (int i = 0; i < 4; ++i) { const f32x4 r = rp[i]; cs[2 * i] = r[0]; sn[2 * i] = r[1]; cs[2 * i + 1] = r[2]; sn[2 * i + 1] = r[3]; }
    bf16* KS = (bf16*)(lds + R_KS); bf16* VT = (bf16*)(lds + R_VT);
    { const u32x4 ka = *(const u32x4*)(zr + 7 * DG + h * 64 + c4 * 8), kb = *(const u32x4*)(zr + 7 * DG + h * 64 + 32 + c4 * 8);
      const unsigned kau[4] = {ka.x, ka.y, ka.z, ka.w}, kbu[4] = {kb.x, kb.y, kb.z, kb.w};
      float k1[8], k2[8];
#pragma unroll
      for (int i = 0; i < 4; ++i) { const float a0 = bflo(kau[i]), a1 = bfhi(kau[i]), b0 = bflo(kbu[i]), b1 = bfhi(kbu[i]);
          k1[2 * i] = a0 * cs[2 * i] - b0 * sn[2 * i]; k2[2 * i] = a0 * sn[2 * i] + b0 * cs[2 * i];
          k1[2 * i + 1] = a1 * cs[2 * i + 1] - b1 * sn[2 * i + 1]; k2[2 * i + 1] = a1 * sn[2 * i + 1] + b1 * cs[2 * i + 1]; }
      u32x4 o1, o2; o1.x = pk2(k1[0], k1[1]); o1.y = pk2(k1[2], k1[3]); o1.z = pk2(k1[4], k1[5]); o1.w = pk2(k1[6], k1[7]);
      o2.x = pk2(k2[0], k2[1]); o2.y = pk2(k2[2], k2[3]); o2.z = pk2(k2[4], k2[5]); o2.w = pk2(k2[6], k2[7]);
      *(u32x4*)(KS + j * 72 + c4 * 8) = o1; *(u32x4*)(KS + j * 72 + 32 + c4 * 8) = o2;
      if (!R2) { bf16* KTF = (bf16*)(lds + R_KTF); bf16* KTB = (bf16*)(lds + R_KTB);
          const float df = exp2f(l2f * (float)(127 - j)), db = exp2f(l2b * (float)j);
#pragma unroll
          for (int i = 0; i < 8; ++i) { KTF[(c4 * 8 + i) * 136 + j] = (bf16)f2bf(k1[i] * df); KTF[(32 + c4 * 8 + i) * 136 + j] = (bf16)f2bf(k2[i] * df);
              KTB[(c4 * 8 + i) * 136 + j] = (bf16)f2bf(k1[i] * db); KTB[(32 + c4 * 8 + i) * 136 + j] = (bf16)f2bf(k2[i] * db); } } }
    { const u32x4 va = *(const u32x4*)(zr + 8 * DG + h * 64 + c4 * 16), vb = *(const u32x4*)(zr + 8 * DG + h * 64 + c4 * 16 + 8);
      const unsigned vu[8] = {va.x, va.y, va.z, va.w, vb.x, vb.y, vb.z, vb.w};
#pragma unroll
      for (int i = 0; i < 8; ++i) { VT[(c4 * 16 + 2 * i) * 136 + j] = (bf16)(vu[i] & 0xffffu); VT[(c4 * 16 + 2 * i + 1) * 136 + j] = (bf16)(vu[i] >> 16); } }
    if (R2) { bf16* QS = (bf16*)(lds + R_QS);
      const u32x4 qa = *(const u32x4*)(zr + 6 * DG + h * 64 + c4 * 8), qb = *(const u32x4*)(zr + 6 * DG + h * 64 + 32 + c4 * 8);
      const unsigned qau[4] = {qa.x, qa.y, qa.z, qa.w}, qbu[4] = {qb.x, qb.y, qb.z, qb.w};
      float q1[8], q2[8];
#pragma unroll
      for (int i = 0; i < 4; ++i) { const float a0 = bflo(qau[i]), a1 = bfhi(qau[i]), b0 = bflo(qbu[i]), b1 = bfhi(qbu[i]);
          q1[2 * i] = (a0 * cs[2 * i] - b0 * sn[2 * i]) * 0.125f; q2[2 * i] = (a0 * sn[2 * i] + b0 * cs[2 * i]) * 0.125f;
          q1[2 * i + 1] = (a1 * cs[2 * i + 1] - b1 * sn[2 * i + 1]) * 0.125f; q2[2 * i + 1] = (a1 * sn[2 * i + 1] + b1 * cs[2 * i + 1]) * 0.125f; }
      u32x4 o1, o2; o1.x = pk2(q1[0], q1[1]); o1.y = pk2(q1[2], q1[3]); o1.z = pk2(q1[4], q1[5]); o1.w = pk2(q1[6], q1[7]);
      o2.x = pk2(q2[0], q2[1]); o2.y = pk2(q2[2], q2[3]); o2.z = pk2(q2[4], q2[5]); o2.w = pk2(q2[6], q2[7]);
      *(u32x4*)(QS + j * 72 + c4 * 8) = o1; *(u32x4*)(QS + j * 72 + 32 + c4 * 8) = o2; }
}

__device__ __forceinline__ void ret1_task(const Params& p, int l, int task, unsigned char* lds) {
    const int n = task & 31, h = (task >> 5) & 7, b = task >> 8;
    const float xf = p.rl_f[l * 8 + h], xb = p.rl_b[l * 8 + h];
    const float l2f = -log1pf(expf(-xf)) * 1.4426950408889634f, l2b = -log1pf(expf(-xb)) * 1.4426950408889634f;
    ret_stage<false>(p, b, h, n, lds, l2f, l2b);
    __syncthreads();
    const int tid = otid(), lane = tid & 63, w = tid >> 6, fr = lane & 15, fq = lane >> 4, dir = w >> 2, et = w & 3;
    const bf16* VT = (const bf16*)(lds + R_VT); const bf16* KT = (const bf16*)(lds + (dir ? R_KTB : R_KTF));
    bf16x8v a[4];
#pragma unroll
    for (int ks = 0; ks < 4; ++ks) a[ks] = *(const bf16x8v*)(VT + (16 * et + fr) * 136 + 32 * ks + 8 * fq);
    float* dst = (float*)(p.ws + WS_KV) + ((size_t)((dir * 2 + b) * 8 + h) * 32 + n) * 4096;
#pragma unroll
    for (int dt = 0; dt < 4; ++dt) { f32x4 acc = {0.f, 0.f, 0.f, 0.f};
#pragma unroll
        for (int ks = 0; ks < 4; ++ks) { const bf16x8v bfr = *(const bf16x8v*)(KT + (16 * dt + fr) * 136 + 32 * ks + 8 * fq); acc = MFMA16(a[ks], bfr, acc); }
#pragma unroll
        for (int r = 0; r < 4; ++r) dst[(16 * et + 4 * fq + r) * 64 + 16 * dt + fr] = acc[r]; }
    __syncthreads();
}

__device__ __forceinline__ void ret2_task(const Params& p, int l, int task, unsigned char* lds) {
    const int n = task & 31, h = (task >> 5) & 7, b = task >> 8;
    const float xf = p.rl_f[l * 8 + h], xb = p.rl_b[l * 8 + h];
    const float l2f = -log1pf(expf(-xf)) * 1.4426950408889634f, l2b = -log1pf(expf(-xb)) * 1.4426950408889634f;
    ret_stage<true>(p, b, h, n, lds, l2f, l2b);
    const int tid = otid(), lane = tid & 63, w = tid >> 6, fr = lane & 15, fq = lane >> 4;
    {
      const float gfC = exp2f(l2f * 128.f), gbC = exp2f(l2b * 128.f);
      const float* KVf = (const float*)(p.ws + WS_KV) + ((size_t)((0 * 2 + b) * 8 + h) * 32) * 4096 + tid * 8;
      const float* KVb = (const float*)(p.ws + WS_KV) + ((size_t)((1 * 2 + b) * 8 + h) * 32) * 4096 + tid * 8;
      f32x4 f0 = {0.f, 0.f, 0.f, 0.f}, f1 = f0, g0 = f0, g1 = f0; float cf = 1.f;
      for (int m = n - 1; m >= 0; --m) { const f32x4 x0 = *(const f32x4*)(KVf + (size_t)m * 4096), x1 = *(const f32x4*)(KVf + (size_t)m * 4096 + 4); f0 += x0 * cf; f1 += x1 * cf; cf *= gfC; }
      cf = 1.f;
      for (int m = n + 1; m < 32; ++m) { const f32x4 x0 = *(const f32x4*)(KVb + (size_t)m * 4096), x1 = *(const f32x4*)(KVb + (size_t)m * 4096 + 4); g0 += x0 * cf; g1 += x1 * cf; cf *= gbC; }
      const int e = tid >> 3, d0 = (tid & 7) * 8; u32x4 o;
      o.x = pk2(f0[0], f0[1]); o.y = pk2(f0[2], f0[3]); o.z = pk2(f1[0], f1[1]); o.w = pk2(f1[2], f1[3]); *(u32x4*)((bf16*)(lds + R_STF) + e * 72 + d0) = o;
      o.x = pk2(g0[0], g0[1]); o.y = pk2(g0[2], g0[3]); o.z = pk2(g1[0], g1[1]); o.w = pk2(g1[2], g1[3]); *(u32x4*)((bf16*)(lds + R_STB) + e * 72 + d0) = o; }
    __syncthreads();
    const bf16* QS = (const bf16*)(lds + R_QS); const bf16* KS = (const bf16*)(lds + R_KS); const bf16* VT = (const bf16*)(lds + R_VT);
    const bf16* STF = (const bf16*)(lds + R_STF); const bf16* STB = (const bf16*)(lds + R_STB);
    bf16x8v qf[2];
#pragma unroll
    for (int ks = 0; ks < 2; ++ks) qf[ks] = *(const bf16x8v*)(QS + (16 * w + fr) * 72 + 32 * ks + 8 * fq);
    const int ai = 16 * w + fr;
    unsigned pp[8][2];
#pragma unroll
    for (int jt = 0; jt < 8; ++jt) { f32x4 acc = {0.f, 0.f, 0.f, 0.f};
#pragma unroll
        for (int ks = 0; ks < 2; ++ks) { const bf16x8v kf = *(const bf16x8v*)(KS + (16 * jt + fr) * 72 + 32 * ks + 8 * fq); acc = MFMA16(kf, qf[ks], acc); }
        float sc[4];
#pragma unroll
        for (int r = 0; r < 4; ++r) { const int aj = 16 * jt + 4 * fq + r; const float wg = (aj <= ai) ? exp2f(l2f * (float)(ai - aj)) : exp2f(l2b * (float)(aj - ai)); sc[r] = acc[r] * wg; }
        pp[jt][0] = pk2(sc[0], sc[1]); pp[jt][1] = pk2(sc[2], sc[3]); }
    const float qdf = exp2f(l2f * (float)(ai + 1)), qdb = exp2f(l2b * (float)(128 - ai));
    f32x4 tot[4]; float ss = 0.f;
#pragma unroll
    for (int et = 0; et < 4; ++et) { f32x4 o = {0.f, 0.f, 0.f, 0.f}, cfa = o, cba = o;
#pragma unroll
        for (int t = 0; t < 4; ++t) { const u32x2 vlo = *(const u32x2*)(VT + (16 * et + fr) * 136 + 32 * t + 4 * fq), vhi = *(const u32x2*)(VT + (16 * et + fr) * 136 + 32 * t + 16 + 4 * fq);
            o = MFMA16(mk8(vlo.x, vlo.y, vhi.x, vhi.y), mk8(pp[2 * t][0], pp[2 * t][1], pp[2 * t + 1][0], pp[2 * t + 1][1]), o); }
#pragma unroll
        for (int ks = 0; ks < 2; ++ks) { const bf16x8v sf = *(const bf16x8v*)(STF + (16 * et + fr) * 72 + 32 * ks + 8 * fq), sb = *(const bf16x8v*)(STB + (16 * et + fr) * 72 + 32 * ks + 8 * fq);
            cfa = MFMA16(sf, qf[ks], cfa); cba = MFMA16(sb, qf[ks], cba); }
        tot[et] = o + cfa * qdf + cba * qdb;
        ss += (tot[et][0] * tot[et][0] + tot[et][1] * tot[et][1]) + (tot[et][2] * tot[et][2] + tot[et][3] * tot[et][3]); }
    ss += __shfl_xor(ss, 16); ss += __shfl_xor(ss, 32);
    const float rs = rsqrtf(ss * (1.f / 64.f) + 1e-6f);
    const size_t tok = (size_t)b * SEQ + n * 128 + ai;
    const bf16* Z = (const bf16*)(p.ws + WS_Z); bf16* CAT = (bf16*)(p.ws + WS_CAT);
#pragma unroll
    for (int et = 0; et < 4; ++et) { const u32x2 gz = *(const u32x2*)(Z + tok * DIN + 9 * DG + h * 64 + 16 * et + 4 * fq); u32x2 o;
        o.x = pk2(tot[et][0] * rs * silu_f(bflo(gz.x)), tot[et][1] * rs * silu_f(bfhi(gz.x))); o.y = pk2(tot[et][2] * rs * silu_f(bflo(gz.y)), tot[et][3] * rs * silu_f(bfhi(gz.y)));
        *(u32x2*)(CAT + tok * DM + 1024 + h * 64 + 16 * et + 4 * fq) = o; }
    __syncthreads();
}

__device__ __forceinline__ void na2_task(const Params& p, int l, int task, unsigned char* lds) {
    const int tid = otid(), lane = tid & 63, w = tid >> 6, fr = lane & 15, fq = lane >> 4;
    const int hp = task & 3, rq = (task >> 2) & 63, b = task >> 8;
    const int row_start = min(max(rq - 4, 0), 56);
    const bf16* Z = (const bf16*)(p.ws + WS_Z); bf16* CAT = (bf16*)(p.ws + WS_CAT);
    bf16* VT = (bf16*)lds; float* BI = (float*)(lds + 133120);
    for (int i = tid; i < 930; i += NTHR) BI[i] = p.na_bias[(size_t)(l * 8 + hp * 2) * 465 + i];
    { const int pair = lane & 31, chunk = (lane >> 5) + 2 * (w & 3), hh = w >> 2, h = hp * 2 + hh;
      unsigned* VTd = (unsigned*)(VT + (size_t)hh * 64 * 520);
#pragma unroll 2
      for (int a = 0; a < 8; ++a) {
          const size_t tok = (size_t)b * SEQ + (row_start + a) * 64 + 2 * pair;
          const bf16* src = Z + tok * DIN + 4 * DG + h * 64 + chunk * 8;
          const u32x4 x = *(const u32x4*)src, y = *(const u32x4*)(src + DIN);
          const unsigned xu[4] = {x.x, x.y, x.z, x.w}, yu[4] = {y.x, y.y, y.z, y.w};
#pragma unroll
          for (int i = 0; i < 4; ++i) { VTd[(chunk * 8 + 2 * i) * 260 + a * 32 + pair] = (xu[i] & 0xffffu) | (yu[i] << 16);
              VTd[(chunk * 8 + 2 * i + 1) * 260 + a * 32 + pair] = (xu[i] >> 16) | (yu[i] & 0xffff0000u); } } }
    __syncthreads();
    const int hh = w >> 2, h = hp * 2 + hh, qb = w & 3, ct0 = (qb >= 2) ? 1 : 0;
    const int c = 16 * qb + fr; const size_t qtok = (size_t)b * SEQ + rq * 64 + c;
    bf16x8v qf[2];
#pragma unroll
    for (int ks = 0; ks < 2; ++ks) qf[ks] = *(const bf16x8v*)(Z + qtok * DIN + 2 * DG + h * 64 + 32 * ks + 8 * fq);
    const int col_start = min(max(c - 8, 0), 48);
    const float* bi = BI + hh * 465;
    float sc[24][4]; float mx = -1e30f;
#pragma unroll
    for (int a = 0; a < 8; ++a)
#pragma unroll
        for (int ci = 0; ci < 3; ++ci) { const int kt = a * 3 + ci;
            const size_t ktok = (size_t)b * SEQ + (row_start + a) * 64 + 16 * (ct0 + ci) + fr;
            f32x4 acc = {0.f, 0.f, 0.f, 0.f};
#pragma unroll
            for (int ks = 0; ks < 2; ++ks) { const bf16x8v kf = *(const bf16x8v*)(Z + ktok * DIN + 3 * DG + h * 64 + 32 * ks + 8 * fq); acc = MFMA16(kf, qf[ks], acc); }
            const int dr = row_start + a - rq;
#pragma unroll
            for (int r = 0; r < 4; ++r) { const int kc = 16 * (ct0 + ci) + 4 * fq + r, rel = kc - col_start, dc = kc - c;
                float v = acc[r] * 0.125f + bi[(dr + 7) * 31 + min(max(dc + 15, 0), 30)];
                v = (rel >= 0 && rel < 16) ? v : -1e30f; sc[kt][r] = v; mx = fmaxf(mx, v); } }
    mx = fmaxf(mx, __shfl_xor(mx, 16)); mx = fmaxf(mx, __shfl_xor(mx, 32));
    float sum = 0.f; unsigned pp[24][2];
#pragma unroll
    for (int kt = 0; kt < 24; ++kt) { const float e0 = __expf(sc[kt][0] - mx), e1 = __expf(sc[kt][1] - mx), e2 = __expf(sc[kt][2] - mx), e3 = __expf(sc[kt][3] - mx);
        sum += (e0 + e1) + (e2 + e3); pp[kt][0] = pk2(e0, e1); pp[kt][1] = pk2(e2, e3); }
    sum += __shfl_xor(sum, 16); sum += __shfl_xor(sum, 32);
    const float inv = 1.f / sum;
    const bf16* VTh = VT + (size_t)hh * 64 * 520;
#pragma unroll
    for (int dt = 0; dt < 4; ++dt) { f32x4 o = {0.f, 0.f, 0.f, 0.f};
#pragma unroll
        for (int t = 0; t < 12; ++t) { const int k0 = 2 * t, k1 = 2 * t + 1, a0 = k0 / 3, c0 = k0 % 3, a1 = k1 / 3, c1 = k1 % 3;
            const u32x2 vlo = *(const u32x2*)(VTh + (16 * dt + fr) * 520 + a0 * 64 + 16 * (ct0 + c0) + 4 * fq), vhi = *(const u32x2*)(VTh + (16 * dt + fr) * 520 + a1 * 64 + 16 * (ct0 + c1) + 4 * fq);
            o = MFMA16(mk8(vlo.x, vlo.y, vhi.x, vhi.y), mk8(pp[k0][0], pp[k0][1], pp[k1][0], pp[k1][1]), o); }
        const u32x2 gz = *(const u32x2*)(Z + qtok * DIN + 5 * DG + h * 64 + 16 * dt + 4 * fq); u32x2 ov;
        ov.x = pk2(o[0] * inv * silu_f(bflo(gz.x)), o[1] * inv * silu_f(bfhi(gz.x))); ov.y = pk2(o[2] * inv * silu_f(bflo(gz.y)), o[3] * inv * silu_f(bfhi(gz.y)));
        *(u32x2*)(CAT + qtok * DM + 512 + h * 64 + 16 * dt + 4 * fq) = ov; }
    __syncthreads();
}

__device__ __forceinline__ void conv_task(const Params& p, int l, int task, unsigned char* lds) {
    const int tid = otid(), lane = tid & 63, wave = tid >> 6;
    float* us = (float*)lds; float* ys = us + 46 * 512;
    const bf16* Z = (const bf16*)(p.ws + WS_Z);
    const int b = task >> 8, t0 = (task & 255) * 16;
    for (int tt = 0; tt < 46; ++tt) { const int tok = t0 - 15 + tt; float u = 0.f;
        if (tok >= 0 && tok < SEQ) { const bf16* zr = Z + (size_t)(b * SEQ + tok) * DIN; const float a = bf2f(zr[10 * DG + tid]), g = bf2f(zr[11 * DG + tid]); u = a / (1.f + __expf(-g)); }
        us[tt * 512 + tid] = u; }
    float w[31];
#pragma unroll
    for (int k = 0; k < 31; ++k) w[k] = p.conv_w[(size_t)(l * 31 + k) * DG + tid];
    const float cb = p.conv_b[l * DG + tid];
    __syncthreads();
    for (int t = 0; t < 16; ++t) { float acc = cb;
#pragma unroll
        for (int k = 0; k < 31; ++k) acc += w[k] * us[(t + k) * 512 + tid];
        ys[t * 512 + tid] = acc; }
    __syncthreads();
#pragma unroll
    for (int tw = 0; tw < 2; ++tw) { const int t = wave + 8 * tw; float v[8]; float s = 0.f;
#pragma unroll
        for (int j = 0; j < 8; ++j) { v[j] = ys[t * 512 + lane + 64 * j]; s += v[j]; }
        const float mu = wave_sum(s) * (1.f / 512.f); float q = 0.f;
#pragma unroll
        for (int j = 0; j < 8; ++j) { v[j] -= mu; q += v[j] * v[j]; }
        const float rstd = rsqrtf(wave_sum(q) * (1.f / 512.f) + 1e-6f);
        bf16* orow = (bf16*)(p.ws + WS_CVH) + (size_t)(b * SEQ + t0 + t) * DG;
#pragma unroll
        for (int j = 0; j < 8; ++j) { const int ch = lane + 64 * j; const float y = v[j] * rstd * p.ln_g[l * DG + ch] + p.ln_b[l * DG + ch]; orow[ch] = (bf16)f2bf(silu_f(y)); } }
    __syncthreads();
}

__device__ __forceinline__ void f1_task(const Params& p, int task, unsigned char* lds) {
    const int tid = otid();
    float* us = (float*)lds; float* cs = us + 8 * 512; float* sn = cs + 128;
    const bf16* Z = (const bf16*)(p.ws + WS_Z);
    const int tok0 = task * 8, b = tok0 >> 12, s0 = tok0 & 4095;
    if (tid < 128) { cs[tid] = cospif((float)tid * (1.f / 64.f)); sn[tid] = sinpif((float)tid * (1.f / 64.f)); }
#pragma unroll
    for (int tk = 0; tk < 8; ++tk) us[tk * 512 + tid] = bf2f(Z[(size_t)(tok0 + tk) * DIN + tid]);
    __syncthreads();
    const int g = tid >> 7, m = tid & 127;
    float P[8], Q[8];
#pragma unroll
    for (int tk = 0; tk < 8; ++tk) { P[tk] = 0.f; Q[tk] = 0.f; }
    for (int c = 0; c < 128; ++c) { const int idx = (m * c) & 127; const float cv = cs[idx], sv = sn[idx];
#pragma unroll
        for (int tk = 0; tk < 8; ++tk) { const float u = us[tk * 512 + g * 128 + c]; P[tk] += u * cv; Q[tk] += u * sv; } }
    const float nrm = 0.0013810679320049757f;
    bf16* PQ = (bf16*)(p.ws + WS_PQT) + ((size_t)(b * 512 + tid) * 2) * 4096 + s0;
    u32x4 o; o.x = pk2(P[0] * nrm, P[1] * nrm); o.y = pk2(P[2] * nrm, P[3] * nrm); o.z = pk2(P[4] * nrm, P[5] * nrm); o.w = pk2(P[6] * nrm, P[7] * nrm);
    *(u32x4*)PQ = o;
    o.x = pk2(Q[0] * nrm, Q[1] * nrm); o.y = pk2(Q[2] * nrm, Q[3] * nrm); o.z = pk2(Q[4] * nrm, Q[5] * nrm); o.w = pk2(Q[6] * nrm, Q[7] * nrm);
    *(u32x4*)(PQ + 4096) = o;
    __syncthreads();
}

__device__ __forceinline__ void ph_mixA(const Params& p, int l, unsigned char* lds) {
    const int G = gridDim.x, bid = blockIdx.x;
    for (int t = bid; t < 512; t += G) ret1_task(p, l, t, lds);
    for (int t = bid; t < 512; t += G) na2_task(p, l, t, lds);
    for (int t = bid; t < 512; t += G) conv_task(p, l, t, lds);
    for (int t = bid; t < 1024; t += G) f1_task(p, t, lds);
}

__device__ __forceinline__ void ph_combine(const Params& p) {
    const float* part = (const float*)(p.ws + WS_U); bf16* Y = (bf16*)(p.ws + WS_Y);
    for (int e = blockIdx.x * NTHR + threadIdx.x; e < MTOK * DG / 4; e += gridDim.x * NTHR) {
        const int row = e >> 7, c4 = (e & 127) * 4, b = row >> 12, k = row & 4095;
        f32x4 s = {0.f, 0.f, 0.f, 0.f};
#pragma unroll
        for (int ks = 0; ks < 4; ++ks) s += *(const f32x4*)(part + ((size_t)((b * 4 + ks) * 4096 + k)) * 512 + c4);
        u32x2 w; w.x = pk2(s[0], s[1]); w.y = pk2(s[2], s[3]);
        *(u32x2*)(Y + (size_t)row * DG + c4) = w;
    }
}

#ifndef REP_PRO
#define REP_PRO 1
#endif
#ifndef REP_NORM
#define REP_NORM 1
#endif
#ifndef REP_Z
#define REP_Z 1
#endif
#ifndef REP_MIX
#define REP_MIX 1
#endif
#ifndef REP_P3
#define REP_P3 1
#endif
#ifndef REP_R2
#define REP_R2 1
#endif
#ifndef REP_CMB
#define REP_CMB 1
#endif
#ifndef REP_FFT
#define REP_FFT 1
#endif
#ifndef REP_OUT
#define REP_OUT 1
#endif
#ifndef REP_SUB
#define REP_SUB 1
#endif

__device__ __forceinline__ void grid_bar(unsigned* bar, unsigned& epoch) {
    asm volatile("s_waitcnt vmcnt(0) lgkmcnt(0)" ::: "memory");
    __syncthreads();
    epoch += 1;
    if (threadIdx.x == 0) {
        __builtin_amdgcn_fence(__ATOMIC_RELEASE, "agent");
        __hip_atomic_fetch_add(bar, 1u, __ATOMIC_RELAXED, __HIP_MEMORY_SCOPE_AGENT);
        const unsigned target = epoch * gridDim.x;
        while (__hip_atomic_load(bar, __ATOMIC_RELAXED, __HIP_MEMORY_SCOPE_AGENT) < target) __builtin_amdgcn_s_sleep(2);
        __builtin_amdgcn_fence(__ATOMIC_ACQUIRE, "agent");
    }
    __syncthreads();
    __builtin_amdgcn_fence(__ATOMIC_ACQUIRE, "agent");
}
constexpr int NPH = 16;
__global__ void __launch_bounds__(NTHR) mega(Params p) {
    extern __shared__ __attribute__((aligned(16))) unsigned char lds[];
    cg::grid_group grid = cg::this_grid();
    PG8_LAS unsigned char* ldsl = (PG8_LAS unsigned char*)lds;
    const int lo = p.ph_lo, hi = p.ph_hi;
#define IN(k) (lo <= (k) && (k) < hi)
#define SEAM(k) do { if (IN(k) && IN((k) + 1)) { grid_bar(gbar, epoch); } } while (0)
#define REPEAT(n) for (int rep_ = 0; rep_ < (n); ++rep_)
    bf16* Zb = (bf16*)(p.ws + WS_Z); bf16* CAT = (bf16*)(p.ws + WS_CAT);
    unsigned* gbar = (unsigned*)(p.ws + WS_BAR); unsigned epoch = 0;
    if (p.ph_lo < 0) grid.sync();
    if (IN(0)) REPEAT(REP_PRO) { ph_prologue(p, lds); __syncthreads(); }
    SEAM(0);
    if (IN(0) && IN(1)) for (int r_ = 1; r_ < REP_SUB; ++r_) grid_bar(gbar, epoch);
#pragma unroll
    for (int l = 0; l < NL; ++l) {
        const int pb = 1 + 7 * l;
        if (IN(pb)) REPEAT(REP_NORM) ph_norm(p, l);
        SEAM(pb);
        if (IN(pb + 1)) REPEAT(REP_Z) {
            SchedS S = make_sched(p.ws + WS_U, DM, p.ws + WS_WIN + (size_t)l * DIN * DM * 2, DM, MTOK, DIN);
            EpiZ E{Zb, DIN};
            pg8::gemm_phase<EpiZ, SchedS, true>(ldsl, pg8::Gemm{DM, DM, DM}, S, E);
        }
        SEAM(pb + 1);
        if (IN(pb + 2)) REPEAT(REP_MIX) ph_mixA(p, l, lds);
        SEAM(pb + 2);
        if (IN(pb + 3)) REPEAT(REP_P3) {
            { SchedDFT S{(const char*)(p.ws + WS_DFT), (const char*)(p.ws + WS_PQT), (int)gridDim.x, (int)blockIdx.x};
              EpiPart E{(float*)(p.ws + WS_U)};
              pg8::gemm_phase<EpiPart, SchedDFT, true>(ldsl, pg8::Gemm{8192, 8192, 2048}, S, E); }
            { SchedS S = make_sched(p.ws + WS_CVH, DG, p.ws + WS_WPW + (size_t)l * DG * DG * 2, DG, MTOK, DG);
              EpiGate E{CAT, Zb, 1536, 12 * DG};
              pg8::gemm_phase<EpiGate, SchedS, true>(ldsl, pg8::Gemm{DG, DG, DG}, S, E); }
            REPEAT(REP_R2) for (int t = blockIdx.x; t < 512; t += gridDim.x) ret2_task(p, l, t, lds);
        }
        SEAM(pb + 3);
        if (IN(pb + 4)) REPEAT(REP_CMB) ph_combine(p);
        SEAM(pb + 4);
        if (IN(pb + 5)) REPEAT(REP_FFT) {
            SchedS S = make_sched(p.ws + WS_Y, DG, p.ws + WS_WFFT + (size_t)l * DG * DG * 2, DG, MTOK, DG);
            EpiGate E{CAT, Zb, 0, 1 * DG};
            pg8::gemm_phase<EpiGate, SchedS, true>(ldsl, pg8::Gemm{DG, DG, DG}, S, E);
        }
        SEAM(pb + 5);
        if (IN(pb + 6)) REPEAT(l == 0 ? REP_OUT : 1) {
            SchedS S = make_sched(CAT, DM, p.ws + WS_WOUT + (size_t)l * DM * DM * 2, DM, MTOK, DM);
            EpiRes E{(l == 0) ? p.x : p.out, p.out, (const float*)(p.ws + WS_MOD) + (size_t)l * 2 * 6144 + 4096};
            pg8::gemm_phase<EpiRes, SchedS, true>(ldsl, pg8::Gemm{DM, DM, DM}, S, E);
        }
        SEAM(pb + 6);
    }
    if (IN(NPH - 1)) ph_final(p);
#undef IN
#undef SEAM
}

extern "C" void kernel_launch(void* const* d_in, const int* in_sizes, int n_in, void* d_out, int out_size, void* d_ws, size_t ws_size, hipStream_t stream) {
    static int grid_blocks = 0;
    if (grid_blocks == 0) {
        if (n_in != 17 || ws_size < WS_END) { fprintf(stderr, "kernel_launch: n_in %d ws %zu (need %zu)\n", n_in, ws_size, (size_t)WS_END); grid_blocks = -1; return; }
        int dev = 0, cus = 0, per_cu = 0;
        hipGetDevice(&dev); hipDeviceGetAttribute(&cus, hipDeviceAttributeMultiprocessorCount, dev);
        if (hipFuncSetAttribute((const void*)mega, hipFuncAttributeMaxDynamicSharedMemorySize, LDS_BYTES) != hipSuccess) { fprintf(stderr, "hipFuncSetAttribute failed\n"); grid_blocks = -1; return; }
        if (hipOccupancyMaxActiveBlocksPerMultiprocessor(&per_cu, (const void*)mega, NTHR, LDS_BYTES) != hipSuccess || per_cu < 1) { fprintf(stderr, "occupancy query: %d\n", per_cu); per_cu = 1; }
        (void)hipGetLastError();
        grid_blocks = cus * 1;
    }
    if (grid_blocks < 0) return;
    Params p{};
    p.x = (const float*)d_in[0]; p.c = (const float*)d_in[1]; p.norm_g = (const float*)d_in[2]; p.w_ada = (const float*)d_in[3]; p.b_ada = (const float*)d_in[4];
    p.w_in = (const float*)d_in[5]; p.w_fft = (const float*)d_in[6]; p.na_bias = (const float*)d_in[7]; p.rl_f = (const float*)d_in[8]; p.rl_b = (const float*)d_in[9];
    p.conv_w = (const float*)d_in[10]; p.conv_b = (const float*)d_in[11]; p.ln_g = (const float*)d_in[12]; p.ln_b = (const float*)d_in[13]; p.w_pw = (const float*)d_in[14];
    p.w_out = (const float*)d_in[15]; p.final_g = (const float*)d_in[16];
    p.out = (float*)d_out; p.ws = (unsigned char*)d_ws;
#if ONE_LAUNCH
    if (hipMemsetAsync((char*)d_ws + WS_BAR, 0, 4096, stream) != hipSuccess) { fprintf(stderr, "memset of the barrier words failed\n"); return; }
    p.ph_lo = 0; p.ph_hi = NPH;
    void* args[] = {&p};
    hipError_t e = hipLaunchCooperativeKernel((const void*)mega, dim3(grid_blocks), dim3(NTHR), args, LDS_BYTES, stream);
    if (e != hipSuccess) fprintf(stderr, "cooperative launch failed: %s (grid %d)\n", hipGetErrorString(e), grid_blocks);
#else
    for (int ph = 0; ph < NPH; ++ph) { p.ph_lo = ph; p.ph_hi = ph + 1; hipLaunchKernelGGL(mega, dim3(grid_blocks), dim3(NTHR), LDS_BYTES, stream, p); }
#endif
}
```

```cpp
#include <hip/hip_runtime.h>
#include <hip/hip_cooperative_groups.h>
#include <cstdio>
#include <cstdint>
namespace cg = cooperative_groups;

#ifndef ONE_LAUNCH
#define ONE_LAUNCH 1
#endif

__device__ __forceinline__ int otid() { int t; asm volatile("v_mov_b32 %0, %1" : "=v"(t) : "v"(threadIdx.x)); return t; }
namespace pg8 {
#define PG8_LAS __attribute__((address_space(3)))
typedef unsigned short bf16_t;
typedef short bf16x8 __attribute__((ext_vector_type(8)));
typedef float f32x4 __attribute__((ext_vector_type(4)));
typedef unsigned u32x4 __attribute__((ext_vector_type(4)));
constexpr int BM = 256, BK = 64, HALF = 128, HTB = HALF * BK * 2, STAGE_BYTES = 8 * HTB, NXCD = 8, WGM = 8;

__host__ __device__ __forceinline__ int lds_byte(int r, int c) { const int st = (r >> 4) * 2 + (c >> 5), rr = r & 15, cc = c & 31, ob = rr * 64 + cc * 2; return st * 1024 + (ob ^ (((ob >> 9) & 1) << 5)); }
__host__ __device__ __forceinline__ void stage_rc(int b, int& R, int& C) { const int st = b / 1024, sb = b % 1024, swz = sb ^ (((sb >> 9) & 1) << 5); R = (st >> 1) * 16 + swz / 64; C = (st & 1) * 32 + (swz % 64) / 2; }
__host__ __device__ __forceinline__ int perm32(int rho) { const int n = rho >> 4, i = rho & 15; return 8 * (i >> 2) + 4 * n + (i & 3); }

struct Unit { int pm, pn, aux, pad; const char* A; const char* B; };
struct Gemm { int lda, ldb, K; };

struct StaticOrder {
    int nM, nN, nwg, G, c;
    __host__ __device__ void init(int M, int N, int G_, int c_) { nM = M / BM; nN = N / BM; nwg = nM * nN; G = G_; c = c_; }
    __device__ bool next(int i, Unit& u) const {
        const long L = (long)i * G + c; if (L >= nwg) return false;
        int wgid = __builtin_amdgcn_readfirstlane((int)L); { const int q = nwg / NXCD, r = nwg % NXCD, xcd = wgid % NXCD, off = wgid / NXCD; wgid = (xcd < r ? xcd * (q + 1) : r * (q + 1) + (xcd - r) * q) + off; }
        const int nig = WGM * nN, gid = wgid / nig, fm = gid * WGM, gsz = (nM - fm) < WGM ? (nM - fm) : WGM;
        u.pm = __builtin_amdgcn_readfirstlane(fm + ((wgid % nig) % gsz)); u.pn = __builtin_amdgcn_readfirstlane((wgid % nig) / gsz); return true;
    }
};

__device__ __forceinline__ unsigned cvt_pk_bf16(float lo, float hi) { unsigned r; asm volatile("v_cvt_pk_bf16_f32 %0, %1, %2" : "=v"(r) : "v"(lo), "v"(hi)); return r; }

template <class Epi, class Sched, bool ALIGN_EPI>
__device__ __forceinline__ void gemm_phase(PG8_LAS unsigned char* lds, const Gemm g, const Sched& S, const Epi& E) {
    const int tid = otid(), wid = __builtin_amdgcn_readfirstlane(tid >> 6), lane = tid & 63, wr = wid >> 2, wc = wid & 3, fr = lane & 15, fq = lane >> 4;
    const int K = g.K, nt = K / BK;
    unsigned voffA[2], voffB[2];
#pragma unroll
    for (int i = 0; i < 2; ++i) { int R, C; stage_rc(tid * 16 + i * 8192, R, C); const int Rb = Epi::PERM ? ((R & ~31) + perm32(R & 31)) : R;
        voffA[i] = (unsigned)(R * g.lda + C) * 2u; voffB[i] = (unsigned)(Rb * g.ldb + C) * 2u; }
    const size_t kstep = (size_t)(BK * 2);
    const size_t hA = (size_t)HALF * g.lda * 2, hB = (size_t)HALF * g.ldb * 2;
    const unsigned ldsw = (unsigned)wid * 1024u;
    const int aoff = lds_byte(wr * 64 + fr, fq * 8), boff = lds_byte(wc * 32 + fr, fq * 8);
#define PG8_SA(b, h) (((b) * 2 + (h)) * HTB)
#define PG8_SB(b, h) ((4 + (b) * 2 + (h)) * HTB)
#define PG8_STAGE(bufoff, gbase, voff) do { _Pragma("unroll") for (int _i = 0; _i < 2; ++_i) \
        __builtin_amdgcn_global_load_lds((const unsigned*)((const char*)(gbase) + (voff)[_i]), (PG8_LAS unsigned*)(lds + (bufoff) + ldsw + _i * 8192), 16, 0, 0); } while (0)
#define PG8_LDA(dst, b, h) do { _Pragma("unroll") for (int m = 0; m < 4; ++m) _Pragma("unroll") for (int k = 0; k < 2; ++k) dst[m][k] = *(const PG8_LAS bf16x8*)(lds + PG8_SA(b, h) + aoff + m * 2048 + k * 1024); } while (0)
#define PG8_LDB(dst, b, h) do { _Pragma("unroll") for (int n = 0; n < 2; ++n) _Pragma("unroll") for (int k = 0; k < 2; ++k) dst[n][k] = *(const PG8_LAS bf16x8*)(lds + PG8_SB(b, h) + boff + n * 2048 + k * 1024); } while (0)
#define PG8_MMA(ai, bj, At, Bt) do { __builtin_amdgcn_s_setprio(1); _Pragma("unroll") for (int m = 0; m < 4; ++m) _Pragma("unroll") for (int n = 0; n < 2; ++n) _Pragma("unroll") for (int k = 0; k < 2; ++k) \
        acc[ai][bj][m][n] = __builtin_amdgcn_mfma_f32_16x16x32_bf16(Bt[n][k], At[m][k], acc[ai][bj][m][n], 0, 0, 0); __builtin_amdgcn_s_setprio(0); } while (0)
#define PG8_WAIT_V(n) asm volatile("s_waitcnt vmcnt(" #n ")" ::: "memory")
#define PG8_WAIT_L(n) asm volatile("s_waitcnt lgkmcnt(" #n ")" ::: "memory")
#define PG8_BAR __builtin_amdgcn_s_barrier()
#define PG8_SCHED __builtin_amdgcn_sched_barrier(0)
    Unit cur, nxt; int ui = 0;
    if (!S.next(0, cur)) return;
    f32x4 acc[2][2][4][2];
#pragma unroll
    for (int a = 0; a < 2; ++a)
#pragma unroll
        for (int b = 0; b < 2; ++b)
#pragma unroll
            for (int m = 0; m < 4; ++m)
#pragma unroll
                for (int n = 0; n < 2; ++n) acc[a][b][m][n] = (f32x4){0.f, 0.f, 0.f, 0.f};
    bf16x8 At[4][2], B0[2][2], B1[2][2];
    const char* cA = cur.A; const char* cB = cur.B;
    PG8_STAGE(PG8_SB(0, 0), cB, voffB); PG8_STAGE(PG8_SB(0, 1), cB + hB, voffB); PG8_STAGE(PG8_SA(0, 0), cA, voffA); PG8_STAGE(PG8_SA(0, 1), cA + hA, voffA);
    if (wr == 1) PG8_BAR;
    PG8_WAIT_V(2); PG8_BAR;
    PG8_STAGE(PG8_SB(1, 0), cB + kstep, voffB); PG8_STAGE(PG8_SA(1, 0), cA + kstep, voffA); PG8_STAGE(PG8_SB(1, 1), cB + hB + kstep, voffB);
    PG8_WAIT_V(6); PG8_BAR;
    for (;;) {
        const bool has_next = S.next(ui + 1, nxt);
        const char* nA = has_next ? nxt.A : cA; const char* nB = has_next ? nxt.B : cB;
        for (int t = 0; t < nt; t += 2) {
            const bool last = (t == nt - 2);
            const char* a1 = cA + (size_t)(t + 1) * kstep;
            const char* a2 = last ? nA : cA + (size_t)(t + 2) * kstep; const char* b2 = last ? nB : cB + (size_t)(t + 2) * kstep;
            const char* a3 = a2 + kstep; const char* b3 = b2 + kstep;
            PG8_LDB(B0, 0, 0); PG8_LDB(B1, 0, 1); PG8_SCHED; PG8_LDA(At, 0, 0); PG8_STAGE(PG8_SA(1, 1), a1 + hA, voffA);
            PG8_WAIT_V(8); PG8_WAIT_L(0); PG8_BAR; PG8_MMA(0, 0, At, B0); PG8_MMA(0, 1, At, B1); PG8_BAR; PG8_SCHED;
            PG8_LDA(At, 0, 1); PG8_STAGE(PG8_SB(0, 0), b2, voffB); PG8_STAGE(PG8_SB(0, 1), b2 + hB, voffB); PG8_STAGE(PG8_SA(0, 0), a2, voffA);
            PG8_WAIT_V(8); PG8_WAIT_L(0); PG8_BAR; PG8_MMA(1, 0, At, B0); PG8_MMA(1, 1, At, B1); PG8_BAR; PG8_SCHED;
            PG8_LDB(B0, 1, 0); PG8_LDB(B1, 1, 1); PG8_SCHED; PG8_LDA(At, 1, 0); PG8_STAGE(PG8_SA(0, 1), a2 + hA, voffA);
            PG8_WAIT_V(8); PG8_WAIT_L(0); PG8_BAR; PG8_MMA(0, 0, At, B0); PG8_MMA(0, 1, At, B1); PG8_BAR; PG8_SCHED;
            PG8_LDA(At, 1, 1); PG8_STAGE(PG8_SB(1, 0), b3, voffB); PG8_STAGE(PG8_SB(1, 1), b3 + hB, voffB); PG8_STAGE(PG8_SA(1, 0), a3, voffA);
            PG8_WAIT_V(8); PG8_WAIT_L(0); PG8_BAR; PG8_MMA(1, 0, At, B0); PG8_MMA(1, 1, At, B1); PG8_BAR; PG8_SCHED;
        }
        if constexpr (ALIGN_EPI) { if (wr == 0) PG8_BAR; }
        E(acc, cur, wr, wc, fr, fq);
        if (!has_next) break;
#pragma unroll
        for (int a = 0; a < 2; ++a)
#pragma unroll
            for (int b = 0; b < 2; ++b)
#pragma unroll
                for (int m = 0; m < 4; ++m)
#pragma unroll
                    for (int n = 0; n < 2; ++n) acc[a][b][m][n] = (f32x4){0.f, 0.f, 0.f, 0.f};
        cur = nxt; cA = nA; cB = nB; ++ui;
        if constexpr (ALIGN_EPI) { if (wr == 1) PG8_BAR; }
    }
    PG8_WAIT_V(0);
    if constexpr (!ALIGN_EPI) { if (wr == 0) PG8_BAR; }
    PG8_BAR;
#undef PG8_SA
#undef PG8_SB
#undef PG8_STAGE
#undef PG8_LDA
#undef PG8_LDB
#undef PG8_MMA
#undef PG8_WAIT_V
#undef PG8_WAIT_L
#undef PG8_BAR
#undef PG8_SCHED
}
}

typedef unsigned short bf16;
typedef float f32x4 __attribute__((ext_vector_type(4)));
typedef unsigned u32x4 __attribute__((ext_vector_type(4)));
typedef unsigned u32x2 __attribute__((ext_vector_type(2)));
constexpr int NB = 2, SEQ = 4096, DM = 2048, MTOK = NB * SEQ, DIN = 6656, DG = 512, NL = 2;
constexpr int LDS_BYTES = 147456;
constexpr int NTHR = 512;

constexpr size_t WS_WIN = 0;
constexpr size_t WS_WOUT = WS_WIN + (size_t)NL * DIN * DM * 2;
constexpr size_t WS_WFFT = WS_WOUT + (size_t)NL * DM * DM * 2;
constexpr size_t WS_WPW = WS_WFFT + (size_t)NL * DG * DG * 2;
constexpr size_t WS_DFT = WS_WPW + (size_t)NL * DG * DG * 2;
constexpr size_t WS_ROPE = WS_DFT + (size_t)SEQ * 2 * SEQ * 2;
constexpr size_t WS_MOD = WS_ROPE + (size_t)SEQ * 32 * 8;
constexpr size_t WS_U = WS_MOD + 131072;
constexpr size_t WS_Z = WS_U + (size_t)4 * MTOK * DG * 4;
constexpr size_t WS_PQT = WS_Z + (size_t)MTOK * DIN * 2;
constexpr size_t WS_Y = WS_PQT + (size_t)NB * DG * 2 * SEQ * 2;
constexpr size_t WS_CVH = WS_Y + (size_t)MTOK * DG * 2;
constexpr size_t WS_CAT = WS_CVH + (size_t)MTOK * DG * 2;
constexpr size_t WS_KV = WS_CAT + (size_t)MTOK * DM * 2;
constexpr size_t WS_BAR = WS_KV + (size_t)2 * NB * 8 * 32 * 4096 * 4;
constexpr size_t WS_END = WS_BAR + 16384;

struct Params {
    const float* x; const float* c; const float* norm_g; const float* w_ada; const float* b_ada; const float* w_in; const float* w_fft; const float* na_bias;
    const float* rl_f; const float* rl_b; const float* conv_w; const float* conv_b; const float* ln_g; const float* ln_b; const float* w_pw; const float* w_out; const float* final_g;
    float* out; unsigned char* ws; int ph_lo, ph_hi;
};

__device__ __forceinline__ unsigned f2bf(float f) { unsigned u = __float_as_uint(f); return (u + 0x7fffu + ((u >> 16) & 1u)) >> 16; }
__device__ __forceinline__ unsigned pk2(float lo, float hi) { return f2bf(lo) | (f2bf(hi) << 16); }
__device__ __forceinline__ float bf2f(bf16 b) { return __uint_as_float((unsigned)b << 16); }
__device__ __forceinline__ float bflo(unsigned u) { return __uint_as_float(u << 16); }
__device__ __forceinline__ float bfhi(unsigned u) { return __uint_as_float(u & 0xffff0000u); }
__device__ __forceinline__ float silu_f(float v) { return v / (1.f + __expf(-v)); }
__device__ __forceinline__ float wave_sum(float v) {
#pragma unroll
    for (int o = 1; o < 64; o <<= 1) v += __shfl_xor(v, o);
    return v;
}
__device__ __forceinline__ float wave_max(float v) {
#pragma unroll
    for (int o = 1; o < 64; o <<= 1) v = fmaxf(v, __shfl_xor(v, o));
    return v;
}

struct SchedS {
    pg8::StaticOrder o; const char* A; const char* B; size_t ta, tb;
    __device__ __forceinline__ bool next(int i, pg8::Unit& u) const { if (!o.next(i, u)) return false; u.A = A + (size_t)u.pm * ta; u.B = B + (size_t)u.pn * tb; u.aux = 0; return true; }
};
__device__ __forceinline__ SchedS make_sched(const void* A, int lda, const void* B, int ldb, int M, int N) {
    SchedS s; s.o.init(M, N, (int)gridDim.x, (int)blockIdx.x); s.A = (const char*)A; s.B = (const char*)B; s.ta = (size_t)256 * lda * 2; s.tb = (size_t)256 * ldb * 2; return s;
}
struct SchedDFT {
    const char* A; const char* B; int G, c;
    __device__ __forceinline__ bool next(int i, pg8::Unit& u) const {
        const int L = __builtin_amdgcn_readfirstlane(i * G + c); if (L >= 256) return false;
        const int sub = L >> 5, t = L & 31; u.pm = t >> 1; u.pn = t & 1; u.aux = sub;
        u.A = A + (size_t)((u.pm << 22) + ((sub & 3) << 12)); u.B = B + (size_t)(((sub >> 2) << 23) + (u.pn << 22) + ((sub & 3) << 12)); return true;
    }
};

struct EpiZ {
    static constexpr bool PERM = true;
    bf16* O; int ldc;
    __device__ __forceinline__ void operator()(const pg8::f32x4 (&acc)[2][2][4][2], const pg8::Unit& u, int wr, int wc, int fr, int fq) const {
        const int row0 = u.pm * 256 + wr * 64 + fr, col0 = u.pn * 256 + wc * 32 + 8 * fq;
#pragma unroll
        for (int ai = 0; ai < 2; ++ai)
#pragma unroll
            for (int m = 0; m < 4; ++m) { bf16* rowp = O + (size_t)(row0 + ai * 128 + m * 16) * ldc + col0;
#pragma unroll
                for (int bj = 0; bj < 2; ++bj) { const pg8::f32x4 v0 = acc[ai][bj][m][0], v1 = acc[ai][bj][m][1]; u32x4 w;
                    w.x = pg8::cvt_pk_bf16(v0[0], v0[1]); w.y = pg8::cvt_pk_bf16(v0[2], v0[3]); w.z = pg8::cvt_pk_bf16(v1[0], v1[1]); w.w = pg8::cvt_pk_bf16(v1[2], v1[3]);
                    *(u32x4*)(rowp + bj * 128) = w; } }
    }
};
struct EpiGate {
    static constexpr bool PERM = true;
    bf16* O; const bf16* Z; int coff, goff;
    __device__ __forceinline__ void operator()(const pg8::f32x4 (&acc)[2][2][4][2], const pg8::Unit& u, int wr, int wc, int fr, int fq) const {
        const int row0 = u.pm * 256 + wr * 64 + fr, col0 = u.pn * 256 + wc * 32 + 8 * fq;
#pragma unroll
        for (int ai = 0; ai < 2; ++ai)
#pragma unroll
            for (int m = 0; m < 4; ++m) { const size_t row = (size_t)(row0 + ai * 128 + m * 16);
#pragma unroll
                for (int bj = 0; bj < 2; ++bj) { const pg8::f32x4 v0 = acc[ai][bj][m][0], v1 = acc[ai][bj][m][1];
                    const u32x4 gz = *(const u32x4*)(Z + row * DIN + goff + col0 + bj * 128); u32x4 w;
                    w.x = pg8::cvt_pk_bf16(v0[0] * silu_f(bflo(gz.x)), v0[1] * silu_f(bfhi(gz.x))); w.y = pg8::cvt_pk_bf16(v0[2] * silu_f(bflo(gz.y)), v0[3] * silu_f(bfhi(gz.y)));
                    w.z = pg8::cvt_pk_bf16(v1[0] * silu_f(bflo(gz.z)), v1[1] * silu_f(bfhi(gz.z))); w.w = pg8::cvt_pk_bf16(v1[2] * silu_f(bflo(gz.w)), v1[3] * silu_f(bfhi(gz.w)));
                    *(u32x4*)(O + row * DM + coff + col0 + bj * 128) = w; } }
    }
};
struct EpiPart {
    static constexpr bool PERM = false;
    float* P;
    __device__ __forceinline__ void operator()(const pg8::f32x4 (&acc)[2][2][4][2], const pg8::Unit& u, int wr, int wc, int fr, int fq) const {
        const int row0 = u.pm * 256 + wr * 64 + fr, col0 = u.pn * 256 + wc * 32 + 4 * fq;
        float* base = P + (size_t)u.aux * 4096 * 512;
#pragma unroll
        for (int ai = 0; ai < 2; ++ai)
#pragma unroll
            for (int m = 0; m < 4; ++m) { float* rowp = base + (size_t)(row0 + ai * 128 + m * 16) * 512 + col0;
#pragma unroll
                for (int bj = 0; bj < 2; ++bj)
#pragma unroll
                    for (int n = 0; n < 2; ++n) *(pg8::f32x4*)(rowp + bj * 128 + n * 16) = acc[ai][bj][m][n]; }
    }
};
struct EpiRes {
    static constexpr bool PERM = false;
    const float* xin; float* xout; const float* gate;
    __device__ __forceinline__ void operator()(const pg8::f32x4 (&acc)[2][2][4][2], const pg8::Unit& u, int wr, int wc, int fr, int fq) const {
        const int row0 = u.pm * 256 + wr * 64 + fr, col0 = u.pn * 256 + wc * 32 + 4 * fq;
        const float* gp = gate + (size_t)(u.pm >> 4) * 6144 + col0;
        pg8::f32x4 gv[2][2];
#pragma unroll
        for (int bj = 0; bj < 2; ++bj)
#pragma unroll
            for (int n = 0; n < 2; ++n) gv[bj][n] = *(const pg8::f32x4*)(gp + bj * 128 + n * 16);
#pragma unroll
        for (int ai = 0; ai < 2; ++ai)
#pragma unroll
            for (int m = 0; m < 4; ++m) { const size_t ro = (size_t)(row0 + ai * 128 + m * 16) * DM + col0;
#pragma unroll
                for (int bj = 0; bj < 2; ++bj)
#pragma unroll
                    for (int n = 0; n < 2; ++n) { const pg8::f32x4 xi = *(const pg8::f32x4*)(xin + ro + bj * 128 + n * 16);
                        *(pg8::f32x4*)(xout + ro + bj * 128 + n * 16) = xi + gv[bj][n] * acc[ai][bj][m][n]; } }
    }
};

__device__ __forceinline__ void transpose_tile(const float* W, int K, int N, bf16* WT, int item, float* scr) {
    const int tid = otid(), nb = N / 64, kb = item / nb, nbk = item % nb, k0 = kb * 64, n0 = nbk * 64;
#pragma unroll
    for (int i = 0; i < 2; ++i) { const int kk = (tid >> 4) + 32 * i, nn = (tid & 15) * 4;
        const f32x4 v = *(const f32x4*)(W + (size_t)(k0 + kk) * N + n0 + nn);
        scr[kk * 65 + nn] = v[0]; scr[kk * 65 + nn + 1] = v[1]; scr[kk * 65 + nn + 2] = v[2]; scr[kk * 65 + nn + 3] = v[3]; }
    __syncthreads();
    { const int n = tid >> 3, kc = (tid & 7) * 8; const float* s = scr + kc * 65 + n; u32x4 o;
      o.x = pk2(s[0], s[65]); o.y = pk2(s[2 * 65], s[3 * 65]); o.z = pk2(s[4 * 65], s[5 * 65]); o.w = pk2(s[6 * 65], s[7 * 65]);
      *(u32x4*)(WT + (size_t)(n0 + n) * K + k0 + kc) = o; }
    __syncthreads();
}

__device__ __forceinline__ void ph_prologue(const Params& p, unsigned char* lds) {
    const int tid = otid(), lane = tid & 63, wave = tid >> 6, G = gridDim.x, bid = blockIdx.x;
    float* scr = (float*)lds;
    bf16* Wt_in = (bf16*)(p.ws + WS_WIN); bf16* Wt_out = (bf16*)(p.ws + WS_WOUT); bf16* Wt_fft = (bf16*)(p.ws + WS_WFFT); bf16* Wt_pw = (bf16*)(p.ws + WS_WPW);
    constexpr int T_IN = 32 * 104, T_OUT = 32 * 32, T_S = 64, T_L = T_IN + T_OUT + 2 * T_S;
    for (int it = bid; it < NL * T_L; it += G) {
        const int l = it / T_L; int r = it % T_L;
        if (r < T_IN) { transpose_tile(p.w_in + (size_t)l * DM * DIN, DM, DIN, Wt_in + (size_t)l * DIN * DM, r, scr); continue; } r -= T_IN;
        if (r < T_OUT) { transpose_tile(p.w_out + (size_t)l * DM * DM, DM, DM, Wt_out + (size_t)l * DM * DM, r, scr); continue; } r -= T_OUT;
        if (r < T_S) { transpose_tile(p.w_fft + (size_t)l * DG * DG, DG, DG, Wt_fft + (size_t)l * DG * DG, r, scr); continue; } r -= T_S;
        transpose_tile(p.w_pw + (size_t)l * DG * DG, DG, DG, Wt_pw + (size_t)l * DG * DG, r, scr);
    }
    float* cosT = (float*)(lds + 32768); float* sinT = (float*)(lds + 49152); float* ca = (float*)(lds + 65536); float* red = (float*)(lds + 81920);
    for (int j = tid; j < 4096; j += NTHR) { cosT[j] = cospif((float)j * (1.f / 2048.f)); sinT[j] = sinpif((float)j * (1.f / 2048.f)); }
    for (int j = tid; j < 4096; j += NTHR) { const float cv = p.c[j]; ca[j] = cv / (1.f + expf(-cv)); }
    __syncthreads();
    bf16* DFT = (bf16*)(p.ws + WS_DFT);
    for (int k = bid; k < 4096; k += G) {
#pragma unroll
        for (int cc = 0; cc < 2; ++cc) { const int kk0 = (tid + cc * NTHR) * 8; float v[8];
#pragma unroll
            for (int j = 0; j < 8; ++j) { const int kk = kk0 + j, idx = (k * (kk & 4095)) & 4095; v[j] = (kk < 4096) ? cosT[idx] : -sinT[idx]; }
            u32x4 o; o.x = pk2(v[0], v[1]); o.y = pk2(v[2], v[3]); o.z = pk2(v[4], v[5]); o.w = pk2(v[6], v[7]);
            *(u32x4*)(DFT + (size_t)k * 8192 + kk0) = o; }
    }
    { float2* rope = (float2*)(p.ws + WS_ROPE);
      for (int e = bid * NTHR + tid; e < 4096 * 32; e += G * NTHR) { const int s = e >> 5, i = e & 31;
          const float inv = (float)pow(10000.0, -(double)i / 32.0); const float ang = (float)s * inv;
          double sn, cs; sincos((double)ang, &sn, &cs); rope[e] = make_float2((float)cs, (float)sn); } }
    float* mod = (float*)(p.ws + WS_MOD);
    for (int t = bid; t < 192; t += G) {
        const int l = t / 96, col = (t % 96) * 64 + lane; const float* W = p.w_ada + (size_t)l * DM * 6144 + col;
        float a0 = 0.f, a1 = 0.f;
#pragma unroll 8
        for (int k = wave * 256; k < wave * 256 + 256; ++k) { const float w = W[(size_t)k * 6144]; a0 += ca[k] * w; a1 += ca[2048 + k] * w; }
        red[(wave * 2 + 0) * 64 + lane] = a0; red[(wave * 2 + 1) * 64 + lane] = a1;
        __syncthreads();
        if (wave < 2) { float s = 0.f;
#pragma unroll
            for (int w = 0; w < 8; ++w) s += red[(w * 2 + wave) * 64 + lane];
            mod[(size_t)(l * 2 + wave) * 6144 + col] = s + p.b_ada[l * 6144 + col]; }
        __syncthreads();
    }
}

__device__ __forceinline__ void ph_norm(const Params& p, int l) {
    const int tid = otid(), lane = tid & 63, wave = tid >> 6;
    const float* xin = (l == 0) ? p.x : p.out; bf16* h = (bf16*)(p.ws + WS_U); const float* mod = (const float*)(p.ws + WS_MOD);
    for (int row = blockIdx.x * 8 + wave; row < MTOK; row += gridDim.x * 8) {
        const f32x4* xr = (const f32x4*)(xin + (size_t)row * DM) + lane; f32x4 v[8]; float ss = 0.f;
#pragma unroll
        for (int j = 0; j < 8; ++j) { v[j] = xr[64 * j]; ss += (v[j][0] * v[j][0] + v[j][1] * v[j][1]) + (v[j][2] * v[j][2] + v[j][3] * v[j][3]); }
        ss = wave_sum(ss); const float rstd = rsqrtf(ss * (1.f / DM) + 1e-6f);
        const float* md = mod + (size_t)(l * 2 + (row >> 12)) * 6144; const float* g = p.norm_g + l * DM;
#pragma unroll
        for (int j = 0; j < 8; ++j) { const int col = (64 * j + lane) * 4;
            const f32x4 g4 = *(const f32x4*)(g + col), sh = *(const f32x4*)(md + col), sc = *(const f32x4*)(md + 2048 + col);
            const f32x4 o = (v[j] * rstd * g4) * (sc + 1.f) + sh; u32x2 w; w.x = pk2(o[0], o[1]); w.y = pk2(o[2], o[3]);
            *(u32x2*)(h + (size_t)row * DM + col) = w; }
    }
}
__device__ __forceinline__ void ph_final(const Params& p) {
    const int tid = otid(), lane = tid & 63, wave = tid >> 6;
    for (int row = blockIdx.x * 8 + wave; row < MTOK; row += gridDim.x * 8) {
        f32x4* xr = (f32x4*)(p.out + (size_t)row * DM) + lane; f32x4 v[8]; float ss = 0.f;
#pragma unroll
        for (int j = 0; j < 8; ++j) { v[j] = xr[64 * j]; ss += (v[j][0] * v[j][0] + v[j][1] * v[j][1]) + (v[j][2] * v[j][2] + v[j][3] * v[j][3]); }
        ss = wave_sum(ss); const float rstd = rsqrtf(ss * (1.f / DM) + 1e-6f);
#pragma unroll
        for (int j = 0; j < 8; ++j) { const int col = (64 * j + lane) * 4; const f32x4 g4 = *(const f32x4*)(p.final_g + col); xr[64 * j] = v[j] * rstd * g4; }
    }
}

typedef short bf16x8v __attribute__((ext_vector_type(8)));
__device__ __forceinline__ bf16x8v mk8(unsigned a, unsigned b, unsigned c, unsigned d) { u32x4 v = {a, b, c, d}; return __builtin_bit_cast(bf16x8v, v); }
#define MFMA16(a, b, c) __builtin_amdgcn_mfma_f32_16x16x32_bf16(a, b, c, 0, 0, 0)
constexpr int R_QS = 0, R_KS = 18432, R_VT = 36864, R_KTF = 54272, R_KTB = 71680, R_STF = 89088, R_STB = 98304;

template <bool R2>
__device__ __forceinline__ void ret_stage(const Params& p, int b, int h, int n, unsigned char* lds, float l2f, float l2b) {
    const int tid = otid(), j = tid >> 2, c4 = tid & 3, s = n * 128 + j;
    const bf16* Z = (const bf16*)(p.ws + WS_Z); const bf16* zr = Z + (size_t)(b * SEQ + s) * DIN;
    const f32x4* rp = (const f32x4*)((const float2*)(p.ws + WS_ROPE) + s * 32 + c4 * 8);
    float cs[8], sn[8];
#pragma unroll
    for (int i = 0; i < 4; ++i) { const f32x4 r = rp[i]; cs[2 * i] = r[0]; sn[2 * i] = r[1]; cs[2 * i + 1] = r[2]; sn[2 * i + 1] = r[3]; }
    bf16* KS = (bf16*)(lds + R_KS); bf16* VT = (bf16*)(lds + R_VT);
    { const u32x4 ka = *(const u32x4*)(zr + 7 * DG + h * 64 + c4 * 8), kb = *(const u32x4*)(zr + 7 * DG + h * 64 + 32 + c4 * 8);
      const unsigned kau[4] = {ka.x, ka.y, ka.z, ka.w}, kbu[4] = {kb.x, kb.y, kb.z, kb.w};
      float k1[8], k2[8];
#pragma unroll
      for (int i = 0; i < 4; ++i) { const float a0 = bflo(kau[i]), a1 = bfhi(kau[i]), b0 = bflo(kbu[i]), b1 = bfhi(kbu[i]);
          k1[2 * i] = a0 * cs[2 * i] - b0 * sn[2 * i]; k2[2 * i] = a0 * sn[2 * i] + b0 * cs[2 * i];
          k1[2 * i + 1] = a1 * cs[2 * i + 1] - b1 * sn[2 * i + 1]; k2[2 * i + 1] = a1 * sn[2 * i + 1] + b1 * cs[2 * i + 1]; }
      u32x4 o1, o2; o1.x = pk2(k1[0], k1[1]); o1.y = pk2(k1[2], k1[3]); o1.z = pk2(k1[4], k1[5]); o1.w = pk2(k1[6], k1[7]);
      o2.x = pk2(k2[0], k2[1]); o2.y = pk2(k2[2], k2[3]); o2.z = pk2(k2[4], k2[5]); o2.w = pk2(k2[6], k2[7]);
      *(u32x4*)(KS + j * 72 + c4 * 8) = o1; *(u32x4*)(KS + j * 72 + 32 + c4 * 8) = o2;
      if (!R2) { bf16* KTF = (bf16*)(lds + R_KTF); bf16* KTB = (bf16*)(lds + R_KTB);
          const float df = exp2f(l2f * (float)(127 - j)), db = exp2f(l2b * (float)j);
#pragma unroll
          for (int i = 0; i < 8; ++i) { KTF[(c4 * 8 + i) * 136 + j] = (bf16)f2bf(k1[i] * df); KTF[(32 + c4 * 8 + i) * 136 + j] = (bf16)f2bf(k2[i] * df);
              KTB[(c4 * 8 + i) * 136 + j] = (bf16)f2bf(k1[i] * db); KTB[(32 + c4 * 8 + i) * 136 + j] = (bf16)f2bf(k2[i] * db); } } }
    { const u32x4 va = *(const u32x4*)(zr + 8 * DG + h * 64 + c4 * 16), vb = *(const u32x4*)(zr + 8 * DG + h * 64 + c4 * 16 + 8);
      const unsigned vu[8] = {va.x, va.y, va.z, va.w, vb.x, vb.y, vb.z, vb.w};
#pragma unroll
      for (int i = 0; i < 8; ++i) { VT[(c4 * 16 + 2 * i) * 136 + j] = (bf16)(vu[i] & 0xffffu); VT[(c4 * 16 + 2 * i + 1) * 136 + j] = (bf16)(vu[i] >> 16); } }
    if (R2) { bf16* QS = (bf16*)(lds + R_QS);
      const u32x4 qa = *(const u32x4*)(zr + 6 * DG + h * 64 + c4 * 8), qb = *(const u32x4*)(zr + 6 * DG + h * 64 + 32 + c4 * 8);
      const unsigned qau[4] = {qa.x, qa.y, qa.z, qa.w}, qbu[4] = {qb.x, qb.y, qb.z, qb.w};
      float q1[8], q2[8];
#pragma unroll
      for (int i = 0; i < 4; ++i) { const float a0 = bflo(qau[i]), a1 = bfhi(qau[i]), b0 = bflo(qbu[i]), b1 = bfhi(qbu[i]);
          q1[2 * i] = (a0 * cs[2 * i] - b0 * sn[2 * i]) * 0.125f; q2[2 * i] = (a0 * sn[2 * i] + b0 * cs[2 * i]) * 0.125f;
          q1[2 * i + 1] = (a1 * cs[2 * i + 1] - b1 * sn[2 * i + 1]) * 0.125f; q2[2 * i + 1] = (a1 * sn[2 * i + 1] + b1 * cs[2 * i + 1]) * 0.125f; }
      u32x4 o1, o2; o1.x = pk2(q1[0], q1[1]); o1.y = pk2(q1[2], q1[3]); o1.z = pk2(q1[4], q1[5]); o1.w = pk2(q1[6], q1[7]);
      o2.x = pk2(q2[0], q2[1]); o2.y = pk2(q2[2], q2[3]); o2.z = pk2(q2[4], q2[5]); o2.w = pk2(q2[6], q2[7]);
      *(u32x4*)(QS + j * 72 + c4 * 8) = o1; *(u32x4*)(QS + j * 72 + 32 + c4 * 8) = o2; }
}

__device__ __forceinline__ void ret1_task(const Params& p, int l, int task, unsigned char* lds) {
    const int n = task & 31, h = (task >> 5) & 7, b = task >> 8;
    const float xf = p.rl_f[l * 8 + h], xb = p.rl_b[l * 8 + h];
    const float l2f = -log1pf(expf(-xf)) * 1.4426950408889634f, l2b = -log1pf(expf(-xb)) * 1.4426950408889634f;
    ret_stage<false>(p, b, h, n, lds, l2f, l2b);
    __syncthreads();
    const int tid = otid(), lane = tid & 63, w = tid >> 6, fr = lane & 15, fq = lane >> 4, dir = w >> 2, et = w & 3;
    const bf16* VT = (const bf16*)(lds + R_VT); const bf16* KT = (const bf16*)(lds + (dir ? R_KTB : R_KTF));
    bf16x8v a[4];
#pragma unroll
    for (int ks = 0; ks < 4; ++ks) a[ks] = *(const bf16x8v*)(VT + (16 * et + fr) * 136 + 32 * ks + 8 * fq);
    float* dst = (float*)(p.ws + WS_KV) + ((size_t)((dir * 2 + b) * 8 + h) * 32 + n) * 4096;
#pragma unroll
    for (int dt = 0; dt < 4; ++dt) { f32x4 acc = {0.f, 0.f, 0.f, 0.f};
#pragma unroll
        for (int ks = 0; ks < 4; ++ks) { const bf16x8v bfr = *(const bf16x8v*)(KT + (16 * dt + fr) * 136 + 32 * ks + 8 * fq); acc = MFMA16(a[ks], bfr, acc); }
#pragma unroll
        for (int r = 0; r < 4; ++r) dst[(16 * et + 4 * fq + r) * 64 + 16 * dt + fr] = acc[r]; }
    __syncthreads();
}

__device__ __forceinline__ void ret2_task(const Params& p, int l, int task, unsigned char* lds) {
    const int n = task & 31, h = (task >> 5) & 7, b = task >> 8;
    const float xf = p.rl_f[l * 8 + h], xb = p.rl_b[l * 8 + h];
    const float l2f = -log1pf(expf(-xf)) * 1.4426950408889634f, l2b = -log1pf(expf(-xb)) * 1.4426950408889634f;
    ret_stage<true>(p, b, h, n, lds, l2f, l2b);
    const int tid = otid(), lane = tid & 63, w = tid >> 6, fr = lane & 15, fq = lane >> 4;
    {
      const float gfC = exp2f(l2f * 128.f), gbC = exp2f(l2b * 128.f);
      const float* KVf = (const float*)(p.ws + WS_KV) + ((size_t)((0 * 2 + b) * 8 + h) * 32) * 4096 + tid * 8;
      const float* KVb = (const float*)(p.ws + WS_KV) + ((size_t)((1 * 2 + b) * 8 + h) * 32) * 4096 + tid * 8;
      f32x4 f0 = {0.f, 0.f, 0.f, 0.f}, f1 = f0, g0 = f0, g1 = f0; float cf = 1.f;
      for (int m = n - 1; m >= 0; --m) { const f32x4 x0 = *(const f32x4*)(KVf + (size_t)m * 4096), x1 = *(const f32x4*)(KVf + (size_t)m * 4096 + 4); f0 += x0 * cf; f1 += x1 * cf; cf *= gfC; }
      cf = 1.f;
      for (int m = n + 1; m < 32; ++m) { const f32x4 x0 = *(const f32x4*)(KVb + (size_t)m * 4096), x1 = *(const f32x4*)(KVb + (size_t)m * 4096 + 4); g0 += x0 * cf; g1 += x1 * cf; cf *= gbC; }
      const int e = tid >> 3, d0 = (tid & 7) * 8; u32x4 o;
      o.x = pk2(f0[0], f0[1]); o.y = pk2(f0[2], f0[3]); o.z = pk2(f1[0], f1[1]); o.w = pk2(f1[2], f1[3]); *(u32x4*)((bf16*)(lds + R_STF) + e * 72 + d0) = o;
      o.x = pk2(g0[0], g0[1]); o.y = pk2(g0[2], g0[3]); o.z = pk2(g1[0], g1[1]); o.w = pk2(g1[2], g1[3]); *(u32x4*)((bf16*)(lds + R_STB) + e * 72 + d0) = o; }
    __syncthreads();
    const bf16* QS = (const bf16*)(lds + R_QS); const bf16* KS = (const bf16*)(lds + R_KS); const bf16* VT = (const bf16*)(lds + R_VT);
    const bf16* STF = (const bf16*)(lds + R_STF); const bf16* STB = (const bf16*)(lds + R_STB);
    bf16x8v qf[2];
#pragma unroll
    for (int ks = 0; ks < 2; ++ks) qf[ks] = *(const bf16x8v*)(QS + (16 * w + fr) * 72 + 32 * ks + 8 * fq);
    const int ai = 16 * w + fr;
    unsigned pp[8][2];
#pragma unroll
    for (int jt = 0; jt < 8; ++jt) { f32x4 acc = {0.f, 0.f, 0.f, 0.f};
#pragma unroll
        for (int ks = 0; ks < 2; ++ks) { const bf16x8v kf = *(const bf16x8v*)(KS + (16 * jt + fr) * 72 + 32 * ks + 8 * fq); acc = MFMA16(kf, qf[ks], acc); }
        float sc[4];
#pragma unroll
        for (int r = 0; r < 4; ++r) { const int aj = 16 * jt + 4 * fq + r; const float wg = (aj <= ai) ? exp2f(l2f * (float)(ai - aj)) : exp2f(l2b * (float)(aj - ai)); sc[r] = acc[r] * wg; }
        pp[jt][0] = pk2(sc[0], sc[1]); pp[jt][1] = pk2(sc[2], sc[3]); }
    const float qdf = exp2f(l2f * (float)(ai + 1)), qdb = exp2f(l2b * (float)(128 - ai));
    f32x4 tot[4]; float ss = 0.f;
#pragma unroll
    for (int et = 0; et < 4; ++et) { f32x4 o = {0.f, 0.f, 0.f, 0.f}, cfa = o, cba = o;
#pragma unroll
        for (int t = 0; t < 4; ++t) { const u32x2 vlo = *(const u32x2*)(VT + (16 * et + fr) * 136 + 32 * t + 4 * fq), vhi = *(const u32x2*)(VT + (16 * et + fr) * 136 + 32 * t + 16 + 4 * fq);
            o = MFMA16(mk8(vlo.x, vlo.y, vhi.x, vhi.y), mk8(pp[2 * t][0], pp[2 * t][1], pp[2 * t + 1][0], pp[2 * t + 1][1]), o); }
#pragma unroll
        for (int ks = 0; ks < 2; ++ks) { const bf16x8v sf = *(const bf16x8v*)(STF + (16 * et + fr) * 72 + 32 * ks + 8 * fq), sb = *(const bf16x8v*)(STB + (16 * et + fr) * 72 + 32 * ks + 8 * fq);
            cfa = MFMA16(sf, qf[ks], cfa); cba = MFMA16(sb, qf[ks], cba); }
        tot[et] = o + cfa * qdf + cba * qdb;
        ss += (tot[et][0] * tot[et][0] + tot[et][1] * tot[et][1]) + (tot[et][2] * tot[et][2] + tot[et][3] * tot[et][3]); }
    ss += __shfl_xor(ss, 16); ss += __shfl_xor(ss, 32);
    const float rs = rsqrtf(ss * (1.f / 64.f) + 1e-6f);
    const size_t tok = (size_t)b * SEQ + n * 128 + ai;
    const bf16* Z = (const bf16*)(p.ws + WS_Z); bf16* CAT = (bf16*)(p.ws + WS_CAT);
#pragma unroll
    for (int et = 0; et < 4; ++et) { const u32x2 gz = *(const u32x2*)(Z + tok * DIN + 9 * DG + h * 64 + 16 * et + 4 * fq); u32x2 o;
        o.x = pk2(tot[et][0] * rs * silu_f(bflo(gz.x)), tot[et][1] * rs * silu_f(bfhi(gz.x))); o.y = pk2(tot[et][2] * rs * silu_f(bflo(gz.y)), tot[et][3] * rs * silu_f(bfhi(gz.y)));
        *(u32x2*)(CAT + tok * DM + 1024 + h * 64 + 16 * et + 4 * fq) = o; }
    __syncthreads();
}

__device__ __forceinline__ void na2_task(const Params& p, int l, int task, unsigned char* lds) {
    const int tid = otid(), lane = tid & 63, w = tid >> 6, fr = lane & 15, fq = lane >> 4;
    const int hp = task & 3, rq = (task >> 2) & 63, b = task >> 8;
    const int row_start = min(max(rq - 4, 0), 56);
    const bf16* Z = (const bf16*)(p.ws + WS_Z); bf16* CAT = (bf16*)(p.ws + WS_CAT);
    bf16* VT = (bf16*)lds; float* BI = (float*)(lds + 133120);
    for (int i = tid; i < 930; i += NTHR) BI[i] = p.na_bias[(size_t)(l * 8 + hp * 2) * 465 + i];
    { const int pair = lane & 31, chunk = (lane >> 5) + 2 * (w & 3), hh = w >> 2, h = hp * 2 + hh;
      unsigned* VTd = (unsigned*)(VT + (size_t)hh * 64 * 520);
#pragma unroll 2
      for (int a = 0; a < 8; ++a) {
          const size_t tok = (size_t)b * SEQ + (row_start + a) * 64 + 2 * pair;
          const bf16* src = Z + tok * DIN + 4 * DG + h * 64 + chunk * 8;
          const u32x4 x = *(const u32x4*)src, y = *(const u32x4*)(src + DIN);
          const unsigned xu[4] = {x.x, x.y, x.z, x.w}, yu[4] = {y.x, y.y, y.z, y.w};
#pragma unroll
          for (int i = 0; i < 4; ++i) { VTd[(chunk * 8 + 2 * i) * 260 + a * 32 + pair] = (xu[i] & 0xffffu) | (yu[i] << 16);
              VTd[(chunk * 8 + 2 * i + 1) * 260 + a * 32 + pair] = (xu[i] >> 16) | (yu[i] & 0xffff0000u); } } }
    __syncthreads();
    const int hh = w >> 2, h = hp * 2 + hh, qb = w & 3, ct0 = (qb >= 2) ? 1 : 0;
    const int c = 16 * qb + fr; const size_t qtok = (size_t)b * SEQ + rq * 64 + c;
    bf16x8v qf[2];
#pragma unroll
    for (int ks = 0; ks < 2; ++ks) qf[ks] = *(const bf16x8v*)(Z + qtok * DIN + 2 * DG + h * 64 + 32 * ks + 8 * fq);
    const int col_start = min(max(c - 8, 0), 48);
    const float* bi = BI + hh * 465;
    float sc[24][4]; float mx = -1e30f;
#pragma unroll
    for (int a = 0; a < 8; ++a)
#pragma unroll
        for (int ci = 0; ci < 3; ++ci) { const int kt = a * 3 + ci;
            const size_t ktok = (size_t)b * SEQ + (row_start + a) * 64 + 16 * (ct0 + ci) + fr;
            f32x4 acc = {0.f, 0.f, 0.f, 0.f};
#pragma unroll
            for (int ks = 0; ks < 2; ++ks) { const bf16x8v kf = *(const bf16x8v*)(Z + ktok * DIN + 3 * DG + h * 64 + 32 * ks + 8 * fq); acc = MFMA16(kf, qf[ks], acc); }
            const int dr = row_start + a - rq;
#pragma unroll
            for (int r = 0; r < 4; ++r) { const int kc = 16 * (ct0 + ci) + 4 * fq + r, rel = kc - col_start, dc = kc - c;
                float v = acc[r] * 0.125f + bi[(dr + 7) * 31 + min(max(dc + 15, 0), 30)];
                v = (rel >= 0 && rel < 16) ? v : -1e30f; sc[kt][r] = v; mx = fmaxf(mx, v); } }
    mx = fmaxf(mx, __shfl_xor(mx, 16)); mx = fmaxf(mx, __shfl_xor(mx, 32));
    float sum = 0.f; unsigned pp[24][2];
#pragma unroll
    for (int kt = 0; kt < 24; ++kt) { const float e0 = __expf(sc[kt][0] - mx), e1 = __expf(sc[kt][1] - mx), e2 = __expf(sc[kt][2] - mx), e3 = __expf(sc[kt][3] - mx);
        sum += (e0 + e1) + (e2 + e3); pp[kt][0] = pk2(e0, e1); pp[kt][1] = pk2(e2, e3); }
    sum += __shfl_xor(sum, 16); sum += __shfl_xor(sum, 32);
    const float inv = 1.f / sum;
    const bf16* VTh = VT + (size_t)hh * 64 * 520;
#pragma unroll
    for (int dt = 0; dt < 4; ++dt) { f32x4 o = {0.f, 0.f, 0.f, 0.f};
#pragma unroll
        for (int t = 0; t < 12; ++t) { const int k0 = 2 * t, k1 = 2 * t + 1, a0 = k0 / 3, c0 = k0 % 3, a1 = k1 / 3, c1 = k1 % 3;
            const u32x2 vlo = *(const u32x2*)(VTh + (16 * dt + fr) * 520 + a0 * 64 + 16 * (ct0 + c0) + 4 * fq), vhi = *(const u32x2*)(VTh + (16 * dt + fr) * 520 + a1 * 64 + 16 * (ct0 + c1) + 4 * fq);
            o = MFMA16(mk8(vlo.x, vlo.y, vhi.x, vhi.y), mk8(pp[k0][0], pp[k0][1], pp[k1][0], pp[k1][1]), o); }
        const u32x2 gz = *(const u32x2*)(Z + qtok * DIN + 5 * DG + h * 64 + 16 * dt + 4 * fq); u32x2 ov;
        ov.x = pk2(o[0] * inv * silu_f(bflo(gz.x)), o[1] * inv * silu_f(bfhi(gz.x))); ov.y = pk2(o[2] * inv * silu_f(bflo(gz.y)), o[3] * inv * silu_f(bfhi(gz.y)));
        *(u32x2*)(CAT + qtok * DM + 512 + h * 64 + 16 * dt + 4 * fq) = ov; }
    __syncthreads();
}

__device__ __forceinline__ void conv_task(const Params& p, int l, int task, unsigned char* lds) {
    const int tid = otid(), lane = tid & 63, wave = tid >> 6;
    float* us = (float*)lds; float* ys = us + 46 * 512;
    const bf16* Z = (const bf16*)(p.ws + WS_Z);
    const int b = task >> 8, t0 = (task & 255) * 16;
    for (int tt = 0; tt < 46; ++tt) { const int tok = t0 - 15 + tt; float u = 0.f;
        if (tok >= 0 && tok < SEQ) { const bf16* zr = Z + (size_t)(b * SEQ + tok) * DIN; const float a = bf2f(zr[10 * DG + tid]), g = bf2f(zr[11 * DG + tid]); u = a / (1.f + __expf(-g)); }
        us[tt * 512 + tid] = u; }
    float w[31];
#pragma unroll
    for (int k = 0; k < 31; ++k) w[k] = p.conv_w[(size_t)(l * 31 + k) * DG + tid];
    const float cb = p.conv_b[l * DG + tid];
    __syncthreads();
    for (int t = 0; t < 16; ++t) { float acc = cb;
#pragma unroll
        for (int k = 0; k < 31; ++k) acc += w[k] * us[(t + k) * 512 + tid];
        ys[t * 512 + tid] = acc; }
    __syncthreads();
#pragma unroll
    for (int tw = 0; tw < 2; ++tw) { const int t = wave + 8 * tw; float v[8]; float s = 0.f;
#pragma unroll
        for (int j = 0; j < 8; ++j) { v[j] = ys[t * 512 + lane + 64 * j]; s += v[j]; }
        const float mu = wave_sum(s) * (1.f / 512.f); float q = 0.f;
#pragma unroll
        for (int j = 0; j < 8; ++j) { v[j] -= mu; q += v[j] * v[j]; }
        const float rstd = rsqrtf(wave_sum(q) * (1.f / 512.f) + 1e-6f);
        bf16* orow = (bf16*)(p.ws + WS_CVH) + (size_t)(b * SEQ + t0 + t) * DG;
#pragma unroll
        for (int j = 0; j < 8; ++j) { const int ch = lane + 64 * j; const float y = v[j] * rstd * p.ln_g[l * DG + ch] + p.ln_b[l * DG + ch]; orow[ch] = (bf16)f2bf(silu_f(y)); } }
    __syncthreads();
}

__device__ __forceinline__ void f1_task(const Params& p, int task, unsigned char* lds) {
    const int tid = otid();
    float* us = (float*)lds; float* cs = us + 8 * 512; float* sn = cs + 128;
    const bf16* Z = (const bf16*)(p.ws + WS_Z);
    const int tok0 = task * 8, b = tok0 >> 12, s0 = tok0 & 4095;
    if (tid < 128) { cs[tid] = cospif((float)tid * (1.f / 64.f)); sn[tid] = sinpif((float)tid * (1.f / 64.f)); }
#pragma unroll
    for (int tk = 0; tk < 8; ++tk) us[tk * 512 + tid] = bf2f(Z[(size_t)(tok0 + tk) * DIN + tid]);
    __syncthreads();
    const int g = tid >> 7, m = tid & 127;
    float P[8], Q[8];
#pragma unroll
    for (int tk = 0; tk < 8; ++tk) { P[tk] = 0.f; Q[tk] = 0.f; }
    for (int c = 0; c < 128; ++c) { const int idx = (m * c) & 127; const float cv = cs[idx], sv = sn[idx];
#pragma unroll
        for (int tk = 0; tk < 8; ++tk) { const float u = us[tk * 512 + g * 128 + c]; P[tk] += u * cv; Q[tk] += u * sv; } }
    const float nrm = 0.0013810679320049757f;
    bf16* PQ = (bf16*)(p.ws + WS_PQT) + ((size_t)(b * 512 + tid) * 2) * 4096 + s0;
    u32x4 o; o.x = pk2(P[0] * nrm, P[1] * nrm); o.y = pk2(P[2] * nrm, P[3] * nrm); o.z = pk2(P[4] * nrm, P[5] * nrm); o.w = pk2(P[6] * nrm, P[7] * nrm);
    *(u32x4*)PQ = o;
    o.x = pk2(Q[0] * nrm, Q[1] * nrm); o.y = pk2(Q[2] * nrm, Q[3] * nrm); o.z = pk2(Q[4] * nrm, Q[5] * nrm); o.w = pk2(Q[6] * nrm, Q[7] * nrm);
    *(u32x4*)(PQ + 4096) = o;
    __syncthreads();
}

__device__ __forceinline__ void ph_mixA(const Params& p, int l, unsigned char* lds) {
    const int G = gridDim.x, bid = blockIdx.x;
    for (int t = bid; t < 512; t += G) ret1_task(p, l, t, lds);
    for (int t = bid; t < 512; t += G) na2_task(p, l, t, lds);
    for (int t = bid; t < 512; t += G) conv_task(p, l, t, lds);
    for (int t = bid; t < 1024; t += G) f1_task(p, t, lds);
}

__device__ __forceinline__ void ph_combine(const Params& p) {
    const float* part = (const float*)(p.ws + WS_U); bf16* Y = (bf16*)(p.ws + WS_Y);
    for (int e = blockIdx.x * NTHR + threadIdx.x; e < MTOK * DG / 4; e += gridDim.x * NTHR) {
        const int row = e >> 7, c4 = (e & 127) * 4, b = row >> 12, k = row & 4095;
        f32x4 s = {0.f, 0.f, 0.f, 0.f};
#pragma unroll
        for (int ks = 0; ks < 4; ++ks) s += *(const f32x4*)(part + ((size_t)((b * 4 + ks) * 4096 + k)) * 512 + c4);
        u32x2 w; w.x = pk2(s[0], s[1]); w.y = pk2(s[2], s[3]);
        *(u32x2*)(Y + (size_t)row * DG + c4) = w;
    }
}

#ifndef REP_PRO
#define REP_PRO 1
#endif
#ifndef REP_NORM
#define REP_NORM 1
#endif
#ifndef REP_Z
#define REP_Z 1
#endif
#ifndef REP_MIX
#define REP_MIX 1
#endif
#ifndef REP_P3
#define REP_P3 1
#endif
#ifndef REP_R2
#define REP_R2 1
#endif
#ifndef REP_CMB
#define REP_CMB 1
#endif
#ifndef REP_FFT
#define REP_FFT 1
#endif
#ifndef REP_OUT
#define REP_OUT 1
#endif
#ifndef REP_SUB
#define REP_SUB 1
#endif

#define XB_TMO      128
#define XB_XCNT(j)  (256  + 64 * (j))
#define XB_XSUB(j)  (1280 + 64 * (j))
#define XB_XGEN(j)  (2304 + 64 * (j))
#define XB_TOP      3328
#define XB_TOPGEN   3392
#define XCD_BAR_WORDS 3456
#define XB_SPIN_CAP (1u << 20)
__device__ __forceinline__ unsigned xb_ld(unsigned* p)              { return __hip_atomic_load(p, __ATOMIC_RELAXED, __HIP_MEMORY_SCOPE_AGENT); }
__device__ __forceinline__ unsigned xb_add(unsigned* p, unsigned v) { return __hip_atomic_fetch_add(p, v, __ATOMIC_RELAXED, __HIP_MEMORY_SCOPE_AGENT); }
__device__ __forceinline__ unsigned xb_xcc_id() { return (unsigned)__builtin_amdgcn_s_getreg((3 << 11) | 20) & 0xFu; }
#define XB_SPIN(cond, bar) do { unsigned _sp = 0; while (cond) { __builtin_amdgcn_s_sleep(1); \
    if ((++_sp & 255u) == 0u) { if (xb_ld(&(bar)[XB_TMO])) break; if (_sp > XB_SPIN_CAP) { atomicAdd(&(bar)[XB_TMO], 1u); break; } } } } while (0)
struct XcdBarrier { unsigned* bar; unsigned x; volatile PG8_LAS unsigned* st; };
__device__ __forceinline__ XcdBarrier xcd_barrier_post(unsigned* bar, volatile PG8_LAS unsigned* st) {
    XcdBarrier b; b.bar = bar; b.x = xb_xcc_id(); b.st = st;
    if (threadIdx.x == 0) (void)xb_add(&bar[XB_XCNT(b.x)], 1u);
    return b;
}
__device__ __forceinline__ void xcd_barrier_complete(unsigned* bar, unsigned x, unsigned& nloc, unsigned& nx) {
    const unsigned G = gridDim.x * gridDim.y * gridDim.z;
    unsigned sum, cnt, mine, sp = 0u;
    for (;;) {
        sum = 0u; cnt = 0u; mine = 0u;
#pragma unroll
        for (unsigned j = 0; j < 16; ++j) { const unsigned c = xb_ld(&bar[XB_XCNT(j)]); sum += c; cnt += (c > 0u) ? 1u : 0u; mine = (j == x) ? c : mine; }
        if (sum == G) break;
        __builtin_amdgcn_s_sleep(1);
        if ((++sp & 255u) == 0u) { if (xb_ld(&bar[XB_TMO])) break; if (sp > XB_SPIN_CAP) { atomicAdd(&bar[XB_TMO], 1u); break; } }
    }
    nloc = mine > 0u ? mine : 1u; nx = cnt > 0u ? cnt : 1u;
}
__device__ __forceinline__ void xcd_barrier(const XcdBarrier& b) {
    asm volatile("s_waitcnt vmcnt(0)" ::: "memory");
    __syncthreads();
    if (threadIdx.x == 0) {
        unsigned* bar = b.bar;
        __builtin_amdgcn_s_waitcnt(0);
        unsigned nloc = b.st[0], nx = b.st[1];
        if (nloc == 0u) { xcd_barrier_complete(bar, b.x, nloc, nx); b.st[0] = nloc; b.st[1] = nx; }
        const unsigned old = xb_add(&bar[XB_XSUB(b.x)], 1u);
        const unsigned gen = old / nloc;
        if (old + 1u == (gen + 1u) * nloc) {
            __builtin_amdgcn_fence(__ATOMIC_RELEASE, "agent");
            asm volatile("s_waitcnt vmcnt(0)" ::: "memory");
            const unsigned og = xb_add(&bar[XB_TOP], 1u);
            const unsigned tg = og / nx;
            if (og + 1u == (tg + 1u) * nx) xb_add(&bar[XB_TOPGEN], 1u);
            else XB_SPIN(xb_ld(&bar[XB_TOPGEN]) == tg, bar);
            __builtin_amdgcn_fence(__ATOMIC_ACQUIRE, "agent");
            xb_add(&bar[XB_XGEN(b.x)], 1u);
            asm volatile("s_waitcnt vmcnt(0)" ::: "memory");
        } else {
            XB_SPIN(xb_ld(&bar[XB_XGEN(b.x)]) == gen, bar);
            __builtin_amdgcn_fence(__ATOMIC_ACQUIRE, "agent");
            asm volatile("s_waitcnt vmcnt(0)" ::: "memory");
        }
    }
    __syncthreads();
}

constexpr int NPH = 16;
__global__ void __launch_bounds__(NTHR) mega(Params p) {
    extern __shared__ __attribute__((aligned(16))) unsigned char lds[];
    cg::grid_group grid = cg::this_grid();
    PG8_LAS unsigned char* ldsl = (PG8_LAS unsigned char*)lds;
    const int lo = p.ph_lo, hi = p.ph_hi;
#define IN(k) (lo <= (k) && (k) < hi)
#define SEAM(k) do { if (IN(k) && IN((k) + 1)) { xcd_barrier(xb); } } while (0)
#define REPEAT(n) for (int rep_ = 0; rep_ < (n); ++rep_)
    bf16* Zb = (bf16*)(p.ws + WS_Z); bf16* CAT = (bf16*)(p.ws + WS_CAT);
    volatile PG8_LAS unsigned* xst = (volatile PG8_LAS unsigned*)(ldsl + LDS_BYTES - 16);
    if (threadIdx.x < 4) xst[threadIdx.x] = 0u;
    __syncthreads();
    XcdBarrier xb = xcd_barrier_post((unsigned*)(p.ws + WS_BAR), xst);
    if (p.ph_lo < 0) grid.sync();
    if (IN(0)) REPEAT(REP_PRO) { ph_prologue(p, lds); __syncthreads(); }
    SEAM(0);
    if (IN(0) && IN(1)) for (int r_ = 1; r_ < REP_SUB; ++r_) xcd_barrier(xb);
#pragma unroll
    for (int l = 0; l < NL; ++l) {
        const int pb = 1 + 7 * l;
        if (IN(pb)) REPEAT(REP_NORM) ph_norm(p, l);
        SEAM(pb);
        if (IN(pb + 1)) REPEAT(REP_Z) {
            SchedS S = make_sched(p.ws + WS_U, DM, p.ws + WS_WIN + (size_t)l * DIN * DM * 2, DM, MTOK, DIN);
            EpiZ E{Zb, DIN};
            pg8::gemm_phase<EpiZ, SchedS, true>(ldsl, pg8::Gemm{DM, DM, DM}, S, E);
        }
        SEAM(pb + 1);
        if (IN(pb + 2)) REPEAT(REP_MIX) ph_mixA(p, l, lds);
        SEAM(pb + 2);
        if (IN(pb + 3)) REPEAT(REP_P3) {
            { SchedDFT S{(const char*)(p.ws + WS_DFT), (const char*)(p.ws + WS_PQT), (int)gridDim.x, (int)blockIdx.x};
              EpiPart E{(float*)(p.ws + WS_U)};
              pg8::gemm_phase<EpiPart, SchedDFT, true>(ldsl, pg8::Gemm{8192, 8192, 2048}, S, E); }
            { SchedS S = make_sched(p.ws + WS_CVH, DG, p.ws + WS_WPW + (size_t)l * DG * DG * 2, DG, MTOK, DG);
              EpiGate E{CAT, Zb, 1536, 12 * DG};
              pg8::gemm_phase<EpiGate, SchedS, true>(ldsl, pg8::Gemm{DG, DG, DG}, S, E); }
            REPEAT(REP_R2) for (int t = blockIdx.x; t < 512; t += gridDim.x) ret2_task(p, l, t, lds);
        }
        SEAM(pb + 3);
        if (IN(pb + 4)) REPEAT(REP_CMB) ph_combine(p);
        SEAM(pb + 4);
        if (IN(pb + 5)) REPEAT(REP_FFT) {
            SchedS S = make_sched(p.ws + WS_Y, DG, p.ws + WS_WFFT + (size_t)l * DG * DG * 2, DG, MTOK, DG);
            EpiGate E{CAT, Zb, 0, 1 * DG};
            pg8::gemm_phase<EpiGate, SchedS, true>(ldsl, pg8::Gemm{DG, DG, DG}, S, E);
        }
        SEAM(pb + 5);
        if (IN(pb + 6)) REPEAT(l == 0 ? REP_OUT : 1) {
            SchedS S = make_sched(CAT, DM, p.ws + WS_WOUT + (size_t)l * DM * DM * 2, DM, MTOK, DM);
            EpiRes E{(l == 0) ? p.x : p.out, p.out, (const float*)(p.ws + WS_MOD) + (size_t)l * 2 * 6144 + 4096};
            pg8::gemm_phase<EpiRes, SchedS, true>(ldsl, pg8::Gemm{DM, DM, DM}, S, E);
        }
        SEAM(pb + 6);
    }
    if (IN(NPH - 1)) ph_final(p);
#undef IN
#undef SEAM
}

extern "C" void kernel_launch(void* const* d_in, const int* in_sizes, int n_in, void* d_out, int out_size, void* d_ws, size_t ws_size, hipStream_t stream) {
    static int grid_blocks = 0;
    if (grid_blocks == 0) {
        if (n_in != 17 || ws_size < WS_END) { fprintf(stderr, "kernel_launch: n_in %d ws %zu (need %zu)\n", n_in, ws_size, (size_t)WS_END); grid_blocks = -1; return; }
        int dev = 0, cus = 0, per_cu = 0;
        hipGetDevice(&dev); hipDeviceGetAttribute(&cus, hipDeviceAttributeMultiprocessorCount, dev);
        if (hipFuncSetAttribute((const void*)mega, hipFuncAttributeMaxDynamicSharedMemorySize, LDS_BYTES) != hipSuccess) { fprintf(stderr, "hipFuncSetAttribute failed\n"); grid_blocks = -1; return; }
        if (hipOccupancyMaxActiveBlocksPerMultiprocessor(&per_cu, (const void*)mega, NTHR, LDS_BYTES) != hipSuccess || per_cu < 1) { fprintf(stderr, "occupancy query: %d\n", per_cu); per_cu = 1; }
        (void)hipGetLastError();
        grid_blocks = cus * 1;
    }
    if (grid_blocks < 0) return;
    Params p{};
    p.x = (const float*)d_in[0]; p.c = (const float*)d_in[1]; p.norm_g = (const float*)d_in[2]; p.w_ada = (const float*)d_in[3]; p.b_ada = (const float*)d_in[4];
    p.w_in = (const float*)d_in[5]; p.w_fft = (const float*)d_in[6]; p.na_bias = (const float*)d_in[7]; p.rl_f = (const float*)d_in[8]; p.rl_b = (const float*)d_in[9];
    p.conv_w = (const float*)d_in[10]; p.conv_b = (const float*)d_in[11]; p.ln_g = (const float*)d_in[12]; p.ln_b = (const float*)d_in[13]; p.w_pw = (const float*)d_in[14];
    p.w_out = (const float*)d_in[15]; p.final_g = (const float*)d_in[16];
    p.out = (float*)d_out; p.ws = (unsigned char*)d_ws;
#if ONE_LAUNCH
    if (hipMemsetAsync((char*)d_ws + WS_BAR, 0, 16384, stream) != hipSuccess) { fprintf(stderr, "memset of the barrier words failed\n"); return; }
    p.ph_lo = 0; p.ph_hi = NPH;
    void* args[] = {&p};
    hipError_t e = hipLaunchCooperativeKernel((const void*)mega, dim3(grid_blocks), dim3(NTHR), args, LDS_BYTES, stream);
    if (e != hipSuccess) fprintf(stderr, "cooperative launch failed: %s (grid %d)\n", hipGetErrorString(e), grid_blocks);
#else
    for (int ph = 0; ph < NPH; ++ph) { p.ph_lo = ph; p.ph_hi = ph + 1; hipLaunchKernelGGL(mega, dim3(grid_blocks), dim3(NTHR), LDS_BYTES, stream, p); }
#endif
}
```

```cpp
#include <hip/hip_runtime.h>
#include <hip/hip_cooperative_groups.h>
#include <cstdio>
#include <cstdint>
namespace cg = cooperative_groups;

#ifndef ONE_LAUNCH
#define ONE_LAUNCH 1
#endif

__device__ __forceinline__ int obid() { int b = (int)blockIdx.x; asm volatile("" : "+s"(b)); return b; }
__device__ __forceinline__ int otid() { int t; asm volatile("v_mov_b32 %0, %1" : "=v"(t) : "v"(threadIdx.x)); return t; }
namespace pg8 {
#define PG8_LAS __attribute__((address_space(3)))
typedef unsigned short bf16_t;
typedef short bf16x8 __attribute__((ext_vector_type(8)));
typedef float f32x4 __attribute__((ext_vector_type(4)));
typedef unsigned u32x4 __attribute__((ext_vector_type(4)));
constexpr int BM = 256, BK = 64, HALF = 128, HTB = HALF * BK * 2, STAGE_BYTES = 8 * HTB, NXCD = 8, WGM = 8;

__host__ __device__ __forceinline__ int lds_byte(int r, int c) { const int st = (r >> 4) * 2 + (c >> 5), rr = r & 15, cc = c & 31, ob = rr * 64 + cc * 2; return st * 1024 + (ob ^ (((ob >> 9) & 1) << 5)); }
__host__ __device__ __forceinline__ void stage_rc(int b, int& R, int& C) { const int st = b / 1024, sb = b % 1024, swz = sb ^ (((sb >> 9) & 1) << 5); R = (st >> 1) * 16 + swz / 64; C = (st & 1) * 32 + (swz % 64) / 2; }
__host__ __device__ __forceinline__ int perm32(int rho) { const int n = rho >> 4, i = rho & 15; return 8 * (i >> 2) + 4 * n + (i & 3); }

struct Unit { int pm, pn, aux, pad; const char* A; const char* B; };
struct Gemm { int lda, ldb, K; };

struct StaticOrder {
    int nM, nN, nwg, G, c;
    __host__ __device__ void init(int M, int N, int G_, int c_) { nM = M / BM; nN = N / BM; nwg = nM * nN; G = G_; c = c_; }
    __device__ bool next(int i, Unit& u) const {
        const long L = (long)i * G + c; if (L >= nwg) return false;
        int wgid = __builtin_amdgcn_readfirstlane((int)L); { const int q = nwg / NXCD, r = nwg % NXCD, xcd = wgid % NXCD, off = wgid / NXCD; wgid = (xcd < r ? xcd * (q + 1) : r * (q + 1) + (xcd - r) * q) + off; }
        const int nig = WGM * nN, gid = wgid / nig, fm = gid * WGM, gsz = (nM - fm) < WGM ? (nM - fm) : WGM;
        u.pm = __builtin_amdgcn_readfirstlane(fm + ((wgid % nig) % gsz)); u.pn = __builtin_amdgcn_readfirstlane((wgid % nig) / gsz); return true;
    }
};

__device__ __forceinline__ unsigned cvt_pk_bf16(float lo, float hi) { unsigned r; asm volatile("v_cvt_pk_bf16_f32 %0, %1, %2" : "=v"(r) : "v"(lo), "v"(hi)); return r; }

template <class Epi, class Sched, bool ALIGN_EPI>
__device__ __forceinline__ void gemm_phase(PG8_LAS unsigned char* lds, const Gemm g, const Sched& S, const Epi& E) {
    const int tid = otid(), wid = __builtin_amdgcn_readfirstlane(tid >> 6), lane = tid & 63, wr = wid >> 2, wc = wid & 3, fr = lane & 15, fq = lane >> 4;
    const int K = g.K, nt = K / BK;
    unsigned voffA[2], voffB[2];
#pragma unroll
    for (int i = 0; i < 2; ++i) { int R, C; stage_rc(tid * 16 + i * 8192, R, C); const int Rb = Epi::PERM ? ((R & ~31) + perm32(R & 31)) : R;
        voffA[i] = (unsigned)(R * g.lda + C) * 2u; voffB[i] = (unsigned)(Rb * g.ldb + C) * 2u; }
    const size_t kstep = (size_t)(BK * 2);
    const size_t hA = (size_t)HALF * g.lda * 2, hB = (size_t)HALF * g.ldb * 2;
    const unsigned ldsw = (unsigned)wid * 1024u;
    const int aoff = lds_byte(wr * 64 + fr, fq * 8), boff = lds_byte(wc * 32 + fr, fq * 8);
#define PG8_SA(b, h) (((b) * 2 + (h)) * HTB)
#define PG8_SB(b, h) ((4 + (b) * 2 + (h)) * HTB)
#define PG8_STAGE(bufoff, gbase, voff) do { _Pragma("unroll") for (int _i = 0; _i < 2; ++_i) \
        __builtin_amdgcn_global_load_lds((const unsigned*)((const char*)(gbase) + (voff)[_i]), (PG8_LAS unsigned*)(lds + (bufoff) + ldsw + _i * 8192), 16, 0, 0); } while (0)
#define PG8_LDA(dst, b, h) do { _Pragma("unroll") for (int m = 0; m < 4; ++m) _Pragma("unroll") for (int k = 0; k < 2; ++k) dst[m][k] = *(const PG8_LAS bf16x8*)(lds + PG8_SA(b, h) + aoff + m * 2048 + k * 1024); } while (0)
#define PG8_LDB(dst, b, h) do { _Pragma("unroll") for (int n = 0; n < 2; ++n) _Pragma("unroll") for (int k = 0; k < 2; ++k) dst[n][k] = *(const PG8_LAS bf16x8*)(lds + PG8_SB(b, h) + boff + n * 2048 + k * 1024); } while (0)
#define PG8_MMA(ai, bj, At, Bt) do { __builtin_amdgcn_s_setprio(1); _Pragma("unroll") for (int m = 0; m < 4; ++m) _Pragma("unroll") for (int n = 0; n < 2; ++n) _Pragma("unroll") for (int k = 0; k < 2; ++k) \
        acc[ai][bj][m][n] = __builtin_amdgcn_mfma_f32_16x16x32_bf16(Bt[n][k], At[m][k], acc[ai][bj][m][n], 0, 0, 0); __builtin_amdgcn_s_setprio(0); } while (0)
#define PG8_WAIT_V(n) asm volatile("s_waitcnt vmcnt(" #n ")" ::: "memory")
#define PG8_WAIT_L(n) asm volatile("s_waitcnt lgkmcnt(" #n ")" ::: "memory")
#define PG8_BAR __builtin_amdgcn_s_barrier()
#define PG8_SCHED __builtin_amdgcn_sched_barrier(0)
    Unit cur, nxt; int ui = 0;
    if (!S.next(0, cur)) return;
    f32x4 acc[2][2][4][2];
#pragma unroll
    for (int a = 0; a < 2; ++a)
#pragma unroll
        for (int b = 0; b < 2; ++b)
#pragma unroll
            for (int m = 0; m < 4; ++m)
#pragma unroll
                for (int n = 0; n < 2; ++n) acc[a][b][m][n] = (f32x4){0.f, 0.f, 0.f, 0.f};
    bf16x8 At[4][2], B0[2][2], B1[2][2];
    const char* cA = cur.A; const char* cB = cur.B;
    PG8_STAGE(PG8_SB(0, 0), cB, voffB); PG8_STAGE(PG8_SB(0, 1), cB + hB, voffB); PG8_STAGE(PG8_SA(0, 0), cA, voffA); PG8_STAGE(PG8_SA(0, 1), cA + hA, voffA);
    if (wr == 1) PG8_BAR;
    PG8_WAIT_V(2); PG8_BAR;
    PG8_STAGE(PG8_SB(1, 0), cB + kstep, voffB); PG8_STAGE(PG8_SA(1, 0), cA + kstep, voffA); PG8_STAGE(PG8_SB(1, 1), cB + hB + kstep, voffB);
    PG8_WAIT_V(6); PG8_BAR;
    for (;;) {
        const bool has_next = S.next(ui + 1, nxt);
        const char* nA = has_next ? nxt.A : cA; const char* nB = has_next ? nxt.B : cB;
        for (int t = 0; t < nt; t += 2) {
            const bool last = (t == nt - 2);
            const char* a1 = cA + (size_t)(t + 1) * kstep;
            const char* a2 = last ? nA : cA + (size_t)(t + 2) * kstep; const char* b2 = last ? nB : cB + (size_t)(t + 2) * kstep;
            const char* a3 = a2 + kstep; const char* b3 = b2 + kstep;
            PG8_LDB(B0, 0, 0); PG8_LDB(B1, 0, 1); PG8_SCHED; PG8_LDA(At, 0, 0); PG8_STAGE(PG8_SA(1, 1), a1 + hA, voffA);
            PG8_WAIT_V(8); PG8_WAIT_L(0); PG8_BAR; PG8_MMA(0, 0, At, B0); PG8_MMA(0, 1, At, B1); PG8_BAR; PG8_SCHED;
            PG8_LDA(At, 0, 1); PG8_STAGE(PG8_SB(0, 0), b2, voffB); PG8_STAGE(PG8_SB(0, 1), b2 + hB, voffB); PG8_STAGE(PG8_SA(0, 0), a2, voffA);
            PG8_WAIT_V(8); PG8_WAIT_L(0); PG8_BAR; PG8_MMA(1, 0, At, B0); PG8_MMA(1, 1, At, B1); PG8_BAR; PG8_SCHED;
            PG8_LDB(B0, 1, 0); PG8_LDB(B1, 1, 1); PG8_SCHED; PG8_LDA(At, 1, 0); PG8_STAGE(PG8_SA(0, 1), a2 + hA, voffA);
            PG8_WAIT_V(8); PG8_WAIT_L(0); PG8_BAR; PG8_MMA(0, 0, At, B0); PG8_MMA(0, 1, At, B1); PG8_BAR; PG8_SCHED;
            PG8_LDA(At, 1, 1); PG8_STAGE(PG8_SB(1, 0), b3, voffB); PG8_STAGE(PG8_SB(1, 1), b3 + hB, voffB); PG8_STAGE(PG8_SA(1, 0), a3, voffA);
            PG8_WAIT_V(8); PG8_WAIT_L(0); PG8_BAR; PG8_MMA(1, 0, At, B0); PG8_MMA(1, 1, At, B1); PG8_BAR; PG8_SCHED;
        }
        if constexpr (ALIGN_EPI) { if (wr == 0) PG8_BAR; }
        E(acc, cur, wr, wc, fr, fq);
        if (!has_next) break;
#pragma unroll
        for (int a = 0; a < 2; ++a)
#pragma unroll
            for (int b = 0; b < 2; ++b)
#pragma unroll
                for (int m = 0; m < 4; ++m)
#pragma unroll
                    for (int n = 0; n < 2; ++n) acc[a][b][m][n] = (f32x4){0.f, 0.f, 0.f, 0.f};
        cur = nxt; cA = nA; cB = nB; ++ui;
        if constexpr (ALIGN_EPI) { if (wr == 1) PG8_BAR; }
    }
    PG8_WAIT_V(0);
    if constexpr (!ALIGN_EPI) { if (wr == 0) PG8_BAR; }
    PG8_BAR;
#undef PG8_SA
#undef PG8_SB
#undef PG8_STAGE
#undef PG8_LDA
#undef PG8_LDB
#undef PG8_MMA
#undef PG8_WAIT_V
#undef PG8_WAIT_L
#undef PG8_BAR
#undef PG8_SCHED
}
}

typedef unsigned short bf16;
typedef float f32x4 __attribute__((ext_vector_type(4)));
typedef unsigned u32x4 __attribute__((ext_vector_type(4)));
typedef unsigned u32x2 __attribute__((ext_vector_type(2)));
constexpr int NB = 2, SEQ = 4096, DM = 2048, MTOK = NB * SEQ, DIN = 6656, DG = 512, NL = 2;
constexpr int LDS_BYTES = 147456;
constexpr int NTHR = 512;

constexpr int WROWS = 7680;
constexpr size_t WS_WIN = 0;
constexpr size_t WS_WOUT = WS_WIN + (size_t)NL * WROWS * DM * 2;
constexpr size_t WS_WCS = WS_WOUT + (size_t)NL * DM * DM * 2;
constexpr size_t WS_WFXB = WS_WCS + (size_t)NL * 1024 * DG * 2;
constexpr size_t WS_WPW = WS_WFXB + (size_t)NL * DM * DG * 2;
constexpr size_t WS_DFT = WS_WPW + (size_t)NL * DG * DG * 2;
constexpr size_t WS_ROPE = WS_DFT + (size_t)SEQ * 2 * SEQ * 2;
constexpr size_t WS_MOD = WS_ROPE + (size_t)SEQ * 32 * 8;
constexpr size_t WS_U = WS_MOD + 131072;
constexpr size_t WS_Z = WS_U + (size_t)4 * MTOK * DG * 4;
constexpr size_t WS_PQT = WS_Z + (size_t)MTOK * DIN * 2;
constexpr size_t WS_CVH = WS_PQT + (size_t)NB * DG * 2 * SEQ * 2;
constexpr size_t WS_CAT = WS_CVH + (size_t)MTOK * DG * 2;
constexpr size_t WS_KV = WS_CAT + (size_t)MTOK * DM * 2;
constexpr size_t WS_BAR = WS_KV + (size_t)2 * NB * 8 * 32 * 4096 * 4;
constexpr size_t WS_END = WS_BAR + 16384;

struct Params {
    const float* x; const float* c; const float* norm_g; const float* w_ada; const float* b_ada; const float* w_in; const float* w_fft; const float* na_bias;
    const float* rl_f; const float* rl_b; const float* conv_w; const float* conv_b; const float* ln_g; const float* ln_b; const float* w_pw; const float* w_out; const float* final_g;
    float* out; unsigned char* ws; int ph_lo, ph_hi;
};

#if defined(__HIP_DEVICE_COMPILE__)
typedef const __attribute__((address_space(4))) Params* KParams;
__device__ __forceinline__ KParams kparams() { KParams k = (KParams)__builtin_amdgcn_kernarg_segment_ptr(); asm volatile("" : "+s"(k)); return k; }
#else
typedef const Params* KParams;
__device__ __forceinline__ KParams kparams() { return nullptr; }
#endif
__device__ __forceinline__ unsigned f2bf(float f) { unsigned u = __float_as_uint(f); return (u + 0x7fffu + ((u >> 16) & 1u)) >> 16; }
__device__ __forceinline__ unsigned pk2(float lo, float hi) { return f2bf(lo) | (f2bf(hi) << 16); }
__device__ __forceinline__ float bf2f(bf16 b) { return __uint_as_float((unsigned)b << 16); }
__device__ __forceinline__ float bflo(unsigned u) { return __uint_as_float(u << 16); }
__device__ __forceinline__ float bfhi(unsigned u) { return __uint_as_float(u & 0xffff0000u); }
__device__ __forceinline__ float silu_f(float v) { return v / (1.f + __expf(-v)); }
__device__ __forceinline__ float wave_sum(float v) {
#pragma unroll
    for (int o = 1; o < 64; o <<= 1) v += __shfl_xor(v, o);
    return v;
}
__device__ __forceinline__ float wave_max(float v) {
#pragma unroll
    for (int o = 1; o < 64; o <<= 1) v = fmaxf(v, __shfl_xor(v, o));
    return v;
}

struct SchedS {
    pg8::StaticOrder o; const char* A; const char* B; size_t ta, tb;
    __device__ __forceinline__ bool next(int i, pg8::Unit& u) const { if (!o.next(i, u)) return false; u.A = A + (size_t)u.pm * ta; u.B = B + (size_t)u.pn * tb; u.aux = 0; return true; }
};
__device__ __forceinline__ SchedS make_sched(const void* A, int lda, const void* B, int ldb, int M, int N, int shift = 0) {
    SchedS s; s.o.init(M, N, (int)gridDim.x, (int)((obid() + gridDim.x - shift) % gridDim.x)); s.A = (const char*)A; s.B = (const char*)B; s.ta = (size_t)256 * lda * 2; s.tb = (size_t)256 * ldb * 2; return s;
}
struct SchedZ {
    pg8::StaticOrder o; const char* A; const char* B; int late;
    __device__ __forceinline__ bool next(int i, pg8::Unit& u) const { if (!o.next(i, u)) return false; const int jn = u.pn;
        u.pn = late ? (jn < 2 ? 2 + jn : 22 + jn) : (jn < 20 ? jn + 4 : jn + 6);
        u.A = A + (size_t)u.pm * (256 * DM * 2); u.B = B + (size_t)u.pn * (256 * DM * 2); u.aux = 0; return true; }
};
struct SchedDFT {
    const char* A; const char* B; int G, c;
    __device__ __forceinline__ bool next(int i, pg8::Unit& u) const {
        const int L = __builtin_amdgcn_readfirstlane(i * G + c); if (L >= 256) return false;
        const int sub = L >> 5, t = L & 31; u.pm = t >> 1; u.pn = t & 1; u.aux = sub;
        u.A = A + (size_t)((u.pm << 22) + ((sub & 3) << 12)); u.B = B + (size_t)(((sub >> 2) << 23) + (u.pn << 22) + ((sub & 3) << 12)); return true;
    }
};

struct EpiZ {
    static constexpr bool PERM = true;
    bf16* O; int ldc;
    __device__ __forceinline__ void operator()(const pg8::f32x4 (&acc)[2][2][4][2], const pg8::Unit& u, int wr, int wc, int fr, int fq) const {
        const int row0 = u.pm * 256 + wr * 64 + fr, col0 = u.pn * 256 + wc * 32 + 8 * fq;
#pragma unroll
        for (int ai = 0; ai < 2; ++ai)
#pragma unroll
            for (int m = 0; m < 4; ++m) { bf16* rowp = O + (size_t)(row0 + ai * 128 + m * 16) * ldc + col0;
#pragma unroll
                for (int bj = 0; bj < 2; ++bj) { const pg8::f32x4 v0 = acc[ai][bj][m][0], v1 = acc[ai][bj][m][1]; u32x4 w;
                    w.x = pg8::cvt_pk_bf16(v0[0], v0[1]); w.y = pg8::cvt_pk_bf16(v0[2], v0[3]); w.z = pg8::cvt_pk_bf16(v1[0], v1[1]); w.w = pg8::cvt_pk_bf16(v1[2], v1[3]);
                    *(u32x4*)(rowp + bj * 128) = w; } }
    }
};
struct EpiZ2 {
    static constexpr bool PERM = true;
    bf16* O; bf16* PQ;
    __device__ __forceinline__ void operator()(const pg8::f32x4 (&acc)[2][2][4][2], const pg8::Unit& u, int wr, int wc, int fr, int fq) const {
        const int row0 = u.pm * 256 + wr * 64 + fr;
        if (u.pn < 26) { const int col0 = u.pn * 256 + wc * 32 + 8 * fq;
#pragma unroll
            for (int ai = 0; ai < 2; ++ai)
#pragma unroll
                for (int m = 0; m < 4; ++m) { bf16* rowp = O + (size_t)(row0 + ai * 128 + m * 16) * DIN + col0;
#pragma unroll
                    for (int bj = 0; bj < 2; ++bj) { const pg8::f32x4 v0 = acc[ai][bj][m][0], v1 = acc[ai][bj][m][1]; u32x4 w;
                        w.x = pg8::cvt_pk_bf16(v0[0], v0[1]); w.y = pg8::cvt_pk_bf16(v0[2], v0[3]); w.z = pg8::cvt_pk_bf16(v1[0], v1[1]); w.w = pg8::cvt_pk_bf16(v1[2], v1[3]);
                        *(u32x4*)(rowp + bj * 128) = w; } }
        } else { const int np0 = (u.pn - 26) * 256 + wc * 32 + 8 * fq;
#pragma unroll
            for (int bj = 0; bj < 2; ++bj) { const int np = np0 + bj * 128, pq = np >> 9, n = np & 511;
#pragma unroll
                for (int ai = 0; ai < 2; ++ai)
#pragma unroll
                    for (int m = 0; m < 4; ++m) { const int row = row0 + ai * 128 + m * 16, b = row >> 12, sq = row & 4095;
                        bf16* dst = PQ + ((size_t)(b * 512 + n) * 2 + pq) * 4096 + sq;
#pragma unroll
                        for (int nn = 0; nn < 2; ++nn)
#pragma unroll
                            for (int j = 0; j < 4; ++j) dst[(size_t)(4 * nn + j) * 8192] = (bf16)f2bf(acc[ai][bj][m][nn][j]); } }
        }
    }
};
struct EpiGate {
    static constexpr bool PERM = true;
    bf16* O; const bf16* Z; int coff, goff;
    __device__ __forceinline__ void operator()(const pg8::f32x4 (&acc)[2][2][4][2], const pg8::Unit& u, int wr, int wc, int fr, int fq) const {
        const int row0 = u.pm * 256 + wr * 64 + fr, col0 = u.pn * 256 + wc * 32 + 8 * fq;
#pragma unroll
        for (int ai = 0; ai < 2; ++ai)
#pragma unroll
            for (int m = 0; m < 4; ++m) { const size_t row = (size_t)(row0 + ai * 128 + m * 16);
#pragma unroll
                for (int bj = 0; bj < 2; ++bj) { const pg8::f32x4 v0 = acc[ai][bj][m][0], v1 = acc[ai][bj][m][1];
                    const u32x4 gz = *(const u32x4*)(Z + row * DIN + goff + col0 + bj * 128); u32x4 w;
                    w.x = pg8::cvt_pk_bf16(v0[0] * silu_f(bflo(gz.x)), v0[1] * silu_f(bfhi(gz.x))); w.y = pg8::cvt_pk_bf16(v0[2] * silu_f(bflo(gz.y)), v0[3] * silu_f(bfhi(gz.y)));
                    w.z = pg8::cvt_pk_bf16(v1[0] * silu_f(bflo(gz.z)), v1[1] * silu_f(bfhi(gz.z))); w.w = pg8::cvt_pk_bf16(v1[2] * silu_f(bflo(gz.w)), v1[3] * silu_f(bfhi(gz.w)));
                    *(u32x4*)(O + row * DM + coff + col0 + bj * 128) = w; } }
    }
};
struct EpiPart {
    static constexpr bool PERM = false;
    float* P;
    __device__ __forceinline__ void operator()(const pg8::f32x4 (&acc)[2][2][4][2], const pg8::Unit& u, int wr, int wc, int fr, int fq) const {
        const int row0 = u.pm * 256 + wr * 64 + fr, col0 = u.pn * 256 + wc * 32 + 4 * fq;
        float* base = P + (size_t)u.aux * 4096 * 512;
#pragma unroll
        for (int ai = 0; ai < 2; ++ai)
#pragma unroll
            for (int m = 0; m < 4; ++m) { float* rowp = base + (size_t)(row0 + ai * 128 + m * 16) * 512 + col0;
#pragma unroll
                for (int bj = 0; bj < 2; ++bj)
#pragma unroll
                    for (int n = 0; n < 2; ++n) *(pg8::f32x4*)(rowp + bj * 128 + n * 16) = acc[ai][bj][m][n]; }
    }
};
struct EpiRes {
    static constexpr bool PERM = false;
    const float* xin; float* xout; const float* gate;
    __device__ __forceinline__ void operator()(const pg8::f32x4 (&acc)[2][2][4][2], const pg8::Unit& u, int wr, int wc, int fr, int fq) const {
        const int row0 = u.pm * 256 + wr * 64 + fr, col0 = u.pn * 256 + wc * 32 + 4 * fq;
        const float* gp = gate + (size_t)(u.pm >> 4) * 6144 + col0;
        pg8::f32x4 gv[2][2];
#pragma unroll
        for (int bj = 0; bj < 2; ++bj)
#pragma unroll
            for (int n = 0; n < 2; ++n) gv[bj][n] = *(const pg8::f32x4*)(gp + bj * 128 + n * 16);
#pragma unroll
        for (int ai = 0; ai < 2; ++ai)
#pragma unroll
            for (int m = 0; m < 4; ++m) { const size_t ro = (size_t)(row0 + ai * 128 + m * 16) * DM + col0;
#pragma unroll
                for (int bj = 0; bj < 2; ++bj)
#pragma unroll
                    for (int n = 0; n < 2; ++n) { const pg8::f32x4 xi = *(const pg8::f32x4*)(xin + ro + bj * 128 + n * 16);
                        *(pg8::f32x4*)(xout + ro + bj * 128 + n * 16) = xi + gv[bj][n] * acc[ai][bj][m][n]; } }
    }
};

__device__ __forceinline__ void transpose_tile(const float* W, int K, int N, bf16* WT, int item, float* scr) {
    const int tid = otid(), nb = N / 64, kb = item / nb, nbk = item % nb, k0 = kb * 64, n0 = nbk * 64;
#pragma unroll
    for (int i = 0; i < 2; ++i) { const int kk = (tid >> 4) + 32 * i, nn = (tid & 15) * 4;
        const f32x4 v = *(const f32x4*)(W + (size_t)(k0 + kk) * N + n0 + nn);
        scr[kk * 65 + nn] = v[0]; scr[kk * 65 + nn + 1] = v[1]; scr[kk * 65 + nn + 2] = v[2]; scr[kk * 65 + nn + 3] = v[3]; }
    __syncthreads();
    { const int n = tid >> 3, kc = (tid & 7) * 8; const float* s = scr + kc * 65 + n; u32x4 o;
      o.x = pk2(s[0], s[65]); o.y = pk2(s[2 * 65], s[3 * 65]); o.z = pk2(s[4 * 65], s[5 * 65]); o.w = pk2(s[6 * 65], s[7 * 65]);
      *(u32x4*)(WT + (size_t)(n0 + n) * K + k0 + kc) = o; }
    __syncthreads();
}

__device__ __forceinline__ void ph_prologue(const Params& p_, unsigned char* lds) {
    const Params p = *kparams(); (void)p_;
    const int tid = otid(), lane = tid & 63, wave = tid >> 6, G = gridDim.x, bid = obid();
    float* scr = (float*)lds;
    bf16* Wt_in = (bf16*)(p.ws + WS_WIN); bf16* Wt_out = (bf16*)(p.ws + WS_WOUT); bf16* Wt_pw = (bf16*)(p.ws + WS_WPW);
    constexpr int T_IN = 32 * 96, T_OUT = 32 * 32, T_S = 64, T_L = T_IN + T_OUT + T_S;
    for (int it = bid; it < NL * T_L; it += G) {
        const int l = it / T_L; int r = it % T_L;
        if (r < T_IN) { const int kb = r / 96, nb = 8 + r % 96; transpose_tile(p.w_in + (size_t)l * DM * DIN, DM, DIN, Wt_in + (size_t)l * WROWS * DM, kb * 104 + nb, scr); continue; } r -= T_IN;
        if (r < T_OUT) { transpose_tile(p.w_out + (size_t)l * DM * DM, DM, DM, Wt_out + (size_t)l * DM * DM, r, scr); continue; } r -= T_OUT;
        transpose_tile(p.w_pw + (size_t)l * DG * DG, DG, DG, Wt_pw + (size_t)l * DG * DG, r, scr);
    }
    { bf16* Wfx = (bf16*)(p.ws + WS_WFXB);
      for (int e = bid * NTHR + tid; e < NL * DM * DG / 8; e += G * NTHR) { const int l = e >> 17, r = e & 131071, k = r >> 6, c8 = (r & 63) * 8;
          const float* src = p.w_in + ((size_t)l * DM + k) * DIN + c8; const f32x4 a = *(const f32x4*)src, b4 = *(const f32x4*)(src + 4);
          u32x4 o; o.x = pk2(a[0], a[1]); o.y = pk2(a[2], a[3]); o.z = pk2(b4[0], b4[1]); o.w = pk2(b4[2], b4[3]);
          *(u32x4*)(Wfx + ((size_t)l * DM + k) * DG + c8) = o; } }
    { float* Wl = (float*)lds; float* tr = Wl + 128 * 65; bf16* Wcs = (bf16*)(p.ws + WS_WCS);
      for (int t = G - 1 - bid; t < 128; t += G) {
          const int l = t >> 6, pq = (t >> 5) & 1, g = (t >> 3) & 3, n0 = (t & 7) * 64;
#pragma unroll
          for (int i = 0; i < 4; ++i) { const int m = (tid >> 4) + 32 * i, nn = (tid & 15) * 4;
              const f32x4 v = *(const f32x4*)(p.w_fft + ((size_t)l * DG + g * 128 + m) * DG + n0 + nn);
              Wl[m * 65 + nn] = v[0]; Wl[m * 65 + nn + 1] = v[1]; Wl[m * 65 + nn + 2] = v[2]; Wl[m * 65 + nn + 3] = v[3]; }
          if (tid < 128) tr[tid] = pq ? sinpif((float)tid * (1.f / 64.f)) : cospif((float)tid * (1.f / 64.f));
          __syncthreads();
          const int nn = tid >> 3, cc = (tid & 7) * 16; float acc[16];
#pragma unroll
          for (int i = 0; i < 16; ++i) acc[i] = 0.f;
          for (int m = 0; m < 128; ++m) { const float w = Wl[m * 65 + nn];
#pragma unroll
              for (int i = 0; i < 16; ++i) acc[i] += tr[((cc + i) * m) & 127] * w; }
          const float nrm = 0.0013810679320049757f;
          u32x4 o0, o1;
          o0.x = pk2(acc[0] * nrm, acc[1] * nrm); o0.y = pk2(acc[2] * nrm, acc[3] * nrm); o0.z = pk2(acc[4] * nrm, acc[5] * nrm); o0.w = pk2(acc[6] * nrm, acc[7] * nrm);
          o1.x = pk2(acc[8] * nrm, acc[9] * nrm); o1.y = pk2(acc[10] * nrm, acc[11] * nrm); o1.z = pk2(acc[12] * nrm, acc[13] * nrm); o1.w = pk2(acc[14] * nrm, acc[15] * nrm);
          bf16* dst = Wcs + ((size_t)l * 1024 + pq * 512 + n0 + nn) * DG + g * 128 + cc;
          *(u32x4*)dst = o0; *(u32x4*)(dst + 8) = o1;
          __syncthreads();
      } }
    __syncthreads();
    float* cosT = (float*)(lds + 32768); float* sinT = (float*)(lds + 49152); float* ca = (float*)(lds + 65536); float* red = (float*)(lds + 81920);
    for (int j = tid; j < 4096; j += NTHR) { cosT[j] = cospif((float)j * (1.f / 2048.f)); sinT[j] = sinpif((float)j * (1.f / 2048.f)); }
    for (int j = tid; j < 4096; j += NTHR) { const float cv = p.c[j]; ca[j] = cv / (1.f + expf(-cv)); }
    __syncthreads();
    bf16* DFT = (bf16*)(p.ws + WS_DFT);
    for (int k = bid; k < 4096; k += G) {
#pragma unroll
        for (int cc = 0; cc < 2; ++cc) { const int kk0 = (tid + cc * NTHR) * 8; float v[8];
#pragma unroll
            for (int j = 0; j < 8; ++j) { const int kk = kk0 + j, idx = (k * (kk & 4095)) & 4095; v[j] = (kk < 4096) ? cosT[idx] : -sinT[idx]; }
            u32x4 o; o.x = pk2(v[0], v[1]); o.y = pk2(v[2], v[3]); o.z = pk2(v[4], v[5]); o.w = pk2(v[6], v[7]);
            *(u32x4*)(DFT + (size_t)k * 8192 + kk0) = o; }
    }
    { float2* rope = (float2*)(p.ws + WS_ROPE);
      for (int e = bid * NTHR + tid; e < 4096 * 32; e += G * NTHR) { const int s = e >> 5, i = e & 31;
          const float inv = (float)pow(10000.0, -(double)i / 32.0); const float ang = (float)s * inv;
          double sn, cs; sincos((double)ang, &sn, &cs); rope[e] = make_float2((float)cs, (float)sn); } }
    float* mod = (float*)(p.ws + WS_MOD);
    for (int t = bid; t < 192; t += G) {
        const int l = t / 96, col = (t % 96) * 64 + lane; const float* W = p.w_ada + (size_t)l * DM * 6144 + col;
        float a0 = 0.f, a1 = 0.f;
#pragma unroll 8
        for (int k = wave * 256; k < wave * 256 + 256; ++k) { const float w = W[(size_t)k * 6144]; a0 += ca[k] * w; a1 += ca[2048 + k] * w; }
        red[(wave * 2 + 0) * 64 + lane] = a0; red[(wave * 2 + 1) * 64 + lane] = a1;
        __syncthreads();
        if (wave < 2) { float s = 0.f;
#pragma unroll
            for (int w = 0; w < 8; ++w) s += red[(w * 2 + wave) * 64 + lane];
            mod[(size_t)(l * 2 + wave) * 6144 + col] = s + p.b_ada[l * 6144 + col]; }
        __syncthreads();
    }
}

__device__ __forceinline__ void ph_norm(const Params& p_, int l) {
    const Params p = *kparams(); (void)p_;
    const int tid = otid(), lane = tid & 63, wave = tid >> 6;
    const float* xin = (l == 0) ? p.x : p.out; bf16* h = (bf16*)(p.ws + WS_U); const float* mod = (const float*)(p.ws + WS_MOD);
    for (int row = obid() * 8 + wave; row < MTOK; row += gridDim.x * 8) {
        const f32x4* xr = (const f32x4*)(xin + (size_t)row * DM) + lane; f32x4 v[8]; float ss = 0.f;
#pragma unroll
        for (int j = 0; j < 8; ++j) { v[j] = xr[64 * j]; ss += (v[j][0] * v[j][0] + v[j][1] * v[j][1]) + (v[j][2] * v[j][2] + v[j][3] * v[j][3]); }
        ss = wave_sum(ss); const float rstd = rsqrtf(ss * (1.f / DM) + 1e-6f);
        const float* md = mod + (size_t)(l * 2 + (row >> 12)) * 6144; const float* g = p.norm_g + l * DM;
#pragma unroll
        for (int j = 0; j < 8; ++j) { const int col = (64 * j + lane) * 4;
            const f32x4 g4 = *(const f32x4*)(g + col), sh = *(const f32x4*)(md + col), sc = *(const f32x4*)(md + 2048 + col);
            const f32x4 o = (v[j] * rstd * g4) * (sc + 1.f) + sh; u32x2 w; w.x = pk2(o[0], o[1]); w.y = pk2(o[2], o[3]);
            *(u32x2*)(h + (size_t)row * DM + col) = w; }
    }
}
__device__ __forceinline__ void ph_final(const Params& p_) {
    const Params p = *kparams(); (void)p_;
    const int tid = otid(), lane = tid & 63, wave = tid >> 6;
    for (int row = obid() * 8 + wave; row < MTOK; row += gridDim.x * 8) {
        f32x4* xr = (f32x4*)(p.out + (size_t)row * DM) + lane; f32x4 v[8]; float ss = 0.f;
#pragma unroll
        for (int j = 0; j < 8; ++j) { v[j] = xr[64 * j]; ss += (v[j][0] * v[j][0] + v[j][1] * v[j][1]) + (v[j][2] * v[j][2] + v[j][3] * v[j][3]); }
        ss = wave_sum(ss); const float rstd = rsqrtf(ss * (1.f / DM) + 1e-6f);
#pragma unroll
        for (int j = 0; j < 8; ++j) { const int col = (64 * j + lane) * 4; const f32x4 g4 = *(const f32x4*)(p.final_g + col); xr[64 * j] = v[j] * rstd * g4; }
    }
}

#ifndef REP_PRO
#define REP_PRO 1
#endif
#ifndef REP_NORM
#define REP_NORM 1
#endif
#ifndef REP_Z
#define REP_Z 1
#endif
#ifndef REP_MIX
#define REP_MIX 1
#endif
#ifndef REP_P3
#define REP_P3 1
#endif
#ifndef REP_R2
#define REP_R2 1
#endif
#ifndef REP_CMB
#define REP_CMB 1
#endif
#ifndef REP_FFT
#define REP_FFT 1
#endif
#ifndef REP_OUT
#define REP_OUT 1
#endif
#ifndef REP_SUB
#define REP_SUB 1
#endif

#ifndef REP_R1
#define REP_R1 1
#endif
#ifndef REP_NA
#define REP_NA 1
#endif
#ifndef REP_CV
#define REP_CV 1
#endif
#ifndef REP_F1
#define REP_F1 1
#endif
#define REPEAT(n) for (int rep_ = 0; rep_ < (n); ++rep_)
typedef short bf16x8v __attribute__((ext_vector_type(8)));
__device__ __forceinline__ bf16x8v mk8(unsigned a, unsigned b, unsigned c, unsigned d) { u32x4 v = {a, b, c, d}; return __builtin_bit_cast(bf16x8v, v); }
#define MFMA16(a, b, c) __builtin_amdgcn_mfma_f32_16x16x32_bf16(a, b, c, 0, 0, 0)
constexpr int R_QS = 0, R_KS = 18432, R_VT = 36864, R_KTF = 54272, R_KTB = 71680, R_STF = 89088, R_STB = 98304;

template <bool R2>
__device__ __forceinline__ void ret_stage(const Params& p_, int b, int h, int n, unsigned char* lds, float l2f, float l2b) {
    const Params p = *kparams(); (void)p_;
    const int tid = otid(), j = tid >> 2, c4 = tid & 3, s = n * 128 + j;
    const bf16* Z = (const bf16*)(p.ws + WS_Z); const bf16* zr = Z + (size_t)(b * SEQ + s) * DIN;
    const f32x4* rp = (const f32x4*)((const float2*)(p.ws + WS_ROPE) + s * 32 + c4 * 8);
    float cs[8], sn[8];
#pragma unroll
    for (int i = 0; i < 4; ++i) { const f32x4 r = rp[i]; cs[2 * i] = r[0]; sn[2 * i] = r[1]; cs[2 * i + 1] = r[2]; sn[2 * i + 1] = r[3]; }
    bf16* KS = (bf16*)(lds + R_KS); bf16* VT = (bf16*)(lds + R_VT);
    { const u32x4 ka = *(const u32x4*)(zr + 7 * DG + h * 64 + c4 * 8), kb = *(const u32x4*)(zr + 7 * DG + h * 64 + 32 + c4 * 8);
      const unsigned kau[4] = {ka.x, ka.y, ka.z, ka.w}, kbu[4] = {kb.x, kb.y, kb.z, kb.w};
      float k1[8], k2[8];
#pragma unroll
      for (int i = 0; i < 4; ++i) { const float a0 = bflo(kau[i]), a1 = bfhi(kau[i]), b0 = bflo(kbu[i]), b1 = bfhi(kbu[i]);
          k1[2 * i] = a0 * cs[2 * i] - b0 * sn[2 * i]; k2[2 * i] = a0 * sn[2 * i] + b0 * cs[2 * i];
          k1[2 * i + 1] = a1 * cs[2 * i + 1] - b1 * sn[2 * i + 1]; k2[2 * i + 1] = a1 * sn[2 * i + 1] + b1 * cs[2 * i + 1]; }
      u32x4 o1, o2; o1.x = pk2(k1[0], k1[1]); o1.y = pk2(k1[2], k1[3]); o1.z = pk2(k1[4], k1[5]); o1.w = pk2(k1[6], k1[7]);
      o2.x = pk2(k2[0], k2[1]); o2.y = pk2(k2[2], k2[3]); o2.z = pk2(k2[4], k2[5]); o2.w = pk2(k2[6], k2[7]);
      *(u32x4*)(KS + j * 72 + c4 * 8) = o1; *(u32x4*)(KS + j * 72 + 32 + c4 * 8) = o2;
      if (!R2) { bf16* KTF = (bf16*)(lds + R_KTF); bf16* KTB = (bf16*)(lds + R_KTB);
          const float df = exp2f(l2f * (float)(127 - j)), db = exp2f(l2b * (float)j);
#pragma unroll
          for (int i = 0; i < 8; ++i) { KTF[(c4 * 8 + i) * 136 + j] = (bf16)f2bf(k1[i] * df); KTF[(32 + c4 * 8 + i) * 136 + j] = (bf16)f2bf(k2[i] * df);
              KTB[(c4 * 8 + i) * 136 + j] = (bf16)f2bf(k1[i] * db); KTB[(32 + c4 * 8 + i) * 136 + j] = (bf16)f2bf(k2[i] * db); } } }
    { const u32x4 va = *(const u32x4*)(zr + 8 * DG + h * 64 + c4 * 16), vb = *(const u32x4*)(zr + 8 * DG + h * 64 + c4 * 16 + 8);
      const unsigned vu[8] = {va.x, va.y, va.z, va.w, vb.x, vb.y, vb.z, vb.w};
#pragma unroll
      for (int i = 0; i < 8; ++i) { VT[(c4 * 16 + 2 * i) * 136 + j] = (bf16)(vu[i] & 0xffffu); VT[(c4 * 16 + 2 * i + 1) * 136 + j] = (bf16)(vu[i] >> 16); } }
    if (R2) { bf16* QS = (bf16*)(lds + R_QS);
      const u32x4 qa = *(const u32x4*)(zr + 6 * DG + h * 64 + c4 * 8), qb = *(const u32x4*)(zr + 6 * DG + h * 64 + 32 + c4 * 8);
      const unsigned qau[4] = {qa.x, qa.y, qa.z, qa.w}, qbu[4] = {qb.x, qb.y, qb.z, qb.w};
      float q1[8], q2[8];
#pragma unroll
      for (int i = 0; i < 4; ++i) { const float a0 = bflo(qau[i]), a1 = bfhi(qau[i]), b0 = bflo(qbu[i]), b1 = bfhi(qbu[i]);
          q1[2 * i] = (a0 * cs[2 * i] - b0 * sn[2 * i]) * 0.125f; q2[2 * i] = (a0 * sn[2 * i] + b0 * cs[2 * i]) * 0.125f;
          q1[2 * i + 1] = (a1 * cs[2 * i + 1] - b1 * sn[2 * i + 1]) * 0.125f; q2[2 * i + 1] = (a1 * sn[2 * i + 1] + b1 * cs[2 * i + 1]) * 0.125f; }
      u32x4 o1, o2; o1.x = pk2(q1[0], q1[1]); o1.y = pk2(q1[2], q1[3]); o1.z = pk2(q1[4], q1[5]); o1.w = pk2(q1[6], q1[7]);
      o2.x = pk2(q2[0], q2[1]); o2.y = pk2(q2[2], q2[3]); o2.z = pk2(q2[4], q2[5]); o2.w = pk2(q2[6], q2[7]);
      *(u32x4*)(QS + j * 72 + c4 * 8) = o1; *(u32x4*)(QS + j * 72 + 32 + c4 * 8) = o2; }
}

__device__ __forceinline__ void ret1_task(const Params& p_, int l, int task, unsigned char* lds) {
    const Params p = *kparams(); (void)p_;
    const int n = task & 31, h = (task >> 5) & 7, b = task >> 8;
    const float xf = p.rl_f[l * 8 + h], xb = p.rl_b[l * 8 + h];
    const float l2f = -log1pf(expf(-xf)) * 1.4426950408889634f, l2b = -log1pf(expf(-xb)) * 1.4426950408889634f;
    ret_stage<false>(p, b, h, n, lds, l2f, l2b);
    __syncthreads();
    const int tid = otid(), lane = tid & 63, w = tid >> 6, fr = lane & 15, fq = lane >> 4, dir = w >> 2, et = w & 3;
    const bf16* VT = (const bf16*)(lds + R_VT); const bf16* KT = (const bf16*)(lds + (dir ? R_KTB : R_KTF));
    bf16x8v a[4];
#pragma unroll
    for (int ks = 0; ks < 4; ++ks) a[ks] = *(const bf16x8v*)(VT + (16 * et + fr) * 136 + 32 * ks + 8 * fq);
    float* dst = (float*)(p.ws + WS_KV) + ((size_t)((dir * 2 + b) * 8 + h) * 32 + n) * 4096;
#pragma unroll
    for (int dt = 0; dt < 4; ++dt) { f32x4 acc = {0.f, 0.f, 0.f, 0.f};
#pragma unroll
        for (int ks = 0; ks < 4; ++ks) { const bf16x8v bfr = *(const bf16x8v*)(KT + (16 * dt + fr) * 136 + 32 * ks + 8 * fq); acc = MFMA16(a[ks], bfr, acc); }
#pragma unroll
        for (int r = 0; r < 4; ++r) dst[(16 * et + 4 * fq + r) * 64 + 16 * dt + fr] = acc[r]; }
    __syncthreads();
}

__device__ __forceinline__ void ret2_task(const Params& p_, int l, int task, unsigned char* lds) {
    const Params p = *kparams(); (void)p_;
    const int n = task & 31, h = (task >> 5) & 7, b = task >> 8;
    const float xf = p.rl_f[l * 8 + h], xb = p.rl_b[l * 8 + h];
    const float l2f = -log1pf(expf(-xf)) * 1.4426950408889634f, l2b = -log1pf(expf(-xb)) * 1.4426950408889634f;
    ret_stage<true>(p, b, h, n, lds, l2f, l2b);
    const int tid = otid(), lane = tid & 63, w = tid >> 6, fr = lane & 15, fq = lane >> 4;
    {
      const float gfC = exp2f(l2f * 128.f), gbC = exp2f(l2b * 128.f);
      const float* KVf = (const float*)(p.ws + WS_KV) + ((size_t)((0 * 2 + b) * 8 + h) * 32) * 4096 + tid * 8;
      const float* KVb = (const float*)(p.ws + WS_KV) + ((size_t)((1 * 2 + b) * 8 + h) * 32) * 4096 + tid * 8;
      f32x4 f0 = {0.f, 0.f, 0.f, 0.f}, f1 = f0, g0 = f0, g1 = f0;
      float cw[4]; cw[0] = 1.f;
      { const float g2 = gfC * gfC; float c1 = gfC, c2 = g2, c3 = g2 * gfC; const float g4 = g2 * g2; float c0 = 1.f;
        int m = n - 1;
        for (; m >= 3; m -= 4) { const f32x4 a0 = *(const f32x4*)(KVf + (size_t)m * 4096), a1 = *(const f32x4*)(KVf + (size_t)m * 4096 + 4), b0 = *(const f32x4*)(KVf + (size_t)(m - 1) * 4096), b1 = *(const f32x4*)(KVf + (size_t)(m - 1) * 4096 + 4),
              c0v = *(const f32x4*)(KVf + (size_t)(m - 2) * 4096), c1v = *(const f32x4*)(KVf + (size_t)(m - 2) * 4096 + 4), d0v = *(const f32x4*)(KVf + (size_t)(m - 3) * 4096), d1v = *(const f32x4*)(KVf + (size_t)(m - 3) * 4096 + 4);
            f0 += a0 * c0 + b0 * c1 + c0v * c2 + d0v * c3; f1 += a1 * c0 + b1 * c1 + c1v * c2 + d1v * c3; c0 *= g4; c1 *= g4; c2 *= g4; c3 *= g4; }
        for (; m >= 0; --m) { const f32x4 x0 = *(const f32x4*)(KVf + (size_t)m * 4096), x1 = *(const f32x4*)(KVf + (size_t)m * 4096 + 4); f0 += x0 * c0; f1 += x1 * c0; c0 *= gfC; } }
      { const float g2 = gbC * gbC; float c0 = 1.f, c1 = gbC, c2 = g2, c3 = g2 * gbC; const float g4 = g2 * g2;
        int m = n + 1;
        for (; m + 3 < 32; m += 4) { const f32x4 a0 = *(const f32x4*)(KVb + (size_t)m * 4096), a1 = *(const f32x4*)(KVb + (size_t)m * 4096 + 4), b0 = *(const f32x4*)(KVb + (size_t)(m + 1) * 4096), b1 = *(const f32x4*)(KVb + (size_t)(m + 1) * 4096 + 4),
              c0v = *(const f32x4*)(KVb + (size_t)(m + 2) * 4096), c1v = *(const f32x4*)(KVb + (size_t)(m + 2) * 4096 + 4), d0v = *(const f32x4*)(KVb + (size_t)(m + 3) * 4096), d1v = *(const f32x4*)(KVb + (size_t)(m + 3) * 4096 + 4);
            g0 += a0 * c0 + b0 * c1 + c0v * c2 + d0v * c3; g1 += a1 * c0 + b1 * c1 + c1v * c2 + d1v * c3; c0 *= g4; c1 *= g4; c2 *= g4; c3 *= g4; }
        for (; m < 32; ++m) { const f32x4 x0 = *(const f32x4*)(KVb + (size_t)m * 4096), x1 = *(const f32x4*)(KVb + (size_t)m * 4096 + 4); g0 += x0 * c0; g1 += x1 * c0; c0 *= gbC; } }
      (void)cw;
      const int e = tid >> 3, d0 = (tid & 7) * 8; u32x4 o;
      o.x = pk2(f0[0], f0[1]); o.y = pk2(f0[2], f0[3]); o.z = pk2(f1[0], f1[1]); o.w = pk2(f1[2], f1[3]); *(u32x4*)((bf16*)(lds + R_STF) + e * 72 + d0) = o;
      o.x = pk2(g0[0], g0[1]); o.y = pk2(g0[2], g0[3]); o.z = pk2(g1[0], g1[1]); o.w = pk2(g1[2], g1[3]); *(u32x4*)((bf16*)(lds + R_STB) + e * 72 + d0) = o; }
    __syncthreads();
    const bf16* QS = (const bf16*)(lds + R_QS); const bf16* KS = (const bf16*)(lds + R_KS); const bf16* VT = (const bf16*)(lds + R_VT);
    const bf16* STF = (const bf16*)(lds + R_STF); const bf16* STB = (const bf16*)(lds + R_STB);
    bf16x8v qf[2];
#pragma unroll
    for (int ks = 0; ks < 2; ++ks) qf[ks] = *(const bf16x8v*)(QS + (16 * w + fr) * 72 + 32 * ks + 8 * fq);
    const int ai = 16 * w + fr;
    unsigned pp[8][2];
#pragma unroll
    for (int jt = 0; jt < 8; ++jt) { f32x4 acc = {0.f, 0.f, 0.f, 0.f};
#pragma unroll
        for (int ks = 0; ks < 2; ++ks) { const bf16x8v kf = *(const bf16x8v*)(KS + (16 * jt + fr) * 72 + 32 * ks + 8 * fq); acc = MFMA16(kf, qf[ks], acc); }
        float sc[4];
#pragma unroll
        for (int r = 0; r < 4; ++r) { const int aj = 16 * jt + 4 * fq + r; const float wg = (aj <= ai) ? exp2f(l2f * (float)(ai - aj)) : exp2f(l2b * (float)(aj - ai)); sc[r] = acc[r] * wg; }
        pp[jt][0] = pk2(sc[0], sc[1]); pp[jt][1] = pk2(sc[2], sc[3]); }
    const float qdf = exp2f(l2f * (float)(ai + 1)), qdb = exp2f(l2b * (float)(128 - ai));
    f32x4 tot[4]; float ss = 0.f;
#pragma unroll
    for (int et = 0; et < 4; ++et) { f32x4 o = {0.f, 0.f, 0.f, 0.f}, cfa = o, cba = o;
#pragma unroll
        for (int t = 0; t < 4; ++t) { const u32x2 vlo = *(const u32x2*)(VT + (16 * et + fr) * 136 + 32 * t + 4 * fq), vhi = *(const u32x2*)(VT + (16 * et + fr) * 136 + 32 * t + 16 + 4 * fq);
            o = MFMA16(mk8(vlo.x, vlo.y, vhi.x, vhi.y), mk8(pp[2 * t][0], pp[2 * t][1], pp[2 * t + 1][0], pp[2 * t + 1][1]), o); }
#pragma unroll
        for (int ks = 0; ks < 2; ++ks) { const bf16x8v sf = *(const bf16x8v*)(STF + (16 * et + fr) * 72 + 32 * ks + 8 * fq), sb = *(const bf16x8v*)(STB + (16 * et + fr) * 72 + 32 * ks + 8 * fq);
            cfa = MFMA16(sf, qf[ks], cfa); cba = MFMA16(sb, qf[ks], cba); }
        tot[et] = o + cfa * qdf + cba * qdb;
        ss += (tot[et][0] * tot[et][0] + tot[et][1] * tot[et][1]) + (tot[et][2] * tot[et][2] + tot[et][3] * tot[et][3]); }
    ss += __shfl_xor(ss, 16); ss += __shfl_xor(ss, 32);
    const float rs = rsqrtf(ss * (1.f / 64.f) + 1e-6f);
    const size_t tok = (size_t)b * SEQ + n * 128 + ai;
    const bf16* Z = (const bf16*)(p.ws + WS_Z); bf16* CAT = (bf16*)(p.ws + WS_CAT);
#pragma unroll
    for (int et = 0; et < 4; ++et) { const u32x2 gz = *(const u32x2*)(Z + tok * DIN + 9 * DG + h * 64 + 16 * et + 4 * fq); u32x2 o;
        o.x = pk2(tot[et][0] * rs * silu_f(bflo(gz.x)), tot[et][1] * rs * silu_f(bfhi(gz.x))); o.y = pk2(tot[et][2] * rs * silu_f(bflo(gz.y)), tot[et][3] * rs * silu_f(bfhi(gz.y)));
        *(u32x2*)(CAT + tok * DM + 1024 + h * 64 + 16 * et + 4 * fq) = o; }
    __syncthreads();
}

__device__ __forceinline__ void na2_task(const Params& p_, int l, int task, unsigned char* lds) {
    const Params p = *kparams(); (void)p_;
    const int tid = otid(), lane = tid & 63, w = tid >> 6, fr = lane & 15, fq = lane >> 4;
    const int hp = task & 3, rq = (task >> 2) & 63, b = task >> 8;
    const int row_start = min(max(rq - 4, 0), 56);
    const bf16* Z = (const bf16*)(p.ws + WS_Z); bf16* CAT = (bf16*)(p.ws + WS_CAT);
    bf16* VT = (bf16*)lds; float* BI = (float*)(lds + 133120);
    for (int i = tid; i < 930; i += NTHR) BI[i] = p.na_bias[(size_t)(l * 8 + hp * 2) * 465 + i];
    { const int pair = lane & 31, chunk = (lane >> 5) + 2 * (w & 3), hh = w >> 2, h = hp * 2 + hh;
      unsigned* VTd = (unsigned*)(VT + (size_t)hh * 64 * 520);
#pragma unroll 2
      for (int a = 0; a < 8; ++a) {
          const size_t tok = (size_t)b * SEQ + (row_start + a) * 64 + 2 * pair;
          const bf16* src = Z + tok * DIN + 4 * DG + h * 64 + chunk * 8;
          const u32x4 x = *(const u32x4*)src, y = *(const u32x4*)(src + DIN);
          const unsigned xu[4] = {x.x, x.y, x.z, x.w}, yu[4] = {y.x, y.y, y.z, y.w};
#pragma unroll
          for (int i = 0; i < 4; ++i) { VTd[(chunk * 8 + 2 * i) * 260 + a * 32 + pair] = (xu[i] & 0xffffu) | (yu[i] << 16);
              VTd[(chunk * 8 + 2 * i + 1) * 260 + a * 32 + pair] = (xu[i] >> 16) | (yu[i] & 0xffff0000u); } } }
    __syncthreads();
    const int hh = w >> 2, h = hp * 2 + hh, qb = w & 3, ct0 = (qb >= 2) ? 1 : 0;
    const int c = 16 * qb + fr; const size_t qtok = (size_t)b * SEQ + rq * 64 + c;
    bf16x8v qf[2];
#pragma unroll
    for (int ks = 0; ks < 2; ++ks) qf[ks] = *(const bf16x8v*)(Z + qtok * DIN + 2 * DG + h * 64 + 32 * ks + 8 * fq);
    const int col_start = min(max(c - 8, 0), 48);
    const float* bi = BI + hh * 465;
    float sc[24][4]; float mx = -1e30f;
#pragma unroll
    for (int a = 0; a < 8; ++a)
#pragma unroll
        for (int ci = 0; ci < 3; ++ci) { const int kt = a * 3 + ci;
            const size_t ktok = (size_t)b * SEQ + (row_start + a) * 64 + 16 * (ct0 + ci) + fr;
            f32x4 acc = {0.f, 0.f, 0.f, 0.f};
#pragma unroll
            for (int ks = 0; ks < 2; ++ks) { const bf16x8v kf = *(const bf16x8v*)(Z + ktok * DIN + 3 * DG + h * 64 + 32 * ks + 8 * fq); acc = MFMA16(kf, qf[ks], acc); }
            const int dr = row_start + a - rq;
#pragma unroll
            for (int r = 0; r < 4; ++r) { const int kc = 16 * (ct0 + ci) + 4 * fq + r, rel = kc - col_start, dc = kc - c;
                float v = acc[r] * 0.125f + bi[(dr + 7) * 31 + min(max(dc + 15, 0), 30)];
                v = (rel >= 0 && rel < 16) ? v : -1e30f; sc[kt][r] = v; mx = fmaxf(mx, v); } }
    mx = fmaxf(mx, __shfl_xor(mx, 16)); mx = fmaxf(mx, __shfl_xor(mx, 32));
    float sum = 0.f; unsigned pp[24][2];
#pragma unroll
    for (int kt = 0; kt < 24; ++kt) { const float e0 = __expf(sc[kt][0] - mx), e1 = __expf(sc[kt][1] - mx), e2 = __expf(sc[kt][2] - mx), e3 = __expf(sc[kt][3] - mx);
        sum += (e0 + e1) + (e2 + e3); pp[kt][0] = pk2(e0, e1); pp[kt][1] = pk2(e2, e3); }
    sum += __shfl_xor(sum, 16); sum += __shfl_xor(sum, 32);
    const float inv = 1.f / sum;
    const bf16* VTh = VT + (size_t)hh * 64 * 520;
#pragma unroll
    for (int dt = 0; dt < 4; ++dt) { f32x4 o = {0.f, 0.f, 0.f, 0.f};
#pragma unroll
        for (int t = 0; t < 12; ++t) { const int k0 = 2 * t, k1 = 2 * t + 1, a0 = k0 / 3, c0 = k0 % 3, a1 = k1 / 3, c1 = k1 % 3;
            const u32x2 vlo = *(const u32x2*)(VTh + (16 * dt + fr) * 520 + a0 * 64 + 16 * (ct0 + c0) + 4 * fq), vhi = *(const u32x2*)(VTh + (16 * dt + fr) * 520 + a1 * 64 + 16 * (ct0 + c1) + 4 * fq);
            o = MFMA16(mk8(vlo.x, vlo.y, vhi.x, vhi.y), mk8(pp[k0][0], pp[k0][1], pp[k1][0], pp[k1][1]), o); }
        const u32x2 gz = *(const u32x2*)(Z + qtok * DIN + 5 * DG + h * 64 + 16 * dt + 4 * fq); u32x2 ov;
        ov.x = pk2(o[0] * inv * silu_f(bflo(gz.x)), o[1] * inv * silu_f(bfhi(gz.x))); ov.y = pk2(o[2] * inv * silu_f(bflo(gz.y)), o[3] * inv * silu_f(bfhi(gz.y)));
        *(u32x2*)(CAT + qtok * DM + 512 + h * 64 + 16 * dt + 4 * fq) = ov; }
    __syncthreads();
}

__device__ __forceinline__ void conv_task(const Params& p_, int l, int task, unsigned char* lds) {
    const Params p = *kparams(); (void)p_;
    const int tid = otid(), lane = tid & 63, wave = tid >> 6;
    float* us = (float*)lds; float* ys = us + 46 * 512;
    const bf16* Z = (const bf16*)(p.ws + WS_Z);
    const int b = task >> 8, t0 = (task & 255) * 16;
#pragma unroll
    for (int it = 0; it < 6; ++it) { const int idx = tid + it * NTHR, tt = idx >> 6, cc = (idx & 63) * 8, tok = t0 - 15 + tt;
        if (idx < 46 * 64) { f32x4 u0 = {0.f, 0.f, 0.f, 0.f}, u1 = u0;
            if (tok >= 0 && tok < SEQ) { const bf16* zr = Z + (size_t)(b * SEQ + tok) * DIN; const u32x4 a = *(const u32x4*)(zr + 10 * DG + cc), g = *(const u32x4*)(zr + 11 * DG + cc);
                u0[0] = bflo(a.x) / (1.f + __expf(-bflo(g.x))); u0[1] = bfhi(a.x) / (1.f + __expf(-bfhi(g.x))); u0[2] = bflo(a.y) / (1.f + __expf(-bflo(g.y))); u0[3] = bfhi(a.y) / (1.f + __expf(-bfhi(g.y)));
                u1[0] = bflo(a.z) / (1.f + __expf(-bflo(g.z))); u1[1] = bfhi(a.z) / (1.f + __expf(-bfhi(g.z))); u1[2] = bflo(a.w) / (1.f + __expf(-bflo(g.w))); u1[3] = bfhi(a.w) / (1.f + __expf(-bfhi(g.w))); }
            *(f32x4*)(us + tt * 512 + cc) = u0; *(f32x4*)(us + tt * 512 + cc + 4) = u1; } }
    float w[31];
#pragma unroll
    for (int k = 0; k < 31; ++k) w[k] = p.conv_w[(size_t)(l * 31 + k) * DG + tid];
    const float cb = p.conv_b[l * DG + tid];
    __syncthreads();
    for (int t = 0; t < 16; ++t) { float acc = cb;
#pragma unroll
        for (int k = 0; k < 31; ++k) acc += w[k] * us[(t + k) * 512 + tid];
        ys[t * 512 + tid] = acc; }
    __syncthreads();
#pragma unroll
    for (int tw = 0; tw < 2; ++tw) { const int t = wave + 8 * tw; float v[8]; float s = 0.f;
#pragma unroll
        for (int j = 0; j < 8; ++j) { v[j] = ys[t * 512 + lane + 64 * j]; s += v[j]; }
        const float mu = wave_sum(s) * (1.f / 512.f); float q = 0.f;
#pragma unroll
        for (int j = 0; j < 8; ++j) { v[j] -= mu; q += v[j] * v[j]; }
        const float rstd = rsqrtf(wave_sum(q) * (1.f / 512.f) + 1e-6f);
        bf16* orow = (bf16*)(p.ws + WS_CVH) + (size_t)(b * SEQ + t0 + t) * DG;
#pragma unroll
        for (int j = 0; j < 8; ++j) { const int ch = lane + 64 * j; const float y = v[j] * rstd * p.ln_g[l * DG + ch] + p.ln_b[l * DG + ch]; orow[ch] = (bf16)f2bf(silu_f(y)); } }
    __syncthreads();
}

__device__ __forceinline__ void ph_mixA(const Params& p, int l, unsigned char* lds) {
    const int G = gridDim.x, bid = obid();
    for (int t = bid; t < 512 * REP_R1; t += G) ret1_task(p, l, t & 511, lds);
    if (G == 256 && REP_NA == 1) {
        if (bid < 128) na2_task(p, l, bid, lds);
        else for (int i = 0; i < 3; ++i) na2_task(p, l, 128 + (bid - 128) * 3 + i, lds);
    } else for (int t = bid; t < 512 * REP_NA; t += G) na2_task(p, l, t & 511, lds);
    for (int t = bid; t < 512 * REP_CV; t += G) conv_task(p, l, t & 511, lds);
}

__device__ __forceinline__ void ph_combine(const Params& p_) {
    const Params p = *kparams(); (void)p_;
    const float* part = (const float*)(p.ws + WS_U); bf16* CAT = (bf16*)(p.ws + WS_CAT); const bf16* Z = (const bf16*)(p.ws + WS_Z);
    for (int e = obid() * NTHR + otid(); e < MTOK * DG / 4; e += gridDim.x * NTHR) {
        const int row = e >> 7, c4 = (e & 127) * 4, b = row >> 12, k = row & 4095;
        f32x4 s = {0.f, 0.f, 0.f, 0.f};
#pragma unroll
        for (int ks = 0; ks < 4; ++ks) s += *(const f32x4*)(part + ((size_t)((b * 4 + ks) * 4096 + k)) * 512 + c4);
        const u32x2 gz = *(const u32x2*)(Z + (size_t)row * DIN + DG + c4);
        u32x2 w; w.x = pk2(s[0] * silu_f(bflo(gz.x)), s[1] * silu_f(bfhi(gz.x))); w.y = pk2(s[2] * silu_f(bflo(gz.y)), s[3] * silu_f(bfhi(gz.y)));
        *(u32x2*)(CAT + (size_t)row * DM + c4) = w;
    }
}

#define XB_TMO      128
#define XB_XCNT(j)  (256  + 64 * (j))
#define XB_XSUB(j)  (1280 + 64 * (j))
#define XB_XGEN(j)  (2304 + 64 * (j))
#define XB_TOP      3328
#define XB_TOPGEN   3392
#define XCD_BAR_WORDS 3456
#define XB_SPIN_CAP (1u << 20)
__device__ __forceinline__ unsigned xb_ld(unsigned* p)              { return __hip_atomic_load(p, __ATOMIC_RELAXED, __HIP_MEMORY_SCOPE_AGENT); }
__device__ __forceinline__ unsigned xb_add(unsigned* p, unsigned v) { return __hip_atomic_fetch_add(p, v, __ATOMIC_RELAXED, __HIP_MEMORY_SCOPE_AGENT); }
__device__ __forceinline__ unsigned xb_xcc_id() { return (unsigned)__builtin_amdgcn_s_getreg((3 << 11) | 20) & 0xFu; }
#define XB_SPIN(cond, bar) do { unsigned _sp = 0; while (cond) { __builtin_amdgcn_s_sleep(1); \
    if ((++_sp & 255u) == 0u) { if (xb_ld(&(bar)[XB_TMO])) break; if (_sp > XB_SPIN_CAP) { atomicAdd(&(bar)[XB_TMO], 1u); break; } } } } while (0)
struct XcdBarrier { unsigned* bar; unsigned x; volatile PG8_LAS unsigned* st; };
__device__ __forceinline__ XcdBarrier xcd_barrier_post(unsigned* bar, volatile PG8_LAS unsigned* st) {
    XcdBarrier b; b.bar = bar; b.x = xb_xcc_id(); b.st = st;
    if (otid() == 0) (void)xb_add(&bar[XB_XCNT(b.x)], 1u);
    return b;
}
__device__ __forceinline__ void xcd_barrier_complete(unsigned* bar, unsigned x, unsigned& nloc, unsigned& nx) {
    const unsigned G = gridDim.x * gridDim.y * gridDim.z;
    unsigned sum, cnt, mine, sp = 0u;
    for (;;) {
        sum = 0u; cnt = 0u; mine = 0u;
#pragma unroll
        for (unsigned j = 0; j < 16; ++j) { const unsigned c = xb_ld(&bar[XB_XCNT(j)]); sum += c; cnt += (c > 0u) ? 1u : 0u; mine = (j == x) ? c : mine; }
        if (sum == G) break;
        __builtin_amdgcn_s_sleep(1);
        if ((++sp & 255u) == 0u) { if (xb_ld(&bar[XB_TMO])) break; if (sp > XB_SPIN_CAP) { atomicAdd(&bar[XB_TMO], 1u); break; } }
    }
    nloc = mine > 0u ? mine : 1u; nx = cnt > 0u ? cnt : 1u;
}
__device__ __forceinline__ void xcd_barrier(const XcdBarrier& b) {
    asm volatile("s_waitcnt vmcnt(0)" ::: "memory");
    __syncthreads();
    if (otid() == 0) {
        unsigned* bar = b.bar;
        __builtin_amdgcn_s_waitcnt(0);
        unsigned nloc = b.st[0], nx = b.st[1];
        if (nloc == 0u) { xcd_barrier_complete(bar, b.x, nloc, nx); b.st[0] = nloc; b.st[1] = nx; }
        const unsigned old = xb_add(&bar[XB_XSUB(b.x)], 1u);
        const unsigned gen = old / nloc;
        if (old + 1u == (gen + 1u) * nloc) {
            __builtin_amdgcn_fence(__ATOMIC_RELEASE, "agent");
            asm volatile("s_waitcnt vmcnt(0)" ::: "memory");
            const unsigned og = xb_add(&bar[XB_TOP], 1u);
            const unsigned tg = og / nx;
            if (og + 1u == (tg + 1u) * nx) xb_add(&bar[XB_TOPGEN], 1u);
            else XB_SPIN(xb_ld(&bar[XB_TOPGEN]) == tg, bar);
            __builtin_amdgcn_fence(__ATOMIC_ACQUIRE, "agent");
            xb_add(&bar[XB_XGEN(b.x)], 1u);
            asm volatile("s_waitcnt vmcnt(0)" ::: "memory");
        } else {
            XB_SPIN(xb_ld(&bar[XB_XGEN(b.x)]) == gen, bar);
            __builtin_amdgcn_fence(__ATOMIC_ACQUIRE, "agent");
            asm volatile("s_waitcnt vmcnt(0)" ::: "memory");
        }
    }
    __syncthreads();
}

constexpr int NPH = 14;
__global__ void __launch_bounds__(NTHR) mega(Params p) {
    extern __shared__ __attribute__((aligned(16))) unsigned char lds[];
    cg::grid_group grid = cg::this_grid();
    PG8_LAS unsigned char* ldsl = (PG8_LAS unsigned char*)lds;
    const int lo = p.ph_lo, hi = p.ph_hi;
#define IN(k) (lo <= (k) && (k) < hi)
#define SEAM(k) do { if (IN(k) && IN((k) + 1)) { xcd_barrier(xb); } } while (0)
    bf16* Zb = (bf16*)(kparams()->ws + WS_Z); bf16* CAT = (bf16*)(kparams()->ws + WS_CAT);
    volatile PG8_LAS unsigned* xst = (volatile PG8_LAS unsigned*)(ldsl + LDS_BYTES - 16);
    { const int t0_ = otid(); if (t0_ < 4) xst[t0_] = 0u; }
    __syncthreads();
    XcdBarrier xb = xcd_barrier_post((unsigned*)(kparams()->ws + WS_BAR), xst);
    if (p.ph_lo < 0) grid.sync();
    if (IN(0)) REPEAT(REP_PRO) { ph_prologue(p, lds); __syncthreads(); }
    SEAM(0);
    if (IN(0) && IN(1)) for (int r_ = 1; r_ < REP_SUB; ++r_) xcd_barrier(xb);
#pragma unroll
    for (int l = 0; l < NL; ++l) {
        const int pb = 1 + 6 * l;
        const char* Wl = (const char*)(kparams()->ws + WS_WIN + (size_t)l * WROWS * DM * 2);
        if (IN(pb)) {
            if (l == 0) {
#pragma unroll
                for (int ll = 0; ll < NL; ++ll) {
                    SchedS S = make_sched(kparams()->ws + WS_WCS + (size_t)ll * 1024 * DG * 2, DG, kparams()->ws + WS_WFXB + (size_t)ll * DM * DG * 2, DG, 1024, DM, 32 * ll);
                    EpiZ E{(bf16*)(kparams()->ws + WS_WIN + ((size_t)ll * WROWS + 6656) * DM * 2), DM};
                    pg8::gemm_phase<EpiZ, SchedS, true>(ldsl, pg8::Gemm{DG, DG, DG}, S, E);
                }
            }
            REPEAT(REP_NORM) ph_norm(p, l);
        }
        SEAM(pb);
        if (IN(pb + 1)) REPEAT(REP_Z) {
            SchedZ S; S.o.init(MTOK, 24 * 256, (int)gridDim.x, obid()); S.A = (const char*)(kparams()->ws + WS_U); S.B = Wl; S.late = 0;
            EpiZ2 E{Zb, (bf16*)(kparams()->ws + WS_PQT)};
            pg8::gemm_phase<EpiZ2, SchedZ, true>(ldsl, pg8::Gemm{DM, DM, DM}, S, E);
        }
        SEAM(pb + 1);
        if (IN(pb + 2)) {
            {
                SchedZ S; S.o.init(MTOK, 4 * 256, (int)gridDim.x, obid()); S.A = (const char*)(kparams()->ws + WS_U); S.B = Wl; S.late = 1;
                EpiZ2 E{Zb, (bf16*)(kparams()->ws + WS_PQT)};
                pg8::gemm_phase<EpiZ2, SchedZ, true>(ldsl, pg8::Gemm{DM, DM, DM}, S, E);
            }
            REPEAT(REP_MIX) ph_mixA(p, l, lds);
        }
        SEAM(pb + 2);
        if (IN(pb + 3)) REPEAT(REP_P3) {
            { SchedDFT S{(const char*)(kparams()->ws + WS_DFT), (const char*)(kparams()->ws + WS_PQT), (int)gridDim.x, obid()};
              EpiPart E{(float*)(kparams()->ws + WS_U)};
              pg8::gemm_phase<EpiPart, SchedDFT, true>(ldsl, pg8::Gemm{8192, 8192, 2048}, S, E); }
            { SchedS S = make_sched(kparams()->ws + WS_CVH, DG, kparams()->ws + WS_WPW + (size_t)l * DG * DG * 2, DG, MTOK, DG);
              EpiGate E{CAT, Zb, 1536, 12 * DG};
              pg8::gemm_phase<EpiGate, SchedS, true>(ldsl, pg8::Gemm{DG, DG, DG}, S, E); }
            for (int t = obid(); t < 512 * REP_R2; t += gridDim.x) ret2_task(p, l, t & 511, lds);
        }
        SEAM(pb + 3);
        if (IN(pb + 4)) REPEAT(REP_CMB) ph_combine(p);
        SEAM(pb + 4);
        if (IN(pb + 5)) REPEAT(l == 0 ? REP_OUT : 1) {
            SchedS S = make_sched(CAT, DM, kparams()->ws + WS_WOUT + (size_t)l * DM * DM * 2, DM, MTOK, DM);
            EpiRes E{(l == 0) ? kparams()->x : kparams()->out, kparams()->out, (const float*)(kparams()->ws + WS_MOD) + (size_t)l * 2 * 6144 + 4096};
            pg8::gemm_phase<EpiRes, SchedS, true>(ldsl, pg8::Gemm{DM, DM, DM}, S, E);
        }
        SEAM(pb + 5);
    }
    if (IN(NPH - 1)) ph_final(p);
#undef IN
#undef SEAM
}

extern "C" void kernel_launch(void* const* d_in, const int* in_sizes, int n_in, void* d_out, int out_size, void* d_ws, size_t ws_size, hipStream_t stream) {
    static int grid_blocks = 0;
    if (grid_blocks == 0) {
        if (n_in != 17 || ws_size < WS_END) { fprintf(stderr, "kernel_launch: n_in %d ws %zu (need %zu)\n", n_in, ws_size, (size_t)WS_END); grid_blocks = -1; return; }
        int dev = 0, cus = 0, per_cu = 0;
        hipGetDevice(&dev); hipDeviceGetAttribute(&cus, hipDeviceAttributeMultiprocessorCount, dev);
        if (hipFuncSetAttribute((const void*)mega, hipFuncAttributeMaxDynamicSharedMemorySize, LDS_BYTES) != hipSuccess) { fprintf(stderr, "hipFuncSetAttribute failed\n"); grid_blocks = -1; return; }
        if (hipOccupancyMaxActiveBlocksPerMultiprocessor(&per_cu, (const void*)mega, NTHR, LDS_BYTES) != hipSuccess || per_cu < 1) { fprintf(stderr, "occupancy query: %d\n", per_cu); per_cu = 1; }
        (void)hipGetLastError();
        grid_blocks = cus * 1;
    }
    if (grid_blocks < 0) return;
    Params p{};
    p.x = (const float*)d_in[0]; p.c = (const float*)d_in[1]; p.norm_g = (const float*)d_in[2]; p.w_ada = (const float*)d_in[3]; p.b_ada = (const float*)d_in[4];
    p.w_in = (const float*)d_in[5]; p.w_fft = (const float*)d_in[6]; p.na_bias = (const float*)d_in[7]; p.rl_f = (const float*)d_in[8]; p.rl_b = (const float*)d_in[9];
    p.conv_w = (const float*)d_in[10]; p.conv_b = (const float*)d_in[11]; p.ln_g = (const float*)d_in[12]; p.ln_b = (const float*)d_in[13]; p.w_pw = (const float*)d_in[14];
    p.w_out = (const float*)d_in[15]; p.final_g = (const float*)d_in[16];
    p.out = (float*)d_out; p.ws = (unsigned char*)d_ws;
#if ONE_LAUNCH
    if (hipMemsetAsync((char*)d_ws + WS_BAR, 0, 16384, stream) != hipSuccess) { fprintf(stderr, "memset of the barrier words failed\n"); return; }
    p.ph_lo = 0; p.ph_hi = NPH;
    void* args[] = {&p};
    hipError_t e = hipLaunchCooperativeKernel((const void*)mega, dim3(grid_blocks), dim3(NTHR), args, LDS_BYTES, stream);
    if (e != hipSuccess) fprintf(stderr, "cooperative launch failed: %s (grid %d)\n", hipGetErrorString(e), grid_blocks);
#else
    for (int ph = 0; ph < NPH; ++ph) { p.ph_lo = ph; p.ph_hi = ph + 1; hipLaunchKernelGGL(mega, dim3(grid_blocks), dim3(NTHR), LDS_BYTES, stream, p); }
#endif
}
```

```cpp
#include <hip/hip_runtime.h>
#include <hip/hip_cooperative_groups.h>
#include <cstdio>
#include <cstdint>
namespace cg = cooperative_groups;

#ifndef ONE_LAUNCH
#define ONE_LAUNCH 1
#endif

__device__ __forceinline__ int obid() { int b = (int)blockIdx.x; asm volatile("" : "+s"(b)); return b; }
__device__ __forceinline__ int otid() { int t; asm volatile("v_mov_b32 %0, %1" : "=v"(t) : "v"(threadIdx.x)); return t; }
namespace pg8 {
#define PG8_LAS __attribute__((address_space(3)))
typedef unsigned short bf16_t;
typedef short bf16x8 __attribute__((ext_vector_type(8)));
typedef float f32x4 __attribute__((ext_vector_type(4)));
typedef unsigned u32x4 __attribute__((ext_vector_type(4)));
constexpr int BM = 256, BK = 64, HALF = 128, HTB = HALF * BK * 2, STAGE_BYTES = 8 * HTB, NXCD = 8, WGM = 8;

__host__ __device__ __forceinline__ int lds_byte(int r, int c) { const int st = (r >> 4) * 2 + (c >> 5), rr = r & 15, cc = c & 31, ob = rr * 64 + cc * 2; return st * 1024 + (ob ^ (((ob >> 9) & 1) << 5)); }
__host__ __device__ __forceinline__ void stage_rc(int b, int& R, int& C) { const int st = b / 1024, sb = b % 1024, swz = sb ^ (((sb >> 9) & 1) << 5); R = (st >> 1) * 16 + swz / 64; C = (st & 1) * 32 + (swz % 64) / 2; }
__host__ __device__ __forceinline__ int perm32(int rho) { const int n = rho >> 4, i = rho & 15; return 8 * (i >> 2) + 4 * n + (i & 3); }

struct Unit { int pm, pn, aux, pad; const char* A; const char* B; };
struct Gemm { int lda, ldb, K; };

struct StaticOrder {
    int nM, nN, nwg, G, c;
    __host__ __device__ void init(int M, int N, int G_, int c_) { nM = M / BM; nN = N / BM; nwg = nM * nN; G = G_; c = c_; }
    __device__ bool next(int i, Unit& u) const {
        const long L = (long)i * G + c; if (L >= nwg) return false;
        int wgid = __builtin_amdgcn_readfirstlane((int)L); { const int q = nwg / NXCD, r = nwg % NXCD, xcd = wgid % NXCD, off = wgid / NXCD; wgid = (xcd < r ? xcd * (q + 1) : r * (q + 1) + (xcd - r) * q) + off; }
        const int nig = WGM * nN, gid = wgid / nig, fm = gid * WGM, gsz = (nM - fm) < WGM ? (nM - fm) : WGM;
        u.pm = __builtin_amdgcn_readfirstlane(fm + ((wgid % nig) % gsz)); u.pn = __builtin_amdgcn_readfirstlane((wgid % nig) / gsz); return true;
    }
};

__device__ __forceinline__ unsigned cvt_pk_bf16(float lo, float hi) { unsigned r; asm volatile("v_cvt_pk_bf16_f32 %0, %1, %2" : "=v"(r) : "v"(lo), "v"(hi)); return r; }

template <class Epi, class Sched, bool ALIGN_EPI>
__device__ __forceinline__ void gemm_phase(PG8_LAS unsigned char* lds, const Gemm g, const Sched& S, const Epi& E) {
    const int tid = otid(), wid = __builtin_amdgcn_readfirstlane(tid >> 6), lane = tid & 63, wr = wid >> 2, wc = wid & 3, fr = lane & 15, fq = lane >> 4;
    const int K = g.K, nt = K / BK;
    unsigned voffA[2], voffB[2];
#pragma unroll
    for (int i = 0; i < 2; ++i) { int R, C; stage_rc(tid * 16 + i * 8192, R, C); const int Rb = Epi::PERM ? ((R & ~31) + perm32(R & 31)) : R;
        voffA[i] = (unsigned)(R * g.lda + C) * 2u; voffB[i] = (unsigned)(Rb * g.ldb + C) * 2u; }
    const size_t kstep = (size_t)(BK * 2);
    const size_t hA = (size_t)HALF * g.lda * 2, hB = (size_t)HALF * g.ldb * 2;
    const unsigned ldsw = (unsigned)wid * 1024u;
    const int aoff = lds_byte(wr * 64 + fr, fq * 8), boff = lds_byte(wc * 32 + fr, fq * 8);
#define PG8_SA(b, h) (((b) * 2 + (h)) * HTB)
#define PG8_SB(b, h) ((4 + (b) * 2 + (h)) * HTB)
#define PG8_STAGE(bufoff, gbase, voff) do { _Pragma("unroll") for (int _i = 0; _i < 2; ++_i) \
        __builtin_amdgcn_global_load_lds((const unsigned*)((const char*)(gbase) + (voff)[_i]), (PG8_LAS unsigned*)(lds + (bufoff) + ldsw + _i * 8192), 16, 0, 0); } while (0)
#define PG8_LDA(dst, b, h) do { _Pragma("unroll") for (int m = 0; m < 4; ++m) _Pragma("unroll") for (int k = 0; k < 2; ++k) dst[m][k] = *(const PG8_LAS bf16x8*)(lds + PG8_SA(b, h) + aoff + m * 2048 + k * 1024); } while (0)
#define PG8_LDB(dst, b, h) do { _Pragma("unroll") for (int n = 0; n < 2; ++n) _Pragma("unroll") for (int k = 0; k < 2; ++k) dst[n][k] = *(const PG8_LAS bf16x8*)(lds + PG8_SB(b, h) + boff + n * 2048 + k * 1024); } while (0)
#define PG8_MMA(ai, bj, At, Bt) do { __builtin_amdgcn_s_setprio(1); _Pragma("unroll") for (int m = 0; m < 4; ++m) _Pragma("unroll") for (int n = 0; n < 2; ++n) _Pragma("unroll") for (int k = 0; k < 2; ++k) \
        acc[ai][bj][m][n] = __builtin_amdgcn_mfma_f32_16x16x32_bf16(Bt[n][k], At[m][k], acc[ai][bj][m][n], 0, 0, 0); __builtin_amdgcn_s_setprio(0); } while (0)
#define PG8_WAIT_V(n) asm volatile("s_waitcnt vmcnt(" #n ")" ::: "memory")
#define PG8_WAIT_L(n) asm volatile("s_waitcnt lgkmcnt(" #n ")" ::: "memory")
#define PG8_BAR __builtin_amdgcn_s_barrier()
#define PG8_SCHED __builtin_amdgcn_sched_barrier(0)
    Unit cur, nxt; int ui = 0;
    if (!S.next(0, cur)) return;
    f32x4 acc[2][2][4][2];
#pragma unroll
    for (int a = 0; a < 2; ++a)
#pragma unroll
        for (int b = 0; b < 2; ++b)
#pragma unroll
            for (int m = 0; m < 4; ++m)
#pragma unroll
                for (int n = 0; n < 2; ++n) acc[a][b][m][n] = (f32x4){0.f, 0.f, 0.f, 0.f};
    bf16x8 At[4][2], B0[2][2], B1[2][2];
    const char* cA = cur.A; const char* cB = cur.B;
    PG8_STAGE(PG8_SB(0, 0), cB, voffB); PG8_STAGE(PG8_SB(0, 1), cB + hB, voffB); PG8_STAGE(PG8_SA(0, 0), cA, voffA); PG8_STAGE(PG8_SA(0, 1), cA + hA, voffA);
    if (wr == 1) PG8_BAR;
    PG8_WAIT_V(2); PG8_BAR;
    PG8_STAGE(PG8_SB(1, 0), cB + kstep, voffB); PG8_STAGE(PG8_SA(1, 0), cA + kstep, voffA); PG8_STAGE(PG8_SB(1, 1), cB + hB + kstep, voffB);
    PG8_WAIT_V(6); PG8_BAR;
    for (;;) {
        const bool has_next = S.next(ui + 1, nxt);
        const char* nA = has_next ? nxt.A : cA; const char* nB = has_next ? nxt.B : cB;
        for (int t = 0; t < nt; t += 2) {
            const bool last = (t == nt - 2);
            const char* a1 = cA + (size_t)(t + 1) * kstep;
            const char* a2 = last ? nA : cA + (size_t)(t + 2) * kstep; const char* b2 = last ? nB : cB + (size_t)(t + 2) * kstep;
            const char* a3 = a2 + kstep; const char* b3 = b2 + kstep;
            PG8_LDB(B0, 0, 0); PG8_LDB(B1, 0, 1); PG8_SCHED; PG8_LDA(At, 0, 0); PG8_STAGE(PG8_SA(1, 1), a1 + hA, voffA);
            PG8_WAIT_V(8); PG8_WAIT_L(0); PG8_BAR; PG8_MMA(0, 0, At, B0); PG8_MMA(0, 1, At, B1); PG8_BAR; PG8_SCHED;
            PG8_LDA(At, 0, 1); PG8_STAGE(PG8_SB(0, 0), b2, voffB); PG8_STAGE(PG8_SB(0, 1), b2 + hB, voffB); PG8_STAGE(PG8_SA(0, 0), a2, voffA);
            PG8_WAIT_V(8); PG8_WAIT_L(0); PG8_BAR; PG8_MMA(1, 0, At, B0); PG8_MMA(1, 1, At, B1); PG8_BAR; PG8_SCHED;
            PG8_LDB(B0, 1, 0); PG8_LDB(B1, 1, 1); PG8_SCHED; PG8_LDA(At, 1, 0); PG8_STAGE(PG8_SA(0, 1), a2 + hA, voffA);
            PG8_WAIT_V(8); PG8_WAIT_L(0); PG8_BAR; PG8_MMA(0, 0, At, B0); PG8_MMA(0, 1, At, B1); PG8_BAR; PG8_SCHED;
            PG8_LDA(At, 1, 1); PG8_STAGE(PG8_SB(1, 0), b3, voffB); PG8_STAGE(PG8_SB(1, 1), b3 + hB, voffB); PG8_STAGE(PG8_SA(1, 0), a3, voffA);
            PG8_WAIT_V(8); PG8_WAIT_L(0); PG8_BAR; PG8_MMA(1, 0, At, B0); PG8_MMA(1, 1, At, B1); PG8_BAR; PG8_SCHED;
        }
        if constexpr (ALIGN_EPI) { if (wr == 0) PG8_BAR; }
        E(acc, cur, wr, wc, fr, fq);
        if (!has_next) break;
#pragma unroll
        for (int a = 0; a < 2; ++a)
#pragma unroll
            for (int b = 0; b < 2; ++b)
#pragma unroll
                for (int m = 0; m < 4; ++m)
#pragma unroll
                    for (int n = 0; n < 2; ++n) acc[a][b][m][n] = (f32x4){0.f, 0.f, 0.f, 0.f};
        cur = nxt; cA = nA; cB = nB; ++ui;
        if constexpr (ALIGN_EPI) { if (wr == 1) PG8_BAR; }
    }
    PG8_WAIT_V(0);
    if constexpr (!ALIGN_EPI) { if (wr == 0) PG8_BAR; }
    PG8_BAR;
#undef PG8_SA
#undef PG8_SB
#undef PG8_STAGE
#undef PG8_LDA
#undef PG8_LDB
#undef PG8_MMA
#undef PG8_WAIT_V
#undef PG8_WAIT_L
#undef PG8_BAR
#undef PG8_SCHED
}
}

typedef unsigned short bf16;
typedef float f32x4 __attribute__((ext_vector_type(4)));
typedef unsigned u32x4 __attribute__((ext_vector_type(4)));
typedef unsigned u32x2 __attribute__((ext_vector_type(2)));
constexpr int NB = 2, SEQ = 4096, DM = 2048, MTOK = NB * SEQ, DIN = 6656, DG = 512, NL = 2;
constexpr int LDS_BYTES = 147456;
constexpr int NTHR = 512;

constexpr int WROWS = 7680;
constexpr size_t WS_WIN = 0;
constexpr size_t WS_WOUT = WS_WIN + (size_t)NL * WROWS * DM * 2;
constexpr size_t WS_WCS = WS_WOUT + (size_t)NL * DM * DM * 2;
constexpr size_t WS_WFXB = WS_WCS + (size_t)NL * 1024 * DG * 2;
constexpr size_t WS_WPW = WS_WFXB + (size_t)NL * DM * DG * 2;
constexpr size_t WS_DFT = WS_WPW + (size_t)NL * DG * DG * 2;
constexpr size_t WS_ROPE = WS_DFT + (size_t)SEQ * 2 * SEQ * 2;
constexpr size_t WS_MOD = WS_ROPE + (size_t)SEQ * 32 * 8;
constexpr size_t WS_U = WS_MOD + 131072;
constexpr size_t WS_Z = WS_U + (size_t)4 * MTOK * DG * 4;
constexpr size_t WS_PQT = WS_Z + (size_t)MTOK * DIN * 2;
constexpr size_t WS_CVH = WS_PQT + (size_t)NB * DG * 2 * SEQ * 2;
constexpr size_t WS_CAT = WS_CVH + (size_t)MTOK * DG * 2;
constexpr size_t WS_KV = WS_CAT + (size_t)MTOK * DM * 2;
constexpr size_t WS_BAR = WS_KV + (size_t)2 * NB * 8 * 32 * 4096 * 4;
constexpr size_t WS_END = WS_BAR + 16384;

struct Params {
    const float* x; const float* c; const float* norm_g; const float* w_ada; const float* b_ada; const float* w_in; const float* w_fft; const float* na_bias;
    const float* rl_f; const float* rl_b; const float* conv_w; const float* conv_b; const float* ln_g; const float* ln_b; const float* w_pw; const float* w_out; const float* final_g;
    float* out; unsigned char* ws; int ph_lo, ph_hi;
};

#if defined(__HIP_DEVICE_COMPILE__)
typedef const __attribute__((address_space(4))) Params* KParams;
__device__ __forceinline__ KParams kparams() { KParams k = (KParams)__builtin_amdgcn_kernarg_segment_ptr(); asm volatile("" : "+s"(k)); return k; }
#else
typedef const Params* KParams;
__device__ __forceinline__ KParams kparams() { return nullptr; }
#endif
__device__ __forceinline__ unsigned f2bf(float f) { unsigned u = __float_as_uint(f); return (u + 0x7fffu + ((u >> 16) & 1u)) >> 16; }
__device__ __forceinline__ unsigned pk2(float lo, float hi) { return f2bf(lo) | (f2bf(hi) << 16); }
__device__ __forceinline__ float bf2f(bf16 b) { return __uint_as_float((unsigned)b << 16); }
__device__ __forceinline__ float bflo(unsigned u) { return __uint_as_float(u << 16); }
__device__ __forceinline__ float bfhi(unsigned u) { return __uint_as_float(u & 0xffff0000u); }
__device__ __forceinline__ float silu_f(float v) { return v / (1.f + __expf(-v)); }
__device__ __forceinline__ float wave_sum(float v) {
#pragma unroll
    for (int o = 1; o < 64; o <<= 1) v += __shfl_xor(v, o);
    return v;
}
__device__ __forceinline__ float wave_max(float v) {
#pragma unroll
    for (int o = 1; o < 64; o <<= 1) v = fmaxf(v, __shfl_xor(v, o));
    return v;
}

struct SchedS {
    pg8::StaticOrder o; const char* A; const char* B; size_t ta, tb;
    __device__ __forceinline__ bool next(int i, pg8::Unit& u) const { if (!o.next(i, u)) return false; u.A = A + (size_t)u.pm * ta; u.B = B + (size_t)u.pn * tb; u.aux = 0; return true; }
};
__device__ __forceinline__ SchedS make_sched(const void* A, int lda, const void* B, int ldb, int M, int N, int shift = 0) {
    SchedS s; s.o.init(M, N, (int)gridDim.x, (int)((obid() + gridDim.x - shift) % gridDim.x)); s.A = (const char*)A; s.B = (const char*)B; s.ta = (size_t)256 * lda * 2; s.tb = (size_t)256 * ldb * 2; return s;
}
struct SchedZ {
    pg8::StaticOrder o; const char* A; const char* B; int late;
    __device__ __forceinline__ bool next(int i, pg8::Unit& u) const { if (!o.next(i, u)) return false; const int jn = u.pn;
        u.pn = late ? (jn < 2 ? 2 + jn : 22 + jn) : (jn < 20 ? jn + 4 : jn + 6);
        u.A = A + (size_t)u.pm * (256 * DM * 2); u.B = B + (size_t)u.pn * (256 * DM * 2); u.aux = 0; return true; }
};
struct SchedDFT {
    const char* A; const char* B; int G, c;
    __device__ __forceinline__ bool next(int i, pg8::Unit& u) const {
        const int L = __builtin_amdgcn_readfirstlane(i * G + c); if (L >= 256) return false;
        const int sub = L >> 5, t = L & 31; u.pm = t >> 1; u.pn = t & 1; u.aux = sub;
        u.A = A + (size_t)((u.pm << 22) + ((sub & 3) << 12)); u.B = B + (size_t)(((sub >> 2) << 23) + (u.pn << 22) + ((sub & 3) << 12)); return true;
    }
};

struct EpiZ {
    static constexpr bool PERM = true;
    bf16* O; int ldc;
    __device__ __forceinline__ void operator()(const pg8::f32x4 (&acc)[2][2][4][2], const pg8::Unit& u, int wr, int wc, int fr, int fq) const {
        const int row0 = u.pm * 256 + wr * 64 + fr, col0 = u.pn * 256 + wc * 32 + 8 * fq;
#pragma unroll
        for (int ai = 0; ai < 2; ++ai)
#pragma unroll
            for (int m = 0; m < 4; ++m) { bf16* rowp = O + (size_t)(row0 + ai * 128 + m * 16) * ldc + col0;
#pragma unroll
                for (int bj = 0; bj < 2; ++bj) { const pg8::f32x4 v0 = acc[ai][bj][m][0], v1 = acc[ai][bj][m][1]; u32x4 w;
                    w.x = pg8::cvt_pk_bf16(v0[0], v0[1]); w.y = pg8::cvt_pk_bf16(v0[2], v0[3]); w.z = pg8::cvt_pk_bf16(v1[0], v1[1]); w.w = pg8::cvt_pk_bf16(v1[2], v1[3]);
                    *(u32x4*)(rowp + bj * 128) = w; } }
    }
};
struct EpiZ2 {
    static constexpr bool PERM = true;
    bf16* O; bf16* PQ;
    __device__ __forceinline__ void operator()(const pg8::f32x4 (&acc)[2][2][4][2], const pg8::Unit& u, int wr, int wc, int fr, int fq) const {
        const int row0 = u.pm * 256 + wr * 64 + fr;
        if (u.pn < 26) { const int col0 = u.pn * 256 + wc * 32 + 8 * fq;
#pragma unroll
            for (int ai = 0; ai < 2; ++ai)
#pragma unroll
                for (int m = 0; m < 4; ++m) { bf16* rowp = O + (size_t)(row0 + ai * 128 + m * 16) * DIN + col0;
#pragma unroll
                    for (int bj = 0; bj < 2; ++bj) { const pg8::f32x4 v0 = acc[ai][bj][m][0], v1 = acc[ai][bj][m][1]; u32x4 w;
                        w.x = pg8::cvt_pk_bf16(v0[0], v0[1]); w.y = pg8::cvt_pk_bf16(v0[2], v0[3]); w.z = pg8::cvt_pk_bf16(v1[0], v1[1]); w.w = pg8::cvt_pk_bf16(v1[2], v1[3]);
                        *(u32x4*)(rowp + bj * 128) = w; } }
        } else { const int np0 = (u.pn - 26) * 256 + wc * 32 + 8 * fq;
#pragma unroll
            for (int bj = 0; bj < 2; ++bj) { const int np = np0 + bj * 128, pq = np >> 9, n = np & 511;
#pragma unroll
                for (int ai = 0; ai < 2; ++ai)
#pragma unroll
                    for (int m = 0; m < 4; ++m) { const int row = row0 + ai * 128 + m * 16, b = row >> 12, sq = row & 4095;
                        bf16* dst = PQ + ((size_t)(b * 512 + n) * 2 + pq) * 4096 + sq;
#pragma unroll
                        for (int nn = 0; nn < 2; ++nn)
#pragma unroll
                            for (int j = 0; j < 4; ++j) dst[(size_t)(4 * nn + j) * 8192] = (bf16)f2bf(acc[ai][bj][m][nn][j]); } }
        }
    }
};
struct EpiGate {
    static constexpr bool PERM = true;
    bf16* O; const bf16* Z; int coff, goff;
    __device__ __forceinline__ void operator()(const pg8::f32x4 (&acc)[2][2][4][2], const pg8::Unit& u, int wr, int wc, int fr, int fq) const {
        const int row0 = u.pm * 256 + wr * 64 + fr, col0 = u.pn * 256 + wc * 32 + 8 * fq;
#pragma unroll
        for (int ai = 0; ai < 2; ++ai)
#pragma unroll
            for (int m = 0; m < 4; ++m) { const size_t row = (size_t)(row0 + ai * 128 + m * 16);
#pragma unroll
                for (int bj = 0; bj < 2; ++bj) { const pg8::f32x4 v0 = acc[ai][bj][m][0], v1 = acc[ai][bj][m][1];
                    const u32x4 gz = *(const u32x4*)(Z + row * DIN + goff + col0 + bj * 128); u32x4 w;
                    w.x = pg8::cvt_pk_bf16(v0[0] * silu_f(bflo(gz.x)), v0[1] * silu_f(bfhi(gz.x))); w.y = pg8::cvt_pk_bf16(v0[2] * silu_f(bflo(gz.y)), v0[3] * silu_f(bfhi(gz.y)));
                    w.z = pg8::cvt_pk_bf16(v1[0] * silu_f(bflo(gz.z)), v1[1] * silu_f(bfhi(gz.z))); w.w = pg8::cvt_pk_bf16(v1[2] * silu_f(bflo(gz.w)), v1[3] * silu_f(bfhi(gz.w)));
                    *(u32x4*)(O + row * DM + coff + col0 + bj * 128) = w; } }
    }
};
struct EpiPart {
    static constexpr bool PERM = false;
    float* P;
    __device__ __forceinline__ void operator()(const pg8::f32x4 (&acc)[2][2][4][2], const pg8::Unit& u, int wr, int wc, int fr, int fq) const {
        const int row0 = u.pm * 256 + wr * 64 + fr, col0 = u.pn * 256 + wc * 32 + 4 * fq;
        float* base = P + (size_t)u.aux * 4096 * 512;
#pragma unroll
        for (int ai = 0; ai < 2; ++ai)
#pragma unroll
            for (int m = 0; m < 4; ++m) { float* rowp = base + (size_t)(row0 + ai * 128 + m * 16) * 512 + col0;
#pragma unroll
                for (int bj = 0; bj < 2; ++bj)
#pragma unroll
                    for (int n = 0; n < 2; ++n) *(pg8::f32x4*)(rowp + bj * 128 + n * 16) = acc[ai][bj][m][n]; }
    }
};
struct EpiRes {
    static constexpr bool PERM = false;
    const float* xin; float* xout; const float* gate;
    __device__ __forceinline__ void operator()(const pg8::f32x4 (&acc)[2][2][4][2], const pg8::Unit& u, int wr, int wc, int fr, int fq) const {
        const int row0 = u.pm * 256 + wr * 64 + fr, col0 = u.pn * 256 + wc * 32 + 4 * fq;
        const float* gp = gate + (size_t)(u.pm >> 4) * 6144 + col0;
        pg8::f32x4 gv[2][2];
#pragma unroll
        for (int bj = 0; bj < 2; ++bj)
#pragma unroll
            for (int n = 0; n < 2; ++n) gv[bj][n] = *(const pg8::f32x4*)(gp + bj * 128 + n * 16);
#pragma unroll
        for (int ai = 0; ai < 2; ++ai)
#pragma unroll
            for (int m = 0; m < 4; ++m) { const size_t ro = (size_t)(row0 + ai * 128 + m * 16) * DM + col0;
#pragma unroll
                for (int bj = 0; bj < 2; ++bj)
#pragma unroll
                    for (int n = 0; n < 2; ++n) { const pg8::f32x4 xi = *(const pg8::f32x4*)(xin + ro + bj * 128 + n * 16);
                        *(pg8::f32x4*)(xout + ro + bj * 128 + n * 16) = xi + gv[bj][n] * acc[ai][bj][m][n]; } }
    }
};

struct TPItem { const float* src; bf16* dst; int N, K; };
__device__ __forceinline__ TPItem tp_decode(const Params& p, int it, int tid) {
    constexpr int T_IN = 32 * 96, T_OUT = 32 * 32, T_S = 64, T_L = T_IN + T_OUT + T_S;
    const int l = it / T_L; int r = it % T_L; const float* W; bf16* WT; int K, N, kb, nb;
    if (r < T_IN) { W = p.w_in + (size_t)l * DM * DIN; WT = (bf16*)(p.ws + WS_WIN) + (size_t)l * WROWS * DM; K = DM; N = DIN; kb = r / 96; nb = 8 + r % 96; }
    else if (r < T_IN + T_OUT) { r -= T_IN; W = p.w_out + (size_t)l * DM * DM; WT = (bf16*)(p.ws + WS_WOUT) + (size_t)l * DM * DM; K = DM; N = DM; kb = r >> 5; nb = r & 31; }
    else { r -= T_IN + T_OUT; W = p.w_pw + (size_t)l * DG * DG; WT = (bf16*)(p.ws + WS_WPW) + (size_t)l * DG * DG; K = DG; N = DG; kb = r >> 3; nb = r & 7; }
    TPItem t; t.N = N; t.K = K;
    t.src = W + (size_t)(kb * 64 + (tid >> 4)) * N + nb * 64 + (tid & 15) * 4;
    t.dst = WT + (size_t)(nb * 64 + (tid >> 3)) * K + kb * 64 + (tid & 7) * 8;
    return t;
}
__device__ __forceinline__ void tp_store(const TPItem& t, int tid, const f32x4& v0, const f32x4& v1, float* scr) {
    { const int kk = tid >> 4, nn = (tid & 15) * 4;
      scr[kk * 65 + nn] = v0[0]; scr[kk * 65 + nn + 1] = v0[1]; scr[kk * 65 + nn + 2] = v0[2]; scr[kk * 65 + nn + 3] = v0[3];
      scr[(kk + 32) * 65 + nn] = v1[0]; scr[(kk + 32) * 65 + nn + 1] = v1[1]; scr[(kk + 32) * 65 + nn + 2] = v1[2]; scr[(kk + 32) * 65 + nn + 3] = v1[3]; }
    __syncthreads();
    { const int n = tid >> 3, kc = (tid & 7) * 8; const float* s = scr + kc * 65 + n; u32x4 o;
      o.x = pk2(s[0], s[65]); o.y = pk2(s[2 * 65], s[3 * 65]); o.z = pk2(s[4 * 65], s[5 * 65]); o.w = pk2(s[6 * 65], s[7 * 65]);
      *(u32x4*)t.dst = o; }
    __syncthreads();
}

__device__ __forceinline__ void ph_prologue(const Params& p_, unsigned char* lds) {
    const Params p = *kparams(); (void)p_;
    const int tid = otid(), lane = tid & 63, wave = tid >> 6, G = gridDim.x, bid = obid();
    float* scr = (float*)lds;
    { constexpr int T_TOT = NL * (32 * 96 + 32 * 32 + 64);
      int it = bid; TPItem cur; f32x4 a0, a1;
      if (it < T_TOT) { cur = tp_decode(p, it, tid); a0 = *(const f32x4*)cur.src; a1 = *(const f32x4*)(cur.src + (size_t)32 * cur.N); }
      while (it < T_TOT) { const int nit = it + G; TPItem nxt = cur; f32x4 b0 = a0, b1 = a1;
          if (nit < T_TOT) { nxt = tp_decode(p, nit, tid); b0 = *(const f32x4*)nxt.src; b1 = *(const f32x4*)(nxt.src + (size_t)32 * nxt.N); }
          tp_store(cur, tid, a0, a1, scr);
          cur = nxt; a0 = b0; a1 = b1; it = nit; } }
    { bf16* Wfx = (bf16*)(p.ws + WS_WFXB);
      for (int e = bid * NTHR + tid; e < NL * DM * DG / 8; e += G * NTHR) { const int l = e >> 17, r = e & 131071, k = r >> 6, c8 = (r & 63) * 8;
          const float* src = p.w_in + ((size_t)l * DM + k) * DIN + c8; const f32x4 a = *(const f32x4*)src, b4 = *(const f32x4*)(src + 4);
          u32x4 o; o.x = pk2(a[0], a[1]); o.y = pk2(a[2], a[3]); o.z = pk2(b4[0], b4[1]); o.w = pk2(b4[2], b4[3]);
          *(u32x4*)(Wfx + ((size_t)l * DM + k) * DG + c8) = o; } }
    { float* Wl = (float*)lds; float* tr = Wl + 128 * 65; bf16* Wcs = (bf16*)(p.ws + WS_WCS);
      for (int t2 = G - 1 - bid; t2 < 256; t2 += G) {
          const int t = t2 >> 1, ch = t2 & 1, l = t >> 6, pq = (t >> 5) & 1, g = (t >> 3) & 3, n0 = (t & 7) * 64;
#pragma unroll
          for (int i = 0; i < 4; ++i) { const int m = (tid >> 4) + 32 * i, nn = (tid & 15) * 4;
              const f32x4 v = *(const f32x4*)(p.w_fft + ((size_t)l * DG + g * 128 + m) * DG + n0 + nn);
              Wl[m * 65 + nn] = v[0]; Wl[m * 65 + nn + 1] = v[1]; Wl[m * 65 + nn + 2] = v[2]; Wl[m * 65 + nn + 3] = v[3]; }
          if (tid < 128) tr[tid] = pq ? sinpif((float)tid * (1.f / 64.f)) : cospif((float)tid * (1.f / 64.f));
          __syncthreads();
          const int nn = tid >> 3, cc = ch * 64 + (tid & 7) * 8; float acc[8];
#pragma unroll
          for (int i = 0; i < 8; ++i) acc[i] = 0.f;
#pragma unroll 4
          for (int m = 0; m < 128; ++m) { const float w = Wl[m * 65 + nn];
#pragma unroll
              for (int i = 0; i < 8; ++i) acc[i] += tr[((cc + i) * m) & 127] * w; }
          const float nrm = 0.0013810679320049757f;
          u32x4 o0;
          o0.x = pk2(acc[0] * nrm, acc[1] * nrm); o0.y = pk2(acc[2] * nrm, acc[3] * nrm); o0.z = pk2(acc[4] * nrm, acc[5] * nrm); o0.w = pk2(acc[6] * nrm, acc[7] * nrm);
          *(u32x4*)(Wcs + ((size_t)l * 1024 + pq * 512 + n0 + nn) * DG + g * 128 + cc) = o0;
          __syncthreads();
      } }
    __syncthreads();
    float* cosT = (float*)(lds + 32768); float* sinT = (float*)(lds + 49152); float* ca = (float*)(lds + 65536); float* red = (float*)(lds + 81920);
    for (int j = tid; j < 4096; j += NTHR) { cosT[j] = cospif((float)j * (1.f / 2048.f)); sinT[j] = sinpif((float)j * (1.f / 2048.f)); }
    for (int j = tid; j < 4096; j += NTHR) { const float cv = p.c[j]; ca[j] = cv / (1.f + expf(-cv)); }
    __syncthreads();
    bf16* DFT = (bf16*)(p.ws + WS_DFT);
    for (int k = bid; k < 4096; k += G) {
#pragma unroll
        for (int cc = 0; cc < 2; ++cc) { const int kk0 = (tid + cc * NTHR) * 8; float v[8];
#pragma unroll
            for (int j = 0; j < 8; ++j) { const int kk = kk0 + j, idx = (k * (kk & 4095)) & 4095; v[j] = (kk < 4096) ? cosT[idx] : -sinT[idx]; }
            u32x4 o; o.x = pk2(v[0], v[1]); o.y = pk2(v[2], v[3]); o.z = pk2(v[4], v[5]); o.w = pk2(v[6], v[7]);
            *(u32x4*)(DFT + (size_t)k * 8192 + kk0) = o; }
    }
    { float2* rope = (float2*)(p.ws + WS_ROPE);
      for (int e = bid * NTHR + tid; e < 4096 * 32; e += G * NTHR) { const int s = e >> 5, i = e & 31;
          const float inv = (float)pow(10000.0, -(double)i / 32.0); const float ang = (float)s * inv;
          double sn, cs; sincos((double)ang, &sn, &cs); rope[e] = make_float2((float)cs, (float)sn); } }
    float* mod = (float*)(p.ws + WS_MOD);
    for (int t = bid; t < 192; t += G) {
        const int l = t / 96, col = (t % 96) * 64 + lane; const float* W = p.w_ada + (size_t)l * DM * 6144 + col;
        float a0 = 0.f, a1 = 0.f;
        for (int k0 = wave * 256; k0 < wave * 256 + 256; k0 += 32) { float wv[32];
#pragma unroll
            for (int j = 0; j < 32; ++j) wv[j] = W[(size_t)(k0 + j) * 6144];
#pragma unroll
            for (int j = 0; j < 32; ++j) { a0 += ca[k0 + j] * wv[j]; a1 += ca[2048 + k0 + j] * wv[j]; } }
        red[(wave * 2 + 0) * 64 + lane] = a0; red[(wave * 2 + 1) * 64 + lane] = a1;
        __syncthreads();
        if (wave < 2) { float s = 0.f;
#pragma unroll
            for (int w = 0; w < 8; ++w) s += red[(w * 2 + wave) * 64 + lane];
            mod[(size_t)(l * 2 + wave) * 6144 + col] = s + p.b_ada[l * 6144 + col]; }
        __syncthreads();
    }
}

__device__ __forceinline__ void ph_norm(const Params& p_, int l) {
    const Params p = *kparams(); (void)p_;
    const int tid = otid(), lane = tid & 63, wave = tid >> 6;
    const float* xin = (l == 0) ? p.x : p.out; bf16* h = (bf16*)(p.ws + WS_U); const float* mod = (const float*)(p.ws + WS_MOD);
    for (int row = obid() * 8 + wave; row < MTOK; row += gridDim.x * 8) {
        const f32x4* xr = (const f32x4*)(xin + (size_t)row * DM) + lane; f32x4 v[8]; float ss = 0.f;
#pragma unroll
        for (int j = 0; j < 8; ++j) { v[j] = xr[64 * j]; ss += (v[j][0] * v[j][0] + v[j][1] * v[j][1]) + (v[j][2] * v[j][2] + v[j][3] * v[j][3]); }
        ss = wave_sum(ss); const float rstd = rsqrtf(ss * (1.f / DM) + 1e-6f);
        const float* md = mod + (size_t)(l * 2 + (row >> 12)) * 6144; const float* g = p.norm_g + l * DM;
#pragma unroll
        for (int j = 0; j < 8; ++j) { const int col = (64 * j + lane) * 4;
            const f32x4 g4 = *(const f32x4*)(g + col), sh = *(const f32x4*)(md + col), sc = *(const f32x4*)(md + 2048 + col);
            const f32x4 o = (v[j] * rstd * g4) * (sc + 1.f) + sh; u32x2 w; w.x = pk2(o[0], o[1]); w.y = pk2(o[2], o[3]);
            *(u32x2*)(h + (size_t)row * DM + col) = w; }
    }
}
__device__ __forceinline__ void ph_final(const Params& p_) {
    const Params p = *kparams(); (void)p_;
    const int tid = otid(), lane = tid & 63, wave = tid >> 6;
    for (int row = obid() * 8 + wave; row < MTOK; row += gridDim.x * 8) {
        f32x4* xr = (f32x4*)(p.out + (size_t)row * DM) + lane; f32x4 v[8]; float ss = 0.f;
#pragma unroll
        for (int j = 0; j < 8; ++j) { v[j] = xr[64 * j]; ss += (v[j][0] * v[j][0] + v[j][1] * v[j][1]) + (v[j][2] * v[j][2] + v[j][3] * v[j][3]); }
        ss = wave_sum(ss); const float rstd = rsqrtf(ss * (1.f / DM) + 1e-6f);
#pragma unroll
        for (int j = 0; j < 8; ++j) { const int col = (64 * j + lane) * 4; const f32x4 g4 = *(const f32x4*)(p.final_g + col); xr[64 * j] = v[j] * rstd * g4; }
    }
}

#ifndef REP_PRO
#define REP_PRO 1
#endif
#ifndef REP_NORM
#define REP_NORM 1
#endif
#ifndef REP_Z
#define REP_Z 1
#endif
#ifndef REP_MIX
#define REP_MIX 1
#endif
#ifndef REP_P3
#define REP_P3 1
#endif
#ifndef REP_R2
#define REP_R2 1
#endif
#ifndef REP_CMB
#define REP_CMB 1
#endif
#ifndef REP_FFT
#define REP_FFT 1
#endif
#ifndef REP_OUT
#define REP_OUT 1
#endif
#ifndef REP_SUB
#define REP_SUB 1
#endif

#ifndef REP_R1
#define REP_R1 1
#endif
#ifndef REP_NA
#define REP_NA 1
#endif
#ifndef REP_CV
#define REP_CV 1
#endif
#ifndef REP_F1
#define REP_F1 1
#endif
#define REPEAT(n) for (int rep_ = 0; rep_ < (n); ++rep_)
typedef short bf16x8v __attribute__((ext_vector_type(8)));
__device__ __forceinline__ bf16x8v mk8(unsigned a, unsigned b, unsigned c, unsigned d) { u32x4 v = {a, b, c, d}; return __builtin_bit_cast(bf16x8v, v); }
#define MFMA16(a, b, c) __builtin_amdgcn_mfma_f32_16x16x32_bf16(a, b, c, 0, 0, 0)
constexpr int R_QS = 0, R_KS = 18432, R_VT = 36864, R_KTF = 54272, R_KTB = 71680, R_STF = 89088, R_STB = 98304;

template <bool R2>
__device__ __forceinline__ void ret_stage(const Params& p_, int b, int h, int n, unsigned char* lds, float l2f, float l2b) {
    const Params p = *kparams(); (void)p_;
    const int tid = otid(), j = tid >> 2, c4 = tid & 3, s = n * 128 + j;
    const bf16* Z = (const bf16*)(p.ws + WS_Z); const bf16* zr = Z + (size_t)(b * SEQ + s) * DIN;
    const f32x4* rp = (const f32x4*)((const float2*)(p.ws + WS_ROPE) + s * 32 + c4 * 8);
    float cs[8], sn[8];
#pragma unroll
    for (int i = 0; i < 4; ++i) { const f32x4 r = rp[i]; cs[2 * i] = r[0]; sn[2 * i] = r[1]; cs[2 * i + 1] = r[2]; sn[2 * i + 1] = r[3]; }
    bf16* KS = (bf16*)(lds + R_KS); bf16* VT = (bf16*)(lds + R_VT);
    { const u32x4 ka = *(const u32x4*)(zr + 7 * DG + h * 64 + c4 * 8), kb = *(const u32x4*)(zr + 7 * DG + h * 64 + 32 + c4 * 8);
      const unsigned kau[4] = {ka.x, ka.y, ka.z, ka.w}, kbu[4] = {kb.x, kb.y, kb.z, kb.w};
      float k1[8], k2[8];
#pragma unroll
      for (int i = 0; i < 4; ++i) { const float a0 = bflo(kau[i]), a1 = bfhi(kau[i]), b0 = bflo(kbu[i]), b1 = bfhi(kbu[i]);
          k1[2 * i] = a0 * cs[2 * i] - b0 * sn[2 * i]; k2[2 * i] = a0 * sn[2 * i] + b0 * cs[2 * i];
          k1[2 * i + 1] = a1 * cs[2 * i + 1] - b1 * sn[2 * i + 1]; k2[2 * i + 1] = a1 * sn[2 * i + 1] + b1 * cs[2 * i + 1]; }
      u32x4 o1, o2; o1.x = pk2(k1[0], k1[1]); o1.y = pk2(k1[2], k1[3]); o1.z = pk2(k1[4], k1[5]); o1.w = pk2(k1[6], k1[7]);
      o2.x = pk2(k2[0], k2[1]); o2.y = pk2(k2[2], k2[3]); o2.z = pk2(k2[4], k2[5]); o2.w = pk2(k2[6], k2[7]);
      *(u32x4*)(KS + j * 72 + c4 * 8) = o1; *(u32x4*)(KS + j * 72 + 32 + c4 * 8) = o2;
      if (!R2) { bf16* KTF = (bf16*)(lds + R_KTF); bf16* KTB = (bf16*)(lds + R_KTB);
          const float df = exp2f(l2f * (float)(127 - j)), db = exp2f(l2b * (float)j);
#pragma unroll
          for (int i = 0; i < 8; ++i) { KTF[(c4 * 8 + i) * 136 + j] = (bf16)f2bf(k1[i] * df); KTF[(32 + c4 * 8 + i) * 136 + j] = (bf16)f2bf(k2[i] * df);
              KTB[(c4 * 8 + i) * 136 + j] = (bf16)f2bf(k1[i] * db); KTB[(32 + c4 * 8 + i) * 136 + j] = (bf16)f2bf(k2[i] * db); } } }
    { const u32x4 va = *(const u32x4*)(zr + 8 * DG + h * 64 + c4 * 16), vb = *(const u32x4*)(zr + 8 * DG + h * 64 + c4 * 16 + 8);
      const unsigned vu[8] = {va.x, va.y, va.z, va.w, vb.x, vb.y, vb.z, vb.w};
#pragma unroll
      for (int i = 0; i < 8; ++i) { VT[(c4 * 16 + 2 * i) * 136 + j] = (bf16)(vu[i] & 0xffffu); VT[(c4 * 16 + 2 * i + 1) * 136 + j] = (bf16)(vu[i] >> 16); } }
    if (R2) { bf16* QS = (bf16*)(lds + R_QS);
      const u32x4 qa = *(const u32x4*)(zr + 6 * DG + h * 64 + c4 * 8), qb = *(const u32x4*)(zr + 6 * DG + h * 64 + 32 + c4 * 8);
      const unsigned qau[4] = {qa.x, qa.y, qa.z, qa.w}, qbu[4] = {qb.x, qb.y, qb.z, qb.w};
      float q1[8], q2[8];
#pragma unroll
      for (int i = 0; i < 4; ++i) { const float a0 = bflo(qau[i]), a1 = bfhi(qau[i]), b0 = bflo(qbu[i]), b1 = bfhi(qbu[i]);
          q1[2 * i] = (a0 * cs[2 * i] - b0 * sn[2 * i]) * 0.125f; q2[2 * i] = (a0 * sn[2 * i] + b0 * cs[2 * i]) * 0.125f;
          q1[2 * i + 1] = (a1 * cs[2 * i + 1] - b1 * sn[2 * i + 1]) * 0.125f; q2[2 * i + 1] = (a1 * sn[2 * i + 1] + b1 * cs[2 * i + 1]) * 0.125f; }
      u32x4 o1, o2; o1.x = pk2(q1[0], q1[1]); o1.y = pk2(q1[2], q1[3]); o1.z = pk2(q1[4], q1[5]); o1.w = pk2(q1[6], q1[7]);
      o2.x = pk2(q2[0], q2[1]); o2.y = pk2(q2[2], q2[3]); o2.z = pk2(q2[4], q2[5]); o2.w = pk2(q2[6], q2[7]);
      *(u32x4*)(QS + j * 72 + c4 * 8) = o1; *(u32x4*)(QS + j * 72 + 32 + c4 * 8) = o2; }
}

__device__ __forceinline__ void ret1_task(const Params& p_, int l, int task, unsigned char* lds) {
    const Params p = *kparams(); (void)p_;
    const int n = task & 31, h = (task >> 5) & 7, b = task >> 8;
    const float xf = p.rl_f[l * 8 + h], xb = p.rl_b[l * 8 + h];
    const float l2f = -log1pf(expf(-xf)) * 1.4426950408889634f, l2b = -log1pf(expf(-xb)) * 1.4426950408889634f;
    ret_stage<false>(p, b, h, n, lds, l2f, l2b);
    __syncthreads();
    const int tid = otid(), lane = tid & 63, w = tid >> 6, fr = lane & 15, fq = lane >> 4, dir = w >> 2, et = w & 3;
    const bf16* VT = (const bf16*)(lds + R_VT); const bf16* KT = (const bf16*)(lds + (dir ? R_KTB : R_KTF));
    bf16x8v a[4];
#pragma unroll
    for (int ks = 0; ks < 4; ++ks) a[ks] = *(const bf16x8v*)(VT + (16 * et + fr) * 136 + 32 * ks + 8 * fq);
    float* dst = (float*)(p.ws + WS_KV) + ((size_t)((dir * 2 + b) * 8 + h) * 32 + n) * 4096;
#pragma unroll
    for (int dt = 0; dt < 4; ++dt) { f32x4 acc = {0.f, 0.f, 0.f, 0.f};
#pragma unroll
        for (int ks = 0; ks < 4; ++ks) { const bf16x8v bfr = *(const bf16x8v*)(KT + (16 * dt + fr) * 136 + 32 * ks + 8 * fq); acc = MFMA16(a[ks], bfr, acc); }
#pragma unroll
        for (int r = 0; r < 4; ++r) dst[(16 * et + 4 * fq + r) * 64 + 16 * dt + fr] = acc[r]; }
    __syncthreads();
}

__device__ __forceinline__ void ret2_task(const Params& p_, int l, int task, unsigned char* lds) {
    const Params p = *kparams(); (void)p_;
    const int n = task & 31, h = (task >> 5) & 7, b = task >> 8;
    const float xf = p.rl_f[l * 8 + h], xb = p.rl_b[l * 8 + h];
    const float l2f = -log1pf(expf(-xf)) * 1.4426950408889634f, l2b = -log1pf(expf(-xb)) * 1.4426950408889634f;
    ret_stage<true>(p, b, h, n, lds, l2f, l2b);
    const int tid = otid(), lane = tid & 63, w = tid >> 6, fr = lane & 15, fq = lane >> 4;
    {
      const float gfC = exp2f(l2f * 128.f), gbC = exp2f(l2b * 128.f);
      const float* KVf = (const float*)(p.ws + WS_KV) + ((size_t)((0 * 2 + b) * 8 + h) * 32) * 4096 + tid * 8;
      const float* KVb = (const float*)(p.ws + WS_KV) + ((size_t)((1 * 2 + b) * 8 + h) * 32) * 4096 + tid * 8;
      f32x4 f0 = {0.f, 0.f, 0.f, 0.f}, f1 = f0, g0 = f0, g1 = f0;
      float cw[4]; cw[0] = 1.f;
      { const float g2 = gfC * gfC; float c1 = gfC, c2 = g2, c3 = g2 * gfC; const float g4 = g2 * g2; float c0 = 1.f;
        int m = n - 1;
        for (; m >= 3; m -= 4) { const f32x4 a0 = *(const f32x4*)(KVf + (size_t)m * 4096), a1 = *(const f32x4*)(KVf + (size_t)m * 4096 + 4), b0 = *(const f32x4*)(KVf + (size_t)(m - 1) * 4096), b1 = *(const f32x4*)(KVf + (size_t)(m - 1) * 4096 + 4),
              c0v = *(const f32x4*)(KVf + (size_t)(m - 2) * 4096), c1v = *(const f32x4*)(KVf + (size_t)(m - 2) * 4096 + 4), d0v = *(const f32x4*)(KVf + (size_t)(m - 3) * 4096), d1v = *(const f32x4*)(KVf + (size_t)(m - 3) * 4096 + 4);
            f0 += a0 * c0 + b0 * c1 + c0v * c2 + d0v * c3; f1 += a1 * c0 + b1 * c1 + c1v * c2 + d1v * c3; c0 *= g4; c1 *= g4; c2 *= g4; c3 *= g4; }
        for (; m >= 0; --m) { const f32x4 x0 = *(const f32x4*)(KVf + (size_t)m * 4096), x1 = *(const f32x4*)(KVf + (size_t)m * 4096 + 4); f0 += x0 * c0; f1 += x1 * c0; c0 *= gfC; } }
      { const float g2 = gbC * gbC; float c0 = 1.f, c1 = gbC, c2 = g2, c3 = g2 * gbC; const float g4 = g2 * g2;
        int m = n + 1;
        for (; m + 3 < 32; m += 4) { const f32x4 a0 = *(const f32x4*)(KVb + (size_t)m * 4096), a1 = *(const f32x4*)(KVb + (size_t)m * 4096 + 4), b0 = *(const f32x4*)(KVb + (size_t)(m + 1) * 4096), b1 = *(const f32x4*)(KVb + (size_t)(m + 1) * 4096 + 4),
              c0v = *(const f32x4*)(KVb + (size_t)(m + 2) * 4096), c1v = *(const f32x4*)(KVb + (size_t)(m + 2) * 4096 + 4), d0v = *(const f32x4*)(KVb + (size_t)(m + 3) * 4096), d1v = *(const f32x4*)(KVb + (size_t)(m + 3) * 4096 + 4);
            g0 += a0 * c0 + b0 * c1 + c0v * c2 + d0v * c3; g1 += a1 * c0 + b1 * c1 + c1v * c2 + d1v * c3; c0 *= g4; c1 *= g4; c2 *= g4; c3 *= g4; }
        for (; m < 32; ++m) { const f32x4 x0 = *(const f32x4*)(KVb + (size_t)m * 4096), x1 = *(const f32x4*)(KVb + (size_t)m * 4096 + 4); g0 += x0 * c0; g1 += x1 * c0; c0 *= gbC; } }
      (void)cw;
      const int e = tid >> 3, d0 = (tid & 7) * 8; u32x4 o;
      o.x = pk2(f0[0], f0[1]); o.y = pk2(f0[2], f0[3]); o.z = pk2(f1[0], f1[1]); o.w = pk2(f1[2], f1[3]); *(u32x4*)((bf16*)(lds + R_STF) + e * 72 + d0) = o;
      o.x = pk2(g0[0], g0[1]); o.y = pk2(g0[2], g0[3]); o.z = pk2(g1[0], g1[1]); o.w = pk2(g1[2], g1[3]); *(u32x4*)((bf16*)(lds + R_STB) + e * 72 + d0) = o; }
    __syncthreads();
    const bf16* QS = (const bf16*)(lds + R_QS); const bf16* KS = (const bf16*)(lds + R_KS); const bf16* VT = (const bf16*)(lds + R_VT);
    const bf16* STF = (const bf16*)(lds + R_STF); const bf16* STB = (const bf16*)(lds + R_STB);
    bf16x8v qf[2];
#pragma unroll
    for (int ks = 0; ks < 2; ++ks) qf[ks] = *(const bf16x8v*)(QS + (16 * w + fr) * 72 + 32 * ks + 8 * fq);
    const int ai = 16 * w + fr;
    unsigned pp[8][2];
#pragma unroll
    for (int jt = 0; jt < 8; ++jt) { f32x4 acc = {0.f, 0.f, 0.f, 0.f};
#pragma unroll
        for (int ks = 0; ks < 2; ++ks) { const bf16x8v kf = *(const bf16x8v*)(KS + (16 * jt + fr) * 72 + 32 * ks + 8 * fq); acc = MFMA16(kf, qf[ks], acc); }
        float sc[4];
#pragma unroll
        for (int r = 0; r < 4; ++r) { const int aj = 16 * jt + 4 * fq + r; const float wg = (aj <= ai) ? exp2f(l2f * (float)(ai - aj)) : exp2f(l2b * (float)(aj - ai)); sc[r] = acc[r] * wg; }
        pp[jt][0] = pk2(sc[0], sc[1]); pp[jt][1] = pk2(sc[2], sc[3]); }
    const float qdf = exp2f(l2f * (float)(ai + 1)), qdb = exp2f(l2b * (float)(128 - ai));
    f32x4 tot[4]; float ss = 0.f;
#pragma unroll
    for (int et = 0; et < 4; ++et) { f32x4 o = {0.f, 0.f, 0.f, 0.f}, cfa = o, cba = o;
#pragma unroll
        for (int t = 0; t < 4; ++t) { const u32x2 vlo = *(const u32x2*)(VT + (16 * et + fr) * 136 + 32 * t + 4 * fq), vhi = *(const u32x2*)(VT + (16 * et + fr) * 136 + 32 * t + 16 + 4 * fq);
            o = MFMA16(mk8(vlo.x, vlo.y, vhi.x, vhi.y), mk8(pp[2 * t][0], pp[2 * t][1], pp[2 * t + 1][0], pp[2 * t + 1][1]), o); }
#pragma unroll
        for (int ks = 0; ks < 2; ++ks) { const bf16x8v sf = *(const bf16x8v*)(STF + (16 * et + fr) * 72 + 32 * ks + 8 * fq), sb = *(const bf16x8v*)(STB + (16 * et + fr) * 72 + 32 * ks + 8 * fq);
            cfa = MFMA16(sf, qf[ks], cfa); cba = MFMA16(sb, qf[ks], cba); }
        tot[et] = o + cfa * qdf + cba * qdb;
        ss += (tot[et][0] * tot[et][0] + tot[et][1] * tot[et][1]) + (tot[et][2] * tot[et][2] + tot[et][3] * tot[et][3]); }
    ss += __shfl_xor(ss, 16); ss += __shfl_xor(ss, 32);
    const float rs = rsqrtf(ss * (1.f / 64.f) + 1e-6f);
    const size_t tok = (size_t)b * SEQ + n * 128 + ai;
    const bf16* Z = (const bf16*)(p.ws + WS_Z); bf16* CAT = (bf16*)(p.ws + WS_CAT);
#pragma unroll
    for (int et = 0; et < 4; ++et) { const u32x2 gz = *(const u32x2*)(Z + tok * DIN + 9 * DG + h * 64 + 16 * et + 4 * fq); u32x2 o;
        o.x = pk2(tot[et][0] * rs * silu_f(bflo(gz.x)), tot[et][1] * rs * silu_f(bfhi(gz.x))); o.y = pk2(tot[et][2] * rs * silu_f(bflo(gz.y)), tot[et][3] * rs * silu_f(bfhi(gz.y)));
        *(u32x2*)(CAT + tok * DM + 1024 + h * 64 + 16 * et + 4 * fq) = o; }
    __syncthreads();
}

__device__ __forceinline__ void na2_task(const Params& p_, int l, int task, unsigned char* lds) {
    const Params p = *kparams(); (void)p_;
    const int tid = otid(), lane = tid & 63, w = tid >> 6, fr = lane & 15, fq = lane >> 4;
    const int hp = task & 3, rq = (task >> 2) & 63, b = task >> 8;
    const int row_start = min(max(rq - 4, 0), 56);
    const bf16* Z = (const bf16*)(p.ws + WS_Z); bf16* CAT = (bf16*)(p.ws + WS_CAT);
    bf16* VT = (bf16*)lds; float* BI = (float*)(lds + 133120);
    for (int i = tid; i < 930; i += NTHR) BI[i] = p.na_bias[(size_t)(l * 8 + hp * 2) * 465 + i];
    { const int pair = lane & 31, chunk = (lane >> 5) + 2 * (w & 3), hh = w >> 2, h = hp * 2 + hh;
      unsigned* VTd = (unsigned*)(VT + (size_t)hh * 64 * 520);
#pragma unroll 2
      for (int a = 0; a < 8; ++a) {
          const size_t tok = (size_t)b * SEQ + (row_start + a) * 64 + 2 * pair;
          const bf16* src = Z + tok * DIN + 4 * DG + h * 64 + chunk * 8;
          const u32x4 x = *(const u32x4*)src, y = *(const u32x4*)(src + DIN);
          const unsigned xu[4] = {x.x, x.y, x.z, x.w}, yu[4] = {y.x, y.y, y.z, y.w};
#pragma unroll
          for (int i = 0; i < 4; ++i) { VTd[(chunk * 8 + 2 * i) * 260 + a * 32 + pair] = (xu[i] & 0xffffu) | (yu[i] << 16);
              VTd[(chunk * 8 + 2 * i + 1) * 260 + a * 32 + pair] = (xu[i] >> 16) | (yu[i] & 0xffff0000u); } } }
    __syncthreads();
    const int hh = w >> 2, h = hp * 2 + hh, qb = w & 3, ct0 = (qb >= 2) ? 1 : 0;
    const int c = 16 * qb + fr; const size_t qtok = (size_t)b * SEQ + rq * 64 + c;
    bf16x8v qf[2];
#pragma unroll
    for (int ks = 0; ks < 2; ++ks) qf[ks] = *(const bf16x8v*)(Z + qtok * DIN + 2 * DG + h * 64 + 32 * ks + 8 * fq);
    const int col_start = min(max(c - 8, 0), 48);
    const float* bi = BI + hh * 465;
    float sc[24][4]; float mx = -1e30f;
#pragma unroll
    for (int a = 0; a < 8; ++a)
#pragma unroll
        for (int ci = 0; ci < 3; ++ci) { const int kt = a * 3 + ci;
            const size_t ktok = (size_t)b * SEQ + (row_start + a) * 64 + 16 * (ct0 + ci) + fr;
            f32x4 acc = {0.f, 0.f, 0.f, 0.f};
#pragma unroll
            for (int ks = 0; ks < 2; ++ks) { const bf16x8v kf = *(const bf16x8v*)(Z + ktok * DIN + 3 * DG + h * 64 + 32 * ks + 8 * fq); acc = MFMA16(kf, qf[ks], acc); }
            const int dr = row_start + a - rq;
#pragma unroll
            for (int r = 0; r < 4; ++r) { const int kc = 16 * (ct0 + ci) + 4 * fq + r, rel = kc - col_start, dc = kc - c;
                float v = acc[r] * 0.125f + bi[(dr + 7) * 31 + min(max(dc + 15, 0), 30)];
                v = (rel >= 0 && rel < 16) ? v : -1e30f; sc[kt][r] = v; mx = fmaxf(mx, v); } }
    mx = fmaxf(mx, __shfl_xor(mx, 16)); mx = fmaxf(mx, __shfl_xor(mx, 32));
    float sum = 0.f; unsigned pp[24][2];
#pragma unroll
    for (int kt = 0; kt < 24; ++kt) { const float e0 = __expf(sc[kt][0] - mx), e1 = __expf(sc[kt][1] - mx), e2 = __expf(sc[kt][2] - mx), e3 = __expf(sc[kt][3] - mx);
        sum += (e0 + e1) + (e2 + e3); pp[kt][0] = pk2(e0, e1); pp[kt][1] = pk2(e2, e3); }
    sum += __shfl_xor(sum, 16); sum += __shfl_xor(sum, 32);
    const float inv = 1.f / sum;
    const bf16* VTh = VT + (size_t)hh * 64 * 520;
#pragma unroll
    for (int dt = 0; dt < 4; ++dt) { f32x4 o = {0.f, 0.f, 0.f, 0.f};
#pragma unroll
        for (int t = 0; t < 12; ++t) { const int k0 = 2 * t, k1 = 2 * t + 1, a0 = k0 / 3, c0 = k0 % 3, a1 = k1 / 3, c1 = k1 % 3;
            const u32x2 vlo = *(const u32x2*)(VTh + (16 * dt + fr) * 520 + a0 * 64 + 16 * (ct0 + c0) + 4 * fq), vhi = *(const u32x2*)(VTh + (16 * dt + fr) * 520 + a1 * 64 + 16 * (ct0 + c1) + 4 * fq);
            o = MFMA16(mk8(vlo.x, vlo.y, vhi.x, vhi.y), mk8(pp[k0][0], pp[k0][1], pp[k1][0], pp[k1][1]), o); }
        const u32x2 gz = *(const u32x2*)(Z + qtok * DIN + 5 * DG + h * 64 + 16 * dt + 4 * fq); u32x2 ov;
        ov.x = pk2(o[0] * inv * silu_f(bflo(gz.x)), o[1] * inv * silu_f(bfhi(gz.x))); ov.y = pk2(o[2] * inv * silu_f(bflo(gz.y)), o[3] * inv * silu_f(bfhi(gz.y)));
        *(u32x2*)(CAT + qtok * DM + 512 + h * 64 + 16 * dt + 4 * fq) = ov; }
    __syncthreads();
}

__device__ __forceinline__ void conv_task(const Params& p_, int l, int task, unsigned char* lds) {
    const Params p = *kparams(); (void)p_;
    const int tid = otid(), lane = tid & 63, wave = tid >> 6;
    float* us = (float*)lds; float* ys = us + 46 * 512;
    const bf16* Z = (const bf16*)(p.ws + WS_Z);
    const int b = task >> 8, t0 = (task & 255) * 16;
#pragma unroll
    for (int it = 0; it < 6; ++it) { const int idx = tid + it * NTHR, tt = idx >> 6, cc = (idx & 63) * 8, tok = t0 - 15 + tt;
        if (idx < 46 * 64) { f32x4 u0 = {0.f, 0.f, 0.f, 0.f}, u1 = u0;
            if (tok >= 0 && tok < SEQ) { const bf16* zr = Z + (size_t)(b * SEQ + tok) * DIN; const u32x4 a = *(const u32x4*)(zr + 10 * DG + cc), g = *(const u32x4*)(zr + 11 * DG + cc);
                u0[0] = bflo(a.x) / (1.f + __expf(-bflo(g.x))); u0[1] = bfhi(a.x) / (1.f + __expf(-bfhi(g.x))); u0[2] = bflo(a.y) / (1.f + __expf(-bflo(g.y))); u0[3] = bfhi(a.y) / (1.f + __expf(-bfhi(g.y)));
                u1[0] = bflo(a.z) / (1.f + __expf(-bflo(g.z))); u1[1] = bfhi(a.z) / (1.f + __expf(-bfhi(g.z))); u1[2] = bflo(a.w) / (1.f + __expf(-bflo(g.w))); u1[3] = bfhi(a.w) / (1.f + __expf(-bfhi(g.w))); }
            *(f32x4*)(us + tt * 512 + cc) = u0; *(f32x4*)(us + tt * 512 + cc + 4) = u1; } }
    float w[31];
#pragma unroll
    for (int k = 0; k < 31; ++k) w[k] = p.conv_w[(size_t)(l * 31 + k) * DG + tid];
    const float cb = p.conv_b[l * DG + tid];
    __syncthreads();
    for (int t = 0; t < 16; ++t) { float acc = cb;
#pragma unroll
        for (int k = 0; k < 31; ++k) acc += w[k] * us[(t + k) * 512 + tid];
        ys[t * 512 + tid] = acc; }
    __syncthreads();
#pragma unroll
    for (int tw = 0; tw < 2; ++tw) { const int t = wave + 8 * tw; float v[8]; float s = 0.f;
#pragma unroll
        for (int j = 0; j < 8; ++j) { v[j] = ys[t * 512 + lane + 64 * j]; s += v[j]; }
        const float mu = wave_sum(s) * (1.f / 512.f); float q = 0.f;
#pragma unroll
        for (int j = 0; j < 8; ++j) { v[j] -= mu; q += v[j] * v[j]; }
        const float rstd = rsqrtf(wave_sum(q) * (1.f / 512.f) + 1e-6f);
        bf16* orow = (bf16*)(p.ws + WS_CVH) + (size_t)(b * SEQ + t0 + t) * DG;
#pragma unroll
        for (int j = 0; j < 8; ++j) { const int ch = lane + 64 * j; const float y = v[j] * rstd * p.ln_g[l * DG + ch] + p.ln_b[l * DG + ch]; orow[ch] = (bf16)f2bf(silu_f(y)); } }
    __syncthreads();
}

__device__ __forceinline__ void ph_mixA(const Params& p, int l, unsigned char* lds) {
    const int G = gridDim.x, bid = obid();
    for (int t = bid; t < 512 * REP_R1; t += G) ret1_task(p, l, t & 511, lds);
    if (G == 256 && REP_NA == 1) {
        if (bid < 128) na2_task(p, l, bid, lds);
        else for (int i = 0; i < 3; ++i) na2_task(p, l, 128 + (bid - 128) * 3 + i, lds);
    } else for (int t = bid; t < 512 * REP_NA; t += G) na2_task(p, l, t & 511, lds);
    for (int t = bid; t < 512 * REP_CV; t += G) conv_task(p, l, t & 511, lds);
}

__device__ __forceinline__ void ph_combine(const Params& p_) {
    const Params p = *kparams(); (void)p_;
    const float* part = (const float*)(p.ws + WS_U); bf16* CAT = (bf16*)(p.ws + WS_CAT); const bf16* Z = (const bf16*)(p.ws + WS_Z);
    for (int e = obid() * NTHR + otid(); e < MTOK * DG / 4; e += gridDim.x * NTHR) {
        const int row = e >> 7, c4 = (e & 127) * 4, b = row >> 12, k = row & 4095;
        f32x4 s = {0.f, 0.f, 0.f, 0.f};
#pragma unroll
        for (int ks = 0; ks < 4; ++ks) s += *(const f32x4*)(part + ((size_t)((b * 4 + ks) * 4096 + k)) * 512 + c4);
        const u32x2 gz = *(const u32x2*)(Z + (size_t)row * DIN + DG + c4);
        u32x2 w; w.x = pk2(s[0] * silu_f(bflo(gz.x)), s[1] * silu_f(bfhi(gz.x))); w.y = pk2(s[2] * silu_f(bflo(gz.y)), s[3] * silu_f(bfhi(gz.y)));
        *(u32x2*)(CAT + (size_t)row * DM + c4) = w;
    }
}

#define XB_TMO      128
#define XB_XCNT(j)  (256  + 64 * (j))
#define XB_XSUB(j)  (1280 + 64 * (j))
#define XB_XGEN(j)  (2304 + 64 * (j))
#define XB_TOP      3328
#define XB_TOPGEN   3392
#define XCD_BAR_WORDS 3456
#define XB_SPIN_CAP (1u << 20)
__device__ __forceinline__ unsigned xb_ld(unsigned* p)              { return __hip_atomic_load(p, __ATOMIC_RELAXED, __HIP_MEMORY_SCOPE_AGENT); }
__device__ __forceinline__ unsigned xb_add(unsigned* p, unsigned v) { return __hip_atomic_fetch_add(p, v, __ATOMIC_RELAXED, __HIP_MEMORY_SCOPE_AGENT); }
__device__ __forceinline__ unsigned xb_xcc_id() { return (unsigned)__builtin_amdgcn_s_getreg((3 << 11) | 20) & 0xFu; }
#define XB_SPIN(cond, bar) do { unsigned _sp = 0; while (cond) { __builtin_amdgcn_s_sleep(1); \
    if ((++_sp & 255u) == 0u) { if (xb_ld(&(bar)[XB_TMO])) break; if (_sp > XB_SPIN_CAP) { atomicAdd(&(bar)[XB_TMO], 1u); break; } } } } while (0)
struct XcdBarrier { unsigned* bar; unsigned x; volatile PG8_LAS unsigned* st; };
__device__ __forceinline__ XcdBarrier xcd_barrier_post(unsigned* bar, volatile PG8_LAS unsigned* st) {
    XcdBarrier b; b.bar = bar; b.x = xb_xcc_id(); b.st = st;
    if (otid() == 0) (void)xb_add(&bar[XB_XCNT(b.x)], 1u);
    return b;
}
__device__ __forceinline__ void xcd_barrier_complete(unsigned* bar, unsigned x, unsigned& nloc, unsigned& nx) {
    const unsigned G = gridDim.x * gridDim.y * gridDim.z;
    unsigned sum, cnt, mine, sp = 0u;
    for (;;) {
        sum = 0u; cnt = 0u; mine = 0u;
#pragma unroll
        for (unsigned j = 0; j < 16; ++j) { const unsigned c = xb_ld(&bar[XB_XCNT(j)]); sum += c; cnt += (c > 0u) ? 1u : 0u; mine = (j == x) ? c : mine; }
        if (sum == G) break;
        __builtin_amdgcn_s_sleep(1);
        if ((++sp & 255u) == 0u) { if (xb_ld(&bar[XB_TMO])) break; if (sp > XB_SPIN_CAP) { atomicAdd(&bar[XB_TMO], 1u); break; } }
    }
    nloc = mine > 0u ? mine : 1u; nx = cnt > 0u ? cnt : 1u;
}
__device__ __forceinline__ void xcd_barrier(const XcdBarrier& b) {
    asm volatile("s_waitcnt vmcnt(0)" ::: "memory");
    __syncthreads();
    if (otid() == 0) {
        unsigned* bar = b.bar;
        __builtin_amdgcn_s_waitcnt(0);
        unsigned nloc = b.st[0], nx = b.st[1];
        if (nloc == 0u) { xcd_barrier_complete(bar, b.x, nloc, nx); b.st[0] = nloc; b.st[1] = nx; }
        const unsigned old = xb_add(&bar[XB_XSUB(b.x)], 1u);
        const unsigned gen = old / nloc;
        if (old + 1u == (gen + 1u) * nloc) {
            __builtin_amdgcn_fence(__ATOMIC_RELEASE, "agent");
            asm volatile("s_waitcnt vmcnt(0)" ::: "memory");
            const unsigned og = xb_add(&bar[XB_TOP], 1u);
            const unsigned tg = og / nx;
            if (og + 1u == (tg + 1u) * nx) xb_add(&bar[XB_TOPGEN], 1u);
            else XB_SPIN(xb_ld(&bar[XB_TOPGEN]) == tg, bar);
            __builtin_amdgcn_fence(__ATOMIC_ACQUIRE, "agent");
            xb_add(&bar[XB_XGEN(b.x)], 1u);
            asm volatile("s_waitcnt vmcnt(0)" ::: "memory");
        } else {
            XB_SPIN(xb_ld(&bar[XB_XGEN(b.x)]) == gen, bar);
            __builtin_amdgcn_fence(__ATOMIC_ACQUIRE, "agent");
            asm volatile("s_waitcnt vmcnt(0)" ::: "memory");
        }
    }
    __syncthreads();
}

constexpr int NPH = 14;
__global__ void __launch_bounds__(NTHR) mega(Params p) {
    extern __shared__ __attribute__((aligned(16))) unsigned char lds[];
    cg::grid_group grid = cg::this_grid();
    PG8_LAS unsigned char* ldsl = (PG8_LAS unsigned char*)lds;
    const int lo = p.ph_lo, hi = p.ph_hi;
#define IN(k) (lo <= (k) && (k) < hi)
#define SEAM(k) do { if (IN(k) && IN((k) + 1)) { xcd_barrier(xb); } } while (0)
    bf16* Zb = (bf16*)(kparams()->ws + WS_Z); bf16* CAT = (bf16*)(kparams()->ws + WS_CAT);
    volatile PG8_LAS unsigned* xst = (volatile PG8_LAS unsigned*)(ldsl + LDS_BYTES - 16);
    { const int t0_ = otid(); if (t0_ < 4) xst[t0_] = 0u; }
    __syncthreads();
    XcdBarrier xb = xcd_barrier_post((unsigned*)(kparams()->ws + WS_BAR), xst);
    if (p.ph_lo < 0) grid.sync();
    if (IN(0)) REPEAT(REP_PRO) { ph_prologue(p, lds); __syncthreads(); }
    SEAM(0);
    if (IN(0) && IN(1)) for (int r_ = 1; r_ < REP_SUB; ++r_) xcd_barrier(xb);
#pragma unroll
    for (int l = 0; l < NL; ++l) {
        const int pb = 1 + 6 * l;
        const char* Wl = (const char*)(kparams()->ws + WS_WIN + (size_t)l * WROWS * DM * 2);
        if (IN(pb)) {
            if (l == 0) {
#pragma unroll
                for (int ll = 0; ll < NL; ++ll) {
                    SchedS S = make_sched(kparams()->ws + WS_WCS + (size_t)ll * 1024 * DG * 2, DG, kparams()->ws + WS_WFXB + (size_t)ll * DM * DG * 2, DG, 1024, DM, 32 * ll);
                    EpiZ E{(bf16*)(kparams()->ws + WS_WIN + ((size_t)ll * WROWS + 6656) * DM * 2), DM};
                    pg8::gemm_phase<EpiZ, SchedS, true>(ldsl, pg8::Gemm{DG, DG, DG}, S, E);
                }
            }
            REPEAT(REP_NORM) ph_norm(p, l);
        }
        SEAM(pb);
        if (IN(pb + 1)) REPEAT(REP_Z) {
            SchedZ S; S.o.init(MTOK, 24 * 256, (int)gridDim.x, obid()); S.A = (const char*)(kparams()->ws + WS_U); S.B = Wl; S.late = 0;
            EpiZ2 E{Zb, (bf16*)(kparams()->ws + WS_PQT)};
            pg8::gemm_phase<EpiZ2, SchedZ, true>(ldsl, pg8::Gemm{DM, DM, DM}, S, E);
        }
        SEAM(pb + 1);
        if (IN(pb + 2)) {
            {
                SchedZ S; S.o.init(MTOK, 4 * 256, (int)gridDim.x, obid()); S.A = (const char*)(kparams()->ws + WS_U); S.B = Wl; S.late = 1;
                EpiZ2 E{Zb, (bf16*)(kparams()->ws + WS_PQT)};
                pg8::gemm_phase<EpiZ2, SchedZ, true>(ldsl, pg8::Gemm{DM, DM, DM}, S, E);
            }
            REPEAT(REP_MIX) ph_mixA(p, l, lds);
        }
        SEAM(pb + 2);
        if (IN(pb + 3)) REPEAT(REP_P3) {
            { SchedDFT S{(const char*)(kparams()->ws + WS_DFT), (const char*)(kparams()->ws + WS_PQT), (int)gridDim.x, obid()};
              EpiPart E{(float*)(kparams()->ws + WS_U)};
              pg8::gemm_phase<EpiPart, SchedDFT, true>(ldsl, pg8::Gemm{8192, 8192, 2048}, S, E); }
            { SchedS S = make_sched(kparams()->ws + WS_CVH, DG, kparams()->ws + WS_WPW + (size_t)l * DG * DG * 2, DG, MTOK, DG);
              EpiGate E{CAT, Zb, 1536, 12 * DG};
              pg8::gemm_phase<EpiGate, SchedS, true>(ldsl, pg8::Gemm{DG, DG, DG}, S, E); }
            for (int t = obid(); t < 512 * REP_R2; t += gridDim.x) ret2_task(p, l, t & 511, lds);
        }
        SEAM(pb + 3);
        if (IN(pb + 4)) REPEAT(REP_CMB) ph_combine(p);
        SEAM(pb + 4);
        if (IN(pb + 5)) REPEAT(l == 0 ? REP_OUT : 1) {
            SchedS S = make_sched(CAT, DM, kparams()->ws + WS_WOUT + (size_t)l * DM * DM * 2, DM, MTOK, DM);
            EpiRes E{(l == 0) ? kparams()->x : kparams()->out, kparams()->out, (const float*)(kparams()->ws + WS_MOD) + (size_t)l * 2 * 6144 + 4096};
            pg8::gemm_phase<EpiRes, SchedS, true>(ldsl, pg8::Gemm{DM, DM, DM}, S, E);
        }
        SEAM(pb + 5);
    }
    if (IN(NPH - 1)) ph_final(p);
#undef IN
#undef SEAM
}

extern "C" void kernel_launch(void* const* d_in, const int* in_sizes, int n_in, void* d_out, int out_size, void* d_ws, size_t ws_size, hipStream_t stream) {
    static int grid_blocks = 0;
    if (grid_blocks == 0) {
        if (n_in != 17 || ws_size < WS_END) { fprintf(stderr, "kernel_launch: n_in %d ws %zu (need %zu)\n", n_in, ws_size, (size_t)WS_END); grid_blocks = -1; return; }
        int dev = 0, cus = 0, per_cu = 0;
        hipGetDevice(&dev); hipDeviceGetAttribute(&cus, hipDeviceAttributeMultiprocessorCount, dev);
        if (hipFuncSetAttribute((const void*)mega, hipFuncAttributeMaxDynamicSharedMemorySize, LDS_BYTES) != hipSuccess) { fprintf(stderr, "hipFuncSetAttribute failed\n"); grid_blocks = -1; return; }
        if (hipOccupancyMaxActiveBlocksPerMultiprocessor(&per_cu, (const void*)mega, NTHR, LDS_BYTES) != hipSuccess || per_cu < 1) { fprintf(stderr, "occupancy query: %d\n", per_cu); per_cu = 1; }
        (void)hipGetLastError();
        grid_blocks = cus * 1;
    }
    if (grid_blocks < 0) return;
    Params p{};
    p.x = (const float*)d_in[0]; p.c = (const float*)d_in[1]; p.norm_g = (const float*)d_in[2]; p.w_ada = (const float*)d_in[3]; p.b_ada = (const float*)d_in[4];
    p.w_in = (const float*)d_in[5]; p.w_fft = (const float*)d_in[6]; p.na_bias = (const float*)d_in[7]; p.rl_f = (const float*)d_in[8]; p.rl_b = (const float*)d_in[9];
    p.conv_w = (const float*)d_in[10]; p.conv_b = (const float*)d_in[11]; p.ln_g = (const float*)d_in[12]; p.ln_b = (const float*)d_in[13]; p.w_pw = (const float*)d_in[14];
    p.w_out = (const float*)d_in[15]; p.final_g = (const float*)d_in[16];
    p.out = (float*)d_out; p.ws = (unsigned char*)d_ws;
#if ONE_LAUNCH
    if (hipMemsetAsync((char*)d_ws + WS_BAR, 0, 16384, stream) != hipSuccess) { fprintf(stderr, "memset of the barrier words failed\n"); return; }
    p.ph_lo = 0; p.ph_hi = NPH;
    void* args[] = {&p};
    hipError_t e = hipLaunchCooperativeKernel((const void*)mega, dim3(grid_blocks), dim3(NTHR), args, LDS_BYTES, stream);
    if (e != hipSuccess) fprintf(stderr, "cooperative launch failed: %s (grid %d)\n", hipGetErrorString(e), grid_blocks);
#else
    for (int ph = 0; ph < NPH; ++ph) { p.ph_lo = ph; p.ph_hi = ph + 1; hipLaunchKernelGGL(mega, dim3(grid_blocks), dim3(NTHR), LDS_BYTES, stream, p); }
#endif
}
```

```cpp
#include <hip/hip_runtime.h>
#include <hip/hip_cooperative_groups.h>
#include <cstdio>
#include <cstdint>
namespace cg = cooperative_groups;

#ifndef ONE_LAUNCH
#define ONE_LAUNCH 1
#endif

__device__ __forceinline__ int obid() { int b = (int)blockIdx.x; asm volatile("" : "+s"(b)); return b; }
__device__ __forceinline__ int otid() { int t; asm volatile("v_mov_b32 %0, %1" : "=v"(t) : "v"(threadIdx.x)); return t; }
namespace pg8 {
#define PG8_LAS __attribute__((address_space(3)))
typedef unsigned short bf16_t;
typedef short bf16x8 __attribute__((ext_vector_type(8)));
typedef float f32x4 __attribute__((ext_vector_type(4)));
typedef unsigned u32x4 __attribute__((ext_vector_type(4)));
constexpr int BM = 256, BK = 64, HALF = 128, HTB = HALF * BK * 2, STAGE_BYTES = 8 * HTB, NXCD = 8, WGM = 8;

__host__ __device__ __forceinline__ int lds_byte(int r, int c) { const int st = (r >> 4) * 2 + (c >> 5), rr = r & 15, cc = c & 31, ob = rr * 64 + cc * 2; return st * 1024 + (ob ^ (((ob >> 9) & 1) << 5)); }
__host__ __device__ __forceinline__ void stage_rc(int b, int& R, int& C) { const int st = b / 1024, sb = b % 1024, swz = sb ^ (((sb >> 9) & 1) << 5); R = (st >> 1) * 16 + swz / 64; C = (st & 1) * 32 + (swz % 64) / 2; }
__host__ __device__ __forceinline__ int perm32(int rho) { const int n = rho >> 4, i = rho & 15; return 8 * (i >> 2) + 4 * n + (i & 3); }

struct Unit { int pm, pn, aux, pad; const char* A; const char* B; };
struct Gemm { int lda, ldb, K; };

struct StaticOrder {
    int nM, nN, nwg, G, c;
    __host__ __device__ void init(int M, int N, int G_, int c_) { nM = M / BM; nN = N / BM; nwg = nM * nN; G = G_; c = c_; }
    __device__ bool next(int i, Unit& u) const {
        const long L = (long)i * G + c; if (L >= nwg) return false;
        int wgid = __builtin_amdgcn_readfirstlane((int)L); { const int q = nwg / NXCD, r = nwg % NXCD, xcd = wgid % NXCD, off = wgid / NXCD; wgid = (xcd < r ? xcd * (q + 1) : r * (q + 1) + (xcd - r) * q) + off; }
        const int nig = WGM * nN, gid = wgid / nig, fm = gid * WGM, gsz = (nM - fm) < WGM ? (nM - fm) : WGM;
        u.pm = __builtin_amdgcn_readfirstlane(fm + ((wgid % nig) % gsz)); u.pn = __builtin_amdgcn_readfirstlane((wgid % nig) / gsz); return true;
    }
};

__device__ __forceinline__ unsigned cvt_pk_bf16(float lo, float hi) { unsigned r; asm volatile("v_cvt_pk_bf16_f32 %0, %1, %2" : "=v"(r) : "v"(lo), "v"(hi)); return r; }

template <class Epi, class Sched, bool ALIGN_EPI>
__device__ __forceinline__ void gemm_phase(PG8_LAS unsigned char* lds, const Gemm g, const Sched& S, const Epi& E) {
    const int tid = otid(), wid = __builtin_amdgcn_readfirstlane(tid >> 6), lane = tid & 63, wr = wid >> 2, wc = wid & 3, fr = lane & 15, fq = lane >> 4;
    const int K = g.K, nt = K / BK;
    unsigned voffA[2], voffB[2];
#pragma unroll
    for (int i = 0; i < 2; ++i) { int R, C; stage_rc(tid * 16 + i * 8192, R, C); const int Rb = Epi::PERM ? ((R & ~31) + perm32(R & 31)) : R;
        voffA[i] = (unsigned)(R * g.lda + C) * 2u; voffB[i] = (unsigned)(Rb * g.ldb + C) * 2u; }
    const size_t kstep = (size_t)(BK * 2);
    const size_t hA = (size_t)HALF * g.lda * 2, hB = (size_t)HALF * g.ldb * 2;
    const unsigned ldsw = (unsigned)wid * 1024u;
    const int aoff = lds_byte(wr * 64 + fr, fq * 8), boff = lds_byte(wc * 32 + fr, fq * 8);
#define PG8_SA(b, h) (((b) * 2 + (h)) * HTB)
#define PG8_SB(b, h) ((4 + (b) * 2 + (h)) * HTB)
#define PG8_STAGE(bufoff, gbase, voff) do { _Pragma("unroll") for (int _i = 0; _i < 2; ++_i) \
        __builtin_amdgcn_global_load_lds((const unsigned*)((const char*)(gbase) + (voff)[_i]), (PG8_LAS unsigned*)(lds + (bufoff) + ldsw + _i * 8192), 16, 0, 0); } while (0)
#define PG8_LDA(dst, b, h) do { _Pragma("unroll") for (int m = 0; m < 4; ++m) _Pragma("unroll") for (int k = 0; k < 2; ++k) dst[m][k] = *(const PG8_LAS bf16x8*)(lds + PG8_SA(b, h) + aoff + m * 2048 + k * 1024); } while (0)
#define PG8_LDB(dst, b, h) do { _Pragma("unroll") for (int n = 0; n < 2; ++n) _Pragma("unroll") for (int k = 0; k < 2; ++k) dst[n][k] = *(const PG8_LAS bf16x8*)(lds + PG8_SB(b, h) + boff + n * 2048 + k * 1024); } while (0)
#define PG8_MMA(ai, bj, At, Bt) do { __builtin_amdgcn_s_setprio(1); _Pragma("unroll") for (int m = 0; m < 4; ++m) _Pragma("unroll") for (int n = 0; n < 2; ++n) _Pragma("unroll") for (int k = 0; k < 2; ++k) \
        acc[ai][bj][m][n] = __builtin_amdgcn_mfma_f32_16x16x32_bf16(Bt[n][k], At[m][k], acc[ai][bj][m][n], 0, 0, 0); __builtin_amdgcn_s_setprio(0); } while (0)
#define PG8_WAIT_V(n) asm volatile("s_waitcnt vmcnt(" #n ")" ::: "memory")
#define PG8_WAIT_L(n) asm volatile("s_waitcnt lgkmcnt(" #n ")" ::: "memory")
#define PG8_BAR __builtin_amdgcn_s_barrier()
#define PG8_SCHED __builtin_amdgcn_sched_barrier(0)
    Unit cur, nxt; int ui = 0;
    if (!S.next(0, cur)) return;
    f32x4 acc[2][2][4][2];
#pragma unroll
    for (int a = 0; a < 2; ++a)
#pragma unroll
        for (int b = 0; b < 2; ++b)
#pragma unroll
            for (int m = 0; m < 4; ++m)
#pragma unroll
                for (int n = 0; n < 2; ++n) acc[a][b][m][n] = (f32x4){0.f, 0.f, 0.f, 0.f};
    bf16x8 At[4][2], B0[2][2], B1[2][2];
    const char* cA = cur.A; const char* cB = cur.B;
    PG8_STAGE(PG8_SB(0, 0), cB, voffB); PG8_STAGE(PG8_SB(0, 1), cB + hB, voffB); PG8_STAGE(PG8_SA(0, 0), cA, voffA); PG8_STAGE(PG8_SA(0, 1), cA + hA, voffA);
    if (wr == 1) PG8_BAR;
    PG8_WAIT_V(2); PG8_BAR;
    PG8_STAGE(PG8_SB(1, 0), cB + kstep, voffB); PG8_STAGE(PG8_SA(1, 0), cA + kstep, voffA); PG8_STAGE(PG8_SB(1, 1), cB + hB + kstep, voffB);
    PG8_WAIT_V(6); PG8_BAR;
    for (;;) {
        const bool has_next = S.next(ui + 1, nxt);
        const char* nA = has_next ? nxt.A : cA; const char* nB = has_next ? nxt.B : cB;
        for (int t = 0; t < nt; t += 2) {
            const bool last = (t == nt - 2);
            const char* a1 = cA + (size_t)(t + 1) * kstep;
            const char* a2 = last ? nA : cA + (size_t)(t + 2) * kstep; const char* b2 = last ? nB : cB + (size_t)(t + 2) * kstep;
            const char* a3 = a2 + kstep; const char* b3 = b2 + kstep;
            PG8_LDB(B0, 0, 0); PG8_LDB(B1, 0, 1); PG8_SCHED; PG8_LDA(At, 0, 0); PG8_STAGE(PG8_SA(1, 1), a1 + hA, voffA);
            PG8_WAIT_V(8); PG8_WAIT_L(0); PG8_BAR; PG8_MMA(0, 0, At, B0); PG8_MMA(0, 1, At, B1); PG8_BAR; PG8_SCHED;
            PG8_LDA(At, 0, 1); PG8_STAGE(PG8_SB(0, 0), b2, voffB); PG8_STAGE(PG8_SB(0, 1), b2 + hB, voffB); PG8_STAGE(PG8_SA(0, 0), a2, voffA);
            PG8_WAIT_V(8); PG8_WAIT_L(0); PG8_BAR; PG8_MMA(1, 0, At, B0); PG8_MMA(1, 1, At, B1); PG8_BAR; PG8_SCHED;
            PG8_LDB(B0, 1, 0); PG8_LDB(B1, 1, 1); PG8_SCHED; PG8_LDA(At, 1, 0); PG8_STAGE(PG8_SA(0, 1), a2 + hA, voffA);
            PG8_WAIT_V(8); PG8_WAIT_L(0); PG8_BAR; PG8_MMA(0, 0, At, B0); PG8_MMA(0, 1, At, B1); PG8_BAR; PG8_SCHED;
            PG8_LDA(At, 1, 1); PG8_STAGE(PG8_SB(1, 0), b3, voffB); PG8_STAGE(PG8_SB(1, 1), b3 + hB, voffB); PG8_STAGE(PG8_SA(1, 0), a3, voffA);
            PG8_WAIT_V(8); PG8_WAIT_L(0); PG8_BAR; PG8_MMA(1, 0, At, B0); PG8_MMA(1, 1, At, B1); PG8_BAR; PG8_SCHED;
        }
        if constexpr (ALIGN_EPI) { if (wr == 0) PG8_BAR; }
        E(acc, cur, wr, wc, fr, fq);
        if (!has_next) break;
#pragma unroll
        for (int a = 0; a < 2; ++a)
#pragma unroll
            for (int b = 0; b < 2; ++b)
#pragma unroll
                for (int m = 0; m < 4; ++m)
#pragma unroll
                    for (int n = 0; n < 2; ++n) acc[a][b][m][n] = (f32x4){0.f, 0.f, 0.f, 0.f};
        cur = nxt; cA = nA; cB = nB; ++ui;
        if constexpr (ALIGN_EPI) { if (wr == 1) PG8_BAR; }
    }
    PG8_WAIT_V(0);
    if constexpr (!ALIGN_EPI) { if (wr == 0) PG8_BAR; }
    PG8_BAR;
#undef PG8_SA
#undef PG8_SB
#undef PG8_STAGE
#undef PG8_LDA
#undef PG8_LDB
#undef PG8_MMA
#undef PG8_WAIT_V
#undef PG8_WAIT_L
#undef PG8_BAR
#undef PG8_SCHED
}
}

typedef unsigned short bf16;
typedef float f32x4 __attribute__((ext_vector_type(4)));
typedef unsigned u32x4 __attribute__((ext_vector_type(4)));
typedef unsigned u32x2 __attribute__((ext_vector_type(2)));
constexpr int NB = 2, SEQ = 4096, DM = 2048, MTOK = NB * SEQ, DIN = 6656, DG = 512, NL = 2;
constexpr int LDS_BYTES = 147456;
constexpr int NTHR = 512;

constexpr int WROWS = 7680;
constexpr size_t WS_WIN = 0;
constexpr size_t WS_WOUT = WS_WIN + (size_t)NL * WROWS * DM * 2;
constexpr size_t WS_WCS = WS_WOUT + (size_t)NL * DM * DM * 2;
constexpr size_t WS_WFXB = WS_WCS + (size_t)NL * 1024 * DG * 2;
constexpr size_t WS_WPW = WS_WFXB + (size_t)NL * DM * DG * 2;
constexpr size_t WS_DFT = WS_WPW + (size_t)NL * DG * DG * 2;
constexpr size_t WS_ROPE = WS_DFT + (size_t)SEQ * 2 * SEQ * 2;
constexpr size_t WS_MOD = WS_ROPE + (size_t)SEQ * 32 * 8;
constexpr size_t WS_U = WS_MOD + 131072;
constexpr size_t WS_PART = WS_U + (size_t)MTOK * DM * 2;
constexpr size_t WS_Z = WS_U + (size_t)4 * MTOK * DG * 4;
constexpr size_t WS_PQT = WS_Z + (size_t)MTOK * DIN * 2;
constexpr size_t WS_CVH = WS_PQT + (size_t)NB * DG * 2 * SEQ * 2;
constexpr size_t WS_CAT = WS_CVH + (size_t)MTOK * DG * 2;
constexpr size_t WS_KV = WS_CAT + (size_t)MTOK * DM * 2;
constexpr size_t WS_BAR = WS_KV + (size_t)2 * NB * 8 * 32 * 4096 * 4;
constexpr size_t WS_END = WS_BAR + 16384;

struct Params {
    const float* x; const float* c; const float* norm_g; const float* w_ada; const float* b_ada; const float* w_in; const float* w_fft; const float* na_bias;
    const float* rl_f; const float* rl_b; const float* conv_w; const float* conv_b; const float* ln_g; const float* ln_b; const float* w_pw; const float* w_out; const float* final_g;
    float* out; unsigned char* ws; int ph_lo, ph_hi;
};

#if defined(__HIP_DEVICE_COMPILE__)
typedef const __attribute__((address_space(4))) Params* KParams;
__device__ __forceinline__ KParams kparams() { KParams k = (KParams)__builtin_amdgcn_kernarg_segment_ptr(); asm volatile("" : "+s"(k)); return k; }
#else
typedef const Params* KParams;
__device__ __forceinline__ KParams kparams() { return nullptr; }
#endif
__device__ __forceinline__ unsigned f2bf(float f) { unsigned u = __float_as_uint(f); return (u + 0x7fffu + ((u >> 16) & 1u)) >> 16; }
__device__ __forceinline__ unsigned pk2(float lo, float hi) { return f2bf(lo) | (f2bf(hi) << 16); }
__device__ __forceinline__ float bf2f(bf16 b) { return __uint_as_float((unsigned)b << 16); }
__device__ __forceinline__ float bflo(unsigned u) { return __uint_as_float(u << 16); }
__device__ __forceinline__ float bfhi(unsigned u) { return __uint_as_float(u & 0xffff0000u); }
__device__ __forceinline__ float silu_f(float v) { return v / (1.f + __expf(-v)); }
__device__ __forceinline__ float wave_sum(float v) {
#pragma unroll
    for (int o = 1; o < 64; o <<= 1) v += __shfl_xor(v, o);
    return v;
}
__device__ __forceinline__ float wave_max(float v) {
#pragma unroll
    for (int o = 1; o < 64; o <<= 1) v = fmaxf(v, __shfl_xor(v, o));
    return v;
}

struct SchedS {
    pg8::StaticOrder o; const char* A; const char* B; size_t ta, tb;
    __device__ __forceinline__ bool next(int i, pg8::Unit& u) const { if (!o.next(i, u)) return false; u.A = A + (size_t)u.pm * ta; u.B = B + (size_t)u.pn * tb; u.aux = 0; return true; }
};
__device__ __forceinline__ SchedS make_sched(const void* A, int lda, const void* B, int ldb, int M, int N, int shift = 0) {
    SchedS s; s.o.init(M, N, (int)gridDim.x, (int)((obid() + gridDim.x - shift) % gridDim.x)); s.A = (const char*)A; s.B = (const char*)B; s.ta = (size_t)256 * lda * 2; s.tb = (size_t)256 * ldb * 2; return s;
}
struct SchedZ {
    pg8::StaticOrder o; const char* A; const char* B; int late;
    __device__ __forceinline__ bool next(int i, pg8::Unit& u) const { if (!o.next(i, u)) return false; const int jn = u.pn;
        u.pn = late ? (jn < 2 ? 2 + jn : 22 + jn) : (jn < 20 ? jn + 4 : jn + 6);
        u.A = A + (size_t)u.pm * (256 * DM * 2); u.B = B + (size_t)u.pn * (256 * DM * 2); u.aux = 0; return true; }
};
struct SchedDFT {
    const char* A; const char* B; int G, c;
    __device__ __forceinline__ bool next(int i, pg8::Unit& u) const {
        if (c < 0) return false;
        const int L = __builtin_amdgcn_readfirstlane(i * G + c); if (L >= 128) return false;
        const int sub = L >> 5, t = L & 31; u.pm = t >> 1; u.pn = t & 1; u.aux = sub;
        u.A = A + (size_t)((u.pm << 22) + ((sub & 1) << 13)); u.B = B + (size_t)(((sub >> 1) << 23) + (u.pn << 22) + ((sub & 1) << 13)); return true;
    }
};

struct EpiZ {
    static constexpr bool PERM = true;
    bf16* O; int ldc;
    __device__ __forceinline__ void operator()(const pg8::f32x4 (&acc)[2][2][4][2], const pg8::Unit& u, int wr, int wc, int fr, int fq) const {
        const int row0 = u.pm * 256 + wr * 64 + fr, col0 = u.pn * 256 + wc * 32 + 8 * fq;
#pragma unroll
        for (int ai = 0; ai < 2; ++ai)
#pragma unroll
            for (int m = 0; m < 4; ++m) { bf16* rowp = O + (size_t)(row0 + ai * 128 + m * 16) * ldc + col0;
#pragma unroll
                for (int bj = 0; bj < 2; ++bj) { const pg8::f32x4 v0 = acc[ai][bj][m][0], v1 = acc[ai][bj][m][1]; u32x4 w;
                    w.x = pg8::cvt_pk_bf16(v0[0], v0[1]); w.y = pg8::cvt_pk_bf16(v0[2], v0[3]); w.z = pg8::cvt_pk_bf16(v1[0], v1[1]); w.w = pg8::cvt_pk_bf16(v1[2], v1[3]);
                    *(u32x4*)(rowp + bj * 128) = w; } }
    }
};
struct EpiZ2 {
    static constexpr bool PERM = true;
    bf16* O; bf16* PQ;
    __device__ __forceinline__ void operator()(const pg8::f32x4 (&acc)[2][2][4][2], const pg8::Unit& u, int wr, int wc, int fr, int fq) const {
        const int row0 = u.pm * 256 + wr * 64 + fr;
        if (u.pn < 26) { const int col0 = u.pn * 256 + wc * 32 + 8 * fq;
#pragma unroll
            for (int ai = 0; ai < 2; ++ai)
#pragma unroll
                for (int m = 0; m < 4; ++m) { bf16* rowp = O + (size_t)(row0 + ai * 128 + m * 16) * DIN + col0;
#pragma unroll
                    for (int bj = 0; bj < 2; ++bj) { const pg8::f32x4 v0 = acc[ai][bj][m][0], v1 = acc[ai][bj][m][1]; u32x4 w;
                        w.x = pg8::cvt_pk_bf16(v0[0], v0[1]); w.y = pg8::cvt_pk_bf16(v0[2], v0[3]); w.z = pg8::cvt_pk_bf16(v1[0], v1[1]); w.w = pg8::cvt_pk_bf16(v1[2], v1[3]);
                        *(u32x4*)(rowp + bj * 128) = w; } }
        } else { const int np0 = (u.pn - 26) * 256 + wc * 32 + 8 * fq;
#pragma unroll
            for (int bj = 0; bj < 2; ++bj) { const int np = np0 + bj * 128, pq = np >> 9, n = np & 511;
#pragma unroll
                for (int ai = 0; ai < 2; ++ai)
#pragma unroll
                    for (int m = 0; m < 4; ++m) { const int row = row0 + ai * 128 + m * 16, b = row >> 12, sq = row & 4095;
                        bf16* dst = PQ + ((size_t)(b * 512 + n) * 2 + pq) * 4096 + sq;
#pragma unroll
                        for (int nn = 0; nn < 2; ++nn)
#pragma unroll
                            for (int j = 0; j < 4; ++j) dst[(size_t)(4 * nn + j) * 8192] = (bf16)f2bf(acc[ai][bj][m][nn][j]); } }
        }
    }
};
struct EpiGate {
    static constexpr bool PERM = true;
    bf16* O; const bf16* Z; int coff, goff;
    __device__ __forceinline__ void operator()(const pg8::f32x4 (&acc)[2][2][4][2], const pg8::Unit& u, int wr, int wc, int fr, int fq) const {
        const int row0 = u.pm * 256 + wr * 64 + fr, col0 = u.pn * 256 + wc * 32 + 8 * fq;
#pragma unroll
        for (int ai = 0; ai < 2; ++ai)
#pragma unroll
            for (int m = 0; m < 4; ++m) { const size_t row = (size_t)(row0 + ai * 128 + m * 16);
#pragma unroll
                for (int bj = 0; bj < 2; ++bj) { const pg8::f32x4 v0 = acc[ai][bj][m][0], v1 = acc[ai][bj][m][1];
                    const u32x4 gz = *(const u32x4*)(Z + row * DIN + goff + col0 + bj * 128); u32x4 w;
                    w.x = pg8::cvt_pk_bf16(v0[0] * silu_f(bflo(gz.x)), v0[1] * silu_f(bfhi(gz.x))); w.y = pg8::cvt_pk_bf16(v0[2] * silu_f(bflo(gz.y)), v0[3] * silu_f(bfhi(gz.y)));
                    w.z = pg8::cvt_pk_bf16(v1[0] * silu_f(bflo(gz.z)), v1[1] * silu_f(bfhi(gz.z))); w.w = pg8::cvt_pk_bf16(v1[2] * silu_f(bflo(gz.w)), v1[3] * silu_f(bfhi(gz.w)));
                    *(u32x4*)(O + row * DM + coff + col0 + bj * 128) = w; } }
    }
};
struct EpiPart {
    static constexpr bool PERM = false;
    float* P;
    __device__ __forceinline__ void operator()(const pg8::f32x4 (&acc)[2][2][4][2], const pg8::Unit& u, int wr, int wc, int fr, int fq) const {
        const int row0 = u.pm * 256 + wr * 64 + fr, col0 = u.pn * 256 + wc * 32 + 4 * fq;
        float* base = P + (size_t)u.aux * 4096 * 512;
#pragma unroll
        for (int ai = 0; ai < 2; ++ai)
#pragma unroll
            for (int m = 0; m < 4; ++m) { float* rowp = base + (size_t)(row0 + ai * 128 + m * 16) * 512 + col0;
#pragma unroll
                for (int bj = 0; bj < 2; ++bj)
#pragma unroll
                    for (int n = 0; n < 2; ++n) *(pg8::f32x4*)(rowp + bj * 128 + n * 16) = acc[ai][bj][m][n]; }
    }
};
struct EpiRes {
    static constexpr bool PERM = false;
    const float* xin; float* xout; const float* gate;
    __device__ __forceinline__ void operator()(const pg8::f32x4 (&acc)[2][2][4][2], const pg8::Unit& u, int wr, int wc, int fr, int fq) const {
        const int row0 = u.pm * 256 + wr * 64 + fr, col0 = u.pn * 256 + wc * 32 + 4 * fq;
        const float* gp = gate + (size_t)(u.pm >> 4) * 6144 + col0;
        pg8::f32x4 gv[2][2];
#pragma unroll
        for (int bj = 0; bj < 2; ++bj)
#pragma unroll
            for (int n = 0; n < 2; ++n) gv[bj][n] = *(const pg8::f32x4*)(gp + bj * 128 + n * 16);
#pragma unroll
        for (int ai = 0; ai < 2; ++ai)
#pragma unroll
            for (int m = 0; m < 4; ++m) { const size_t ro = (size_t)(row0 + ai * 128 + m * 16) * DM + col0;
#pragma unroll
                for (int bj = 0; bj < 2; ++bj)
#pragma unroll
                    for (int n = 0; n < 2; ++n) { const pg8::f32x4 xi = *(const pg8::f32x4*)(xin + ro + bj * 128 + n * 16);
                        *(pg8::f32x4*)(xout + ro + bj * 128 + n * 16) = xi + gv[bj][n] * acc[ai][bj][m][n]; } }
    }
};

struct TPItem { const float* src; bf16* dst; int N, K; };
__device__ __forceinline__ TPItem tp_decode(const Params& p, int it, int tid) {
    constexpr int T_IN = 32 * 96, T_OUT = 32 * 32, T_S = 64, T_L = T_IN + T_OUT + T_S;
    const int l = it / T_L; int r = it % T_L; const float* W; bf16* WT; int K, N, kb, nb;
    if (r < T_IN) { W = p.w_in + (size_t)l * DM * DIN; WT = (bf16*)(p.ws + WS_WIN) + (size_t)l * WROWS * DM; K = DM; N = DIN; kb = r / 96; nb = 8 + r % 96; }
    else if (r < T_IN + T_OUT) { r -= T_IN; W = p.w_out + (size_t)l * DM * DM; WT = (bf16*)(p.ws + WS_WOUT) + (size_t)l * DM * DM; K = DM; N = DM; kb = r >> 5; nb = r & 31; }
    else { r -= T_IN + T_OUT; W = p.w_pw + (size_t)l * DG * DG; WT = (bf16*)(p.ws + WS_WPW) + (size_t)l * DG * DG; K = DG; N = DG; kb = r >> 3; nb = r & 7; }
    TPItem t; t.N = N; t.K = K;
    t.src = W + (size_t)(kb * 64 + (tid >> 4)) * N + nb * 64 + (tid & 15) * 4;
    t.dst = WT + (size_t)(nb * 64 + (tid >> 3)) * K + kb * 64 + (tid & 7) * 8;
    return t;
}
__device__ __forceinline__ void tp_store(const TPItem& t, int tid, const f32x4& v0, const f32x4& v1, float* scr) {
    { const int kk = tid >> 4, nn = (tid & 15) * 4;
      scr[kk * 65 + nn] = v0[0]; scr[kk * 65 + nn + 1] = v0[1]; scr[kk * 65 + nn + 2] = v0[2]; scr[kk * 65 + nn + 3] = v0[3];
      scr[(kk + 32) * 65 + nn] = v1[0]; scr[(kk + 32) * 65 + nn + 1] = v1[1]; scr[(kk + 32) * 65 + nn + 2] = v1[2]; scr[(kk + 32) * 65 + nn + 3] = v1[3]; }
    __syncthreads();
    { const int n = tid >> 3, kc = (tid & 7) * 8; const float* s = scr + kc * 65 + n; u32x4 o;
      o.x = pk2(s[0], s[65]); o.y = pk2(s[2 * 65], s[3 * 65]); o.z = pk2(s[4 * 65], s[5 * 65]); o.w = pk2(s[6 * 65], s[7 * 65]);
      *(u32x4*)t.dst = o; }
    __syncthreads();
}

__device__ __forceinline__ void ph_prologue(const Params& p_, unsigned char* lds) {
    const Params p = *kparams(); (void)p_;
    const int tid = otid(), lane = tid & 63, wave = tid >> 6, G = gridDim.x, bid = obid();
    float* scr = (float*)lds;
    { constexpr int T_TOT = NL * (32 * 96 + 32 * 32 + 64);
      int it = bid; TPItem cur; f32x4 a0, a1;
      if (it < T_TOT) { cur = tp_decode(p, it, tid); a0 = *(const f32x4*)cur.src; a1 = *(const f32x4*)(cur.src + (size_t)32 * cur.N); }
      while (it < T_TOT) { const int nit = it + G; TPItem nxt = cur; f32x4 b0 = a0, b1 = a1;
          if (nit < T_TOT) { nxt = tp_decode(p, nit, tid); b0 = *(const f32x4*)nxt.src; b1 = *(const f32x4*)(nxt.src + (size_t)32 * nxt.N); }
          tp_store(cur, tid, a0, a1, scr);
          cur = nxt; a0 = b0; a1 = b1; it = nit; } }
    { bf16* Wfx = (bf16*)(p.ws + WS_WFXB);
      for (int e = bid * NTHR + tid; e < NL * DM * DG / 8; e += G * NTHR) { const int l = e >> 17, r = e & 131071, k = r >> 6, c8 = (r & 63) * 8;
          const float* src = p.w_in + ((size_t)l * DM + k) * DIN + c8; const f32x4 a = *(const f32x4*)src, b4 = *(const f32x4*)(src + 4);
          u32x4 o; o.x = pk2(a[0], a[1]); o.y = pk2(a[2], a[3]); o.z = pk2(b4[0], b4[1]); o.w = pk2(b4[2], b4[3]);
          *(u32x4*)(Wfx + ((size_t)l * DM + k) * DG + c8) = o; } }
    { float* Wl = (float*)lds; float* tr = Wl + 128 * 65; bf16* Wcs = (bf16*)(p.ws + WS_WCS);
      for (int t2 = G - 1 - bid; t2 < 256; t2 += G) {
          const int t = t2 >> 1, ch = t2 & 1, l = t >> 6, pq = (t >> 5) & 1, g = (t >> 3) & 3, n0 = (t & 7) * 64;
#pragma unroll
          for (int i = 0; i < 4; ++i) { const int m = (tid >> 4) + 32 * i, nn = (tid & 15) * 4;
              const f32x4 v = *(const f32x4*)(p.w_fft + ((size_t)l * DG + g * 128 + m) * DG + n0 + nn);
              Wl[m * 65 + nn] = v[0]; Wl[m * 65 + nn + 1] = v[1]; Wl[m * 65 + nn + 2] = v[2]; Wl[m * 65 + nn + 3] = v[3]; }
          if (tid < 128) tr[tid] = pq ? sinpif((float)tid * (1.f / 64.f)) : cospif((float)tid * (1.f / 64.f));
          __syncthreads();
          const int nn = tid >> 3, cc = ch * 64 + (tid & 7) * 8; float acc[8];
#pragma unroll
          for (int i = 0; i < 8; ++i) acc[i] = 0.f;
#pragma unroll 4
          for (int m = 0; m < 128; ++m) { const float w = Wl[m * 65 + nn];
#pragma unroll
              for (int i = 0; i < 8; ++i) acc[i] += tr[((cc + i) * m) & 127] * w; }
          const float nrm = 0.0013810679320049757f;
          u32x4 o0;
          o0.x = pk2(acc[0] * nrm, acc[1] * nrm); o0.y = pk2(acc[2] * nrm, acc[3] * nrm); o0.z = pk2(acc[4] * nrm, acc[5] * nrm); o0.w = pk2(acc[6] * nrm, acc[7] * nrm);
          *(u32x4*)(Wcs + ((size_t)l * 1024 + pq * 512 + n0 + nn) * DG + g * 128 + cc) = o0;
          __syncthreads();
      } }
    __syncthreads();
    float* cosT = (float*)(lds + 32768); float* sinT = (float*)(lds + 49152); float* ca = (float*)(lds + 65536); float* red = (float*)(lds + 81920);
    for (int j = tid; j < 4096; j += NTHR) { cosT[j] = cospif((float)j * (1.f / 2048.f)); sinT[j] = sinpif((float)j * (1.f / 2048.f)); }
    for (int j = tid; j < 4096; j += NTHR) { const float cv = p.c[j]; ca[j] = cv / (1.f + expf(-cv)); }
    __syncthreads();
    bf16* DFT = (bf16*)(p.ws + WS_DFT);
    for (int k = bid; k < 4096; k += G) {
#pragma unroll
        for (int cc = 0; cc < 2; ++cc) { const int kk0 = (tid + cc * NTHR) * 8; float v[8];
#pragma unroll
            for (int j = 0; j < 8; ++j) { const int kk = kk0 + j, idx = (k * (kk & 4095)) & 4095; v[j] = (kk < 4096) ? cosT[idx] : -sinT[idx]; }
            u32x4 o; o.x = pk2(v[0], v[1]); o.y = pk2(v[2], v[3]); o.z = pk2(v[4], v[5]); o.w = pk2(v[6], v[7]);
            *(u32x4*)(DFT + (size_t)k * 8192 + kk0) = o; }
    }
    { float2* rope = (float2*)(p.ws + WS_ROPE);
      for (int e = bid * NTHR + tid; e < 4096 * 32; e += G * NTHR) { const int s = e >> 5, i = e & 31;
          const float inv = (float)pow(10000.0, -(double)i / 32.0); const float ang = (float)s * inv;
          double sn, cs; sincos((double)ang, &sn, &cs); rope[e] = make_float2((float)cs, (float)sn); } }
    float* mod = (float*)(p.ws + WS_MOD);
    for (int t = bid; t < 192; t += G) {
        const int l = t / 96, col = (t % 96) * 64 + lane; const float* W = p.w_ada + (size_t)l * DM * 6144 + col;
        float a0 = 0.f, a1 = 0.f;
        for (int k0 = wave * 256; k0 < wave * 256 + 256; k0 += 32) { float wv[32];
#pragma unroll
            for (int j = 0; j < 32; ++j) wv[j] = W[(size_t)(k0 + j) * 6144];
            asm volatile("" ::: "memory");
#pragma unroll
            for (int j = 0; j < 32; ++j) { a0 += ca[k0 + j] * wv[j]; a1 += ca[2048 + k0 + j] * wv[j]; } }
        red[(wave * 2 + 0) * 64 + lane] = a0; red[(wave * 2 + 1) * 64 + lane] = a1;
        __syncthreads();
        if (wave < 2) { float s = 0.f;
#pragma unroll
            for (int w = 0; w < 8; ++w) s += red[(w * 2 + wave) * 64 + lane];
            mod[(size_t)(l * 2 + wave) * 6144 + col] = s + p.b_ada[l * 6144 + col]; }
        __syncthreads();
    }
}

__device__ __forceinline__ void ph_norm(const Params& p_, int l) {
    const Params p = *kparams(); (void)p_;
    const int tid = otid(), lane = tid & 63, wave = tid >> 6;
    const float* xin = (l == 0) ? p.x : p.out; bf16* h = (bf16*)(p.ws + WS_U); const float* mod = (const float*)(p.ws + WS_MOD);
    for (int row = obid() * 8 + wave; row < MTOK; row += gridDim.x * 8) {
        const f32x4* xr = (const f32x4*)(xin + (size_t)row * DM) + lane; f32x4 v[8]; float ss = 0.f;
#pragma unroll
        for (int j = 0; j < 8; ++j) { v[j] = xr[64 * j]; ss += (v[j][0] * v[j][0] + v[j][1] * v[j][1]) + (v[j][2] * v[j][2] + v[j][3] * v[j][3]); }
        ss = wave_sum(ss); const float rstd = rsqrtf(ss * (1.f / DM) + 1e-6f);
        const float* md = mod + (size_t)(l * 2 + (row >> 12)) * 6144; const float* g = p.norm_g + l * DM;
#pragma unroll
        for (int j = 0; j < 8; ++j) { const int col = (64 * j + lane) * 4;
            const f32x4 g4 = *(const f32x4*)(g + col), sh = *(const f32x4*)(md + col), sc = *(const f32x4*)(md + 2048 + col);
            const f32x4 o = (v[j] * rstd * g4) * (sc + 1.f) + sh; u32x2 w; w.x = pk2(o[0], o[1]); w.y = pk2(o[2], o[3]);
            *(u32x2*)(h + (size_t)row * DM + col) = w; }
    }
}
__device__ __forceinline__ void ph_final(const Params& p_) {
    const Params p = *kparams(); (void)p_;
    const int tid = otid(), lane = tid & 63, wave = tid >> 6;
    for (int row = obid() * 8 + wave; row < MTOK; row += gridDim.x * 8) {
        f32x4* xr = (f32x4*)(p.out + (size_t)row * DM) + lane; f32x4 v[8]; float ss = 0.f;
#pragma unroll
        for (int j = 0; j < 8; ++j) { v[j] = xr[64 * j]; ss += (v[j][0] * v[j][0] + v[j][1] * v[j][1]) + (v[j][2] * v[j][2] + v[j][3] * v[j][3]); }
        ss = wave_sum(ss); const float rstd = rsqrtf(ss * (1.f / DM) + 1e-6f);
#pragma unroll
        for (int j = 0; j < 8; ++j) { const int col = (64 * j + lane) * 4; const f32x4 g4 = *(const f32x4*)(p.final_g + col); xr[64 * j] = v[j] * rstd * g4; }
    }
}

#ifndef REP_PRO
#define REP_PRO 1
#endif
#ifndef REP_NORM
#define REP_NORM 1
#endif
#ifndef REP_Z
#define REP_Z 1
#endif
#ifndef REP_MIX
#define REP_MIX 1
#endif
#ifndef REP_P3
#define REP_P3 1
#endif
#ifndef REP_R2
#define REP_R2 1
#endif
#ifndef REP_CMB
#define REP_CMB 1
#endif
#ifndef REP_FFT
#define REP_FFT 1
#endif
#ifndef REP_OUT
#define REP_OUT 1
#endif
#ifndef REP_SUB
#define REP_SUB 1
#endif

#ifndef REP_R1
#define REP_R1 1
#endif
#ifndef REP_NA
#define REP_NA 1
#endif
#ifndef REP_CV
#define REP_CV 1
#endif
#ifndef REP_F1
#define REP_F1 1
#endif
#define REPEAT(n) for (int rep_ = 0; rep_ < (n); ++rep_)
typedef short bf16x8v __attribute__((ext_vector_type(8)));
__device__ __forceinline__ bf16x8v mk8(unsigned a, unsigned b, unsigned c, unsigned d) { u32x4 v = {a, b, c, d}; return __builtin_bit_cast(bf16x8v, v); }
#define MFMA16(a, b, c) __builtin_amdgcn_mfma_f32_16x16x32_bf16(a, b, c, 0, 0, 0)
constexpr int R_QS = 0, R_KS = 18432, R_VT = 36864, R_KTF = 54272, R_KTB = 71680, R_STF = 89088, R_STB = 98304;

template <bool R2>
__device__ __forceinline__ void ret_stage(const Params& p_, int b, int h, int n, unsigned char* lds, float l2f, float l2b) {
    const Params p = *kparams(); (void)p_;
    const int tid = otid(), j = tid >> 2, c4 = tid & 3, s = n * 128 + j;
    const bf16* Z = (const bf16*)(p.ws + WS_Z); const bf16* zr = Z + (size_t)(b * SEQ + s) * DIN;
    const f32x4* rp = (const f32x4*)((const float2*)(p.ws + WS_ROPE) + s * 32 + c4 * 8);
    f32x4 rr[4];
#pragma unroll
    for (int i = 0; i < 4; ++i) rr[i] = rp[i];
    const u32x4 ka = *(const u32x4*)(zr + 7 * DG + h * 64 + c4 * 8), kb = *(const u32x4*)(zr + 7 * DG + h * 64 + 32 + c4 * 8);
    const u32x4 va = *(const u32x4*)(zr + 8 * DG + h * 64 + c4 * 16), vb = *(const u32x4*)(zr + 8 * DG + h * 64 + c4 * 16 + 8);
    u32x4 qa = ka, qb = kb;
    if (R2) { qa = *(const u32x4*)(zr + 6 * DG + h * 64 + c4 * 8); qb = *(const u32x4*)(zr + 6 * DG + h * 64 + 32 + c4 * 8); }
    asm volatile("" ::: "memory");
    float cs[8], sn[8];
#pragma unroll
    for (int i = 0; i < 4; ++i) { const f32x4 r = rr[i]; cs[2 * i] = r[0]; sn[2 * i] = r[1]; cs[2 * i + 1] = r[2]; sn[2 * i + 1] = r[3]; }
    bf16* KS = (bf16*)(lds + R_KS); bf16* VT = (bf16*)(lds + R_VT);
    {
      const unsigned kau[4] = {ka.x, ka.y, ka.z, ka.w}, kbu[4] = {kb.x, kb.y, kb.z, kb.w};
      float k1[8], k2[8];
#pragma unroll
      for (int i = 0; i < 4; ++i) { const float a0 = bflo(kau[i]), a1 = bfhi(kau[i]), b0 = bflo(kbu[i]), b1 = bfhi(kbu[i]);
          k1[2 * i] = a0 * cs[2 * i] - b0 * sn[2 * i]; k2[2 * i] = a0 * sn[2 * i] + b0 * cs[2 * i];
          k1[2 * i + 1] = a1 * cs[2 * i + 1] - b1 * sn[2 * i + 1]; k2[2 * i + 1] = a1 * sn[2 * i + 1] + b1 * cs[2 * i + 1]; }
      u32x4 o1, o2; o1.x = pk2(k1[0], k1[1]); o1.y = pk2(k1[2], k1[3]); o1.z = pk2(k1[4], k1[5]); o1.w = pk2(k1[6], k1[7]);
      o2.x = pk2(k2[0], k2[1]); o2.y = pk2(k2[2], k2[3]); o2.z = pk2(k2[4], k2[5]); o2.w = pk2(k2[6], k2[7]);
      *(u32x4*)(KS + j * 72 + c4 * 8) = o1; *(u32x4*)(KS + j * 72 + 32 + c4 * 8) = o2;
      if (!R2) { bf16* KTF = (bf16*)(lds + R_KTF); bf16* KTB = (bf16*)(lds + R_KTB);
          const float df = exp2f(l2f * (float)(127 - j)), db = exp2f(l2b * (float)j);
#pragma unroll
          for (int i = 0; i < 8; ++i) { KTF[(c4 * 8 + i) * 136 + j] = (bf16)f2bf(k1[i] * df); KTF[(32 + c4 * 8 + i) * 136 + j] = (bf16)f2bf(k2[i] * df);
              KTB[(c4 * 8 + i) * 136 + j] = (bf16)f2bf(k1[i] * db); KTB[(32 + c4 * 8 + i) * 136 + j] = (bf16)f2bf(k2[i] * db); } } }
    {
      const unsigned vu[8] = {va.x, va.y, va.z, va.w, vb.x, vb.y, vb.z, vb.w};
#pragma unroll
      for (int i = 0; i < 8; ++i) { VT[(c4 * 16 + 2 * i) * 136 + j] = (bf16)(vu[i] & 0xffffu); VT[(c4 * 16 + 2 * i + 1) * 136 + j] = (bf16)(vu[i] >> 16); } }
    if (R2) { bf16* QS = (bf16*)(lds + R_QS);
      const unsigned qau[4] = {qa.x, qa.y, qa.z, qa.w}, qbu[4] = {qb.x, qb.y, qb.z, qb.w};
      float q1[8], q2[8];
#pragma unroll
      for (int i = 0; i < 4; ++i) { const float a0 = bflo(qau[i]), a1 = bfhi(qau[i]), b0 = bflo(qbu[i]), b1 = bfhi(qbu[i]);
          q1[2 * i] = (a0 * cs[2 * i] - b0 * sn[2 * i]) * 0.125f; q2[2 * i] = (a0 * sn[2 * i] + b0 * cs[2 * i]) * 0.125f;
          q1[2 * i + 1] = (a1 * cs[2 * i + 1] - b1 * sn[2 * i + 1]) * 0.125f; q2[2 * i + 1] = (a1 * sn[2 * i + 1] + b1 * cs[2 * i + 1]) * 0.125f; }
      u32x4 o1, o2; o1.x = pk2(q1[0], q1[1]); o1.y = pk2(q1[2], q1[3]); o1.z = pk2(q1[4], q1[5]); o1.w = pk2(q1[6], q1[7]);
      o2.x = pk2(q2[0], q2[1]); o2.y = pk2(q2[2], q2[3]); o2.z = pk2(q2[4], q2[5]); o2.w = pk2(q2[6], q2[7]);
      *(u32x4*)(QS + j * 72 + c4 * 8) = o1; *(u32x4*)(QS + j * 72 + 32 + c4 * 8) = o2; }
}

__device__ __forceinline__ void ret1_task(const Params& p_, int l, int task, unsigned char* lds) {
    const Params p = *kparams(); (void)p_;
    const int n = task & 31, h = (task >> 5) & 7, b = task >> 8;
    const float xf = p.rl_f[l * 8 + h], xb = p.rl_b[l * 8 + h];
    const float l2f = -log1pf(expf(-xf)) * 1.4426950408889634f, l2b = -log1pf(expf(-xb)) * 1.4426950408889634f;
    ret_stage<false>(p, b, h, n, lds, l2f, l2b);
    __syncthreads();
    const int tid = otid(), lane = tid & 63, w = tid >> 6, fr = lane & 15, fq = lane >> 4, dir = w >> 2, et = w & 3;
    const bf16* VT = (const bf16*)(lds + R_VT); const bf16* KT = (const bf16*)(lds + (dir ? R_KTB : R_KTF));
    bf16x8v a[4];
#pragma unroll
    for (int ks = 0; ks < 4; ++ks) a[ks] = *(const bf16x8v*)(VT + (16 * et + fr) * 136 + 32 * ks + 8 * fq);
    float* dst = (float*)(p.ws + WS_KV) + ((size_t)((dir * 2 + b) * 8 + h) * 32 + n) * 4096;
#pragma unroll
    for (int dt = 0; dt < 4; ++dt) { f32x4 acc = {0.f, 0.f, 0.f, 0.f};
#pragma unroll
        for (int ks = 0; ks < 4; ++ks) { const bf16x8v bfr = *(const bf16x8v*)(KT + (16 * dt + fr) * 136 + 32 * ks + 8 * fq); acc = MFMA16(a[ks], bfr, acc); }
#pragma unroll
        for (int r = 0; r < 4; ++r) dst[(16 * et + 4 * fq + r) * 64 + 16 * dt + fr] = acc[r]; }
    __syncthreads();
}

__device__ __forceinline__ void ret2_task(const Params& p_, int l, int task, unsigned char* lds) {
    const Params p = *kparams(); (void)p_;
    const int n = task & 31, h = (task >> 5) & 7, b = task >> 8;
    const float xf = p.rl_f[l * 8 + h], xb = p.rl_b[l * 8 + h];
    const float l2f = -log1pf(expf(-xf)) * 1.4426950408889634f, l2b = -log1pf(expf(-xb)) * 1.4426950408889634f;
    ret_stage<true>(p, b, h, n, lds, l2f, l2b);
    const int tid = otid(), lane = tid & 63, w = tid >> 6, fr = lane & 15, fq = lane >> 4;
    {
      const float gfC = exp2f(l2f * 128.f), gbC = exp2f(l2b * 128.f);
      const float* KVf = (const float*)(p.ws + WS_KV) + ((size_t)((0 * 2 + b) * 8 + h) * 32) * 4096 + tid * 8;
      const float* KVb = (const float*)(p.ws + WS_KV) + ((size_t)((1 * 2 + b) * 8 + h) * 32) * 4096 + tid * 8;
      f32x4 f0 = {0.f, 0.f, 0.f, 0.f}, f1 = f0, g0 = f0, g1 = f0;
      { float c0 = 1.f; int m = n - 1;
        for (; m >= 7; m -= 8) { f32x4 xa[8], xb[8];
#pragma unroll
            for (int j = 0; j < 8; ++j) { xa[j] = *(const f32x4*)(KVf + (size_t)(m - j) * 4096); xb[j] = *(const f32x4*)(KVf + (size_t)(m - j) * 4096 + 4); }
            asm volatile("" ::: "memory");
#pragma unroll
            for (int j = 0; j < 8; ++j) { f0 += xa[j] * c0; f1 += xb[j] * c0; c0 *= gfC; } }
        for (; m >= 0; --m) { const f32x4 x0 = *(const f32x4*)(KVf + (size_t)m * 4096), x1 = *(const f32x4*)(KVf + (size_t)m * 4096 + 4); f0 += x0 * c0; f1 += x1 * c0; c0 *= gfC; } }
      { float c0 = 1.f; int m = n + 1;
        for (; m + 7 < 32; m += 8) { f32x4 xa[8], xb[8];
#pragma unroll
            for (int j = 0; j < 8; ++j) { xa[j] = *(const f32x4*)(KVb + (size_t)(m + j) * 4096); xb[j] = *(const f32x4*)(KVb + (size_t)(m + j) * 4096 + 4); }
            asm volatile("" ::: "memory");
#pragma unroll
            for (int j = 0; j < 8; ++j) { g0 += xa[j] * c0; g1 += xb[j] * c0; c0 *= gbC; } }
        for (; m < 32; ++m) { const f32x4 x0 = *(const f32x4*)(KVb + (size_t)m * 4096), x1 = *(const f32x4*)(KVb + (size_t)m * 4096 + 4); g0 += x0 * c0; g1 += x1 * c0; c0 *= gbC; } }
      const int e = tid >> 3, d0 = (tid & 7) * 8; u32x4 o;
      o.x = pk2(f0[0], f0[1]); o.y = pk2(f0[2], f0[3]); o.z = pk2(f1[0], f1[1]); o.w = pk2(f1[2], f1[3]); *(u32x4*)((bf16*)(lds + R_STF) + e * 72 + d0) = o;
      o.x = pk2(g0[0], g0[1]); o.y = pk2(g0[2], g0[3]); o.z = pk2(g1[0], g1[1]); o.w = pk2(g1[2], g1[3]); *(u32x4*)((bf16*)(lds + R_STB) + e * 72 + d0) = o; }
    __syncthreads();
    const bf16* QS = (const bf16*)(lds + R_QS); const bf16* KS = (const bf16*)(lds + R_KS); const bf16* VT = (const bf16*)(lds + R_VT);
    const bf16* STF = (const bf16*)(lds + R_STF); const bf16* STB = (const bf16*)(lds + R_STB);
    bf16x8v qf[2];
#pragma unroll
    for (int ks = 0; ks < 2; ++ks) qf[ks] = *(const bf16x8v*)(QS + (16 * w + fr) * 72 + 32 * ks + 8 * fq);
    const int ai = 16 * w + fr;
    unsigned pp[8][2];
#pragma unroll
    for (int jt = 0; jt < 8; ++jt) { f32x4 acc = {0.f, 0.f, 0.f, 0.f};
#pragma unroll
        for (int ks = 0; ks < 2; ++ks) { const bf16x8v kf = *(const bf16x8v*)(KS + (16 * jt + fr) * 72 + 32 * ks + 8 * fq); acc = MFMA16(kf, qf[ks], acc); }
        float sc[4];
#pragma unroll
        for (int r = 0; r < 4; ++r) { const int aj = 16 * jt + 4 * fq + r; const float wg = (aj <= ai) ? exp2f(l2f * (float)(ai - aj)) : exp2f(l2b * (float)(aj - ai)); sc[r] = acc[r] * wg; }
        pp[jt][0] = pk2(sc[0], sc[1]); pp[jt][1] = pk2(sc[2], sc[3]); }
    const float qdf = exp2f(l2f * (float)(ai + 1)), qdb = exp2f(l2b * (float)(128 - ai));
    f32x4 tot[4]; float ss = 0.f;
#pragma unroll
    for (int et = 0; et < 4; ++et) { f32x4 o = {0.f, 0.f, 0.f, 0.f}, cfa = o, cba = o;
#pragma unroll
        for (int t = 0; t < 4; ++t) { const u32x2 vlo = *(const u32x2*)(VT + (16 * et + fr) * 136 + 32 * t + 4 * fq), vhi = *(const u32x2*)(VT + (16 * et + fr) * 136 + 32 * t + 16 + 4 * fq);
            o = MFMA16(mk8(vlo.x, vlo.y, vhi.x, vhi.y), mk8(pp[2 * t][0], pp[2 * t][1], pp[2 * t + 1][0], pp[2 * t + 1][1]), o); }
#pragma unroll
        for (int ks = 0; ks < 2; ++ks) { const bf16x8v sf = *(const bf16x8v*)(STF + (16 * et + fr) * 72 + 32 * ks + 8 * fq), sb = *(const bf16x8v*)(STB + (16 * et + fr) * 72 + 32 * ks + 8 * fq);
            cfa = MFMA16(sf, qf[ks], cfa); cba = MFMA16(sb, qf[ks], cba); }
        tot[et] = o + cfa * qdf + cba * qdb;
        ss += (tot[et][0] * tot[et][0] + tot[et][1] * tot[et][1]) + (tot[et][2] * tot[et][2] + tot[et][3] * tot[et][3]); }
    ss += __shfl_xor(ss, 16); ss += __shfl_xor(ss, 32);
    const float rs = rsqrtf(ss * (1.f / 64.f) + 1e-6f);
    const size_t tok = (size_t)b * SEQ + n * 128 + ai;
    const bf16* Z = (const bf16*)(p.ws + WS_Z); bf16* CAT = (bf16*)(p.ws + WS_CAT);
#pragma unroll
    for (int et = 0; et < 4; ++et) { const u32x2 gz = *(const u32x2*)(Z + tok * DIN + 9 * DG + h * 64 + 16 * et + 4 * fq); u32x2 o;
        o.x = pk2(tot[et][0] * rs * silu_f(bflo(gz.x)), tot[et][1] * rs * silu_f(bfhi(gz.x))); o.y = pk2(tot[et][2] * rs * silu_f(bflo(gz.y)), tot[et][3] * rs * silu_f(bfhi(gz.y)));
        *(u32x2*)(CAT + tok * DM + 1024 + h * 64 + 16 * et + 4 * fq) = o; }
    __syncthreads();
}

__device__ __forceinline__ void na2_task(const Params& p_, int l, int task, unsigned char* lds) {
    const Params p = *kparams(); (void)p_;
    const int tid = otid(), lane = tid & 63, w = tid >> 6, fr = lane & 15, fq = lane >> 4;
    const int hp = task & 3, rq = (task >> 2) & 63, b = task >> 8;
    const int row_start = min(max(rq - 4, 0), 56);
    const bf16* Z = (const bf16*)(p.ws + WS_Z); bf16* CAT = (bf16*)(p.ws + WS_CAT);
    bf16* VT = (bf16*)lds; float* BI = (float*)(lds + 133120);
    for (int i = tid; i < 930; i += NTHR) BI[i] = p.na_bias[(size_t)(l * 8 + hp * 2) * 465 + i];
    { const int pair = lane & 31, chunk = (lane >> 5) + 2 * (w & 3), hh = w >> 2, h = hp * 2 + hh;
      unsigned* VTd = (unsigned*)(VT + (size_t)hh * 64 * 520);
      u32x4 xs[8], ys[8];
#pragma unroll
      for (int a = 0; a < 8; ++a) { const size_t tok = (size_t)b * SEQ + (row_start + a) * 64 + 2 * pair;
          const bf16* src = Z + tok * DIN + 4 * DG + h * 64 + chunk * 8; xs[a] = *(const u32x4*)src; ys[a] = *(const u32x4*)(src + DIN); }
      asm volatile("" ::: "memory");
#pragma unroll
      for (int a = 0; a < 8; ++a) { const unsigned xu[4] = {xs[a].x, xs[a].y, xs[a].z, xs[a].w}, yu[4] = {ys[a].x, ys[a].y, ys[a].z, ys[a].w};
#pragma unroll
          for (int i = 0; i < 4; ++i) { VTd[(chunk * 8 + 2 * i) * 260 + a * 32 + pair] = (xu[i] & 0xffffu) | (yu[i] << 16);
              VTd[(chunk * 8 + 2 * i + 1) * 260 + a * 32 + pair] = (xu[i] >> 16) | (yu[i] & 0xffff0000u); } } }
    __syncthreads();
    const int hh = w >> 2, h = hp * 2 + hh, qb = w & 3, ct0 = (qb >= 2) ? 1 : 0;
    const int c = 16 * qb + fr; const size_t qtok = (size_t)b * SEQ + rq * 64 + c;
    bf16x8v qf[2];
#pragma unroll
    for (int ks = 0; ks < 2; ++ks) qf[ks] = *(const bf16x8v*)(Z + qtok * DIN + 2 * DG + h * 64 + 32 * ks + 8 * fq);
    const int col_start = min(max(c - 8, 0), 48);
    const float* bi = BI + hh * 465;
    float sc[24][4]; float mx = -1e30f;
#pragma unroll
    for (int hf = 0; hf < 2; ++hf) {
        bf16x8v kfr[12][2];
#pragma unroll
        for (int i = 0; i < 12; ++i) { const int a = 4 * hf + i / 3, ci = i % 3;
            const size_t ktok = (size_t)b * SEQ + (row_start + a) * 64 + 16 * (ct0 + ci) + fr;
#pragma unroll
            for (int ks = 0; ks < 2; ++ks) kfr[i][ks] = *(const bf16x8v*)(Z + ktok * DIN + 3 * DG + h * 64 + 32 * ks + 8 * fq); }
        asm volatile("" ::: "memory");
#pragma unroll
        for (int i = 0; i < 12; ++i) { const int a = 4 * hf + i / 3, ci = i % 3, kt = a * 3 + ci;
            f32x4 acc = {0.f, 0.f, 0.f, 0.f};
#pragma unroll
            for (int ks = 0; ks < 2; ++ks) acc = MFMA16(kfr[i][ks], qf[ks], acc);
            const int dr = row_start + a - rq;
#pragma unroll
            for (int r = 0; r < 4; ++r) { const int kc = 16 * (ct0 + ci) + 4 * fq + r, rel = kc - col_start, dc = kc - c;
                float v = acc[r] * 0.125f + bi[(dr + 7) * 31 + min(max(dc + 15, 0), 30)];
                v = (rel >= 0 && rel < 16) ? v : -1e30f; sc[kt][r] = v; mx = fmaxf(mx, v); } }
    }
    mx = fmaxf(mx, __shfl_xor(mx, 16)); mx = fmaxf(mx, __shfl_xor(mx, 32));
    float sum = 0.f; unsigned pp[24][2];
#pragma unroll
    for (int kt = 0; kt < 24; ++kt) { const float e0 = __expf(sc[kt][0] - mx), e1 = __expf(sc[kt][1] - mx), e2 = __expf(sc[kt][2] - mx), e3 = __expf(sc[kt][3] - mx);
        sum += (e0 + e1) + (e2 + e3); pp[kt][0] = pk2(e0, e1); pp[kt][1] = pk2(e2, e3); }
    sum += __shfl_xor(sum, 16); sum += __shfl_xor(sum, 32);
    const float inv = 1.f / sum;
    const bf16* VTh = VT + (size_t)hh * 64 * 520;
#pragma unroll
    for (int dt = 0; dt < 4; ++dt) { f32x4 o = {0.f, 0.f, 0.f, 0.f};
#pragma unroll
        for (int t = 0; t < 12; ++t) { const int k0 = 2 * t, k1 = 2 * t + 1, a0 = k0 / 3, c0 = k0 % 3, a1 = k1 / 3, c1 = k1 % 3;
            const u32x2 vlo = *(const u32x2*)(VTh + (16 * dt + fr) * 520 + a0 * 64 + 16 * (ct0 + c0) + 4 * fq), vhi = *(const u32x2*)(VTh + (16 * dt + fr) * 520 + a1 * 64 + 16 * (ct0 + c1) + 4 * fq);
            o = MFMA16(mk8(vlo.x, vlo.y, vhi.x, vhi.y), mk8(pp[k0][0], pp[k0][1], pp[k1][0], pp[k1][1]), o); }
        const u32x2 gz = *(const u32x2*)(Z + qtok * DIN + 5 * DG + h * 64 + 16 * dt + 4 * fq); u32x2 ov;
        ov.x = pk2(o[0] * inv * silu_f(bflo(gz.x)), o[1] * inv * silu_f(bfhi(gz.x))); ov.y = pk2(o[2] * inv * silu_f(bflo(gz.y)), o[3] * inv * silu_f(bfhi(gz.y)));
        *(u32x2*)(CAT + qtok * DM + 512 + h * 64 + 16 * dt + 4 * fq) = ov; }
    __syncthreads();
}

__device__ __forceinline__ void conv_task(const Params& p_, int l, int task, unsigned char* lds) {
    const Params p = *kparams(); (void)p_;
    const int tid = otid(), lane = tid & 63, wave = tid >> 6;
    float* us = (float*)lds; float* ys = us + 46 * 512;
    const bf16* Z = (const bf16*)(p.ws + WS_Z);
    const int b = task >> 8, t0 = (task & 255) * 16;
    { u32x4 av[6], gv[6];
#pragma unroll
      for (int it = 0; it < 6; ++it) { const int idx = tid + it * NTHR, tt = idx >> 6, cc = (idx & 63) * 8, tok = t0 - 15 + tt;
          av[it] = (u32x4){0u, 0u, 0u, 0u}; gv[it] = av[it];
          if (idx < 46 * 64 && tok >= 0 && tok < SEQ) { const bf16* zr = Z + (size_t)(b * SEQ + tok) * DIN; av[it] = *(const u32x4*)(zr + 10 * DG + cc); gv[it] = *(const u32x4*)(zr + 11 * DG + cc); } }
      asm volatile("" ::: "memory");
#pragma unroll
      for (int it = 0; it < 6; ++it) { const int idx = tid + it * NTHR, tt = idx >> 6, cc = (idx & 63) * 8;
          if (idx < 46 * 64) { const u32x4 a = av[it], g = gv[it]; f32x4 u0, u1;
              u0[0] = bflo(a.x) / (1.f + __expf(-bflo(g.x))); u0[1] = bfhi(a.x) / (1.f + __expf(-bfhi(g.x))); u0[2] = bflo(a.y) / (1.f + __expf(-bflo(g.y))); u0[3] = bfhi(a.y) / (1.f + __expf(-bfhi(g.y)));
              u1[0] = bflo(a.z) / (1.f + __expf(-bflo(g.z))); u1[1] = bfhi(a.z) / (1.f + __expf(-bfhi(g.z))); u1[2] = bflo(a.w) / (1.f + __expf(-bflo(g.w))); u1[3] = bfhi(a.w) / (1.f + __expf(-bfhi(g.w)));
              *(f32x4*)(us + tt * 512 + cc) = u0; *(f32x4*)(us + tt * 512 + cc + 4) = u1; } } }
    float w[31];
#pragma unroll
    for (int k = 0; k < 31; ++k) w[k] = p.conv_w[(size_t)(l * 31 + k) * DG + tid];
    const float cb = p.conv_b[l * DG + tid];
    __syncthreads();
    for (int t = 0; t < 16; ++t) { float acc = cb;
#pragma unroll
        for (int k = 0; k < 31; ++k) acc += w[k] * us[(t + k) * 512 + tid];
        ys[t * 512 + tid] = acc; }
    __syncthreads();
#pragma unroll
    for (int tw = 0; tw < 2; ++tw) { const int t = wave + 8 * tw; float v[8]; float s = 0.f;
#pragma unroll
        for (int j = 0; j < 8; ++j) { v[j] = ys[t * 512 + lane + 64 * j]; s += v[j]; }
        const float mu = wave_sum(s) * (1.f / 512.f); float q = 0.f;
#pragma unroll
        for (int j = 0; j < 8; ++j) { v[j] -= mu; q += v[j] * v[j]; }
        const float rstd = rsqrtf(wave_sum(q) * (1.f / 512.f) + 1e-6f);
        bf16* orow = (bf16*)(p.ws + WS_CVH) + (size_t)(b * SEQ + t0 + t) * DG;
#pragma unroll
        for (int j = 0; j < 8; ++j) { const int ch = lane + 64 * j; const float y = v[j] * rstd * p.ln_g[l * DG + ch] + p.ln_b[l * DG + ch]; orow[ch] = (bf16)f2bf(silu_f(y)); } }
    __syncthreads();
}

__device__ __forceinline__ void ph_mixA(const Params& p, int l, unsigned char* lds) {
    const int G = gridDim.x, bid = obid();
    for (int t = bid; t < 512 * REP_R1; t += G) ret1_task(p, l, t & 511, lds);
    if (G == 256 && REP_NA == 1) {
        if (bid < 128) { for (int i = 0; i < 3; ++i) na2_task(p, l, 128 + bid * 3 + i, lds); }
        else na2_task(p, l, bid - 128, lds);
    } else for (int t = bid; t < 512 * REP_NA; t += G) na2_task(p, l, t & 511, lds);
    for (int t = bid; t < 512 * REP_CV; t += G) conv_task(p, l, t & 511, lds);
}

__device__ __forceinline__ void ph_combine(const Params& p_) {
    const Params p = *kparams(); (void)p_;
    const float* part = (const float*)(p.ws + WS_PART); bf16* CAT = (bf16*)(p.ws + WS_CAT); const bf16* Z = (const bf16*)(p.ws + WS_Z);
    for (int e = obid() * NTHR + otid(); e < MTOK * DG / 4; e += gridDim.x * NTHR) {
        const int row = e >> 7, c4 = (e & 127) * 4, b = row >> 12, k = row & 4095;
        f32x4 s = {0.f, 0.f, 0.f, 0.f};
#pragma unroll
        for (int ks = 0; ks < 2; ++ks) s += *(const f32x4*)(part + ((size_t)((b * 2 + ks) * 4096 + k)) * 512 + c4);
        const u32x2 gz = *(const u32x2*)(Z + (size_t)row * DIN + DG + c4);
        u32x2 w; w.x = pk2(s[0] * silu_f(bflo(gz.x)), s[1] * silu_f(bfhi(gz.x))); w.y = pk2(s[2] * silu_f(bflo(gz.y)), s[3] * silu_f(bfhi(gz.y)));
        *(u32x2*)(CAT + (size_t)row * DM + c4) = w;
    }
}

#define XB_TMO      128
#define XB_XCNT(j)  (256  + 64 * (j))
#define XB_XSUB(j)  (1280 + 64 * (j))
#define XB_XGEN(j)  (2304 + 64 * (j))
#define XB_TOP      3328
#define XB_TOPGEN   3392
#define XCD_BAR_WORDS 3456
#define XB_SPIN_CAP (1u << 20)
__device__ __forceinline__ unsigned xb_ld(unsigned* p)              { return __hip_atomic_load(p, __ATOMIC_RELAXED, __HIP_MEMORY_SCOPE_AGENT); }
__device__ __forceinline__ unsigned xb_add(unsigned* p, unsigned v) { return __hip_atomic_fetch_add(p, v, __ATOMIC_RELAXED, __HIP_MEMORY_SCOPE_AGENT); }
__device__ __forceinline__ unsigned xb_xcc_id() { return (unsigned)__builtin_amdgcn_s_getreg((3 << 11) | 20) & 0xFu; }
#define XB_SPIN(cond, bar) do { unsigned _sp = 0; while (cond) { __builtin_amdgcn_s_sleep(1); \
    if ((++_sp & 255u) == 0u) { if (xb_ld(&(bar)[XB_TMO])) break; if (_sp > XB_SPIN_CAP) { atomicAdd(&(bar)[XB_TMO], 1u); break; } } } } while (0)
struct XcdBarrier { unsigned* bar; unsigned x; volatile PG8_LAS unsigned* st; };
__device__ __forceinline__ XcdBarrier xcd_barrier_post(unsigned* bar, volatile PG8_LAS unsigned* st) {
    XcdBarrier b; b.bar = bar; b.x = xb_xcc_id(); b.st = st;
    if (otid() == 0) (void)xb_add(&bar[XB_XCNT(b.x)], 1u);
    return b;
}
__device__ __forceinline__ void xcd_barrier_complete(unsigned* bar, unsigned x, unsigned& nloc, unsigned& nx) {
    const unsigned G = gridDim.x * gridDim.y * gridDim.z;
    unsigned sum, cnt, mine, sp = 0u;
    for (;;) {
        sum = 0u; cnt = 0u; mine = 0u;
#pragma unroll
        for (unsigned j = 0; j < 16; ++j) { const unsigned c = xb_ld(&bar[XB_XCNT(j)]); sum += c; cnt += (c > 0u) ? 1u : 0u; mine = (j == x) ? c : mine; }
        if (sum == G) break;
        __builtin_amdgcn_s_sleep(1);
        if ((++sp & 255u) == 0u) { if (xb_ld(&bar[XB_TMO])) break; if (sp > XB_SPIN_CAP) { atomicAdd(&bar[XB_TMO], 1u); break; } }
    }
    nloc = mine > 0u ? mine : 1u; nx = cnt > 0u ? cnt : 1u;
}
__device__ __forceinline__ void xcd_barrier(const XcdBarrier& b) {
    asm volatile("s_waitcnt vmcnt(0)" ::: "memory");
    __syncthreads();
    if (otid() == 0) {
        unsigned* bar = b.bar;
        __builtin_amdgcn_s_waitcnt(0);
        unsigned nloc = b.st[0], nx = b.st[1];
        if (nloc == 0u) { xcd_barrier_complete(bar, b.x, nloc, nx); b.st[0] = nloc; b.st[1] = nx; }
        const unsigned old = xb_add(&bar[XB_XSUB(b.x)], 1u);
        const unsigned gen = old / nloc;
        if (old + 1u == (gen + 1u) * nloc) {
            __builtin_amdgcn_fence(__ATOMIC_RELEASE, "agent");
            asm volatile("s_waitcnt vmcnt(0)" ::: "memory");
            const unsigned og = xb_add(&bar[XB_TOP], 1u);
            const unsigned tg = og / nx;
            if (og + 1u == (tg + 1u) * nx) xb_add(&bar[XB_TOPGEN], 1u);
            else XB_SPIN(xb_ld(&bar[XB_TOPGEN]) == tg, bar);
            __builtin_amdgcn_fence(__ATOMIC_ACQUIRE, "agent");
            xb_add(&bar[XB_XGEN(b.x)], 1u);
            asm volatile("s_waitcnt vmcnt(0)" ::: "memory");
        } else {
            XB_SPIN(xb_ld(&bar[XB_XGEN(b.x)]) == gen, bar);
            __builtin_amdgcn_fence(__ATOMIC_ACQUIRE, "agent");
            asm volatile("s_waitcnt vmcnt(0)" ::: "memory");
        }
    }
    __syncthreads();
}

constexpr int NPH = 12;
__global__ void __launch_bounds__(NTHR) mega(Params p) {
    extern __shared__ __attribute__((aligned(16))) unsigned char lds[];
    cg::grid_group grid = cg::this_grid();
    PG8_LAS unsigned char* ldsl = (PG8_LAS unsigned char*)lds;
    const int lo = p.ph_lo, hi = p.ph_hi;
#define IN(k) (lo <= (k) && (k) < hi)
#define SEAM(k) do { if (IN(k) && IN((k) + 1)) { xcd_barrier(xb); } } while (0)
    bf16* Zb = (bf16*)(kparams()->ws + WS_Z); bf16* CAT = (bf16*)(kparams()->ws + WS_CAT);
    volatile PG8_LAS unsigned* xst = (volatile PG8_LAS unsigned*)(ldsl + LDS_BYTES - 16);
    { const int t0_ = otid(); if (t0_ < 4) xst[t0_] = 0u; }
    __syncthreads();
    XcdBarrier xb = xcd_barrier_post((unsigned*)(kparams()->ws + WS_BAR), xst);
    if (p.ph_lo < 0) grid.sync();
    if (IN(0)) REPEAT(REP_PRO) { ph_prologue(p, lds); __syncthreads(); }
    SEAM(0);
    if (IN(0) && IN(1)) for (int r_ = 1; r_ < REP_SUB; ++r_) xcd_barrier(xb);
#pragma unroll
    for (int l = 0; l < NL; ++l) {
        const int pb = 1 + 5 * l;
        const char* Wl = (const char*)(kparams()->ws + WS_WIN + (size_t)l * WROWS * DM * 2);
        if (IN(pb)) {
            if (l == 0) {
#pragma unroll
                for (int ll = 0; ll < NL; ++ll) {
                    SchedS S = make_sched(kparams()->ws + WS_WCS + (size_t)ll * 1024 * DG * 2, DG, kparams()->ws + WS_WFXB + (size_t)ll * DM * DG * 2, DG, 1024, DM, 32 * ll);
                    EpiZ E{(bf16*)(kparams()->ws + WS_WIN + ((size_t)ll * WROWS + 6656) * DM * 2), DM};
                    pg8::gemm_phase<EpiZ, SchedS, true>(ldsl, pg8::Gemm{DG, DG, DG}, S, E);
                }
            }
            REPEAT(REP_NORM) ph_norm(p, l);
        }
        SEAM(pb);
        if (IN(pb + 1)) REPEAT(REP_Z) {
            SchedZ S; S.o.init(MTOK, 24 * 256, (int)gridDim.x, obid()); S.A = (const char*)(kparams()->ws + WS_U); S.B = Wl; S.late = 0;
            EpiZ2 E{Zb, (bf16*)(kparams()->ws + WS_PQT)};
            pg8::gemm_phase<EpiZ2, SchedZ, true>(ldsl, pg8::Gemm{DM, DM, DM}, S, E);
        }
        SEAM(pb + 1);
        if (IN(pb + 2)) {
            {
                SchedZ S; S.o.init(MTOK, 4 * 256, (int)gridDim.x, obid()); S.A = (const char*)(kparams()->ws + WS_U); S.B = Wl; S.late = 1;
                EpiZ2 E{Zb, (bf16*)(kparams()->ws + WS_PQT)};
                pg8::gemm_phase<EpiZ2, SchedZ, true>(ldsl, pg8::Gemm{DM, DM, DM}, S, E);
            }
            {
                const int G_ = (int)gridDim.x, b_ = obid(); const bool bal = (G_ == 256);
                SchedDFT S{(const char*)(kparams()->ws + WS_DFT), (const char*)(kparams()->ws + WS_PQT), bal ? 128 : G_, bal ? b_ - 128 : b_};
                EpiPart E{(float*)(kparams()->ws + WS_PART)};
                pg8::gemm_phase<EpiPart, SchedDFT, true>(ldsl, pg8::Gemm{8192, 8192, 4096}, S, E);
            }
            REPEAT(REP_MIX) ph_mixA(p, l, lds);
        }
        SEAM(pb + 2);
        if (IN(pb + 3)) REPEAT(REP_P3) {
            { SchedS S = make_sched(kparams()->ws + WS_CVH, DG, kparams()->ws + WS_WPW + (size_t)l * DG * DG * 2, DG, MTOK, DG);
              EpiGate E{CAT, Zb, 1536, 12 * DG};
              pg8::gemm_phase<EpiGate, SchedS, true>(ldsl, pg8::Gemm{DG, DG, DG}, S, E); }
            for (int t = obid(); t < 512 * REP_R2; t += gridDim.x) ret2_task(p, l, t & 511, lds);
            ph_combine(p);
        }
        SEAM(pb + 3);
        if (IN(pb + 4)) REPEAT(l == 0 ? REP_OUT : 1) {
            SchedS S = make_sched(CAT, DM, kparams()->ws + WS_WOUT + (size_t)l * DM * DM * 2, DM, MTOK, DM);
            EpiRes E{(l == 0) ? kparams()->x : kparams()->out, kparams()->out, (const float*)(kparams()->ws + WS_MOD) + (size_t)l * 2 * 6144 + 4096};
            pg8::gemm_phase<EpiRes, SchedS, true>(ldsl, pg8::Gemm{DM, DM, DM}, S, E);
        }
        SEAM(pb + 4);
    }
    if (IN(NPH - 1)) ph_final(p);
#undef IN
#undef SEAM
}

extern "C" void kernel_launch(void* const* d_in, const int* in_sizes, int n_in, void* d_out, int out_size, void* d_ws, size_t ws_size, hipStream_t stream) {
    static int grid_blocks = 0;
    if (grid_blocks == 0) {
        if (n_in != 17 || ws_size < WS_END) { fprintf(stderr, "kernel_launch: n_in %d ws %zu (need %zu)\n", n_in, ws_size, (size_t)WS_END); grid_blocks = -1; return; }
        int dev = 0, cus = 0, per_cu = 0;
        hipGetDevice(&dev); hipDeviceGetAttribute(&cus, hipDeviceAttributeMultiprocessorCount, dev);
        if (hipFuncSetAttribute((const void*)mega, hipFuncAttributeMaxDynamicSharedMemorySize, LDS_BYTES) != hipSuccess) { fprintf(stderr, "hipFuncSetAttribute failed\n"); grid_blocks = -1; return; }
        if (hipOccupancyMaxActiveBlocksPerMultiprocessor(&per_cu, (const void*)mega, NTHR, LDS_BYTES) != hipSuccess || per_cu < 1) { fprintf(stderr, "occupancy query: %d\n", per_cu); per_cu = 1; }
        (void)hipGetLastError();
        grid_blocks = cus * 1;
    }
    if (grid_blocks < 0) return;
    Params p{};
    p.x = (const float*)d_in[0]; p.c = (const float*)d_in[1]; p.norm_g = (const float*)d_in[2]; p.w_ada = (const float*)d_in[3]; p.b_ada = (const float*)d_in[4];
    p.w_in = (const float*)d_in[5]; p.w_fft = (const float*)d_in[6]; p.na_bias = (const float*)d_in[7]; p.rl_f = (const float*)d_in[8]; p.rl_b = (const float*)d_in[9];
    p.conv_w = (const float*)d_in[10]; p.conv_b = (const float*)d_in[11]; p.ln_g = (const float*)d_in[12]; p.ln_b = (const float*)d_in[13]; p.w_pw = (const float*)d_in[14];
    p.w_out = (const float*)d_in[15]; p.final_g = (const float*)d_in[16];
    p.out = (float*)d_out; p.ws = (unsigned char*)d_ws;
#if ONE_LAUNCH
    if (hipMemsetAsync((char*)d_ws + WS_BAR, 0, 16384, stream) != hipSuccess) { fprintf(stderr, "memset of the barrier words failed\n"); return; }
    p.ph_lo = 0; p.ph_hi = NPH;
    void* args[] = {&p};
    hipError_t e = hipLaunchCooperativeKernel((const void*)mega, dim3(grid_blocks), dim3(NTHR), args, LDS_BYTES, stream);
    if (e != hipSuccess) fprintf(stderr, "cooperative launch failed: %s (grid %d)\n", hipGetErrorString(e), grid_blocks);
#else
    for (int ph = 0; ph < NPH; ++ph) { p.ph_lo = ph; p.ph_hi = ph + 1; hipLaunchKernelGGL(mega, dim3(grid_blocks), dim3(NTHR), LDS_BYTES, stream, p); }
#endif
}
```

```cpp
#include <hip/hip_runtime.h>
#include <hip/hip_cooperative_groups.h>
#include <cstdio>
#include <cstdint>
namespace cg = cooperative_groups;

#ifndef ONE_LAUNCH
#define ONE_LAUNCH 1
#endif

__device__ __forceinline__ int obid() { int b = (int)blockIdx.x; asm volatile("" : "+s"(b)); return b; }
__device__ __forceinline__ int otid() { int t; asm volatile("v_mov_b32 %0, %1" : "=v"(t) : "v"(threadIdx.x)); return t; }
namespace pg8 {
#define PG8_LAS __attribute__((address_space(3)))
typedef unsigned short bf16_t;
typedef short bf16x8 __attribute__((ext_vector_type(8)));
typedef float f32x4 __attribute__((ext_vector_type(4)));
typedef unsigned u32x4 __attribute__((ext_vector_type(4)));
constexpr int BM = 256, BK = 64, HALF = 128, HTB = HALF * BK * 2, STAGE_BYTES = 8 * HTB, NXCD = 8, WGM = 8;

__host__ __device__ __forceinline__ int lds_byte(int r, int c) { const int st = (r >> 4) * 2 + (c >> 5), rr = r & 15, cc = c & 31, ob = rr * 64 + cc * 2; return st * 1024 + (ob ^ (((ob >> 9) & 1) << 5)); }
__host__ __device__ __forceinline__ void stage_rc(int b, int& R, int& C) { const int st = b / 1024, sb = b % 1024, swz = sb ^ (((sb >> 9) & 1) << 5); R = (st >> 1) * 16 + swz / 64; C = (st & 1) * 32 + (swz % 64) / 2; }
__host__ __device__ __forceinline__ int perm32(int rho) { const int n = rho >> 4, i = rho & 15; return 8 * (i >> 2) + 4 * n + (i & 3); }

struct Unit { int pm, pn, aux, pad; const char* A; const char* B; };
struct Gemm { int lda, ldb, K; };

struct StaticOrder {
    int nM, nN, nwg, G, c;
    __host__ __device__ void init(int M, int N, int G_, int c_) { nM = M / BM; nN = N / BM; nwg = nM * nN; G = G_; c = c_; }
    __device__ bool next(int i, Unit& u) const {
        const long L = (long)i * G + c; if (L >= nwg) return false;
        int wgid = __builtin_amdgcn_readfirstlane((int)L); { const int q = nwg / NXCD, r = nwg % NXCD, xcd = wgid % NXCD, off = wgid / NXCD; wgid = (xcd < r ? xcd * (q + 1) : r * (q + 1) + (xcd - r) * q) + off; }
        const int nig = WGM * nN, gid = wgid / nig, fm = gid * WGM, gsz = (nM - fm) < WGM ? (nM - fm) : WGM;
        u.pm = __builtin_amdgcn_readfirstlane(fm + ((wgid % nig) % gsz)); u.pn = __builtin_amdgcn_readfirstlane((wgid % nig) / gsz); return true;
    }
};

__device__ __forceinline__ unsigned cvt_pk_bf16(float lo, float hi) { unsigned r; asm volatile("v_cvt_pk_bf16_f32 %0, %1, %2" : "=v"(r) : "v"(lo), "v"(hi)); return r; }

template <class Epi, class Sched, bool ALIGN_EPI>
__device__ __forceinline__ void gemm_phase(PG8_LAS unsigned char* lds, const Gemm g, const Sched& S, const Epi& E) {
    const int tid = otid(), wid = __builtin_amdgcn_readfirstlane(tid >> 6), lane = tid & 63, wr = wid >> 2, wc = wid & 3, fr = lane & 15, fq = lane >> 4;
    const int K = g.K, nt = K / BK;
    unsigned voffA[2], voffB[2];
#pragma unroll
    for (int i = 0; i < 2; ++i) { int R, C; stage_rc(tid * 16 + i * 8192, R, C); const int Rb = Epi::PERM ? ((R & ~31) + perm32(R & 31)) : R;
        voffA[i] = (unsigned)(R * g.lda + C) * 2u; voffB[i] = (unsigned)(Rb * g.ldb + C) * 2u; }
    const size_t kstep = (size_t)(BK * 2);
    const size_t hA = (size_t)HALF * g.lda * 2, hB = (size_t)HALF * g.ldb * 2;
    const unsigned ldsw = (unsigned)wid * 1024u;
    const int aoff = lds_byte(wr * 64 + fr, fq * 8), boff = lds_byte(wc * 32 + fr, fq * 8);
#define PG8_SA(b, h) (((b) * 2 + (h)) * HTB)
#define PG8_SB(b, h) ((4 + (b) * 2 + (h)) * HTB)
#define PG8_STAGE(bufoff, gbase, voff) do { _Pragma("unroll") for (int _i = 0; _i < 2; ++_i) \
        __builtin_amdgcn_global_load_lds((const unsigned*)((const char*)(gbase) + (voff)[_i]), (PG8_LAS unsigned*)(lds + (bufoff) + ldsw + _i * 8192), 16, 0, 0); } while (0)
#define PG8_LDA(dst, b, h) do { _Pragma("unroll") for (int m = 0; m < 4; ++m) _Pragma("unroll") for (int k = 0; k < 2; ++k) dst[m][k] = *(const PG8_LAS bf16x8*)(lds + PG8_SA(b, h) + aoff + m * 2048 + k * 1024); } while (0)
#define PG8_LDB(dst, b, h) do { _Pragma("unroll") for (int n = 0; n < 2; ++n) _Pragma("unroll") for (int k = 0; k < 2; ++k) dst[n][k] = *(const PG8_LAS bf16x8*)(lds + PG8_SB(b, h) + boff + n * 2048 + k * 1024); } while (0)
#define PG8_MMA(ai, bj, At, Bt) do { __builtin_amdgcn_s_setprio(1); _Pragma("unroll") for (int m = 0; m < 4; ++m) _Pragma("unroll") for (int n = 0; n < 2; ++n) _Pragma("unroll") for (int k = 0; k < 2; ++k) \
        acc[ai][bj][m][n] = __builtin_amdgcn_mfma_f32_16x16x32_bf16(Bt[n][k], At[m][k], acc[ai][bj][m][n], 0, 0, 0); __builtin_amdgcn_s_setprio(0); } while (0)
#define PG8_WAIT_V(n) asm volatile("s_waitcnt vmcnt(" #n ")" ::: "memory")
#define PG8_WAIT_L(n) asm volatile("s_waitcnt lgkmcnt(" #n ")" ::: "memory")
#define PG8_BAR __builtin_amdgcn_s_barrier()
#define PG8_SCHED __builtin_amdgcn_sched_barrier(0)
    Unit cur, nxt; int ui = 0;
    if (!S.next(0, cur)) return;
    f32x4 acc[2][2][4][2];
#pragma unroll
    for (int a = 0; a < 2; ++a)
#pragma unroll
        for (int b = 0; b < 2; ++b)
#pragma unroll
            for (int m = 0; m < 4; ++m)
#pragma unroll
                for (int n = 0; n < 2; ++n) acc[a][b][m][n] = (f32x4){0.f, 0.f, 0.f, 0.f};
    bf16x8 At[4][2], B0[2][2], B1[2][2];
    const char* cA = cur.A; const char* cB = cur.B;
    PG8_STAGE(PG8_SB(0, 0), cB, voffB); PG8_STAGE(PG8_SB(0, 1), cB + hB, voffB); PG8_STAGE(PG8_SA(0, 0), cA, voffA); PG8_STAGE(PG8_SA(0, 1), cA + hA, voffA);
    if (wr == 1) PG8_BAR;
    PG8_WAIT_V(2); PG8_BAR;
    PG8_STAGE(PG8_SB(1, 0), cB + kstep, voffB); PG8_STAGE(PG8_SA(1, 0), cA + kstep, voffA); PG8_STAGE(PG8_SB(1, 1), cB + hB + kstep, voffB);
    PG8_WAIT_V(6); PG8_BAR;
    for (;;) {
        const bool has_next = S.next(ui + 1, nxt);
        const char* nA = has_next ? nxt.A : cA; const char* nB = has_next ? nxt.B : cB;
        for (int t = 0; t < nt; t += 2) {
            const bool last = (t == nt - 2);
            const char* a1 = cA + (size_t)(t + 1) * kstep;
            const char* a2 = last ? nA : cA + (size_t)(t + 2) * kstep; const char* b2 = last ? nB : cB + (size_t)(t + 2) * kstep;
            const char* a3 = a2 + kstep; const char* b3 = b2 + kstep;
            PG8_LDB(B0, 0, 0); PG8_LDB(B1, 0, 1); PG8_SCHED; PG8_LDA(At, 0, 0); PG8_STAGE(PG8_SA(1, 1), a1 + hA, voffA);
            PG8_WAIT_V(8); PG8_WAIT_L(0); PG8_BAR; PG8_MMA(0, 0, At, B0); PG8_MMA(0, 1, At, B1); PG8_BAR; PG8_SCHED;
            PG8_LDA(At, 0, 1); PG8_STAGE(PG8_SB(0, 0), b2, voffB); PG8_STAGE(PG8_SB(0, 1), b2 + hB, voffB); PG8_STAGE(PG8_SA(0, 0), a2, voffA);
            PG8_WAIT_V(8); PG8_WAIT_L(0); PG8_BAR; PG8_MMA(1, 0, At, B0); PG8_MMA(1, 1, At, B1); PG8_BAR; PG8_SCHED;
            PG8_LDB(B0, 1, 0); PG8_LDB(B1, 1, 1); PG8_SCHED; PG8_LDA(At, 1, 0); PG8_STAGE(PG8_SA(0, 1), a2 + hA, voffA);
            PG8_WAIT_V(8); PG8_WAIT_L(0); PG8_BAR; PG8_MMA(0, 0, At, B0); PG8_MMA(0, 1, At, B1); PG8_BAR; PG8_SCHED;
            PG8_LDA(At, 1, 1); PG8_STAGE(PG8_SB(1, 0), b3, voffB); PG8_STAGE(PG8_SB(1, 1), b3 + hB, voffB); PG8_STAGE(PG8_SA(1, 0), a3, voffA);
            PG8_WAIT_V(8); PG8_WAIT_L(0); PG8_BAR; PG8_MMA(1, 0, At, B0); PG8_MMA(1, 1, At, B1); PG8_BAR; PG8_SCHED;
        }
        if constexpr (ALIGN_EPI) { if (wr == 0) PG8_BAR; }
        E(acc, cur, wr, wc, fr, fq);
        if (!has_next) break;
#pragma unroll
        for (int a = 0; a < 2; ++a)
#pragma unroll
            for (int b = 0; b < 2; ++b)
#pragma unroll
                for (int m = 0; m < 4; ++m)
#pragma unroll
                    for (int n = 0; n < 2; ++n) acc[a][b][m][n] = (f32x4){0.f, 0.f, 0.f, 0.f};
        cur = nxt; cA = nA; cB = nB; ++ui;
        if constexpr (ALIGN_EPI) { if (wr == 1) PG8_BAR; }
    }
    PG8_WAIT_V(0);
    if constexpr (!ALIGN_EPI) { if (wr == 0) PG8_BAR; }
    PG8_BAR;
#undef PG8_SA
#undef PG8_SB
#undef PG8_STAGE
#undef PG8_LDA
#undef PG8_LDB
#undef PG8_MMA
#undef PG8_WAIT_V
#undef PG8_WAIT_L
#undef PG8_BAR
#undef PG8_SCHED
}
}

typedef unsigned short bf16;
typedef float f32x4 __attribute__((ext_vector_type(4)));
typedef unsigned u32x4 __attribute__((ext_vector_type(4)));
typedef unsigned u32x2 __attribute__((ext_vector_type(2)));
constexpr int NB = 2, SEQ = 4096, DM = 2048, MTOK = NB * SEQ, DIN = 6656, DG = 512, NL = 2;
constexpr int LDS_BYTES = 147456;
constexpr int NTHR = 512;

constexpr int WROWS = 7680;
constexpr size_t WS_WIN = 0;
constexpr size_t WS_WOUT = WS_WIN + (size_t)NL * WROWS * DM * 2;
constexpr size_t WS_WCS = WS_WOUT + (size_t)NL * DM * DM * 2;
constexpr size_t WS_WFXB = WS_WCS + (size_t)NL * 1024 * DG * 2;
constexpr size_t WS_WPW = WS_WFXB + (size_t)NL * DM * DG * 2;
constexpr size_t WS_DC = WS_WPW + (size_t)NL * DG * DG * 2;
constexpr size_t WS_DS = WS_DC + (size_t)2304 * 2048 * 2;
constexpr size_t WS_PQF = WS_DS + (size_t)2048 * 2048 * 2;
constexpr size_t WS_ROPE = WS_PQF + (size_t)NB * DG * 2 * 2048 * 2;
constexpr size_t WS_MOD = WS_ROPE + (size_t)SEQ * 32 * 8;
constexpr size_t WS_U = WS_MOD + 131072;
constexpr size_t WS_PART = WS_U + (size_t)MTOK * DM * 2;
constexpr size_t WS_Z = WS_U + (size_t)4 * MTOK * DG * 4;
constexpr size_t WS_PQT = WS_Z + (size_t)MTOK * DIN * 2;
constexpr size_t WS_CVH = WS_PQT + (size_t)NB * DG * 2 * SEQ * 2;
constexpr size_t WS_CAT = WS_CVH + (size_t)MTOK * DG * 2;
constexpr size_t WS_KV = WS_CAT + (size_t)MTOK * DM * 2;
constexpr size_t WS_BAR = WS_KV + (size_t)2 * NB * 8 * 32 * 4096 * 4;
constexpr size_t WS_END = WS_BAR + 16384;

struct Params {
    const float* x; const float* c; const float* norm_g; const float* w_ada; const float* b_ada; const float* w_in; const float* w_fft; const float* na_bias;
    const float* rl_f; const float* rl_b; const float* conv_w; const float* conv_b; const float* ln_g; const float* ln_b; const float* w_pw; const float* w_out; const float* final_g;
    float* out; unsigned char* ws; int ph_lo, ph_hi;
};

#if defined(__HIP_DEVICE_COMPILE__)
typedef const __attribute__((address_space(4))) Params* KParams;
__device__ __forceinline__ KParams kparams() { KParams k = (KParams)__builtin_amdgcn_kernarg_segment_ptr(); asm volatile("" : "+s"(k)); return k; }
#else
typedef const Params* KParams;
__device__ __forceinline__ KParams kparams() { return nullptr; }
#endif
__device__ __forceinline__ unsigned f2bf(float f) { unsigned u = __float_as_uint(f); return (u + 0x7fffu + ((u >> 16) & 1u)) >> 16; }
__device__ __forceinline__ unsigned pk2(float lo, float hi) { return f2bf(lo) | (f2bf(hi) << 16); }
__device__ __forceinline__ float bf2f(bf16 b) { return __uint_as_float((unsigned)b << 16); }
__device__ __forceinline__ float bflo(unsigned u) { return __uint_as_float(u << 16); }
__device__ __forceinline__ float bfhi(unsigned u) { return __uint_as_float(u & 0xffff0000u); }
__device__ __forceinline__ float silu_f(float v) { return v / (1.f + __expf(-v)); }
__device__ __forceinline__ float wave_sum(float v) {
#pragma unroll
    for (int o = 1; o < 64; o <<= 1) v += __shfl_xor(v, o);
    return v;
}
__device__ __forceinline__ float wave_max(float v) {
#pragma unroll
    for (int o = 1; o < 64; o <<= 1) v = fmaxf(v, __shfl_xor(v, o));
    return v;
}

struct SchedS {
    pg8::StaticOrder o; const char* A; const char* B; size_t ta, tb;
    __device__ __forceinline__ bool next(int i, pg8::Unit& u) const { if (!o.next(i, u)) return false; u.A = A + (size_t)u.pm * ta; u.B = B + (size_t)u.pn * tb; u.aux = 0; return true; }
};
__device__ __forceinline__ SchedS make_sched(const void* A, int lda, const void* B, int ldb, int M, int N, int shift = 0) {
    SchedS s; s.o.init(M, N, (int)gridDim.x, (int)((obid() + gridDim.x - shift) % gridDim.x)); s.A = (const char*)A; s.B = (const char*)B; s.ta = (size_t)256 * lda * 2; s.tb = (size_t)256 * ldb * 2; return s;
}
struct SchedZ {
    pg8::StaticOrder o; const char* A; const char* B; int late;
    __device__ __forceinline__ bool next(int i, pg8::Unit& u) const { if (!o.next(i, u)) return false; const int jn = u.pn;
        u.pn = late ? (jn < 2 ? 2 + jn : 22 + jn) : (jn < 20 ? jn + 4 : jn + 6);
        u.A = A + (size_t)u.pm * (256 * DM * 2); u.B = B + (size_t)u.pn * (256 * DM * 2); u.aux = 0; return true; }
};
struct SchedDFT {
    const char* DC; const char* DSn; const char* PQF; int G, c;
    __device__ __forceinline__ bool next(int i, pg8::Unit& u) const {
        if (c < 0) return false;
        const int L = __builtin_amdgcn_readfirstlane(i * G + c); if (L >= 68) return false;
        const int b = L / 34, t = L % 34, odd = (t >= 18) ? 1 : 0, tt = odd ? t - 18 : t; u.pm = tt >> 1; u.pn = tt & 1; u.aux = b * 2 + odd;
        u.A = (odd ? DSn : DC) + (size_t)u.pm * (256 * 2048 * 2);
        u.B = PQF + ((size_t)(b * 512 + u.pn * 256) * 4096 + odd * 2048) * 2; return true;
    }
};

struct EpiZ {
    static constexpr bool PERM = true;
    bf16* O; int ldc;
    __device__ __forceinline__ void operator()(const pg8::f32x4 (&acc)[2][2][4][2], const pg8::Unit& u, int wr, int wc, int fr, int fq) const {
        const int row0 = u.pm * 256 + wr * 64 + fr, col0 = u.pn * 256 + wc * 32 + 8 * fq;
#pragma unroll
        for (int ai = 0; ai < 2; ++ai)
#pragma unroll
            for (int m = 0; m < 4; ++m) { bf16* rowp = O + (size_t)(row0 + ai * 128 + m * 16) * ldc + col0;
#pragma unroll
                for (int bj = 0; bj < 2; ++bj) { const pg8::f32x4 v0 = acc[ai][bj][m][0], v1 = acc[ai][bj][m][1]; u32x4 w;
                    w.x = pg8::cvt_pk_bf16(v0[0], v0[1]); w.y = pg8::cvt_pk_bf16(v0[2], v0[3]); w.z = pg8::cvt_pk_bf16(v1[0], v1[1]); w.w = pg8::cvt_pk_bf16(v1[2], v1[3]);
                    *(u32x4*)(rowp + bj * 128) = w; } }
    }
};
struct EpiZ2 {
    static constexpr bool PERM = true;
    bf16* O; bf16* PQ;
    __device__ __forceinline__ void operator()(const pg8::f32x4 (&acc)[2][2][4][2], const pg8::Unit& u, int wr, int wc, int fr, int fq) const {
        const int row0 = u.pm * 256 + wr * 64 + fr;
        if (u.pn < 26) { const int col0 = u.pn * 256 + wc * 32 + 8 * fq;
#pragma unroll
            for (int ai = 0; ai < 2; ++ai)
#pragma unroll
                for (int m = 0; m < 4; ++m) { bf16* rowp = O + (size_t)(row0 + ai * 128 + m * 16) * DIN + col0;
#pragma unroll
                    for (int bj = 0; bj < 2; ++bj) { const pg8::f32x4 v0 = acc[ai][bj][m][0], v1 = acc[ai][bj][m][1]; u32x4 w;
                        w.x = pg8::cvt_pk_bf16(v0[0], v0[1]); w.y = pg8::cvt_pk_bf16(v0[2], v0[3]); w.z = pg8::cvt_pk_bf16(v1[0], v1[1]); w.w = pg8::cvt_pk_bf16(v1[2], v1[3]);
                        *(u32x4*)(rowp + bj * 128) = w; } }
        } else { const int np0 = (u.pn - 26) * 256 + wc * 32 + 8 * fq;
#pragma unroll
            for (int bj = 0; bj < 2; ++bj) { const int np = np0 + bj * 128, pq = np >> 9, n = np & 511;
#pragma unroll
                for (int ai = 0; ai < 2; ++ai)
#pragma unroll
                    for (int m = 0; m < 4; ++m) { const int row = row0 + ai * 128 + m * 16, b = row >> 12, sq = row & 4095;
                        bf16* dst = PQ + ((size_t)(b * 512 + n) * 2 + pq) * 4096 + sq;
#pragma unroll
                        for (int nn = 0; nn < 2; ++nn)
#pragma unroll
                            for (int j = 0; j < 4; ++j) dst[(size_t)(4 * nn + j) * 8192] = (bf16)f2bf(acc[ai][bj][m][nn][j]); } }
        }
    }
};
struct EpiGate {
    static constexpr bool PERM = true;
    bf16* O; const bf16* Z; int coff, goff;
    __device__ __forceinline__ void operator()(const pg8::f32x4 (&acc)[2][2][4][2], const pg8::Unit& u, int wr, int wc, int fr, int fq) const {
        const int row0 = u.pm * 256 + wr * 64 + fr, col0 = u.pn * 256 + wc * 32 + 8 * fq;
#pragma unroll
        for (int ai = 0; ai < 2; ++ai)
#pragma unroll
            for (int m = 0; m < 4; ++m) { const size_t row = (size_t)(row0 + ai * 128 + m * 16);
#pragma unroll
                for (int bj = 0; bj < 2; ++bj) { const pg8::f32x4 v0 = acc[ai][bj][m][0], v1 = acc[ai][bj][m][1];
                    const u32x4 gz = *(const u32x4*)(Z + row * DIN + goff + col0 + bj * 128); u32x4 w;
                    w.x = pg8::cvt_pk_bf16(v0[0] * silu_f(bflo(gz.x)), v0[1] * silu_f(bfhi(gz.x))); w.y = pg8::cvt_pk_bf16(v0[2] * silu_f(bflo(gz.y)), v0[3] * silu_f(bfhi(gz.y)));
                    w.z = pg8::cvt_pk_bf16(v1[0] * silu_f(bflo(gz.z)), v1[1] * silu_f(bfhi(gz.z))); w.w = pg8::cvt_pk_bf16(v1[2] * silu_f(bflo(gz.w)), v1[3] * silu_f(bfhi(gz.w)));
                    *(u32x4*)(O + row * DM + coff + col0 + bj * 128) = w; } }
    }
};
struct EpiPart {
    static constexpr bool PERM = false;
    float* P;
    __device__ __forceinline__ void operator()(const pg8::f32x4 (&acc)[2][2][4][2], const pg8::Unit& u, int wr, int wc, int fr, int fq) const {
        const int row0 = u.pm * 256 + wr * 64 + fr, col0 = u.pn * 256 + wc * 32 + 4 * fq;
        float* base = (u.aux & 1) ? P + (size_t)2 * 2304 * 512 + (size_t)(u.aux >> 1) * 2048 * 512 : P + (size_t)(u.aux >> 1) * 2304 * 512;
#pragma unroll
        for (int ai = 0; ai < 2; ++ai)
#pragma unroll
            for (int m = 0; m < 4; ++m) { float* rowp = base + (size_t)(row0 + ai * 128 + m * 16) * 512 + col0;
#pragma unroll
                for (int bj = 0; bj < 2; ++bj)
#pragma unroll
                    for (int n = 0; n < 2; ++n) *(pg8::f32x4*)(rowp + bj * 128 + n * 16) = acc[ai][bj][m][n]; }
    }
};
struct EpiRes {
    static constexpr bool PERM = false;
    const float* xin; float* xout; const float* gate;
    __device__ __forceinline__ void operator()(const pg8::f32x4 (&acc)[2][2][4][2], const pg8::Unit& u, int wr, int wc, int fr, int fq) const {
        const int row0 = u.pm * 256 + wr * 64 + fr, col0 = u.pn * 256 + wc * 32 + 4 * fq;
        const float* gp = gate + (size_t)(u.pm >> 4) * 6144 + col0;
        pg8::f32x4 gv[2][2];
#pragma unroll
        for (int bj = 0; bj < 2; ++bj)
#pragma unroll
            for (int n = 0; n < 2; ++n) gv[bj][n] = *(const pg8::f32x4*)(gp + bj * 128 + n * 16);
#pragma unroll
        for (int ai = 0; ai < 2; ++ai)
#pragma unroll
            for (int m = 0; m < 4; ++m) { const size_t ro = (size_t)(row0 + ai * 128 + m * 16) * DM + col0;
#pragma unroll
                for (int bj = 0; bj < 2; ++bj)
#pragma unroll
                    for (int n = 0; n < 2; ++n) { const pg8::f32x4 xi = *(const pg8::f32x4*)(xin + ro + bj * 128 + n * 16);
                        *(pg8::f32x4*)(xout + ro + bj * 128 + n * 16) = xi + gv[bj][n] * acc[ai][bj][m][n]; } }
    }
};

struct TPItem { const float* src; bf16* dst; int N, K; };
__device__ __forceinline__ TPItem tp_decode(const Params& p, int it, int tid) {
    constexpr int T_IN = 32 * 96, T_OUT = 32 * 32, T_S = 64, T_L = T_IN + T_OUT + T_S;
    const int l = it / T_L; int r = it % T_L; const float* W; bf16* WT; int K, N, kb, nb;
    if (r < T_IN) { W = p.w_in + (size_t)l * DM * DIN; WT = (bf16*)(p.ws + WS_WIN) + (size_t)l * WROWS * DM; K = DM; N = DIN; kb = r / 96; nb = 8 + r % 96; }
    else if (r < T_IN + T_OUT) { r -= T_IN; W = p.w_out + (size_t)l * DM * DM; WT = (bf16*)(p.ws + WS_WOUT) + (size_t)l * DM * DM; K = DM; N = DM; kb = r >> 5; nb = r & 31; }
    else { r -= T_IN + T_OUT; W = p.w_pw + (size_t)l * DG * DG; WT = (bf16*)(p.ws + WS_WPW) + (size_t)l * DG * DG; K = DG; N = DG; kb = r >> 3; nb = r & 7; }
    TPItem t; t.N = N; t.K = K;
    t.src = W + (size_t)(kb * 64 + (tid >> 4)) * N + nb * 64 + (tid & 15) * 4;
    t.dst = WT + (size_t)(nb * 64 + (tid >> 3)) * K + kb * 64 + (tid & 7) * 8;
    return t;
}
__device__ __forceinline__ void tp_store(const TPItem& t, int tid, const f32x4& v0, const f32x4& v1, float* scr) {
    { const int kk = tid >> 4, nn = (tid & 15) * 4;
      scr[kk * 65 + nn] = v0[0]; scr[kk * 65 + nn + 1] = v0[1]; scr[kk * 65 + nn + 2] = v0[2]; scr[kk * 65 + nn + 3] = v0[3];
      scr[(kk + 32) * 65 + nn] = v1[0]; scr[(kk + 32) * 65 + nn + 1] = v1[1]; scr[(kk + 32) * 65 + nn + 2] = v1[2]; scr[(kk + 32) * 65 + nn + 3] = v1[3]; }
    __syncthreads();
    { const int n = tid >> 3, kc = (tid & 7) * 8; const float* s = scr + kc * 65 + n; u32x4 o;
      o.x = pk2(s[0], s[65]); o.y = pk2(s[2 * 65], s[3 * 65]); o.z = pk2(s[4 * 65], s[5 * 65]); o.w = pk2(s[6 * 65], s[7 * 65]);
      *(u32x4*)t.dst = o; }
    __syncthreads();
}

__device__ __forceinline__ void ph_prologue(const Params& p_, unsigned char* lds) {
    const Params p = *kparams(); (void)p_;
    const int tid = otid(), lane = tid & 63, wave = tid >> 6, G = gridDim.x, bid = obid();
    float* scr = (float*)lds;
    { constexpr int T_TOT = NL * (32 * 96 + 32 * 32 + 64);
      int it = bid; TPItem cur; f32x4 a0, a1;
      if (it < T_TOT) { cur = tp_decode(p, it, tid); a0 = *(const f32x4*)cur.src; a1 = *(const f32x4*)(cur.src + (size_t)32 * cur.N); }
      while (it < T_TOT) { const int nit = it + G; TPItem nxt = cur; f32x4 b0 = a0, b1 = a1;
          if (nit < T_TOT) { nxt = tp_decode(p, nit, tid); b0 = *(const f32x4*)nxt.src; b1 = *(const f32x4*)(nxt.src + (size_t)32 * nxt.N); }
          tp_store(cur, tid, a0, a1, scr);
          cur = nxt; a0 = b0; a1 = b1; it = nit; } }
    { bf16* Wfx = (bf16*)(p.ws + WS_WFXB);
      for (int e = bid * NTHR + tid; e < NL * DM * DG / 8; e += G * NTHR) { const int l = e >> 17, r = e & 131071, k = r >> 6, c8 = (r & 63) * 8;
          const float* src = p.w_in + ((size_t)l * DM + k) * DIN + c8; const f32x4 a = *(const f32x4*)src, b4 = *(const f32x4*)(src + 4);
          u32x4 o; o.x = pk2(a[0], a[1]); o.y = pk2(a[2], a[3]); o.z = pk2(b4[0], b4[1]); o.w = pk2(b4[2], b4[3]);
          *(u32x4*)(Wfx + ((size_t)l * DM + k) * DG + c8) = o; } }
    { float* Wl = (float*)lds; float* tr = Wl + 128 * 65; bf16* Wcs = (bf16*)(p.ws + WS_WCS);
      for (int t2 = G - 1 - bid; t2 < 256; t2 += G) {
          const int t = t2 >> 1, ch = t2 & 1, l = t >> 6, pq = (t >> 5) & 1, g = (t >> 3) & 3, n0 = (t & 7) * 64;
#pragma unroll
          for (int i = 0; i < 4; ++i) { const int m = (tid >> 4) + 32 * i, nn = (tid & 15) * 4;
              const f32x4 v = *(const f32x4*)(p.w_fft + ((size_t)l * DG + g * 128 + m) * DG + n0 + nn);
              Wl[m * 65 + nn] = v[0]; Wl[m * 65 + nn + 1] = v[1]; Wl[m * 65 + nn + 2] = v[2]; Wl[m * 65 + nn + 3] = v[3]; }
          if (tid < 128) tr[tid] = pq ? sinpif((float)tid * (1.f / 64.f)) : cospif((float)tid * (1.f / 64.f));
          __syncthreads();
          const int nn = tid >> 3, cc = ch * 64 + (tid & 7) * 8; float acc[8];
#pragma unroll
          for (int i = 0; i < 8; ++i) acc[i] = 0.f;
#pragma unroll 4
          for (int m = 0; m < 128; ++m) { const float w = Wl[m * 65 + nn];
#pragma unroll
              for (int i = 0; i < 8; ++i) acc[i] += tr[((cc + i) * m) & 127] * w; }
          const float nrm = 0.0013810679320049757f;
          u32x4 o0;
          o0.x = pk2(acc[0] * nrm, acc[1] * nrm); o0.y = pk2(acc[2] * nrm, acc[3] * nrm); o0.z = pk2(acc[4] * nrm, acc[5] * nrm); o0.w = pk2(acc[6] * nrm, acc[7] * nrm);
          *(u32x4*)(Wcs + ((size_t)l * 1024 + pq * 512 + n0 + nn) * DG + g * 128 + cc) = o0;
          __syncthreads();
      } }
    __syncthreads();
    float* cosT = (float*)(lds + 32768); float* sinT = (float*)(lds + 49152); float* ca = (float*)(lds + 65536); float* red = (float*)(lds + 81920);
    for (int j = tid; j < 4096; j += NTHR) { cosT[j] = cospif((float)j * (1.f / 2048.f)); sinT[j] = sinpif((float)j * (1.f / 2048.f)); }
    for (int j = tid; j < 4096; j += NTHR) { const float cv = p.c[j]; ca[j] = cv / (1.f + expf(-cv)); }
    __syncthreads();
    { bf16* DC = (bf16*)(p.ws + WS_DC); bf16* DSm = (bf16*)(p.ws + WS_DS);
      for (int r = bid * 2 + (tid >> 8); r < 4352; r += G * 2) { const int is_sin = (r >= 2304) ? 1 : 0, k = is_sin ? r - 2304 : r, s0 = (tid & 255) * 8; float v[8];
#pragma unroll
          for (int j = 0; j < 8; ++j) { const int idx = (k * (s0 + j)) & 4095; v[j] = is_sin ? sinT[idx] : cosT[idx]; }
          u32x4 o; o.x = pk2(v[0], v[1]); o.y = pk2(v[2], v[3]); o.z = pk2(v[4], v[5]); o.w = pk2(v[6], v[7]);
          *(u32x4*)((is_sin ? DSm : DC) + (size_t)k * 2048 + s0) = o; } }
    { float2* rope = (float2*)(p.ws + WS_ROPE);
      for (int e = bid * NTHR + tid; e < 4096 * 32; e += G * NTHR) { const int s = e >> 5, i = e & 31;
          const float inv = (float)pow(10000.0, -(double)i / 32.0); const float ang = (float)s * inv;
          double sn, cs; sincos((double)ang, &sn, &cs); rope[e] = make_float2((float)cs, (float)sn); } }
    float* mod = (float*)(p.ws + WS_MOD);
    for (int t = bid; t < 192; t += G) {
        const int l = t / 96, col = (t % 96) * 64 + lane; const float* W = p.w_ada + (size_t)l * DM * 6144 + col;
        float a0 = 0.f, a1 = 0.f;
        for (int k0 = wave * 256; k0 < wave * 256 + 256; k0 += 32) { float wv[32];
#pragma unroll
            for (int j = 0; j < 32; ++j) wv[j] = W[(size_t)(k0 + j) * 6144];
            asm volatile("" ::: "memory");
#pragma unroll
            for (int j = 0; j < 32; ++j) { a0 += ca[k0 + j] * wv[j]; a1 += ca[2048 + k0 + j] * wv[j]; } }
        red[(wave * 2 + 0) * 64 + lane] = a0; red[(wave * 2 + 1) * 64 + lane] = a1;
        __syncthreads();
        if (wave < 2) { float s = 0.f;
#pragma unroll
            for (int w = 0; w < 8; ++w) s += red[(w * 2 + wave) * 64 + lane];
            mod[(size_t)(l * 2 + wave) * 6144 + col] = s + p.b_ada[l * 6144 + col]; }
        __syncthreads();
    }
}

__device__ __forceinline__ void ph_norm(const Params& p_, int l) {
    const Params p = *kparams(); (void)p_;
    const int tid = otid(), lane = tid & 63, wave = tid >> 6;
    const float* xin = (l == 0) ? p.x : p.out; bf16* h = (bf16*)(p.ws + WS_U); const float* mod = (const float*)(p.ws + WS_MOD);
    for (int row = obid() * 8 + wave; row < MTOK; row += gridDim.x * 8) {
        const f32x4* xr = (const f32x4*)(xin + (size_t)row * DM) + lane; f32x4 v[8]; float ss = 0.f;
#pragma unroll
        for (int j = 0; j < 8; ++j) { v[j] = xr[64 * j]; ss += (v[j][0] * v[j][0] + v[j][1] * v[j][1]) + (v[j][2] * v[j][2] + v[j][3] * v[j][3]); }
        ss = wave_sum(ss); const float rstd = rsqrtf(ss * (1.f / DM) + 1e-6f);
        const float* md = mod + (size_t)(l * 2 + (row >> 12)) * 6144; const float* g = p.norm_g + l * DM;
#pragma unroll
        for (int j = 0; j < 8; ++j) { const int col = (64 * j + lane) * 4;
            const f32x4 g4 = *(const f32x4*)(g + col), sh = *(const f32x4*)(md + col), sc = *(const f32x4*)(md + 2048 + col);
            const f32x4 o = (v[j] * rstd * g4) * (sc + 1.f) + sh; u32x2 w; w.x = pk2(o[0], o[1]); w.y = pk2(o[2], o[3]);
            *(u32x2*)(h + (size_t)row * DM + col) = w; }
    }
}
__device__ __forceinline__ void ph_final(const Params& p_) {
    const Params p = *kparams(); (void)p_;
    const int tid = otid(), lane = tid & 63, wave = tid >> 6;
    for (int row = obid() * 8 + wave; row < MTOK; row += gridDim.x * 8) {
        f32x4* xr = (f32x4*)(p.out + (size_t)row * DM) + lane; f32x4 v[8]; float ss = 0.f;
#pragma unroll
        for (int j = 0; j < 8; ++j) { v[j] = xr[64 * j]; ss += (v[j][0] * v[j][0] + v[j][1] * v[j][1]) + (v[j][2] * v[j][2] + v[j][3] * v[j][3]); }
        ss = wave_sum(ss); const float rstd = rsqrtf(ss * (1.f / DM) + 1e-6f);
#pragma unroll
        for (int j = 0; j < 8; ++j) { const int col = (64 * j + lane) * 4; const f32x4 g4 = *(const f32x4*)(p.final_g + col); xr[64 * j] = v[j] * rstd * g4; }
    }
}

#ifndef REP_PRO
#define REP_PRO 1
#endif
#ifndef REP_NORM
#define REP_NORM 1
#endif
#ifndef REP_Z
#define REP_Z 1
#endif
#ifndef REP_MIX
#define REP_MIX 1
#endif
#ifndef REP_P3
#define REP_P3 1
#endif
#ifndef REP_R2
#define REP_R2 1
#endif
#ifndef REP_CMB
#define REP_CMB 1
#endif
#ifndef REP_FFT
#define REP_FFT 1
#endif
#ifndef REP_OUT
#define REP_OUT 1
#endif
#ifndef REP_SUB
#define REP_SUB 1
#endif

#ifndef REP_R1
#define REP_R1 1
#endif
#ifndef REP_NA
#define REP_NA 1
#endif
#ifndef REP_CV
#define REP_CV 1
#endif
#ifndef REP_F1
#define REP_F1 1
#endif
#define REPEAT(n) for (int rep_ = 0; rep_ < (n); ++rep_)
typedef short bf16x8v __attribute__((ext_vector_type(8)));
__device__ __forceinline__ bf16x8v mk8(unsigned a, unsigned b, unsigned c, unsigned d) { u32x4 v = {a, b, c, d}; return __builtin_bit_cast(bf16x8v, v); }
#define MFMA16(a, b, c) __builtin_amdgcn_mfma_f32_16x16x32_bf16(a, b, c, 0, 0, 0)
constexpr int R_QS = 0, R_KS = 18432, R_VT = 36864, R_KTF = 54272, R_KTB = 71680, R_STF = 89088, R_STB = 98304;

template <bool R2>
__device__ __forceinline__ void ret_stage(const Params& p_, int b, int h, int n, unsigned char* lds, float l2f, float l2b) {
    const Params p = *kparams(); (void)p_;
    const int tid = otid(), j = tid >> 2, c4 = tid & 3, s = n * 128 + j;
    const bf16* Z = (const bf16*)(p.ws + WS_Z); const bf16* zr = Z + (size_t)(b * SEQ + s) * DIN;
    const f32x4* rp = (const f32x4*)((const float2*)(p.ws + WS_ROPE) + s * 32 + c4 * 8);
    f32x4 rr[4];
#pragma unroll
    for (int i = 0; i < 4; ++i) rr[i] = rp[i];
    const u32x4 ka = *(const u32x4*)(zr + 7 * DG + h * 64 + c4 * 8), kb = *(const u32x4*)(zr + 7 * DG + h * 64 + 32 + c4 * 8);
    const u32x4 va = *(const u32x4*)(zr + 8 * DG + h * 64 + c4 * 16), vb = *(const u32x4*)(zr + 8 * DG + h * 64 + c4 * 16 + 8);
    u32x4 qa = ka, qb = kb;
    if (R2) { qa = *(const u32x4*)(zr + 6 * DG + h * 64 + c4 * 8); qb = *(const u32x4*)(zr + 6 * DG + h * 64 + 32 + c4 * 8); }
    asm volatile("" ::: "memory");
    float cs[8], sn[8];
#pragma unroll
    for (int i = 0; i < 4; ++i) { const f32x4 r = rr[i]; cs[2 * i] = r[0]; sn[2 * i] = r[1]; cs[2 * i + 1] = r[2]; sn[2 * i + 1] = r[3]; }
    bf16* KS = (bf16*)(lds + R_KS); bf16* VT = (bf16*)(lds + R_VT);
    {
      const unsigned kau[4] = {ka.x, ka.y, ka.z, ka.w}, kbu[4] = {kb.x, kb.y, kb.z, kb.w};
      float k1[8], k2[8];
#pragma unroll
      for (int i = 0; i < 4; ++i) { const float a0 = bflo(kau[i]), a1 = bfhi(kau[i]), b0 = bflo(kbu[i]), b1 = bfhi(kbu[i]);
          k1[2 * i] = a0 * cs[2 * i] - b0 * sn[2 * i]; k2[2 * i] = a0 * sn[2 * i] + b0 * cs[2 * i];
          k1[2 * i + 1] = a1 * cs[2 * i + 1] - b1 * sn[2 * i + 1]; k2[2 * i + 1] = a1 * sn[2 * i + 1] + b1 * cs[2 * i + 1]; }
      u32x4 o1, o2; o1.x = pk2(k1[0], k1[1]); o1.y = pk2(k1[2], k1[3]); o1.z = pk2(k1[4], k1[5]); o1.w = pk2(k1[6], k1[7]);
      o2.x = pk2(k2[0], k2[1]); o2.y = pk2(k2[2], k2[3]); o2.z = pk2(k2[4], k2[5]); o2.w = pk2(k2[6], k2[7]);
      *(u32x4*)(KS + j * 72 + c4 * 8) = o1; *(u32x4*)(KS + j * 72 + 32 + c4 * 8) = o2;
      if (!R2) { bf16* KTF = (bf16*)(lds + R_KTF); bf16* KTB = (bf16*)(lds + R_KTB);
          const float df = exp2f(l2f * (float)(127 - j)), db = exp2f(l2b * (float)j);
#pragma unroll
          for (int i = 0; i < 8; ++i) { KTF[(c4 * 8 + i) * 136 + j] = (bf16)f2bf(k1[i] * df); KTF[(32 + c4 * 8 + i) * 136 + j] = (bf16)f2bf(k2[i] * df);
              KTB[(c4 * 8 + i) * 136 + j] = (bf16)f2bf(k1[i] * db); KTB[(32 + c4 * 8 + i) * 136 + j] = (bf16)f2bf(k2[i] * db); } } }
    {
      const unsigned vu[8] = {va.x, va.y, va.z, va.w, vb.x, vb.y, vb.z, vb.w};
#pragma unroll
      for (int i = 0; i < 8; ++i) { VT[(c4 * 16 + 2 * i) * 136 + j] = (bf16)(vu[i] & 0xffffu); VT[(c4 * 16 + 2 * i + 1) * 136 + j] = (bf16)(vu[i] >> 16); } }
    if (R2) { bf16* QS = (bf16*)(lds + R_QS);
      const unsigned qau[4] = {qa.x, qa.y, qa.z, qa.w}, qbu[4] = {qb.x, qb.y, qb.z, qb.w};
      float q1[8], q2[8];
#pragma unroll
      for (int i = 0; i < 4; ++i) { const float a0 = bflo(qau[i]), a1 = bfhi(qau[i]), b0 = bflo(qbu[i]), b1 = bfhi(qbu[i]);
          q1[2 * i] = (a0 * cs[2 * i] - b0 * sn[2 * i]) * 0.125f; q2[2 * i] = (a0 * sn[2 * i] + b0 * cs[2 * i]) * 0.125f;
          q1[2 * i + 1] = (a1 * cs[2 * i + 1] - b1 * sn[2 * i + 1]) * 0.125f; q2[2 * i + 1] = (a1 * sn[2 * i + 1] + b1 * cs[2 * i + 1]) * 0.125f; }
      u32x4 o1, o2; o1.x = pk2(q1[0], q1[1]); o1.y = pk2(q1[2], q1[3]); o1.z = pk2(q1[4], q1[5]); o1.w = pk2(q1[6], q1[7]);
      o2.x = pk2(q2[0], q2[1]); o2.y = pk2(q2[2], q2[3]); o2.z = pk2(q2[4], q2[5]); o2.w = pk2(q2[6], q2[7]);
      *(u32x4*)(QS + j * 72 + c4 * 8) = o1; *(u32x4*)(QS + j * 72 + 32 + c4 * 8) = o2; }
}

__device__ __forceinline__ void ret1_task(const Params& p_, int l, int task, unsigned char* lds) {
    const Params p = *kparams(); (void)p_;
    const int n = task & 31, h = (task >> 5) & 7, b = task >> 8;
    const float xf = p.rl_f[l * 8 + h], xb = p.rl_b[l * 8 + h];
    const float l2f = -log1pf(expf(-xf)) * 1.4426950408889634f, l2b = -log1pf(expf(-xb)) * 1.4426950408889634f;
    ret_stage<false>(p, b, h, n, lds, l2f, l2b);
    __syncthreads();
    const int tid = otid(), lane = tid & 63, w = tid >> 6, fr = lane & 15, fq = lane >> 4, dir = w >> 2, et = w & 3;
    const bf16* VT = (const bf16*)(lds + R_VT); const bf16* KT = (const bf16*)(lds + (dir ? R_KTB : R_KTF));
    bf16x8v a[4];
#pragma unroll
    for (int ks = 0; ks < 4; ++ks) a[ks] = *(const bf16x8v*)(VT + (16 * et + fr) * 136 + 32 * ks + 8 * fq);
    float* dst = (float*)(p.ws + WS_KV) + ((size_t)((dir * 2 + b) * 8 + h) * 32 + n) * 4096;
#pragma unroll
    for (int dt = 0; dt < 4; ++dt) { f32x4 acc = {0.f, 0.f, 0.f, 0.f};
#pragma unroll
        for (int ks = 0; ks < 4; ++ks) { const bf16x8v bfr = *(const bf16x8v*)(KT + (16 * dt + fr) * 136 + 32 * ks + 8 * fq); acc = MFMA16(a[ks], bfr, acc); }
#pragma unroll
        for (int r = 0; r < 4; ++r) dst[(16 * et + 4 * fq + r) * 64 + 16 * dt + fr] = acc[r]; }
    __syncthreads();
}

__device__ __forceinline__ void ret2_task(const Params& p_, int l, int task, unsigned char* lds) {
    const Params p = *kparams(); (void)p_;
    const int n = task & 31, h = (task >> 5) & 7, b = task >> 8;
    const float xf = p.rl_f[l * 8 + h], xb = p.rl_b[l * 8 + h];
    const float l2f = -log1pf(expf(-xf)) * 1.4426950408889634f, l2b = -log1pf(expf(-xb)) * 1.4426950408889634f;
    ret_stage<true>(p, b, h, n, lds, l2f, l2b);
    const int tid = otid(), lane = tid & 63, w = tid >> 6, fr = lane & 15, fq = lane >> 4;
    {
      const float gfC = exp2f(l2f * 128.f), gbC = exp2f(l2b * 128.f);
      const float* KVf = (const float*)(p.ws + WS_KV) + ((size_t)((0 * 2 + b) * 8 + h) * 32) * 4096 + tid * 8;
      const float* KVb = (const float*)(p.ws + WS_KV) + ((size_t)((1 * 2 + b) * 8 + h) * 32) * 4096 + tid * 8;
      f32x4 f0 = {0.f, 0.f, 0.f, 0.f}, f1 = f0, g0 = f0, g1 = f0;
      { float c0 = 1.f; int m = n - 1;
        for (; m >= 7; m -= 8) { f32x4 xa[8], xb[8];
#pragma unroll
            for (int j = 0; j < 8; ++j) { xa[j] = *(const f32x4*)(KVf + (size_t)(m - j) * 4096); xb[j] = *(const f32x4*)(KVf + (size_t)(m - j) * 4096 + 4); }
            asm volatile("" ::: "memory");
#pragma unroll
            for (int j = 0; j < 8; ++j) { f0 += xa[j] * c0; f1 += xb[j] * c0; c0 *= gfC; } }
        for (; m >= 0; --m) { const f32x4 x0 = *(const f32x4*)(KVf + (size_t)m * 4096), x1 = *(const f32x4*)(KVf + (size_t)m * 4096 + 4); f0 += x0 * c0; f1 += x1 * c0; c0 *= gfC; } }
      { float c0 = 1.f; int m = n + 1;
        for (; m + 7 < 32; m += 8) { f32x4 xa[8], xb[8];
#pragma unroll
            for (int j = 0; j < 8; ++j) { xa[j] = *(const f32x4*)(KVb + (size_t)(m + j) * 4096); xb[j] = *(const f32x4*)(KVb + (size_t)(m + j) * 4096 + 4); }
            asm volatile("" ::: "memory");
#pragma unroll
            for (int j = 0; j < 8; ++j) { g0 += xa[j] * c0; g1 += xb[j] * c0; c0 *= gbC; } }
        for (; m < 32; ++m) { const f32x4 x0 = *(const f32x4*)(KVb + (size_t)m * 4096), x1 = *(const f32x4*)(KVb + (size_t)m * 4096 + 4); g0 += x0 * c0; g1 += x1 * c0; c0 *= gbC; } }
      const int e = tid >> 3, d0 = (tid & 7) * 8; u32x4 o;
      o.x = pk2(f0[0], f0[1]); o.y = pk2(f0[2], f0[3]); o.z = pk2(f1[0], f1[1]); o.w = pk2(f1[2], f1[3]); *(u32x4*)((bf16*)(lds + R_STF) + e * 72 + d0) = o;
      o.x = pk2(g0[0], g0[1]); o.y = pk2(g0[2], g0[3]); o.z = pk2(g1[0], g1[1]); o.w = pk2(g1[2], g1[3]); *(u32x4*)((bf16*)(lds + R_STB) + e * 72 + d0) = o; }
    __syncthreads();
    const bf16* QS = (const bf16*)(lds + R_QS); const bf16* KS = (const bf16*)(lds + R_KS); const bf16* VT = (const bf16*)(lds + R_VT);
    const bf16* STF = (const bf16*)(lds + R_STF); const bf16* STB = (const bf16*)(lds + R_STB);
    bf16x8v qf[2];
#pragma unroll
    for (int ks = 0; ks < 2; ++ks) qf[ks] = *(const bf16x8v*)(QS + (16 * w + fr) * 72 + 32 * ks + 8 * fq);
    const int ai = 16 * w + fr;
    unsigned pp[8][2];
#pragma unroll
    for (int jt = 0; jt < 8; ++jt) { f32x4 acc = {0.f, 0.f, 0.f, 0.f};
#pragma unroll
        for (int ks = 0; ks < 2; ++ks) { const bf16x8v kf = *(const bf16x8v*)(KS + (16 * jt + fr) * 72 + 32 * ks + 8 * fq); acc = MFMA16(kf, qf[ks], acc); }
        float sc[4];
#pragma unroll
        for (int r = 0; r < 4; ++r) { const int aj = 16 * jt + 4 * fq + r; const float wg = (aj <= ai) ? exp2f(l2f * (float)(ai - aj)) : exp2f(l2b * (float)(aj - ai)); sc[r] = acc[r] * wg; }
        pp[jt][0] = pk2(sc[0], sc[1]); pp[jt][1] = pk2(sc[2], sc[3]); }
    const float qdf = exp2f(l2f * (float)(ai + 1)), qdb = exp2f(l2b * (float)(128 - ai));
    f32x4 tot[4]; float ss = 0.f;
#pragma unroll
    for (int et = 0; et < 4; ++et) { f32x4 o = {0.f, 0.f, 0.f, 0.f}, cfa = o, cba = o;
#pragma unroll
        for (int t = 0; t < 4; ++t) { const u32x2 vlo = *(const u32x2*)(VT + (16 * et + fr) * 136 + 32 * t + 4 * fq), vhi = *(const u32x2*)(VT + (16 * et + fr) * 136 + 32 * t + 16 + 4 * fq);
            o = MFMA16(mk8(vlo.x, vlo.y, vhi.x, vhi.y), mk8(pp[2 * t][0], pp[2 * t][1], pp[2 * t + 1][0], pp[2 * t + 1][1]), o); }
#pragma unroll
        for (int ks = 0; ks < 2; ++ks) { const bf16x8v sf = *(const bf16x8v*)(STF + (16 * et + fr) * 72 + 32 * ks + 8 * fq), sb = *(const bf16x8v*)(STB + (16 * et + fr) * 72 + 32 * ks + 8 * fq);
            cfa = MFMA16(sf, qf[ks], cfa); cba = MFMA16(sb, qf[ks], cba); }
        tot[et] = o + cfa * qdf + cba * qdb;
        ss += (tot[et][0] * tot[et][0] + tot[et][1] * tot[et][1]) + (tot[et][2] * tot[et][2] + tot[et][3] * tot[et][3]); }
    ss += __shfl_xor(ss, 16); ss += __shfl_xor(ss, 32);
    const float rs = rsqrtf(ss * (1.f / 64.f) + 1e-6f);
    const size_t tok = (size_t)b * SEQ + n * 128 + ai;
    const bf16* Z = (const bf16*)(p.ws + WS_Z); bf16* CAT = (bf16*)(p.ws + WS_CAT);
#pragma unroll
    for (int et = 0; et < 4; ++et) { const u32x2 gz = *(const u32x2*)(Z + tok * DIN + 9 * DG + h * 64 + 16 * et + 4 * fq); u32x2 o;
        o.x = pk2(tot[et][0] * rs * silu_f(bflo(gz.x)), tot[et][1] * rs * silu_f(bfhi(gz.x))); o.y = pk2(tot[et][2] * rs * silu_f(bflo(gz.y)), tot[et][3] * rs * silu_f(bfhi(gz.y)));
        *(u32x2*)(CAT + tok * DM + 1024 + h * 64 + 16 * et + 4 * fq) = o; }
    __syncthreads();
}

__device__ __forceinline__ void na2_task(const Params& p_, int l, int task, unsigned char* lds) {
    const Params p = *kparams(); (void)p_;
    const int tid = otid(), lane = tid & 63, w = tid >> 6, fr = lane & 15, fq = lane >> 4;
    const int hp = task & 3, rq = (task >> 2) & 63, b = task >> 8;
    const int row_start = min(max(rq - 4, 0), 56);
    const bf16* Z = (const bf16*)(p.ws + WS_Z); bf16* CAT = (bf16*)(p.ws + WS_CAT);
    bf16* VT = (bf16*)lds; float* BI = (float*)(lds + 133120);
    for (int i = tid; i < 930; i += NTHR) BI[i] = p.na_bias[(size_t)(l * 8 + hp * 2) * 465 + i];
    { const int pair = lane & 31, chunk = (lane >> 5) + 2 * (w & 3), hh = w >> 2, h = hp * 2 + hh;
      unsigned* VTd = (unsigned*)(VT + (size_t)hh * 64 * 520);
      u32x4 xs[8], ys[8];
#pragma unroll
      for (int a = 0; a < 8; ++a) { const size_t tok = (size_t)b * SEQ + (row_start + a) * 64 + 2 * pair;
          const bf16* src = Z + tok * DIN + 4 * DG + h * 64 + chunk * 8; xs[a] = *(const u32x4*)src; ys[a] = *(const u32x4*)(src + DIN); }
      asm volatile("" ::: "memory");
#pragma unroll
      for (int a = 0; a < 8; ++a) { const unsigned xu[4] = {xs[a].x, xs[a].y, xs[a].z, xs[a].w}, yu[4] = {ys[a].x, ys[a].y, ys[a].z, ys[a].w};
#pragma unroll
          for (int i = 0; i < 4; ++i) { VTd[(chunk * 8 + 2 * i) * 260 + a * 32 + pair] = (xu[i] & 0xffffu) | (yu[i] << 16);
              VTd[(chunk * 8 + 2 * i + 1) * 260 + a * 32 + pair] = (xu[i] >> 16) | (yu[i] & 0xffff0000u); } } }
    __syncthreads();
    const int hh = w >> 2, h = hp * 2 + hh, qb = w & 3, ct0 = (qb >= 2) ? 1 : 0;
    const int c = 16 * qb + fr; const size_t qtok = (size_t)b * SEQ + rq * 64 + c;
    bf16x8v qf[2];
#pragma unroll
    for (int ks = 0; ks < 2; ++ks) qf[ks] = *(const bf16x8v*)(Z + qtok * DIN + 2 * DG + h * 64 + 32 * ks + 8 * fq);
    const int col_start = min(max(c - 8, 0), 48);
    const float* bi = BI + hh * 465;
    float sc[24][4]; float mx = -1e30f;
#pragma unroll
    for (int hf = 0; hf < 2; ++hf) {
        bf16x8v kfr[12][2];
#pragma unroll
        for (int i = 0; i < 12; ++i) { const int a = 4 * hf + i / 3, ci = i % 3;
            const size_t ktok = (size_t)b * SEQ + (row_start + a) * 64 + 16 * (ct0 + ci) + fr;
#pragma unroll
            for (int ks = 0; ks < 2; ++ks) kfr[i][ks] = *(const bf16x8v*)(Z + ktok * DIN + 3 * DG + h * 64 + 32 * ks + 8 * fq); }
        asm volatile("" ::: "memory");
#pragma unroll
        for (int i = 0; i < 12; ++i) { const int a = 4 * hf + i / 3, ci = i % 3, kt = a * 3 + ci;
            f32x4 acc = {0.f, 0.f, 0.f, 0.f};
#pragma unroll
            for (int ks = 0; ks < 2; ++ks) acc = MFMA16(kfr[i][ks], qf[ks], acc);
            const int dr = row_start + a - rq;
#pragma unroll
            for (int r = 0; r < 4; ++r) { const int kc = 16 * (ct0 + ci) + 4 * fq + r, rel = kc - col_start, dc = kc - c;
                float v = acc[r] * 0.125f + bi[(dr + 7) * 31 + min(max(dc + 15, 0), 30)];
                v = (rel >= 0 && rel < 16) ? v : -1e30f; sc[kt][r] = v; mx = fmaxf(mx, v); } }
    }
    mx = fmaxf(mx, __shfl_xor(mx, 16)); mx = fmaxf(mx, __shfl_xor(mx, 32));
    float sum = 0.f; unsigned pp[24][2];
#pragma unroll
    for (int kt = 0; kt < 24; ++kt) { const float e0 = __expf(sc[kt][0] - mx), e1 = __expf(sc[kt][1] - mx), e2 = __expf(sc[kt][2] - mx), e3 = __expf(sc[kt][3] - mx);
        sum += (e0 + e1) + (e2 + e3); pp[kt][0] = pk2(e0, e1); pp[kt][1] = pk2(e2, e3); }
    sum += __shfl_xor(sum, 16); sum += __shfl_xor(sum, 32);
    const float inv = 1.f / sum;
    const bf16* VTh = VT + (size_t)hh * 64 * 520;
#pragma unroll
    for (int dt = 0; dt < 4; ++dt) { f32x4 o = {0.f, 0.f, 0.f, 0.f};
#pragma unroll
        for (int t = 0; t < 12; ++t) { const int k0 = 2 * t, k1 = 2 * t + 1, a0 = k0 / 3, c0 = k0 % 3, a1 = k1 / 3, c1 = k1 % 3;
            const u32x2 vlo = *(const u32x2*)(VTh + (16 * dt + fr) * 520 + a0 * 64 + 16 * (ct0 + c0) + 4 * fq), vhi = *(const u32x2*)(VTh + (16 * dt + fr) * 520 + a1 * 64 + 16 * (ct0 + c1) + 4 * fq);
            o = MFMA16(mk8(vlo.x, vlo.y, vhi.x, vhi.y), mk8(pp[k0][0], pp[k0][1], pp[k1][0], pp[k1][1]), o); }
        const u32x2 gz = *(const u32x2*)(Z + qtok * DIN + 5 * DG + h * 64 + 16 * dt + 4 * fq); u32x2 ov;
        ov.x = pk2(o[0] * inv * silu_f(bflo(gz.x)), o[1] * inv * silu_f(bfhi(gz.x))); ov.y = pk2(o[2] * inv * silu_f(bflo(gz.y)), o[3] * inv * silu_f(bfhi(gz.y)));
        *(u32x2*)(CAT + qtok * DM + 512 + h * 64 + 16 * dt + 4 * fq) = ov; }
    __syncthreads();
}

__device__ __forceinline__ void conv_task(const Params& p_, int l, int task, unsigned char* lds) {
    const Params p = *kparams(); (void)p_;
    const int tid = otid(), lane = tid & 63, wave = tid >> 6;
    float* us = (float*)lds; float* ys = us + 46 * 512;
    const bf16* Z = (const bf16*)(p.ws + WS_Z);
    const int b = task >> 8, t0 = (task & 255) * 16;
    { u32x4 av[6], gv[6];
#pragma unroll
      for (int it = 0; it < 6; ++it) { const int idx = tid + it * NTHR, tt = idx >> 6, cc = (idx & 63) * 8, tok = t0 - 15 + tt;
          av[it] = (u32x4){0u, 0u, 0u, 0u}; gv[it] = av[it];
          if (idx < 46 * 64 && tok >= 0 && tok < SEQ) { const bf16* zr = Z + (size_t)(b * SEQ + tok) * DIN; av[it] = *(const u32x4*)(zr + 10 * DG + cc); gv[it] = *(const u32x4*)(zr + 11 * DG + cc); } }
      asm volatile("" ::: "memory");
#pragma unroll
      for (int it = 0; it < 6; ++it) { const int idx = tid + it * NTHR, tt = idx >> 6, cc = (idx & 63) * 8;
          if (idx < 46 * 64) { const u32x4 a = av[it], g = gv[it]; f32x4 u0, u1;
              u0[0] = bflo(a.x) / (1.f + __expf(-bflo(g.x))); u0[1] = bfhi(a.x) / (1.f + __expf(-bfhi(g.x))); u0[2] = bflo(a.y) / (1.f + __expf(-bflo(g.y))); u0[3] = bfhi(a.y) / (1.f + __expf(-bfhi(g.y)));
              u1[0] = bflo(a.z) / (1.f + __expf(-bflo(g.z))); u1[1] = bfhi(a.z) / (1.f + __expf(-bfhi(g.z))); u1[2] = bflo(a.w) / (1.f + __expf(-bflo(g.w))); u1[3] = bfhi(a.w) / (1.f + __expf(-bfhi(g.w)));
              *(f32x4*)(us + tt * 512 + cc) = u0; *(f32x4*)(us + tt * 512 + cc + 4) = u1; } } }
    float w[31];
#pragma unroll
    for (int k = 0; k < 31; ++k) w[k] = p.conv_w[(size_t)(l * 31 + k) * DG + tid];
    const float cb = p.conv_b[l * DG + tid];
    __syncthreads();
    for (int t = 0; t < 16; ++t) { float acc = cb;
#pragma unroll
        for (int k = 0; k < 31; ++k) acc += w[k] * us[(t + k) * 512 + tid];
        ys[t * 512 + tid] = acc; }
    __syncthreads();
#pragma unroll
    for (int tw = 0; tw < 2; ++tw) { const int t = wave + 8 * tw; float v[8]; float s = 0.f;
#pragma unroll
        for (int j = 0; j < 8; ++j) { v[j] = ys[t * 512 + lane + 64 * j]; s += v[j]; }
        const float mu = wave_sum(s) * (1.f / 512.f); float q = 0.f;
#pragma unroll
        for (int j = 0; j < 8; ++j) { v[j] -= mu; q += v[j] * v[j]; }
        const float rstd = rsqrtf(wave_sum(q) * (1.f / 512.f) + 1e-6f);
        bf16* orow = (bf16*)(p.ws + WS_CVH) + (size_t)(b * SEQ + t0 + t) * DG;
#pragma unroll
        for (int j = 0; j < 8; ++j) { const int ch = lane + 64 * j; const float y = v[j] * rstd * p.ln_g[l * DG + ch] + p.ln_b[l * DG + ch]; orow[ch] = (bf16)f2bf(silu_f(y)); } }
    __syncthreads();
}

__device__ __forceinline__ void ph_mixA(const Params& p, int l, unsigned char* lds) {
    const int G = gridDim.x, bid = obid();
    for (int t = bid; t < 512 * REP_R1; t += G) ret1_task(p, l, t & 511, lds);
    if (G == 256 && REP_NA == 1) {
        if (bid < 128) na2_task(p, l, bid, lds);
        else for (int i = 0; i < 3; ++i) na2_task(p, l, 128 + (bid - 128) * 3 + i, lds);
    } else for (int t = bid; t < 512 * REP_NA; t += G) na2_task(p, l, t & 511, lds);
    for (int t = bid; t < 512 * REP_CV; t += G) conv_task(p, l, t & 511, lds);
}

__device__ __forceinline__ void ph_fold(const Params& p_) {
    const Params p = *kparams(); (void)p_;
    const bf16* PQ = (const bf16*)(p.ws + WS_PQT); bf16* PQF = (bf16*)(p.ws + WS_PQF);
    for (int e = obid() * NTHR + otid(); e < NB * DG * 2 * 256; e += gridDim.x * NTHR) {
        const int row = e >> 8, s0 = (e & 255) * 8, pq = row & 1;
        const bf16* src = PQ + (size_t)row * 4096;
        const u32x4 own = *(const u32x4*)(src + s0), low = *(const u32x4*)(src + 4096 - s0 - 8);
        const float top = (s0 == 0) ? 0.f : bf2f(src[4096 - s0]);
        const float sg = pq ? -1.f : 1.f;
        float o[8];
        o[0] = bflo(own.x) + sg * top;            o[1] = bfhi(own.x) + sg * bfhi(low.w);
        o[2] = bflo(own.y) + sg * bflo(low.w);    o[3] = bfhi(own.y) + sg * bfhi(low.z);
        o[4] = bflo(own.z) + sg * bflo(low.z);    o[5] = bfhi(own.z) + sg * bfhi(low.y);
        o[6] = bflo(own.w) + sg * bflo(low.y);    o[7] = bfhi(own.w) + sg * bfhi(low.x);
        if (s0 == 0 && pq) o[0] = 0.f;
        u32x4 w; w.x = pk2(o[0], o[1]); w.y = pk2(o[2], o[3]); w.z = pk2(o[4], o[5]); w.w = pk2(o[6], o[7]);
        *(u32x4*)(PQF + (size_t)row * 2048 + s0) = w;
    }
}
__device__ __forceinline__ void ph_combine(const Params& p_) {
    const Params p = *kparams(); (void)p_;
    const float* Ce = (const float*)(p.ws + WS_PART); const float* So = Ce + (size_t)2 * 2304 * 512;
    bf16* CAT = (bf16*)(p.ws + WS_CAT); const bf16* Z = (const bf16*)(p.ws + WS_Z); const bf16* PQ = (const bf16*)(p.ws + WS_PQT);
    for (int e = obid() * NTHR + otid(); e < MTOK * DG / 4; e += gridDim.x * NTHR) {
        const int row = e >> 7, c4 = (e & 127) * 4, b = row >> 12, k = row & 4095, kk = (k <= 2048) ? k : 4096 - k;
        f32x4 s = *(const f32x4*)(Ce + ((size_t)b * 2304 + kk) * 512 + c4);
        if (kk != 0 && kk != 2048) { const f32x4 so = *(const f32x4*)(So + ((size_t)b * 2048 + kk) * 512 + c4); s = (k <= 2048) ? s - so : s + so; }
        const float alt = (k & 1) ? -1.f : 1.f;
#pragma unroll
        for (int j = 0; j < 4; ++j) s[j] += alt * bf2f(PQ[((size_t)(b * 512 + c4 + j) * 2) * 4096 + 2048]);
        const u32x2 gz = *(const u32x2*)(Z + (size_t)row * DIN + DG + c4);
        u32x2 w; w.x = pk2(s[0] * silu_f(bflo(gz.x)), s[1] * silu_f(bfhi(gz.x))); w.y = pk2(s[2] * silu_f(bflo(gz.y)), s[3] * silu_f(bfhi(gz.y)));
        *(u32x2*)(CAT + (size_t)row * DM + c4) = w;
    }
}

#define XB_TMO      128
#define XB_XCNT(j)  (256  + 64 * (j))
#define XB_XSUB(j)  (1280 + 64 * (j))
#define XB_XGEN(j)  (2304 + 64 * (j))
#define XB_TOP      3328
#define XB_TOPGEN   3392
#define XCD_BAR_WORDS 3456
#define XB_SPIN_CAP (1u << 20)
__device__ __forceinline__ unsigned xb_ld(unsigned* p)              { return __hip_atomic_load(p, __ATOMIC_RELAXED, __HIP_MEMORY_SCOPE_AGENT); }
__device__ __forceinline__ unsigned xb_add(unsigned* p, unsigned v) { return __hip_atomic_fetch_add(p, v, __ATOMIC_RELAXED, __HIP_MEMORY_SCOPE_AGENT); }
__device__ __forceinline__ unsigned xb_xcc_id() { return (unsigned)__builtin_amdgcn_s_getreg((3 << 11) | 20) & 0xFu; }
#define XB_SPIN(cond, bar) do { unsigned _sp = 0; while (cond) { __builtin_amdgcn_s_sleep(1); \
    if ((++_sp & 255u) == 0u) { if (xb_ld(&(bar)[XB_TMO])) break; if (_sp > XB_SPIN_CAP) { atomicAdd(&(bar)[XB_TMO], 1u); break; } } } } while (0)
struct XcdBarrier { unsigned* bar; unsigned x; volatile PG8_LAS unsigned* st; };
__device__ __forceinline__ XcdBarrier xcd_barrier_post(unsigned* bar, volatile PG8_LAS unsigned* st) {
    XcdBarrier b; b.bar = bar; b.x = xb_xcc_id(); b.st = st;
    if (otid() == 0) (void)xb_add(&bar[XB_XCNT(b.x)], 1u);
    return b;
}
__device__ __forceinline__ void xcd_barrier_complete(unsigned* bar, unsigned x, unsigned& nloc, unsigned& nx) {
    const unsigned G = gridDim.x * gridDim.y * gridDim.z;
    unsigned sum, cnt, mine, sp = 0u;
    for (;;) {
        sum = 0u; cnt = 0u; mine = 0u;
#pragma unroll
        for (unsigned j = 0; j < 16; ++j) { const unsigned c = xb_ld(&bar[XB_XCNT(j)]); sum += c; cnt += (c > 0u) ? 1u : 0u; mine = (j == x) ? c : mine; }
        if (sum == G) break;
        __builtin_amdgcn_s_sleep(1);
        if ((++sp & 255u) == 0u) { if (xb_ld(&bar[XB_TMO])) break; if (sp > XB_SPIN_CAP) { atomicAdd(&bar[XB_TMO], 1u); break; } }
    }
    nloc = mine > 0u ? mine : 1u; nx = cnt > 0u ? cnt : 1u;
}
__device__ __forceinline__ void xcd_barrier(const XcdBarrier& b) {
    asm volatile("s_waitcnt vmcnt(0)" ::: "memory");
    __syncthreads();
    if (otid() == 0) {
        unsigned* bar = b.bar;
        __builtin_amdgcn_s_waitcnt(0);
        unsigned nloc = b.st[0], nx = b.st[1];
        if (nloc == 0u) { xcd_barrier_complete(bar, b.x, nloc, nx); b.st[0] = nloc; b.st[1] = nx; }
        const unsigned old = xb_add(&bar[XB_XSUB(b.x)], 1u);
        const unsigned gen = old / nloc;
        if (old + 1u == (gen + 1u) * nloc) {
            __builtin_amdgcn_fence(__ATOMIC_RELEASE, "agent");
            asm volatile("s_waitcnt vmcnt(0)" ::: "memory");
            const unsigned og = xb_add(&bar[XB_TOP], 1u);
            const unsigned tg = og / nx;
            if (og + 1u == (tg + 1u) * nx) xb_add(&bar[XB_TOPGEN], 1u);
            else XB_SPIN(xb_ld(&bar[XB_TOPGEN]) == tg, bar);
            __builtin_amdgcn_fence(__ATOMIC_ACQUIRE, "agent");
            xb_add(&bar[XB_XGEN(b.x)], 1u);
            asm volatile("s_waitcnt vmcnt(0)" ::: "memory");
        } else {
            XB_SPIN(xb_ld(&bar[XB_XGEN(b.x)]) == gen, bar);
            __builtin_amdgcn_fence(__ATOMIC_ACQUIRE, "agent");
            asm volatile("s_waitcnt vmcnt(0)" ::: "memory");
        }
    }
    __syncthreads();
}

constexpr int NPH = 14;
__global__ void __launch_bounds__(NTHR) mega(Params p) {
    extern __shared__ __attribute__((aligned(16))) unsigned char lds[];
    cg::grid_group grid = cg::this_grid();
    PG8_LAS unsigned char* ldsl = (PG8_LAS unsigned char*)lds;
    const int lo = p.ph_lo, hi = p.ph_hi;
#define IN(k) (lo <= (k) && (k) < hi)
#define SEAM(k) do { if (IN(k) && IN((k) + 1)) { xcd_barrier(xb); } } while (0)
    bf16* Zb = (bf16*)(kparams()->ws + WS_Z); bf16* CAT = (bf16*)(kparams()->ws + WS_CAT);
    volatile PG8_LAS unsigned* xst = (volatile PG8_LAS unsigned*)(ldsl + LDS_BYTES - 16);
    { const int t0_ = otid(); if (t0_ < 4) xst[t0_] = 0u; }
    __syncthreads();
    XcdBarrier xb = xcd_barrier_post((unsigned*)(kparams()->ws + WS_BAR), xst);
    if (p.ph_lo < 0) grid.sync();
    if (IN(0)) REPEAT(REP_PRO) { ph_prologue(p, lds); __syncthreads(); }
    SEAM(0);
    if (IN(0) && IN(1)) for (int r_ = 1; r_ < REP_SUB; ++r_) xcd_barrier(xb);
#pragma unroll
    for (int l = 0; l < NL; ++l) {
        const int pb = 1 + 6 * l;
        const char* Wl = (const char*)(kparams()->ws + WS_WIN + (size_t)l * WROWS * DM * 2);
        if (IN(pb)) {
            if (l == 0) {
#pragma unroll
                for (int ll = 0; ll < NL; ++ll) {
                    SchedS S = make_sched(kparams()->ws + WS_WCS + (size_t)ll * 1024 * DG * 2, DG, kparams()->ws + WS_WFXB + (size_t)ll * DM * DG * 2, DG, 1024, DM, 32 * ll);
                    EpiZ E{(bf16*)(kparams()->ws + WS_WIN + ((size_t)ll * WROWS + 6656) * DM * 2), DM};
                    pg8::gemm_phase<EpiZ, SchedS, true>(ldsl, pg8::Gemm{DG, DG, DG}, S, E);
                }
            }
            REPEAT(REP_NORM) ph_norm(p, l);
        }
        SEAM(pb);
        if (IN(pb + 1)) REPEAT(REP_Z) {
            SchedZ S; S.o.init(MTOK, 24 * 256, (int)gridDim.x, obid()); S.A = (const char*)(kparams()->ws + WS_U); S.B = Wl; S.late = 0;
            EpiZ2 E{Zb, (bf16*)(kparams()->ws + WS_PQT)};
            pg8::gemm_phase<EpiZ2, SchedZ, true>(ldsl, pg8::Gemm{DM, DM, DM}, S, E);
        }
        SEAM(pb + 1);
        if (IN(pb + 2)) {
            {
                SchedZ S; S.o.init(MTOK, 4 * 256, (int)gridDim.x, obid()); S.A = (const char*)(kparams()->ws + WS_U); S.B = Wl; S.late = 1;
                EpiZ2 E{Zb, (bf16*)(kparams()->ws + WS_PQT)};
                pg8::gemm_phase<EpiZ2, SchedZ, true>(ldsl, pg8::Gemm{DM, DM, DM}, S, E);
            }
            REPEAT(REP_MIX) ph_mixA(p, l, lds);
            ph_fold(p);
        }
        SEAM(pb + 2);
        if (IN(pb + 3)) REPEAT(REP_P3) {
            const int G_ = (int)gridDim.x, b_ = obid(); const bool bal = (G_ == 256);
            {
                SchedDFT S{(const char*)(kparams()->ws + WS_DC), (const char*)(kparams()->ws + WS_DS), (const char*)(kparams()->ws + WS_PQF), G_, b_};
                EpiPart E{(float*)(kparams()->ws + WS_PART)};
                pg8::gemm_phase<EpiPart, SchedDFT, true>(ldsl, pg8::Gemm{2048, 4096, 2048}, S, E); }
            {
                SchedS S = make_sched(kparams()->ws + WS_CVH, DG, kparams()->ws + WS_WPW + (size_t)l * DG * DG * 2, DG, MTOK, DG, 68);
                EpiGate E{CAT, Zb, 1536, 12 * DG};
                pg8::gemm_phase<EpiGate, SchedS, true>(ldsl, pg8::Gemm{DG, DG, DG}, S, E); }
            if (bal && REP_R2 == 1) { for (int t = b_ - 68; t >= 0 && t < 512; t += 188) ret2_task(p, l, t, lds); }
            else for (int t = b_; t < 512 * REP_R2; t += G_) ret2_task(p, l, t & 511, lds);
        }
        SEAM(pb + 3);
        if (IN(pb + 4)) REPEAT(REP_CMB) ph_combine(p);
        SEAM(pb + 4);
        if (IN(pb + 5)) REPEAT(l == 0 ? REP_OUT : 1) {
            SchedS S = make_sched(CAT, DM, kparams()->ws + WS_WOUT + (size_t)l * DM * DM * 2, DM, MTOK, DM);
            EpiRes E{(l == 0) ? kparams()->x : kparams()->out, kparams()->out, (const float*)(kparams()->ws + WS_MOD) + (size_t)l * 2 * 6144 + 4096};
            pg8::gemm_phase<EpiRes, SchedS, true>(ldsl, pg8::Gemm{DM, DM, DM}, S, E);
        }
        SEAM(pb + 5);
    }
    if (IN(NPH - 1)) ph_final(p);
#undef IN
#undef SEAM
}

extern "C" void kernel_launch(void* const* d_in, const int* in_sizes, int n_in, void* d_out, int out_size, void* d_ws, size_t ws_size, hipStream_t stream) {
    static int grid_blocks = 0;
    if (grid_blocks == 0) {
        if (n_in != 17 || ws_size < WS_END) { fprintf(stderr, "kernel_launch: n_in %d ws %zu (need %zu)\n", n_in, ws_size, (size_t)WS_END); grid_blocks = -1; return; }
        int dev = 0, cus = 0, per_cu = 0;
        hipGetDevice(&dev); hipDeviceGetAttribute(&cus, hipDeviceAttributeMultiprocessorCount, dev);
        if (hipFuncSetAttribute((const void*)mega, hipFuncAttributeMaxDynamicSharedMemorySize, LDS_BYTES) != hipSuccess) { fprintf(stderr, "hipFuncSetAttribute failed\n"); grid_blocks = -1; return; }
        if (hipOccupancyMaxActiveBlocksPerMultiprocessor(&per_cu, (const void*)mega, NTHR, LDS_BYTES) != hipSuccess || per_cu < 1) { fprintf(stderr, "occupancy query: %d\n", per_cu); per_cu = 1; }
        (void)hipGetLastError();
        grid_blocks = cus * 1;
    }
    if (grid_blocks < 0) return;
    Params p{};
    p.x = (const float*)d_in[0]; p.c = (const float*)d_in[1]; p.norm_g = (const float*)d_in[2]; p.w_ada = (const float*)d_in[3]; p.b_ada = (const float*)d_in[4];
    p.w_in = (const float*)d_in[5]; p.w_fft = (const float*)d_in[6]; p.na_bias = (const float*)d_in[7]; p.rl_f = (const float*)d_in[8]; p.rl_b = (const float*)d_in[9];
    p.conv_w = (const float*)d_in[10]; p.conv_b = (const float*)d_in[11]; p.ln_g = (const float*)d_in[12]; p.ln_b = (const float*)d_in[13]; p.w_pw = (const float*)d_in[14];
    p.w_out = (const float*)d_in[15]; p.final_g = (const float*)d_in[16];
    p.out = (float*)d_out; p.ws = (unsigned char*)d_ws;
#if ONE_LAUNCH
    if (hipMemsetAsync((char*)d_ws + WS_BAR, 0, 16384, stream) != hipSuccess) { fprintf(stderr, "memset of the barrier words failed\n"); return; }
    p.ph_lo = 0; p.ph_hi = NPH;
    void* args[] = {&p};
    hipError_t e = hipLaunchCooperativeKernel((const void*)mega, dim3(grid_blocks), dim3(NTHR), args, LDS_BYTES, stream);
    if (e != hipSuccess) fprintf(stderr, "cooperative launch failed: %s (grid %d)\n", hipGetErrorString(e), grid_blocks);
#else
    for (int ph = 0; ph < NPH; ++ph) { p.ph_lo = ph; p.ph_hi = ph + 1; hipLaunchKernelGGL(mega, dim3(grid_blocks), dim3(NTHR), LDS_BYTES, stream, p); }
#endif
}
```

```cpp
#include <hip/hip_runtime.h>
#include <hip/hip_cooperative_groups.h>
#include <cstdio>
#include <cstdint>
namespace cg = cooperative_groups;

#ifndef ONE_LAUNCH
#define ONE_LAUNCH 1
#endif

__device__ __forceinline__ int obid() { int b = (int)blockIdx.x; asm volatile("" : "+s"(b)); return b; }
__device__ __forceinline__ int otid() { int t; asm volatile("v_mov_b32 %0, %1" : "=v"(t) : "v"(threadIdx.x)); return t; }
namespace pg8 {
#define PG8_LAS __attribute__((address_space(3)))
typedef unsigned short bf16_t;
typedef short bf16x8 __attribute__((ext_vector_type(8)));
typedef float f32x4 __attribute__((ext_vector_type(4)));
typedef unsigned u32x4 __attribute__((ext_vector_type(4)));
constexpr int BM = 256, BK = 64, HALF = 128, HTB = HALF * BK * 2, STAGE_BYTES = 8 * HTB, NXCD = 8, WGM = 8;

__host__ __device__ __forceinline__ int lds_byte(int r, int c) { const int st = (r >> 4) * 2 + (c >> 5), rr = r & 15, cc = c & 31, ob = rr * 64 + cc * 2; return st * 1024 + (ob ^ (((ob >> 9) & 1) << 5)); }
__host__ __device__ __forceinline__ void stage_rc(int b, int& R, int& C) { const int st = b / 1024, sb = b % 1024, swz = sb ^ (((sb >> 9) & 1) << 5); R = (st >> 1) * 16 + swz / 64; C = (st & 1) * 32 + (swz % 64) / 2; }
__host__ __device__ __forceinline__ int perm32(int rho) { const int n = rho >> 4, i = rho & 15; return 8 * (i >> 2) + 4 * n + (i & 3); }

struct Unit { int pm, pn, aux, pad; const char* A; const char* B; };
struct Gemm { int lda, ldb, K; };

struct StaticOrder {
    int nM, nN, nwg, G, c;
    __host__ __device__ void init(int M, int N, int G_, int c_) { nM = M / BM; nN = N / BM; nwg = nM * nN; G = G_; c = c_; }
    __device__ bool next(int i, Unit& u) const {
        const long L = (long)i * G + c; if (L >= nwg) return false;
        int wgid = __builtin_amdgcn_readfirstlane((int)L); { const int q = nwg / NXCD, r = nwg % NXCD, xcd = wgid % NXCD, off = wgid / NXCD; wgid = (xcd < r ? xcd * (q + 1) : r * (q + 1) + (xcd - r) * q) + off; }
        const int nig = WGM * nN, gid = wgid / nig, fm = gid * WGM, gsz = (nM - fm) < WGM ? (nM - fm) : WGM;
        u.pm = __builtin_amdgcn_readfirstlane(fm + ((wgid % nig) % gsz)); u.pn = __builtin_amdgcn_readfirstlane((wgid % nig) / gsz); return true;
    }
};

__device__ __forceinline__ unsigned cvt_pk_bf16(float lo, float hi) { unsigned r; asm volatile("v_cvt_pk_bf16_f32 %0, %1, %2" : "=v"(r) : "v"(lo), "v"(hi)); return r; }

template <class Epi, class Sched, bool ALIGN_EPI>
__device__ __forceinline__ void gemm_phase(PG8_LAS unsigned char* lds, const Gemm g, const Sched& S, const Epi& E) {
    const int tid = otid(), wid = __builtin_amdgcn_readfirstlane(tid >> 6), lane = tid & 63, wr = wid >> 2, wc = wid & 3, fr = lane & 15, fq = lane >> 4;
    const int K = g.K, nt = K / BK;
    unsigned voffA[2], voffB[2];
#pragma unroll
    for (int i = 0; i < 2; ++i) { int R, C; stage_rc(tid * 16 + i * 8192, R, C); const int Rb = Epi::PERM ? ((R & ~31) + perm32(R & 31)) : R;
        voffA[i] = (unsigned)(R * g.lda + C) * 2u; voffB[i] = (unsigned)(Rb * g.ldb + C) * 2u; }
    const size_t kstep = (size_t)(BK * 2);
    const size_t hA = (size_t)HALF * g.lda * 2, hB = (size_t)HALF * g.ldb * 2;
    const unsigned ldsw = (unsigned)wid * 1024u;
    const int aoff = lds_byte(wr * 64 + fr, fq * 8), boff = lds_byte(wc * 32 + fr, fq * 8);
#define PG8_SA(b, h) (((b) * 2 + (h)) * HTB)
#define PG8_SB(b, h) ((4 + (b) * 2 + (h)) * HTB)
#define PG8_STAGE(bufoff, gbase, voff) do { _Pragma("unroll") for (int _i = 0; _i < 2; ++_i) \
        __builtin_amdgcn_global_load_lds((const unsigned*)((const char*)(gbase) + (voff)[_i]), (PG8_LAS unsigned*)(lds + (bufoff) + ldsw + _i * 8192), 16, 0, 0); } while (0)
#define PG8_LDA(dst, b, h) do { _Pragma("unroll") for (int m = 0; m < 4; ++m) _Pragma("unroll") for (int k = 0; k < 2; ++k) dst[m][k] = *(const PG8_LAS bf16x8*)(lds + PG8_SA(b, h) + aoff + m * 2048 + k * 1024); } while (0)
#define PG8_LDB(dst, b, h) do { _Pragma("unroll") for (int n = 0; n < 2; ++n) _Pragma("unroll") for (int k = 0; k < 2; ++k) dst[n][k] = *(const PG8_LAS bf16x8*)(lds + PG8_SB(b, h) + boff + n * 2048 + k * 1024); } while (0)
#define PG8_MMA(ai, bj, At, Bt) do { __builtin_amdgcn_s_setprio(1); _Pragma("unroll") for (int m = 0; m < 4; ++m) _Pragma("unroll") for (int n = 0; n < 2; ++n) _Pragma("unroll") for (int k = 0; k < 2; ++k) \
        acc[ai][bj][m][n] = __builtin_amdgcn_mfma_f32_16x16x32_bf16(Bt[n][k], At[m][k], acc[ai][bj][m][n], 0, 0, 0); __builtin_amdgcn_s_setprio(0); } while (0)
#define PG8_WAIT_V(n) asm volatile("s_waitcnt vmcnt(" #n ")" ::: "memory")
#define PG8_WAIT_L(n) asm volatile("s_waitcnt lgkmcnt(" #n ")" ::: "memory")
#define PG8_BAR __builtin_amdgcn_s_barrier()
#define PG8_SCHED __builtin_amdgcn_sched_barrier(0)
    Unit cur, nxt; int ui = 0;
    if (!S.next(0, cur)) return;
    f32x4 acc[2][2][4][2];
#pragma unroll
    for (int a = 0; a < 2; ++a)
#pragma unroll
        for (int b = 0; b < 2; ++b)
#pragma unroll
            for (int m = 0; m < 4; ++m)
#pragma unroll
                for (int n = 0; n < 2; ++n) acc[a][b][m][n] = (f32x4){0.f, 0.f, 0.f, 0.f};
    bf16x8 At[4][2], B0[2][2], B1[2][2];
    const char* cA = cur.A; const char* cB = cur.B;
    PG8_STAGE(PG8_SB(0, 0), cB, voffB); PG8_STAGE(PG8_SB(0, 1), cB + hB, voffB); PG8_STAGE(PG8_SA(0, 0), cA, voffA); PG8_STAGE(PG8_SA(0, 1), cA + hA, voffA);
    if (wr == 1) PG8_BAR;
    PG8_WAIT_V(2); PG8_BAR;
    PG8_STAGE(PG8_SB(1, 0), cB + kstep, voffB); PG8_STAGE(PG8_SA(1, 0), cA + kstep, voffA); PG8_STAGE(PG8_SB(1, 1), cB + hB + kstep, voffB);
    PG8_WAIT_V(6); PG8_BAR;
    for (;;) {
        const bool has_next = S.next(ui + 1, nxt);
        const char* nA = has_next ? nxt.A : cA; const char* nB = has_next ? nxt.B : cB;
        for (int t = 0; t < nt; t += 2) {
            const bool last = (t == nt - 2);
            const char* a1 = cA + (size_t)(t + 1) * kstep;
            const char* a2 = last ? nA : cA + (size_t)(t + 2) * kstep; const char* b2 = last ? nB : cB + (size_t)(t + 2) * kstep;
            const char* a3 = a2 + kstep; const char* b3 = b2 + kstep;
            PG8_LDB(B0, 0, 0); PG8_LDB(B1, 0, 1); PG8_SCHED; PG8_LDA(At, 0, 0); PG8_STAGE(PG8_SA(1, 1), a1 + hA, voffA);
            PG8_WAIT_V(8); PG8_WAIT_L(0); PG8_BAR; PG8_MMA(0, 0, At, B0); PG8_MMA(0, 1, At, B1); PG8_BAR; PG8_SCHED;
            PG8_LDA(At, 0, 1); PG8_STAGE(PG8_SB(0, 0), b2, voffB); PG8_STAGE(PG8_SB(0, 1), b2 + hB, voffB); PG8_STAGE(PG8_SA(0, 0), a2, voffA);
            PG8_WAIT_V(8); PG8_WAIT_L(0); PG8_BAR; PG8_MMA(1, 0, At, B0); PG8_MMA(1, 1, At, B1); PG8_BAR; PG8_SCHED;
            PG8_LDB(B0, 1, 0); PG8_LDB(B1, 1, 1); PG8_SCHED; PG8_LDA(At, 1, 0); PG8_STAGE(PG8_SA(0, 1), a2 + hA, voffA);
            PG8_WAIT_V(8); PG8_WAIT_L(0); PG8_BAR; PG8_MMA(0, 0, At, B0); PG8_MMA(0, 1, At, B1); PG8_BAR; PG8_SCHED;
            PG8_LDA(At, 1, 1); PG8_STAGE(PG8_SB(1, 0), b3, voffB); PG8_STAGE(PG8_SB(1, 1), b3 + hB, voffB); PG8_STAGE(PG8_SA(1, 0), a3, voffA);
            PG8_WAIT_V(8); PG8_WAIT_L(0); PG8_BAR; PG8_MMA(1, 0, At, B0); PG8_MMA(1, 1, At, B1); PG8_BAR; PG8_SCHED;
        }
        if constexpr (ALIGN_EPI) { if (wr == 0) PG8_BAR; }
        E(acc, cur, wr, wc, fr, fq);
        if (!has_next) break;
#pragma unroll
        for (int a = 0; a < 2; ++a)
#pragma unroll
            for (int b = 0; b < 2; ++b)
#pragma unroll
                for (int m = 0; m < 4; ++m)
#pragma unroll
                    for (int n = 0; n < 2; ++n) acc[a][b][m][n] = (f32x4){0.f, 0.f, 0.f, 0.f};
        cur = nxt; cA = nA; cB = nB; ++ui;
        if constexpr (ALIGN_EPI) { if (wr == 1) PG8_BAR; }
    }
    PG8_WAIT_V(0);
    if constexpr (!ALIGN_EPI) { if (wr == 0) PG8_BAR; }
    PG8_BAR;
#undef PG8_SA
#undef PG8_SB
#undef PG8_STAGE
#undef PG8_LDA
#undef PG8_LDB
#undef PG8_MMA
#undef PG8_WAIT_V
#undef PG8_WAIT_L
#undef PG8_BAR
#undef PG8_SCHED
}
}

typedef unsigned short bf16;
typedef float f32x4 __attribute__((ext_vector_type(4)));
typedef unsigned u32x4 __attribute__((ext_vector_type(4)));
typedef unsigned u32x2 __attribute__((ext_vector_type(2)));
constexpr int NB = 2, SEQ = 4096, DM = 2048, MTOK = NB * SEQ, DIN = 6656, DG = 512, NL = 2;
constexpr int LDS_BYTES = 147456;
constexpr int NTHR = 512;

constexpr int WROWS = 7680;
constexpr size_t WS_WIN = 0;
constexpr size_t WS_WOUT = WS_WIN + (size_t)NL * WROWS * DM * 2;
constexpr size_t WS_WCS = WS_WOUT + (size_t)NL * DM * DM * 2;
constexpr size_t WS_WFXB = WS_WCS + (size_t)NL * 1024 * DG * 2;
constexpr size_t WS_WPW = WS_WFXB + (size_t)NL * DM * DG * 2;
constexpr size_t WS_DC = WS_WPW + (size_t)NL * DG * DG * 2;
constexpr size_t WS_DS = WS_DC + (size_t)2304 * 2048 * 2;
constexpr size_t WS_PQF = WS_DS + (size_t)2048 * 2048 * 2;
constexpr size_t WS_ROPE = WS_PQF + (size_t)NB * DG * 2 * 2048 * 2;
constexpr size_t WS_MOD = WS_ROPE + (size_t)SEQ * 32 * 8;
constexpr size_t WS_U = WS_MOD + 131072;
constexpr size_t WS_PART = WS_U + (size_t)MTOK * DM * 2;
constexpr size_t WS_Z = WS_U + (size_t)4 * MTOK * DG * 4;
constexpr size_t WS_PQT = WS_Z + (size_t)MTOK * DIN * 2;
constexpr size_t WS_CVH = WS_PQT + (size_t)NB * DG * 2 * SEQ * 2;
constexpr size_t WS_CAT = WS_CVH + (size_t)MTOK * DG * 2;
constexpr size_t WS_KV = WS_CAT + (size_t)MTOK * DM * 2;
constexpr size_t WS_BAR = WS_KV + (size_t)2 * NB * 8 * 32 * 4096 * 4;
constexpr size_t WS_END = WS_BAR + 16384;

struct Params {
    const float* x; const float* c; const float* norm_g; const float* w_ada; const float* b_ada; const float* w_in; const float* w_fft; const float* na_bias;
    const float* rl_f; const float* rl_b; const float* conv_w; const float* conv_b; const float* ln_g; const float* ln_b; const float* w_pw; const float* w_out; const float* final_g;
    float* out; unsigned char* ws; int ph_lo, ph_hi;
};

#if defined(__HIP_DEVICE_COMPILE__)
typedef const __attribute__((address_space(4))) Params* KParams;
__device__ __forceinline__ KParams kparams() { KParams k = (KParams)__builtin_amdgcn_kernarg_segment_ptr(); asm volatile("" : "+s"(k)); return k; }
#else
typedef const Params* KParams;
__device__ __forceinline__ KParams kparams() { return nullptr; }
#endif
__device__ __forceinline__ unsigned f2bf(float f) { unsigned u = __float_as_uint(f); return (u + 0x7fffu + ((u >> 16) & 1u)) >> 16; }
__device__ __forceinline__ unsigned pk2(float lo, float hi) { return f2bf(lo) | (f2bf(hi) << 16); }
__device__ __forceinline__ float bf2f(bf16 b) { return __uint_as_float((unsigned)b << 16); }
__device__ __forceinline__ float bflo(unsigned u) { return __uint_as_float(u << 16); }
__device__ __forceinline__ float bfhi(unsigned u) { return __uint_as_float(u & 0xffff0000u); }
__device__ __forceinline__ float silu_f(float v) { return v / (1.f + __expf(-v)); }
__device__ __forceinline__ float wave_sum(float v) {
#pragma unroll
    for (int o = 1; o < 64; o <<= 1) v += __shfl_xor(v, o);
    return v;
}
__device__ __forceinline__ float wave_max(float v) {
#pragma unroll
    for (int o = 1; o < 64; o <<= 1) v = fmaxf(v, __shfl_xor(v, o));
    return v;
}

struct SchedS {
    pg8::StaticOrder o; const char* A; const char* B; size_t ta, tb;
    __device__ __forceinline__ bool next(int i, pg8::Unit& u) const { if (!o.next(i, u)) return false; u.A = A + (size_t)u.pm * ta; u.B = B + (size_t)u.pn * tb; u.aux = 0; return true; }
};
__device__ __forceinline__ SchedS make_sched(const void* A, int lda, const void* B, int ldb, int M, int N, int shift = 0) {
    SchedS s; s.o.init(M, N, (int)gridDim.x, (int)((obid() + gridDim.x - shift) % gridDim.x)); s.A = (const char*)A; s.B = (const char*)B; s.ta = (size_t)256 * lda * 2; s.tb = (size_t)256 * ldb * 2; return s;
}
struct SchedZ {
    pg8::StaticOrder o; const char* A; const char* B; int late;
    __device__ __forceinline__ bool next(int i, pg8::Unit& u) const { if (!o.next(i, u)) return false; const int jn = u.pn;
        u.pn = late ? (jn < 2 ? 2 + jn : 22 + jn) : (jn < 20 ? jn + 4 : jn + 6);
        u.A = A + (size_t)u.pm * (256 * DM * 2); u.B = B + (size_t)u.pn * (256 * DM * 2); u.aux = 0; return true; }
};
struct SchedDFT {
    const char* DC; const char* DSn; const char* PQF; int G, c;
    __device__ __forceinline__ bool next(int i, pg8::Unit& u) const {
        if (c < 0) return false;
        const int L = __builtin_amdgcn_readfirstlane(i * G + c); if (L >= 68) return false;
        const int b = L / 34, t = L % 34, odd = (t >= 18) ? 1 : 0, tt = odd ? t - 18 : t; u.pm = tt >> 1; u.pn = tt & 1; u.aux = b * 2 + odd;
        u.A = (odd ? DSn : DC) + (size_t)u.pm * (256 * 2048 * 2);
        u.B = PQF + ((size_t)(b * 512 + u.pn * 256) * 4096 + odd * 2048) * 2; return true;
    }
};

struct EpiZ {
    static constexpr bool PERM = true;
    bf16* O; int ldc;
    __device__ __forceinline__ void operator()(const pg8::f32x4 (&acc)[2][2][4][2], const pg8::Unit& u, int wr, int wc, int fr, int fq) const {
        const int row0 = u.pm * 256 + wr * 64 + fr, col0 = u.pn * 256 + wc * 32 + 8 * fq;
#pragma unroll
        for (int ai = 0; ai < 2; ++ai)
#pragma unroll
            for (int m = 0; m < 4; ++m) { bf16* rowp = O + (size_t)(row0 + ai * 128 + m * 16) * ldc + col0;
#pragma unroll
                for (int bj = 0; bj < 2; ++bj) { const pg8::f32x4 v0 = acc[ai][bj][m][0], v1 = acc[ai][bj][m][1]; u32x4 w;
                    w.x = pg8::cvt_pk_bf16(v0[0], v0[1]); w.y = pg8::cvt_pk_bf16(v0[2], v0[3]); w.z = pg8::cvt_pk_bf16(v1[0], v1[1]); w.w = pg8::cvt_pk_bf16(v1[2], v1[3]);
                    *(u32x4*)(rowp + bj * 128) = w; } }
    }
};
struct EpiZ2 {
    static constexpr bool PERM = true;
    bf16* O; bf16* PQ;
    __device__ __forceinline__ void operator()(const pg8::f32x4 (&acc)[2][2][4][2], const pg8::Unit& u, int wr, int wc, int fr, int fq) const {
        const int row0 = u.pm * 256 + wr * 64 + fr;
        if (u.pn < 26) { const int col0 = u.pn * 256 + wc * 32 + 8 * fq;
#pragma unroll
            for (int ai = 0; ai < 2; ++ai)
#pragma unroll
                for (int m = 0; m < 4; ++m) { bf16* rowp = O + (size_t)(row0 + ai * 128 + m * 16) * DIN + col0;
#pragma unroll
                    for (int bj = 0; bj < 2; ++bj) { const pg8::f32x4 v0 = acc[ai][bj][m][0], v1 = acc[ai][bj][m][1]; u32x4 w;
                        w.x = pg8::cvt_pk_bf16(v0[0], v0[1]); w.y = pg8::cvt_pk_bf16(v0[2], v0[3]); w.z = pg8::cvt_pk_bf16(v1[0], v1[1]); w.w = pg8::cvt_pk_bf16(v1[2], v1[3]);
                        *(u32x4*)(rowp + bj * 128) = w; } }
        } else { const int np0 = (u.pn - 26) * 256 + wc * 32 + 8 * fq;
#pragma unroll
            for (int bj = 0; bj < 2; ++bj) { const int np = np0 + bj * 128, pq = np >> 9, n = np & 511;
#pragma unroll
                for (int ai = 0; ai < 2; ++ai)
#pragma unroll
                    for (int m = 0; m < 4; ++m) { const int row = row0 + ai * 128 + m * 16, b = row >> 12, sq = row & 4095;
                        bf16* dst = PQ + ((size_t)(b * 512 + n) * 2 + pq) * 4096 + sq;
#pragma unroll
                        for (int nn = 0; nn < 2; ++nn)
#pragma unroll
                            for (int j = 0; j < 4; ++j) dst[(size_t)(4 * nn + j) * 8192] = (bf16)f2bf(acc[ai][bj][m][nn][j]); } }
        }
    }
};
struct EpiGate {
    static constexpr bool PERM = true;
    bf16* O; const bf16* Z; int coff, goff;
    __device__ __forceinline__ void operator()(const pg8::f32x4 (&acc)[2][2][4][2], const pg8::Unit& u, int wr, int wc, int fr, int fq) const {
        const int row0 = u.pm * 256 + wr * 64 + fr, col0 = u.pn * 256 + wc * 32 + 8 * fq;
#pragma unroll
        for (int ai = 0; ai < 2; ++ai)
#pragma unroll
            for (int m = 0; m < 4; ++m) { const size_t row = (size_t)(row0 + ai * 128 + m * 16);
#pragma unroll
                for (int bj = 0; bj < 2; ++bj) { const pg8::f32x4 v0 = acc[ai][bj][m][0], v1 = acc[ai][bj][m][1];
                    const u32x4 gz = *(const u32x4*)(Z + row * DIN + goff + col0 + bj * 128); u32x4 w;
                    w.x = pg8::cvt_pk_bf16(v0[0] * silu_f(bflo(gz.x)), v0[1] * silu_f(bfhi(gz.x))); w.y = pg8::cvt_pk_bf16(v0[2] * silu_f(bflo(gz.y)), v0[3] * silu_f(bfhi(gz.y)));
                    w.z = pg8::cvt_pk_bf16(v1[0] * silu_f(bflo(gz.z)), v1[1] * silu_f(bfhi(gz.z))); w.w = pg8::cvt_pk_bf16(v1[2] * silu_f(bflo(gz.w)), v1[3] * silu_f(bfhi(gz.w)));
                    *(u32x4*)(O + row * DM + coff + col0 + bj * 128) = w; } }
    }
};
struct EpiPart {
    static constexpr bool PERM = false;
    float* P;
    __device__ __forceinline__ void operator()(const pg8::f32x4 (&acc)[2][2][4][2], const pg8::Unit& u, int wr, int wc, int fr, int fq) const {
        const int row0 = u.pm * 256 + wr * 64 + fr, col0 = u.pn * 256 + wc * 32 + 4 * fq;
        float* base = (u.aux & 1) ? P + (size_t)2 * 2304 * 512 + (size_t)(u.aux >> 1) * 2048 * 512 : P + (size_t)(u.aux >> 1) * 2304 * 512;
#pragma unroll
        for (int ai = 0; ai < 2; ++ai)
#pragma unroll
            for (int m = 0; m < 4; ++m) { float* rowp = base + (size_t)(row0 + ai * 128 + m * 16) * 512 + col0;
#pragma unroll
                for (int bj = 0; bj < 2; ++bj)
#pragma unroll
                    for (int n = 0; n < 2; ++n) *(pg8::f32x4*)(rowp + bj * 128 + n * 16) = acc[ai][bj][m][n]; }
    }
};
struct EpiRes {
    static constexpr bool PERM = false;
    const float* xin; float* xout; const float* gate;
    __device__ __forceinline__ void operator()(const pg8::f32x4 (&acc)[2][2][4][2], const pg8::Unit& u, int wr, int wc, int fr, int fq) const {
        const int row0 = u.pm * 256 + wr * 64 + fr, col0 = u.pn * 256 + wc * 32 + 4 * fq;
        const float* gp = gate + (size_t)(u.pm >> 4) * 6144 + col0;
        pg8::f32x4 gv[2][2];
#pragma unroll
        for (int bj = 0; bj < 2; ++bj)
#pragma unroll
            for (int n = 0; n < 2; ++n) gv[bj][n] = *(const pg8::f32x4*)(gp + bj * 128 + n * 16);
#pragma unroll
        for (int ai = 0; ai < 2; ++ai)
#pragma unroll
            for (int m = 0; m < 4; ++m) { const size_t ro = (size_t)(row0 + ai * 128 + m * 16) * DM + col0;
#pragma unroll
                for (int bj = 0; bj < 2; ++bj)
#pragma unroll
                    for (int n = 0; n < 2; ++n) { const pg8::f32x4 xi = *(const pg8::f32x4*)(xin + ro + bj * 128 + n * 16);
                        *(pg8::f32x4*)(xout + ro + bj * 128 + n * 16) = xi + gv[bj][n] * acc[ai][bj][m][n]; } }
    }
};

struct TPItem { const float* src; bf16* dst; int N, K; };
__device__ __forceinline__ TPItem tp_decode(const Params& p, int it, int tid) {
    constexpr int T_IN = 32 * 96, T_OUT = 32 * 32, T_S = 64, T_L = T_IN + T_OUT + T_S;
    const int l = it / T_L; int r = it % T_L; const float* W; bf16* WT; int K, N, kb, nb;
    if (r < T_IN) { W = p.w_in + (size_t)l * DM * DIN; WT = (bf16*)(p.ws + WS_WIN) + (size_t)l * WROWS * DM; K = DM; N = DIN; kb = r / 96; nb = 8 + r % 96; }
    else if (r < T_IN + T_OUT) { r -= T_IN; W = p.w_out + (size_t)l * DM * DM; WT = (bf16*)(p.ws + WS_WOUT) + (size_t)l * DM * DM; K = DM; N = DM; kb = r >> 5; nb = r & 31; }
    else { r -= T_IN + T_OUT; W = p.w_pw + (size_t)l * DG * DG; WT = (bf16*)(p.ws + WS_WPW) + (size_t)l * DG * DG; K = DG; N = DG; kb = r >> 3; nb = r & 7; }
    TPItem t; t.N = N; t.K = K;
    t.src = W + (size_t)(kb * 64 + (tid >> 4)) * N + nb * 64 + (tid & 15) * 4;
    t.dst = WT + (size_t)(nb * 64 + (tid >> 3)) * K + kb * 64 + (tid & 7) * 8;
    return t;
}
__device__ __forceinline__ void tp_store(const TPItem& t, int tid, const f32x4& v0, const f32x4& v1, float* scr) {
    { const int kk = tid >> 4, nn = (tid & 15) * 4;
      scr[kk * 65 + nn] = v0[0]; scr[kk * 65 + nn + 1] = v0[1]; scr[kk * 65 + nn + 2] = v0[2]; scr[kk * 65 + nn + 3] = v0[3];
      scr[(kk + 32) * 65 + nn] = v1[0]; scr[(kk + 32) * 65 + nn + 1] = v1[1]; scr[(kk + 32) * 65 + nn + 2] = v1[2]; scr[(kk + 32) * 65 + nn + 3] = v1[3]; }
    __syncthreads();
    { const int n = tid >> 3, kc = (tid & 7) * 8; const float* s = scr + kc * 65 + n; u32x4 o;
      o.x = pk2(s[0], s[65]); o.y = pk2(s[2 * 65], s[3 * 65]); o.z = pk2(s[4 * 65], s[5 * 65]); o.w = pk2(s[6 * 65], s[7 * 65]);
      *(u32x4*)t.dst = o; }
    __syncthreads();
}

__device__ __forceinline__ void ph_prologue(const Params& p_, unsigned char* lds) {
    const Params p = *kparams(); (void)p_;
    const int tid = otid(), lane = tid & 63, wave = tid >> 6, G = gridDim.x, bid = obid();
    float* scr = (float*)lds;
    { constexpr int T_TOT = NL * (32 * 96 + 32 * 32 + 64);
      int it = bid; TPItem cur; f32x4 a0, a1;
      if (it < T_TOT) { cur = tp_decode(p, it, tid); a0 = *(const f32x4*)cur.src; a1 = *(const f32x4*)(cur.src + (size_t)32 * cur.N); }
      while (it < T_TOT) { const int nit = it + G; TPItem nxt = cur; f32x4 b0 = a0, b1 = a1;
          if (nit < T_TOT) { nxt = tp_decode(p, nit, tid); b0 = *(const f32x4*)nxt.src; b1 = *(const f32x4*)(nxt.src + (size_t)32 * nxt.N); }
          tp_store(cur, tid, a0, a1, scr);
          cur = nxt; a0 = b0; a1 = b1; it = nit; } }
    { bf16* Wfx = (bf16*)(p.ws + WS_WFXB);
      for (int e = bid * NTHR + tid; e < NL * DM * DG / 8; e += G * NTHR) { const int l = e >> 17, r = e & 131071, k = r >> 6, c8 = (r & 63) * 8;
          const float* src = p.w_in + ((size_t)l * DM + k) * DIN + c8; const f32x4 a = *(const f32x4*)src, b4 = *(const f32x4*)(src + 4);
          u32x4 o; o.x = pk2(a[0], a[1]); o.y = pk2(a[2], a[3]); o.z = pk2(b4[0], b4[1]); o.w = pk2(b4[2], b4[3]);
          *(u32x4*)(Wfx + ((size_t)l * DM + k) * DG + c8) = o; } }
    { float* Wl = (float*)lds; float* tr = Wl + 128 * 65; bf16* Wcs = (bf16*)(p.ws + WS_WCS);
      for (int t2 = G - 1 - bid; t2 < 256; t2 += G) {
          const int t = t2 >> 1, ch = t2 & 1, l = t >> 6, pq = (t >> 5) & 1, g = (t >> 3) & 3, n0 = (t & 7) * 64;
#pragma unroll
          for (int i = 0; i < 4; ++i) { const int m = (tid >> 4) + 32 * i, nn = (tid & 15) * 4;
              const f32x4 v = *(const f32x4*)(p.w_fft + ((size_t)l * DG + g * 128 + m) * DG + n0 + nn);
              Wl[m * 65 + nn] = v[0]; Wl[m * 65 + nn + 1] = v[1]; Wl[m * 65 + nn + 2] = v[2]; Wl[m * 65 + nn + 3] = v[3]; }
          if (tid < 128) tr[tid] = pq ? sinpif((float)tid * (1.f / 64.f)) : cospif((float)tid * (1.f / 64.f));
          __syncthreads();
          const int nn = tid >> 3, cc = ch * 64 + (tid & 7) * 8; float acc[8];
#pragma unroll
          for (int i = 0; i < 8; ++i) acc[i] = 0.f;
#pragma unroll 4
          for (int m = 0; m < 128; ++m) { const float w = Wl[m * 65 + nn];
#pragma unroll
              for (int i = 0; i < 8; ++i) acc[i] += tr[((cc + i) * m) & 127] * w; }
          const float nrm = 0.0013810679320049757f;
          u32x4 o0;
          o0.x = pk2(acc[0] * nrm, acc[1] * nrm); o0.y = pk2(acc[2] * nrm, acc[3] * nrm); o0.z = pk2(acc[4] * nrm, acc[5] * nrm); o0.w = pk2(acc[6] * nrm, acc[7] * nrm);
          *(u32x4*)(Wcs + ((size_t)l * 1024 + pq * 512 + n0 + nn) * DG + g * 128 + cc) = o0;
          __syncthreads();
      } }
    __syncthreads();
    float* cosT = (float*)(lds + 32768); float* sinT = (float*)(lds + 49152); float* ca = (float*)(lds + 65536); float* red = (float*)(lds + 81920);
    for (int j = tid; j < 4096; j += NTHR) { cosT[j] = cospif((float)j * (1.f / 2048.f)); sinT[j] = sinpif((float)j * (1.f / 2048.f)); }
    for (int j = tid; j < 4096; j += NTHR) { const float cv = p.c[j]; ca[j] = cv / (1.f + expf(-cv)); }
    __syncthreads();
    { bf16* DC = (bf16*)(p.ws + WS_DC); bf16* DSm = (bf16*)(p.ws + WS_DS);
      for (int r = bid * 2 + (tid >> 8); r < 4352; r += G * 2) { const int is_sin = (r >= 2304) ? 1 : 0, k = is_sin ? r - 2304 : r, s0 = (tid & 255) * 8; float v[8];
#pragma unroll
          for (int j = 0; j < 8; ++j) { const int idx = (k * (s0 + j)) & 4095; v[j] = is_sin ? sinT[idx] : cosT[idx]; }
          u32x4 o; o.x = pk2(v[0], v[1]); o.y = pk2(v[2], v[3]); o.z = pk2(v[4], v[5]); o.w = pk2(v[6], v[7]);
          *(u32x4*)((is_sin ? DSm : DC) + (size_t)k * 2048 + s0) = o; } }
    { float2* rope = (float2*)(p.ws + WS_ROPE);
      for (int e = bid * NTHR + tid; e < 4096 * 32; e += G * NTHR) { const int s = e >> 5, i = e & 31;
          const float inv = (float)pow(10000.0, -(double)i / 32.0); const float ang = (float)s * inv;
          double sn, cs; sincos((double)ang, &sn, &cs); rope[e] = make_float2((float)cs, (float)sn); } }
    float* mod = (float*)(p.ws + WS_MOD);
    for (int t = bid; t < 192; t += G) {
        const int l = t / 96, col = (t % 96) * 64 + lane; const float* W = p.w_ada + (size_t)l * DM * 6144 + col;
        float a0 = 0.f, a1 = 0.f;
        for (int k0 = wave * 256; k0 < wave * 256 + 256; k0 += 32) { float wv[32];
#pragma unroll
            for (int j = 0; j < 32; ++j) wv[j] = W[(size_t)(k0 + j) * 6144];
            asm volatile("" ::: "memory");
#pragma unroll
            for (int j = 0; j < 32; ++j) { a0 += ca[k0 + j] * wv[j]; a1 += ca[2048 + k0 + j] * wv[j]; } }
        red[(wave * 2 + 0) * 64 + lane] = a0; red[(wave * 2 + 1) * 64 + lane] = a1;
        __syncthreads();
        if (wave < 2) { float s = 0.f;
#pragma unroll
            for (int w = 0; w < 8; ++w) s += red[(w * 2 + wave) * 64 + lane];
            mod[(size_t)(l * 2 + wave) * 6144 + col] = s + p.b_ada[l * 6144 + col]; }
        __syncthreads();
    }
}

__device__ __forceinline__ void ph_norm(const Params& p_, int l) {
    const Params p = *kparams(); (void)p_;
    const int tid = otid(), lane = tid & 63, wave = tid >> 6;
    const float* xin = (l == 0) ? p.x : p.out; bf16* h = (bf16*)(p.ws + WS_U); const float* mod = (const float*)(p.ws + WS_MOD);
    const int stride = gridDim.x * 8; const float* g = p.norm_g + l * DM;
    if (stride == 2048) {
        for (int row = obid() * 8 + wave; row < MTOK; row += 2 * stride) {
            const f32x4* xr0 = (const f32x4*)(xin + (size_t)row * DM) + lane; const f32x4* xr1 = (const f32x4*)(xin + (size_t)(row + stride) * DM) + lane;
            const float* md = mod + (size_t)(l * 2 + (row >> 12)) * 6144;
            f32x4 v0[8], v1[8], ca[8], cb[8];
#pragma unroll
            for (int j = 0; j < 8; ++j) { v0[j] = xr0[64 * j]; v1[j] = xr1[64 * j]; }
#pragma unroll
            for (int j = 0; j < 8; ++j) { const int col = (64 * j + lane) * 4; ca[j] = *(const f32x4*)(g + col) * (*(const f32x4*)(md + 2048 + col) + 1.f); cb[j] = *(const f32x4*)(md + col); }
            asm volatile("" ::: "memory");
            float s0 = 0.f, s1 = 0.f;
#pragma unroll
            for (int j = 0; j < 8; ++j) { s0 += (v0[j][0] * v0[j][0] + v0[j][1] * v0[j][1]) + (v0[j][2] * v0[j][2] + v0[j][3] * v0[j][3]); s1 += (v1[j][0] * v1[j][0] + v1[j][1] * v1[j][1]) + (v1[j][2] * v1[j][2] + v1[j][3] * v1[j][3]); }
            s0 = wave_sum(s0); s1 = wave_sum(s1);
            const float r0 = rsqrtf(s0 * (1.f / DM) + 1e-6f), r1 = rsqrtf(s1 * (1.f / DM) + 1e-6f);
#pragma unroll
            for (int j = 0; j < 8; ++j) { const int col = (64 * j + lane) * 4;
                const f32x4 o0 = (v0[j] * r0) * ca[j] + cb[j], o1 = (v1[j] * r1) * ca[j] + cb[j]; u32x2 w;
                w.x = pk2(o0[0], o0[1]); w.y = pk2(o0[2], o0[3]); *(u32x2*)(h + (size_t)row * DM + col) = w;
                w.x = pk2(o1[0], o1[1]); w.y = pk2(o1[2], o1[3]); *(u32x2*)(h + (size_t)(row + stride) * DM + col) = w; }
        }
        return;
    }
    for (int row = obid() * 8 + wave; row < MTOK; row += stride) {
        const f32x4* xr = (const f32x4*)(xin + (size_t)row * DM) + lane; f32x4 v[8]; float ss = 0.f;
#pragma unroll
        for (int j = 0; j < 8; ++j) { v[j] = xr[64 * j]; ss += (v[j][0] * v[j][0] + v[j][1] * v[j][1]) + (v[j][2] * v[j][2] + v[j][3] * v[j][3]); }
        ss = wave_sum(ss); const float rstd = rsqrtf(ss * (1.f / DM) + 1e-6f);
        const float* md = mod + (size_t)(l * 2 + (row >> 12)) * 6144;
#pragma unroll
        for (int j = 0; j < 8; ++j) { const int col = (64 * j + lane) * 4;
            const f32x4 g4 = *(const f32x4*)(g + col), sh = *(const f32x4*)(md + col), sc = *(const f32x4*)(md + 2048 + col);
            const f32x4 o = (v[j] * rstd * g4) * (sc + 1.f) + sh; u32x2 w; w.x = pk2(o[0], o[1]); w.y = pk2(o[2], o[3]);
            *(u32x2*)(h + (size_t)row * DM + col) = w; }
    }
}
__device__ __forceinline__ void ph_final(const Params& p_) {
    const Params p = *kparams(); (void)p_;
    const int tid = otid(), lane = tid & 63, wave = tid >> 6;
    const int stride = gridDim.x * 8;
    for (int row = obid() * 8 + wave; row < MTOK; row += 2 * stride) {
        const bool two = (row + stride < MTOK);
        f32x4* xr0 = (f32x4*)(p.out + (size_t)row * DM) + lane; f32x4* xr1 = (f32x4*)(p.out + (size_t)(two ? row + stride : row) * DM) + lane;
        f32x4 v0[8], v1[8], g4[8];
#pragma unroll
        for (int j = 0; j < 8; ++j) { v0[j] = xr0[64 * j]; v1[j] = xr1[64 * j]; g4[j] = *(const f32x4*)(p.final_g + (64 * j + lane) * 4); }
        asm volatile("" ::: "memory");
        float s0 = 0.f, s1 = 0.f;
#pragma unroll
        for (int j = 0; j < 8; ++j) { s0 += (v0[j][0] * v0[j][0] + v0[j][1] * v0[j][1]) + (v0[j][2] * v0[j][2] + v0[j][3] * v0[j][3]); s1 += (v1[j][0] * v1[j][0] + v1[j][1] * v1[j][1]) + (v1[j][2] * v1[j][2] + v1[j][3] * v1[j][3]); }
        s0 = wave_sum(s0); s1 = wave_sum(s1);
        const float r0 = rsqrtf(s0 * (1.f / DM) + 1e-6f), r1 = rsqrtf(s1 * (1.f / DM) + 1e-6f);
#pragma unroll
        for (int j = 0; j < 8; ++j) { xr0[64 * j] = v0[j] * r0 * g4[j]; if (two) xr1[64 * j] = v1[j] * r1 * g4[j]; }
    }
}

#ifndef REP_PRO
#define REP_PRO 1
#endif
#ifndef REP_NORM
#define REP_NORM 1
#endif
#ifndef REP_Z
#define REP_Z 1
#endif
#ifndef REP_MIX
#define REP_MIX 1
#endif
#ifndef REP_P3
#define REP_P3 1
#endif
#ifndef REP_R2
#define REP_R2 1
#endif
#ifndef REP_CMB
#define REP_CMB 1
#endif
#ifndef REP_FFT
#define REP_FFT 1
#endif
#ifndef REP_OUT
#define REP_OUT 1
#endif
#ifndef REP_SUB
#define REP_SUB 1
#endif

#ifndef REP_R1
#define REP_R1 1
#endif
#ifndef REP_NA
#define REP_NA 1
#endif
#ifndef REP_CV
#define REP_CV 1
#endif
#ifndef REP_F1
#define REP_F1 1
#endif
#define REPEAT(n) for (int rep_ = 0; rep_ < (n); ++rep_)
typedef short bf16x8v __attribute__((ext_vector_type(8)));
__device__ __forceinline__ bf16x8v mk8(unsigned a, unsigned b, unsigned c, unsigned d) { u32x4 v = {a, b, c, d}; return __builtin_bit_cast(bf16x8v, v); }
#define MFMA16(a, b, c) __builtin_amdgcn_mfma_f32_16x16x32_bf16(a, b, c, 0, 0, 0)
constexpr int R_QS = 0, R_KS = 18432, R_VT = 36864, R_KTF = 54272, R_KTB = 71680, R_STF = 89088, R_STB = 98304;

template <bool R2>
__device__ __forceinline__ void ret_stage(const Params& p_, int b, int h, int n, unsigned char* lds, float l2f, float l2b) {
    const Params p = *kparams(); (void)p_;
    const int tid = otid(), j = tid >> 2, c4 = tid & 3, s = n * 128 + j;
    const bf16* Z = (const bf16*)(p.ws + WS_Z); const bf16* zr = Z + (size_t)(b * SEQ + s) * DIN;
    const f32x4* rp = (const f32x4*)((const float2*)(p.ws + WS_ROPE) + s * 32 + c4 * 8);
    f32x4 rr[4];
#pragma unroll
    for (int i = 0; i < 4; ++i) rr[i] = rp[i];
    const u32x4 ka = *(const u32x4*)(zr + 7 * DG + h * 64 + c4 * 8), kb = *(const u32x4*)(zr + 7 * DG + h * 64 + 32 + c4 * 8);
    const u32x4 va = *(const u32x4*)(zr + 8 * DG + h * 64 + c4 * 16), vb = *(const u32x4*)(zr + 8 * DG + h * 64 + c4 * 16 + 8);
    u32x4 qa = ka, qb = kb;
    if (R2) { qa = *(const u32x4*)(zr + 6 * DG + h * 64 + c4 * 8); qb = *(const u32x4*)(zr + 6 * DG + h * 64 + 32 + c4 * 8); }
    asm volatile("" ::: "memory");
    float cs[8], sn[8];
#pragma unroll
    for (int i = 0; i < 4; ++i) { const f32x4 r = rr[i]; cs[2 * i] = r[0]; sn[2 * i] = r[1]; cs[2 * i + 1] = r[2]; sn[2 * i + 1] = r[3]; }
    bf16* KS = (bf16*)(lds + R_KS); bf16* VT = (bf16*)(lds + R_VT);
    {
      const unsigned kau[4] = {ka.x, ka.y, ka.z, ka.w}, kbu[4] = {kb.x, kb.y, kb.z, kb.w};
      float k1[8], k2[8];
#pragma unroll
      for (int i = 0; i < 4; ++i) { const float a0 = bflo(kau[i]), a1 = bfhi(kau[i]), b0 = bflo(kbu[i]), b1 = bfhi(kbu[i]);
          k1[2 * i] = a0 * cs[2 * i] - b0 * sn[2 * i]; k2[2 * i] = a0 * sn[2 * i] + b0 * cs[2 * i];
          k1[2 * i + 1] = a1 * cs[2 * i + 1] - b1 * sn[2 * i + 1]; k2[2 * i + 1] = a1 * sn[2 * i + 1] + b1 * cs[2 * i + 1]; }
      u32x4 o1, o2; o1.x = pk2(k1[0], k1[1]); o1.y = pk2(k1[2], k1[3]); o1.z = pk2(k1[4], k1[5]); o1.w = pk2(k1[6], k1[7]);
      o2.x = pk2(k2[0], k2[1]); o2.y = pk2(k2[2], k2[3]); o2.z = pk2(k2[4], k2[5]); o2.w = pk2(k2[6], k2[7]);
      *(u32x4*)(KS + j * 72 + c4 * 8) = o1; *(u32x4*)(KS + j * 72 + 32 + c4 * 8) = o2;
      if (!R2) { bf16* KTF = (bf16*)(lds + R_KTF); bf16* KTB = (bf16*)(lds + R_KTB);
          const float df = exp2f(l2f * (float)(127 - j)), db = exp2f(l2b * (float)j);
#pragma unroll
          for (int i = 0; i < 8; ++i) { KTF[(c4 * 8 + i) * 136 + j] = (bf16)f2bf(k1[i] * df); KTF[(32 + c4 * 8 + i) * 136 + j] = (bf16)f2bf(k2[i] * df);
              KTB[(c4 * 8 + i) * 136 + j] = (bf16)f2bf(k1[i] * db); KTB[(32 + c4 * 8 + i) * 136 + j] = (bf16)f2bf(k2[i] * db); } } }
    {
      const unsigned vu[8] = {va.x, va.y, va.z, va.w, vb.x, vb.y, vb.z, vb.w};
#pragma unroll
      for (int i = 0; i < 8; ++i) { VT[(c4 * 16 + 2 * i) * 136 + j] = (bf16)(vu[i] & 0xffffu); VT[(c4 * 16 + 2 * i + 1) * 136 + j] = (bf16)(vu[i] >> 16); } }
    if (R2) { bf16* QS = (bf16*)(lds + R_QS);
      const unsigned qau[4] = {qa.x, qa.y, qa.z, qa.w}, qbu[4] = {qb.x, qb.y, qb.z, qb.w};
      float q1[8], q2[8];
#pragma unroll
      for (int i = 0; i < 4; ++i) { const float a0 = bflo(qau[i]), a1 = bfhi(qau[i]), b0 = bflo(qbu[i]), b1 = bfhi(qbu[i]);
          q1[2 * i] = (a0 * cs[2 * i] - b0 * sn[2 * i]) * 0.125f; q2[2 * i] = (a0 * sn[2 * i] + b0 * cs[2 * i]) * 0.125f;
          q1[2 * i + 1] = (a1 * cs[2 * i + 1] - b1 * sn[2 * i + 1]) * 0.125f; q2[2 * i + 1] = (a1 * sn[2 * i + 1] + b1 * cs[2 * i + 1]) * 0.125f; }
      u32x4 o1, o2; o1.x = pk2(q1[0], q1[1]); o1.y = pk2(q1[2], q1[3]); o1.z = pk2(q1[4], q1[5]); o1.w = pk2(q1[6], q1[7]);
      o2.x = pk2(q2[0], q2[1]); o2.y = pk2(q2[2], q2[3]); o2.z = pk2(q2[4], q2[5]); o2.w = pk2(q2[6], q2[7]);
      *(u32x4*)(QS + j * 72 + c4 * 8) = o1; *(u32x4*)(QS + j * 72 + 32 + c4 * 8) = o2; }
}

__device__ __forceinline__ void ret1_task(const Params& p_, int l, int task, unsigned char* lds) {
    const Params p = *kparams(); (void)p_;
    const int n = task & 31, h = (task >> 5) & 7, b = task >> 8;
    const float xf = p.rl_f[l * 8 + h], xb = p.rl_b[l * 8 + h];
    const float l2f = -log1pf(expf(-xf)) * 1.4426950408889634f, l2b = -log1pf(expf(-xb)) * 1.4426950408889634f;
    ret_stage<false>(p, b, h, n, lds, l2f, l2b);
    __syncthreads();
    const int tid = otid(), lane = tid & 63, w = tid >> 6, fr = lane & 15, fq = lane >> 4, dir = w >> 2, et = w & 3;
    const bf16* VT = (const bf16*)(lds + R_VT); const bf16* KT = (const bf16*)(lds + (dir ? R_KTB : R_KTF));
    bf16x8v a[4];
#pragma unroll
    for (int ks = 0; ks < 4; ++ks) a[ks] = *(const bf16x8v*)(VT + (16 * et + fr) * 136 + 32 * ks + 8 * fq);
    float* dst = (float*)(p.ws + WS_KV) + ((size_t)((dir * 2 + b) * 8 + h) * 32 + n) * 4096;
#pragma unroll
    for (int dt = 0; dt < 4; ++dt) { f32x4 acc = {0.f, 0.f, 0.f, 0.f};
#pragma unroll
        for (int ks = 0; ks < 4; ++ks) { const bf16x8v bfr = *(const bf16x8v*)(KT + (16 * dt + fr) * 136 + 32 * ks + 8 * fq); acc = MFMA16(a[ks], bfr, acc); }
#pragma unroll
        for (int r = 0; r < 4; ++r) dst[(16 * et + 4 * fq + r) * 64 + 16 * dt + fr] = acc[r]; }
    __syncthreads();
}

__device__ __forceinline__ void ret2_task(const Params& p_, int l, int task, unsigned char* lds) {
    const Params p = *kparams(); (void)p_;
    const int n = task & 31, h = (task >> 5) & 7, b = task >> 8;
    const float xf = p.rl_f[l * 8 + h], xb = p.rl_b[l * 8 + h];
    const float l2f = -log1pf(expf(-xf)) * 1.4426950408889634f, l2b = -log1pf(expf(-xb)) * 1.4426950408889634f;
    ret_stage<true>(p, b, h, n, lds, l2f, l2b);
    const int tid = otid(), lane = tid & 63, w = tid >> 6, fr = lane & 15, fq = lane >> 4;
    {
      const float gfC = exp2f(l2f * 128.f), gbC = exp2f(l2b * 128.f);
      const float* KVf = (const float*)(p.ws + WS_KV) + ((size_t)((0 * 2 + b) * 8 + h) * 32) * 4096 + tid * 8;
      const float* KVb = (const float*)(p.ws + WS_KV) + ((size_t)((1 * 2 + b) * 8 + h) * 32) * 4096 + tid * 8;
      f32x4 f0 = {0.f, 0.f, 0.f, 0.f}, f1 = f0, g0 = f0, g1 = f0;
      { float c0 = 1.f; int m = n - 1;
        for (; m >= 7; m -= 8) { f32x4 xa[8], xb[8];
#pragma unroll
            for (int j = 0; j < 8; ++j) { xa[j] = *(const f32x4*)(KVf + (size_t)(m - j) * 4096); xb[j] = *(const f32x4*)(KVf + (size_t)(m - j) * 4096 + 4); }
            asm volatile("" ::: "memory");
#pragma unroll
            for (int j = 0; j < 8; ++j) { f0 += xa[j] * c0; f1 += xb[j] * c0; c0 *= gfC; } }
        for (; m >= 0; --m) { const f32x4 x0 = *(const f32x4*)(KVf + (size_t)m * 4096), x1 = *(const f32x4*)(KVf + (size_t)m * 4096 + 4); f0 += x0 * c0; f1 += x1 * c0; c0 *= gfC; } }
      { float c0 = 1.f; int m = n + 1;
        for (; m + 7 < 32; m += 8) { f32x4 xa[8], xb[8];
#pragma unroll
            for (int j = 0; j < 8; ++j) { xa[j] = *(const f32x4*)(KVb + (size_t)(m + j) * 4096); xb[j] = *(const f32x4*)(KVb + (size_t)(m + j) * 4096 + 4); }
            asm volatile("" ::: "memory");
#pragma unroll
            for (int j = 0; j < 8; ++j) { g0 += xa[j] * c0; g1 += xb[j] * c0; c0 *= gbC; } }
        for (; m < 32; ++m) { const f32x4 x0 = *(const f32x4*)(KVb + (size_t)m * 4096), x1 = *(const f32x4*)(KVb + (size_t)m * 4096 + 4); g0 += x0 * c0; g1 += x1 * c0; c0 *= gbC; } }
      const int e = tid >> 3, d0 = (tid & 7) * 8; u32x4 o;
      o.x = pk2(f0[0], f0[1]); o.y = pk2(f0[2], f0[3]); o.z = pk2(f1[0], f1[1]); o.w = pk2(f1[2], f1[3]); *(u32x4*)((bf16*)(lds + R_STF) + e * 72 + d0) = o;
      o.x = pk2(g0[0], g0[1]); o.y = pk2(g0[2], g0[3]); o.z = pk2(g1[0], g1[1]); o.w = pk2(g1[2], g1[3]); *(u32x4*)((bf16*)(lds + R_STB) + e * 72 + d0) = o; }
    __syncthreads();
    const bf16* QS = (const bf16*)(lds + R_QS); const bf16* KS = (const bf16*)(lds + R_KS); const bf16* VT = (const bf16*)(lds + R_VT);
    const bf16* STF = (const bf16*)(lds + R_STF); const bf16* STB = (const bf16*)(lds + R_STB);
    bf16x8v qf[2];
#pragma unroll
    for (int ks = 0; ks < 2; ++ks) qf[ks] = *(const bf16x8v*)(QS + (16 * w + fr) * 72 + 32 * ks + 8 * fq);
    const int ai = 16 * w + fr;
    unsigned pp[8][2];
#pragma unroll
    for (int jt = 0; jt < 8; ++jt) { f32x4 acc = {0.f, 0.f, 0.f, 0.f};
#pragma unroll
        for (int ks = 0; ks < 2; ++ks) { const bf16x8v kf = *(const bf16x8v*)(KS + (16 * jt + fr) * 72 + 32 * ks + 8 * fq); acc = MFMA16(kf, qf[ks], acc); }
        float sc[4];
#pragma unroll
        for (int r = 0; r < 4; ++r) { const int aj = 16 * jt + 4 * fq + r; const float wg = (aj <= ai) ? exp2f(l2f * (float)(ai - aj)) : exp2f(l2b * (float)(aj - ai)); sc[r] = acc[r] * wg; }
        pp[jt][0] = pk2(sc[0], sc[1]); pp[jt][1] = pk2(sc[2], sc[3]); }
    const float qdf = exp2f(l2f * (float)(ai + 1)), qdb = exp2f(l2b * (float)(128 - ai));
    f32x4 tot[4]; float ss = 0.f;
#pragma unroll
    for (int et = 0; et < 4; ++et) { f32x4 o = {0.f, 0.f, 0.f, 0.f}, cfa = o, cba = o;
#pragma unroll
        for (int t = 0; t < 4; ++t) { const u32x2 vlo = *(const u32x2*)(VT + (16 * et + fr) * 136 + 32 * t + 4 * fq), vhi = *(const u32x2*)(VT + (16 * et + fr) * 136 + 32 * t + 16 + 4 * fq);
            o = MFMA16(mk8(vlo.x, vlo.y, vhi.x, vhi.y), mk8(pp[2 * t][0], pp[2 * t][1], pp[2 * t + 1][0], pp[2 * t + 1][1]), o); }
#pragma unroll
        for (int ks = 0; ks < 2; ++ks) { const bf16x8v sf = *(const bf16x8v*)(STF + (16 * et + fr) * 72 + 32 * ks + 8 * fq), sb = *(const bf16x8v*)(STB + (16 * et + fr) * 72 + 32 * ks + 8 * fq);
            cfa = MFMA16(sf, qf[ks], cfa); cba = MFMA16(sb, qf[ks], cba); }
        tot[et] = o + cfa * qdf + cba * qdb;
        ss += (tot[et][0] * tot[et][0] + tot[et][1] * tot[et][1]) + (tot[et][2] * tot[et][2] + tot[et][3] * tot[et][3]); }
    ss += __shfl_xor(ss, 16); ss += __shfl_xor(ss, 32);
    const float rs = rsqrtf(ss * (1.f / 64.f) + 1e-6f);
    const size_t tok = (size_t)b * SEQ + n * 128 + ai;
    const bf16* Z = (const bf16*)(p.ws + WS_Z); bf16* CAT = (bf16*)(p.ws + WS_CAT);
#pragma unroll
    for (int et = 0; et < 4; ++et) { const u32x2 gz = *(const u32x2*)(Z + tok * DIN + 9 * DG + h * 64 + 16 * et + 4 * fq); u32x2 o;
        o.x = pk2(tot[et][0] * rs * silu_f(bflo(gz.x)), tot[et][1] * rs * silu_f(bfhi(gz.x))); o.y = pk2(tot[et][2] * rs * silu_f(bflo(gz.y)), tot[et][3] * rs * silu_f(bfhi(gz.y)));
        *(u32x2*)(CAT + tok * DM + 1024 + h * 64 + 16 * et + 4 * fq) = o; }
    __syncthreads();
}

__device__ __forceinline__ void na2_task(const Params& p_, int l, int task, unsigned char* lds) {
    const Params p = *kparams(); (void)p_;
    const int tid = otid(), lane = tid & 63, w = tid >> 6, fr = lane & 15, fq = lane >> 4;
    const int hp = task & 3, rq = (task >> 2) & 63, b = task >> 8;
    const int row_start = min(max(rq - 4, 0), 56);
    const bf16* Z = (const bf16*)(p.ws + WS_Z); bf16* CAT = (bf16*)(p.ws + WS_CAT);
    bf16* VT = (bf16*)lds; float* BI = (float*)(lds + 133120);
    const int hh = w >> 2, h = hp * 2 + hh, qb = w & 3, ct0 = (qb >= 2) ? 1 : 0;
    const int c = 16 * qb + fr; const size_t qtok = (size_t)b * SEQ + rq * 64 + c;
    bf16x8v qf[2], kfr[12][2];
#pragma unroll
    for (int ks = 0; ks < 2; ++ks) qf[ks] = *(const bf16x8v*)(Z + qtok * DIN + 2 * DG + h * 64 + 32 * ks + 8 * fq);
#pragma unroll
    for (int i = 0; i < 12; ++i) { const int a = i / 3, ci = i % 3;
        const size_t ktok = (size_t)b * SEQ + (row_start + a) * 64 + 16 * (ct0 + ci) + fr;
#pragma unroll
        for (int ks = 0; ks < 2; ++ks) kfr[i][ks] = *(const bf16x8v*)(Z + ktok * DIN + 3 * DG + h * 64 + 32 * ks + 8 * fq); }
    asm volatile("" ::: "memory");
    for (int i = tid; i < 930; i += NTHR) BI[i] = p.na_bias[(size_t)(l * 8 + hp * 2) * 465 + i];
    { const int pair = lane & 31, chunk = (lane >> 5) + 2 * (w & 3);
      unsigned* VTd = (unsigned*)(VT + (size_t)hh * 64 * 520);
      u32x4 xs[8], ys[8];
#pragma unroll
      for (int a = 0; a < 8; ++a) { const size_t tok = (size_t)b * SEQ + (row_start + a) * 64 + 2 * pair;
          const bf16* src = Z + tok * DIN + 4 * DG + h * 64 + chunk * 8; xs[a] = *(const u32x4*)src; ys[a] = *(const u32x4*)(src + DIN); }
      asm volatile("" ::: "memory");
#pragma unroll
      for (int a = 0; a < 8; ++a) { const unsigned xu[4] = {xs[a].x, xs[a].y, xs[a].z, xs[a].w}, yu[4] = {ys[a].x, ys[a].y, ys[a].z, ys[a].w};
#pragma unroll
          for (int i = 0; i < 4; ++i) { VTd[(chunk * 8 + 2 * i) * 260 + a * 32 + pair] = (xu[i] & 0xffffu) | (yu[i] << 16);
              VTd[(chunk * 8 + 2 * i + 1) * 260 + a * 32 + pair] = (xu[i] >> 16) | (yu[i] & 0xffff0000u); } } }
    __syncthreads();
    const int col_start = min(max(c - 8, 0), 48);
    const float* bi = BI + hh * 465;
    float sc[24][4]; float mx = -1e30f;
#pragma unroll
    for (int hf = 0; hf < 2; ++hf) {
        if (hf == 1) {
#pragma unroll
            for (int i = 0; i < 12; ++i) { const int a = 4 + i / 3, ci = i % 3;
                const size_t ktok = (size_t)b * SEQ + (row_start + a) * 64 + 16 * (ct0 + ci) + fr;
#pragma unroll
                for (int ks = 0; ks < 2; ++ks) kfr[i][ks] = *(const bf16x8v*)(Z + ktok * DIN + 3 * DG + h * 64 + 32 * ks + 8 * fq); }
            asm volatile("" ::: "memory");
        }
#pragma unroll
        for (int i = 0; i < 12; ++i) { const int a = 4 * hf + i / 3, ci = i % 3, kt = a * 3 + ci;
            f32x4 acc = {0.f, 0.f, 0.f, 0.f};
#pragma unroll
            for (int ks = 0; ks < 2; ++ks) acc = MFMA16(kfr[i][ks], qf[ks], acc);
            const int dr = row_start + a - rq;
#pragma unroll
            for (int r = 0; r < 4; ++r) { const int kc = 16 * (ct0 + ci) + 4 * fq + r, rel = kc - col_start, dc = kc - c;
                float v = acc[r] * 0.125f + bi[(dr + 7) * 31 + min(max(dc + 15, 0), 30)];
                v = (rel >= 0 && rel < 16) ? v : -1e30f; sc[kt][r] = v; mx = fmaxf(mx, v); } }
    }
    mx = fmaxf(mx, __shfl_xor(mx, 16)); mx = fmaxf(mx, __shfl_xor(mx, 32));
    float sum = 0.f; unsigned pp[24][2];
#pragma unroll
    for (int kt = 0; kt < 24; ++kt) { const float e0 = __expf(sc[kt][0] - mx), e1 = __expf(sc[kt][1] - mx), e2 = __expf(sc[kt][2] - mx), e3 = __expf(sc[kt][3] - mx);
        sum += (e0 + e1) + (e2 + e3); pp[kt][0] = pk2(e0, e1); pp[kt][1] = pk2(e2, e3); }
    sum += __shfl_xor(sum, 16); sum += __shfl_xor(sum, 32);
    const float inv = 1.f / sum;
    const bf16* VTh = VT + (size_t)hh * 64 * 520;
#pragma unroll
    for (int dt = 0; dt < 4; ++dt) { f32x4 o = {0.f, 0.f, 0.f, 0.f};
#pragma unroll
        for (int t = 0; t < 12; ++t) { const int k0 = 2 * t, k1 = 2 * t + 1, a0 = k0 / 3, c0 = k0 % 3, a1 = k1 / 3, c1 = k1 % 3;
            const u32x2 vlo = *(const u32x2*)(VTh + (16 * dt + fr) * 520 + a0 * 64 + 16 * (ct0 + c0) + 4 * fq), vhi = *(const u32x2*)(VTh + (16 * dt + fr) * 520 + a1 * 64 + 16 * (ct0 + c1) + 4 * fq);
            o = MFMA16(mk8(vlo.x, vlo.y, vhi.x, vhi.y), mk8(pp[k0][0], pp[k0][1], pp[k1][0], pp[k1][1]), o); }
        const u32x2 gz = *(const u32x2*)(Z + qtok * DIN + 5 * DG + h * 64 + 16 * dt + 4 * fq); u32x2 ov;
        ov.x = pk2(o[0] * inv * silu_f(bflo(gz.x)), o[1] * inv * silu_f(bfhi(gz.x))); ov.y = pk2(o[2] * inv * silu_f(bflo(gz.y)), o[3] * inv * silu_f(bfhi(gz.y)));
        *(u32x2*)(CAT + qtok * DM + 512 + h * 64 + 16 * dt + 4 * fq) = ov; }
    __syncthreads();
}

__device__ __forceinline__ void conv_task(const Params& p_, int l, int task, unsigned char* lds) {
    const Params p = *kparams(); (void)p_;
    const int tid = otid(), lane = tid & 63, wave = tid >> 6;
    float* us = (float*)lds; float* ys = us + 46 * 512;
    const bf16* Z = (const bf16*)(p.ws + WS_Z);
    const int b = task >> 8, t0 = (task & 255) * 16;
    { u32x4 av[6], gv[6];
#pragma unroll
      for (int it = 0; it < 6; ++it) { const int idx = tid + it * NTHR, tt = idx >> 6, cc = (idx & 63) * 8, tok = t0 - 15 + tt;
          av[it] = (u32x4){0u, 0u, 0u, 0u}; gv[it] = av[it];
          if (idx < 46 * 64 && tok >= 0 && tok < SEQ) { const bf16* zr = Z + (size_t)(b * SEQ + tok) * DIN; av[it] = *(const u32x4*)(zr + 10 * DG + cc); gv[it] = *(const u32x4*)(zr + 11 * DG + cc); } }
      asm volatile("" ::: "memory");
#pragma unroll
      for (int it = 0; it < 6; ++it) { const int idx = tid + it * NTHR, tt = idx >> 6, cc = (idx & 63) * 8;
          if (idx < 46 * 64) { const u32x4 a = av[it], g = gv[it]; f32x4 u0, u1;
              u0[0] = bflo(a.x) / (1.f + __expf(-bflo(g.x))); u0[1] = bfhi(a.x) / (1.f + __expf(-bfhi(g.x))); u0[2] = bflo(a.y) / (1.f + __expf(-bflo(g.y))); u0[3] = bfhi(a.y) / (1.f + __expf(-bfhi(g.y)));
              u1[0] = bflo(a.z) / (1.f + __expf(-bflo(g.z))); u1[1] = bfhi(a.z) / (1.f + __expf(-bfhi(g.z))); u1[2] = bflo(a.w) / (1.f + __expf(-bflo(g.w))); u1[3] = bfhi(a.w) / (1.f + __expf(-bfhi(g.w)));
              *(f32x4*)(us + tt * 512 + cc) = u0; *(f32x4*)(us + tt * 512 + cc + 4) = u1; } } }
    float w[31];
#pragma unroll
    for (int k = 0; k < 31; ++k) w[k] = p.conv_w[(size_t)(l * 31 + k) * DG + tid];
    const float cb = p.conv_b[l * DG + tid];
    __syncthreads();
    for (int t = 0; t < 16; ++t) { float acc = cb;
#pragma unroll
        for (int k = 0; k < 31; ++k) acc += w[k] * us[(t + k) * 512 + tid];
        ys[t * 512 + tid] = acc; }
    __syncthreads();
#pragma unroll
    for (int tw = 0; tw < 2; ++tw) { const int t = wave + 8 * tw; float v[8]; float s = 0.f;
#pragma unroll
        for (int j = 0; j < 8; ++j) { v[j] = ys[t * 512 + lane + 64 * j]; s += v[j]; }
        const float mu = wave_sum(s) * (1.f / 512.f); float q = 0.f;
#pragma unroll
        for (int j = 0; j < 8; ++j) { v[j] -= mu; q += v[j] * v[j]; }
        const float rstd = rsqrtf(wave_sum(q) * (1.f / 512.f) + 1e-6f);
        bf16* orow = (bf16*)(p.ws + WS_CVH) + (size_t)(b * SEQ + t0 + t) * DG;
#pragma unroll
        for (int j = 0; j < 8; ++j) { const int ch = lane + 64 * j; const float y = v[j] * rstd * p.ln_g[l * DG + ch] + p.ln_b[l * DG + ch]; orow[ch] = (bf16)f2bf(silu_f(y)); } }
    __syncthreads();
}

__device__ __forceinline__ void ph_mixA(const Params& p, int l, unsigned char* lds) {
    const int G = gridDim.x, bid = obid();
    for (int t = bid; t < 512 * REP_R1; t += G) ret1_task(p, l, t & 511, lds);
    if (G == 256 && REP_NA == 1) {
        if (bid < 128) na2_task(p, l, bid, lds);
        else for (int i = 0; i < 3; ++i) na2_task(p, l, 128 + (bid - 128) * 3 + i, lds);
    } else for (int t = bid; t < 512 * REP_NA; t += G) na2_task(p, l, t & 511, lds);
    if (G == 256 && REP_CV == 1) {
        if (bid < 128) conv_task(p, l, bid, lds);
        else for (int i = 0; i < 3; ++i) conv_task(p, l, 128 + (bid - 128) * 3 + i, lds);
    } else for (int t = bid; t < 512 * REP_CV; t += G) conv_task(p, l, t & 511, lds);
}

__device__ __forceinline__ void ph_fold(const Params& p_) {
    const Params p = *kparams(); (void)p_;
    const bf16* PQ = (const bf16*)(p.ws + WS_PQT); bf16* PQF = (bf16*)(p.ws + WS_PQF);
    for (int e = obid() * NTHR + otid(); e < NB * DG * 2 * 256; e += gridDim.x * NTHR) {
        const int row = e >> 8, s0 = (e & 255) * 8, pq = row & 1;
        const bf16* src = PQ + (size_t)row * 4096;
        const u32x4 own = *(const u32x4*)(src + s0), low = *(const u32x4*)(src + 4096 - s0 - 8);
        const float top = (s0 == 0) ? 0.f : bf2f(src[4096 - s0]);
        const float sg = pq ? -1.f : 1.f;
        float o[8];
        o[0] = bflo(own.x) + sg * top;            o[1] = bfhi(own.x) + sg * bfhi(low.w);
        o[2] = bflo(own.y) + sg * bflo(low.w);    o[3] = bfhi(own.y) + sg * bfhi(low.z);
        o[4] = bflo(own.z) + sg * bflo(low.z);    o[5] = bfhi(own.z) + sg * bfhi(low.y);
        o[6] = bflo(own.w) + sg * bflo(low.y);    o[7] = bfhi(own.w) + sg * bfhi(low.x);
        if (s0 == 0 && pq) o[0] = 0.f;
        u32x4 w; w.x = pk2(o[0], o[1]); w.y = pk2(o[2], o[3]); w.z = pk2(o[4], o[5]); w.w = pk2(o[6], o[7]);
        *(u32x4*)(PQF + (size_t)row * 2048 + s0) = w;
    }
}
__device__ __forceinline__ void ph_combine(const Params& p_) {
    const Params p = *kparams(); (void)p_;
    const float* Ce = (const float*)(p.ws + WS_PART); const float* So = Ce + (size_t)2 * 2304 * 512;
    bf16* CAT = (bf16*)(p.ws + WS_CAT); const bf16* Z = (const bf16*)(p.ws + WS_Z); const bf16* PQ = (const bf16*)(p.ws + WS_PQT);
    for (int e = obid() * NTHR + otid(); e < MTOK * DG / 4; e += gridDim.x * NTHR) {
        const int row = e >> 7, c4 = (e & 127) * 4, b = row >> 12, k = row & 4095, kk = (k <= 2048) ? k : 4096 - k;
        f32x4 s = *(const f32x4*)(Ce + ((size_t)b * 2304 + kk) * 512 + c4);
        if (kk != 0 && kk != 2048) { const f32x4 so = *(const f32x4*)(So + ((size_t)b * 2048 + kk) * 512 + c4); s = (k <= 2048) ? s - so : s + so; }
        const float alt = (k & 1) ? -1.f : 1.f;
#pragma unroll
        for (int j = 0; j < 4; ++j) s[j] += alt * bf2f(PQ[((size_t)(b * 512 + c4 + j) * 2) * 4096 + 2048]);
        const u32x2 gz = *(const u32x2*)(Z + (size_t)row * DIN + DG + c4);
        u32x2 w; w.x = pk2(s[0] * silu_f(bflo(gz.x)), s[1] * silu_f(bfhi(gz.x))); w.y = pk2(s[2] * silu_f(bflo(gz.y)), s[3] * silu_f(bfhi(gz.y)));
        *(u32x2*)(CAT + (size_t)row * DM + c4) = w;
    }
}

#define XB_TMO      128
#define XB_XCNT(j)  (256  + 64 * (j))
#define XB_XSUB(j)  (1280 + 64 * (j))
#define XB_XGEN(j)  (2304 + 64 * (j))
#define XB_TOP      3328
#define XB_TOPGEN   3392
#define XCD_BAR_WORDS 3456
#define XB_SPIN_CAP (1u << 20)
__device__ __forceinline__ unsigned xb_ld(unsigned* p)              { return __hip_atomic_load(p, __ATOMIC_RELAXED, __HIP_MEMORY_SCOPE_AGENT); }
__device__ __forceinline__ unsigned xb_add(unsigned* p, unsigned v) { return __hip_atomic_fetch_add(p, v, __ATOMIC_RELAXED, __HIP_MEMORY_SCOPE_AGENT); }
__device__ __forceinline__ unsigned xb_xcc_id() { return (unsigned)__builtin_amdgcn_s_getreg((3 << 11) | 20) & 0xFu; }
#define XB_SPIN(cond, bar) do { unsigned _sp = 0; while (cond) { __builtin_amdgcn_s_sleep(1); \
    if ((++_sp & 255u) == 0u) { if (xb_ld(&(bar)[XB_TMO])) break; if (_sp > XB_SPIN_CAP) { atomicAdd(&(bar)[XB_TMO], 1u); break; } } } } while (0)
struct XcdBarrier { unsigned* bar; unsigned x; volatile PG8_LAS unsigned* st; };
__device__ __forceinline__ XcdBarrier xcd_barrier_post(unsigned* bar, volatile PG8_LAS unsigned* st) {
    XcdBarrier b; b.bar = bar; b.x = xb_xcc_id(); b.st = st;
    if (otid() == 0) (void)xb_add(&bar[XB_XCNT(b.x)], 1u);
    return b;
}
__device__ __forceinline__ void xcd_barrier_complete(unsigned* bar, unsigned x, unsigned& nloc, unsigned& nx) {
    const unsigned G = gridDim.x * gridDim.y * gridDim.z;
    unsigned sum, cnt, mine, sp = 0u;
    for (;;) {
        sum = 0u; cnt = 0u; mine = 0u;
#pragma unroll
        for (unsigned j = 0; j < 16; ++j) { const unsigned c = xb_ld(&bar[XB_XCNT(j)]); sum += c; cnt += (c > 0u) ? 1u : 0u; mine = (j == x) ? c : mine; }
        if (sum == G) break;
        __builtin_amdgcn_s_sleep(1);
        if ((++sp & 255u) == 0u) { if (xb_ld(&bar[XB_TMO])) break; if (sp > XB_SPIN_CAP) { atomicAdd(&bar[XB_TMO], 1u); break; } }
    }
    nloc = mine > 0u ? mine : 1u; nx = cnt > 0u ? cnt : 1u;
}
__device__ __forceinline__ void xcd_barrier(const XcdBarrier& b) {
    asm volatile("s_waitcnt vmcnt(0)" ::: "memory");
    __syncthreads();
    if (otid() == 0) {
        unsigned* bar = b.bar;
        __builtin_amdgcn_s_waitcnt(0);
        unsigned nloc = b.st[0], nx = b.st[1];
        if (nloc == 0u) { xcd_barrier_complete(bar, b.x, nloc, nx); b.st[0] = nloc; b.st[1] = nx; }
        const unsigned old = xb_add(&bar[XB_XSUB(b.x)], 1u);
        const unsigned gen = old / nloc;
        if (old + 1u == (gen + 1u) * nloc) {
            __builtin_amdgcn_fence(__ATOMIC_RELEASE, "agent");
            asm volatile("s_waitcnt vmcnt(0)" ::: "memory");
            const unsigned og = xb_add(&bar[XB_TOP], 1u);
            const unsigned tg = og / nx;
            if (og + 1u == (tg + 1u) * nx) xb_add(&bar[XB_TOPGEN], 1u);
            else XB_SPIN(xb_ld(&bar[XB_TOPGEN]) == tg, bar);
            __builtin_amdgcn_fence(__ATOMIC_ACQUIRE, "agent");
            xb_add(&bar[XB_XGEN(b.x)], 1u);
            asm volatile("s_waitcnt vmcnt(0)" ::: "memory");
        } else {
            XB_SPIN(xb_ld(&bar[XB_XGEN(b.x)]) == gen, bar);
            __builtin_amdgcn_fence(__ATOMIC_ACQUIRE, "agent");
            asm volatile("s_waitcnt vmcnt(0)" ::: "memory");
        }
    }
    __syncthreads();
}

constexpr int NPH = 14;
__global__ void __launch_bounds__(NTHR) mega(Params p) {
    extern __shared__ __attribute__((aligned(16))) unsigned char lds[];
    cg::grid_group grid = cg::this_grid();
    PG8_LAS unsigned char* ldsl = (PG8_LAS unsigned char*)lds;
    const int lo = p.ph_lo, hi = p.ph_hi;
#define IN(k) (lo <= (k) && (k) < hi)
#define SEAM(k) do { if (IN(k) && IN((k) + 1)) { xcd_barrier(xb); } } while (0)
    bf16* Zb = (bf16*)(kparams()->ws + WS_Z); bf16* CAT = (bf16*)(kparams()->ws + WS_CAT);
    volatile PG8_LAS unsigned* xst = (volatile PG8_LAS unsigned*)(ldsl + LDS_BYTES - 16);
    { const int t0_ = otid(); if (t0_ < 4) xst[t0_] = 0u; }
    __syncthreads();
    XcdBarrier xb = xcd_barrier_post((unsigned*)(kparams()->ws + WS_BAR), xst);
    if (p.ph_lo < 0) grid.sync();
    if (IN(0)) REPEAT(REP_PRO) { ph_prologue(p, lds); __syncthreads(); }
    SEAM(0);
    if (IN(0) && IN(1)) for (int r_ = 1; r_ < REP_SUB; ++r_) xcd_barrier(xb);
#pragma unroll
    for (int l = 0; l < NL; ++l) {
        const int pb = 1 + 6 * l;
        const char* Wl = (const char*)(kparams()->ws + WS_WIN + (size_t)l * WROWS * DM * 2);
        if (IN(pb)) {
            if (l == 0) {
#pragma unroll
                for (int ll = 0; ll < NL; ++ll) {
                    SchedS S = make_sched(kparams()->ws + WS_WCS + (size_t)ll * 1024 * DG * 2, DG, kparams()->ws + WS_WFXB + (size_t)ll * DM * DG * 2, DG, 1024, DM, 32 * ll);
                    EpiZ E{(bf16*)(kparams()->ws + WS_WIN + ((size_t)ll * WROWS + 6656) * DM * 2), DM};
                    pg8::gemm_phase<EpiZ, SchedS, true>(ldsl, pg8::Gemm{DG, DG, DG}, S, E);
                }
            }
            REPEAT(REP_NORM) ph_norm(p, l);
        }
        SEAM(pb);
        if (IN(pb + 1)) REPEAT(REP_Z) {
            SchedZ S; S.o.init(MTOK, 24 * 256, (int)gridDim.x, obid()); S.A = (const char*)(kparams()->ws + WS_U); S.B = Wl; S.late = 0;
            EpiZ2 E{Zb, (bf16*)(kparams()->ws + WS_PQT)};
            pg8::gemm_phase<EpiZ2, SchedZ, true>(ldsl, pg8::Gemm{DM, DM, DM}, S, E);
        }
        SEAM(pb + 1);
        if (IN(pb + 2)) {
            {
                SchedZ S; S.o.init(MTOK, 4 * 256, (int)gridDim.x, obid()); S.A = (const char*)(kparams()->ws + WS_U); S.B = Wl; S.late = 1;
                EpiZ2 E{Zb, (bf16*)(kparams()->ws + WS_PQT)};
                pg8::gemm_phase<EpiZ2, SchedZ, true>(ldsl, pg8::Gemm{DM, DM, DM}, S, E);
            }
            REPEAT(REP_MIX) ph_mixA(p, l, lds);
            ph_fold(p);
        }
        SEAM(pb + 2);
        if (IN(pb + 3)) REPEAT(REP_P3) {
            const int G_ = (int)gridDim.x, b_ = obid(); const bool bal = (G_ == 256);
            {
                SchedDFT S{(const char*)(kparams()->ws + WS_DC), (const char*)(kparams()->ws + WS_DS), (const char*)(kparams()->ws + WS_PQF), G_, b_};
                EpiPart E{(float*)(kparams()->ws + WS_PART)};
                pg8::gemm_phase<EpiPart, SchedDFT, true>(ldsl, pg8::Gemm{2048, 4096, 2048}, S, E); }
            {
                SchedS S = make_sched(kparams()->ws + WS_CVH, DG, kparams()->ws + WS_WPW + (size_t)l * DG * DG * 2, DG, MTOK, DG, 68);
                EpiGate E{CAT, Zb, 1536, 12 * DG};
                pg8::gemm_phase<EpiGate, SchedS, true>(ldsl, pg8::Gemm{DG, DG, DG}, S, E); }
            if (bal && REP_R2 == 1) { for (int t = b_ - 68; t >= 0 && t < 512; t += 188) ret2_task(p, l, t, lds); }
            else for (int t = b_; t < 512 * REP_R2; t += G_) ret2_task(p, l, t & 511, lds);
        }
        SEAM(pb + 3);
        if (IN(pb + 4)) REPEAT(REP_CMB) ph_combine(p);
        SEAM(pb + 4);
        if (IN(pb + 5)) REPEAT(l == 0 ? REP_OUT : 1) {
            SchedS S = make_sched(CAT, DM, kparams()->ws + WS_WOUT + (size_t)l * DM * DM * 2, DM, MTOK, DM);
            EpiRes E{(l == 0) ? kparams()->x : kparams()->out, kparams()->out, (const float*)(kparams()->ws + WS_MOD) + (size_t)l * 2 * 6144 + 4096};
            pg8::gemm_phase<EpiRes, SchedS, true>(ldsl, pg8::Gemm{DM, DM, DM}, S, E);
        }
        SEAM(pb + 5);
    }
    if (IN(NPH - 1)) ph_final(p);
#undef IN
#undef SEAM
}

extern "C" void kernel_launch(void* const* d_in, const int* in_sizes, int n_in, void* d_out, int out_size, void* d_ws, size_t ws_size, hipStream_t stream) {
    static int grid_blocks = 0;
    if (grid_blocks == 0) {
        if (n_in != 17 || ws_size < WS_END) { fprintf(stderr, "kernel_launch: n_in %d ws %zu (need %zu)\n", n_in, ws_size, (size_t)WS_END); grid_blocks = -1; return; }
        int dev = 0, cus = 0, per_cu = 0;
        hipGetDevice(&dev); hipDeviceGetAttribute(&cus, hipDeviceAttributeMultiprocessorCount, dev);
        if (hipFuncSetAttribute((const void*)mega, hipFuncAttributeMaxDynamicSharedMemorySize, LDS_BYTES) != hipSuccess) { fprintf(stderr, "hipFuncSetAttribute failed\n"); grid_blocks = -1; return; }
        if (hipOccupancyMaxActiveBlocksPerMultiprocessor(&per_cu, (const void*)mega, NTHR, LDS_BYTES) != hipSuccess || per_cu < 1) { fprintf(stderr, "occupancy query: %d\n", per_cu); per_cu = 1; }
        (void)hipGetLastError();
        grid_blocks = cus * 1;
    }
    if (grid_blocks < 0) return;
    Params p{};
    p.x = (const float*)d_in[0]; p.c = (const float*)d_in[1]; p.norm_g = (const float*)d_in[2]; p.w_ada = (const float*)d_in[3]; p.b_ada = (const float*)d_in[4];
    p.w_in = (const float*)d_in[5]; p.w_fft = (const float*)d_in[6]; p.na_bias = (const float*)d_in[7]; p.rl_f = (const float*)d_in[8]; p.rl_b = (const float*)d_in[9];
    p.conv_w = (const float*)d_in[10]; p.conv_b = (const float*)d_in[11]; p.ln_g = (const float*)d_in[12]; p.ln_b = (const float*)d_in[13]; p.w_pw = (const float*)d_in[14];
    p.w_out = (const float*)d_in[15]; p.final_g = (const float*)d_in[16];
    p.out = (float*)d_out; p.ws = (unsigned char*)d_ws;
#if ONE_LAUNCH
    if (hipMemsetAsync((char*)d_ws + WS_BAR, 0, 16384, stream) != hipSuccess) { fprintf(stderr, "memset of the barrier words failed\n"); return; }
    p.ph_lo = 0; p.ph_hi = NPH;
    void* args[] = {&p};
    hipError_t e = hipLaunchCooperativeKernel((const void*)mega, dim3(grid_blocks), dim3(NTHR), args, LDS_BYTES, stream);
    if (e != hipSuccess) fprintf(stderr, "cooperative launch failed: %s (grid %d)\n", hipGetErrorString(e), grid_blocks);
#else
    for (int ph = 0; ph < NPH; ++ph) { p.ph_lo = ph; p.ph_hi = ph + 1; hipLaunchKernelGGL(mega, dim3(grid_blocks), dim3(NTHR), LDS_BYTES, stream, p); }
#endif
}
```

```cpp
#include <hip/hip_runtime.h>
#include <hip/hip_cooperative_groups.h>
#include <cstdio>
#include <cstdint>
namespace cg = cooperative_groups;

#ifndef ONE_LAUNCH
#define ONE_LAUNCH 1
#endif

__device__ __forceinline__ int obid() { int b = (int)blockIdx.x; asm volatile("" : "+s"(b)); return b; }
__device__ __forceinline__ int otid() { int t; asm volatile("v_mov_b32 %0, %1" : "=v"(t) : "v"(threadIdx.x)); return t; }
namespace pg8 {
#define PG8_LAS __attribute__((address_space(3)))
typedef unsigned short bf16_t;
typedef short bf16x8 __attribute__((ext_vector_type(8)));
typedef float f32x4 __attribute__((ext_vector_type(4)));
typedef unsigned u32x4 __attribute__((ext_vector_type(4)));
constexpr int BM = 256, BK = 64, HALF = 128, HTB = HALF * BK * 2, STAGE_BYTES = 8 * HTB, NXCD = 8, WGM = 8;

__host__ __device__ __forceinline__ int lds_byte(int r, int c) { const int st = (r >> 4) * 2 + (c >> 5), rr = r & 15, cc = c & 31, ob = rr * 64 + cc * 2; return st * 1024 + (ob ^ (((ob >> 9) & 1) << 5)); }
__host__ __device__ __forceinline__ void stage_rc(int b, int& R, int& C) { const int st = b / 1024, sb = b % 1024, swz = sb ^ (((sb >> 9) & 1) << 5); R = (st >> 1) * 16 + swz / 64; C = (st & 1) * 32 + (swz % 64) / 2; }
__host__ __device__ __forceinline__ int perm32(int rho) { const int n = rho >> 4, i = rho & 15; return 8 * (i >> 2) + 4 * n + (i & 3); }

struct Unit { int pm, pn, aux, pad; const char* A; const char* B; };
struct Gemm { int lda, ldb, K; };

struct StaticOrder {
    int nM, nN, nwg, G, c;
    __host__ __device__ void init(int M, int N, int G_, int c_) { nM = M / BM; nN = N / BM; nwg = nM * nN; G = G_; c = c_; }
    __device__ bool next(int i, Unit& u) const {
        const long L = (long)i * G + c; if (L >= nwg) return false;
        int wgid = __builtin_amdgcn_readfirstlane((int)L); { const int q = nwg / NXCD, r = nwg % NXCD, xcd = wgid % NXCD, off = wgid / NXCD; wgid = (xcd < r ? xcd * (q + 1) : r * (q + 1) + (xcd - r) * q) + off; }
        const int nig = WGM * nN, gid = wgid / nig, fm = gid * WGM, gsz = (nM - fm) < WGM ? (nM - fm) : WGM;
        u.pm = __builtin_amdgcn_readfirstlane(fm + ((wgid % nig) % gsz)); u.pn = __builtin_amdgcn_readfirstlane((wgid % nig) / gsz); return true;
    }
};

__device__ __forceinline__ unsigned cvt_pk_bf16(float lo, float hi) { unsigned r; asm volatile("v_cvt_pk_bf16_f32 %0, %1, %2" : "=v"(r) : "v"(lo), "v"(hi)); return r; }

template <class Epi, class Sched, bool ALIGN_EPI>
__device__ __forceinline__ void gemm_phase(PG8_LAS unsigned char* lds, const Gemm g, const Sched& S, const Epi& E) {
    const int tid = otid(), wid = __builtin_amdgcn_readfirstlane(tid >> 6), lane = tid & 63, wr = wid >> 2, wc = wid & 3, fr = lane & 15, fq = lane >> 4;
    const int K = g.K, nt = K / BK;
    unsigned voffA[2], voffB[2];
#pragma unroll
    for (int i = 0; i < 2; ++i) { int R, C; stage_rc(tid * 16 + i * 8192, R, C); const int Rb = Epi::PERM ? ((R & ~31) + perm32(R & 31)) : R;
        voffA[i] = (unsigned)(R * g.lda + C) * 2u; voffB[i] = (unsigned)(Rb * g.ldb + C) * 2u; }
    const size_t kstep = (size_t)(BK * 2);
    const size_t hA = (size_t)HALF * g.lda * 2, hB = (size_t)HALF * g.ldb * 2;
    const unsigned ldsw = (unsigned)wid * 1024u;
    const int aoff = lds_byte(wr * 64 + fr, fq * 8), boff = lds_byte(wc * 32 + fr, fq * 8);
#define PG8_SA(b, h) (((b) * 2 + (h)) * HTB)
#define PG8_SB(b, h) ((4 + (b) * 2 + (h)) * HTB)
#define PG8_STAGE(bufoff, gbase, voff) do { _Pragma("unroll") for (int _i = 0; _i < 2; ++_i) \
        __builtin_amdgcn_global_load_lds((const unsigned*)((const char*)(gbase) + (voff)[_i]), (PG8_LAS unsigned*)(lds + (bufoff) + ldsw + _i * 8192), 16, 0, 0); } while (0)
#define PG8_LDA(dst, b, h) do { _Pragma("unroll") for (int m = 0; m < 4; ++m) _Pragma("unroll") for (int k = 0; k < 2; ++k) dst[m][k] = *(const PG8_LAS bf16x8*)(lds + PG8_SA(b, h) + aoff + m * 2048 + k * 1024); } while (0)
#define PG8_LDB(dst, b, h) do { _Pragma("unroll") for (int n = 0; n < 2; ++n) _Pragma("unroll") for (int k = 0; k < 2; ++k) dst[n][k] = *(const PG8_LAS bf16x8*)(lds + PG8_SB(b, h) + boff + n * 2048 + k * 1024); } while (0)
#define PG8_MMA(ai, bj, At, Bt) do { __builtin_amdgcn_s_setprio(1); _Pragma("unroll") for (int m = 0; m < 4; ++m) _Pragma("unroll") for (int n = 0; n < 2; ++n) _Pragma("unroll") for (int k = 0; k < 2; ++k) \
        acc[ai][bj][m][n] = __builtin_amdgcn_mfma_f32_16x16x32_bf16(Bt[n][k], At[m][k], acc[ai][bj][m][n], 0, 0, 0); __builtin_amdgcn_s_setprio(0); } while (0)
#define PG8_WAIT_V(n) asm volatile("s_waitcnt vmcnt(" #n ")" ::: "memory")
#define PG8_WAIT_L(n) asm volatile("s_waitcnt lgkmcnt(" #n ")" ::: "memory")
#define PG8_BAR __builtin_amdgcn_s_barrier()
#define PG8_SCHED __builtin_amdgcn_sched_barrier(0)
    Unit cur, nxt; int ui = 0;
    if (!S.next(0, cur)) return;
    f32x4 acc[2][2][4][2];
#pragma unroll
    for (int a = 0; a < 2; ++a)
#pragma unroll
        for (int b = 0; b < 2; ++b)
#pragma unroll
            for (int m = 0; m < 4; ++m)
#pragma unroll
                for (int n = 0; n < 2; ++n) acc[a][b][m][n] = (f32x4){0.f, 0.f, 0.f, 0.f};
    bf16x8 At[4][2], B0[2][2], B1[2][2];
    const char* cA = cur.A; const char* cB = cur.B;
    PG8_STAGE(PG8_SB(0, 0), cB, voffB); PG8_STAGE(PG8_SB(0, 1), cB + hB, voffB); PG8_STAGE(PG8_SA(0, 0), cA, voffA); PG8_STAGE(PG8_SA(0, 1), cA + hA, voffA);
    if (wr == 1) PG8_BAR;
    PG8_WAIT_V(2); PG8_BAR;
    PG8_STAGE(PG8_SB(1, 0), cB + kstep, voffB); PG8_STAGE(PG8_SA(1, 0), cA + kstep, voffA); PG8_STAGE(PG8_SB(1, 1), cB + hB + kstep, voffB);
    PG8_WAIT_V(6); PG8_BAR;
    for (;;) {
        const bool has_next = S.next(ui + 1, nxt);
        const char* nA = has_next ? nxt.A : cA; const char* nB = has_next ? nxt.B : cB;
        for (int t = 0; t < nt; t += 2) {
            const bool last = (t == nt - 2);
            const char* a1 = cA + (size_t)(t + 1) * kstep;
            const char* a2 = last ? nA : cA + (size_t)(t + 2) * kstep; const char* b2 = last ? nB : cB + (size_t)(t + 2) * kstep;
            const char* a3 = a2 + kstep; const char* b3 = b2 + kstep;
            PG8_LDB(B0, 0, 0); PG8_LDB(B1, 0, 1); PG8_SCHED; PG8_LDA(At, 0, 0); PG8_STAGE(PG8_SA(1, 1), a1 + hA, voffA);
            PG8_WAIT_V(8); PG8_WAIT_L(0); PG8_BAR; PG8_MMA(0, 0, At, B0); PG8_MMA(0, 1, At, B1); PG8_BAR; PG8_SCHED;
            PG8_LDA(At, 0, 1); PG8_STAGE(PG8_SB(0, 0), b2, voffB); PG8_STAGE(PG8_SB(0, 1), b2 + hB, voffB); PG8_STAGE(PG8_SA(0, 0), a2, voffA);
            PG8_WAIT_V(8); PG8_WAIT_L(0); PG8_BAR; PG8_MMA(1, 0, At, B0); PG8_MMA(1, 1, At, B1); PG8_BAR; PG8_SCHED;
            PG8_LDB(B0, 1, 0); PG8_LDB(B1, 1, 1); PG8_SCHED; PG8_LDA(At, 1, 0); PG8_STAGE(PG8_SA(0, 1), a2 + hA, voffA);
            PG8_WAIT_V(8); PG8_WAIT_L(0); PG8_BAR; PG8_MMA(0, 0, At, B0); PG8_MMA(0, 1, At, B1); PG8_BAR; PG8_SCHED;
            PG8_LDA(At, 1, 1); PG8_STAGE(PG8_SB(1, 0), b3, voffB); PG8_STAGE(PG8_SB(1, 1), b3 + hB, voffB); PG8_STAGE(PG8_SA(1, 0), a3, voffA);
            PG8_WAIT_V(8); PG8_WAIT_L(0); PG8_BAR; PG8_MMA(1, 0, At, B0); PG8_MMA(1, 1, At, B1); PG8_BAR; PG8_SCHED;
        }
        if constexpr (ALIGN_EPI) { if (wr == 0) PG8_BAR; }
        E(acc, cur, wr, wc, fr, fq);
        if (!has_next) break;
#pragma unroll
        for (int a = 0; a < 2; ++a)
#pragma unroll
            for (int b = 0; b < 2; ++b)
#pragma unroll
                for (int m = 0; m < 4; ++m)
#pragma unroll
                    for (int n = 0; n < 2; ++n) acc[a][b][m][n] = (f32x4){0.f, 0.f, 0.f, 0.f};
        cur = nxt; cA = nA; cB = nB; ++ui;
        if constexpr (ALIGN_EPI) { if (wr == 1) PG8_BAR; }
    }
    PG8_WAIT_V(0);
    if constexpr (!ALIGN_EPI) { if (wr == 0) PG8_BAR; }
    PG8_BAR;
#undef PG8_SA
#undef PG8_SB
#undef PG8_STAGE
#undef PG8_LDA
#undef PG8_LDB
#undef PG8_MMA
#undef PG8_WAIT_V
#undef PG8_WAIT_L
#undef PG8_BAR
#undef PG8_SCHED
}
}

typedef unsigned short bf16;
typedef float f32x4 __attribute__((ext_vector_type(4)));
typedef unsigned u32x4 __attribute__((ext_vector_type(4)));
typedef unsigned u32x2 __attribute__((ext_vector_type(2)));
constexpr int NB = 2, SEQ = 4096, DM = 2048, MTOK = NB * SEQ, DIN = 6656, DG = 512, NL = 2;
constexpr int LDS_BYTES = 147456;
constexpr int NTHR = 512;

constexpr int WROWS = 7680;
constexpr size_t WS_WIN = 0;
constexpr size_t WS_WOUT = WS_WIN + (size_t)NL * WROWS * DM * 2;
constexpr size_t WS_WCS = WS_WOUT + (size_t)NL * DM * DM * 2;
constexpr size_t WS_WFXB = WS_WCS + (size_t)NL * 1024 * DG * 2;
constexpr size_t WS_WPW = WS_WFXB + (size_t)NL * DM * DG * 2;
constexpr size_t WS_DC = WS_WPW + (size_t)NL * DG * DG * 2;
constexpr size_t WS_DS = WS_DC + (size_t)2304 * 2048 * 2;
constexpr size_t WS_PQF = WS_DS + (size_t)2048 * 2048 * 2;
constexpr size_t WS_ROPE = WS_PQF + (size_t)NB * DG * 2 * 2048 * 2;
constexpr size_t WS_MOD = WS_ROPE + (size_t)SEQ * 32 * 8;
constexpr size_t WS_U = WS_MOD + 131072;
constexpr size_t WS_PART = WS_U + (size_t)MTOK * DM * 2;
constexpr size_t WS_Z = WS_U + (size_t)4 * MTOK * DG * 4;
constexpr size_t WS_PQT = WS_Z + (size_t)MTOK * DIN * 2;
constexpr size_t WS_CVH = WS_PQT + (size_t)NB * DG * 2 * SEQ * 2;
constexpr size_t WS_CAT = WS_CVH + (size_t)MTOK * DG * 2;
constexpr size_t WS_KV = WS_CAT + (size_t)MTOK * DM * 2;
constexpr size_t WS_BAR = WS_KV + (size_t)2 * NB * 8 * 32 * 4096 * 4;
constexpr size_t WS_END = WS_BAR + 16384;

struct Params {
    const float* x; const float* c; const float* norm_g; const float* w_ada; const float* b_ada; const float* w_in; const float* w_fft; const float* na_bias;
    const float* rl_f; const float* rl_b; const float* conv_w; const float* conv_b; const float* ln_g; const float* ln_b; const float* w_pw; const float* w_out; const float* final_g;
    float* out; unsigned char* ws; int ph_lo, ph_hi;
};

#if defined(__HIP_DEVICE_COMPILE__)
typedef const __attribute__((address_space(4))) Params* KParams;
__device__ __forceinline__ KParams kparams() { KParams k = (KParams)__builtin_amdgcn_kernarg_segment_ptr(); asm volatile("" : "+s"(k)); return k; }
#else
typedef const Params* KParams;
__device__ __forceinline__ KParams kparams() { return nullptr; }
#endif
__device__ __forceinline__ unsigned f2bf(float f) { unsigned u = __float_as_uint(f); return (u + 0x7fffu + ((u >> 16) & 1u)) >> 16; }
__device__ __forceinline__ unsigned pk2(float lo, float hi) { return f2bf(lo) | (f2bf(hi) << 16); }
__device__ __forceinline__ float bf2f(bf16 b) { return __uint_as_float((unsigned)b << 16); }
__device__ __forceinline__ float bflo(unsigned u) { return __uint_as_float(u << 16); }
__device__ __forceinline__ float bfhi(unsigned u) { return __uint_as_float(u & 0xffff0000u); }
__device__ __forceinline__ float silu_f(float v) { return v / (1.f + __expf(-v)); }
__device__ __forceinline__ float wave_sum(float v) {
#pragma unroll
    for (int o = 1; o < 64; o <<= 1) v += __shfl_xor(v, o);
    return v;
}
__device__ __forceinline__ float wave_max(float v) {
#pragma unroll
    for (int o = 1; o < 64; o <<= 1) v = fmaxf(v, __shfl_xor(v, o));
    return v;
}

struct SchedS {
    pg8::StaticOrder o; const char* A; const char* B; size_t ta, tb;
    __device__ __forceinline__ bool next(int i, pg8::Unit& u) const { if (!o.next(i, u)) return false; u.A = A + (size_t)u.pm * ta; u.B = B + (size_t)u.pn * tb; u.aux = 0; return true; }
};
__device__ __forceinline__ SchedS make_sched(const void* A, int lda, const void* B, int ldb, int M, int N, int shift = 0) {
    SchedS s; s.o.init(M, N, (int)gridDim.x, (int)((obid() + gridDim.x - shift) % gridDim.x)); s.A = (const char*)A; s.B = (const char*)B; s.ta = (size_t)256 * lda * 2; s.tb = (size_t)256 * ldb * 2; return s;
}
struct SchedZ {
    pg8::StaticOrder o; const char* A; const char* B; int late;
    __device__ __forceinline__ bool next(int i, pg8::Unit& u) const { if (!o.next(i, u)) return false; const int jn = u.pn;
        u.pn = late ? (jn < 2 ? 2 + jn : 22 + jn) : (jn < 20 ? jn + 4 : jn + 6);
        u.A = A + (size_t)u.pm * (256 * DM * 2); u.B = B + (size_t)u.pn * (256 * DM * 2); u.aux = 0; return true; }
};
struct SchedDFT {
    const char* DC; const char* DSn; const char* PQF; int G, c;
    __device__ __forceinline__ bool next(int i, pg8::Unit& u) const {
        if (c < 0) return false;
        const int L = __builtin_amdgcn_readfirstlane(i * G + c); if (L >= 68) return false;
        const int b = L / 34, t = L % 34, odd = (t >= 18) ? 1 : 0, tt = odd ? t - 18 : t; u.pm = tt >> 1; u.pn = tt & 1; u.aux = b * 2 + odd;
        u.A = (odd ? DSn : DC) + (size_t)u.pm * (256 * 2048 * 2);
        u.B = PQF + ((size_t)(b * 512 + u.pn * 256) * 4096 + odd * 2048) * 2; return true;
    }
};

struct EpiZ {
    static constexpr bool PERM = true;
    bf16* O; int ldc;
    __device__ __forceinline__ void operator()(const pg8::f32x4 (&acc)[2][2][4][2], const pg8::Unit& u, int wr, int wc, int fr, int fq) const {
        const int row0 = u.pm * 256 + wr * 64 + fr, col0 = u.pn * 256 + wc * 32 + 8 * fq;
#pragma unroll
        for (int ai = 0; ai < 2; ++ai)
#pragma unroll
            for (int m = 0; m < 4; ++m) { bf16* rowp = O + (size_t)(row0 + ai * 128 + m * 16) * ldc + col0;
#pragma unroll
                for (int bj = 0; bj < 2; ++bj) { const pg8::f32x4 v0 = acc[ai][bj][m][0], v1 = acc[ai][bj][m][1]; u32x4 w;
                    w.x = pg8::cvt_pk_bf16(v0[0], v0[1]); w.y = pg8::cvt_pk_bf16(v0[2], v0[3]); w.z = pg8::cvt_pk_bf16(v1[0], v1[1]); w.w = pg8::cvt_pk_bf16(v1[2], v1[3]);
                    *(u32x4*)(rowp + bj * 128) = w; } }
    }
};
struct EpiZ2 {
    static constexpr bool PERM = true;
    bf16* O; bf16* PQ;
    __device__ __forceinline__ void operator()(const pg8::f32x4 (&acc)[2][2][4][2], const pg8::Unit& u, int wr, int wc, int fr, int fq) const {
        const int row0 = u.pm * 256 + wr * 64 + fr;
        if (u.pn < 26) { const int col0 = u.pn * 256 + wc * 32 + 8 * fq;
#pragma unroll
            for (int ai = 0; ai < 2; ++ai)
#pragma unroll
                for (int m = 0; m < 4; ++m) { bf16* rowp = O + (size_t)(row0 + ai * 128 + m * 16) * DIN + col0;
#pragma unroll
                    for (int bj = 0; bj < 2; ++bj) { const pg8::f32x4 v0 = acc[ai][bj][m][0], v1 = acc[ai][bj][m][1]; u32x4 w;
                        w.x = pg8::cvt_pk_bf16(v0[0], v0[1]); w.y = pg8::cvt_pk_bf16(v0[2], v0[3]); w.z = pg8::cvt_pk_bf16(v1[0], v1[1]); w.w = pg8::cvt_pk_bf16(v1[2], v1[3]);
                        *(u32x4*)(rowp + bj * 128) = w; } }
        } else { const int np0 = (u.pn - 26) * 256 + wc * 32 + 8 * fq;
#pragma unroll
            for (int bj = 0; bj < 2; ++bj) { const int np = np0 + bj * 128, pq = np >> 9, n = np & 511;
#pragma unroll
                for (int ai = 0; ai < 2; ++ai)
#pragma unroll
                    for (int m = 0; m < 4; ++m) { const int row = row0 + ai * 128 + m * 16, b = row >> 12, sq = row & 4095;
                        bf16* dst = PQ + ((size_t)(b * 512 + n) * 2 + pq) * 4096 + sq;
#pragma unroll
                        for (int nn = 0; nn < 2; ++nn)
#pragma unroll
                            for (int j = 0; j < 4; ++j) dst[(size_t)(4 * nn + j) * 8192] = (bf16)f2bf(acc[ai][bj][m][nn][j]); } }
        }
    }
};
struct EpiGate {
    static constexpr bool PERM = true;
    bf16* O; const bf16* Z; int coff, goff;
    __device__ __forceinline__ void operator()(const pg8::f32x4 (&acc)[2][2][4][2], const pg8::Unit& u, int wr, int wc, int fr, int fq) const {
        const int row0 = u.pm * 256 + wr * 64 + fr, col0 = u.pn * 256 + wc * 32 + 8 * fq;
#pragma unroll
        for (int ai = 0; ai < 2; ++ai)
#pragma unroll
            for (int m = 0; m < 4; ++m) { const size_t row = (size_t)(row0 + ai * 128 + m * 16);
#pragma unroll
                for (int bj = 0; bj < 2; ++bj) { const pg8::f32x4 v0 = acc[ai][bj][m][0], v1 = acc[ai][bj][m][1];
                    const u32x4 gz = *(const u32x4*)(Z + row * DIN + goff + col0 + bj * 128); u32x4 w;
                    w.x = pg8::cvt_pk_bf16(v0[0] * silu_f(bflo(gz.x)), v0[1] * silu_f(bfhi(gz.x))); w.y = pg8::cvt_pk_bf16(v0[2] * silu_f(bflo(gz.y)), v0[3] * silu_f(bfhi(gz.y)));
                    w.z = pg8::cvt_pk_bf16(v1[0] * silu_f(bflo(gz.z)), v1[1] * silu_f(bfhi(gz.z))); w.w = pg8::cvt_pk_bf16(v1[2] * silu_f(bflo(gz.w)), v1[3] * silu_f(bfhi(gz.w)));
                    *(u32x4*)(O + row * DM + coff + col0 + bj * 128) = w; } }
    }
};
struct EpiPart {
    static constexpr bool PERM = false;
    float* P;
    __device__ __forceinline__ void operator()(const pg8::f32x4 (&acc)[2][2][4][2], const pg8::Unit& u, int wr, int wc, int fr, int fq) const {
        const int row0 = u.pm * 256 + wr * 64 + fr, col0 = u.pn * 256 + wc * 32 + 4 * fq;
        float* base = (u.aux & 1) ? P + (size_t)2 * 2304 * 512 + (size_t)(u.aux >> 1) * 2048 * 512 : P + (size_t)(u.aux >> 1) * 2304 * 512;
#pragma unroll
        for (int ai = 0; ai < 2; ++ai)
#pragma unroll
            for (int m = 0; m < 4; ++m) { float* rowp = base + (size_t)(row0 + ai * 128 + m * 16) * 512 + col0;
#pragma unroll
                for (int bj = 0; bj < 2; ++bj)
#pragma unroll
                    for (int n = 0; n < 2; ++n) *(pg8::f32x4*)(rowp + bj * 128 + n * 16) = acc[ai][bj][m][n]; }
    }
};
struct EpiRes {
    static constexpr bool PERM = false;
    const float* xin; float* xout; const float* gate;
    __device__ __forceinline__ void operator()(const pg8::f32x4 (&acc)[2][2][4][2], const pg8::Unit& u, int wr, int wc, int fr, int fq) const {
        const int row0 = u.pm * 256 + wr * 64 + fr, col0 = u.pn * 256 + wc * 32 + 4 * fq;
        const float* gp = gate + (size_t)(u.pm >> 4) * 6144 + col0;
        pg8::f32x4 gv[2][2];
#pragma unroll
        for (int bj = 0; bj < 2; ++bj)
#pragma unroll
            for (int n = 0; n < 2; ++n) gv[bj][n] = *(const pg8::f32x4*)(gp + bj * 128 + n * 16);
#pragma unroll
        for (int ai = 0; ai < 2; ++ai)
#pragma unroll
            for (int m = 0; m < 4; ++m) { const size_t ro = (size_t)(row0 + ai * 128 + m * 16) * DM + col0;
#pragma unroll
                for (int bj = 0; bj < 2; ++bj)
#pragma unroll
                    for (int n = 0; n < 2; ++n) { const pg8::f32x4 xi = *(const pg8::f32x4*)(xin + ro + bj * 128 + n * 16);
                        *(pg8::f32x4*)(xout + ro + bj * 128 + n * 16) = xi + gv[bj][n] * acc[ai][bj][m][n]; } }
    }
};

struct TPItem { const float* src; bf16* dst; int N, K; };
__device__ __forceinline__ TPItem tp_decode(const Params& p, int it, int tid) {
    constexpr int T_IN = 32 * 96, T_OUT = 32 * 32, T_S = 64, T_L = T_IN + T_OUT + T_S;
    const int l = it / T_L; int r = it % T_L; const float* W; bf16* WT; int K, N, kb, nb;
    if (r < T_IN) { W = p.w_in + (size_t)l * DM * DIN; WT = (bf16*)(p.ws + WS_WIN) + (size_t)l * WROWS * DM; K = DM; N = DIN; kb = r / 96; nb = 8 + r % 96; }
    else if (r < T_IN + T_OUT) { r -= T_IN; W = p.w_out + (size_t)l * DM * DM; WT = (bf16*)(p.ws + WS_WOUT) + (size_t)l * DM * DM; K = DM; N = DM; kb = r >> 5; nb = r & 31; }
    else { r -= T_IN + T_OUT; W = p.w_pw + (size_t)l * DG * DG; WT = (bf16*)(p.ws + WS_WPW) + (size_t)l * DG * DG; K = DG; N = DG; kb = r >> 3; nb = r & 7; }
    TPItem t; t.N = N; t.K = K;
    t.src = W + (size_t)(kb * 64 + (tid >> 4)) * N + nb * 64 + (tid & 15) * 4;
    t.dst = WT + (size_t)(nb * 64 + (tid >> 3)) * K + kb * 64 + (tid & 7) * 8;
    return t;
}
__device__ __forceinline__ void tp_store(const TPItem& t, int tid, const f32x4& v0, const f32x4& v1, float* scr) {
    { const int kk = tid >> 4, nn = (tid & 15) * 4;
      scr[kk * 65 + nn] = v0[0]; scr[kk * 65 + nn + 1] = v0[1]; scr[kk * 65 + nn + 2] = v0[2]; scr[kk * 65 + nn + 3] = v0[3];
      scr[(kk + 32) * 65 + nn] = v1[0]; scr[(kk + 32) * 65 + nn + 1] = v1[1]; scr[(kk + 32) * 65 + nn + 2] = v1[2]; scr[(kk + 32) * 65 + nn + 3] = v1[3]; }
    __syncthreads();
    { const int n = tid >> 3, kc = (tid & 7) * 8; const float* s = scr + kc * 65 + n; u32x4 o;
      o.x = pk2(s[0], s[65]); o.y = pk2(s[2 * 65], s[3 * 65]); o.z = pk2(s[4 * 65], s[5 * 65]); o.w = pk2(s[6 * 65], s[7 * 65]);
      *(u32x4*)t.dst = o; }
    __syncthreads();
}

__device__ __forceinline__ void ph_prologue(const Params& p_, unsigned char* lds) {
    const Params p = *kparams(); (void)p_;
    const int tid = otid(), lane = tid & 63, wave = tid >> 6, G = gridDim.x, bid = obid();
    float* scr = (float*)lds;
    { constexpr int T_TOT = NL * (32 * 96 + 32 * 32 + 64);
      int it = bid; TPItem cur; f32x4 a0, a1;
      if (it < T_TOT) { cur = tp_decode(p, it, tid); a0 = *(const f32x4*)cur.src; a1 = *(const f32x4*)(cur.src + (size_t)32 * cur.N); }
      while (it < T_TOT) { const int nit = it + G; TPItem nxt = cur; f32x4 b0 = a0, b1 = a1;
          if (nit < T_TOT) { nxt = tp_decode(p, nit, tid); b0 = *(const f32x4*)nxt.src; b1 = *(const f32x4*)(nxt.src + (size_t)32 * nxt.N); }
          tp_store(cur, tid, a0, a1, scr);
          cur = nxt; a0 = b0; a1 = b1; it = nit; } }
    { bf16* Wfx = (bf16*)(p.ws + WS_WFXB);
      for (int e = bid * NTHR + tid; e < NL * DM * DG / 8; e += G * NTHR) { const int l = e >> 17, r = e & 131071, k = r >> 6, c8 = (r & 63) * 8;
          const float* src = p.w_in + ((size_t)l * DM + k) * DIN + c8; const f32x4 a = *(const f32x4*)src, b4 = *(const f32x4*)(src + 4);
          u32x4 o; o.x = pk2(a[0], a[1]); o.y = pk2(a[2], a[3]); o.z = pk2(b4[0], b4[1]); o.w = pk2(b4[2], b4[3]);
          *(u32x4*)(Wfx + ((size_t)l * DM + k) * DG + c8) = o; } }
    { float* Wl = (float*)lds; float* tr = Wl + 128 * 65; bf16* Wcs = (bf16*)(p.ws + WS_WCS);
      for (int t2 = G - 1 - bid; t2 < 256; t2 += G) {
          const int t = t2 >> 1, ch = t2 & 1, l = t >> 6, pq = (t >> 5) & 1, g = (t >> 3) & 3, n0 = (t & 7) * 64;
#pragma unroll
          for (int i = 0; i < 4; ++i) { const int m = (tid >> 4) + 32 * i, nn = (tid & 15) * 4;
              const f32x4 v = *(const f32x4*)(p.w_fft + ((size_t)l * DG + g * 128 + m) * DG + n0 + nn);
              Wl[m * 65 + nn] = v[0]; Wl[m * 65 + nn + 1] = v[1]; Wl[m * 65 + nn + 2] = v[2]; Wl[m * 65 + nn + 3] = v[3]; }
          if (tid < 128) tr[tid] = pq ? sinpif((float)tid * (1.f / 64.f)) : cospif((float)tid * (1.f / 64.f));
          __syncthreads();
          const int nn = tid >> 3, cc = ch * 64 + (tid & 7) * 8; float acc[8];
#pragma unroll
          for (int i = 0; i < 8; ++i) acc[i] = 0.f;
#pragma unroll 4
          for (int m = 0; m < 128; ++m) { const float w = Wl[m * 65 + nn];
#pragma unroll
              for (int i = 0; i < 8; ++i) acc[i] += tr[((cc + i) * m) & 127] * w; }
          const float nrm = 0.0013810679320049757f;
          u32x4 o0;
          o0.x = pk2(acc[0] * nrm, acc[1] * nrm); o0.y = pk2(acc[2] * nrm, acc[3] * nrm); o0.z = pk2(acc[4] * nrm, acc[5] * nrm); o0.w = pk2(acc[6] * nrm, acc[7] * nrm);
          *(u32x4*)(Wcs + ((size_t)l * 1024 + pq * 512 + n0 + nn) * DG + g * 128 + cc) = o0;
          __syncthreads();
      } }
    __syncthreads();
    float* cosT = (float*)(lds + 32768); float* sinT = (float*)(lds + 49152); float* ca = (float*)(lds + 65536); float* red = (float*)(lds + 81920);
    for (int j = tid; j < 4096; j += NTHR) { cosT[j] = cospif((float)j * (1.f / 2048.f)); sinT[j] = sinpif((float)j * (1.f / 2048.f)); }
    for (int j = tid; j < 4096; j += NTHR) { const float cv = p.c[j]; ca[j] = cv / (1.f + expf(-cv)); }
    __syncthreads();
    { bf16* DC = (bf16*)(p.ws + WS_DC); bf16* DSm = (bf16*)(p.ws + WS_DS);
      for (int r = bid * 2 + (tid >> 8); r < 4352; r += G * 2) { const int is_sin = (r >= 2304) ? 1 : 0, k = is_sin ? r - 2304 : r, s0 = (tid & 255) * 8; float v[8];
#pragma unroll
          for (int j = 0; j < 8; ++j) { const int idx = (k * (s0 + j)) & 4095; v[j] = is_sin ? sinT[idx] : cosT[idx]; }
          u32x4 o; o.x = pk2(v[0], v[1]); o.y = pk2(v[2], v[3]); o.z = pk2(v[4], v[5]); o.w = pk2(v[6], v[7]);
          *(u32x4*)((is_sin ? DSm : DC) + (size_t)k * 2048 + s0) = o; } }
    { float2* rope = (float2*)(p.ws + WS_ROPE);
      for (int e = bid * NTHR + tid; e < 4096 * 32; e += G * NTHR) { const int s = e >> 5, i = e & 31;
          const float inv = (float)pow(10000.0, -(double)i / 32.0); const float ang = (float)s * inv;
          double sn, cs; sincos((double)ang, &sn, &cs); rope[e] = make_float2((float)cs, (float)sn); } }
    float* mod = (float*)(p.ws + WS_MOD);
    for (int t = bid; t < 192; t += G) {
        const int l = t / 96, col = (t % 96) * 64 + lane; const float* W = p.w_ada + (size_t)l * DM * 6144 + col;
        float a0 = 0.f, a1 = 0.f;
        for (int k0 = wave * 256; k0 < wave * 256 + 256; k0 += 32) { float wv[32];
#pragma unroll
            for (int j = 0; j < 32; ++j) wv[j] = W[(size_t)(k0 + j) * 6144];
            asm volatile("" ::: "memory");
#pragma unroll
            for (int j = 0; j < 32; ++j) { a0 += ca[k0 + j] * wv[j]; a1 += ca[2048 + k0 + j] * wv[j]; } }
        red[(wave * 2 + 0) * 64 + lane] = a0; red[(wave * 2 + 1) * 64 + lane] = a1;
        __syncthreads();
        if (wave < 2) { float s = 0.f;
#pragma unroll
            for (int w = 0; w < 8; ++w) s += red[(w * 2 + wave) * 64 + lane];
            mod[(size_t)(l * 2 + wave) * 6144 + col] = s + p.b_ada[l * 6144 + col]; }
        __syncthreads();
    }
}

__device__ __forceinline__ void ph_norm(const Params& p_, int l) {
    const Params p = *kparams(); (void)p_;
    const int tid = otid(), lane = tid & 63, wave = tid >> 6;
    const float* xin = (l == 0) ? p.x : p.out; bf16* h = (bf16*)(p.ws + WS_U); const float* mod = (const float*)(p.ws + WS_MOD);
    const int stride = gridDim.x * 8; const float* g = p.norm_g + l * DM;
    if (stride == 2048) {
        for (int row = obid() * 8 + wave; row < MTOK; row += 2 * stride) {
            const f32x4* xr0 = (const f32x4*)(xin + (size_t)row * DM) + lane; const f32x4* xr1 = (const f32x4*)(xin + (size_t)(row + stride) * DM) + lane;
            const float* md = mod + (size_t)(l * 2 + (row >> 12)) * 6144;
            f32x4 v0[8], v1[8], ca[8], cb[8];
#pragma unroll
            for (int j = 0; j < 8; ++j) { v0[j] = xr0[64 * j]; v1[j] = xr1[64 * j]; }
#pragma unroll
            for (int j = 0; j < 8; ++j) { const int col = (64 * j + lane) * 4; ca[j] = *(const f32x4*)(g + col) * (*(const f32x4*)(md + 2048 + col) + 1.f); cb[j] = *(const f32x4*)(md + col); }
            asm volatile("" ::: "memory");
            float s0 = 0.f, s1 = 0.f;
#pragma unroll
            for (int j = 0; j < 8; ++j) { s0 += (v0[j][0] * v0[j][0] + v0[j][1] * v0[j][1]) + (v0[j][2] * v0[j][2] + v0[j][3] * v0[j][3]); s1 += (v1[j][0] * v1[j][0] + v1[j][1] * v1[j][1]) + (v1[j][2] * v1[j][2] + v1[j][3] * v1[j][3]); }
            s0 = wave_sum(s0); s1 = wave_sum(s1);
            const float r0 = rsqrtf(s0 * (1.f / DM) + 1e-6f), r1 = rsqrtf(s1 * (1.f / DM) + 1e-6f);
#pragma unroll
            for (int j = 0; j < 8; ++j) { const int col = (64 * j + lane) * 4;
                const f32x4 o0 = (v0[j] * r0) * ca[j] + cb[j], o1 = (v1[j] * r1) * ca[j] + cb[j]; u32x2 w;
                w.x = pk2(o0[0], o0[1]); w.y = pk2(o0[2], o0[3]); *(u32x2*)(h + (size_t)row * DM + col) = w;
                w.x = pk2(o1[0], o1[1]); w.y = pk2(o1[2], o1[3]); *(u32x2*)(h + (size_t)(row + stride) * DM + col) = w; }
        }
        return;
    }
    for (int row = obid() * 8 + wave; row < MTOK; row += stride) {
        const f32x4* xr = (const f32x4*)(xin + (size_t)row * DM) + lane; f32x4 v[8]; float ss = 0.f;
#pragma unroll
        for (int j = 0; j < 8; ++j) { v[j] = xr[64 * j]; ss += (v[j][0] * v[j][0] + v[j][1] * v[j][1]) + (v[j][2] * v[j][2] + v[j][3] * v[j][3]); }
        ss = wave_sum(ss); const float rstd = rsqrtf(ss * (1.f / DM) + 1e-6f);
        const float* md = mod + (size_t)(l * 2 + (row >> 12)) * 6144;
#pragma unroll
        for (int j = 0; j < 8; ++j) { const int col = (64 * j + lane) * 4;
            const f32x4 g4 = *(const f32x4*)(g + col), sh = *(const f32x4*)(md + col), sc = *(const f32x4*)(md + 2048 + col);
            const f32x4 o = (v[j] * rstd * g4) * (sc + 1.f) + sh; u32x2 w; w.x = pk2(o[0], o[1]); w.y = pk2(o[2], o[3]);
            *(u32x2*)(h + (size_t)row * DM + col) = w; }
    }
}
__device__ __forceinline__ void ph_final(const Params& p_) {
    const Params p = *kparams(); (void)p_;
    const int tid = otid(), lane = tid & 63, wave = tid >> 6;
    const int stride = gridDim.x * 8;
    for (int row = obid() * 8 + wave; row < MTOK; row += 2 * stride) {
        const bool two = (row + stride < MTOK);
        f32x4* xr0 = (f32x4*)(p.out + (size_t)row * DM) + lane; f32x4* xr1 = (f32x4*)(p.out + (size_t)(two ? row + stride : row) * DM) + lane;
        f32x4 v0[8], v1[8], g4[8];
#pragma unroll
        for (int j = 0; j < 8; ++j) { v0[j] = xr0[64 * j]; v1[j] = xr1[64 * j]; g4[j] = *(const f32x4*)(p.final_g + (64 * j + lane) * 4); }
        asm volatile("" ::: "memory");
        float s0 = 0.f, s1 = 0.f;
#pragma unroll
        for (int j = 0; j < 8; ++j) { s0 += (v0[j][0] * v0[j][0] + v0[j][1] * v0[j][1]) + (v0[j][2] * v0[j][2] + v0[j][3] * v0[j][3]); s1 += (v1[j][0] * v1[j][0] + v1[j][1] * v1[j][1]) + (v1[j][2] * v1[j][2] + v1[j][3] * v1[j][3]); }
        s0 = wave_sum(s0); s1 = wave_sum(s1);
        const float r0 = rsqrtf(s0 * (1.f / DM) + 1e-6f), r1 = rsqrtf(s1 * (1.f / DM) + 1e-6f);
#pragma unroll
        for (int j = 0; j < 8; ++j) { xr0[64 * j] = v0[j] * r0 * g4[j]; if (two) xr1[64 * j] = v1[j] * r1 * g4[j]; }
    }
}

#ifndef REP_PRO
#define REP_PRO 1
#endif
#ifndef REP_NORM
#define REP_NORM 1
#endif
#ifndef REP_Z
#define REP_Z 1
#endif
#ifndef REP_MIX
#define REP_MIX 1
#endif
#ifndef REP_P3
#define REP_P3 1
#endif
#ifndef REP_R2
#define REP_R2 1
#endif
#ifndef REP_CMB
#define REP_CMB 1
#endif
#ifndef REP_FFT
#define REP_FFT 1
#endif
#ifndef REP_OUT
#define REP_OUT 1
#endif
#ifndef REP_SUB
#define REP_SUB 1
#endif

#ifndef REP_R1
#define REP_R1 1
#endif
#ifndef REP_NA
#define REP_NA 1
#endif
#ifndef REP_CV
#define REP_CV 1
#endif
#ifndef REP_F1
#define REP_F1 1
#endif
#define REPEAT(n) for (int rep_ = 0; rep_ < (n); ++rep_)
typedef short bf16x8v __attribute__((ext_vector_type(8)));
__device__ __forceinline__ bf16x8v mk8(unsigned a, unsigned b, unsigned c, unsigned d) { u32x4 v = {a, b, c, d}; return __builtin_bit_cast(bf16x8v, v); }
#define MFMA16(a, b, c) __builtin_amdgcn_mfma_f32_16x16x32_bf16(a, b, c, 0, 0, 0)
constexpr int R_QS = 0, R_KS = 18432, R_VT = 36864, R_KTF = 54272, R_KTB = 71680, R_STF = 89088, R_STB = 98304;

template <bool R2>
__device__ __forceinline__ void ret_stage(const Params& p_, int b, int h, int n, unsigned char* lds, float l2f, float l2b) {
    const Params p = *kparams(); (void)p_;
    const int tid = otid(), j = tid >> 2, c4 = tid & 3, s = n * 128 + j;
    const bf16* Z = (const bf16*)(p.ws + WS_Z); const bf16* zr = Z + (size_t)(b * SEQ + s) * DIN;
    const f32x4* rp = (const f32x4*)((const float2*)(p.ws + WS_ROPE) + s * 32 + c4 * 8);
    f32x4 rr[4];
#pragma unroll
    for (int i = 0; i < 4; ++i) rr[i] = rp[i];
    const u32x4 ka = *(const u32x4*)(zr + 7 * DG + h * 64 + c4 * 8), kb = *(const u32x4*)(zr + 7 * DG + h * 64 + 32 + c4 * 8);
    const u32x4 va = *(const u32x4*)(zr + 8 * DG + h * 64 + c4 * 16), vb = *(const u32x4*)(zr + 8 * DG + h * 64 + c4 * 16 + 8);
    u32x4 qa = ka, qb = kb;
    if (R2) { qa = *(const u32x4*)(zr + 6 * DG + h * 64 + c4 * 8); qb = *(const u32x4*)(zr + 6 * DG + h * 64 + 32 + c4 * 8); }
    asm volatile("" ::: "memory");
    float cs[8], sn[8];
#pragma unroll
    for (int i = 0; i < 4; ++i) { const f32x4 r = rr[i]; cs[2 * i] = r[0]; sn[2 * i] = r[1]; cs[2 * i + 1] = r[2]; sn[2 * i + 1] = r[3]; }
    bf16* KS = (bf16*)(lds + R_KS); bf16* VT = (bf16*)(lds + R_VT);
    {
      const unsigned kau[4] = {ka.x, ka.y, ka.z, ka.w}, kbu[4] = {kb.x, kb.y, kb.z, kb.w};
      float k1[8], k2[8];
#pragma unroll
      for (int i = 0; i < 4; ++i) { const float a0 = bflo(kau[i]), a1 = bfhi(kau[i]), b0 = bflo(kbu[i]), b1 = bfhi(kbu[i]);
          k1[2 * i] = a0 * cs[2 * i] - b0 * sn[2 * i]; k2[2 * i] = a0 * sn[2 * i] + b0 * cs[2 * i];
          k1[2 * i + 1] = a1 * cs[2 * i + 1] - b1 * sn[2 * i + 1]; k2[2 * i + 1] = a1 * sn[2 * i + 1] + b1 * cs[2 * i + 1]; }
      u32x4 o1, o2; o1.x = pk2(k1[0], k1[1]); o1.y = pk2(k1[2], k1[3]); o1.z = pk2(k1[4], k1[5]); o1.w = pk2(k1[6], k1[7]);
      o2.x = pk2(k2[0], k2[1]); o2.y = pk2(k2[2], k2[3]); o2.z = pk2(k2[4], k2[5]); o2.w = pk2(k2[6], k2[7]);
      *(u32x4*)(KS + j * 72 + c4 * 8) = o1; *(u32x4*)(KS + j * 72 + 32 + c4 * 8) = o2;
      if (!R2) { bf16* KTF = (bf16*)(lds + R_KTF); bf16* KTB = (bf16*)(lds + R_KTB);
          const float df = exp2f(l2f * (float)(127 - j)), db = exp2f(l2b * (float)j);
#pragma unroll
          for (int i = 0; i < 8; ++i) { KTF[(c4 * 8 + i) * 136 + j] = (bf16)f2bf(k1[i] * df); KTF[(32 + c4 * 8 + i) * 136 + j] = (bf16)f2bf(k2[i] * df);
              KTB[(c4 * 8 + i) * 136 + j] = (bf16)f2bf(k1[i] * db); KTB[(32 + c4 * 8 + i) * 136 + j] = (bf16)f2bf(k2[i] * db); } } }
    {
      const unsigned vu[8] = {va.x, va.y, va.z, va.w, vb.x, vb.y, vb.z, vb.w};
#pragma unroll
      for (int i = 0; i < 8; ++i) { VT[(c4 * 16 + 2 * i) * 136 + j] = (bf16)(vu[i] & 0xffffu); VT[(c4 * 16 + 2 * i + 1) * 136 + j] = (bf16)(vu[i] >> 16); } }
    if (R2) { bf16* QS = (bf16*)(lds + R_QS);
      const unsigned qau[4] = {qa.x, qa.y, qa.z, qa.w}, qbu[4] = {qb.x, qb.y, qb.z, qb.w};
      float q1[8], q2[8];
#pragma unroll
      for (int i = 0; i < 4; ++i) { const float a0 = bflo(qau[i]), a1 = bfhi(qau[i]), b0 = bflo(qbu[i]), b1 = bfhi(qbu[i]);
          q1[2 * i] = (a0 * cs[2 * i] - b0 * sn[2 * i]) * 0.125f; q2[2 * i] = (a0 * sn[2 * i] + b0 * cs[2 * i]) * 0.125f;
          q1[2 * i + 1] = (a1 * cs[2 * i + 1] - b1 * sn[2 * i + 1]) * 0.125f; q2[2 * i + 1] = (a1 * sn[2 * i + 1] + b1 * cs[2 * i + 1]) * 0.125f; }
      u32x4 o1, o2; o1.x = pk2(q1[0], q1[1]); o1.y = pk2(q1[2], q1[3]); o1.z = pk2(q1[4], q1[5]); o1.w = pk2(q1[6], q1[7]);
      o2.x = pk2(q2[0], q2[1]); o2.y = pk2(q2[2], q2[3]); o2.z = pk2(q2[4], q2[5]); o2.w = pk2(q2[6], q2[7]);
      *(u32x4*)(QS + j * 72 + c4 * 8) = o1; *(u32x4*)(QS + j * 72 + 32 + c4 * 8) = o2; }
}

__device__ __forceinline__ void ret1_task(const Params& p_, int l, int task, unsigned char* lds) {
    const Params p = *kparams(); (void)p_;
    const int n = task & 31, h = (task >> 5) & 7, b = task >> 8;
    const float xf = p.rl_f[l * 8 + h], xb = p.rl_b[l * 8 + h];
    const float l2f = -log1pf(expf(-xf)) * 1.4426950408889634f, l2b = -log1pf(expf(-xb)) * 1.4426950408889634f;
    ret_stage<false>(p, b, h, n, lds, l2f, l2b);
    __syncthreads();
    const int tid = otid(), lane = tid & 63, w = tid >> 6, fr = lane & 15, fq = lane >> 4, dir = w >> 2, et = w & 3;
    const bf16* VT = (const bf16*)(lds + R_VT); const bf16* KT = (const bf16*)(lds + (dir ? R_KTB : R_KTF));
    bf16x8v a[4];
#pragma unroll
    for (int ks = 0; ks < 4; ++ks) a[ks] = *(const bf16x8v*)(VT + (16 * et + fr) * 136 + 32 * ks + 8 * fq);
    float* dst = (float*)(p.ws + WS_KV) + ((size_t)((dir * 2 + b) * 8 + h) * 32 + n) * 4096;
#pragma unroll
    for (int dt = 0; dt < 4; ++dt) { f32x4 acc = {0.f, 0.f, 0.f, 0.f};
#pragma unroll
        for (int ks = 0; ks < 4; ++ks) { const bf16x8v bfr = *(const bf16x8v*)(KT + (16 * dt + fr) * 136 + 32 * ks + 8 * fq); acc = MFMA16(a[ks], bfr, acc); }
#pragma unroll
        for (int r = 0; r < 4; ++r) dst[(16 * et + 4 * fq + r) * 64 + 16 * dt + fr] = acc[r]; }
    __syncthreads();
}

__device__ __forceinline__ void ret2_task(const Params& p_, int l, int task, unsigned char* lds) {
    const Params p = *kparams(); (void)p_;
    const int n = task & 31, h = (task >> 5) & 7, b = task >> 8;
    const float xf = p.rl_f[l * 8 + h], xb = p.rl_b[l * 8 + h];
    const float l2f = -log1pf(expf(-xf)) * 1.4426950408889634f, l2b = -log1pf(expf(-xb)) * 1.4426950408889634f;
    ret_stage<true>(p, b, h, n, lds, l2f, l2b);
    const int tid = otid(), lane = tid & 63, w = tid >> 6, fr = lane & 15, fq = lane >> 4;
    {
      const float gfC = exp2f(l2f * 128.f), gbC = exp2f(l2b * 128.f);
      const float* KVf = (const float*)(p.ws + WS_KV) + ((size_t)((0 * 2 + b) * 8 + h) * 32) * 4096 + tid * 8;
      const float* KVb = (const float*)(p.ws + WS_KV) + ((size_t)((1 * 2 + b) * 8 + h) * 32) * 4096 + tid * 8;
      f32x4 f0 = {0.f, 0.f, 0.f, 0.f}, f1 = f0, g0 = f0, g1 = f0;
      { float c0 = 1.f; int m = n - 1;
        for (; m >= 7; m -= 8) { f32x4 xa[8], xb[8];
#pragma unroll
            for (int j = 0; j < 8; ++j) { xa[j] = *(const f32x4*)(KVf + (size_t)(m - j) * 4096); xb[j] = *(const f32x4*)(KVf + (size_t)(m - j) * 4096 + 4); }
            asm volatile("" ::: "memory");
#pragma unroll
            for (int j = 0; j < 8; ++j) { f0 += xa[j] * c0; f1 += xb[j] * c0; c0 *= gfC; } }
        for (; m >= 0; --m) { const f32x4 x0 = *(const f32x4*)(KVf + (size_t)m * 4096), x1 = *(const f32x4*)(KVf + (size_t)m * 4096 + 4); f0 += x0 * c0; f1 += x1 * c0; c0 *= gfC; } }
      { float c0 = 1.f; int m = n + 1;
        for (; m + 7 < 32; m += 8) { f32x4 xa[8], xb[8];
#pragma unroll
            for (int j = 0; j < 8; ++j) { xa[j] = *(const f32x4*)(KVb + (size_t)(m + j) * 4096); xb[j] = *(const f32x4*)(KVb + (size_t)(m + j) * 4096 + 4); }
            asm volatile("" ::: "memory");
#pragma unroll
            for (int j = 0; j < 8; ++j) { g0 += xa[j] * c0; g1 += xb[j] * c0; c0 *= gbC; } }
        for (; m < 32; ++m) { const f32x4 x0 = *(const f32x4*)(KVb + (size_t)m * 4096), x1 = *(const f32x4*)(KVb + (size_t)m * 4096 + 4); g0 += x0 * c0; g1 += x1 * c0; c0 *= gbC; } }
      const int e = tid >> 3, d0 = (tid & 7) * 8; u32x4 o;
      o.x = pk2(f0[0], f0[1]); o.y = pk2(f0[2], f0[3]); o.z = pk2(f1[0], f1[1]); o.w = pk2(f1[2], f1[3]); *(u32x4*)((bf16*)(lds + R_STF) + e * 72 + d0) = o;
      o.x = pk2(g0[0], g0[1]); o.y = pk2(g0[2], g0[3]); o.z = pk2(g1[0], g1[1]); o.w = pk2(g1[2], g1[3]); *(u32x4*)((bf16*)(lds + R_STB) + e * 72 + d0) = o; }
    __syncthreads();
    const bf16* QS = (const bf16*)(lds + R_QS); const bf16* KS = (const bf16*)(lds + R_KS); const bf16* VT = (const bf16*)(lds + R_VT);
    const bf16* STF = (const bf16*)(lds + R_STF); const bf16* STB = (const bf16*)(lds + R_STB);
    bf16x8v qf[2];
#pragma unroll
    for (int ks = 0; ks < 2; ++ks) qf[ks] = *(const bf16x8v*)(QS + (16 * w + fr) * 72 + 32 * ks + 8 * fq);
    const int ai = 16 * w + fr;
    unsigned pp[8][2];
#pragma unroll
    for (int jt = 0; jt < 8; ++jt) { f32x4 acc = {0.f, 0.f, 0.f, 0.f};
#pragma unroll
        for (int ks = 0; ks < 2; ++ks) { const bf16x8v kf = *(const bf16x8v*)(KS + (16 * jt + fr) * 72 + 32 * ks + 8 * fq); acc = MFMA16(kf, qf[ks], acc); }
        float sc[4];
#pragma unroll
        for (int r = 0; r < 4; ++r) { const int aj = 16 * jt + 4 * fq + r; const float wg = (aj <= ai) ? exp2f(l2f * (float)(ai - aj)) : exp2f(l2b * (float)(aj - ai)); sc[r] = acc[r] * wg; }
        pp[jt][0] = pk2(sc[0], sc[1]); pp[jt][1] = pk2(sc[2], sc[3]); }
    const float qdf = exp2f(l2f * (float)(ai + 1)), qdb = exp2f(l2b * (float)(128 - ai));
    f32x4 tot[4]; float ss = 0.f;
#pragma unroll
    for (int et = 0; et < 4; ++et) { f32x4 o = {0.f, 0.f, 0.f, 0.f}, cfa = o, cba = o;
#pragma unroll
        for (int t = 0; t < 4; ++t) { const u32x2 vlo = *(const u32x2*)(VT + (16 * et + fr) * 136 + 32 * t + 4 * fq), vhi = *(const u32x2*)(VT + (16 * et + fr) * 136 + 32 * t + 16 + 4 * fq);
            o = MFMA16(mk8(vlo.x, vlo.y, vhi.x, vhi.y), mk8(pp[2 * t][0], pp[2 * t][1], pp[2 * t + 1][0], pp[2 * t + 1][1]), o); }
#pragma unroll
        for (int ks = 0; ks < 2; ++ks) { const bf16x8v sf = *(const bf16x8v*)(STF + (16 * et + fr) * 72 + 32 * ks + 8 * fq), sb = *(const bf16x8v*)(STB + (16 * et + fr) * 72 + 32 * ks + 8 * fq);
            cfa = MFMA16(sf, qf[ks], cfa); cba = MFMA16(sb, qf[ks], cba); }
        tot[et] = o + cfa * qdf + cba * qdb;
        ss += (tot[et][0] * tot[et][0] + tot[et][1] * tot[et][1]) + (tot[et][2] * tot[et][2] + tot[et][3] * tot[et][3]); }
    ss += __shfl_xor(ss, 16); ss += __shfl_xor(ss, 32);
    const float rs = rsqrtf(ss * (1.f / 64.f) + 1e-6f);
    const size_t tok = (size_t)b * SEQ + n * 128 + ai;
    const bf16* Z = (const bf16*)(p.ws + WS_Z); bf16* CAT = (bf16*)(p.ws + WS_CAT);
#pragma unroll
    for (int et = 0; et < 4; ++et) { const u32x2 gz = *(const u32x2*)(Z + tok * DIN + 9 * DG + h * 64 + 16 * et + 4 * fq); u32x2 o;
        o.x = pk2(tot[et][0] * rs * silu_f(bflo(gz.x)), tot[et][1] * rs * silu_f(bfhi(gz.x))); o.y = pk2(tot[et][2] * rs * silu_f(bflo(gz.y)), tot[et][3] * rs * silu_f(bfhi(gz.y)));
        *(u32x2*)(CAT + tok * DM + 1024 + h * 64 + 16 * et + 4 * fq) = o; }
    __syncthreads();
}

__device__ __forceinline__ void na2_task(const Params& p_, int l, int task, unsigned char* lds) {
    const Params p = *kparams(); (void)p_;
    const int tid = otid(), lane = tid & 63, w = tid >> 6, fr = lane & 15, fq = lane >> 4;
    const int hp = task & 3, rq = (task >> 2) & 63, b = task >> 8;
    const int row_start = min(max(rq - 4, 0), 56);
    const bf16* Z = (const bf16*)(p.ws + WS_Z); bf16* CAT = (bf16*)(p.ws + WS_CAT);
    bf16* VT = (bf16*)lds; float* BI = (float*)(lds + 133120);
    const int hh = w >> 2, h = hp * 2 + hh, qb = w & 3, kst = min(max(16 * qb - 8, 0), 32);
    const int c = 16 * qb + fr; const size_t qtok = (size_t)b * SEQ + rq * 64 + c;
    bf16x8v qf[2], kfr[8][2];
#pragma unroll
    for (int ks = 0; ks < 2; ++ks) qf[ks] = *(const bf16x8v*)(Z + qtok * DIN + 2 * DG + h * 64 + 32 * ks + 8 * fq);
#pragma unroll
    for (int i = 0; i < 8; ++i) { const int a = i / 2, ci = i % 2;
        const size_t ktok = (size_t)b * SEQ + (row_start + a) * 64 + kst + 16 * ci + fr;
#pragma unroll
        for (int ks = 0; ks < 2; ++ks) kfr[i][ks] = *(const bf16x8v*)(Z + ktok * DIN + 3 * DG + h * 64 + 32 * ks + 8 * fq); }
    asm volatile("" ::: "memory");
    for (int i = tid; i < 930; i += NTHR) BI[i] = p.na_bias[(size_t)(l * 8 + hp * 2) * 465 + i];
    { const int pair = lane & 31, chunk = (lane >> 5) + 2 * (w & 3);
      unsigned* VTd = (unsigned*)(VT + (size_t)hh * 64 * 520);
      u32x4 xs[8], ys[8];
#pragma unroll
      for (int a = 0; a < 8; ++a) { const size_t tok = (size_t)b * SEQ + (row_start + a) * 64 + 2 * pair;
          const bf16* src = Z + tok * DIN + 4 * DG + h * 64 + chunk * 8; xs[a] = *(const u32x4*)src; ys[a] = *(const u32x4*)(src + DIN); }
      asm volatile("" ::: "memory");
#pragma unroll
      for (int a = 0; a < 8; ++a) { const unsigned xu[4] = {xs[a].x, xs[a].y, xs[a].z, xs[a].w}, yu[4] = {ys[a].x, ys[a].y, ys[a].z, ys[a].w};
#pragma unroll
          for (int i = 0; i < 4; ++i) { VTd[(chunk * 8 + 2 * i) * 260 + a * 32 + pair] = (xu[i] & 0xffffu) | (yu[i] << 16);
              VTd[(chunk * 8 + 2 * i + 1) * 260 + a * 32 + pair] = (xu[i] >> 16) | (yu[i] & 0xffff0000u); } } }
    __syncthreads();
    const int col_start = min(max(c - 8, 0), 48);
    const float* bi = BI + hh * 465;
    float sc[16][4]; float mx = -1e30f;
#pragma unroll
    for (int hf = 0; hf < 2; ++hf) {
        if (hf == 1) {
#pragma unroll
            for (int i = 0; i < 8; ++i) { const int a = 4 + i / 2, ci = i % 2;
                const size_t ktok = (size_t)b * SEQ + (row_start + a) * 64 + kst + 16 * ci + fr;
#pragma unroll
                for (int ks = 0; ks < 2; ++ks) kfr[i][ks] = *(const bf16x8v*)(Z + ktok * DIN + 3 * DG + h * 64 + 32 * ks + 8 * fq); }
            asm volatile("" ::: "memory");
        }
#pragma unroll
        for (int i = 0; i < 8; ++i) { const int a = 4 * hf + i / 2, ci = i % 2, kt = a * 2 + ci;
            f32x4 acc = {0.f, 0.f, 0.f, 0.f};
#pragma unroll
            for (int ks = 0; ks < 2; ++ks) acc = MFMA16(kfr[i][ks], qf[ks], acc);
            const int dr = row_start + a - rq;
#pragma unroll
            for (int r = 0; r < 4; ++r) { const int kc = kst + 16 * ci + 4 * fq + r, rel = kc - col_start, dc = kc - c;
                float v = acc[r] * 0.125f + bi[(dr + 7) * 31 + min(max(dc + 15, 0), 30)];
                v = (rel >= 0 && rel < 16) ? v : -1e30f; sc[kt][r] = v; mx = fmaxf(mx, v); } }
    }
    mx = fmaxf(mx, __shfl_xor(mx, 16)); mx = fmaxf(mx, __shfl_xor(mx, 32));
    float sum = 0.f; unsigned pp[16][2];
#pragma unroll
    for (int kt = 0; kt < 16; ++kt) { const float e0 = __expf(sc[kt][0] - mx), e1 = __expf(sc[kt][1] - mx), e2 = __expf(sc[kt][2] - mx), e3 = __expf(sc[kt][3] - mx);
        sum += (e0 + e1) + (e2 + e3); pp[kt][0] = pk2(e0, e1); pp[kt][1] = pk2(e2, e3); }
    sum += __shfl_xor(sum, 16); sum += __shfl_xor(sum, 32);
    const float inv = 1.f / sum;
    const bf16* VTh = VT + (size_t)hh * 64 * 520;
#pragma unroll
    for (int dt = 0; dt < 4; ++dt) { f32x4 o = {0.f, 0.f, 0.f, 0.f};
#pragma unroll
        for (int t = 0; t < 8; ++t) { const int k0 = 2 * t, k1 = 2 * t + 1, a0 = k0 / 2, c0 = k0 % 2, a1 = k1 / 2, c1 = k1 % 2;
            const u32x2 vlo = *(const u32x2*)(VTh + (16 * dt + fr) * 520 + a0 * 64 + kst + 16 * c0 + 4 * fq), vhi = *(const u32x2*)(VTh + (16 * dt + fr) * 520 + a1 * 64 + kst + 16 * c1 + 4 * fq);
            o = MFMA16(mk8(vlo.x, vlo.y, vhi.x, vhi.y), mk8(pp[k0][0], pp[k0][1], pp[k1][0], pp[k1][1]), o); }
        const u32x2 gz = *(const u32x2*)(Z + qtok * DIN + 5 * DG + h * 64 + 16 * dt + 4 * fq); u32x2 ov;
        ov.x = pk2(o[0] * inv * silu_f(bflo(gz.x)), o[1] * inv * silu_f(bfhi(gz.x))); ov.y = pk2(o[2] * inv * silu_f(bflo(gz.y)), o[3] * inv * silu_f(bfhi(gz.y)));
        *(u32x2*)(CAT + qtok * DM + 512 + h * 64 + 16 * dt + 4 * fq) = ov; }
    __syncthreads();
}

__device__ __forceinline__ void conv_task(const Params& p_, int l, int task, unsigned char* lds) {
    const Params p = *kparams(); (void)p_;
    const int tid = otid(), lane = tid & 63, wave = tid >> 6;
    float* us = (float*)lds; float* ys = us + 46 * 512;
    const bf16* Z = (const bf16*)(p.ws + WS_Z);
    const int b = task >> 8, t0 = (task & 255) * 16;
    { u32x4 av[6], gv[6];
#pragma unroll
      for (int it = 0; it < 6; ++it) { const int idx = tid + it * NTHR, tt = idx >> 6, cc = (idx & 63) * 8, tok = t0 - 15 + tt;
          av[it] = (u32x4){0u, 0u, 0u, 0u}; gv[it] = av[it];
          if (idx < 46 * 64 && tok >= 0 && tok < SEQ) { const bf16* zr = Z + (size_t)(b * SEQ + tok) * DIN; av[it] = *(const u32x4*)(zr + 10 * DG + cc); gv[it] = *(const u32x4*)(zr + 11 * DG + cc); } }
      asm volatile("" ::: "memory");
#pragma unroll
      for (int it = 0; it < 6; ++it) { const int idx = tid + it * NTHR, tt = idx >> 6, cc = (idx & 63) * 8;
          if (idx < 46 * 64) { const u32x4 a = av[it], g = gv[it]; f32x4 u0, u1;
              u0[0] = bflo(a.x) / (1.f + __expf(-bflo(g.x))); u0[1] = bfhi(a.x) / (1.f + __expf(-bfhi(g.x))); u0[2] = bflo(a.y) / (1.f + __expf(-bflo(g.y))); u0[3] = bfhi(a.y) / (1.f + __expf(-bfhi(g.y)));
              u1[0] = bflo(a.z) / (1.f + __expf(-bflo(g.z))); u1[1] = bfhi(a.z) / (1.f + __expf(-bfhi(g.z))); u1[2] = bflo(a.w) / (1.f + __expf(-bflo(g.w))); u1[3] = bfhi(a.w) / (1.f + __expf(-bfhi(g.w)));
              *(f32x4*)(us + tt * 512 + cc) = u0; *(f32x4*)(us + tt * 512 + cc + 4) = u1; } } }
    float w[31];
#pragma unroll
    for (int k = 0; k < 31; ++k) w[k] = p.conv_w[(size_t)(l * 31 + k) * DG + tid];
    const float cb = p.conv_b[l * DG + tid];
    __syncthreads();
    for (int t = 0; t < 16; ++t) { float acc = cb;
#pragma unroll
        for (int k = 0; k < 31; ++k) acc += w[k] * us[(t + k) * 512 + tid];
        ys[t * 512 + tid] = acc; }
    __syncthreads();
#pragma unroll
    for (int tw = 0; tw < 2; ++tw) { const int t = wave + 8 * tw; float v[8]; float s = 0.f;
#pragma unroll
        for (int j = 0; j < 8; ++j) { v[j] = ys[t * 512 + lane + 64 * j]; s += v[j]; }
        const float mu = wave_sum(s) * (1.f / 512.f); float q = 0.f;
#pragma unroll
        for (int j = 0; j < 8; ++j) { v[j] -= mu; q += v[j] * v[j]; }
        const float rstd = rsqrtf(wave_sum(q) * (1.f / 512.f) + 1e-6f);
        bf16* orow = (bf16*)(p.ws + WS_CVH) + (size_t)(b * SEQ + t0 + t) * DG;
#pragma unroll
        for (int j = 0; j < 8; ++j) { const int ch = lane + 64 * j; const float y = v[j] * rstd * p.ln_g[l * DG + ch] + p.ln_b[l * DG + ch]; orow[ch] = (bf16)f2bf(silu_f(y)); } }
    __syncthreads();
}

__device__ __forceinline__ void ph_mixA(const Params& p, int l, unsigned char* lds) {
    const int G = gridDim.x, bid = obid();
    for (int t = bid; t < 512 * REP_R1; t += G) ret1_task(p, l, t & 511, lds);
    if (G == 256 && REP_NA == 1) {
        if (bid < 128) na2_task(p, l, bid, lds);
        else for (int i = 0; i < 3; ++i) na2_task(p, l, 128 + (bid - 128) * 3 + i, lds);
    } else for (int t = bid; t < 512 * REP_NA; t += G) na2_task(p, l, t & 511, lds);
    if (G == 256 && REP_CV == 1) {
        if (bid < 128) conv_task(p, l, bid, lds);
        else for (int i = 0; i < 3; ++i) conv_task(p, l, 128 + (bid - 128) * 3 + i, lds);
    } else for (int t = bid; t < 512 * REP_CV; t += G) conv_task(p, l, t & 511, lds);
}

__device__ __forceinline__ void ph_fold(const Params& p_) {
    const Params p = *kparams(); (void)p_;
    const bf16* PQ = (const bf16*)(p.ws + WS_PQT); bf16* PQF = (bf16*)(p.ws + WS_PQF);
    for (int e = obid() * NTHR + otid(); e < NB * DG * 2 * 256; e += gridDim.x * NTHR) {
        const int row = e >> 8, s0 = (e & 255) * 8, pq = row & 1;
        const bf16* src = PQ + (size_t)row * 4096;
        const u32x4 own = *(const u32x4*)(src + s0), low = *(const u32x4*)(src + 4096 - s0 - 8);
        const float top = (s0 == 0) ? 0.f : bf2f(src[4096 - s0]);
        const float sg = pq ? -1.f : 1.f;
        float o[8];
        o[0] = bflo(own.x) + sg * top;            o[1] = bfhi(own.x) + sg * bfhi(low.w);
        o[2] = bflo(own.y) + sg * bflo(low.w);    o[3] = bfhi(own.y) + sg * bfhi(low.z);
        o[4] = bflo(own.z) + sg * bflo(low.z);    o[5] = bfhi(own.z) + sg * bfhi(low.y);
        o[6] = bflo(own.w) + sg * bflo(low.y);    o[7] = bfhi(own.w) + sg * bfhi(low.x);
        if (s0 == 0 && pq) o[0] = 0.f;
        u32x4 w; w.x = pk2(o[0], o[1]); w.y = pk2(o[2], o[3]); w.z = pk2(o[4], o[5]); w.w = pk2(o[6], o[7]);
        *(u32x4*)(PQF + (size_t)row * 2048 + s0) = w;
    }
}
__device__ __forceinline__ void ph_combine(const Params& p_) {
    const Params p = *kparams(); (void)p_;
    const float* Ce = (const float*)(p.ws + WS_PART); const float* So = Ce + (size_t)2 * 2304 * 512;
    bf16* CAT = (bf16*)(p.ws + WS_CAT); const bf16* Z = (const bf16*)(p.ws + WS_Z); const bf16* PQ = (const bf16*)(p.ws + WS_PQT);
    for (int e = obid() * NTHR + otid(); e < MTOK * DG / 4; e += gridDim.x * NTHR) {
        const int row = e >> 7, c4 = (e & 127) * 4, b = row >> 12, k = row & 4095, kk = (k <= 2048) ? k : 4096 - k;
        f32x4 s = *(const f32x4*)(Ce + ((size_t)b * 2304 + kk) * 512 + c4);
        if (kk != 0 && kk != 2048) { const f32x4 so = *(const f32x4*)(So + ((size_t)b * 2048 + kk) * 512 + c4); s = (k <= 2048) ? s - so : s + so; }
        const float alt = (k & 1) ? -1.f : 1.f;
#pragma unroll
        for (int j = 0; j < 4; ++j) s[j] += alt * bf2f(PQ[((size_t)(b * 512 + c4 + j) * 2) * 4096 + 2048]);
        const u32x2 gz = *(const u32x2*)(Z + (size_t)row * DIN + DG + c4);
        u32x2 w; w.x = pk2(s[0] * silu_f(bflo(gz.x)), s[1] * silu_f(bfhi(gz.x))); w.y = pk2(s[2] * silu_f(bflo(gz.y)), s[3] * silu_f(bfhi(gz.y)));
        *(u32x2*)(CAT + (size_t)row * DM + c4) = w;
    }
}

#define XB_TMO      128
#define XB_XCNT(j)  (256  + 64 * (j))
#define XB_XSUB(j)  (1280 + 64 * (j))
#define XB_XGEN(j)  (2304 + 64 * (j))
#define XB_TOP      3328
#define XB_TOPGEN   3392
#define XCD_BAR_WORDS 3456
#define XB_SPIN_CAP (1u << 20)
__device__ __forceinline__ unsigned xb_ld(unsigned* p)              { return __hip_atomic_load(p, __ATOMIC_RELAXED, __HIP_MEMORY_SCOPE_AGENT); }
__device__ __forceinline__ unsigned xb_add(unsigned* p, unsigned v) { return __hip_atomic_fetch_add(p, v, __ATOMIC_RELAXED, __HIP_MEMORY_SCOPE_AGENT); }
__device__ __forceinline__ unsigned xb_xcc_id() { return (unsigned)__builtin_amdgcn_s_getreg((3 << 11) | 20) & 0xFu; }
#define XB_SPIN(cond, bar) do { unsigned _sp = 0; while (cond) { __builtin_amdgcn_s_sleep(1); \
    if ((++_sp & 255u) == 0u) { if (xb_ld(&(bar)[XB_TMO])) break; if (_sp > XB_SPIN_CAP) { atomicAdd(&(bar)[XB_TMO], 1u); break; } } } } while (0)
struct XcdBarrier { unsigned* bar; unsigned x; volatile PG8_LAS unsigned* st; };
__device__ __forceinline__ XcdBarrier xcd_barrier_post(unsigned* bar, volatile PG8_LAS unsigned* st) {
    XcdBarrier b; b.bar = bar; b.x = xb_xcc_id(); b.st = st;
    if (otid() == 0) (void)xb_add(&bar[XB_XCNT(b.x)], 1u);
    return b;
}
__device__ __forceinline__ void xcd_barrier_complete(unsigned* bar, unsigned x, unsigned& nloc, unsigned& nx) {
    const unsigned G = gridDim.x * gridDim.y * gridDim.z;
    unsigned sum, cnt, mine, sp = 0u;
    for (;;) {
        sum = 0u; cnt = 0u; mine = 0u;
#pragma unroll
        for (unsigned j = 0; j < 16; ++j) { const unsigned c = xb_ld(&bar[XB_XCNT(j)]); sum += c; cnt += (c > 0u) ? 1u : 0u; mine = (j == x) ? c : mine; }
        if (sum == G) break;
        __builtin_amdgcn_s_sleep(1);
        if ((++sp & 255u) == 0u) { if (xb_ld(&bar[XB_TMO])) break; if (sp > XB_SPIN_CAP) { atomicAdd(&bar[XB_TMO], 1u); break; } }
    }
    nloc = mine > 0u ? mine : 1u; nx = cnt > 0u ? cnt : 1u;
}
__device__ __forceinline__ void xcd_barrier(const XcdBarrier& b) {
    asm volatile("s_waitcnt vmcnt(0)" ::: "memory");
    __syncthreads();
    if (otid() == 0) {
        unsigned* bar = b.bar;
        __builtin_amdgcn_s_waitcnt(0);
        unsigned nloc = b.st[0], nx = b.st[1];
        if (nloc == 0u) { xcd_barrier_complete(bar, b.x, nloc, nx); b.st[0] = nloc; b.st[1] = nx; }
        const unsigned old = xb_add(&bar[XB_XSUB(b.x)], 1u);
        const unsigned gen = old / nloc;
        if (old + 1u == (gen + 1u) * nloc) {
            __builtin_amdgcn_fence(__ATOMIC_RELEASE, "agent");
            asm volatile("s_waitcnt vmcnt(0)" ::: "memory");
            const unsigned og = xb_add(&bar[XB_TOP], 1u);
            const unsigned tg = og / nx;
            if (og + 1u == (tg + 1u) * nx) xb_add(&bar[XB_TOPGEN], 1u);
            else XB_SPIN(xb_ld(&bar[XB_TOPGEN]) == tg, bar);
            __builtin_amdgcn_fence(__ATOMIC_ACQUIRE, "agent");
            xb_add(&bar[XB_XGEN(b.x)], 1u);
            asm volatile("s_waitcnt vmcnt(0)" ::: "memory");
        } else {
            XB_SPIN(xb_ld(&bar[XB_XGEN(b.x)]) == gen, bar);
            __builtin_amdgcn_fence(__ATOMIC_ACQUIRE, "agent");
            asm volatile("s_waitcnt vmcnt(0)" ::: "memory");
        }
    }
    __syncthreads();
}

constexpr int NPH = 14;
__global__ void __launch_bounds__(NTHR) mega(Params p) {
    extern __shared__ __attribute__((aligned(16))) unsigned char lds[];
    cg::grid_group grid = cg::this_grid();
    PG8_LAS unsigned char* ldsl = (PG8_LAS unsigned char*)lds;
    const int lo = p.ph_lo, hi = p.ph_hi;
#define IN(k) (lo <= (k) && (k) < hi)
#define SEAM(k) do { if (IN(k) && IN((k) + 1)) { xcd_barrier(xb); } } while (0)
    bf16* Zb = (bf16*)(kparams()->ws + WS_Z); bf16* CAT = (bf16*)(kparams()->ws + WS_CAT);
    volatile PG8_LAS unsigned* xst = (volatile PG8_LAS unsigned*)(ldsl + LDS_BYTES - 16);
    { const int t0_ = otid(); if (t0_ < 4) xst[t0_] = 0u; }
    __syncthreads();
    XcdBarrier xb = xcd_barrier_post((unsigned*)(kparams()->ws + WS_BAR), xst);
    if (p.ph_lo < 0) grid.sync();
    if (IN(0)) REPEAT(REP_PRO) { ph_prologue(p, lds); __syncthreads(); }
    SEAM(0);
    if (IN(0) && IN(1)) for (int r_ = 1; r_ < REP_SUB; ++r_) xcd_barrier(xb);
#pragma unroll
    for (int l = 0; l < NL; ++l) {
        const int pb = 1 + 6 * l;
        const char* Wl = (const char*)(kparams()->ws + WS_WIN + (size_t)l * WROWS * DM * 2);
        if (IN(pb)) {
            if (l == 0) {
#pragma unroll
                for (int ll = 0; ll < NL; ++ll) {
                    SchedS S = make_sched(kparams()->ws + WS_WCS + (size_t)ll * 1024 * DG * 2, DG, kparams()->ws + WS_WFXB + (size_t)ll * DM * DG * 2, DG, 1024, DM, 32 * ll);
                    EpiZ E{(bf16*)(kparams()->ws + WS_WIN + ((size_t)ll * WROWS + 6656) * DM * 2), DM};
                    pg8::gemm_phase<EpiZ, SchedS, true>(ldsl, pg8::Gemm{DG, DG, DG}, S, E);
                }
            }
            REPEAT(REP_NORM) ph_norm(p, l);
        }
        SEAM(pb);
        if (IN(pb + 1)) REPEAT(REP_Z) {
            SchedZ S; S.o.init(MTOK, 24 * 256, (int)gridDim.x, obid()); S.A = (const char*)(kparams()->ws + WS_U); S.B = Wl; S.late = 0;
            EpiZ2 E{Zb, (bf16*)(kparams()->ws + WS_PQT)};
            pg8::gemm_phase<EpiZ2, SchedZ, true>(ldsl, pg8::Gemm{DM, DM, DM}, S, E);
        }
        SEAM(pb + 1);
        if (IN(pb + 2)) {
            {
                SchedZ S; S.o.init(MTOK, 4 * 256, (int)gridDim.x, obid()); S.A = (const char*)(kparams()->ws + WS_U); S.B = Wl; S.late = 1;
                EpiZ2 E{Zb, (bf16*)(kparams()->ws + WS_PQT)};
                pg8::gemm_phase<EpiZ2, SchedZ, true>(ldsl, pg8::Gemm{DM, DM, DM}, S, E);
            }
            REPEAT(REP_MIX) ph_mixA(p, l, lds);
            ph_fold(p);
        }
        SEAM(pb + 2);
        if (IN(pb + 3)) REPEAT(REP_P3) {
            const int G_ = (int)gridDim.x, b_ = obid(); const bool bal = (G_ == 256);
            {
                SchedDFT S{(const char*)(kparams()->ws + WS_DC), (const char*)(kparams()->ws + WS_DS), (const char*)(kparams()->ws + WS_PQF), G_, b_};
                EpiPart E{(float*)(kparams()->ws + WS_PART)};
                pg8::gemm_phase<EpiPart, SchedDFT, true>(ldsl, pg8::Gemm{2048, 4096, 2048}, S, E); }
            {
                SchedS S = make_sched(kparams()->ws + WS_CVH, DG, kparams()->ws + WS_WPW + (size_t)l * DG * DG * 2, DG, MTOK, DG, 68);
                EpiGate E{CAT, Zb, 1536, 12 * DG};
                pg8::gemm_phase<EpiGate, SchedS, true>(ldsl, pg8::Gemm{DG, DG, DG}, S, E); }
            if (bal && REP_R2 == 1) { for (int t = b_ - 68; t >= 0 && t < 512; t += 188) ret2_task(p, l, t, lds); }
            else for (int t = b_; t < 512 * REP_R2; t += G_) ret2_task(p, l, t & 511, lds);
        }
        SEAM(pb + 3);
        if (IN(pb + 4)) REPEAT(REP_CMB) ph_combine(p);
        SEAM(pb + 4);
        if (IN(pb + 5)) REPEAT(l == 0 ? REP_OUT : 1) {
            SchedS S = make_sched(CAT, DM, kparams()->ws + WS_WOUT + (size_t)l * DM * DM * 2, DM, MTOK, DM);
            EpiRes E{(l == 0) ? kparams()->x : kparams()->out, kparams()->out, (const float*)(kparams()->ws + WS_MOD) + (size_t)l * 2 * 6144 + 4096};
            pg8::gemm_phase<EpiRes, SchedS, true>(ldsl, pg8::Gemm{DM, DM, DM}, S, E);
        }
        SEAM(pb + 5);
    }
    if (IN(NPH - 1)) ph_final(p);
#undef IN
#undef SEAM
}

extern "C" void kernel_launch(void* const* d_in, const int* in_sizes, int n_in, void* d_out, int out_size, void* d_ws, size_t ws_size, hipStream_t stream) {
    static int grid_blocks = 0;
    if (grid_blocks == 0) {
        if (n_in != 17 || ws_size < WS_END) { fprintf(stderr, "kernel_launch: n_in %d ws %zu (need %zu)\n", n_in, ws_size, (size_t)WS_END); grid_blocks = -1; return; }
        int dev = 0, cus = 0, per_cu = 0;
        hipGetDevice(&dev); hipDeviceGetAttribute(&cus, hipDeviceAttributeMultiprocessorCount, dev);
        if (hipFuncSetAttribute((const void*)mega, hipFuncAttributeMaxDynamicSharedMemorySize, LDS_BYTES) != hipSuccess) { fprintf(stderr, "hipFuncSetAttribute failed\n"); grid_blocks = -1; return; }
        if (hipOccupancyMaxActiveBlocksPerMultiprocessor(&per_cu, (const void*)mega, NTHR, LDS_BYTES) != hipSuccess || per_cu < 1) { fprintf(stderr, "occupancy query: %d\n", per_cu); per_cu = 1; }
        (void)hipGetLastError();
        grid_blocks = cus * 1;
    }
    if (grid_blocks < 0) return;
    Params p{};
    p.x = (const float*)d_in[0]; p.c = (const float*)d_in[1]; p.norm_g = (const float*)d_in[2]; p.w_ada = (const float*)d_in[3]; p.b_ada = (const float*)d_in[4];
    p.w_in = (const float*)d_in[5]; p.w_fft = (const float*)d_in[6]; p.na_bias = (const float*)d_in[7]; p.rl_f = (const float*)d_in[8]; p.rl_b = (const float*)d_in[9];
    p.conv_w = (const float*)d_in[10]; p.conv_b = (const float*)d_in[11]; p.ln_g = (const float*)d_in[12]; p.ln_b = (const float*)d_in[13]; p.w_pw = (const float*)d_in[14];
    p.w_out = (const float*)d_in[15]; p.final_g = (const float*)d_in[16];
    p.out = (float*)d_out; p.ws = (unsigned char*)d_ws;
#if ONE_LAUNCH
    if (hipMemsetAsync((char*)d_ws + WS_BAR, 0, 16384, stream) != hipSuccess) { fprintf(stderr, "memset of the barrier words failed\n"); return; }
    p.ph_lo = 0; p.ph_hi = NPH;
    void* args[] = {&p};
    hipError_t e = hipLaunchCooperativeKernel((const void*)mega, dim3(grid_blocks), dim3(NTHR), args, LDS_BYTES, stream);
    if (e != hipSuccess) fprintf(stderr, "cooperative launch failed: %s (grid %d)\n", hipGetErrorString(e), grid_blocks);
#else
    for (int ph = 0; ph < NPH; ++ph) { p.ph_lo = ph; p.ph_hi = ph + 1; hipLaunchKernelGGL(mega, dim3(grid_blocks), dim3(NTHR), LDS_BYTES, stream, p); }
#endif
}
```

```cpp
#include <hip/hip_runtime.h>
#include <hip/hip_cooperative_groups.h>
#include <cstdio>
#include <cstdint>
namespace cg = cooperative_groups;

#ifndef ONE_LAUNCH
#define ONE_LAUNCH 1
#endif

__device__ __forceinline__ int obid() { int b = (int)blockIdx.x; asm volatile("" : "+s"(b)); return b; }
__device__ __forceinline__ int otid() { int t; asm volatile("v_mov_b32 %0, %1" : "=v"(t) : "v"(threadIdx.x)); return t; }
namespace pg8 {
#define PG8_LAS __attribute__((address_space(3)))
typedef unsigned short bf16_t;
typedef short bf16x8 __attribute__((ext_vector_type(8)));
typedef float f32x4 __attribute__((ext_vector_type(4)));
typedef unsigned u32x4 __attribute__((ext_vector_type(4)));
constexpr int BM = 256, BK = 64, HALF = 128, HTB = HALF * BK * 2, STAGE_BYTES = 8 * HTB, NXCD = 8, WGM = 8;

__host__ __device__ __forceinline__ int lds_byte(int r, int c) { const int st = (r >> 4) * 2 + (c >> 5), rr = r & 15, cc = c & 31, ob = rr * 64 + cc * 2; return st * 1024 + (ob ^ (((ob >> 9) & 1) << 5)); }
__host__ __device__ __forceinline__ void stage_rc(int b, int& R, int& C) { const int st = b / 1024, sb = b % 1024, swz = sb ^ (((sb >> 9) & 1) << 5); R = (st >> 1) * 16 + swz / 64; C = (st & 1) * 32 + (swz % 64) / 2; }
__host__ __device__ __forceinline__ int perm32(int rho) { const int n = rho >> 4, i = rho & 15; return 8 * (i >> 2) + 4 * n + (i & 3); }

struct Unit { int pm, pn, aux, pad; const char* A; const char* B; };
struct Gemm { int lda, ldb, K; };

struct StaticOrder {
    int nM, nN, nwg, G, c;
    __host__ __device__ void init(int M, int N, int G_, int c_) { nM = M / BM; nN = N / BM; nwg = nM * nN; G = G_; c = c_; }
    __device__ bool next(int i, Unit& u) const {
        const long L = (long)i * G + c; if (L >= nwg) return false;
        int wgid = __builtin_amdgcn_readfirstlane((int)L); { const int q = nwg / NXCD, r = nwg % NXCD, xcd = wgid % NXCD, off = wgid / NXCD; wgid = (xcd < r ? xcd * (q + 1) : r * (q + 1) + (xcd - r) * q) + off; }
        const int nig = WGM * nN, gid = wgid / nig, fm = gid * WGM, gsz = (nM - fm) < WGM ? (nM - fm) : WGM;
        u.pm = __builtin_amdgcn_readfirstlane(fm + ((wgid % nig) % gsz)); u.pn = __builtin_amdgcn_readfirstlane((wgid % nig) / gsz); return true;
    }
};

__device__ __forceinline__ unsigned cvt_pk_bf16(float lo, float hi) { unsigned r; asm volatile("v_cvt_pk_bf16_f32 %0, %1, %2" : "=v"(r) : "v"(lo), "v"(hi)); return r; }

template <class Epi, class Sched, bool ALIGN_EPI>
__device__ __forceinline__ void gemm_phase(PG8_LAS unsigned char* lds, const Gemm g, const Sched& S, const Epi& E) {
    const int tid = otid(), wid = __builtin_amdgcn_readfirstlane(tid >> 6), lane = tid & 63, wr = wid >> 2, wc = wid & 3, fr = lane & 15, fq = lane >> 4;
    const int K = g.K, nt = K / BK;
    unsigned voffA[2], voffB[2];
#pragma unroll
    for (int i = 0; i < 2; ++i) { int R, C; stage_rc(tid * 16 + i * 8192, R, C); const int Rb = Epi::PERM ? ((R & ~31) + perm32(R & 31)) : R;
        voffA[i] = (unsigned)(R * g.lda + C) * 2u; voffB[i] = (unsigned)(Rb * g.ldb + C) * 2u; }
    const size_t kstep = (size_t)(BK * 2);
    const size_t hA = (size_t)HALF * g.lda * 2, hB = (size_t)HALF * g.ldb * 2;
    const unsigned ldsw = (unsigned)wid * 1024u;
    const int aoff = lds_byte(wr * 64 + fr, fq * 8), boff = lds_byte(wc * 32 + fr, fq * 8);
#define PG8_SA(b, h) (((b) * 2 + (h)) * HTB)
#define PG8_SB(b, h) ((4 + (b) * 2 + (h)) * HTB)
#define PG8_STAGE(bufoff, gbase, voff) do { _Pragma("unroll") for (int _i = 0; _i < 2; ++_i) \
        __builtin_amdgcn_global_load_lds((const unsigned*)((const char*)(gbase) + (voff)[_i]), (PG8_LAS unsigned*)(lds + (bufoff) + ldsw + _i * 8192), 16, 0, 0); } while (0)
#define PG8_LDA(dst, b, h) do { _Pragma("unroll") for (int m = 0; m < 4; ++m) _Pragma("unroll") for (int k = 0; k < 2; ++k) dst[m][k] = *(const PG8_LAS bf16x8*)(lds + PG8_SA(b, h) + aoff + m * 2048 + k * 1024); } while (0)
#define PG8_LDB(dst, b, h) do { _Pragma("unroll") for (int n = 0; n < 2; ++n) _Pragma("unroll") for (int k = 0; k < 2; ++k) dst[n][k] = *(const PG8_LAS bf16x8*)(lds + PG8_SB(b, h) + boff + n * 2048 + k * 1024); } while (0)
#define PG8_MMA(ai, bj, At, Bt) do { __builtin_amdgcn_s_setprio(1); _Pragma("unroll") for (int m = 0; m < 4; ++m) _Pragma("unroll") for (int n = 0; n < 2; ++n) _Pragma("unroll") for (int k = 0; k < 2; ++k) \
        acc[ai][bj][m][n] = __builtin_amdgcn_mfma_f32_16x16x32_bf16(Bt[n][k], At[m][k], acc[ai][bj][m][n], 0, 0, 0); __builtin_amdgcn_s_setprio(0); } while (0)
#define PG8_WAIT_V(n) asm volatile("s_waitcnt vmcnt(" #n ")" ::: "memory")
#define PG8_WAIT_L(n) asm volatile("s_waitcnt lgkmcnt(" #n ")" ::: "memory")
#define PG8_BAR __builtin_amdgcn_s_barrier()
#define PG8_SCHED __builtin_amdgcn_sched_barrier(0)
    Unit cur, nxt; int ui = 0;
    if (!S.next(0, cur)) return;
    f32x4 acc[2][2][4][2];
#pragma unroll
    for (int a = 0; a < 2; ++a)
#pragma unroll
        for (int b = 0; b < 2; ++b)
#pragma unroll
            for (int m = 0; m < 4; ++m)
#pragma unroll
                for (int n = 0; n < 2; ++n) acc[a][b][m][n] = (f32x4){0.f, 0.f, 0.f, 0.f};
    bf16x8 At[4][2], B0[2][2], B1[2][2];
    const char* cA = cur.A; const char* cB = cur.B;
    PG8_STAGE(PG8_SB(0, 0), cB, voffB); PG8_STAGE(PG8_SB(0, 1), cB + hB, voffB); PG8_STAGE(PG8_SA(0, 0), cA, voffA); PG8_STAGE(PG8_SA(0, 1), cA + hA, voffA);
    if (wr == 1) PG8_BAR;
    PG8_WAIT_V(2); PG8_BAR;
    PG8_STAGE(PG8_SB(1, 0), cB + kstep, voffB); PG8_STAGE(PG8_SA(1, 0), cA + kstep, voffA); PG8_STAGE(PG8_SB(1, 1), cB + hB + kstep, voffB);
    PG8_WAIT_V(6); PG8_BAR;
    for (;;) {
        const bool has_next = S.next(ui + 1, nxt);
        const char* nA = has_next ? nxt.A : cA; const char* nB = has_next ? nxt.B : cB;
        for (int t = 0; t < nt; t += 2) {
            const bool last = (t == nt - 2);
            const char* a1 = cA + (size_t)(t + 1) * kstep;
            const char* a2 = last ? nA : cA + (size_t)(t + 2) * kstep; const char* b2 = last ? nB : cB + (size_t)(t + 2) * kstep;
            const char* a3 = a2 + kstep; const char* b3 = b2 + kstep;
            PG8_LDB(B0, 0, 0); PG8_LDB(B1, 0, 1); PG8_SCHED; PG8_LDA(At, 0, 0); PG8_STAGE(PG8_SA(1, 1), a1 + hA, voffA);
            PG8_WAIT_V(8); PG8_WAIT_L(0); PG8_BAR; PG8_MMA(0, 0, At, B0); PG8_MMA(0, 1, At, B1); PG8_BAR; PG8_SCHED;
            PG8_LDA(At, 0, 1); PG8_STAGE(PG8_SB(0, 0), b2, voffB); PG8_STAGE(PG8_SB(0, 1), b2 + hB, voffB); PG8_STAGE(PG8_SA(0, 0), a2, voffA);
            PG8_WAIT_V(8); PG8_WAIT_L(0); PG8_BAR; PG8_MMA(1, 0, At, B0); PG8_MMA(1, 1, At, B1); PG8_BAR; PG8_SCHED;
            PG8_LDB(B0, 1, 0); PG8_LDB(B1, 1, 1); PG8_SCHED; PG8_LDA(At, 1, 0); PG8_STAGE(PG8_SA(0, 1), a2 + hA, voffA);
            PG8_WAIT_V(8); PG8_WAIT_L(0); PG8_BAR; PG8_MMA(0, 0, At, B0); PG8_MMA(0, 1, At, B1); PG8_BAR; PG8_SCHED;
            PG8_LDA(At, 1, 1); PG8_STAGE(PG8_SB(1, 0), b3, voffB); PG8_STAGE(PG8_SB(1, 1), b3 + hB, voffB); PG8_STAGE(PG8_SA(1, 0), a3, voffA);
            PG8_WAIT_V(8); PG8_WAIT_L(0); PG8_BAR; PG8_MMA(1, 0, At, B0); PG8_MMA(1, 1, At, B1); PG8_BAR; PG8_SCHED;
        }
        if constexpr (ALIGN_EPI) { if (wr == 0) PG8_BAR; }
        E(acc, cur, wr, wc, fr, fq);
        if (!has_next) break;
#pragma unroll
        for (int a = 0; a < 2; ++a)
#pragma unroll
            for (int b = 0; b < 2; ++b)
#pragma unroll
                for (int m = 0; m < 4; ++m)
#pragma unroll
                    for (int n = 0; n < 2; ++n) acc[a][b][m][n] = (f32x4){0.f, 0.f, 0.f, 0.f};
        cur = nxt; cA = nA; cB = nB; ++ui;
        if constexpr (ALIGN_EPI) { if (wr == 1) PG8_BAR; }
    }
    PG8_WAIT_V(0);
    if constexpr (!ALIGN_EPI) { if (wr == 0) PG8_BAR; }
    PG8_BAR;
#undef PG8_SA
#undef PG8_SB
#undef PG8_STAGE
#undef PG8_LDA
#undef PG8_LDB
#undef PG8_MMA
#undef PG8_WAIT_V
#undef PG8_WAIT_L
#undef PG8_BAR
#undef PG8_SCHED
}
}

typedef unsigned short bf16;
typedef float f32x4 __attribute__((ext_vector_type(4)));
typedef unsigned u32x4 __attribute__((ext_vector_type(4)));
typedef unsigned u32x2 __attribute__((ext_vector_type(2)));
constexpr int NB = 2, SEQ = 4096, DM = 2048, MTOK = NB * SEQ, DIN = 6656, DG = 512, NL = 2;
constexpr int LDS_BYTES = 147456;
constexpr int NTHR = 512;

constexpr int WROWS = 7680;
constexpr size_t WS_WIN = 0;
constexpr size_t WS_WOUT = WS_WIN + (size_t)NL * WROWS * DM * 2;
constexpr size_t WS_WCS = WS_WOUT + (size_t)NL * DM * DM * 2;
constexpr size_t WS_WFXB = WS_WCS + (size_t)NL * 1024 * DG * 2;
constexpr size_t WS_WPW = WS_WFXB + (size_t)NL * DM * DG * 2;
constexpr size_t WS_DC = WS_WPW + (size_t)NL * DG * DG * 2;
constexpr size_t WS_DS = WS_DC + (size_t)2304 * 2048 * 2;
constexpr size_t WS_PQF = WS_DS + (size_t)2048 * 2048 * 2;
constexpr size_t WS_ROPE = WS_PQF + (size_t)NB * DG * 2 * 2048 * 2;
constexpr size_t WS_MOD = WS_ROPE + (size_t)SEQ * 32 * 8;
constexpr size_t WS_U = WS_MOD + 131072;
constexpr size_t WS_PART = WS_U + (size_t)MTOK * DM * 2;
constexpr size_t WS_Z = WS_U + (size_t)4 * MTOK * DG * 4;
constexpr size_t WS_PQT = WS_Z + (size_t)MTOK * DIN * 2;
constexpr size_t WS_CVH = WS_PQT + (size_t)NB * DG * 2 * SEQ * 2;
constexpr size_t WS_CAT = WS_CVH + (size_t)MTOK * DG * 2;
constexpr size_t WS_KV = WS_CAT + (size_t)MTOK * DM * 2;
constexpr size_t WS_BAR = WS_KV + (size_t)2 * NB * 8 * 32 * 4096 * 4;
constexpr size_t WS_END = WS_BAR + 16384;

struct Params {
    const float* x; const float* c; const float* norm_g; const float* w_ada; const float* b_ada; const float* w_in; const float* w_fft; const float* na_bias;
    const float* rl_f; const float* rl_b; const float* conv_w; const float* conv_b; const float* ln_g; const float* ln_b; const float* w_pw; const float* w_out; const float* final_g;
    float* out; unsigned char* ws; int ph_lo, ph_hi;
};

#if defined(__HIP_DEVICE_COMPILE__)
typedef const __attribute__((address_space(4))) Params* KParams;
__device__ __forceinline__ KParams kparams() { KParams k = (KParams)__builtin_amdgcn_kernarg_segment_ptr(); asm volatile("" : "+s"(k)); return k; }
#else
typedef const Params* KParams;
__device__ __forceinline__ KParams kparams() { return nullptr; }
#endif
__device__ __forceinline__ unsigned f2bf(float f) { unsigned u = __float_as_uint(f); return (u + 0x7fffu + ((u >> 16) & 1u)) >> 16; }
__device__ __forceinline__ unsigned pk2(float lo, float hi) { return f2bf(lo) | (f2bf(hi) << 16); }
__device__ __forceinline__ float bf2f(bf16 b) { return __uint_as_float((unsigned)b << 16); }
__device__ __forceinline__ float bflo(unsigned u) { return __uint_as_float(u << 16); }
__device__ __forceinline__ float bfhi(unsigned u) { return __uint_as_float(u & 0xffff0000u); }
__device__ __forceinline__ float silu_f(float v) { return v / (1.f + __expf(-v)); }
__device__ __forceinline__ float wave_sum(float v) {
#pragma unroll
    for (int o = 1; o < 64; o <<= 1) v += __shfl_xor(v, o);
    return v;
}
__device__ __forceinline__ float wave_max(float v) {
#pragma unroll
    for (int o = 1; o < 64; o <<= 1) v = fmaxf(v, __shfl_xor(v, o));
    return v;
}

struct SchedS {
    pg8::StaticOrder o; const char* A; const char* B; size_t ta, tb;
    __device__ __forceinline__ bool next(int i, pg8::Unit& u) const { if (!o.next(i, u)) return false; u.A = A + (size_t)u.pm * ta; u.B = B + (size_t)u.pn * tb; u.aux = 0; return true; }
};
__device__ __forceinline__ SchedS make_sched(const void* A, int lda, const void* B, int ldb, int M, int N, int shift = 0) {
    SchedS s; s.o.init(M, N, (int)gridDim.x, (int)((obid() + gridDim.x - shift) % gridDim.x)); s.A = (const char*)A; s.B = (const char*)B; s.ta = (size_t)256 * lda * 2; s.tb = (size_t)256 * ldb * 2; return s;
}
struct SchedZ {
    pg8::StaticOrder o; const char* A; const char* B; int late;
    __device__ __forceinline__ bool next(int i, pg8::Unit& u) const { if (!o.next(i, u)) return false; const int jn = u.pn;
        u.pn = late ? (jn < 2 ? 2 + jn : 22 + jn) : (jn < 20 ? jn + 4 : jn + 6);
        u.A = A + (size_t)u.pm * (256 * DM * 2); u.B = B + (size_t)u.pn * (256 * DM * 2); u.aux = 0; return true; }
};
struct SchedDFT {
    const char* DC; const char* PQF; int G, c;
    __device__ __forceinline__ bool next(int i, pg8::Unit& u) const {
        if (c < 0) return false;
        const int L = __builtin_amdgcn_readfirstlane(i * G + c); if (L >= 64) return false;
        const int b = L >> 5, t = L & 31, odd = t >> 4, tt = t & 15; u.pm = tt >> 1; u.pn = tt & 1; u.aux = b * 2 + odd;
        u.A = DC + (size_t)odd * (WS_DS - WS_DC) + (size_t)u.pm * (256 * 2048 * 2);
        u.B = PQF + ((size_t)(b * 512 + u.pn * 256) * 4096 + odd * 2048) * 2; return true;
    }
};

struct EpiZ {
    static constexpr bool PERM = true;
    bf16* O; int ldc;
    __device__ __forceinline__ void operator()(const pg8::f32x4 (&acc)[2][2][4][2], const pg8::Unit& u, int wr, int wc, int fr, int fq) const {
        const int row0 = u.pm * 256 + wr * 64 + fr, col0 = u.pn * 256 + wc * 32 + 8 * fq;
#pragma unroll
        for (int ai = 0; ai < 2; ++ai)
#pragma unroll
            for (int m = 0; m < 4; ++m) { bf16* rowp = O + (size_t)(row0 + ai * 128 + m * 16) * ldc + col0;
#pragma unroll
                for (int bj = 0; bj < 2; ++bj) { const pg8::f32x4 v0 = acc[ai][bj][m][0], v1 = acc[ai][bj][m][1]; u32x4 w;
                    w.x = pg8::cvt_pk_bf16(v0[0], v0[1]); w.y = pg8::cvt_pk_bf16(v0[2], v0[3]); w.z = pg8::cvt_pk_bf16(v1[0], v1[1]); w.w = pg8::cvt_pk_bf16(v1[2], v1[3]);
                    *(u32x4*)(rowp + bj * 128) = w; } }
    }
};
struct EpiZ2 {
    static constexpr bool PERM = true;
    bf16* O; bf16* PQ;
    __device__ __forceinline__ void operator()(const pg8::f32x4 (&acc)[2][2][4][2], const pg8::Unit& u, int wr, int wc, int fr, int fq) const {
        const int row0 = u.pm * 256 + wr * 64 + fr;
        if (u.pn < 26) { const int col0 = u.pn * 256 + wc * 32 + 8 * fq;
#pragma unroll
            for (int ai = 0; ai < 2; ++ai)
#pragma unroll
                for (int m = 0; m < 4; ++m) { bf16* rowp = O + (size_t)(row0 + ai * 128 + m * 16) * DIN + col0;
#pragma unroll
                    for (int bj = 0; bj < 2; ++bj) { const pg8::f32x4 v0 = acc[ai][bj][m][0], v1 = acc[ai][bj][m][1]; u32x4 w;
                        w.x = pg8::cvt_pk_bf16(v0[0], v0[1]); w.y = pg8::cvt_pk_bf16(v0[2], v0[3]); w.z = pg8::cvt_pk_bf16(v1[0], v1[1]); w.w = pg8::cvt_pk_bf16(v1[2], v1[3]);
                        *(u32x4*)(rowp + bj * 128) = w; } }
        } else { const int np0 = (u.pn - 26) * 256 + wc * 32 + 8 * fq;
#pragma unroll
            for (int bj = 0; bj < 2; ++bj) { const int np = np0 + bj * 128, pq = np >> 9, n = np & 511;
#pragma unroll
                for (int ai = 0; ai < 2; ++ai)
#pragma unroll
                    for (int m = 0; m < 4; ++m) { const int row = row0 + ai * 128 + m * 16, b = row >> 12, sq = row & 4095;
                        bf16* dst = PQ + ((size_t)(b * 512 + n) * 2 + pq) * 4096 + sq;
#pragma unroll
                        for (int nn = 0; nn < 2; ++nn)
#pragma unroll
                            for (int j = 0; j < 4; ++j) dst[(size_t)(4 * nn + j) * 8192] = (bf16)f2bf(acc[ai][bj][m][nn][j]); } }
        }
    }
};
struct EpiGate {
    static constexpr bool PERM = true;
    bf16* O; const bf16* Z; int coff, goff;
    __device__ __forceinline__ void operator()(const pg8::f32x4 (&acc)[2][2][4][2], const pg8::Unit& u, int wr, int wc, int fr, int fq) const {
        const int row0 = u.pm * 256 + wr * 64 + fr, col0 = u.pn * 256 + wc * 32 + 8 * fq;
#pragma unroll
        for (int ai = 0; ai < 2; ++ai)
#pragma unroll
            for (int m = 0; m < 4; ++m) { const size_t row = (size_t)(row0 + ai * 128 + m * 16);
#pragma unroll
                for (int bj = 0; bj < 2; ++bj) { const pg8::f32x4 v0 = acc[ai][bj][m][0], v1 = acc[ai][bj][m][1];
                    const u32x4 gz = *(const u32x4*)(Z + row * DIN + goff + col0 + bj * 128); u32x4 w;
                    w.x = pg8::cvt_pk_bf16(v0[0] * silu_f(bflo(gz.x)), v0[1] * silu_f(bfhi(gz.x))); w.y = pg8::cvt_pk_bf16(v0[2] * silu_f(bflo(gz.y)), v0[3] * silu_f(bfhi(gz.y)));
                    w.z = pg8::cvt_pk_bf16(v1[0] * silu_f(bflo(gz.z)), v1[1] * silu_f(bfhi(gz.z))); w.w = pg8::cvt_pk_bf16(v1[2] * silu_f(bflo(gz.w)), v1[3] * silu_f(bfhi(gz.w)));
                    *(u32x4*)(O + row * DM + coff + col0 + bj * 128) = w; } }
    }
};
struct EpiPart {
    static constexpr bool PERM = false;
    float* P;
    __device__ __forceinline__ void operator()(const pg8::f32x4 (&acc)[2][2][4][2], const pg8::Unit& u, int wr, int wc, int fr, int fq) const {
        const int row0 = u.pm * 256 + wr * 64 + fr, col0 = u.pn * 256 + wc * 32 + 4 * fq;
        float* base = (u.aux & 1) ? P + (size_t)2 * 2304 * 512 + (size_t)(u.aux >> 1) * 2048 * 512 : P + (size_t)(u.aux >> 1) * 2304 * 512;
#pragma unroll
        for (int ai = 0; ai < 2; ++ai)
#pragma unroll
            for (int m = 0; m < 4; ++m) { float* rowp = base + (size_t)(row0 + ai * 128 + m * 16) * 512 + col0;
#pragma unroll
                for (int bj = 0; bj < 2; ++bj)
#pragma unroll
                    for (int n = 0; n < 2; ++n) *(pg8::f32x4*)(rowp + bj * 128 + n * 16) = acc[ai][bj][m][n]; }
    }
};
struct EpiRes {
    static constexpr bool PERM = false;
    const float* xin; float* xout; const float* gate;
    __device__ __forceinline__ void operator()(const pg8::f32x4 (&acc)[2][2][4][2], const pg8::Unit& u, int wr, int wc, int fr, int fq) const {
        const int row0 = u.pm * 256 + wr * 64 + fr, col0 = u.pn * 256 + wc * 32 + 4 * fq;
        const float* gp = gate + (size_t)(u.pm >> 4) * 6144 + col0;
        pg8::f32x4 gv[2][2];
#pragma unroll
        for (int bj = 0; bj < 2; ++bj)
#pragma unroll
            for (int n = 0; n < 2; ++n) gv[bj][n] = *(const pg8::f32x4*)(gp + bj * 128 + n * 16);
#pragma unroll
        for (int ai = 0; ai < 2; ++ai)
#pragma unroll
            for (int m = 0; m < 4; ++m) { const size_t ro = (size_t)(row0 + ai * 128 + m * 16) * DM + col0;
#pragma unroll
                for (int bj = 0; bj < 2; ++bj)
#pragma unroll
                    for (int n = 0; n < 2; ++n) { const pg8::f32x4 xi = *(const pg8::f32x4*)(xin + ro + bj * 128 + n * 16);
                        *(pg8::f32x4*)(xout + ro + bj * 128 + n * 16) = xi + gv[bj][n] * acc[ai][bj][m][n]; } }
    }
};

struct TPItem { const float* src; bf16* dst; int N, K; };
__device__ __forceinline__ TPItem tp_decode(const Params& p, int it, int tid) {
    constexpr int T_IN = 32 * 96, T_OUT = 32 * 32, T_S = 64, T_L = T_IN + T_OUT + T_S;
    const int l = it / T_L; int r = it % T_L; const float* W; bf16* WT; int K, N, kb, nb;
    if (r < T_IN) { W = p.w_in + (size_t)l * DM * DIN; WT = (bf16*)(p.ws + WS_WIN) + (size_t)l * WROWS * DM; K = DM; N = DIN; kb = r / 96; nb = 8 + r % 96; }
    else if (r < T_IN + T_OUT) { r -= T_IN; W = p.w_out + (size_t)l * DM * DM; WT = (bf16*)(p.ws + WS_WOUT) + (size_t)l * DM * DM; K = DM; N = DM; kb = r >> 5; nb = r & 31; }
    else { r -= T_IN + T_OUT; W = p.w_pw + (size_t)l * DG * DG; WT = (bf16*)(p.ws + WS_WPW) + (size_t)l * DG * DG; K = DG; N = DG; kb = r >> 3; nb = r & 7; }
    TPItem t; t.N = N; t.K = K;
    t.src = W + (size_t)(kb * 64 + (tid >> 4)) * N + nb * 64 + (tid & 15) * 4;
    t.dst = WT + (size_t)(nb * 64 + (tid >> 3)) * K + kb * 64 + (tid & 7) * 8;
    return t;
}
__device__ __forceinline__ void tp_store(const TPItem& t, int tid, const f32x4& v0, const f32x4& v1, float* scr) {
    { const int kk = tid >> 4, nn = (tid & 15) * 4;
      scr[kk * 65 + nn] = v0[0]; scr[kk * 65 + nn + 1] = v0[1]; scr[kk * 65 + nn + 2] = v0[2]; scr[kk * 65 + nn + 3] = v0[3];
      scr[(kk + 32) * 65 + nn] = v1[0]; scr[(kk + 32) * 65 + nn + 1] = v1[1]; scr[(kk + 32) * 65 + nn + 2] = v1[2]; scr[(kk + 32) * 65 + nn + 3] = v1[3]; }
    __syncthreads();
    { const int n = tid >> 3, kc = (tid & 7) * 8; const float* s = scr + kc * 65 + n; u32x4 o;
      o.x = pk2(s[0], s[65]); o.y = pk2(s[2 * 65], s[3 * 65]); o.z = pk2(s[4 * 65], s[5 * 65]); o.w = pk2(s[6 * 65], s[7 * 65]);
      *(u32x4*)t.dst = o; }
    __syncthreads();
}

__device__ __forceinline__ void ph_prologue(const Params& p_, unsigned char* lds) {
    const Params p = *kparams(); (void)p_;
    const int tid = otid(), lane = tid & 63, wave = tid >> 6, G = gridDim.x, bid = obid();
    float* scr = (float*)lds;
    { constexpr int T_TOT = NL * (32 * 96 + 32 * 32 + 64);
      int it = bid; TPItem cur; f32x4 a0, a1;
      if (it < T_TOT) { cur = tp_decode(p, it, tid); a0 = *(const f32x4*)cur.src; a1 = *(const f32x4*)(cur.src + (size_t)32 * cur.N); }
      while (it < T_TOT) { const int nit = it + G; TPItem nxt = cur; f32x4 b0 = a0, b1 = a1;
          if (nit < T_TOT) { nxt = tp_decode(p, nit, tid); b0 = *(const f32x4*)nxt.src; b1 = *(const f32x4*)(nxt.src + (size_t)32 * nxt.N); }
          tp_store(cur, tid, a0, a1, scr);
          cur = nxt; a0 = b0; a1 = b1; it = nit; } }
    { bf16* Wfx = (bf16*)(p.ws + WS_WFXB);
      for (int e = bid * NTHR + tid; e < NL * DM * DG / 8; e += G * NTHR) { const int l = e >> 17, r = e & 131071, k = r >> 6, c8 = (r & 63) * 8;
          const float* src = p.w_in + ((size_t)l * DM + k) * DIN + c8; const f32x4 a = *(const f32x4*)src, b4 = *(const f32x4*)(src + 4);
          u32x4 o; o.x = pk2(a[0], a[1]); o.y = pk2(a[2], a[3]); o.z = pk2(b4[0], b4[1]); o.w = pk2(b4[2], b4[3]);
          *(u32x4*)(Wfx + ((size_t)l * DM + k) * DG + c8) = o; } }
    { float* Wl = (float*)lds; float* tr = Wl + 128 * 65; bf16* Wcs = (bf16*)(p.ws + WS_WCS);
      for (int t2 = G - 1 - bid; t2 < 256; t2 += G) {
          const int t = t2 >> 1, ch = t2 & 1, l = t >> 6, pq = (t >> 5) & 1, g = (t >> 3) & 3, n0 = (t & 7) * 64;
#pragma unroll
          for (int i = 0; i < 4; ++i) { const int m = (tid >> 4) + 32 * i, nn = (tid & 15) * 4;
              const f32x4 v = *(const f32x4*)(p.w_fft + ((size_t)l * DG + g * 128 + m) * DG + n0 + nn);
              Wl[m * 65 + nn] = v[0]; Wl[m * 65 + nn + 1] = v[1]; Wl[m * 65 + nn + 2] = v[2]; Wl[m * 65 + nn + 3] = v[3]; }
          if (tid < 128) tr[tid] = pq ? sinpif((float)tid * (1.f / 64.f)) : cospif((float)tid * (1.f / 64.f));
          __syncthreads();
          const int nn = tid >> 3, cc = ch * 64 + (tid & 7) * 8; float acc[8];
#pragma unroll
          for (int i = 0; i < 8; ++i) acc[i] = 0.f;
#pragma unroll 4
          for (int m = 0; m < 128; ++m) { const float w = Wl[m * 65 + nn];
#pragma unroll
              for (int i = 0; i < 8; ++i) acc[i] += tr[((cc + i) * m) & 127] * w; }
          const float nrm = 0.0013810679320049757f;
          u32x4 o0;
          o0.x = pk2(acc[0] * nrm, acc[1] * nrm); o0.y = pk2(acc[2] * nrm, acc[3] * nrm); o0.z = pk2(acc[4] * nrm, acc[5] * nrm); o0.w = pk2(acc[6] * nrm, acc[7] * nrm);
          *(u32x4*)(Wcs + ((size_t)l * 1024 + pq * 512 + n0 + nn) * DG + g * 128 + cc) = o0;
          __syncthreads();
      } }
    __syncthreads();
    float* cosT = (float*)(lds + 32768); float* sinT = (float*)(lds + 49152); float* ca = (float*)(lds + 65536); float* red = (float*)(lds + 81920);
    for (int j = tid; j < 4096; j += NTHR) { cosT[j] = cospif((float)j * (1.f / 2048.f)); sinT[j] = sinpif((float)j * (1.f / 2048.f)); }
    for (int j = tid; j < 4096; j += NTHR) { const float cv = p.c[j]; ca[j] = cv / (1.f + expf(-cv)); }
    __syncthreads();
    { bf16* DC = (bf16*)(p.ws + WS_DC); bf16* DSm = (bf16*)(p.ws + WS_DS);
      for (int r = bid * 2 + (tid >> 8); r < 4352; r += G * 2) { const int is_sin = (r >= 2304) ? 1 : 0, k = is_sin ? r - 2304 : r, s0 = (tid & 255) * 8; float v[8];
#pragma unroll
          for (int j = 0; j < 8; ++j) { const int idx = (k * (s0 + j)) & 4095; v[j] = is_sin ? sinT[idx] : cosT[idx]; }
          u32x4 o; o.x = pk2(v[0], v[1]); o.y = pk2(v[2], v[3]); o.z = pk2(v[4], v[5]); o.w = pk2(v[6], v[7]);
          *(u32x4*)((is_sin ? DSm : DC) + (size_t)k * 2048 + s0) = o; } }
    { float2* rope = (float2*)(p.ws + WS_ROPE);
      for (int e = bid * NTHR + tid; e < 4096 * 32; e += G * NTHR) { const int s = e >> 5, i = e & 31;
          const float inv = (float)pow(10000.0, -(double)i / 32.0); const float ang = (float)s * inv;
          double sn, cs; sincos((double)ang, &sn, &cs); rope[e] = make_float2((float)cs, (float)sn); } }
    float* mod = (float*)(p.ws + WS_MOD);
    for (int t = bid; t < 192; t += G) {
        const int l = t / 96, col = (t % 96) * 64 + lane; const float* W = p.w_ada + (size_t)l * DM * 6144 + col;
        float a0 = 0.f, a1 = 0.f;
        for (int k0 = wave * 256; k0 < wave * 256 + 256; k0 += 32) { float wv[32];
#pragma unroll
            for (int j = 0; j < 32; ++j) wv[j] = W[(size_t)(k0 + j) * 6144];
            asm volatile("" ::: "memory");
#pragma unroll
            for (int j = 0; j < 32; ++j) { a0 += ca[k0 + j] * wv[j]; a1 += ca[2048 + k0 + j] * wv[j]; } }
        red[(wave * 2 + 0) * 64 + lane] = a0; red[(wave * 2 + 1) * 64 + lane] = a1;
        __syncthreads();
        if (wave < 2) { float s = 0.f;
#pragma unroll
            for (int w = 0; w < 8; ++w) s += red[(w * 2 + wave) * 64 + lane];
            mod[(size_t)(l * 2 + wave) * 6144 + col] = s + p.b_ada[l * 6144 + col]; }
        __syncthreads();
    }
}

__device__ __forceinline__ void ph_norm(const Params& p_, int l) {
    const Params p = *kparams(); (void)p_;
    const int tid = otid(), lane = tid & 63, wave = tid >> 6;
    const float* xin = (l == 0) ? p.x : p.out; bf16* h = (bf16*)(p.ws + WS_U); const float* mod = (const float*)(p.ws + WS_MOD);
    const int stride = gridDim.x * 8; const float* g = p.norm_g + l * DM;
    if (stride == 2048) {
        for (int row = obid() * 8 + wave; row < MTOK; row += 2 * stride) {
            const f32x4* xr0 = (const f32x4*)(xin + (size_t)row * DM) + lane; const f32x4* xr1 = (const f32x4*)(xin + (size_t)(row + stride) * DM) + lane;
            const float* md = mod + (size_t)(l * 2 + (row >> 12)) * 6144;
            f32x4 v0[8], v1[8], ca[8], cb[8];
#pragma unroll
            for (int j = 0; j < 8; ++j) { v0[j] = xr0[64 * j]; v1[j] = xr1[64 * j]; }
#pragma unroll
            for (int j = 0; j < 8; ++j) { const int col = (64 * j + lane) * 4; ca[j] = *(const f32x4*)(g + col) * (*(const f32x4*)(md + 2048 + col) + 1.f); cb[j] = *(const f32x4*)(md + col); }
            asm volatile("" ::: "memory");
            float s0 = 0.f, s1 = 0.f;
#pragma unroll
            for (int j = 0; j < 8; ++j) { s0 += (v0[j][0] * v0[j][0] + v0[j][1] * v0[j][1]) + (v0[j][2] * v0[j][2] + v0[j][3] * v0[j][3]); s1 += (v1[j][0] * v1[j][0] + v1[j][1] * v1[j][1]) + (v1[j][2] * v1[j][2] + v1[j][3] * v1[j][3]); }
            s0 = wave_sum(s0); s1 = wave_sum(s1);
            const float r0 = rsqrtf(s0 * (1.f / DM) + 1e-6f), r1 = rsqrtf(s1 * (1.f / DM) + 1e-6f);
#pragma unroll
            for (int j = 0; j < 8; ++j) { const int col = (64 * j + lane) * 4;
                const f32x4 o0 = (v0[j] * r0) * ca[j] + cb[j], o1 = (v1[j] * r1) * ca[j] + cb[j]; u32x2 w;
                w.x = pk2(o0[0], o0[1]); w.y = pk2(o0[2], o0[3]); *(u32x2*)(h + (size_t)row * DM + col) = w;
                w.x = pk2(o1[0], o1[1]); w.y = pk2(o1[2], o1[3]); *(u32x2*)(h + (size_t)(row + stride) * DM + col) = w; }
        }
        return;
    }
    for (int row = obid() * 8 + wave; row < MTOK; row += stride) {
        const f32x4* xr = (const f32x4*)(xin + (size_t)row * DM) + lane; f32x4 v[8]; float ss = 0.f;
#pragma unroll
        for (int j = 0; j < 8; ++j) { v[j] = xr[64 * j]; ss += (v[j][0] * v[j][0] + v[j][1] * v[j][1]) + (v[j][2] * v[j][2] + v[j][3] * v[j][3]); }
        ss = wave_sum(ss); const float rstd = rsqrtf(ss * (1.f / DM) + 1e-6f);
        const float* md = mod + (size_t)(l * 2 + (row >> 12)) * 6144;
#pragma unroll
        for (int j = 0; j < 8; ++j) { const int col = (64 * j + lane) * 4;
            const f32x4 g4 = *(const f32x4*)(g + col), sh = *(const f32x4*)(md + col), sc = *(const f32x4*)(md + 2048 + col);
            const f32x4 o = (v[j] * rstd * g4) * (sc + 1.f) + sh; u32x2 w; w.x = pk2(o[0], o[1]); w.y = pk2(o[2], o[3]);
            *(u32x2*)(h + (size_t)row * DM + col) = w; }
    }
}
__device__ __forceinline__ void ph_final(const Params& p_) {
    const Params p = *kparams(); (void)p_;
    const int tid = otid(), lane = tid & 63, wave = tid >> 6;
    const int stride = gridDim.x * 8;
    for (int row = obid() * 8 + wave; row < MTOK; row += 2 * stride) {
        const bool two = (row + stride < MTOK);
        f32x4* xr0 = (f32x4*)(p.out + (size_t)row * DM) + lane; f32x4* xr1 = (f32x4*)(p.out + (size_t)(two ? row + stride : row) * DM) + lane;
        f32x4 v0[8], v1[8], g4[8];
#pragma unroll
        for (int j = 0; j < 8; ++j) { v0[j] = xr0[64 * j]; v1[j] = xr1[64 * j]; g4[j] = *(const f32x4*)(p.final_g + (64 * j + lane) * 4); }
        asm volatile("" ::: "memory");
        float s0 = 0.f, s1 = 0.f;
#pragma unroll
        for (int j = 0; j < 8; ++j) { s0 += (v0[j][0] * v0[j][0] + v0[j][1] * v0[j][1]) + (v0[j][2] * v0[j][2] + v0[j][3] * v0[j][3]); s1 += (v1[j][0] * v1[j][0] + v1[j][1] * v1[j][1]) + (v1[j][2] * v1[j][2] + v1[j][3] * v1[j][3]); }
        s0 = wave_sum(s0); s1 = wave_sum(s1);
        const float r0 = rsqrtf(s0 * (1.f / DM) + 1e-6f), r1 = rsqrtf(s1 * (1.f / DM) + 1e-6f);
#pragma unroll
        for (int j = 0; j < 8; ++j) { xr0[64 * j] = v0[j] * r0 * g4[j]; if (two) xr1[64 * j] = v1[j] * r1 * g4[j]; }
    }
}

#ifndef REP_PRO
#define REP_PRO 1
#endif
#ifndef REP_NORM
#define REP_NORM 1
#endif
#ifndef REP_Z
#define REP_Z 1
#endif
#ifndef REP_MIX
#define REP_MIX 1
#endif
#ifndef REP_P3
#define REP_P3 1
#endif
#ifndef REP_R2
#define REP_R2 1
#endif
#ifndef REP_CMB
#define REP_CMB 1
#endif
#ifndef REP_FFT
#define REP_FFT 1
#endif
#ifndef REP_OUT
#define REP_OUT 1
#endif
#ifndef REP_SUB
#define REP_SUB 1
#endif

#ifndef REP_R1
#define REP_R1 1
#endif
#ifndef REP_NA
#define REP_NA 1
#endif
#ifndef REP_CV
#define REP_CV 1
#endif
#ifndef REP_F1
#define REP_F1 1
#endif
#define REPEAT(n) for (int rep_ = 0; rep_ < (n); ++rep_)
typedef short bf16x8v __attribute__((ext_vector_type(8)));
__device__ __forceinline__ bf16x8v mk8(unsigned a, unsigned b, unsigned c, unsigned d) { u32x4 v = {a, b, c, d}; return __builtin_bit_cast(bf16x8v, v); }
#define MFMA16(a, b, c) __builtin_amdgcn_mfma_f32_16x16x32_bf16(a, b, c, 0, 0, 0)
constexpr int R_QS = 0, R_KS = 18432, R_VT = 36864, R_KTF = 54272, R_KTB = 71680, R_STF = 89088, R_STB = 98304;

template <bool R2>
__device__ __forceinline__ void ret_stage(const Params& p_, int b, int h, int n, unsigned char* lds, float l2f, float l2b) {
    const Params p = *kparams(); (void)p_;
    const int tid = otid(), j = tid >> 2, c4 = tid & 3, s = n * 128 + j;
    const bf16* Z = (const bf16*)(p.ws + WS_Z); const bf16* zr = Z + (size_t)(b * SEQ + s) * DIN;
    const f32x4* rp = (const f32x4*)((const float2*)(p.ws + WS_ROPE) + s * 32 + c4 * 8);
    f32x4 rr[4];
#pragma unroll
    for (int i = 0; i < 4; ++i) rr[i] = rp[i];
    const u32x4 ka = *(const u32x4*)(zr + 7 * DG + h * 64 + c4 * 8), kb = *(const u32x4*)(zr + 7 * DG + h * 64 + 32 + c4 * 8);
    const u32x4 va = *(const u32x4*)(zr + 8 * DG + h * 64 + c4 * 16), vb = *(const u32x4*)(zr + 8 * DG + h * 64 + c4 * 16 + 8);
    u32x4 qa = ka, qb = kb;
    if (R2) { qa = *(const u32x4*)(zr + 6 * DG + h * 64 + c4 * 8); qb = *(const u32x4*)(zr + 6 * DG + h * 64 + 32 + c4 * 8); }
    asm volatile("" ::: "memory");
    float cs[8], sn[8];
#pragma unroll
    for (int i = 0; i < 4; ++i) { const f32x4 r = rr[i]; cs[2 * i] = r[0]; sn[2 * i] = r[1]; cs[2 * i + 1] = r[2]; sn[2 * i + 1] = r[3]; }
    bf16* KS = (bf16*)(lds + R_KS); bf16* VT = (bf16*)(lds + R_VT);
    {
      const unsigned kau[4] = {ka.x, ka.y, ka.z, ka.w}, kbu[4] = {kb.x, kb.y, kb.z, kb.w};
      float k1[8], k2[8];
#pragma unroll
      for (int i = 0; i < 4; ++i) { const float a0 = bflo(kau[i]), a1 = bfhi(kau[i]), b0 = bflo(kbu[i]), b1 = bfhi(kbu[i]);
          k1[2 * i] = a0 * cs[2 * i] - b0 * sn[2 * i]; k2[2 * i] = a0 * sn[2 * i] + b0 * cs[2 * i];
          k1[2 * i + 1] = a1 * cs[2 * i + 1] - b1 * sn[2 * i + 1]; k2[2 * i + 1] = a1 * sn[2 * i + 1] + b1 * cs[2 * i + 1]; }
      u32x4 o1, o2; o1.x = pk2(k1[0], k1[1]); o1.y = pk2(k1[2], k1[3]); o1.z = pk2(k1[4], k1[5]); o1.w = pk2(k1[6], k1[7]);
      o2.x = pk2(k2[0], k2[1]); o2.y = pk2(k2[2], k2[3]); o2.z = pk2(k2[4], k2[5]); o2.w = pk2(k2[6], k2[7]);
      *(u32x4*)(KS + j * 72 + c4 * 8) = o1; *(u32x4*)(KS + j * 72 + 32 + c4 * 8) = o2;
      if (!R2) { bf16* KTF = (bf16*)(lds + R_KTF); bf16* KTB = (bf16*)(lds + R_KTB);
          const float df = exp2f(l2f * (float)(127 - j)), db = exp2f(l2b * (float)j);
#pragma unroll
          for (int i = 0; i < 8; ++i) { KTF[(c4 * 8 + i) * 136 + j] = (bf16)f2bf(k1[i] * df); KTF[(32 + c4 * 8 + i) * 136 + j] = (bf16)f2bf(k2[i] * df);
              KTB[(c4 * 8 + i) * 136 + j] = (bf16)f2bf(k1[i] * db); KTB[(32 + c4 * 8 + i) * 136 + j] = (bf16)f2bf(k2[i] * db); } } }
    {
      const unsigned vu[8] = {va.x, va.y, va.z, va.w, vb.x, vb.y, vb.z, vb.w};
#pragma unroll
      for (int i = 0; i < 8; ++i) { VT[(c4 * 16 + 2 * i) * 136 + j] = (bf16)(vu[i] & 0xffffu); VT[(c4 * 16 + 2 * i + 1) * 136 + j] = (bf16)(vu[i] >> 16); } }
    if (R2) { bf16* QS = (bf16*)(lds + R_QS);
      const unsigned qau[4] = {qa.x, qa.y, qa.z, qa.w}, qbu[4] = {qb.x, qb.y, qb.z, qb.w};
      float q1[8], q2[8];
#pragma unroll
      for (int i = 0; i < 4; ++i) { const float a0 = bflo(qau[i]), a1 = bfhi(qau[i]), b0 = bflo(qbu[i]), b1 = bfhi(qbu[i]);
          q1[2 * i] = (a0 * cs[2 * i] - b0 * sn[2 * i]) * 0.125f; q2[2 * i] = (a0 * sn[2 * i] + b0 * cs[2 * i]) * 0.125f;
          q1[2 * i + 1] = (a1 * cs[2 * i + 1] - b1 * sn[2 * i + 1]) * 0.125f; q2[2 * i + 1] = (a1 * sn[2 * i + 1] + b1 * cs[2 * i + 1]) * 0.125f; }
      u32x4 o1, o2; o1.x = pk2(q1[0], q1[1]); o1.y = pk2(q1[2], q1[3]); o1.z = pk2(q1[4], q1[5]); o1.w = pk2(q1[6], q1[7]);
      o2.x = pk2(q2[0], q2[1]); o2.y = pk2(q2[2], q2[3]); o2.z = pk2(q2[4], q2[5]); o2.w = pk2(q2[6], q2[7]);
      *(u32x4*)(QS + j * 72 + c4 * 8) = o1; *(u32x4*)(QS + j * 72 + 32 + c4 * 8) = o2; }
}

__device__ __forceinline__ void ret1_task(const Params& p_, int l, int task, unsigned char* lds) {
    const Params p = *kparams(); (void)p_;
    const int n = task & 31, h = (task >> 5) & 7, b = task >> 8;
    const float xf = p.rl_f[l * 8 + h], xb = p.rl_b[l * 8 + h];
    const float l2f = -log1pf(expf(-xf)) * 1.4426950408889634f, l2b = -log1pf(expf(-xb)) * 1.4426950408889634f;
    ret_stage<false>(p, b, h, n, lds, l2f, l2b);
    __syncthreads();
    const int tid = otid(), lane = tid & 63, w = tid >> 6, fr = lane & 15, fq = lane >> 4, dir = w >> 2, et = w & 3;
    const bf16* VT = (const bf16*)(lds + R_VT); const bf16* KT = (const bf16*)(lds + (dir ? R_KTB : R_KTF));
    bf16x8v a[4];
#pragma unroll
    for (int ks = 0; ks < 4; ++ks) a[ks] = *(const bf16x8v*)(VT + (16 * et + fr) * 136 + 32 * ks + 8 * fq);
    float* dst = (float*)(p.ws + WS_KV) + ((size_t)((dir * 2 + b) * 8 + h) * 32 + n) * 4096;
#pragma unroll
    for (int dt = 0; dt < 4; ++dt) { f32x4 acc = {0.f, 0.f, 0.f, 0.f};
#pragma unroll
        for (int ks = 0; ks < 4; ++ks) { const bf16x8v bfr = *(const bf16x8v*)(KT + (16 * dt + fr) * 136 + 32 * ks + 8 * fq); acc = MFMA16(a[ks], bfr, acc); }
#pragma unroll
        for (int r = 0; r < 4; ++r) dst[(16 * et + 4 * fq + r) * 64 + 16 * dt + fr] = acc[r]; }
    __syncthreads();
}

__device__ __forceinline__ void ret2_task(const Params& p_, int l, int task, unsigned char* lds) {
    const Params p = *kparams(); (void)p_;
    const int n = task & 31, h = (task >> 5) & 7, b = task >> 8;
    const float xf = p.rl_f[l * 8 + h], xb = p.rl_b[l * 8 + h];
    const float l2f = -log1pf(expf(-xf)) * 1.4426950408889634f, l2b = -log1pf(expf(-xb)) * 1.4426950408889634f;
    ret_stage<true>(p, b, h, n, lds, l2f, l2b);
    const int tid = otid(), lane = tid & 63, w = tid >> 6, fr = lane & 15, fq = lane >> 4;
    {
      const float gfC = exp2f(l2f * 128.f), gbC = exp2f(l2b * 128.f);
      const float* KVf = (const float*)(p.ws + WS_KV) + ((size_t)((0 * 2 + b) * 8 + h) * 32) * 4096 + tid * 8;
      const float* KVb = (const float*)(p.ws + WS_KV) + ((size_t)((1 * 2 + b) * 8 + h) * 32) * 4096 + tid * 8;
      f32x4 f0 = {0.f, 0.f, 0.f, 0.f}, f1 = f0, g0 = f0, g1 = f0;
      { float c0 = 1.f; int m = n - 1;
        for (; m >= 7; m -= 8) { f32x4 xa[8], xb[8];
#pragma unroll
            for (int j = 0; j < 8; ++j) { xa[j] = *(const f32x4*)(KVf + (size_t)(m - j) * 4096); xb[j] = *(const f32x4*)(KVf + (size_t)(m - j) * 4096 + 4); }
            asm volatile("" ::: "memory");
#pragma unroll
            for (int j = 0; j < 8; ++j) { f0 += xa[j] * c0; f1 += xb[j] * c0; c0 *= gfC; } }
        for (; m >= 0; --m) { const f32x4 x0 = *(const f32x4*)(KVf + (size_t)m * 4096), x1 = *(const f32x4*)(KVf + (size_t)m * 4096 + 4); f0 += x0 * c0; f1 += x1 * c0; c0 *= gfC; } }
      { float c0 = 1.f; int m = n + 1;
        for (; m + 7 < 32; m += 8) { f32x4 xa[8], xb[8];
#pragma unroll
            for (int j = 0; j < 8; ++j) { xa[j] = *(const f32x4*)(KVb + (size_t)(m + j) * 4096); xb[j] = *(const f32x4*)(KVb + (size_t)(m + j) * 4096 + 4); }
            asm volatile("" ::: "memory");
#pragma unroll
            for (int j = 0; j < 8; ++j) { g0 += xa[j] * c0; g1 += xb[j] * c0; c0 *= gbC; } }
        for (; m < 32; ++m) { const f32x4 x0 = *(const f32x4*)(KVb + (size_t)m * 4096), x1 = *(const f32x4*)(KVb + (size_t)m * 4096 + 4); g0 += x0 * c0; g1 += x1 * c0; c0 *= gbC; } }
      const int e = tid >> 3, d0 = (tid & 7) * 8; u32x4 o;
      o.x = pk2(f0[0], f0[1]); o.y = pk2(f0[2], f0[3]); o.z = pk2(f1[0], f1[1]); o.w = pk2(f1[2], f1[3]); *(u32x4*)((bf16*)(lds + R_STF) + e * 72 + d0) = o;
      o.x = pk2(g0[0], g0[1]); o.y = pk2(g0[2], g0[3]); o.z = pk2(g1[0], g1[1]); o.w = pk2(g1[2], g1[3]); *(u32x4*)((bf16*)(lds + R_STB) + e * 72 + d0) = o; }
    __syncthreads();
    const bf16* QS = (const bf16*)(lds + R_QS); const bf16* KS = (const bf16*)(lds + R_KS); const bf16* VT = (const bf16*)(lds + R_VT);
    const bf16* STF = (const bf16*)(lds + R_STF); const bf16* STB = (const bf16*)(lds + R_STB);
    bf16x8v qf[2];
#pragma unroll
    for (int ks = 0; ks < 2; ++ks) qf[ks] = *(const bf16x8v*)(QS + (16 * w + fr) * 72 + 32 * ks + 8 * fq);
    const int ai = 16 * w + fr;
    unsigned pp[8][2];
#pragma unroll
    for (int jt = 0; jt < 8; ++jt) { f32x4 acc = {0.f, 0.f, 0.f, 0.f};
#pragma unroll
        for (int ks = 0; ks < 2; ++ks) { const bf16x8v kf = *(const bf16x8v*)(KS + (16 * jt + fr) * 72 + 32 * ks + 8 * fq); acc = MFMA16(kf, qf[ks], acc); }
        float sc[4];
#pragma unroll
        for (int r = 0; r < 4; ++r) { const int aj = 16 * jt + 4 * fq + r; const float wg = (aj <= ai) ? exp2f(l2f * (float)(ai - aj)) : exp2f(l2b * (float)(aj - ai)); sc[r] = acc[r] * wg; }
        pp[jt][0] = pk2(sc[0], sc[1]); pp[jt][1] = pk2(sc[2], sc[3]); }
    const float qdf = exp2f(l2f * (float)(ai + 1)), qdb = exp2f(l2b * (float)(128 - ai));
    f32x4 tot[4]; float ss = 0.f;
#pragma unroll
    for (int et = 0; et < 4; ++et) { f32x4 o = {0.f, 0.f, 0.f, 0.f}, cfa = o, cba = o;
#pragma unroll
        for (int t = 0; t < 4; ++t) { const u32x2 vlo = *(const u32x2*)(VT + (16 * et + fr) * 136 + 32 * t + 4 * fq), vhi = *(const u32x2*)(VT + (16 * et + fr) * 136 + 32 * t + 16 + 4 * fq);
            o = MFMA16(mk8(vlo.x, vlo.y, vhi.x, vhi.y), mk8(pp[2 * t][0], pp[2 * t][1], pp[2 * t + 1][0], pp[2 * t + 1][1]), o); }
#pragma unroll
        for (int ks = 0; ks < 2; ++ks) { const bf16x8v sf = *(const bf16x8v*)(STF + (16 * et + fr) * 72 + 32 * ks + 8 * fq), sb = *(const bf16x8v*)(STB + (16 * et + fr) * 72 + 32 * ks + 8 * fq);
            cfa = MFMA16(sf, qf[ks], cfa); cba = MFMA16(sb, qf[ks], cba); }
        tot[et] = o + cfa * qdf + cba * qdb;
        ss += (tot[et][0] * tot[et][0] + tot[et][1] * tot[et][1]) + (tot[et][2] * tot[et][2] + tot[et][3] * tot[et][3]); }
    ss += __shfl_xor(ss, 16); ss += __shfl_xor(ss, 32);
    const float rs = rsqrtf(ss * (1.f / 64.f) + 1e-6f);
    const size_t tok = (size_t)b * SEQ + n * 128 + ai;
    const bf16* Z = (const bf16*)(p.ws + WS_Z); bf16* CAT = (bf16*)(p.ws + WS_CAT);
#pragma unroll
    for (int et = 0; et < 4; ++et) { const u32x2 gz = *(const u32x2*)(Z + tok * DIN + 9 * DG + h * 64 + 16 * et + 4 * fq); u32x2 o;
        o.x = pk2(tot[et][0] * rs * silu_f(bflo(gz.x)), tot[et][1] * rs * silu_f(bfhi(gz.x))); o.y = pk2(tot[et][2] * rs * silu_f(bflo(gz.y)), tot[et][3] * rs * silu_f(bfhi(gz.y)));
        *(u32x2*)(CAT + tok * DM + 1024 + h * 64 + 16 * et + 4 * fq) = o; }
    __syncthreads();
}

__device__ __forceinline__ void na2_task(const Params& p_, int l, int task, unsigned char* lds) {
    const Params p = *kparams(); (void)p_;
    const int tid = otid(), lane = tid & 63, w = tid >> 6, fr = lane & 15, fq = lane >> 4;
    const int hp = task & 3, rq = (task >> 2) & 63, b = task >> 8;
    const int row_start = min(max(rq - 4, 0), 56);
    const bf16* Z = (const bf16*)(p.ws + WS_Z); bf16* CAT = (bf16*)(p.ws + WS_CAT);
    bf16* VT = (bf16*)lds; float* BI = (float*)(lds + 133120);
    const int hh = w >> 2, h = hp * 2 + hh, qb = w & 3, kst = min(max(16 * qb - 8, 0), 32);
    const int c = 16 * qb + fr; const size_t qtok = (size_t)b * SEQ + rq * 64 + c;
    bf16x8v qf[2], kfr[8][2];
#pragma unroll
    for (int ks = 0; ks < 2; ++ks) qf[ks] = *(const bf16x8v*)(Z + qtok * DIN + 2 * DG + h * 64 + 32 * ks + 8 * fq);
#pragma unroll
    for (int i = 0; i < 8; ++i) { const int a = i / 2, ci = i % 2;
        const size_t ktok = (size_t)b * SEQ + (row_start + a) * 64 + kst + 16 * ci + fr;
#pragma unroll
        for (int ks = 0; ks < 2; ++ks) kfr[i][ks] = *(const bf16x8v*)(Z + ktok * DIN + 3 * DG + h * 64 + 32 * ks + 8 * fq); }
    asm volatile("" ::: "memory");
    for (int i = tid; i < 930; i += NTHR) BI[i] = p.na_bias[(size_t)(l * 8 + hp * 2) * 465 + i];
    { const int pair = lane & 31, chunk = (lane >> 5) + 2 * (w & 3);
      unsigned* VTd = (unsigned*)(VT + (size_t)hh * 64 * 520);
      u32x4 xs[8], ys[8];
#pragma unroll
      for (int a = 0; a < 8; ++a) { const size_t tok = (size_t)b * SEQ + (row_start + a) * 64 + 2 * pair;
          const bf16* src = Z + tok * DIN + 4 * DG + h * 64 + chunk * 8; xs[a] = *(const u32x4*)src; ys[a] = *(const u32x4*)(src + DIN); }
      asm volatile("" ::: "memory");
#pragma unroll
      for (int a = 0; a < 8; ++a) { const unsigned xu[4] = {xs[a].x, xs[a].y, xs[a].z, xs[a].w}, yu[4] = {ys[a].x, ys[a].y, ys[a].z, ys[a].w};
#pragma unroll
          for (int i = 0; i < 4; ++i) { VTd[(chunk * 8 + 2 * i) * 260 + a * 32 + pair] = (xu[i] & 0xffffu) | (yu[i] << 16);
              VTd[(chunk * 8 + 2 * i + 1) * 260 + a * 32 + pair] = (xu[i] >> 16) | (yu[i] & 0xffff0000u); } } }
    __syncthreads();
    const int col_start = min(max(c - 8, 0), 48);
    const float* bi = BI + hh * 465;
    float sc[16][4]; float mx = -1e30f;
#pragma unroll
    for (int hf = 0; hf < 2; ++hf) {
        if (hf == 1) {
#pragma unroll
            for (int i = 0; i < 8; ++i) { const int a = 4 + i / 2, ci = i % 2;
                const size_t ktok = (size_t)b * SEQ + (row_start + a) * 64 + kst + 16 * ci + fr;
#pragma unroll
                for (int ks = 0; ks < 2; ++ks) kfr[i][ks] = *(const bf16x8v*)(Z + ktok * DIN + 3 * DG + h * 64 + 32 * ks + 8 * fq); }
            asm volatile("" ::: "memory");
        }
#pragma unroll
        for (int i = 0; i < 8; ++i) { const int a = 4 * hf + i / 2, ci = i % 2, kt = a * 2 + ci;
            f32x4 acc = {0.f, 0.f, 0.f, 0.f};
#pragma unroll
            for (int ks = 0; ks < 2; ++ks) acc = MFMA16(kfr[i][ks], qf[ks], acc);
            const int dr = row_start + a - rq;
#pragma unroll
            for (int r = 0; r < 4; ++r) { const int kc = kst + 16 * ci + 4 * fq + r, rel = kc - col_start, dc = kc - c;
                float v = acc[r] * 0.125f + bi[(dr + 7) * 31 + min(max(dc + 15, 0), 30)];
                v = (rel >= 0 && rel < 16) ? v : -1e30f; sc[kt][r] = v; mx = fmaxf(mx, v); } }
    }
    mx = fmaxf(mx, __shfl_xor(mx, 16)); mx = fmaxf(mx, __shfl_xor(mx, 32));
    float sum = 0.f; unsigned pp[16][2];
#pragma unroll
    for (int kt = 0; kt < 16; ++kt) { const float e0 = __expf(sc[kt][0] - mx), e1 = __expf(sc[kt][1] - mx), e2 = __expf(sc[kt][2] - mx), e3 = __expf(sc[kt][3] - mx);
        sum += (e0 + e1) + (e2 + e3); pp[kt][0] = pk2(e0, e1); pp[kt][1] = pk2(e2, e3); }
    sum += __shfl_xor(sum, 16); sum += __shfl_xor(sum, 32);
    const float inv = 1.f / sum;
    const bf16* VTh = VT + (size_t)hh * 64 * 520;
#pragma unroll
    for (int dt = 0; dt < 4; ++dt) { f32x4 o = {0.f, 0.f, 0.f, 0.f};
#pragma unroll
        for (int t = 0; t < 8; ++t) { const int k0 = 2 * t, k1 = 2 * t + 1, a0 = k0 / 2, c0 = k0 % 2, a1 = k1 / 2, c1 = k1 % 2;
            const u32x2 vlo = *(const u32x2*)(VTh + (16 * dt + fr) * 520 + a0 * 64 + kst + 16 * c0 + 4 * fq), vhi = *(const u32x2*)(VTh + (16 * dt + fr) * 520 + a1 * 64 + kst + 16 * c1 + 4 * fq);
            o = MFMA16(mk8(vlo.x, vlo.y, vhi.x, vhi.y), mk8(pp[k0][0], pp[k0][1], pp[k1][0], pp[k1][1]), o); }
        const u32x2 gz = *(const u32x2*)(Z + qtok * DIN + 5 * DG + h * 64 + 16 * dt + 4 * fq); u32x2 ov;
        ov.x = pk2(o[0] * inv * silu_f(bflo(gz.x)), o[1] * inv * silu_f(bfhi(gz.x))); ov.y = pk2(o[2] * inv * silu_f(bflo(gz.y)), o[3] * inv * silu_f(bfhi(gz.y)));
        *(u32x2*)(CAT + qtok * DM + 512 + h * 64 + 16 * dt + 4 * fq) = ov; }
    __syncthreads();
}

__device__ __forceinline__ void conv_task(const Params& p_, int l, int task, unsigned char* lds) {
    const Params p = *kparams(); (void)p_;
    const int tid = otid(), lane = tid & 63, wave = tid >> 6;
    float* us = (float*)lds; float* ys = us + 46 * 512;
    const bf16* Z = (const bf16*)(p.ws + WS_Z);
    const int b = task >> 8, t0 = (task & 255) * 16;
    { u32x4 av[6], gv[6];
#pragma unroll
      for (int it = 0; it < 6; ++it) { const int idx = tid + it * NTHR, tt = idx >> 6, cc = (idx & 63) * 8, tok = t0 - 15 + tt;
          av[it] = (u32x4){0u, 0u, 0u, 0u}; gv[it] = av[it];
          if (idx < 46 * 64 && tok >= 0 && tok < SEQ) { const bf16* zr = Z + (size_t)(b * SEQ + tok) * DIN; av[it] = *(const u32x4*)(zr + 10 * DG + cc); gv[it] = *(const u32x4*)(zr + 11 * DG + cc); } }
      asm volatile("" ::: "memory");
#pragma unroll
      for (int it = 0; it < 6; ++it) { const int idx = tid + it * NTHR, tt = idx >> 6, cc = (idx & 63) * 8;
          if (idx < 46 * 64) { const u32x4 a = av[it], g = gv[it]; f32x4 u0, u1;
              u0[0] = bflo(a.x) / (1.f + __expf(-bflo(g.x))); u0[1] = bfhi(a.x) / (1.f + __expf(-bfhi(g.x))); u0[2] = bflo(a.y) / (1.f + __expf(-bflo(g.y))); u0[3] = bfhi(a.y) / (1.f + __expf(-bfhi(g.y)));
              u1[0] = bflo(a.z) / (1.f + __expf(-bflo(g.z))); u1[1] = bfhi(a.z) / (1.f + __expf(-bfhi(g.z))); u1[2] = bflo(a.w) / (1.f + __expf(-bflo(g.w))); u1[3] = bfhi(a.w) / (1.f + __expf(-bfhi(g.w)));
              *(f32x4*)(us + tt * 512 + cc) = u0; *(f32x4*)(us + tt * 512 + cc + 4) = u1; } } }
    float w[31];
#pragma unroll
    for (int k = 0; k < 31; ++k) w[k] = p.conv_w[(size_t)(l * 31 + k) * DG + tid];
    const float cb = p.conv_b[l * DG + tid];
    __syncthreads();
    for (int t = 0; t < 16; ++t) { float acc = cb;
#pragma unroll
        for (int k = 0; k < 31; ++k) acc += w[k] * us[(t + k) * 512 + tid];
        ys[t * 512 + tid] = acc; }
    __syncthreads();
#pragma unroll
    for (int tw = 0; tw < 2; ++tw) { const int t = wave + 8 * tw; float v[8]; float s = 0.f;
#pragma unroll
        for (int j = 0; j < 8; ++j) { v[j] = ys[t * 512 + lane + 64 * j]; s += v[j]; }
        const float mu = wave_sum(s) * (1.f / 512.f); float q = 0.f;
#pragma unroll
        for (int j = 0; j < 8; ++j) { v[j] -= mu; q += v[j] * v[j]; }
        const float rstd = rsqrtf(wave_sum(q) * (1.f / 512.f) + 1e-6f);
        bf16* orow = (bf16*)(p.ws + WS_CVH) + (size_t)(b * SEQ + t0 + t) * DG;
#pragma unroll
        for (int j = 0; j < 8; ++j) { const int ch = lane + 64 * j; const float y = v[j] * rstd * p.ln_g[l * DG + ch] + p.ln_b[l * DG + ch]; orow[ch] = (bf16)f2bf(silu_f(y)); } }
    __syncthreads();
}

__device__ __forceinline__ void ph_mixA(const Params& p, int l, unsigned char* lds) {
    const int G = gridDim.x, bid = obid();
    for (int t = bid; t < 512 * REP_R1; t += G) ret1_task(p, l, t & 511, lds);
    if (G == 256 && REP_NA == 1) {
        if (bid < 128) na2_task(p, l, bid, lds);
        else for (int i = 0; i < 3; ++i) na2_task(p, l, 128 + (bid - 128) * 3 + i, lds);
    } else for (int t = bid; t < 512 * REP_NA; t += G) na2_task(p, l, t & 511, lds);
    if (G == 256 && REP_CV == 1) {
        if (bid < 128) conv_task(p, l, bid, lds);
        else for (int i = 0; i < 3; ++i) conv_task(p, l, 128 + (bid - 128) * 3 + i, lds);
    } else for (int t = bid; t < 512 * REP_CV; t += G) conv_task(p, l, t & 511, lds);
}

__device__ __forceinline__ void ph_fold(const Params& p_) {
    const Params p = *kparams(); (void)p_;
    const bf16* PQ = (const bf16*)(p.ws + WS_PQT); bf16* PQF = (bf16*)(p.ws + WS_PQF);
    for (int e = obid() * NTHR + otid(); e < NB * DG * 2 * 256; e += gridDim.x * NTHR) {
        const int row = e >> 8, s0 = (e & 255) * 8, pq = row & 1;
        const bf16* src = PQ + (size_t)row * 4096;
        const u32x4 own = *(const u32x4*)(src + s0), low = *(const u32x4*)(src + 4096 - s0 - 8);
        const float top = (s0 == 0) ? 0.f : bf2f(src[4096 - s0]);
        const float sg = pq ? -1.f : 1.f;
        float o[8];
        o[0] = bflo(own.x) + sg * top;            o[1] = bfhi(own.x) + sg * bfhi(low.w);
        o[2] = bflo(own.y) + sg * bflo(low.w);    o[3] = bfhi(own.y) + sg * bfhi(low.z);
        o[4] = bflo(own.z) + sg * bflo(low.z);    o[5] = bfhi(own.z) + sg * bfhi(low.y);
        o[6] = bflo(own.w) + sg * bflo(low.y);    o[7] = bfhi(own.w) + sg * bfhi(low.x);
        if (s0 == 0 && pq) o[0] = 0.f;
        u32x4 w; w.x = pk2(o[0], o[1]); w.y = pk2(o[2], o[3]); w.z = pk2(o[4], o[5]); w.w = pk2(o[6], o[7]);
        *(u32x4*)(PQF + (size_t)row * 2048 + s0) = w;
    }
}
__device__ __forceinline__ void ph_alt(const Params& p_) {
    const Params p = *kparams(); (void)p_;
    const int tid = otid(), lane = tid & 63, wave = tid >> 6; const bf16* PQF = (const bf16*)(p.ws + WS_PQF);
    float* dst = (float*)(p.ws + WS_PART) + (size_t)(2 * 2304 + 2 * 2048) * 512;
    for (int r = obid() * 8 + wave; r < NB * DG; r += gridDim.x * 8) {
        const u32x4* src = (const u32x4*)(PQF + (size_t)r * 4096) + lane; float acc = 0.f;
#pragma unroll
        for (int j = 0; j < 4; ++j) { const u32x4 v = src[64 * j];
            acc += (bflo(v.x) - bfhi(v.x)) + (bflo(v.y) - bfhi(v.y)) + (bflo(v.z) - bfhi(v.z)) + (bflo(v.w) - bfhi(v.w)); }
        acc = wave_sum(acc);
        if (lane == 0) dst[r] = acc;
    }
}
__device__ __forceinline__ void ph_combine(const Params& p_) {
    const Params p = *kparams(); (void)p_;
    const float* Ce = (const float*)(p.ws + WS_PART); const float* So = Ce + (size_t)2 * 2304 * 512;
    bf16* CAT = (bf16*)(p.ws + WS_CAT); const bf16* Z = (const bf16*)(p.ws + WS_Z); const bf16* PQ = (const bf16*)(p.ws + WS_PQT);
    for (int e = obid() * NTHR + otid(); e < MTOK * DG / 4; e += gridDim.x * NTHR) {
        const int row = e >> 7, c4 = (e & 127) * 4, b = row >> 12, k = row & 4095, kk = (k <= 2048) ? k : 4096 - k;
        f32x4 s = (kk == 2048) ? *(const f32x4*)(Ce + (size_t)(2 * 2304 + 2 * 2048) * 512 + b * 512 + c4) : *(const f32x4*)(Ce + ((size_t)b * 2304 + kk) * 512 + c4);
        if (kk != 0 && kk != 2048) { const f32x4 so = *(const f32x4*)(So + ((size_t)b * 2048 + kk) * 512 + c4); s = (k <= 2048) ? s - so : s + so; }
        const float alt = (k & 1) ? -1.f : 1.f;
#pragma unroll
        for (int j = 0; j < 4; ++j) s[j] += alt * bf2f(PQ[((size_t)(b * 512 + c4 + j) * 2) * 4096 + 2048]);
        const u32x2 gz = *(const u32x2*)(Z + (size_t)row * DIN + DG + c4);
        u32x2 w; w.x = pk2(s[0] * silu_f(bflo(gz.x)), s[1] * silu_f(bfhi(gz.x))); w.y = pk2(s[2] * silu_f(bflo(gz.y)), s[3] * silu_f(bfhi(gz.y)));
        *(u32x2*)(CAT + (size_t)row * DM + c4) = w;
    }
}

#define XB_TMO      128
#define XB_XCNT(j)  (256  + 64 * (j))
#define XB_XSUB(j)  (1280 + 64 * (j))
#define XB_XGEN(j)  (2304 + 64 * (j))
#define XB_TOP      3328
#define XB_TOPGEN   3392
#define XCD_BAR_WORDS 3456
#define XB_SPIN_CAP (1u << 20)
__device__ __forceinline__ unsigned xb_ld(unsigned* p)              { return __hip_atomic_load(p, __ATOMIC_RELAXED, __HIP_MEMORY_SCOPE_AGENT); }
__device__ __forceinline__ unsigned xb_add(unsigned* p, unsigned v) { return __hip_atomic_fetch_add(p, v, __ATOMIC_RELAXED, __HIP_MEMORY_SCOPE_AGENT); }
__device__ __forceinline__ unsigned xb_xcc_id() { return (unsigned)__builtin_amdgcn_s_getreg((3 << 11) | 20) & 0xFu; }
#define XB_SPIN(cond, bar) do { unsigned _sp = 0; while (cond) { __builtin_amdgcn_s_sleep(1); \
    if ((++_sp & 255u) == 0u) { if (xb_ld(&(bar)[XB_TMO])) break; if (_sp > XB_SPIN_CAP) { atomicAdd(&(bar)[XB_TMO], 1u); break; } } } } while (0)
struct XcdBarrier { unsigned* bar; unsigned x; volatile PG8_LAS unsigned* st; };
__device__ __forceinline__ XcdBarrier xcd_barrier_post(unsigned* bar, volatile PG8_LAS unsigned* st) {
    XcdBarrier b; b.bar = bar; b.x = xb_xcc_id(); b.st = st;
    if (otid() == 0) (void)xb_add(&bar[XB_XCNT(b.x)], 1u);
    return b;
}
__device__ __forceinline__ void xcd_barrier_complete(unsigned* bar, unsigned x, unsigned& nloc, unsigned& nx) {
    const unsigned G = gridDim.x * gridDim.y * gridDim.z;
    unsigned sum, cnt, mine, sp = 0u;
    for (;;) {
        sum = 0u; cnt = 0u; mine = 0u;
#pragma unroll
        for (unsigned j = 0; j < 16; ++j) { const unsigned c = xb_ld(&bar[XB_XCNT(j)]); sum += c; cnt += (c > 0u) ? 1u : 0u; mine = (j == x) ? c : mine; }
        if (sum == G) break;
        __builtin_amdgcn_s_sleep(1);
        if ((++sp & 255u) == 0u) { if (xb_ld(&bar[XB_TMO])) break; if (sp > XB_SPIN_CAP) { atomicAdd(&bar[XB_TMO], 1u); break; } }
    }
    nloc = mine > 0u ? mine : 1u; nx = cnt > 0u ? cnt : 1u;
}
__device__ __forceinline__ void xcd_barrier(const XcdBarrier& b) {
    asm volatile("s_waitcnt vmcnt(0)" ::: "memory");
    __syncthreads();
    if (otid() == 0) {
        unsigned* bar = b.bar;
        __builtin_amdgcn_s_waitcnt(0);
        unsigned nloc = b.st[0], nx = b.st[1];
        if (nloc == 0u) { xcd_barrier_complete(bar, b.x, nloc, nx); b.st[0] = nloc; b.st[1] = nx; }
        const unsigned old = xb_add(&bar[XB_XSUB(b.x)], 1u);
        const unsigned gen = old / nloc;
        if (old + 1u == (gen + 1u) * nloc) {
            __builtin_amdgcn_fence(__ATOMIC_RELEASE, "agent");
            asm volatile("s_waitcnt vmcnt(0)" ::: "memory");
            const unsigned og = xb_add(&bar[XB_TOP], 1u);
            const unsigned tg = og / nx;
            if (og + 1u == (tg + 1u) * nx) xb_add(&bar[XB_TOPGEN], 1u);
            else XB_SPIN(xb_ld(&bar[XB_TOPGEN]) == tg, bar);
            __builtin_amdgcn_fence(__ATOMIC_ACQUIRE, "agent");
            xb_add(&bar[XB_XGEN(b.x)], 1u);
            asm volatile("s_waitcnt vmcnt(0)" ::: "memory");
        } else {
            XB_SPIN(xb_ld(&bar[XB_XGEN(b.x)]) == gen, bar);
            __builtin_amdgcn_fence(__ATOMIC_ACQUIRE, "agent");
            asm volatile("s_waitcnt vmcnt(0)" ::: "memory");
        }
    }
    __syncthreads();
}

constexpr int NPH = 14;
__global__ void __launch_bounds__(NTHR) mega(Params p) {
    extern __shared__ __attribute__((aligned(16))) unsigned char lds[];
    cg::grid_group grid = cg::this_grid();
    PG8_LAS unsigned char* ldsl = (PG8_LAS unsigned char*)lds;
    const int lo = p.ph_lo, hi = p.ph_hi;
#define IN(k) (lo <= (k) && (k) < hi)
#define SEAM(k) do { if (IN(k) && IN((k) + 1)) { xcd_barrier(xb); } } while (0)
    bf16* Zb = (bf16*)(kparams()->ws + WS_Z); bf16* CAT = (bf16*)(kparams()->ws + WS_CAT);
    volatile PG8_LAS unsigned* xst = (volatile PG8_LAS unsigned*)(ldsl + LDS_BYTES - 16);
    { const int t0_ = otid(); if (t0_ < 4) xst[t0_] = 0u; }
    __syncthreads();
    XcdBarrier xb = xcd_barrier_post((unsigned*)(kparams()->ws + WS_BAR), xst);
    if (p.ph_lo < 0) grid.sync();
    if (IN(0)) REPEAT(REP_PRO) { ph_prologue(p, lds); __syncthreads(); }
    SEAM(0);
    if (IN(0) && IN(1)) for (int r_ = 1; r_ < REP_SUB; ++r_) xcd_barrier(xb);
#pragma unroll
    for (int l = 0; l < NL; ++l) {
        const int pb = 1 + 6 * l;
        const char* Wl = (const char*)(kparams()->ws + WS_WIN + (size_t)l * WROWS * DM * 2);
        if (IN(pb)) {
            if (l == 0) {
#pragma unroll
                for (int ll = 0; ll < NL; ++ll) {
                    SchedS S = make_sched(kparams()->ws + WS_WCS + (size_t)ll * 1024 * DG * 2, DG, kparams()->ws + WS_WFXB + (size_t)ll * DM * DG * 2, DG, 1024, DM, 32 * ll);
                    EpiZ E{(bf16*)(kparams()->ws + WS_WIN + ((size_t)ll * WROWS + 6656) * DM * 2), DM};
                    pg8::gemm_phase<EpiZ, SchedS, true>(ldsl, pg8::Gemm{DG, DG, DG}, S, E);
                }
            }
            REPEAT(REP_NORM) ph_norm(p, l);
        }
        SEAM(pb);
        if (IN(pb + 1)) REPEAT(REP_Z) {
            SchedZ S; S.o.init(MTOK, 24 * 256, (int)gridDim.x, obid()); S.A = (const char*)(kparams()->ws + WS_U); S.B = Wl; S.late = 0;
            EpiZ2 E{Zb, (bf16*)(kparams()->ws + WS_PQT)};
            pg8::gemm_phase<EpiZ2, SchedZ, true>(ldsl, pg8::Gemm{DM, DM, DM}, S, E);
        }
        SEAM(pb + 1);
        if (IN(pb + 2)) {
            {
                SchedZ S; S.o.init(MTOK, 4 * 256, (int)gridDim.x, obid()); S.A = (const char*)(kparams()->ws + WS_U); S.B = Wl; S.late = 1;
                EpiZ2 E{Zb, (bf16*)(kparams()->ws + WS_PQT)};
                pg8::gemm_phase<EpiZ2, SchedZ, true>(ldsl, pg8::Gemm{DM, DM, DM}, S, E);
            }
            REPEAT(REP_MIX) ph_mixA(p, l, lds);
            ph_fold(p);
        }
        SEAM(pb + 2);
        if (IN(pb + 3)) REPEAT(REP_P3) {
            const int G_ = (int)gridDim.x, b_ = obid(); const bool bal = (G_ == 256);
            {
                SchedDFT S{(const char*)(kparams()->ws + WS_DC), (const char*)(kparams()->ws + WS_PQF), G_, b_};
                EpiPart E{(float*)(kparams()->ws + WS_PART)};
                pg8::gemm_phase<EpiPart, SchedDFT, true>(ldsl, pg8::Gemm{2048, 4096, 2048}, S, E); }
            {
                SchedS S = make_sched(kparams()->ws + WS_CVH, DG, kparams()->ws + WS_WPW + (size_t)l * DG * DG * 2, DG, MTOK, DG, bal ? 192 : 0);
                EpiGate E{CAT, Zb, 1536, 12 * DG};
                pg8::gemm_phase<EpiGate, SchedS, true>(ldsl, pg8::Gemm{DG, DG, DG}, S, E); }
            if (bal && REP_R2 == 1) {
                int t0 = 0, nt_ = 0;
                if (b_ >= 192) { t0 = 384 + (b_ - 192) * 2; nt_ = 2; } else if (b_ >= 64) { t0 = (b_ - 64) * 3; nt_ = 3; }
                for (int i = 0; i < nt_; ++i) ret2_task(p, l, t0 + i, lds);
            }
            else for (int t = b_; t < 512 * REP_R2; t += G_) ret2_task(p, l, t & 511, lds);
            ph_alt(p);
        }
        SEAM(pb + 3);
        if (IN(pb + 4)) REPEAT(REP_CMB) ph_combine(p);
        SEAM(pb + 4);
        if (IN(pb + 5)) REPEAT(l == 0 ? REP_OUT : 1) {
            SchedS S = make_sched(CAT, DM, kparams()->ws + WS_WOUT + (size_t)l * DM * DM * 2, DM, MTOK, DM);
            EpiRes E{(l == 0) ? kparams()->x : kparams()->out, kparams()->out, (const float*)(kparams()->ws + WS_MOD) + (size_t)l * 2 * 6144 + 4096};
            pg8::gemm_phase<EpiRes, SchedS, true>(ldsl, pg8::Gemm{DM, DM, DM}, S, E);
        }
        SEAM(pb + 5);
    }
    if (IN(NPH - 1)) ph_final(p);
#undef IN
#undef SEAM
}

extern "C" void kernel_launch(void* const* d_in, const int* in_sizes, int n_in, void* d_out, int out_size, void* d_ws, size_t ws_size, hipStream_t stream) {
    static int grid_blocks = 0;
    if (grid_blocks == 0) {
        if (n_in != 17 || ws_size < WS_END) { fprintf(stderr, "kernel_launch: n_in %d ws %zu (need %zu)\n", n_in, ws_size, (size_t)WS_END); grid_blocks = -1; return; }
        int dev = 0, cus = 0, per_cu = 0;
        hipGetDevice(&dev); hipDeviceGetAttribute(&cus, hipDeviceAttributeMultiprocessorCount, dev);
        if (hipFuncSetAttribute((const void*)mega, hipFuncAttributeMaxDynamicSharedMemorySize, LDS_BYTES) != hipSuccess) { fprintf(stderr, "hipFuncSetAttribute failed\n"); grid_blocks = -1; return; }
        if (hipOccupancyMaxActiveBlocksPerMultiprocessor(&per_cu, (const void*)mega, NTHR, LDS_BYTES) != hipSuccess || per_cu < 1) { fprintf(stderr, "occupancy query: %d\n", per_cu); per_cu = 1; }
        (void)hipGetLastError();
        grid_blocks = cus * 1;
    }
    if (grid_blocks < 0) return;
    Params p{};
    p.x = (const float*)d_in[0]; p.c = (const float*)d_in[1]; p.norm_g = (const float*)d_in[2]; p.w_ada = (const float*)d_in[3]; p.b_ada = (const float*)d_in[4];
    p.w_in = (const float*)d_in[5]; p.w_fft = (const float*)d_in[6]; p.na_bias = (const float*)d_in[7]; p.rl_f = (const float*)d_in[8]; p.rl_b = (const float*)d_in[9];
    p.conv_w = (const float*)d_in[10]; p.conv_b = (const float*)d_in[11]; p.ln_g = (const float*)d_in[12]; p.ln_b = (const float*)d_in[13]; p.w_pw = (const float*)d_in[14];
    p.w_out = (const float*)d_in[15]; p.final_g = (const float*)d_in[16];
    p.out = (float*)d_out; p.ws = (unsigned char*)d_ws;
#if ONE_LAUNCH
    if (hipMemsetAsync((char*)d_ws + WS_BAR, 0, 16384, stream) != hipSuccess) { fprintf(stderr, "memset of the barrier words failed\n"); return; }
    p.ph_lo = 0; p.ph_hi = NPH;
    void* args[] = {&p};
    hipError_t e = hipLaunchCooperativeKernel((const void*)mega, dim3(grid_blocks), dim3(NTHR), args, LDS_BYTES, stream);
    if (e != hipSuccess) fprintf(stderr, "cooperative launch failed: %s (grid %d)\n", hipGetErrorString(e), grid_blocks);
#else
    for (int ph = 0; ph < NPH; ++ph) { p.ph_lo = ph; p.ph_hi = ph + 1; hipLaunchKernelGGL(mega, dim3(grid_blocks), dim3(NTHR), LDS_BYTES, stream, p); }
#endif
}
```

```cpp
#include <hip/hip_runtime.h>
#include <hip/hip_cooperative_groups.h>
#include <cstdio>
#include <cstdint>
namespace cg = cooperative_groups;

#ifndef ONE_LAUNCH
#define ONE_LAUNCH 1
#endif

__device__ __forceinline__ int obid() { int b = (int)blockIdx.x; asm volatile("" : "+s"(b)); return b; }
__device__ __forceinline__ int otid() { int t; asm volatile("v_mov_b32 %0, %1" : "=v"(t) : "v"(threadIdx.x)); return t; }
namespace pg8 {
#define PG8_LAS __attribute__((address_space(3)))
typedef unsigned short bf16_t;
typedef short bf16x8 __attribute__((ext_vector_type(8)));
typedef float f32x4 __attribute__((ext_vector_type(4)));
typedef unsigned u32x4 __attribute__((ext_vector_type(4)));
constexpr int BM = 256, BK = 64, HALF = 128, HTB = HALF * BK * 2, STAGE_BYTES = 8 * HTB, NXCD = 8, WGM = 8;

__host__ __device__ __forceinline__ int lds_byte(int r, int c) { const int st = (r >> 4) * 2 + (c >> 5), rr = r & 15, cc = c & 31, ob = rr * 64 + cc * 2; return st * 1024 + (ob ^ (((ob >> 9) & 1) << 5)); }
__host__ __device__ __forceinline__ void stage_rc(int b, int& R, int& C) { const int st = b / 1024, sb = b % 1024, swz = sb ^ (((sb >> 9) & 1) << 5); R = (st >> 1) * 16 + swz / 64; C = (st & 1) * 32 + (swz % 64) / 2; }
__host__ __device__ __forceinline__ int perm32(int rho) { const int n = rho >> 4, i = rho & 15; return 8 * (i >> 2) + 4 * n + (i & 3); }

struct Unit { int pm, pn, aux, pad; const char* A; const char* B; };
struct Gemm { int lda, ldb, K; };

struct StaticOrder {
    int nM, nN, nwg, G, c;
    __host__ __device__ void init(int M, int N, int G_, int c_) { nM = M / BM; nN = N / BM; nwg = nM * nN; G = G_; c = c_; }
    __device__ bool next(int i, Unit& u) const {
        const long L = (long)i * G + c; if (L >= nwg) return false;
        int wgid = __builtin_amdgcn_readfirstlane((int)L); { const int q = nwg / NXCD, r = nwg % NXCD, xcd = wgid % NXCD, off = wgid / NXCD; wgid = (xcd < r ? xcd * (q + 1) : r * (q + 1) + (xcd - r) * q) + off; }
        const int nig = WGM * nN, gid = wgid / nig, fm = gid * WGM, gsz = (nM - fm) < WGM ? (nM - fm) : WGM;
        u.pm = __builtin_amdgcn_readfirstlane(fm + ((wgid % nig) % gsz)); u.pn = __builtin_amdgcn_readfirstlane((wgid % nig) / gsz); return true;
    }
};

__device__ __forceinline__ unsigned cvt_pk_bf16(float lo, float hi) { unsigned r; asm volatile("v_cvt_pk_bf16_f32 %0, %1, %2" : "=v"(r) : "v"(lo), "v"(hi)); return r; }

template <class Epi, class Sched, bool ALIGN_EPI>
__device__ __forceinline__ void gemm_phase(PG8_LAS unsigned char* lds, const Gemm g, const Sched& S, const Epi& E) {
    const int tid = otid(), wid = __builtin_amdgcn_readfirstlane(tid >> 6), lane = tid & 63, wr = wid >> 2, wc = wid & 3, fr = lane & 15, fq = lane >> 4;
    const int K = g.K, nt = K / BK;
    unsigned voffA[2], voffB[2];
#pragma unroll
    for (int i = 0; i < 2; ++i) { int R, C; stage_rc(tid * 16 + i * 8192, R, C); const int Rb = Epi::PERM ? ((R & ~31) + perm32(R & 31)) : R;
        voffA[i] = (unsigned)(R * g.lda + C) * 2u; voffB[i] = (unsigned)(Rb * g.ldb + C) * 2u; }
    const size_t kstep = (size_t)(BK * 2);
    const size_t hA = (size_t)HALF * g.lda * 2, hB = (size_t)HALF * g.ldb * 2;
    const unsigned ldsw = (unsigned)wid * 1024u;
    const int aoff = lds_byte(wr * 64 + fr, fq * 8), boff = lds_byte(wc * 32 + fr, fq * 8);
#define PG8_SA(b, h) (((b) * 2 + (h)) * HTB)
#define PG8_SB(b, h) ((4 + (b) * 2 + (h)) * HTB)
#define PG8_STAGE(bufoff, gbase, voff) do { _Pragma("unroll") for (int _i = 0; _i < 2; ++_i) \
        __builtin_amdgcn_global_load_lds((const unsigned*)((const char*)(gbase) + (voff)[_i]), (PG8_LAS unsigned*)(lds + (bufoff) + ldsw + _i * 8192), 16, 0, 0); } while (0)
#define PG8_LDA(dst, b, h) do { _Pragma("unroll") for (int m = 0; m < 4; ++m) _Pragma("unroll") for (int k = 0; k < 2; ++k) dst[m][k] = *(const PG8_LAS bf16x8*)(lds + PG8_SA(b, h) + aoff + m * 2048 + k * 1024); } while (0)
#define PG8_LDB(dst, b, h) do { _Pragma("unroll") for (int n = 0; n < 2; ++n) _Pragma("unroll") for (int k = 0; k < 2; ++k) dst[n][k] = *(const PG8_LAS bf16x8*)(lds + PG8_SB(b, h) + boff + n * 2048 + k * 1024); } while (0)
#define PG8_MMA(ai, bj, At, Bt) do { __builtin_amdgcn_s_setprio(1); _Pragma("unroll") for (int m = 0; m < 4; ++m) _Pragma("unroll") for (int n = 0; n < 2; ++n) _Pragma("unroll") for (int k = 0; k < 2; ++k) \
        acc[ai][bj][m][n] = __builtin_amdgcn_mfma_f32_16x16x32_bf16(Bt[n][k], At[m][k], acc[ai][bj][m][n], 0, 0, 0); __builtin_amdgcn_s_setprio(0); } while (0)
#define PG8_WAIT_V(n) asm volatile("s_waitcnt vmcnt(" #n ")" ::: "memory")
#define PG8_WAIT_L(n) asm volatile("s_waitcnt lgkmcnt(" #n ")" ::: "memory")
#define PG8_BAR __builtin_amdgcn_s_barrier()
#define PG8_SCHED __builtin_amdgcn_sched_barrier(0)
    Unit cur, nxt; int ui = 0;
    if (!S.next(0, cur)) return;
    f32x4 acc[2][2][4][2];
#pragma unroll
    for (int a = 0; a < 2; ++a)
#pragma unroll
        for (int b = 0; b < 2; ++b)
#pragma unroll
            for (int m = 0; m < 4; ++m)
#pragma unroll
                for (int n = 0; n < 2; ++n) acc[a][b][m][n] = (f32x4){0.f, 0.f, 0.f, 0.f};
    bf16x8 At[4][2], B0[2][2], B1[2][2];
    const char* cA = cur.A; const char* cB = cur.B;
    PG8_STAGE(PG8_SB(0, 0), cB, voffB); PG8_STAGE(PG8_SB(0, 1), cB + hB, voffB); PG8_STAGE(PG8_SA(0, 0), cA, voffA); PG8_STAGE(PG8_SA(0, 1), cA + hA, voffA);
    if (wr == 1) PG8_BAR;
    PG8_WAIT_V(2); PG8_BAR;
    PG8_STAGE(PG8_SB(1, 0), cB + kstep, voffB); PG8_STAGE(PG8_SA(1, 0), cA + kstep, voffA); PG8_STAGE(PG8_SB(1, 1), cB + hB + kstep, voffB);
    PG8_WAIT_V(6); PG8_BAR;
    for (;;) {
        const bool has_next = S.next(ui + 1, nxt);
        const char* nA = has_next ? nxt.A : cA; const char* nB = has_next ? nxt.B : cB;
        for (int t = 0; t < nt; t += 2) {
            const bool last = (t == nt - 2);
            const char* a1 = cA + (size_t)(t + 1) * kstep;
            const char* a2 = last ? nA : cA + (size_t)(t + 2) * kstep; const char* b2 = last ? nB : cB + (size_t)(t + 2) * kstep;
            const char* a3 = a2 + kstep; const char* b3 = b2 + kstep;
            PG8_LDB(B0, 0, 0); PG8_LDB(B1, 0, 1); PG8_SCHED; PG8_LDA(At, 0, 0); PG8_STAGE(PG8_SA(1, 1), a1 + hA, voffA);
            PG8_WAIT_V(8); PG8_WAIT_L(0); PG8_BAR; PG8_MMA(0, 0, At, B0); PG8_MMA(0, 1, At, B1); PG8_BAR; PG8_SCHED;
            PG8_LDA(At, 0, 1); PG8_STAGE(PG8_SB(0, 0), b2, voffB); PG8_STAGE(PG8_SB(0, 1), b2 + hB, voffB); PG8_STAGE(PG8_SA(0, 0), a2, voffA);
            PG8_WAIT_V(8); PG8_WAIT_L(0); PG8_BAR; PG8_MMA(1, 0, At, B0); PG8_MMA(1, 1, At, B1); PG8_BAR; PG8_SCHED;
            PG8_LDB(B0, 1, 0); PG8_LDB(B1, 1, 1); PG8_SCHED; PG8_LDA(At, 1, 0); PG8_STAGE(PG8_SA(0, 1), a2 + hA, voffA);
            PG8_WAIT_V(8); PG8_WAIT_L(0); PG8_BAR; PG8_MMA(0, 0, At, B0); PG8_MMA(0, 1, At, B1); PG8_BAR; PG8_SCHED;
            PG8_LDA(At, 1, 1); PG8_STAGE(PG8_SB(1, 0), b3, voffB); PG8_STAGE(PG8_SB(1, 1), b3 + hB, voffB); PG8_STAGE(PG8_SA(1, 0), a3, voffA);
            PG8_WAIT_V(8); PG8_WAIT_L(0); PG8_BAR; PG8_MMA(1, 0, At, B0); PG8_MMA(1, 1, At, B1); PG8_BAR; PG8_SCHED;
        }
        if constexpr (ALIGN_EPI) { if (wr == 0) PG8_BAR; }
        E(acc, cur, wr, wc, fr, fq);
        if (!has_next) break;
#pragma unroll
        for (int a = 0; a < 2; ++a)
#pragma unroll
            for (int b = 0; b < 2; ++b)
#pragma unroll
                for (int m = 0; m < 4; ++m)
#pragma unroll
                    for (int n = 0; n < 2; ++n) acc[a][b][m][n] = (f32x4){0.f, 0.f, 0.f, 0.f};
        cur = nxt; cA = nA; cB = nB; ++ui;
        if constexpr (ALIGN_EPI) { if (wr == 1) PG8_BAR; }
    }
    PG8_WAIT_V(0);
    if constexpr (!ALIGN_EPI) { if (wr == 0) PG8_BAR; }
    PG8_BAR;
#undef PG8_SA
#undef PG8_SB
#undef PG8_STAGE
#undef PG8_LDA
#undef PG8_LDB
#undef PG8_MMA
#undef PG8_WAIT_V
#undef PG8_WAIT_L
#undef PG8_BAR
#undef PG8_SCHED
}
}

typedef unsigned short bf16;
typedef float f32x4 __attribute__((ext_vector_type(4)));
typedef unsigned u32x4 __attribute__((ext_vector_type(4)));
typedef unsigned u32x2 __attribute__((ext_vector_type(2)));
constexpr int NB = 2, SEQ = 4096, DM = 2048, MTOK = NB * SEQ, DIN = 6656, DG = 512, NL = 2;
constexpr int LDS_BYTES = 147456;
constexpr int NTHR = 512;

constexpr int WROWS = 7680;
constexpr size_t WS_WIN = 0;
constexpr size_t WS_WOUT = WS_WIN + (size_t)NL * WROWS * DM * 2;
constexpr size_t WS_WCS = WS_WOUT + (size_t)NL * DM * DM * 2;
constexpr size_t WS_WFXB = WS_WCS + (size_t)NL * 1024 * DG * 2;
constexpr size_t WS_WPW = WS_WFXB + (size_t)NL * DM * DG * 2;
constexpr size_t WS_DC = WS_WPW + (size_t)NL * DG * DG * 2;
constexpr size_t WS_DS = WS_DC + (size_t)2304 * 2048 * 2;
constexpr size_t WS_PQF = WS_DS + (size_t)2048 * 2048 * 2;
constexpr size_t WS_ROPE = WS_PQF + (size_t)NB * DG * 2 * 2048 * 2;
constexpr size_t WS_MOD = WS_ROPE + (size_t)SEQ * 32 * 8;
constexpr size_t WS_U = WS_MOD + 131072;
constexpr size_t WS_PART = WS_U + (size_t)MTOK * DM * 2;
constexpr size_t WS_Z = WS_U + (size_t)4 * MTOK * DG * 4;
constexpr size_t WS_PQT = WS_Z + (size_t)MTOK * DIN * 2;
constexpr size_t WS_CVH = WS_PQT + (size_t)NB * DG * 2 * SEQ * 2;
constexpr size_t WS_CAT = WS_CVH + (size_t)MTOK * DG * 2;
constexpr size_t WS_KV = WS_CAT + (size_t)MTOK * DM * 2;
constexpr size_t WS_BAR = WS_KV + (size_t)2 * NB * 8 * 32 * 4096 * 4;
constexpr size_t WS_END = WS_BAR + 16384;

struct Params {
    const float* x; const float* c; const float* norm_g; const float* w_ada; const float* b_ada; const float* w_in; const float* w_fft; const float* na_bias;
    const float* rl_f; const float* rl_b; const float* conv_w; const float* conv_b; const float* ln_g; const float* ln_b; const float* w_pw; const float* w_out; const float* final_g;
    float* out; unsigned char* ws; int ph_lo, ph_hi;
};

#if defined(__HIP_DEVICE_COMPILE__)
typedef const __attribute__((address_space(4))) Params* KParams;
__device__ __forceinline__ KParams kparams() { KParams k = (KParams)__builtin_amdgcn_kernarg_segment_ptr(); asm volatile("" : "+s"(k)); return k; }
#else
typedef const Params* KParams;
__device__ __forceinline__ KParams kparams() { return nullptr; }
#endif
__device__ __forceinline__ unsigned f2bf(float f) { unsigned u = __float_as_uint(f); return (u + 0x7fffu + ((u >> 16) & 1u)) >> 16; }
__device__ __forceinline__ unsigned pk2(float lo, float hi) { return f2bf(lo) | (f2bf(hi) << 16); }
__device__ __forceinline__ float bf2f(bf16 b) { return __uint_as_float((unsigned)b << 16); }
__device__ __forceinline__ float bflo(unsigned u) { return __uint_as_float(u << 16); }
__device__ __forceinline__ float bfhi(unsigned u) { return __uint_as_float(u & 0xffff0000u); }
__device__ __forceinline__ float silu_f(float v) { return v / (1.f + __expf(-v)); }
__device__ __forceinline__ float wave_sum(float v) {
#pragma unroll
    for (int o = 1; o < 64; o <<= 1) v += __shfl_xor(v, o);
    return v;
}
__device__ __forceinline__ float wave_max(float v) {
#pragma unroll
    for (int o = 1; o < 64; o <<= 1) v = fmaxf(v, __shfl_xor(v, o));
    return v;
}

struct SchedS {
    pg8::StaticOrder o; const char* A; const char* B; size_t ta, tb;
    __device__ __forceinline__ bool next(int i, pg8::Unit& u) const { if (!o.next(i, u)) return false; u.A = A + (size_t)u.pm * ta; u.B = B + (size_t)u.pn * tb; u.aux = 0; return true; }
};
__device__ __forceinline__ SchedS make_sched(const void* A, int lda, const void* B, int ldb, int M, int N, int shift = 0) {
    SchedS s; s.o.init(M, N, (int)gridDim.x, (int)((obid() + gridDim.x - shift) % gridDim.x)); s.A = (const char*)A; s.B = (const char*)B; s.ta = (size_t)256 * lda * 2; s.tb = (size_t)256 * ldb * 2; return s;
}
struct SchedZ {
    pg8::StaticOrder o; const char* A; const char* B; int late;
    __device__ __forceinline__ bool next(int i, pg8::Unit& u) const { if (!o.next(i, u)) return false; const int jn = u.pn;
        u.pn = late ? (jn < 2 ? 2 + jn : 22 + jn) : (jn < 20 ? jn + 4 : jn + 6);
        u.A = A + (size_t)u.pm * (256 * DM * 2); u.B = B + (size_t)u.pn * (256 * DM * 2); u.aux = 0; return true; }
};
struct SchedDFT {
    const char* DC; const char* PQF; int G, c;
    __device__ __forceinline__ bool next(int i, pg8::Unit& u) const {
        if (c < 0) return false;
        const int L = __builtin_amdgcn_readfirstlane(i * G + c); if (L >= 64) return false;
        const int b = L >> 5, t = L & 31, odd = t >> 4, tt = t & 15; u.pm = tt >> 1; u.pn = tt & 1; u.aux = b * 2 + odd;
        u.A = DC + (size_t)odd * (WS_DS - WS_DC) + (size_t)u.pm * (256 * 2048 * 2);
        u.B = PQF + ((size_t)(b * 512 + u.pn * 256) * 4096 + odd * 2048) * 2; return true;
    }
};

struct EpiZ {
    static constexpr bool PERM = true;
    bf16* O; int ldc;
    __device__ __forceinline__ void operator()(const pg8::f32x4 (&acc)[2][2][4][2], const pg8::Unit& u, int wr, int wc, int fr, int fq) const {
        const int row0 = u.pm * 256 + wr * 64 + fr, col0 = u.pn * 256 + wc * 32 + 8 * fq;
#pragma unroll
        for (int ai = 0; ai < 2; ++ai)
#pragma unroll
            for (int m = 0; m < 4; ++m) { bf16* rowp = O + (size_t)(row0 + ai * 128 + m * 16) * ldc + col0;
#pragma unroll
                for (int bj = 0; bj < 2; ++bj) { const pg8::f32x4 v0 = acc[ai][bj][m][0], v1 = acc[ai][bj][m][1]; u32x4 w;
                    w.x = pg8::cvt_pk_bf16(v0[0], v0[1]); w.y = pg8::cvt_pk_bf16(v0[2], v0[3]); w.z = pg8::cvt_pk_bf16(v1[0], v1[1]); w.w = pg8::cvt_pk_bf16(v1[2], v1[3]);
                    *(u32x4*)(rowp + bj * 128) = w; } }
    }
};
struct EpiZ2 {
    static constexpr bool PERM = true;
    bf16* O; bf16* PQ;
    __device__ __forceinline__ void operator()(const pg8::f32x4 (&acc)[2][2][4][2], const pg8::Unit& u, int wr, int wc, int fr, int fq) const {
        const int row0 = u.pm * 256 + wr * 64 + fr;
        if (u.pn < 26) { const int col0 = u.pn * 256 + wc * 32 + 8 * fq;
#pragma unroll
            for (int ai = 0; ai < 2; ++ai)
#pragma unroll
                for (int m = 0; m < 4; ++m) { bf16* rowp = O + (size_t)(row0 + ai * 128 + m * 16) * DIN + col0;
#pragma unroll
                    for (int bj = 0; bj < 2; ++bj) { const pg8::f32x4 v0 = acc[ai][bj][m][0], v1 = acc[ai][bj][m][1]; u32x4 w;
                        w.x = pg8::cvt_pk_bf16(v0[0], v0[1]); w.y = pg8::cvt_pk_bf16(v0[2], v0[3]); w.z = pg8::cvt_pk_bf16(v1[0], v1[1]); w.w = pg8::cvt_pk_bf16(v1[2], v1[3]);
                        *(u32x4*)(rowp + bj * 128) = w; } }
        } else { const int np0 = (u.pn - 26) * 256 + wc * 32 + 8 * fq;
#pragma unroll
            for (int bj = 0; bj < 2; ++bj) { const int np = np0 + bj * 128, pq = np >> 9, n = np & 511;
#pragma unroll
                for (int ai = 0; ai < 2; ++ai)
#pragma unroll
                    for (int m = 0; m < 4; ++m) { const int row = row0 + ai * 128 + m * 16, b = row >> 12, sq = row & 4095;
                        bf16* dst = PQ + ((size_t)(b * 512 + n) * 2 + pq) * 4096 + sq;
#pragma unroll
                        for (int nn = 0; nn < 2; ++nn)
#pragma unroll
                            for (int j = 0; j < 4; ++j) dst[(size_t)(4 * nn + j) * 8192] = (bf16)f2bf(acc[ai][bj][m][nn][j]); } }
        }
    }
};
struct EpiGate {
    static constexpr bool PERM = true;
    bf16* O; const bf16* Z; int coff, goff;
    __device__ __forceinline__ void operator()(const pg8::f32x4 (&acc)[2][2][4][2], const pg8::Unit& u, int wr, int wc, int fr, int fq) const {
        const int row0 = u.pm * 256 + wr * 64 + fr, col0 = u.pn * 256 + wc * 32 + 8 * fq;
#pragma unroll
        for (int ai = 0; ai < 2; ++ai)
#pragma unroll
            for (int m = 0; m < 4; ++m) { const size_t row = (size_t)(row0 + ai * 128 + m * 16);
#pragma unroll
                for (int bj = 0; bj < 2; ++bj) { const pg8::f32x4 v0 = acc[ai][bj][m][0], v1 = acc[ai][bj][m][1];
                    const u32x4 gz = *(const u32x4*)(Z + row * DIN + goff + col0 + bj * 128); u32x4 w;
                    w.x = pg8::cvt_pk_bf16(v0[0] * silu_f(bflo(gz.x)), v0[1] * silu_f(bfhi(gz.x))); w.y = pg8::cvt_pk_bf16(v0[2] * silu_f(bflo(gz.y)), v0[3] * silu_f(bfhi(gz.y)));
                    w.z = pg8::cvt_pk_bf16(v1[0] * silu_f(bflo(gz.z)), v1[1] * silu_f(bfhi(gz.z))); w.w = pg8::cvt_pk_bf16(v1[2] * silu_f(bflo(gz.w)), v1[3] * silu_f(bfhi(gz.w)));
                    *(u32x4*)(O + row * DM + coff + col0 + bj * 128) = w; } }
    }
};
struct EpiPart {
    static constexpr bool PERM = false;
    float* P;
    __device__ __forceinline__ void operator()(const pg8::f32x4 (&acc)[2][2][4][2], const pg8::Unit& u, int wr, int wc, int fr, int fq) const {
        const int row0 = u.pm * 256 + wr * 64 + fr, col0 = u.pn * 256 + wc * 32 + 4 * fq;
        float* base = (u.aux & 1) ? P + (size_t)2 * 2304 * 512 + (size_t)(u.aux >> 1) * 2048 * 512 : P + (size_t)(u.aux >> 1) * 2304 * 512;
#pragma unroll
        for (int ai = 0; ai < 2; ++ai)
#pragma unroll
            for (int m = 0; m < 4; ++m) { float* rowp = base + (size_t)(row0 + ai * 128 + m * 16) * 512 + col0;
#pragma unroll
                for (int bj = 0; bj < 2; ++bj)
#pragma unroll
                    for (int n = 0; n < 2; ++n) *(pg8::f32x4*)(rowp + bj * 128 + n * 16) = acc[ai][bj][m][n]; }
    }
};
struct EpiRes {
    static constexpr bool PERM = false;
    const float* xin; float* xout; const float* gate;
    __device__ __forceinline__ void operator()(const pg8::f32x4 (&acc)[2][2][4][2], const pg8::Unit& u, int wr, int wc, int fr, int fq) const {
        const int row0 = u.pm * 256 + wr * 64 + fr, col0 = u.pn * 256 + wc * 32 + 4 * fq;
        const float* gp = gate + (size_t)(u.pm >> 4) * 6144 + col0;
        pg8::f32x4 gv[2][2];
#pragma unroll
        for (int bj = 0; bj < 2; ++bj)
#pragma unroll
            for (int n = 0; n < 2; ++n) gv[bj][n] = *(const pg8::f32x4*)(gp + bj * 128 + n * 16);
#pragma unroll
        for (int ai = 0; ai < 2; ++ai)
#pragma unroll
            for (int m = 0; m < 4; ++m) { const size_t ro = (size_t)(row0 + ai * 128 + m * 16) * DM + col0;
#pragma unroll
                for (int bj = 0; bj < 2; ++bj)
#pragma unroll
                    for (int n = 0; n < 2; ++n) { const pg8::f32x4 xi = *(const pg8::f32x4*)(xin + ro + bj * 128 + n * 16);
                        *(pg8::f32x4*)(xout + ro + bj * 128 + n * 16) = xi + gv[bj][n] * acc[ai][bj][m][n]; } }
    }
};

struct TPItem { const float* src; bf16* dst; int N, K; };
__device__ __forceinline__ TPItem tp_decode(const Params& p, int it, int tid) {
    constexpr int T_IN = 32 * 96, T_OUT = 32 * 32, T_S = 64, T_L = T_IN + T_OUT + T_S;
    const int l = it / T_L; int r = it % T_L; const float* W; bf16* WT; int K, N, kb, nb;
    if (r < T_IN) { W = p.w_in + (size_t)l * DM * DIN; WT = (bf16*)(p.ws + WS_WIN) + (size_t)l * WROWS * DM; K = DM; N = DIN; kb = r / 96; nb = 8 + r % 96; }
    else if (r < T_IN + T_OUT) { r -= T_IN; W = p.w_out + (size_t)l * DM * DM; WT = (bf16*)(p.ws + WS_WOUT) + (size_t)l * DM * DM; K = DM; N = DM; kb = r >> 5; nb = r & 31; }
    else { r -= T_IN + T_OUT; W = p.w_pw + (size_t)l * DG * DG; WT = (bf16*)(p.ws + WS_WPW) + (size_t)l * DG * DG; K = DG; N = DG; kb = r >> 3; nb = r & 7; }
    TPItem t; t.N = N; t.K = K;
    t.src = W + (size_t)(kb * 64 + (tid >> 4)) * N + nb * 64 + (tid & 15) * 4;
    t.dst = WT + (size_t)(nb * 64 + (tid >> 3)) * K + kb * 64 + (tid & 7) * 8;
    return t;
}
__device__ __forceinline__ void tp_store(const TPItem& t, int tid, const f32x4& v0, const f32x4& v1, float* scr) {
    { const int kk = tid >> 4, nn = (tid & 15) * 4;
      scr[kk * 65 + nn] = v0[0]; scr[kk * 65 + nn + 1] = v0[1]; scr[kk * 65 + nn + 2] = v0[2]; scr[kk * 65 + nn + 3] = v0[3];
      scr[(kk + 32) * 65 + nn] = v1[0]; scr[(kk + 32) * 65 + nn + 1] = v1[1]; scr[(kk + 32) * 65 + nn + 2] = v1[2]; scr[(kk + 32) * 65 + nn + 3] = v1[3]; }
    __syncthreads();
    { const int n = tid >> 3, kc = (tid & 7) * 8; const float* s = scr + kc * 65 + n; u32x4 o;
      o.x = pk2(s[0], s[65]); o.y = pk2(s[2 * 65], s[3 * 65]); o.z = pk2(s[4 * 65], s[5 * 65]); o.w = pk2(s[6 * 65], s[7 * 65]);
      *(u32x4*)t.dst = o; }
    __syncthreads();
}

__device__ __forceinline__ void ph_prologue(const Params& p_, unsigned char* lds) {
    const Params p = *kparams(); (void)p_;
    const int tid = otid(), lane = tid & 63, wave = tid >> 6, G = gridDim.x, bid = obid();
    float* scr = (float*)lds;
    { constexpr int T_TOT = NL * (32 * 96 + 32 * 32 + 64);
      int it = bid; TPItem cur; f32x4 a0, a1;
      if (it < T_TOT) { cur = tp_decode(p, it, tid); a0 = *(const f32x4*)cur.src; a1 = *(const f32x4*)(cur.src + (size_t)32 * cur.N); }
      while (it < T_TOT) { const int nit = it + G; TPItem nxt = cur; f32x4 b0 = a0, b1 = a1;
          if (nit < T_TOT) { nxt = tp_decode(p, nit, tid); b0 = *(const f32x4*)nxt.src; b1 = *(const f32x4*)(nxt.src + (size_t)32 * nxt.N); }
          tp_store(cur, tid, a0, a1, scr);
          cur = nxt; a0 = b0; a1 = b1; it = nit; } }
    { bf16* Wfx = (bf16*)(p.ws + WS_WFXB);
      for (int e = bid * NTHR + tid; e < NL * DM * DG / 8; e += G * NTHR) { const int l = e >> 17, r = e & 131071, k = r >> 6, c8 = (r & 63) * 8;
          const float* src = p.w_in + ((size_t)l * DM + k) * DIN + c8; const f32x4 a = *(const f32x4*)src, b4 = *(const f32x4*)(src + 4);
          u32x4 o; o.x = pk2(a[0], a[1]); o.y = pk2(a[2], a[3]); o.z = pk2(b4[0], b4[1]); o.w = pk2(b4[2], b4[3]);
          *(u32x4*)(Wfx + ((size_t)l * DM + k) * DG + c8) = o; } }
    { float* Wl = (float*)lds; float* tr = Wl + 128 * 65; bf16* Wcs = (bf16*)(p.ws + WS_WCS);
      for (int t2 = G - 1 - bid; t2 < 256; t2 += G) {
          const int t = t2 >> 1, ch = t2 & 1, l = t >> 6, pq = (t >> 5) & 1, g = (t >> 3) & 3, n0 = (t & 7) * 64;
#pragma unroll
          for (int i = 0; i < 4; ++i) { const int m = (tid >> 4) + 32 * i, nn = (tid & 15) * 4;
              const f32x4 v = *(const f32x4*)(p.w_fft + ((size_t)l * DG + g * 128 + m) * DG + n0 + nn);
              Wl[m * 65 + nn] = v[0]; Wl[m * 65 + nn + 1] = v[1]; Wl[m * 65 + nn + 2] = v[2]; Wl[m * 65 + nn + 3] = v[3]; }
          if (tid < 128) tr[tid] = pq ? sinpif((float)tid * (1.f / 64.f)) : cospif((float)tid * (1.f / 64.f));
          __syncthreads();
          const int nn = tid >> 3, cc = ch * 64 + (tid & 7) * 8; float acc[8];
#pragma unroll
          for (int i = 0; i < 8; ++i) acc[i] = 0.f;
#pragma unroll 4
          for (int m = 0; m < 128; ++m) { const float w = Wl[m * 65 + nn];
#pragma unroll
              for (int i = 0; i < 8; ++i) acc[i] += tr[((cc + i) * m) & 127] * w; }
          const float nrm = 0.0013810679320049757f;
          u32x4 o0;
          o0.x = pk2(acc[0] * nrm, acc[1] * nrm); o0.y = pk2(acc[2] * nrm, acc[3] * nrm); o0.z = pk2(acc[4] * nrm, acc[5] * nrm); o0.w = pk2(acc[6] * nrm, acc[7] * nrm);
          *(u32x4*)(Wcs + ((size_t)l * 1024 + pq * 512 + n0 + nn) * DG + g * 128 + cc) = o0;
          __syncthreads();
      } }
    __syncthreads();
    float* cosT = (float*)(lds + 32768); float* sinT = (float*)(lds + 49152); float* ca = (float*)(lds + 65536); float* red = (float*)(lds + 81920);
    for (int j = tid; j < 4096; j += NTHR) { cosT[j] = cospif((float)j * (1.f / 2048.f)); sinT[j] = sinpif((float)j * (1.f / 2048.f)); }
    for (int j = tid; j < 4096; j += NTHR) { const float cv = p.c[j]; ca[j] = cv / (1.f + expf(-cv)); }
    __syncthreads();
    { bf16* DC = (bf16*)(p.ws + WS_DC); bf16* DSm = (bf16*)(p.ws + WS_DS);
      for (int r = bid * 2 + (tid >> 8); r < 4352; r += G * 2) { const int is_sin = (r >= 2304) ? 1 : 0, k = is_sin ? r - 2304 : r, s0 = (tid & 255) * 8; float v[8];
#pragma unroll
          for (int j = 0; j < 8; ++j) { const int idx = (k * (s0 + j)) & 4095; v[j] = is_sin ? sinT[idx] : cosT[idx]; }
          u32x4 o; o.x = pk2(v[0], v[1]); o.y = pk2(v[2], v[3]); o.z = pk2(v[4], v[5]); o.w = pk2(v[6], v[7]);
          *(u32x4*)((is_sin ? DSm : DC) + (size_t)k * 2048 + s0) = o; } }
    { float2* rope = (float2*)(p.ws + WS_ROPE);
      for (int e = bid * NTHR + tid; e < 4096 * 32; e += G * NTHR) { const int s = e >> 5, i = e & 31;
          const float inv = (float)pow(10000.0, -(double)i / 32.0); const float ang = (float)s * inv;
          double sn, cs; sincos((double)ang, &sn, &cs); rope[e] = make_float2((float)cs, (float)sn); } }
    float* mod = (float*)(p.ws + WS_MOD);
    for (int t = bid; t < 192; t += G) {
        const int l = t / 96, col = (t % 96) * 64 + lane; const float* W = p.w_ada + (size_t)l * DM * 6144 + col;
        float a0 = 0.f, a1 = 0.f;
        for (int k0 = wave * 256; k0 < wave * 256 + 256; k0 += 32) { float wv[32];
#pragma unroll
            for (int j = 0; j < 32; ++j) wv[j] = W[(size_t)(k0 + j) * 6144];
            asm volatile("" ::: "memory");
#pragma unroll
            for (int j = 0; j < 32; ++j) { a0 += ca[k0 + j] * wv[j]; a1 += ca[2048 + k0 + j] * wv[j]; } }
        red[(wave * 2 + 0) * 64 + lane] = a0; red[(wave * 2 + 1) * 64 + lane] = a1;
        __syncthreads();
        if (wave < 2) { float s = 0.f;
#pragma unroll
            for (int w = 0; w < 8; ++w) s += red[(w * 2 + wave) * 64 + lane];
            mod[(size_t)(l * 2 + wave) * 6144 + col] = s + p.b_ada[l * 6144 + col]; }
        __syncthreads();
    }
}

__device__ __forceinline__ void ph_norm(const Params& p_, int l) {
    const Params p = *kparams(); (void)p_;
    const int tid = otid(), lane = tid & 63, wave = tid >> 6;
    const float* xin = (l == 0) ? p.x : p.out; bf16* h = (bf16*)(p.ws + WS_U); const float* mod = (const float*)(p.ws + WS_MOD);
    const int stride = gridDim.x * 8; const float* g = p.norm_g + l * DM;
    if (stride == 2048) {
        for (int row = obid() * 8 + wave; row < MTOK; row += 2 * stride) {
            const f32x4* xr0 = (const f32x4*)(xin + (size_t)row * DM) + lane; const f32x4* xr1 = (const f32x4*)(xin + (size_t)(row + stride) * DM) + lane;
            const float* md = mod + (size_t)(l * 2 + (row >> 12)) * 6144;
            f32x4 v0[8], v1[8], ca[8], cb[8];
#pragma unroll
            for (int j = 0; j < 8; ++j) { v0[j] = xr0[64 * j]; v1[j] = xr1[64 * j]; }
#pragma unroll
            for (int j = 0; j < 8; ++j) { const int col = (64 * j + lane) * 4; ca[j] = *(const f32x4*)(g + col) * (*(const f32x4*)(md + 2048 + col) + 1.f); cb[j] = *(const f32x4*)(md + col); }
            asm volatile("" ::: "memory");
            float s0 = 0.f, s1 = 0.f;
#pragma unroll
            for (int j = 0; j < 8; ++j) { s0 += (v0[j][0] * v0[j][0] + v0[j][1] * v0[j][1]) + (v0[j][2] * v0[j][2] + v0[j][3] * v0[j][3]); s1 += (v1[j][0] * v1[j][0] + v1[j][1] * v1[j][1]) + (v1[j][2] * v1[j][2] + v1[j][3] * v1[j][3]); }
            s0 = wave_sum(s0); s1 = wave_sum(s1);
            const float r0 = rsqrtf(s0 * (1.f / DM) + 1e-6f), r1 = rsqrtf(s1 * (1.f / DM) + 1e-6f);
#pragma unroll
            for (int j = 0; j < 8; ++j) { const int col = (64 * j + lane) * 4;
                const f32x4 o0 = (v0[j] * r0) * ca[j] + cb[j], o1 = (v1[j] * r1) * ca[j] + cb[j]; u32x2 w;
                w.x = pk2(o0[0], o0[1]); w.y = pk2(o0[2], o0[3]); *(u32x2*)(h + (size_t)row * DM + col) = w;
                w.x = pk2(o1[0], o1[1]); w.y = pk2(o1[2], o1[3]); *(u32x2*)(h + (size_t)(row + stride) * DM + col) = w; }
        }
        return;
    }
    for (int row = obid() * 8 + wave; row < MTOK; row += stride) {
        const f32x4* xr = (const f32x4*)(xin + (size_t)row * DM) + lane; f32x4 v[8]; float ss = 0.f;
#pragma unroll
        for (int j = 0; j < 8; ++j) { v[j] = xr[64 * j]; ss += (v[j][0] * v[j][0] + v[j][1] * v[j][1]) + (v[j][2] * v[j][2] + v[j][3] * v[j][3]); }
        ss = wave_sum(ss); const float rstd = rsqrtf(ss * (1.f / DM) + 1e-6f);
        const float* md = mod + (size_t)(l * 2 + (row >> 12)) * 6144;
#pragma unroll
        for (int j = 0; j < 8; ++j) { const int col = (64 * j + lane) * 4;
            const f32x4 g4 = *(const f32x4*)(g + col), sh = *(const f32x4*)(md + col), sc = *(const f32x4*)(md + 2048 + col);
            const f32x4 o = (v[j] * rstd * g4) * (sc + 1.f) + sh; u32x2 w; w.x = pk2(o[0], o[1]); w.y = pk2(o[2], o[3]);
            *(u32x2*)(h + (size_t)row * DM + col) = w; }
    }
}
__device__ __forceinline__ void ph_final(const Params& p_) {
    const Params p = *kparams(); (void)p_;
    const int tid = otid(), lane = tid & 63, wave = tid >> 6;
    const int stride = gridDim.x * 8;
    for (int row = obid() * 8 + wave; row < MTOK; row += 2 * stride) {
        const bool two = (row + stride < MTOK);
        f32x4* xr0 = (f32x4*)(p.out + (size_t)row * DM) + lane; f32x4* xr1 = (f32x4*)(p.out + (size_t)(two ? row + stride : row) * DM) + lane;
        f32x4 v0[8], v1[8], g4[8];
#pragma unroll
        for (int j = 0; j < 8; ++j) { v0[j] = xr0[64 * j]; v1[j] = xr1[64 * j]; g4[j] = *(const f32x4*)(p.final_g + (64 * j + lane) * 4); }
        asm volatile("" ::: "memory");
        float s0 = 0.f, s1 = 0.f;
#pragma unroll
        for (int j = 0; j < 8; ++j) { s0 += (v0[j][0] * v0[j][0] + v0[j][1] * v0[j][1]) + (v0[j][2] * v0[j][2] + v0[j][3] * v0[j][3]); s1 += (v1[j][0] * v1[j][0] + v1[j][1] * v1[j][1]) + (v1[j][2] * v1[j][2] + v1[j][3] * v1[j][3]); }
        s0 = wave_sum(s0); s1 = wave_sum(s1);
        const float r0 = rsqrtf(s0 * (1.f / DM) + 1e-6f), r1 = rsqrtf(s1 * (1.f / DM) + 1e-6f);
#pragma unroll
        for (int j = 0; j < 8; ++j) { xr0[64 * j] = v0[j] * r0 * g4[j]; if (two) xr1[64 * j] = v1[j] * r1 * g4[j]; }
    }
}

#ifndef REP_PRO
#define REP_PRO 1
#endif
#ifndef REP_NORM
#define REP_NORM 1
#endif
#ifndef REP_Z
#define REP_Z 1
#endif
#ifndef REP_MIX
#define REP_MIX 1
#endif
#ifndef REP_P3
#define REP_P3 1
#endif
#ifndef REP_R2
#define REP_R2 1
#endif
#ifndef REP_CMB
#define REP_CMB 1
#endif
#ifndef REP_FFT
#define REP_FFT 1
#endif
#ifndef REP_OUT
#define REP_OUT 1
#endif
#ifndef REP_SUB
#define REP_SUB 1
#endif

#ifndef REP_R1
#define REP_R1 1
#endif
#ifndef REP_NA
#define REP_NA 1
#endif
#ifndef REP_CV
#define REP_CV 1
#endif
#ifndef REP_F1
#define REP_F1 1
#endif
#define REPEAT(n) for (int rep_ = 0; rep_ < (n); ++rep_)
typedef short bf16x8v __attribute__((ext_vector_type(8)));
__device__ __forceinline__ bf16x8v mk8(unsigned a, unsigned b, unsigned c, unsigned d) { u32x4 v = {a, b, c, d}; return __builtin_bit_cast(bf16x8v, v); }
#define MFMA16(a, b, c) __builtin_amdgcn_mfma_f32_16x16x32_bf16(a, b, c, 0, 0, 0)
constexpr int R_QS = 0, R_KS = 18432, R_VT = 36864, R_KTF = 54272, R_KTB = 71680, R_STF = 89088, R_STB = 98304;

template <bool R2>
__device__ __forceinline__ void ret_stage(const Params& p_, int b, int h, int n, unsigned char* lds, float l2f, float l2b) {
    const Params p = *kparams(); (void)p_;
    const int tid = otid(), j = tid >> 2, c4 = tid & 3, s = n * 128 + j;
    const bf16* Z = (const bf16*)(p.ws + WS_Z); const bf16* zr = Z + (size_t)(b * SEQ + s) * DIN;
    const f32x4* rp = (const f32x4*)((const float2*)(p.ws + WS_ROPE) + s * 32 + c4 * 8);
    f32x4 rr[4];
#pragma unroll
    for (int i = 0; i < 4; ++i) rr[i] = rp[i];
    const u32x4 ka = *(const u32x4*)(zr + 7 * DG + h * 64 + c4 * 8), kb = *(const u32x4*)(zr + 7 * DG + h * 64 + 32 + c4 * 8);
    const u32x4 va = *(const u32x4*)(zr + 8 * DG + h * 64 + c4 * 16), vb = *(const u32x4*)(zr + 8 * DG + h * 64 + c4 * 16 + 8);
    u32x4 qa = ka, qb = kb;
    if (R2) { qa = *(const u32x4*)(zr + 6 * DG + h * 64 + c4 * 8); qb = *(const u32x4*)(zr + 6 * DG + h * 64 + 32 + c4 * 8); }
    asm volatile("" ::: "memory");
    float cs[8], sn[8];
#pragma unroll
    for (int i = 0; i < 4; ++i) { const f32x4 r = rr[i]; cs[2 * i] = r[0]; sn[2 * i] = r[1]; cs[2 * i + 1] = r[2]; sn[2 * i + 1] = r[3]; }
    bf16* KS = (bf16*)(lds + R_KS); bf16* VT = (bf16*)(lds + R_VT);
    {
      const unsigned kau[4] = {ka.x, ka.y, ka.z, ka.w}, kbu[4] = {kb.x, kb.y, kb.z, kb.w};
      float k1[8], k2[8];
#pragma unroll
      for (int i = 0; i < 4; ++i) { const float a0 = bflo(kau[i]), a1 = bfhi(kau[i]), b0 = bflo(kbu[i]), b1 = bfhi(kbu[i]);
          k1[2 * i] = a0 * cs[2 * i] - b0 * sn[2 * i]; k2[2 * i] = a0 * sn[2 * i] + b0 * cs[2 * i];
          k1[2 * i + 1] = a1 * cs[2 * i + 1] - b1 * sn[2 * i + 1]; k2[2 * i + 1] = a1 * sn[2 * i + 1] + b1 * cs[2 * i + 1]; }
      u32x4 o1, o2; o1.x = pk2(k1[0], k1[1]); o1.y = pk2(k1[2], k1[3]); o1.z = pk2(k1[4], k1[5]); o1.w = pk2(k1[6], k1[7]);
      o2.x = pk2(k2[0], k2[1]); o2.y = pk2(k2[2], k2[3]); o2.z = pk2(k2[4], k2[5]); o2.w = pk2(k2[6], k2[7]);
      *(u32x4*)(KS + j * 72 + c4 * 8) = o1; *(u32x4*)(KS + j * 72 + 32 + c4 * 8) = o2;
      if (!R2) { bf16* KTF = (bf16*)(lds + R_KTF); bf16* KTB = (bf16*)(lds + R_KTB);
          const float df = exp2f(l2f * (float)(127 - j)), db = exp2f(l2b * (float)j);
#pragma unroll
          for (int i = 0; i < 8; ++i) { KTF[(c4 * 8 + i) * 136 + j] = (bf16)f2bf(k1[i] * df); KTF[(32 + c4 * 8 + i) * 136 + j] = (bf16)f2bf(k2[i] * df);
              KTB[(c4 * 8 + i) * 136 + j] = (bf16)f2bf(k1[i] * db); KTB[(32 + c4 * 8 + i) * 136 + j] = (bf16)f2bf(k2[i] * db); } } }
    {
      const unsigned vu[8] = {va.x, va.y, va.z, va.w, vb.x, vb.y, vb.z, vb.w};
#pragma unroll
      for (int i = 0; i < 8; ++i) { VT[(c4 * 16 + 2 * i) * 136 + j] = (bf16)(vu[i] & 0xffffu); VT[(c4 * 16 + 2 * i + 1) * 136 + j] = (bf16)(vu[i] >> 16); } }
    if (R2) { bf16* QS = (bf16*)(lds + R_QS);
      const unsigned qau[4] = {qa.x, qa.y, qa.z, qa.w}, qbu[4] = {qb.x, qb.y, qb.z, qb.w};
      float q1[8], q2[8];
#pragma unroll
      for (int i = 0; i < 4; ++i) { const float a0 = bflo(qau[i]), a1 = bfhi(qau[i]), b0 = bflo(qbu[i]), b1 = bfhi(qbu[i]);
          q1[2 * i] = (a0 * cs[2 * i] - b0 * sn[2 * i]) * 0.125f; q2[2 * i] = (a0 * sn[2 * i] + b0 * cs[2 * i]) * 0.125f;
          q1[2 * i + 1] = (a1 * cs[2 * i + 1] - b1 * sn[2 * i + 1]) * 0.125f; q2[2 * i + 1] = (a1 * sn[2 * i + 1] + b1 * cs[2 * i + 1]) * 0.125f; }
      u32x4 o1, o2; o1.x = pk2(q1[0], q1[1]); o1.y = pk2(q1[2], q1[3]); o1.z = pk2(q1[4], q1[5]); o1.w = pk2(q1[6], q1[7]);
      o2.x = pk2(q2[0], q2[1]); o2.y = pk2(q2[2], q2[3]); o2.z = pk2(q2[4], q2[5]); o2.w = pk2(q2[6], q2[7]);
      *(u32x4*)(QS + j * 72 + c4 * 8) = o1; *(u32x4*)(QS + j * 72 + 32 + c4 * 8) = o2; }
}

__device__ __forceinline__ void ret1_task(const Params& p_, int l, int task, unsigned char* lds) {
    const Params p = *kparams(); (void)p_;
    const int n = task & 31, h = (task >> 5) & 7, b = task >> 8;
    const float xf = p.rl_f[l * 8 + h], xb = p.rl_b[l * 8 + h];
    const float l2f = -log1pf(expf(-xf)) * 1.4426950408889634f, l2b = -log1pf(expf(-xb)) * 1.4426950408889634f;
    ret_stage<false>(p, b, h, n, lds, l2f, l2b);
    __syncthreads();
    const int tid = otid(), lane = tid & 63, w = tid >> 6, fr = lane & 15, fq = lane >> 4, dir = w >> 2, et = w & 3;
    const bf16* VT = (const bf16*)(lds + R_VT); const bf16* KT = (const bf16*)(lds + (dir ? R_KTB : R_KTF));
    bf16x8v a[4];
#pragma unroll
    for (int ks = 0; ks < 4; ++ks) a[ks] = *(const bf16x8v*)(VT + (16 * et + fr) * 136 + 32 * ks + 8 * fq);
    float* dst = (float*)(p.ws + WS_KV) + ((size_t)((dir * 2 + b) * 8 + h) * 32 + n) * 4096;
#pragma unroll
    for (int dt = 0; dt < 4; ++dt) { f32x4 acc = {0.f, 0.f, 0.f, 0.f};
#pragma unroll
        for (int ks = 0; ks < 4; ++ks) { const bf16x8v bfr = *(const bf16x8v*)(KT + (16 * dt + fr) * 136 + 32 * ks + 8 * fq); acc = MFMA16(a[ks], bfr, acc); }
#pragma unroll
        for (int r = 0; r < 4; ++r) dst[(16 * et + 4 * fq + r) * 64 + 16 * dt + fr] = acc[r]; }
    __syncthreads();
}

__device__ __forceinline__ void ret2_task(const Params& p_, int l, int task, unsigned char* lds) {
    const Params p = *kparams(); (void)p_;
    const int n = task & 31, h = (task >> 5) & 7, b = task >> 8;
    const float xf = p.rl_f[l * 8 + h], xb = p.rl_b[l * 8 + h];
    const float l2f = -log1pf(expf(-xf)) * 1.4426950408889634f, l2b = -log1pf(expf(-xb)) * 1.4426950408889634f;
    ret_stage<true>(p, b, h, n, lds, l2f, l2b);
    const int tid = otid(), lane = tid & 63, w = tid >> 6, fr = lane & 15, fq = lane >> 4;
    {
      const float gfC = exp2f(l2f * 128.f), gbC = exp2f(l2b * 128.f);
      const float* KVf = (const float*)(p.ws + WS_KV) + ((size_t)((0 * 2 + b) * 8 + h) * 32) * 4096 + tid * 8;
      const float* KVb = (const float*)(p.ws + WS_KV) + ((size_t)((1 * 2 + b) * 8 + h) * 32) * 4096 + tid * 8;
      f32x4 f0 = {0.f, 0.f, 0.f, 0.f}, f1 = f0, g0 = f0, g1 = f0;
      { float c0 = 1.f; int m = n - 1;
        for (; m >= 7; m -= 8) { f32x4 xa[8], xb[8];
#pragma unroll
            for (int j = 0; j < 8; ++j) { xa[j] = *(const f32x4*)(KVf + (size_t)(m - j) * 4096); xb[j] = *(const f32x4*)(KVf + (size_t)(m - j) * 4096 + 4); }
            asm volatile("" ::: "memory");
#pragma unroll
            for (int j = 0; j < 8; ++j) { f0 += xa[j] * c0; f1 += xb[j] * c0; c0 *= gfC; } }
        for (; m >= 0; --m) { const f32x4 x0 = *(const f32x4*)(KVf + (size_t)m * 4096), x1 = *(const f32x4*)(KVf + (size_t)m * 4096 + 4); f0 += x0 * c0; f1 += x1 * c0; c0 *= gfC; } }
      { float c0 = 1.f; int m = n + 1;
        for (; m + 7 < 32; m += 8) { f32x4 xa[8], xb[8];
#pragma unroll
            for (int j = 0; j < 8; ++j) { xa[j] = *(const f32x4*)(KVb + (size_t)(m + j) * 4096); xb[j] = *(const f32x4*)(KVb + (size_t)(m + j) * 4096 + 4); }
            asm volatile("" ::: "memory");
#pragma unroll
            for (int j = 0; j < 8; ++j) { g0 += xa[j] * c0; g1 += xb[j] * c0; c0 *= gbC; } }
        for (; m < 32; ++m) { const f32x4 x0 = *(const f32x4*)(KVb + (size_t)m * 4096), x1 = *(const f32x4*)(KVb + (size_t)m * 4096 + 4); g0 += x0 * c0; g1 += x1 * c0; c0 *= gbC; } }
      const int e = tid >> 3, d0 = (tid & 7) * 8; u32x4 o;
      o.x = pk2(f0[0], f0[1]); o.y = pk2(f0[2], f0[3]); o.z = pk2(f1[0], f1[1]); o.w = pk2(f1[2], f1[3]); *(u32x4*)((bf16*)(lds + R_STF) + e * 72 + d0) = o;
      o.x = pk2(g0[0], g0[1]); o.y = pk2(g0[2], g0[3]); o.z = pk2(g1[0], g1[1]); o.w = pk2(g1[2], g1[3]); *(u32x4*)((bf16*)(lds + R_STB) + e * 72 + d0) = o; }
    __syncthreads();
    const bf16* QS = (const bf16*)(lds + R_QS); const bf16* KS = (const bf16*)(lds + R_KS); const bf16* VT = (const bf16*)(lds + R_VT);
    const bf16* STF = (const bf16*)(lds + R_STF); const bf16* STB = (const bf16*)(lds + R_STB);
    bf16x8v qf[2];
#pragma unroll
    for (int ks = 0; ks < 2; ++ks) qf[ks] = *(const bf16x8v*)(QS + (16 * w + fr) * 72 + 32 * ks + 8 * fq);
    const int ai = 16 * w + fr;
    unsigned pp[8][2];
#pragma unroll
    for (int jt = 0; jt < 8; ++jt) { f32x4 acc = {0.f, 0.f, 0.f, 0.f};
#pragma unroll
        for (int ks = 0; ks < 2; ++ks) { const bf16x8v kf = *(const bf16x8v*)(KS + (16 * jt + fr) * 72 + 32 * ks + 8 * fq); acc = MFMA16(kf, qf[ks], acc); }
        float sc[4];
#pragma unroll
        for (int r = 0; r < 4; ++r) { const int aj = 16 * jt + 4 * fq + r; const float wg = (aj <= ai) ? exp2f(l2f * (float)(ai - aj)) : exp2f(l2b * (float)(aj - ai)); sc[r] = acc[r] * wg; }
        pp[jt][0] = pk2(sc[0], sc[1]); pp[jt][1] = pk2(sc[2], sc[3]); }
    const float qdf = exp2f(l2f * (float)(ai + 1)), qdb = exp2f(l2b * (float)(128 - ai));
    f32x4 tot[4]; float ss = 0.f;
#pragma unroll
    for (int et = 0; et < 4; ++et) { f32x4 o = {0.f, 0.f, 0.f, 0.f}, cfa = o, cba = o;
#pragma unroll
        for (int t = 0; t < 4; ++t) { const u32x2 vlo = *(const u32x2*)(VT + (16 * et + fr) * 136 + 32 * t + 4 * fq), vhi = *(const u32x2*)(VT + (16 * et + fr) * 136 + 32 * t + 16 + 4 * fq);
            o = MFMA16(mk8(vlo.x, vlo.y, vhi.x, vhi.y), mk8(pp[2 * t][0], pp[2 * t][1], pp[2 * t + 1][0], pp[2 * t + 1][1]), o); }
#pragma unroll
        for (int ks = 0; ks < 2; ++ks) { const bf16x8v sf = *(const bf16x8v*)(STF + (16 * et + fr) * 72 + 32 * ks + 8 * fq), sb = *(const bf16x8v*)(STB + (16 * et + fr) * 72 + 32 * ks + 8 * fq);
            cfa = MFMA16(sf, qf[ks], cfa); cba = MFMA16(sb, qf[ks], cba); }
        tot[et] = o + cfa * qdf + cba * qdb;
        ss += (tot[et][0] * tot[et][0] + tot[et][1] * tot[et][1]) + (tot[et][2] * tot[et][2] + tot[et][3] * tot[et][3]); }
    ss += __shfl_xor(ss, 16); ss += __shfl_xor(ss, 32);
    const float rs = rsqrtf(ss * (1.f / 64.f) + 1e-6f);
    const size_t tok = (size_t)b * SEQ + n * 128 + ai;
    const bf16* Z = (const bf16*)(p.ws + WS_Z); bf16* CAT = (bf16*)(p.ws + WS_CAT);
#pragma unroll
    for (int et = 0; et < 4; ++et) { const u32x2 gz = *(const u32x2*)(Z + tok * DIN + 9 * DG + h * 64 + 16 * et + 4 * fq); u32x2 o;
        o.x = pk2(tot[et][0] * rs * silu_f(bflo(gz.x)), tot[et][1] * rs * silu_f(bfhi(gz.x))); o.y = pk2(tot[et][2] * rs * silu_f(bflo(gz.y)), tot[et][3] * rs * silu_f(bfhi(gz.y)));
        *(u32x2*)(CAT + tok * DM + 1024 + h * 64 + 16 * et + 4 * fq) = o; }
    __syncthreads();
}

__device__ __forceinline__ void na2_task(const Params& p_, int l, int task, unsigned char* lds) {
    const Params p = *kparams(); (void)p_;
    const int tid = otid(), lane = tid & 63, w = tid >> 6, fr = lane & 15, fq = lane >> 4;
    const int hp = task & 3, rq = (task >> 2) & 63, b = task >> 8;
    const int row_start = min(max(rq - 4, 0), 56);
    const bf16* Z = (const bf16*)(p.ws + WS_Z); bf16* CAT = (bf16*)(p.ws + WS_CAT);
    bf16* VT = (bf16*)lds; float* BI = (float*)(lds + 133120);
    const int hh = w >> 2, h = hp * 2 + hh, qb = w & 3, kst = min(max(16 * qb - 8, 0), 32);
    const int c = 16 * qb + fr; const size_t qtok = (size_t)b * SEQ + rq * 64 + c;
    bf16x8v qf[2], kfr[8][2];
#pragma unroll
    for (int ks = 0; ks < 2; ++ks) qf[ks] = *(const bf16x8v*)(Z + qtok * DIN + 2 * DG + h * 64 + 32 * ks + 8 * fq);
#pragma unroll
    for (int i = 0; i < 8; ++i) { const int a = i / 2, ci = i % 2;
        const size_t ktok = (size_t)b * SEQ + (row_start + a) * 64 + kst + 16 * ci + fr;
#pragma unroll
        for (int ks = 0; ks < 2; ++ks) kfr[i][ks] = *(const bf16x8v*)(Z + ktok * DIN + 3 * DG + h * 64 + 32 * ks + 8 * fq); }
    asm volatile("" ::: "memory");
    for (int i = tid; i < 930; i += NTHR) BI[i] = p.na_bias[(size_t)(l * 8 + hp * 2) * 465 + i];
    { const int pair = lane & 31, chunk = (lane >> 5) + 2 * (w & 3);
      unsigned* VTd = (unsigned*)(VT + (size_t)hh * 64 * 520);
      u32x4 xs[8], ys[8];
#pragma unroll
      for (int a = 0; a < 8; ++a) { const size_t tok = (size_t)b * SEQ + (row_start + a) * 64 + 2 * pair;
          const bf16* src = Z + tok * DIN + 4 * DG + h * 64 + chunk * 8; xs[a] = *(const u32x4*)src; ys[a] = *(const u32x4*)(src + DIN); }
      asm volatile("" ::: "memory");
#pragma unroll
      for (int a = 0; a < 8; ++a) { const unsigned xu[4] = {xs[a].x, xs[a].y, xs[a].z, xs[a].w}, yu[4] = {ys[a].x, ys[a].y, ys[a].z, ys[a].w};
#pragma unroll
          for (int i = 0; i < 4; ++i) { VTd[(chunk * 8 + 2 * i) * 260 + a * 32 + pair] = (xu[i] & 0xffffu) | (yu[i] << 16);
              VTd[(chunk * 8 + 2 * i + 1) * 260 + a * 32 + pair] = (xu[i] >> 16) | (yu[i] & 0xffff0000u); } } }
    __syncthreads();
    const int col_start = min(max(c - 8, 0), 48);
    const float* bi = BI + hh * 465;
    float sc[16][4]; float mx = -1e30f;
#pragma unroll
    for (int hf = 0; hf < 2; ++hf) {
        if (hf == 1) {
#pragma unroll
            for (int i = 0; i < 8; ++i) { const int a = 4 + i / 2, ci = i % 2;
                const size_t ktok = (size_t)b * SEQ + (row_start + a) * 64 + kst + 16 * ci + fr;
#pragma unroll
                for (int ks = 0; ks < 2; ++ks) kfr[i][ks] = *(const bf16x8v*)(Z + ktok * DIN + 3 * DG + h * 64 + 32 * ks + 8 * fq); }
            asm volatile("" ::: "memory");
        }
#pragma unroll
        for (int i = 0; i < 8; ++i) { const int a = 4 * hf + i / 2, ci = i % 2, kt = a * 2 + ci;
            f32x4 acc = {0.f, 0.f, 0.f, 0.f};
#pragma unroll
            for (int ks = 0; ks < 2; ++ks) acc = MFMA16(kfr[i][ks], qf[ks], acc);
            const int dr = row_start + a - rq;
#pragma unroll
            for (int r = 0; r < 4; ++r) { const int kc = kst + 16 * ci + 4 * fq + r, rel = kc - col_start, dc = kc - c;
                float v = acc[r] * 0.125f + bi[(dr + 7) * 31 + min(max(dc + 15, 0), 30)];
                v = (rel >= 0 && rel < 16) ? v : -1e30f; sc[kt][r] = v; mx = fmaxf(mx, v); } }
    }
    mx = fmaxf(mx, __shfl_xor(mx, 16)); mx = fmaxf(mx, __shfl_xor(mx, 32));
    float sum = 0.f; unsigned pp[16][2];
#pragma unroll
    for (int kt = 0; kt < 16; ++kt) { const float e0 = __expf(sc[kt][0] - mx), e1 = __expf(sc[kt][1] - mx), e2 = __expf(sc[kt][2] - mx), e3 = __expf(sc[kt][3] - mx);
        sum += (e0 + e1) + (e2 + e3); pp[kt][0] = pk2(e0, e1); pp[kt][1] = pk2(e2, e3); }
    sum += __shfl_xor(sum, 16); sum += __shfl_xor(sum, 32);
    const float inv = 1.f / sum;
    const bf16* VTh = VT + (size_t)hh * 64 * 520;
#pragma unroll
    for (int dt = 0; dt < 4; ++dt) { f32x4 o = {0.f, 0.f, 0.f, 0.f};
#pragma unroll
        for (int t = 0; t < 8; ++t) { const int k0 = 2 * t, k1 = 2 * t + 1, a0 = k0 / 2, c0 = k0 % 2, a1 = k1 / 2, c1 = k1 % 2;
            const u32x2 vlo = *(const u32x2*)(VTh + (16 * dt + fr) * 520 + a0 * 64 + kst + 16 * c0 + 4 * fq), vhi = *(const u32x2*)(VTh + (16 * dt + fr) * 520 + a1 * 64 + kst + 16 * c1 + 4 * fq);
            o = MFMA16(mk8(vlo.x, vlo.y, vhi.x, vhi.y), mk8(pp[k0][0], pp[k0][1], pp[k1][0], pp[k1][1]), o); }
        const u32x2 gz = *(const u32x2*)(Z + qtok * DIN + 5 * DG + h * 64 + 16 * dt + 4 * fq); u32x2 ov;
        ov.x = pk2(o[0] * inv * silu_f(bflo(gz.x)), o[1] * inv * silu_f(bfhi(gz.x))); ov.y = pk2(o[2] * inv * silu_f(bflo(gz.y)), o[3] * inv * silu_f(bfhi(gz.y)));
        *(u32x2*)(CAT + qtok * DM + 512 + h * 64 + 16 * dt + 4 * fq) = ov; }
    __syncthreads();
}

__device__ __forceinline__ void conv_task(const Params& p_, int l, int task, unsigned char* lds) {
    const Params p = *kparams(); (void)p_;
    const int tid = otid(), lane = tid & 63, wave = tid >> 6;
    float* us = (float*)lds; float* ys = us + 46 * 512;
    const bf16* Z = (const bf16*)(p.ws + WS_Z);
    const int b = task >> 8, t0 = (task & 255) * 16;
    { u32x4 av[6], gv[6];
#pragma unroll
      for (int it = 0; it < 6; ++it) { const int idx = tid + it * NTHR, tt = idx >> 6, cc = (idx & 63) * 8, tok = t0 - 15 + tt;
          av[it] = (u32x4){0u, 0u, 0u, 0u}; gv[it] = av[it];
          if (idx < 46 * 64 && tok >= 0 && tok < SEQ) { const bf16* zr = Z + (size_t)(b * SEQ + tok) * DIN; av[it] = *(const u32x4*)(zr + 10 * DG + cc); gv[it] = *(const u32x4*)(zr + 11 * DG + cc); } }
      asm volatile("" ::: "memory");
#pragma unroll
      for (int it = 0; it < 6; ++it) { const int idx = tid + it * NTHR, tt = idx >> 6, cc = (idx & 63) * 8;
          if (idx < 46 * 64) { const u32x4 a = av[it], g = gv[it]; f32x4 u0, u1;
              u0[0] = bflo(a.x) / (1.f + __expf(-bflo(g.x))); u0[1] = bfhi(a.x) / (1.f + __expf(-bfhi(g.x))); u0[2] = bflo(a.y) / (1.f + __expf(-bflo(g.y))); u0[3] = bfhi(a.y) / (1.f + __expf(-bfhi(g.y)));
              u1[0] = bflo(a.z) / (1.f + __expf(-bflo(g.z))); u1[1] = bfhi(a.z) / (1.f + __expf(-bfhi(g.z))); u1[2] = bflo(a.w) / (1.f + __expf(-bflo(g.w))); u1[3] = bfhi(a.w) / (1.f + __expf(-bfhi(g.w)));
              *(f32x4*)(us + tt * 512 + cc) = u0; *(f32x4*)(us + tt * 512 + cc + 4) = u1; } } }
    float w[31];
#pragma unroll
    for (int k = 0; k < 31; ++k) w[k] = p.conv_w[(size_t)(l * 31 + k) * DG + tid];
    const float cb = p.conv_b[l * DG + tid];
    __syncthreads();
    { float y[16];
#pragma unroll
      for (int t = 0; t < 16; ++t) y[t] = cb;
#pragma unroll
      for (int j = 0; j < 46; ++j) { const float u = us[j * 512 + tid];
#pragma unroll
          for (int t = 0; t < 16; ++t) { const int k = j - t; if (k >= 0 && k < 31) y[t] += w[k] * u; } }
#pragma unroll
      for (int t = 0; t < 16; ++t) ys[t * 512 + tid] = y[t]; }
    __syncthreads();
#pragma unroll
    for (int tw = 0; tw < 2; ++tw) { const int t = wave + 8 * tw; float v[8]; float s = 0.f;
#pragma unroll
        for (int j = 0; j < 8; ++j) { v[j] = ys[t * 512 + lane + 64 * j]; s += v[j]; }
        const float mu = wave_sum(s) * (1.f / 512.f); float q = 0.f;
#pragma unroll
        for (int j = 0; j < 8; ++j) { v[j] -= mu; q += v[j] * v[j]; }
        const float rstd = rsqrtf(wave_sum(q) * (1.f / 512.f) + 1e-6f);
        bf16* orow = (bf16*)(p.ws + WS_CVH) + (size_t)(b * SEQ + t0 + t) * DG;
#pragma unroll
        for (int j = 0; j < 8; ++j) { const int ch = lane + 64 * j; const float y = v[j] * rstd * p.ln_g[l * DG + ch] + p.ln_b[l * DG + ch]; orow[ch] = (bf16)f2bf(silu_f(y)); } }
    __syncthreads();
}

__device__ __forceinline__ void ph_mixA(const Params& p, int l, unsigned char* lds) {
    const int G = gridDim.x, bid = obid();
    for (int t = bid; t < 512 * REP_R1; t += G) ret1_task(p, l, t & 511, lds);
    if (G == 256 && REP_NA == 1) {
        if (bid < 128) na2_task(p, l, bid, lds);
        else for (int i = 0; i < 3; ++i) na2_task(p, l, 128 + (bid - 128) * 3 + i, lds);
    } else for (int t = bid; t < 512 * REP_NA; t += G) na2_task(p, l, t & 511, lds);
    if (G == 256 && REP_CV == 1) {
        if (bid < 128) conv_task(p, l, bid, lds);
        else for (int i = 0; i < 3; ++i) conv_task(p, l, 128 + (bid - 128) * 3 + i, lds);
    } else for (int t = bid; t < 512 * REP_CV; t += G) conv_task(p, l, t & 511, lds);
}

__device__ __forceinline__ void ph_fold(const Params& p_) {
    const Params p = *kparams(); (void)p_;
    const bf16* PQ = (const bf16*)(p.ws + WS_PQT); bf16* PQF = (bf16*)(p.ws + WS_PQF);
    for (int e = obid() * NTHR + otid(); e < NB * DG * 2 * 256; e += gridDim.x * NTHR) {
        const int row = e >> 8, s0 = (e & 255) * 8, pq = row & 1;
        const bf16* src = PQ + (size_t)row * 4096;
        const u32x4 own = *(const u32x4*)(src + s0), low = *(const u32x4*)(src + 4096 - s0 - 8);
        const float top = (s0 == 0) ? 0.f : bf2f(src[4096 - s0]);
        const float sg = pq ? -1.f : 1.f;
        float o[8];
        o[0] = bflo(own.x) + sg * top;            o[1] = bfhi(own.x) + sg * bfhi(low.w);
        o[2] = bflo(own.y) + sg * bflo(low.w);    o[3] = bfhi(own.y) + sg * bfhi(low.z);
        o[4] = bflo(own.z) + sg * bflo(low.z);    o[5] = bfhi(own.z) + sg * bfhi(low.y);
        o[6] = bflo(own.w) + sg * bflo(low.y);    o[7] = bfhi(own.w) + sg * bfhi(low.x);
        if (s0 == 0 && pq) o[0] = 0.f;
        u32x4 w; w.x = pk2(o[0], o[1]); w.y = pk2(o[2], o[3]); w.z = pk2(o[4], o[5]); w.w = pk2(o[6], o[7]);
        *(u32x4*)(PQF + (size_t)row * 2048 + s0) = w;
    }
}
__device__ __forceinline__ void ph_alt(const Params& p_) {
    const Params p = *kparams(); (void)p_;
    const int tid = otid(), lane = tid & 63, wave = tid >> 6; const bf16* PQF = (const bf16*)(p.ws + WS_PQF);
    float* dst = (float*)(p.ws + WS_PART) + (size_t)(2 * 2304 + 2 * 2048) * 512;
    for (int r = obid() * 8 + wave; r < NB * DG; r += gridDim.x * 8) {
        const u32x4* src = (const u32x4*)(PQF + (size_t)r * 4096) + lane; float acc = 0.f;
#pragma unroll
        for (int j = 0; j < 4; ++j) { const u32x4 v = src[64 * j];
            acc += (bflo(v.x) - bfhi(v.x)) + (bflo(v.y) - bfhi(v.y)) + (bflo(v.z) - bfhi(v.z)) + (bflo(v.w) - bfhi(v.w)); }
        acc = wave_sum(acc);
        if (lane == 0) dst[r] = acc;
    }
}
__device__ __forceinline__ void ph_combine(const Params& p_) {
    const Params p = *kparams(); (void)p_;
    const float* Ce = (const float*)(p.ws + WS_PART); const float* So = Ce + (size_t)2 * 2304 * 512;
    bf16* CAT = (bf16*)(p.ws + WS_CAT); const bf16* Z = (const bf16*)(p.ws + WS_Z); const bf16* PQ = (const bf16*)(p.ws + WS_PQT);
    const int nth = gridDim.x * NTHR;
    for (int e0 = obid() * NTHR + otid(); e0 < MTOK * DG / 4; e0 += 2 * nth) {
        f32x4 ce[2], so[2]; u32x2 gz[2]; float pv[2][4]; int rowv[2], c4v[2], kv[2]; bool use_so[2], act[2];
#pragma unroll
        for (int u = 0; u < 2; ++u) { const int e = e0 + u * nth; act[u] = e < MTOK * DG / 4; const int ee = act[u] ? e : e0;
            const int row = ee >> 7, c4 = (ee & 127) * 4, b = row >> 12, k = row & 4095, kk = (k <= 2048) ? k : 4096 - k;
            rowv[u] = row; c4v[u] = c4; kv[u] = k; use_so[u] = (kk != 0 && kk != 2048);
            ce[u] = (kk == 2048) ? *(const f32x4*)(Ce + (size_t)(2 * 2304 + 2 * 2048) * 512 + b * 512 + c4) : *(const f32x4*)(Ce + ((size_t)b * 2304 + kk) * 512 + c4);
            so[u] = *(const f32x4*)(So + ((size_t)b * 2048 + (use_so[u] ? kk : 1)) * 512 + c4);
            gz[u] = *(const u32x2*)(Z + (size_t)row * DIN + DG + c4);
#pragma unroll
            for (int j = 0; j < 4; ++j) pv[u][j] = bf2f(PQ[((size_t)(b * 512 + c4 + j) * 2) * 4096 + 2048]); }
        asm volatile("" ::: "memory");
#pragma unroll
        for (int u = 0; u < 2; ++u) if (act[u]) { f32x4 s = ce[u];
            if (use_so[u]) s = (kv[u] <= 2048) ? s - so[u] : s + so[u];
            const float alt = (kv[u] & 1) ? -1.f : 1.f;
#pragma unroll
            for (int j = 0; j < 4; ++j) s[j] += alt * pv[u][j];
            u32x2 w; w.x = pk2(s[0] * silu_f(bflo(gz[u].x)), s[1] * silu_f(bfhi(gz[u].x))); w.y = pk2(s[2] * silu_f(bflo(gz[u].y)), s[3] * silu_f(bfhi(gz[u].y)));
            *(u32x2*)(CAT + (size_t)rowv[u] * DM + c4v[u]) = w; }
    }
}

#define XB_TMO      128
#define XB_XCNT(j)  (256  + 64 * (j))
#define XB_XSUB(j)  (1280 + 64 * (j))
#define XB_XGEN(j)  (2304 + 64 * (j))
#define XB_TOP      3328
#define XB_TOPGEN   3392
#define XCD_BAR_WORDS 3456
#define XB_SPIN_CAP (1u << 20)
__device__ __forceinline__ unsigned xb_ld(unsigned* p)              { return __hip_atomic_load(p, __ATOMIC_RELAXED, __HIP_MEMORY_SCOPE_AGENT); }
__device__ __forceinline__ unsigned xb_add(unsigned* p, unsigned v) { return __hip_atomic_fetch_add(p, v, __ATOMIC_RELAXED, __HIP_MEMORY_SCOPE_AGENT); }
__device__ __forceinline__ unsigned xb_xcc_id() { return (unsigned)__builtin_amdgcn_s_getreg((3 << 11) | 20) & 0xFu; }
#define XB_SPIN(cond, bar) do { unsigned _sp = 0; while (cond) { __builtin_amdgcn_s_sleep(1); \
    if ((++_sp & 255u) == 0u) { if (xb_ld(&(bar)[XB_TMO])) break; if (_sp > XB_SPIN_CAP) { atomicAdd(&(bar)[XB_TMO], 1u); break; } } } } while (0)
struct XcdBarrier { unsigned* bar; unsigned x; volatile PG8_LAS unsigned* st; };
__device__ __forceinline__ XcdBarrier xcd_barrier_post(unsigned* bar, volatile PG8_LAS unsigned* st) {
    XcdBarrier b; b.bar = bar; b.x = xb_xcc_id(); b.st = st;
    if (otid() == 0) (void)xb_add(&bar[XB_XCNT(b.x)], 1u);
    return b;
}
__device__ __forceinline__ void xcd_barrier_complete(unsigned* bar, unsigned x, unsigned& nloc, unsigned& nx) {
    const unsigned G = gridDim.x * gridDim.y * gridDim.z;
    unsigned sum, cnt, mine, sp = 0u;
    for (;;) {
        sum = 0u; cnt = 0u; mine = 0u;
#pragma unroll
        for (unsigned j = 0; j < 16; ++j) { const unsigned c = xb_ld(&bar[XB_XCNT(j)]); sum += c; cnt += (c > 0u) ? 1u : 0u; mine = (j == x) ? c : mine; }
        if (sum == G) break;
        __builtin_amdgcn_s_sleep(1);
        if ((++sp & 255u) == 0u) { if (xb_ld(&bar[XB_TMO])) break; if (sp > XB_SPIN_CAP) { atomicAdd(&bar[XB_TMO], 1u); break; } }
    }
    nloc = mine > 0u ? mine : 1u; nx = cnt > 0u ? cnt : 1u;
}
__device__ __forceinline__ void xcd_barrier(const XcdBarrier& b) {
    asm volatile("s_waitcnt vmcnt(0)" ::: "memory");
    __syncthreads();
    if (otid() == 0) {
        unsigned* bar = b.bar;
        __builtin_amdgcn_s_waitcnt(0);
        unsigned nloc = b.st[0], nx = b.st[1];
        if (nloc == 0u) { xcd_barrier_complete(bar, b.x, nloc, nx); b.st[0] = nloc; b.st[1] = nx; }
        const unsigned old = xb_add(&bar[XB_XSUB(b.x)], 1u);
        const unsigned gen = old / nloc;
        if (old + 1u == (gen + 1u) * nloc) {
            __builtin_amdgcn_fence(__ATOMIC_RELEASE, "agent");
            asm volatile("s_waitcnt vmcnt(0)" ::: "memory");
            const unsigned og = xb_add(&bar[XB_TOP], 1u);
            const unsigned tg = og / nx;
            if (og + 1u == (tg + 1u) * nx) xb_add(&bar[XB_TOPGEN], 1u);
            else XB_SPIN(xb_ld(&bar[XB_TOPGEN]) == tg, bar);
            __builtin_amdgcn_fence(__ATOMIC_ACQUIRE, "agent");
            xb_add(&bar[XB_XGEN(b.x)], 1u);
            asm volatile("s_waitcnt vmcnt(0)" ::: "memory");
        } else {
            XB_SPIN(xb_ld(&bar[XB_XGEN(b.x)]) == gen, bar);
            __builtin_amdgcn_fence(__ATOMIC_ACQUIRE, "agent");
            asm volatile("s_waitcnt vmcnt(0)" ::: "memory");
        }
    }
    __syncthreads();
}

constexpr int NPH = 14;
__global__ void __launch_bounds__(NTHR) mega(Params p) {
    extern __shared__ __attribute__((aligned(16))) unsigned char lds[];
    cg::grid_group grid = cg::this_grid();
    PG8_LAS unsigned char* ldsl = (PG8_LAS unsigned char*)lds;
    const int lo = p.ph_lo, hi = p.ph_hi;
#define IN(k) (lo <= (k) && (k) < hi)
#define SEAM(k) do { if (IN(k) && IN((k) + 1)) { xcd_barrier(xb); } } while (0)
    bf16* Zb = (bf16*)(kparams()->ws + WS_Z); bf16* CAT = (bf16*)(kparams()->ws + WS_CAT);
    volatile PG8_LAS unsigned* xst = (volatile PG8_LAS unsigned*)(ldsl + LDS_BYTES - 16);
    { const int t0_ = otid(); if (t0_ < 4) xst[t0_] = 0u; }
    __syncthreads();
    XcdBarrier xb = xcd_barrier_post((unsigned*)(kparams()->ws + WS_BAR), xst);
    if (p.ph_lo < 0) grid.sync();
    if (IN(0)) REPEAT(REP_PRO) { ph_prologue(p, lds); __syncthreads(); }
    SEAM(0);
    if (IN(0) && IN(1)) for (int r_ = 1; r_ < REP_SUB; ++r_) xcd_barrier(xb);
#pragma unroll
    for (int l = 0; l < NL; ++l) {
        const int pb = 1 + 6 * l;
        const char* Wl = (const char*)(kparams()->ws + WS_WIN + (size_t)l * WROWS * DM * 2);
        if (IN(pb)) {
            if (l == 0) {
#pragma unroll
                for (int ll = 0; ll < NL; ++ll) {
                    SchedS S = make_sched(kparams()->ws + WS_WCS + (size_t)ll * 1024 * DG * 2, DG, kparams()->ws + WS_WFXB + (size_t)ll * DM * DG * 2, DG, 1024, DM, 32 * ll);
                    EpiZ E{(bf16*)(kparams()->ws + WS_WIN + ((size_t)ll * WROWS + 6656) * DM * 2), DM};
                    pg8::gemm_phase<EpiZ, SchedS, true>(ldsl, pg8::Gemm{DG, DG, DG}, S, E);
                }
            }
            REPEAT(REP_NORM) ph_norm(p, l);
        }
        SEAM(pb);
        if (IN(pb + 1)) REPEAT(REP_Z) {
            SchedZ S; S.o.init(MTOK, 24 * 256, (int)gridDim.x, obid()); S.A = (const char*)(kparams()->ws + WS_U); S.B = Wl; S.late = 0;
            EpiZ2 E{Zb, (bf16*)(kparams()->ws + WS_PQT)};
            pg8::gemm_phase<EpiZ2, SchedZ, true>(ldsl, pg8::Gemm{DM, DM, DM}, S, E);
        }
        SEAM(pb + 1);
        if (IN(pb + 2)) {
            {
                SchedZ S; S.o.init(MTOK, 4 * 256, (int)gridDim.x, obid()); S.A = (const char*)(kparams()->ws + WS_U); S.B = Wl; S.late = 1;
                EpiZ2 E{Zb, (bf16*)(kparams()->ws + WS_PQT)};
                pg8::gemm_phase<EpiZ2, SchedZ, true>(ldsl, pg8::Gemm{DM, DM, DM}, S, E);
            }
            REPEAT(REP_MIX) ph_mixA(p, l, lds);
            ph_fold(p);
        }
        SEAM(pb + 2);
        if (IN(pb + 3)) REPEAT(REP_P3) {
            const int G_ = (int)gridDim.x, b_ = obid(); const bool bal = (G_ == 256);
            {
                SchedDFT S{(const char*)(kparams()->ws + WS_DC), (const char*)(kparams()->ws + WS_PQF), G_, b_};
                EpiPart E{(float*)(kparams()->ws + WS_PART)};
                pg8::gemm_phase<EpiPart, SchedDFT, true>(ldsl, pg8::Gemm{2048, 4096, 2048}, S, E); }
            {
                SchedS S = make_sched(kparams()->ws + WS_CVH, DG, kparams()->ws + WS_WPW + (size_t)l * DG * DG * 2, DG, MTOK, DG, bal ? 192 : 0);
                EpiGate E{CAT, Zb, 1536, 12 * DG};
                pg8::gemm_phase<EpiGate, SchedS, true>(ldsl, pg8::Gemm{DG, DG, DG}, S, E); }
            if (bal && REP_R2 == 1) {
                int t0 = 0, nt_ = 0;
                if (b_ >= 192) { t0 = 384 + (b_ - 192) * 2; nt_ = 2; } else if (b_ >= 64) { t0 = (b_ - 64) * 3; nt_ = 3; }
                for (int i = 0; i < nt_; ++i) ret2_task(p, l, t0 + i, lds);
            }
            else for (int t = b_; t < 512 * REP_R2; t += G_) ret2_task(p, l, t & 511, lds);
            ph_alt(p);
        }
        SEAM(pb + 3);
        if (IN(pb + 4)) REPEAT(REP_CMB) ph_combine(p);
        SEAM(pb + 4);
        if (IN(pb + 5)) REPEAT(l == 0 ? REP_OUT : 1) {
            SchedS S = make_sched(CAT, DM, kparams()->ws + WS_WOUT + (size_t)l * DM * DM * 2, DM, MTOK, DM);
            EpiRes E{(l == 0) ? kparams()->x : kparams()->out, kparams()->out, (const float*)(kparams()->ws + WS_MOD) + (size_t)l * 2 * 6144 + 4096};
            pg8::gemm_phase<EpiRes, SchedS, true>(ldsl, pg8::Gemm{DM, DM, DM}, S, E);
        }
        SEAM(pb + 5);
    }
    if (IN(NPH - 1)) ph_final(p);
#undef IN
#undef SEAM
}

extern "C" void kernel_launch(void* const* d_in, const int* in_sizes, int n_in, void* d_out, int out_size, void* d_ws, size_t ws_size, hipStream_t stream) {
    static int grid_blocks = 0;
    if (grid_blocks == 0) {
        if (n_in != 17 || ws_size < WS_END) { fprintf(stderr, "kernel_launch: n_in %d ws %zu (need %zu)\n", n_in, ws_size, (size_t)WS_END); grid_blocks = -1; return; }
        int dev = 0, cus = 0, per_cu = 0;
        hipGetDevice(&dev); hipDeviceGetAttribute(&cus, hipDeviceAttributeMultiprocessorCount, dev);
        if (hipFuncSetAttribute((const void*)mega, hipFuncAttributeMaxDynamicSharedMemorySize, LDS_BYTES) != hipSuccess) { fprintf(stderr, "hipFuncSetAttribute failed\n"); grid_blocks = -1; return; }
        if (hipOccupancyMaxActiveBlocksPerMultiprocessor(&per_cu, (const void*)mega, NTHR, LDS_BYTES) != hipSuccess || per_cu < 1) { fprintf(stderr, "occupancy query: %d\n", per_cu); per_cu = 1; }
        (void)hipGetLastError();
        grid_blocks = cus * 1;
    }
    if (grid_blocks < 0) return;
    Params p{};
    p.x = (const float*)d_in[0]; p.c = (const float*)d_in[1]; p.norm_g = (const float*)d_in[2]; p.w_ada = (const float*)d_in[3]; p.b_ada = (const float*)d_in[4];
    p.w_in = (const float*)d_in[5]; p.w_fft = (const float*)d_in[6]; p.na_bias = (const float*)d_in[7]; p.rl_f = (const float*)d_in[8]; p.rl_b = (const float*)d_in[9];
    p.conv_w = (const float*)d_in[10]; p.conv_b = (const float*)d_in[11]; p.ln_g = (const float*)d_in[12]; p.ln_b = (const float*)d_in[13]; p.w_pw = (const float*)d_in[14];
    p.w_out = (const float*)d_in[15]; p.final_g = (const float*)d_in[16];
    p.out = (float*)d_out; p.ws = (unsigned char*)d_ws;
#if ONE_LAUNCH
    if (hipMemsetAsync((char*)d_ws + WS_BAR, 0, 16384, stream) != hipSuccess) { fprintf(stderr, "memset of the barrier words failed\n"); return; }
    p.ph_lo = 0; p.ph_hi = NPH;
    void* args[] = {&p};
    hipError_t e = hipLaunchCooperativeKernel((const void*)mega, dim3(grid_blocks), dim3(NTHR), args, LDS_BYTES, stream);
    if (e != hipSuccess) fprintf(stderr, "cooperative launch failed: %s (grid %d)\n", hipGetErrorString(e), grid_blocks);
#else
    for (int ph = 0; ph < NPH; ++ph) { p.ph_lo = ph; p.ph_hi = ph + 1; hipLaunchKernelGGL(mega, dim3(grid_blocks), dim3(NTHR), LDS_BYTES, stream, p); }
#endif
}
```

```cpp
#include <hip/hip_runtime.h>
#include <hip/hip_cooperative_groups.h>
#include <cstdio>
#include <cstdint>
namespace cg = cooperative_groups;

#ifndef ONE_LAUNCH
#define ONE_LAUNCH 1
#endif

__device__ __forceinline__ int obid() { int b = (int)blockIdx.x; asm volatile("" : "+s"(b)); return b; }
__device__ __forceinline__ int otid() { int t; asm volatile("v_mov_b32 %0, %1" : "=v"(t) : "v"(threadIdx.x)); return t; }
namespace pg8 {
#define PG8_LAS __attribute__((address_space(3)))
typedef unsigned short bf16_t;
typedef short bf16x8 __attribute__((ext_vector_type(8)));
typedef float f32x4 __attribute__((ext_vector_type(4)));
typedef unsigned u32x4 __attribute__((ext_vector_type(4)));
constexpr int BM = 256, BK = 64, HALF = 128, HTB = HALF * BK * 2, STAGE_BYTES = 8 * HTB, NXCD = 8, WGM = 8;

__host__ __device__ __forceinline__ int lds_byte(int r, int c) { const int st = (r >> 4) * 2 + (c >> 5), rr = r & 15, cc = c & 31, ob = rr * 64 + cc * 2; return st * 1024 + (ob ^ (((ob >> 9) & 1) << 5)); }
__host__ __device__ __forceinline__ void stage_rc(int b, int& R, int& C) { const int st = b / 1024, sb = b % 1024, swz = sb ^ (((sb >> 9) & 1) << 5); R = (st >> 1) * 16 + swz / 64; C = (st & 1) * 32 + (swz % 64) / 2; }
__host__ __device__ __forceinline__ int perm32(int rho) { const int n = rho >> 4, i = rho & 15; return 8 * (i >> 2) + 4 * n + (i & 3); }

struct Unit { int pm, pn, aux, pad; const char* A; const char* B; };
struct Gemm { int lda, ldb, K; };

struct StaticOrder {
    int nM, nN, nwg, G, c;
    __host__ __device__ void init(int M, int N, int G_, int c_) { nM = M / BM; nN = N / BM; nwg = nM * nN; G = G_; c = c_; }
    __device__ bool next(int i, Unit& u) const {
        const long L = (long)i * G + c; if (L >= nwg) return false;
        int wgid = __builtin_amdgcn_readfirstlane((int)L); { const int q = nwg / NXCD, r = nwg % NXCD, xcd = wgid % NXCD, off = wgid / NXCD; wgid = (xcd < r ? xcd * (q + 1) : r * (q + 1) + (xcd - r) * q) + off; }
        const int nig = WGM * nN, gid = wgid / nig, fm = gid * WGM, gsz = (nM - fm) < WGM ? (nM - fm) : WGM;
        u.pm = __builtin_amdgcn_readfirstlane(fm + ((wgid % nig) % gsz)); u.pn = __builtin_amdgcn_readfirstlane((wgid % nig) / gsz); return true;
    }
};

__device__ __forceinline__ unsigned cvt_pk_bf16(float lo, float hi) { unsigned r; asm volatile("v_cvt_pk_bf16_f32 %0, %1, %2" : "=v"(r) : "v"(lo), "v"(hi)); return r; }

template <class Epi, class Sched, bool ALIGN_EPI>
__device__ __forceinline__ void gemm_phase(PG8_LAS unsigned char* lds, const Gemm g, const Sched& S, const Epi& E) {
    const int tid = otid(), wid = __builtin_amdgcn_readfirstlane(tid >> 6), lane = tid & 63, wr = wid >> 2, wc = wid & 3, fr = lane & 15, fq = lane >> 4;
    const int K = g.K, nt = K / BK;
    unsigned voffA[2], voffB[2];
#pragma unroll
    for (int i = 0; i < 2; ++i) { int R, C; stage_rc(tid * 16 + i * 8192, R, C); const int Rb = Epi::PERM ? ((R & ~31) + perm32(R & 31)) : R;
        voffA[i] = (unsigned)(R * g.lda + C) * 2u; voffB[i] = (unsigned)(Rb * g.ldb + C) * 2u; }
    const size_t kstep = (size_t)(BK * 2);
    const size_t hA = (size_t)HALF * g.lda * 2, hB = (size_t)HALF * g.ldb * 2;
    const unsigned ldsw = (unsigned)wid * 1024u;
    const int aoff = lds_byte(wr * 64 + fr, fq * 8), boff = lds_byte(wc * 32 + fr, fq * 8);
#define PG8_SA(b, h) (((b) * 2 + (h)) * HTB)
#define PG8_SB(b, h) ((4 + (b) * 2 + (h)) * HTB)
#define PG8_STAGE(bufoff, gbase, voff) do { _Pragma("unroll") for (int _i = 0; _i < 2; ++_i) \
        __builtin_amdgcn_global_load_lds((const unsigned*)((const char*)(gbase) + (voff)[_i]), (PG8_LAS unsigned*)(lds + (bufoff) + ldsw + _i * 8192), 16, 0, 0); } while (0)
#define PG8_LDA(dst, b, h) do { _Pragma("unroll") for (int m = 0; m < 4; ++m) _Pragma("unroll") for (int k = 0; k < 2; ++k) dst[m][k] = *(const PG8_LAS bf16x8*)(lds + PG8_SA(b, h) + aoff + m * 2048 + k * 1024); } while (0)
#define PG8_LDB(dst, b, h) do { _Pragma("unroll") for (int n = 0; n < 2; ++n) _Pragma("unroll") for (int k = 0; k < 2; ++k) dst[n][k] = *(const PG8_LAS bf16x8*)(lds + PG8_SB(b, h) + boff + n * 2048 + k * 1024); } while (0)
#define PG8_MMA(ai, bj, At, Bt) do { __builtin_amdgcn_s_setprio(1); _Pragma("unroll") for (int m = 0; m < 4; ++m) _Pragma("unroll") for (int n = 0; n < 2; ++n) _Pragma("unroll") for (int k = 0; k < 2; ++k) \
        acc[ai][bj][m][n] = __builtin_amdgcn_mfma_f32_16x16x32_bf16(Bt[n][k], At[m][k], acc[ai][bj][m][n], 0, 0, 0); __builtin_amdgcn_s_setprio(0); } while (0)
#define PG8_WAIT_V(n) asm volatile("s_waitcnt vmcnt(" #n ")" ::: "memory")
#define PG8_WAIT_L(n) asm volatile("s_waitcnt lgkmcnt(" #n ")" ::: "memory")
#define PG8_BAR __builtin_amdgcn_s_barrier()
#define PG8_SCHED __builtin_amdgcn_sched_barrier(0)
    Unit cur, nxt; int ui = 0;
    if (!S.next(0, cur)) return;
    f32x4 acc[2][2][4][2];
#pragma unroll
    for (int a = 0; a < 2; ++a)
#pragma unroll
        for (int b = 0; b < 2; ++b)
#pragma unroll
            for (int m = 0; m < 4; ++m)
#pragma unroll
                for (int n = 0; n < 2; ++n) acc[a][b][m][n] = (f32x4){0.f, 0.f, 0.f, 0.f};
    bf16x8 At[4][2], B0[2][2], B1[2][2];
    const char* cA = cur.A; const char* cB = cur.B;
    PG8_STAGE(PG8_SB(0, 0), cB, voffB); PG8_STAGE(PG8_SB(0, 1), cB + hB, voffB); PG8_STAGE(PG8_SA(0, 0), cA, voffA); PG8_STAGE(PG8_SA(0, 1), cA + hA, voffA);
    if (wr == 1) PG8_BAR;
    PG8_WAIT_V(2); PG8_BAR;
    PG8_STAGE(PG8_SB(1, 0), cB + kstep, voffB); PG8_STAGE(PG8_SA(1, 0), cA + kstep, voffA); PG8_STAGE(PG8_SB(1, 1), cB + hB + kstep, voffB);
    PG8_WAIT_V(6); PG8_BAR;
    for (;;) {
        const bool has_next = S.next(ui + 1, nxt);
        const char* nA = has_next ? nxt.A : cA; const char* nB = has_next ? nxt.B : cB;
        for (int t = 0; t < nt; t += 2) {
            const bool last = (t == nt - 2);
            const char* a1 = cA + (size_t)(t + 1) * kstep;
            const char* a2 = last ? nA : cA + (size_t)(t + 2) * kstep; const char* b2 = last ? nB : cB + (size_t)(t + 2) * kstep;
            const char* a3 = a2 + kstep; const char* b3 = b2 + kstep;
            PG8_LDB(B0, 0, 0); PG8_LDB(B1, 0, 1); PG8_SCHED; PG8_LDA(At, 0, 0); PG8_STAGE(PG8_SA(1, 1), a1 + hA, voffA);
            PG8_WAIT_V(8); PG8_WAIT_L(0); PG8_BAR; PG8_MMA(0, 0, At, B0); PG8_MMA(0, 1, At, B1); PG8_BAR; PG8_SCHED;
            PG8_LDA(At, 0, 1); PG8_STAGE(PG8_SB(0, 0), b2, voffB); PG8_STAGE(PG8_SB(0, 1), b2 + hB, voffB); PG8_STAGE(PG8_SA(0, 0), a2, voffA);
            PG8_WAIT_V(8); PG8_WAIT_L(0); PG8_BAR; PG8_MMA(1, 0, At, B0); PG8_MMA(1, 1, At, B1); PG8_BAR; PG8_SCHED;
            PG8_LDB(B0, 1, 0); PG8_LDB(B1, 1, 1); PG8_SCHED; PG8_LDA(At, 1, 0); PG8_STAGE(PG8_SA(0, 1), a2 + hA, voffA);
            PG8_WAIT_V(8); PG8_WAIT_L(0); PG8_BAR; PG8_MMA(0, 0, At, B0); PG8_MMA(0, 1, At, B1); PG8_BAR; PG8_SCHED;
            PG8_LDA(At, 1, 1); PG8_STAGE(PG8_SB(1, 0), b3, voffB); PG8_STAGE(PG8_SB(1, 1), b3 + hB, voffB); PG8_STAGE(PG8_SA(1, 0), a3, voffA);
            PG8_WAIT_V(8); PG8_WAIT_L(0); PG8_BAR; PG8_MMA(1, 0, At, B0); PG8_MMA(1, 1, At, B1); PG8_BAR; PG8_SCHED;
        }
        if constexpr (ALIGN_EPI) { if (wr == 0) PG8_BAR; }
        E(acc, cur, wr, wc, fr, fq);
        if (!has_next) break;
#pragma unroll
        for (int a = 0; a < 2; ++a)
#pragma unroll
            for (int b = 0; b < 2; ++b)
#pragma unroll
                for (int m = 0; m < 4; ++m)
#pragma unroll
                    for (int n = 0; n < 2; ++n) acc[a][b][m][n] = (f32x4){0.f, 0.f, 0.f, 0.f};
        cur = nxt; cA = nA; cB = nB; ++ui;
        if constexpr (ALIGN_EPI) { if (wr == 1) PG8_BAR; }
    }
    PG8_WAIT_V(0);
    if constexpr (!ALIGN_EPI) { if (wr == 0) PG8_BAR; }
    PG8_BAR;
#undef PG8_SA
#undef PG8_SB
#undef PG8_STAGE
#undef PG8_LDA
#undef PG8_LDB
#undef PG8_MMA
#undef PG8_WAIT_V
#undef PG8_WAIT_L
#undef PG8_BAR
#undef PG8_SCHED
}
}

typedef unsigned short bf16;
typedef float f32x4 __attribute__((ext_vector_type(4)));
typedef unsigned u32x4 __attribute__((ext_vector_type(4)));
typedef unsigned u32x2 __attribute__((ext_vector_type(2)));
constexpr int NB = 2, SEQ = 4096, DM = 2048, MTOK = NB * SEQ, DIN = 6656, DG = 512, NL = 2;
constexpr int LDS_BYTES = 147456;
constexpr int NTHR = 512;

constexpr int WROWS = 7680;
constexpr size_t WS_WIN = 0;
constexpr size_t WS_WOUT = WS_WIN + (size_t)NL * WROWS * DM * 2;
constexpr size_t WS_WCS = WS_WOUT + (size_t)NL * DM * DM * 2;
constexpr size_t WS_WFXB = WS_WCS + (size_t)NL * 1024 * DG * 2;
constexpr size_t WS_WPW = WS_WFXB + (size_t)NL * DM * DG * 2;
constexpr size_t WS_DC = WS_WPW + (size_t)NL * DG * DG * 2;
constexpr size_t WS_DS = WS_DC + (size_t)2304 * 2048 * 2;
constexpr size_t WS_PQF = WS_DS + (size_t)2048 * 2048 * 2;
constexpr size_t WS_ROPE = WS_PQF + (size_t)NB * DG * 2 * 2048 * 2;
constexpr size_t WS_MOD = WS_ROPE + (size_t)SEQ * 32 * 8;
constexpr size_t WS_U = WS_MOD + 131072;
constexpr size_t WS_PART = WS_U + (size_t)MTOK * DM * 2;
constexpr size_t WS_Z = WS_U + (size_t)4 * MTOK * DG * 4;
constexpr size_t WS_PQT = WS_Z + (size_t)MTOK * DIN * 2;
constexpr size_t WS_CVH = WS_PQT + (size_t)NB * DG * 2 * SEQ * 2;
constexpr size_t WS_CAT = WS_CVH + (size_t)MTOK * DG * 2;
constexpr size_t WS_KV = WS_CAT + (size_t)MTOK * DM * 2;
constexpr size_t WS_BAR = WS_KV + (size_t)2 * NB * 8 * 32 * 4096 * 4;
constexpr size_t WS_END = WS_BAR + 16384;

struct Params {
    const float* x; const float* c; const float* norm_g; const float* w_ada; const float* b_ada; const float* w_in; const float* w_fft; const float* na_bias;
    const float* rl_f; const float* rl_b; const float* conv_w; const float* conv_b; const float* ln_g; const float* ln_b; const float* w_pw; const float* w_out; const float* final_g;
    float* out; unsigned char* ws; int ph_lo, ph_hi;
};

#if defined(__HIP_DEVICE_COMPILE__)
typedef const __attribute__((address_space(4))) Params* KParams;
__device__ __forceinline__ KParams kparams() { KParams k = (KParams)__builtin_amdgcn_kernarg_segment_ptr(); asm volatile("" : "+s"(k)); return k; }
#else
typedef const Params* KParams;
__device__ __forceinline__ KParams kparams() { return nullptr; }
#endif
__device__ __forceinline__ unsigned f2bf(float f) { unsigned u = __float_as_uint(f); return (u + 0x7fffu + ((u >> 16) & 1u)) >> 16; }
__device__ __forceinline__ unsigned pk2(float lo, float hi) { return f2bf(lo) | (f2bf(hi) << 16); }
__device__ __forceinline__ float bf2f(bf16 b) { return __uint_as_float((unsigned)b << 16); }
__device__ __forceinline__ float bflo(unsigned u) { return __uint_as_float(u << 16); }
__device__ __forceinline__ float bfhi(unsigned u) { return __uint_as_float(u & 0xffff0000u); }
__device__ __forceinline__ float silu_f(float v) { return v / (1.f + __expf(-v)); }
__device__ __forceinline__ float wave_sum(float v) {
#pragma unroll
    for (int o = 1; o < 64; o <<= 1) v += __shfl_xor(v, o);
    return v;
}
__device__ __forceinline__ float wave_max(float v) {
#pragma unroll
    for (int o = 1; o < 64; o <<= 1) v = fmaxf(v, __shfl_xor(v, o));
    return v;
}

struct SchedS {
    pg8::StaticOrder o; const char* A; const char* B; size_t ta, tb;
    __device__ __forceinline__ bool next(int i, pg8::Unit& u) const { if (!o.next(i, u)) return false; u.A = A + (size_t)u.pm * ta; u.B = B + (size_t)u.pn * tb; u.aux = 0; return true; }
};
__device__ __forceinline__ SchedS make_sched(const void* A, int lda, const void* B, int ldb, int M, int N, int shift = 0) {
    SchedS s; s.o.init(M, N, (int)gridDim.x, (int)((obid() + gridDim.x - shift) % gridDim.x)); s.A = (const char*)A; s.B = (const char*)B; s.ta = (size_t)256 * lda * 2; s.tb = (size_t)256 * ldb * 2; return s;
}
struct SchedZ {
    pg8::StaticOrder o; const char* A; const char* B; int late;
    __device__ __forceinline__ bool next(int i, pg8::Unit& u) const { if (!o.next(i, u)) return false; const int jn = u.pn;
        u.pn = late ? (jn < 2 ? 2 + jn : 22 + jn) : (jn < 20 ? jn + 4 : jn + 6);
        u.A = A + (size_t)u.pm * (256 * DM * 2); u.B = B + (size_t)u.pn * (256 * DM * 2); u.aux = 0; return true; }
};
struct SchedDFT {
    const char* DC; const char* PQF; int G, c;
    __device__ __forceinline__ bool next(int i, pg8::Unit& u) const {
        if (c < 0) return false;
        const int L = __builtin_amdgcn_readfirstlane(i * G + c); if (L >= 64) return false;
        const int b = L >> 5, t = L & 31, odd = t >> 4, tt = t & 15; u.pm = tt >> 1; u.pn = tt & 1; u.aux = b * 2 + odd;
        u.A = DC + (size_t)odd * (WS_DS - WS_DC) + (size_t)u.pm * (256 * 2048 * 2);
        u.B = PQF + ((size_t)(b * 512 + u.pn * 256) * 4096 + odd * 2048) * 2; return true;
    }
};

struct EpiZ {
    static constexpr bool PERM = true;
    bf16* O; int ldc;
    __device__ __forceinline__ void operator()(const pg8::f32x4 (&acc)[2][2][4][2], const pg8::Unit& u, int wr, int wc, int fr, int fq) const {
        const int row0 = u.pm * 256 + wr * 64 + fr, col0 = u.pn * 256 + wc * 32 + 8 * fq;
#pragma unroll
        for (int ai = 0; ai < 2; ++ai)
#pragma unroll
            for (int m = 0; m < 4; ++m) { bf16* rowp = O + (size_t)(row0 + ai * 128 + m * 16) * ldc + col0;
#pragma unroll
                for (int bj = 0; bj < 2; ++bj) { const pg8::f32x4 v0 = acc[ai][bj][m][0], v1 = acc[ai][bj][m][1]; u32x4 w;
                    w.x = pg8::cvt_pk_bf16(v0[0], v0[1]); w.y = pg8::cvt_pk_bf16(v0[2], v0[3]); w.z = pg8::cvt_pk_bf16(v1[0], v1[1]); w.w = pg8::cvt_pk_bf16(v1[2], v1[3]);
                    *(u32x4*)(rowp + bj * 128) = w; } }
    }
};
struct EpiZ2 {
    static constexpr bool PERM = true;
    bf16* O; bf16* PQ;
    __device__ __forceinline__ void operator()(const pg8::f32x4 (&acc)[2][2][4][2], const pg8::Unit& u, int wr, int wc, int fr, int fq) const {
        const int row0 = u.pm * 256 + wr * 64 + fr;
        if (u.pn < 26) { const int col0 = u.pn * 256 + wc * 32 + 8 * fq;
#pragma unroll
            for (int ai = 0; ai < 2; ++ai)
#pragma unroll
                for (int m = 0; m < 4; ++m) { bf16* rowp = O + (size_t)(row0 + ai * 128 + m * 16) * DIN + col0;
#pragma unroll
                    for (int bj = 0; bj < 2; ++bj) { const pg8::f32x4 v0 = acc[ai][bj][m][0], v1 = acc[ai][bj][m][1]; u32x4 w;
                        w.x = pg8::cvt_pk_bf16(v0[0], v0[1]); w.y = pg8::cvt_pk_bf16(v0[2], v0[3]); w.z = pg8::cvt_pk_bf16(v1[0], v1[1]); w.w = pg8::cvt_pk_bf16(v1[2], v1[3]);
                        *(u32x4*)(rowp + bj * 128) = w; } }
        } else { const int np0 = (u.pn - 26) * 256 + wc * 32 + 8 * fq;
#pragma unroll
            for (int bj = 0; bj < 2; ++bj) { const int np = np0 + bj * 128, pq = np >> 9, n = np & 511;
#pragma unroll
                for (int ai = 0; ai < 2; ++ai)
#pragma unroll
                    for (int m = 0; m < 4; ++m) { const int row = row0 + ai * 128 + m * 16, b = row >> 12, sq = row & 4095;
                        bf16* dst = PQ + ((size_t)(b * 512 + n) * 2 + pq) * 4096 + sq;
#pragma unroll
                        for (int nn = 0; nn < 2; ++nn)
#pragma unroll
                            for (int j = 0; j < 4; ++j) dst[(size_t)(4 * nn + j) * 8192] = (bf16)f2bf(acc[ai][bj][m][nn][j]); } }
        }
    }
};
struct EpiGate {
    static constexpr bool PERM = true;
    bf16* O; const bf16* Z; int coff, goff;
    __device__ __forceinline__ void operator()(const pg8::f32x4 (&acc)[2][2][4][2], const pg8::Unit& u, int wr, int wc, int fr, int fq) const {
        const int row0 = u.pm * 256 + wr * 64 + fr, col0 = u.pn * 256 + wc * 32 + 8 * fq;
#pragma unroll
        for (int ai = 0; ai < 2; ++ai)
#pragma unroll
            for (int m = 0; m < 4; ++m) { const size_t row = (size_t)(row0 + ai * 128 + m * 16);
#pragma unroll
                for (int bj = 0; bj < 2; ++bj) { const pg8::f32x4 v0 = acc[ai][bj][m][0], v1 = acc[ai][bj][m][1];
                    const u32x4 gz = *(const u32x4*)(Z + row * DIN + goff + col0 + bj * 128); u32x4 w;
                    w.x = pg8::cvt_pk_bf16(v0[0] * silu_f(bflo(gz.x)), v0[1] * silu_f(bfhi(gz.x))); w.y = pg8::cvt_pk_bf16(v0[2] * silu_f(bflo(gz.y)), v0[3] * silu_f(bfhi(gz.y)));
                    w.z = pg8::cvt_pk_bf16(v1[0] * silu_f(bflo(gz.z)), v1[1] * silu_f(bfhi(gz.z))); w.w = pg8::cvt_pk_bf16(v1[2] * silu_f(bflo(gz.w)), v1[3] * silu_f(bfhi(gz.w)));
                    *(u32x4*)(O + row * DM + coff + col0 + bj * 128) = w; } }
    }
};
struct EpiPart {
    static constexpr bool PERM = false;
    float* P;
    __device__ __forceinline__ void operator()(const pg8::f32x4 (&acc)[2][2][4][2], const pg8::Unit& u, int wr, int wc, int fr, int fq) const {
        const int row0 = u.pm * 256 + wr * 64 + fr, col0 = u.pn * 256 + wc * 32 + 4 * fq;
        float* base = (u.aux & 1) ? P + (size_t)2 * 2304 * 512 + (size_t)(u.aux >> 1) * 2048 * 512 : P + (size_t)(u.aux >> 1) * 2304 * 512;
#pragma unroll
        for (int ai = 0; ai < 2; ++ai)
#pragma unroll
            for (int m = 0; m < 4; ++m) { float* rowp = base + (size_t)(row0 + ai * 128 + m * 16) * 512 + col0;
#pragma unroll
                for (int bj = 0; bj < 2; ++bj)
#pragma unroll
                    for (int n = 0; n < 2; ++n) *(pg8::f32x4*)(rowp + bj * 128 + n * 16) = acc[ai][bj][m][n]; }
    }
};
struct EpiRes {
    static constexpr bool PERM = false;
    const float* xin; float* xout; const float* gate;
    __device__ __forceinline__ void operator()(const pg8::f32x4 (&acc)[2][2][4][2], const pg8::Unit& u, int wr, int wc, int fr, int fq) const {
        const int row0 = u.pm * 256 + wr * 64 + fr, col0 = u.pn * 256 + wc * 32 + 4 * fq;
        const float* gp = gate + (size_t)(u.pm >> 4) * 6144 + col0;
        pg8::f32x4 gv[2][2];
#pragma unroll
        for (int bj = 0; bj < 2; ++bj)
#pragma unroll
            for (int n = 0; n < 2; ++n) gv[bj][n] = *(const pg8::f32x4*)(gp + bj * 128 + n * 16);
#pragma unroll
        for (int ai = 0; ai < 2; ++ai)
#pragma unroll
            for (int m = 0; m < 4; ++m) { const size_t ro = (size_t)(row0 + ai * 128 + m * 16) * DM + col0;
#pragma unroll
                for (int bj = 0; bj < 2; ++bj)
#pragma unroll
                    for (int n = 0; n < 2; ++n) { const pg8::f32x4 xi = *(const pg8::f32x4*)(xin + ro + bj * 128 + n * 16);
                        *(pg8::f32x4*)(xout + ro + bj * 128 + n * 16) = xi + gv[bj][n] * acc[ai][bj][m][n]; } }
    }
};

struct TPItem { const float* src; bf16* dst; int N, K; };
__device__ __forceinline__ TPItem tp_decode(const Params& p, int it, int tid) {
    constexpr int T_IN = 32 * 96, T_OUT = 32 * 32, T_S = 64, T_L = T_IN + T_OUT + T_S;
    const int l = it / T_L; int r = it % T_L; const float* W; bf16* WT; int K, N, kb, nb;
    if (r < T_IN) { W = p.w_in + (size_t)l * DM * DIN; WT = (bf16*)(p.ws + WS_WIN) + (size_t)l * WROWS * DM; K = DM; N = DIN; kb = r / 96; nb = 8 + r % 96; }
    else if (r < T_IN + T_OUT) { r -= T_IN; W = p.w_out + (size_t)l * DM * DM; WT = (bf16*)(p.ws + WS_WOUT) + (size_t)l * DM * DM; K = DM; N = DM; kb = r >> 5; nb = r & 31; }
    else { r -= T_IN + T_OUT; W = p.w_pw + (size_t)l * DG * DG; WT = (bf16*)(p.ws + WS_WPW) + (size_t)l * DG * DG; K = DG; N = DG; kb = r >> 3; nb = r & 7; }
    TPItem t; t.N = N; t.K = K;
    t.src = W + (size_t)(kb * 64 + (tid >> 4)) * N + nb * 64 + (tid & 15) * 4;
    t.dst = WT + (size_t)(nb * 64 + (tid >> 3)) * K + kb * 64 + (tid & 7) * 8;
    return t;
}
__device__ __forceinline__ void tp_store(const TPItem& t, int tid, const f32x4& v0, const f32x4& v1, float* scr) {
    { const int kk = tid >> 4, nn = (tid & 15) * 4;
      scr[kk * 65 + nn] = v0[0]; scr[kk * 65 + nn + 1] = v0[1]; scr[kk * 65 + nn + 2] = v0[2]; scr[kk * 65 + nn + 3] = v0[3];
      scr[(kk + 32) * 65 + nn] = v1[0]; scr[(kk + 32) * 65 + nn + 1] = v1[1]; scr[(kk + 32) * 65 + nn + 2] = v1[2]; scr[(kk + 32) * 65 + nn + 3] = v1[3]; }
    __syncthreads();
    { const int n = tid >> 3, kc = (tid & 7) * 8; const float* s = scr + kc * 65 + n; u32x4 o;
      o.x = pk2(s[0], s[65]); o.y = pk2(s[2 * 65], s[3 * 65]); o.z = pk2(s[4 * 65], s[5 * 65]); o.w = pk2(s[6 * 65], s[7 * 65]);
      *(u32x4*)t.dst = o; }
    __syncthreads();
}

__device__ __forceinline__ void ph_prologue(const Params& p_, unsigned char* lds) {
    const Params p = *kparams(); (void)p_;
    const int tid = otid(), lane = tid & 63, wave = tid >> 6, G = gridDim.x, bid = obid();
    float* scr = (float*)lds;
    { constexpr int T_TOT = NL * (32 * 96 + 32 * 32 + 64);
      int it = bid; TPItem cur; f32x4 a0, a1;
      if (it < T_TOT) { cur = tp_decode(p, it, tid); a0 = __builtin_nontemporal_load((const f32x4*)cur.src); a1 = __builtin_nontemporal_load((const f32x4*)(cur.src + (size_t)32 * cur.N)); }
      while (it < T_TOT) { const int nit = it + G; TPItem nxt = cur; f32x4 b0 = a0, b1 = a1;
          if (nit < T_TOT) { nxt = tp_decode(p, nit, tid); b0 = __builtin_nontemporal_load((const f32x4*)nxt.src); b1 = __builtin_nontemporal_load((const f32x4*)(nxt.src + (size_t)32 * nxt.N)); }
          tp_store(cur, tid, a0, a1, scr);
          cur = nxt; a0 = b0; a1 = b1; it = nit; } }
    { bf16* Wfx = (bf16*)(p.ws + WS_WFXB);
      for (int e = bid * NTHR + tid; e < NL * DM * DG / 8; e += G * NTHR) { const int l = e >> 17, r = e & 131071, k = r >> 6, c8 = (r & 63) * 8;
          const float* src = p.w_in + ((size_t)l * DM + k) * DIN + c8; const f32x4 a = *(const f32x4*)src, b4 = *(const f32x4*)(src + 4);
          u32x4 o; o.x = pk2(a[0], a[1]); o.y = pk2(a[2], a[3]); o.z = pk2(b4[0], b4[1]); o.w = pk2(b4[2], b4[3]);
          *(u32x4*)(Wfx + ((size_t)l * DM + k) * DG + c8) = o; } }
    { float* Wl = (float*)lds; float* tr = Wl + 128 * 65; bf16* Wcs = (bf16*)(p.ws + WS_WCS);
      for (int t2 = G - 1 - bid; t2 < 256; t2 += G) {
          const int t = t2 >> 1, ch = t2 & 1, l = t >> 6, pq = (t >> 5) & 1, g = (t >> 3) & 3, n0 = (t & 7) * 64;
#pragma unroll
          for (int i = 0; i < 4; ++i) { const int m = (tid >> 4) + 32 * i, nn = (tid & 15) * 4;
              const f32x4 v = *(const f32x4*)(p.w_fft + ((size_t)l * DG + g * 128 + m) * DG + n0 + nn);
              Wl[m * 65 + nn] = v[0]; Wl[m * 65 + nn + 1] = v[1]; Wl[m * 65 + nn + 2] = v[2]; Wl[m * 65 + nn + 3] = v[3]; }
          if (tid < 128) tr[tid] = pq ? sinpif((float)tid * (1.f / 64.f)) : cospif((float)tid * (1.f / 64.f));
          __syncthreads();
          const int nn = tid >> 3, cc = ch * 64 + (tid & 7) * 8; float acc[8];
#pragma unroll
          for (int i = 0; i < 8; ++i) acc[i] = 0.f;
#pragma unroll 4
          for (int m = 0; m < 128; ++m) { const float w = Wl[m * 65 + nn];
#pragma unroll
              for (int i = 0; i < 8; ++i) acc[i] += tr[((cc + i) * m) & 127] * w; }
          const float nrm = 0.0013810679320049757f;
          u32x4 o0;
          o0.x = pk2(acc[0] * nrm, acc[1] * nrm); o0.y = pk2(acc[2] * nrm, acc[3] * nrm); o0.z = pk2(acc[4] * nrm, acc[5] * nrm); o0.w = pk2(acc[6] * nrm, acc[7] * nrm);
          *(u32x4*)(Wcs + ((size_t)l * 1024 + pq * 512 + n0 + nn) * DG + g * 128 + cc) = o0;
          __syncthreads();
      } }
    __syncthreads();
    float* cosT = (float*)(lds + 32768); float* sinT = (float*)(lds + 49152); float* ca = (float*)(lds + 65536); float* red = (float*)(lds + 81920);
    for (int j = tid; j < 4096; j += NTHR) { cosT[j] = cospif((float)j * (1.f / 2048.f)); sinT[j] = sinpif((float)j * (1.f / 2048.f)); }
    for (int j = tid; j < 4096; j += NTHR) { const float cv = p.c[j]; ca[j] = cv / (1.f + expf(-cv)); }
    __syncthreads();
    { bf16* DC = (bf16*)(p.ws + WS_DC); bf16* DSm = (bf16*)(p.ws + WS_DS);
      for (int r = bid * 2 + (tid >> 8); r < 4352; r += G * 2) { const int is_sin = (r >= 2304) ? 1 : 0, k = is_sin ? r - 2304 : r, s0 = (tid & 255) * 8; float v[8];
#pragma unroll
          for (int j = 0; j < 8; ++j) { const int idx = (k * (s0 + j)) & 4095; v[j] = is_sin ? sinT[idx] : cosT[idx]; }
          u32x4 o; o.x = pk2(v[0], v[1]); o.y = pk2(v[2], v[3]); o.z = pk2(v[4], v[5]); o.w = pk2(v[6], v[7]);
          *(u32x4*)((is_sin ? DSm : DC) + (size_t)k * 2048 + s0) = o; } }
    { float2* rope = (float2*)(p.ws + WS_ROPE);
      for (int e = bid * NTHR + tid; e < 4096 * 32; e += G * NTHR) { const int s = e >> 5, i = e & 31;
          const float inv = (float)pow(10000.0, -(double)i / 32.0); const float ang = (float)s * inv;
          double sn, cs; sincos((double)ang, &sn, &cs); rope[e] = make_float2((float)cs, (float)sn); } }
    float* mod = (float*)(p.ws + WS_MOD);
    for (int t = bid; t < 192; t += G) {
        const int l = t / 96, col = (t % 96) * 64 + lane; const float* W = p.w_ada + (size_t)l * DM * 6144 + col;
        float a0 = 0.f, a1 = 0.f;
        for (int k0 = wave * 256; k0 < wave * 256 + 256; k0 += 32) { float wv[32];
#pragma unroll
            for (int j = 0; j < 32; ++j) wv[j] = __builtin_nontemporal_load(W + (size_t)(k0 + j) * 6144);
            asm volatile("" ::: "memory");
#pragma unroll
            for (int j = 0; j < 32; ++j) { a0 += ca[k0 + j] * wv[j]; a1 += ca[2048 + k0 + j] * wv[j]; } }
        red[(wave * 2 + 0) * 64 + lane] = a0; red[(wave * 2 + 1) * 64 + lane] = a1;
        __syncthreads();
        if (wave < 2) { float s = 0.f;
#pragma unroll
            for (int w = 0; w < 8; ++w) s += red[(w * 2 + wave) * 64 + lane];
            mod[(size_t)(l * 2 + wave) * 6144 + col] = s + p.b_ada[l * 6144 + col]; }
        __syncthreads();
    }
}

__device__ __forceinline__ void ph_norm(const Params& p_, int l) {
    const Params p = *kparams(); (void)p_;
    const int tid = otid(), lane = tid & 63, wave = tid >> 6;
    const float* xin = (l == 0) ? p.x : p.out; bf16* h = (bf16*)(p.ws + WS_U); const float* mod = (const float*)(p.ws + WS_MOD);
    const int stride = gridDim.x * 8; const float* g = p.norm_g + l * DM;
    if (stride == 2048) {
        for (int row = obid() * 8 + wave; row < MTOK; row += 2 * stride) {
            const f32x4* xr0 = (const f32x4*)(xin + (size_t)row * DM) + lane; const f32x4* xr1 = (const f32x4*)(xin + (size_t)(row + stride) * DM) + lane;
            const float* md = mod + (size_t)(l * 2 + (row >> 12)) * 6144;
            f32x4 v0[8], v1[8], ca[8], cb[8];
#pragma unroll
            for (int j = 0; j < 8; ++j) { v0[j] = xr0[64 * j]; v1[j] = xr1[64 * j]; }
#pragma unroll
            for (int j = 0; j < 8; ++j) { const int col = (64 * j + lane) * 4; ca[j] = *(const f32x4*)(g + col) * (*(const f32x4*)(md + 2048 + col) + 1.f); cb[j] = *(const f32x4*)(md + col); }
            asm volatile("" ::: "memory");
            float s0 = 0.f, s1 = 0.f;
#pragma unroll
            for (int j = 0; j < 8; ++j) { s0 += (v0[j][0] * v0[j][0] + v0[j][1] * v0[j][1]) + (v0[j][2] * v0[j][2] + v0[j][3] * v0[j][3]); s1 += (v1[j][0] * v1[j][0] + v1[j][1] * v1[j][1]) + (v1[j][2] * v1[j][2] + v1[j][3] * v1[j][3]); }
            s0 = wave_sum(s0); s1 = wave_sum(s1);
            const float r0 = rsqrtf(s0 * (1.f / DM) + 1e-6f), r1 = rsqrtf(s1 * (1.f / DM) + 1e-6f);
#pragma unroll
            for (int j = 0; j < 8; ++j) { const int col = (64 * j + lane) * 4;
                const f32x4 o0 = (v0[j] * r0) * ca[j] + cb[j], o1 = (v1[j] * r1) * ca[j] + cb[j]; u32x2 w;
                w.x = pk2(o0[0], o0[1]); w.y = pk2(o0[2], o0[3]); *(u32x2*)(h + (size_t)row * DM + col) = w;
                w.x = pk2(o1[0], o1[1]); w.y = pk2(o1[2], o1[3]); *(u32x2*)(h + (size_t)(row + stride) * DM + col) = w; }
        }
        return;
    }
    for (int row = obid() * 8 + wave; row < MTOK; row += stride) {
        const f32x4* xr = (const f32x4*)(xin + (size_t)row * DM) + lane; f32x4 v[8]; float ss = 0.f;
#pragma unroll
        for (int j = 0; j < 8; ++j) { v[j] = xr[64 * j]; ss += (v[j][0] * v[j][0] + v[j][1] * v[j][1]) + (v[j][2] * v[j][2] + v[j][3] * v[j][3]); }
        ss = wave_sum(ss); const float rstd = rsqrtf(ss * (1.f / DM) + 1e-6f);
        const float* md = mod + (size_t)(l * 2 + (row >> 12)) * 6144;
#pragma unroll
        for (int j = 0; j < 8; ++j) { const int col = (64 * j + lane) * 4;
            const f32x4 g4 = *(const f32x4*)(g + col), sh = *(const f32x4*)(md + col), sc = *(const f32x4*)(md + 2048 + col);
            const f32x4 o = (v[j] * rstd * g4) * (sc + 1.f) + sh; u32x2 w; w.x = pk2(o[0], o[1]); w.y = pk2(o[2], o[3]);
            *(u32x2*)(h + (size_t)row * DM + col) = w; }
    }
}
__device__ __forceinline__ void ph_final(const Params& p_) {
    const Params p = *kparams(); (void)p_;
    const int tid = otid(), lane = tid & 63, wave = tid >> 6;
    const int stride = gridDim.x * 8;
    for (int row = obid() * 8 + wave; row < MTOK; row += 2 * stride) {
        const bool two = (row + stride < MTOK);
        f32x4* xr0 = (f32x4*)(p.out + (size_t)row * DM) + lane; f32x4* xr1 = (f32x4*)(p.out + (size_t)(two ? row + stride : row) * DM) + lane;
        f32x4 v0[8], v1[8], g4[8];
#pragma unroll
        for (int j = 0; j < 8; ++j) { v0[j] = xr0[64 * j]; v1[j] = xr1[64 * j]; g4[j] = *(const f32x4*)(p.final_g + (64 * j + lane) * 4); }
        asm volatile("" ::: "memory");
        float s0 = 0.f, s1 = 0.f;
#pragma unroll
        for (int j = 0; j < 8; ++j) { s0 += (v0[j][0] * v0[j][0] + v0[j][1] * v0[j][1]) + (v0[j][2] * v0[j][2] + v0[j][3] * v0[j][3]); s1 += (v1[j][0] * v1[j][0] + v1[j][1] * v1[j][1]) + (v1[j][2] * v1[j][2] + v1[j][3] * v1[j][3]); }
        s0 = wave_sum(s0); s1 = wave_sum(s1);
        const float r0 = rsqrtf(s0 * (1.f / DM) + 1e-6f), r1 = rsqrtf(s1 * (1.f / DM) + 1e-6f);
#pragma unroll
        for (int j = 0; j < 8; ++j) { xr0[64 * j] = v0[j] * r0 * g4[j]; if (two) xr1[64 * j] = v1[j] * r1 * g4[j]; }
    }
}

#ifndef REP_PRO
#define REP_PRO 1
#endif
#ifndef REP_NORM
#define REP_NORM 1
#endif
#ifndef REP_Z
#define REP_Z 1
#endif
#ifndef REP_MIX
#define REP_MIX 1
#endif
#ifndef REP_P3
#define REP_P3 1
#endif
#ifndef REP_R2
#define REP_R2 1
#endif
#ifndef REP_CMB
#define REP_CMB 1
#endif
#ifndef REP_FFT
#define REP_FFT 1
#endif
#ifndef REP_OUT
#define REP_OUT 1
#endif
#ifndef REP_SUB
#define REP_SUB 1
#endif

#ifndef REP_R1
#define REP_R1 1
#endif
#ifndef REP_NA
#define REP_NA 1
#endif
#ifndef REP_CV
#define REP_CV 1
#endif
#ifndef REP_F1
#define REP_F1 1
#endif
#define REPEAT(n) for (int rep_ = 0; rep_ < (n); ++rep_)
typedef short bf16x8v __attribute__((ext_vector_type(8)));
__device__ __forceinline__ bf16x8v mk8(unsigned a, unsigned b, unsigned c, unsigned d) { u32x4 v = {a, b, c, d}; return __builtin_bit_cast(bf16x8v, v); }
#define MFMA16(a, b, c) __builtin_amdgcn_mfma_f32_16x16x32_bf16(a, b, c, 0, 0, 0)
constexpr int R_QS = 0, R_KS = 18432, R_VT = 36864, R_KTF = 54272, R_KTB = 71680, R_STF = 89088, R_STB = 98304;

template <bool R2>
__device__ __forceinline__ void ret_stage(const Params& p_, int b, int h, int n, unsigned char* lds, float l2f, float l2b) {
    const Params p = *kparams(); (void)p_;
    const int tid = otid(), j = tid >> 2, c4 = tid & 3, s = n * 128 + j;
    const bf16* Z = (const bf16*)(p.ws + WS_Z); const bf16* zr = Z + (size_t)(b * SEQ + s) * DIN;
    const f32x4* rp = (const f32x4*)((const float2*)(p.ws + WS_ROPE) + s * 32 + c4 * 8);
    f32x4 rr[4];
#pragma unroll
    for (int i = 0; i < 4; ++i) rr[i] = rp[i];
    const u32x4 ka = *(const u32x4*)(zr + 7 * DG + h * 64 + c4 * 8), kb = *(const u32x4*)(zr + 7 * DG + h * 64 + 32 + c4 * 8);
    const u32x4 va = *(const u32x4*)(zr + 8 * DG + h * 64 + c4 * 16), vb = *(const u32x4*)(zr + 8 * DG + h * 64 + c4 * 16 + 8);
    u32x4 qa = ka, qb = kb;
    if (R2) { qa = *(const u32x4*)(zr + 6 * DG + h * 64 + c4 * 8); qb = *(const u32x4*)(zr + 6 * DG + h * 64 + 32 + c4 * 8); }
    asm volatile("" ::: "memory");
    float cs[8], sn[8];
#pragma unroll
    for (int i = 0; i < 4; ++i) { const f32x4 r = rr[i]; cs[2 * i] = r[0]; sn[2 * i] = r[1]; cs[2 * i + 1] = r[2]; sn[2 * i + 1] = r[3]; }
    bf16* KS = (bf16*)(lds + R_KS); bf16* VT = (bf16*)(lds + R_VT);
    {
      const unsigned kau[4] = {ka.x, ka.y, ka.z, ka.w}, kbu[4] = {kb.x, kb.y, kb.z, kb.w};
      float k1[8], k2[8];
#pragma unroll
      for (int i = 0; i < 4; ++i) { const float a0 = bflo(kau[i]), a1 = bfhi(kau[i]), b0 = bflo(kbu[i]), b1 = bfhi(kbu[i]);
          k1[2 * i] = a0 * cs[2 * i] - b0 * sn[2 * i]; k2[2 * i] = a0 * sn[2 * i] + b0 * cs[2 * i];
          k1[2 * i + 1] = a1 * cs[2 * i + 1] - b1 * sn[2 * i + 1]; k2[2 * i + 1] = a1 * sn[2 * i + 1] + b1 * cs[2 * i + 1]; }
      u32x4 o1, o2; o1.x = pk2(k1[0], k1[1]); o1.y = pk2(k1[2], k1[3]); o1.z = pk2(k1[4], k1[5]); o1.w = pk2(k1[6], k1[7]);
      o2.x = pk2(k2[0], k2[1]); o2.y = pk2(k2[2], k2[3]); o2.z = pk2(k2[4], k2[5]); o2.w = pk2(k2[6], k2[7]);
      *(u32x4*)(KS + j * 72 + c4 * 8) = o1; *(u32x4*)(KS + j * 72 + 32 + c4 * 8) = o2;
      if (!R2) { bf16* KTF = (bf16*)(lds + R_KTF); bf16* KTB = (bf16*)(lds + R_KTB);
          const float df = exp2f(l2f * (float)(127 - j)), db = exp2f(l2b * (float)j);
#pragma unroll
          for (int i = 0; i < 8; ++i) { KTF[(c4 * 8 + i) * 136 + j] = (bf16)f2bf(k1[i] * df); KTF[(32 + c4 * 8 + i) * 136 + j] = (bf16)f2bf(k2[i] * df);
              KTB[(c4 * 8 + i) * 136 + j] = (bf16)f2bf(k1[i] * db); KTB[(32 + c4 * 8 + i) * 136 + j] = (bf16)f2bf(k2[i] * db); } } }
    {
      const unsigned vu[8] = {va.x, va.y, va.z, va.w, vb.x, vb.y, vb.z, vb.w};
#pragma unroll
      for (int i = 0; i < 8; ++i) { VT[(c4 * 16 + 2 * i) * 136 + j] = (bf16)(vu[i] & 0xffffu); VT[(c4 * 16 + 2 * i + 1) * 136 + j] = (bf16)(vu[i] >> 16); } }
    if (R2) { bf16* QS = (bf16*)(lds + R_QS);
      const unsigned qau[4] = {qa.x, qa.y, qa.z, qa.w}, qbu[4] = {qb.x, qb.y, qb.z, qb.w};
      float q1[8], q2[8];
#pragma unroll
      for (int i = 0; i < 4; ++i) { const float a0 = bflo(qau[i]), a1 = bfhi(qau[i]), b0 = bflo(qbu[i]), b1 = bfhi(qbu[i]);
          q1[2 * i] = (a0 * cs[2 * i] - b0 * sn[2 * i]) * 0.125f; q2[2 * i] = (a0 * sn[2 * i] + b0 * cs[2 * i]) * 0.125f;
          q1[2 * i + 1] = (a1 * cs[2 * i + 1] - b1 * sn[2 * i + 1]) * 0.125f; q2[2 * i + 1] = (a1 * sn[2 * i + 1] + b1 * cs[2 * i + 1]) * 0.125f; }
      u32x4 o1, o2; o1.x = pk2(q1[0], q1[1]); o1.y = pk2(q1[2], q1[3]); o1.z = pk2(q1[4], q1[5]); o1.w = pk2(q1[6], q1[7]);
      o2.x = pk2(q2[0], q2[1]); o2.y = pk2(q2[2], q2[3]); o2.z = pk2(q2[4], q2[5]); o2.w = pk2(q2[6], q2[7]);
      *(u32x4*)(QS + j * 72 + c4 * 8) = o1; *(u32x4*)(QS + j * 72 + 32 + c4 * 8) = o2; }
}

__device__ __forceinline__ void ret1_task(const Params& p_, int l, int task, unsigned char* lds) {
    const Params p = *kparams(); (void)p_;
    const int n = task & 31, h = (task >> 5) & 7, b = task >> 8;
    const float xf = p.rl_f[l * 8 + h], xb = p.rl_b[l * 8 + h];
    const float l2f = -log1pf(expf(-xf)) * 1.4426950408889634f, l2b = -log1pf(expf(-xb)) * 1.4426950408889634f;
    ret_stage<false>(p, b, h, n, lds, l2f, l2b);
    __syncthreads();
    const int tid = otid(), lane = tid & 63, w = tid >> 6, fr = lane & 15, fq = lane >> 4, dir = w >> 2, et = w & 3;
    const bf16* VT = (const bf16*)(lds + R_VT); const bf16* KT = (const bf16*)(lds + (dir ? R_KTB : R_KTF));
    bf16x8v a[4];
#pragma unroll
    for (int ks = 0; ks < 4; ++ks) a[ks] = *(const bf16x8v*)(VT + (16 * et + fr) * 136 + 32 * ks + 8 * fq);
    float* dst = (float*)(p.ws + WS_KV) + ((size_t)((dir * 2 + b) * 8 + h) * 32 + n) * 4096;
#pragma unroll
    for (int dt = 0; dt < 4; ++dt) { f32x4 acc = {0.f, 0.f, 0.f, 0.f};
#pragma unroll
        for (int ks = 0; ks < 4; ++ks) { const bf16x8v bfr = *(const bf16x8v*)(KT + (16 * dt + fr) * 136 + 32 * ks + 8 * fq); acc = MFMA16(a[ks], bfr, acc); }
#pragma unroll
        for (int r = 0; r < 4; ++r) dst[(16 * et + 4 * fq + r) * 64 + 16 * dt + fr] = acc[r]; }
    __syncthreads();
}

__device__ __forceinline__ void ret2_task(const Params& p_, int l, int task, unsigned char* lds) {
    const Params p = *kparams(); (void)p_;
    const int n = task & 31, h = (task >> 5) & 7, b = task >> 8;
    const float xf = p.rl_f[l * 8 + h], xb = p.rl_b[l * 8 + h];
    const float l2f = -log1pf(expf(-xf)) * 1.4426950408889634f, l2b = -log1pf(expf(-xb)) * 1.4426950408889634f;
    ret_stage<true>(p, b, h, n, lds, l2f, l2b);
    const int tid = otid(), lane = tid & 63, w = tid >> 6, fr = lane & 15, fq = lane >> 4;
    {
      const float gfC = exp2f(l2f * 128.f), gbC = exp2f(l2b * 128.f);
      const float* KVf = (const float*)(p.ws + WS_KV) + ((size_t)((0 * 2 + b) * 8 + h) * 32) * 4096 + tid * 8;
      const float* KVb = (const float*)(p.ws + WS_KV) + ((size_t)((1 * 2 + b) * 8 + h) * 32) * 4096 + tid * 8;
      f32x4 f0 = {0.f, 0.f, 0.f, 0.f}, f1 = f0, g0 = f0, g1 = f0;
      { float c0 = 1.f; int m = n - 1;
        for (; m >= 7; m -= 8) { f32x4 xa[8], xb[8];
#pragma unroll
            for (int j = 0; j < 8; ++j) { xa[j] = *(const f32x4*)(KVf + (size_t)(m - j) * 4096); xb[j] = *(const f32x4*)(KVf + (size_t)(m - j) * 4096 + 4); }
            asm volatile("" ::: "memory");
#pragma unroll
            for (int j = 0; j < 8; ++j) { f0 += xa[j] * c0; f1 += xb[j] * c0; c0 *= gfC; } }
        for (; m >= 0; --m) { const f32x4 x0 = *(const f32x4*)(KVf + (size_t)m * 4096), x1 = *(const f32x4*)(KVf + (size_t)m * 4096 + 4); f0 += x0 * c0; f1 += x1 * c0; c0 *= gfC; } }
      { float c0 = 1.f; int m = n + 1;
        for (; m + 7 < 32; m += 8) { f32x4 xa[8], xb[8];
#pragma unroll
            for (int j = 0; j < 8; ++j) { xa[j] = *(const f32x4*)(KVb + (size_t)(m + j) * 4096); xb[j] = *(const f32x4*)(KVb + (size_t)(m + j) * 4096 + 4); }
            asm volatile("" ::: "memory");
#pragma unroll
            for (int j = 0; j < 8; ++j) { g0 += xa[j] * c0; g1 += xb[j] * c0; c0 *= gbC; } }
        for (; m < 32; ++m) { const f32x4 x0 = *(const f32x4*)(KVb + (size_t)m * 4096), x1 = *(const f32x4*)(KVb + (size_t)m * 4096 + 4); g0 += x0 * c0; g1 += x1 * c0; c0 *= gbC; } }
      const int e = tid >> 3, d0 = (tid & 7) * 8; u32x4 o;
      o.x = pk2(f0[0], f0[1]); o.y = pk2(f0[2], f0[3]); o.z = pk2(f1[0], f1[1]); o.w = pk2(f1[2], f1[3]); *(u32x4*)((bf16*)(lds + R_STF) + e * 72 + d0) = o;
      o.x = pk2(g0[0], g0[1]); o.y = pk2(g0[2], g0[3]); o.z = pk2(g1[0], g1[1]); o.w = pk2(g1[2], g1[3]); *(u32x4*)((bf16*)(lds + R_STB) + e * 72 + d0) = o; }
    __syncthreads();
    const bf16* QS = (const bf16*)(lds + R_QS); const bf16* KS = (const bf16*)(lds + R_KS); const bf16* VT = (const bf16*)(lds + R_VT);
    const bf16* STF = (const bf16*)(lds + R_STF); const bf16* STB = (const bf16*)(lds + R_STB);
    bf16x8v qf[2];
#pragma unroll
    for (int ks = 0; ks < 2; ++ks) qf[ks] = *(const bf16x8v*)(QS + (16 * w + fr) * 72 + 32 * ks + 8 * fq);
    const int ai = 16 * w + fr;
    unsigned pp[8][2];
#pragma unroll
    for (int jt = 0; jt < 8; ++jt) { f32x4 acc = {0.f, 0.f, 0.f, 0.f};
#pragma unroll
        for (int ks = 0; ks < 2; ++ks) { const bf16x8v kf = *(const bf16x8v*)(KS + (16 * jt + fr) * 72 + 32 * ks + 8 * fq); acc = MFMA16(kf, qf[ks], acc); }
        float sc[4];
#pragma unroll
        for (int r = 0; r < 4; ++r) { const int aj = 16 * jt + 4 * fq + r; const float wg = (aj <= ai) ? exp2f(l2f * (float)(ai - aj)) : exp2f(l2b * (float)(aj - ai)); sc[r] = acc[r] * wg; }
        pp[jt][0] = pk2(sc[0], sc[1]); pp[jt][1] = pk2(sc[2], sc[3]); }
    const float qdf = exp2f(l2f * (float)(ai + 1)), qdb = exp2f(l2b * (float)(128 - ai));
    f32x4 tot[4]; float ss = 0.f;
#pragma unroll
    for (int et = 0; et < 4; ++et) { f32x4 o = {0.f, 0.f, 0.f, 0.f}, cfa = o, cba = o;
#pragma unroll
        for (int t = 0; t < 4; ++t) { const u32x2 vlo = *(const u32x2*)(VT + (16 * et + fr) * 136 + 32 * t + 4 * fq), vhi = *(const u32x2*)(VT + (16 * et + fr) * 136 + 32 * t + 16 + 4 * fq);
            o = MFMA16(mk8(vlo.x, vlo.y, vhi.x, vhi.y), mk8(pp[2 * t][0], pp[2 * t][1], pp[2 * t + 1][0], pp[2 * t + 1][1]), o); }
#pragma unroll
        for (int ks = 0; ks < 2; ++ks) { const bf16x8v sf = *(const bf16x8v*)(STF + (16 * et + fr) * 72 + 32 * ks + 8 * fq), sb = *(const bf16x8v*)(STB + (16 * et + fr) * 72 + 32 * ks + 8 * fq);
            cfa = MFMA16(sf, qf[ks], cfa); cba = MFMA16(sb, qf[ks], cba); }
        tot[et] = o + cfa * qdf + cba * qdb;
        ss += (tot[et][0] * tot[et][0] + tot[et][1] * tot[et][1]) + (tot[et][2] * tot[et][2] + tot[et][3] * tot[et][3]); }
    ss += __shfl_xor(ss, 16); ss += __shfl_xor(ss, 32);
    const float rs = rsqrtf(ss * (1.f / 64.f) + 1e-6f);
    const size_t tok = (size_t)b * SEQ + n * 128 + ai;
    const bf16* Z = (const bf16*)(p.ws + WS_Z); bf16* CAT = (bf16*)(p.ws + WS_CAT);
#pragma unroll
    for (int et = 0; et < 4; ++et) { const u32x2 gz = *(const u32x2*)(Z + tok * DIN + 9 * DG + h * 64 + 16 * et + 4 * fq); u32x2 o;
        o.x = pk2(tot[et][0] * rs * silu_f(bflo(gz.x)), tot[et][1] * rs * silu_f(bfhi(gz.x))); o.y = pk2(tot[et][2] * rs * silu_f(bflo(gz.y)), tot[et][3] * rs * silu_f(bfhi(gz.y)));
        *(u32x2*)(CAT + tok * DM + 1024 + h * 64 + 16 * et + 4 * fq) = o; }
    __syncthreads();
}

__device__ __forceinline__ void na2_task(const Params& p_, int l, int task, unsigned char* lds) {
    const Params p = *kparams(); (void)p_;
    const int tid = otid(), lane = tid & 63, w = tid >> 6, fr = lane & 15, fq = lane >> 4;
    const int hp = task & 3, rq = (task >> 2) & 63, b = task >> 8;
    const int row_start = min(max(rq - 4, 0), 56);
    const bf16* Z = (const bf16*)(p.ws + WS_Z); bf16* CAT = (bf16*)(p.ws + WS_CAT);
    bf16* VT = (bf16*)lds; float* BI = (float*)(lds + 133120);
    const int hh = w >> 2, h = hp * 2 + hh, qb = w & 3, kst = min(max(16 * qb - 8, 0), 32);
    const int c = 16 * qb + fr; const size_t qtok = (size_t)b * SEQ + rq * 64 + c;
    bf16x8v qf[2], kfr[8][2];
#pragma unroll
    for (int ks = 0; ks < 2; ++ks) qf[ks] = *(const bf16x8v*)(Z + qtok * DIN + 2 * DG + h * 64 + 32 * ks + 8 * fq);
#pragma unroll
    for (int i = 0; i < 8; ++i) { const int a = i / 2, ci = i % 2;
        const size_t ktok = (size_t)b * SEQ + (row_start + a) * 64 + kst + 16 * ci + fr;
#pragma unroll
        for (int ks = 0; ks < 2; ++ks) kfr[i][ks] = *(const bf16x8v*)(Z + ktok * DIN + 3 * DG + h * 64 + 32 * ks + 8 * fq); }
    asm volatile("" ::: "memory");
    for (int i = tid; i < 930; i += NTHR) BI[i] = p.na_bias[(size_t)(l * 8 + hp * 2) * 465 + i];
    { const int pair = lane & 31, chunk = (lane >> 5) + 2 * (w & 3);
      unsigned* VTd = (unsigned*)(VT + (size_t)hh * 64 * 520);
      u32x4 xs[8], ys[8];
#pragma unroll
      for (int a = 0; a < 8; ++a) { const size_t tok = (size_t)b * SEQ + (row_start + a) * 64 + 2 * pair;
          const bf16* src = Z + tok * DIN + 4 * DG + h * 64 + chunk * 8; xs[a] = *(const u32x4*)src; ys[a] = *(const u32x4*)(src + DIN); }
      asm volatile("" ::: "memory");
#pragma unroll
      for (int a = 0; a < 8; ++a) { const unsigned xu[4] = {xs[a].x, xs[a].y, xs[a].z, xs[a].w}, yu[4] = {ys[a].x, ys[a].y, ys[a].z, ys[a].w};
#pragma unroll
          for (int i = 0; i < 4; ++i) { VTd[(chunk * 8 + 2 * i) * 260 + a * 32 + pair] = (xu[i] & 0xffffu) | (yu[i] << 16);
              VTd[(chunk * 8 + 2 * i + 1) * 260 + a * 32 + pair] = (xu[i] >> 16) | (yu[i] & 0xffff0000u); } } }
    __syncthreads();
    const int col_start = min(max(c - 8, 0), 48);
    const float* bi = BI + hh * 465;
    float sc[16][4]; float mx = -1e30f;
#pragma unroll
    for (int hf = 0; hf < 2; ++hf) {
        if (hf == 1) {
#pragma unroll
            for (int i = 0; i < 8; ++i) { const int a = 4 + i / 2, ci = i % 2;
                const size_t ktok = (size_t)b * SEQ + (row_start + a) * 64 + kst + 16 * ci + fr;
#pragma unroll
                for (int ks = 0; ks < 2; ++ks) kfr[i][ks] = *(const bf16x8v*)(Z + ktok * DIN + 3 * DG + h * 64 + 32 * ks + 8 * fq); }
            asm volatile("" ::: "memory");
        }
#pragma unroll
        for (int i = 0; i < 8; ++i) { const int a = 4 * hf + i / 2, ci = i % 2, kt = a * 2 + ci;
            f32x4 acc = {0.f, 0.f, 0.f, 0.f};
#pragma unroll
            for (int ks = 0; ks < 2; ++ks) acc = MFMA16(kfr[i][ks], qf[ks], acc);
            const int dr = row_start + a - rq;
#pragma unroll
            for (int r = 0; r < 4; ++r) { const int kc = kst + 16 * ci + 4 * fq + r, rel = kc - col_start, dc = kc - c;
                float v = acc[r] * 0.125f + bi[(dr + 7) * 31 + min(max(dc + 15, 0), 30)];
                v = (rel >= 0 && rel < 16) ? v : -1e30f; sc[kt][r] = v; mx = fmaxf(mx, v); } }
    }
    mx = fmaxf(mx, __shfl_xor(mx, 16)); mx = fmaxf(mx, __shfl_xor(mx, 32));
    float sum = 0.f; unsigned pp[16][2];
#pragma unroll
    for (int kt = 0; kt < 16; ++kt) { const float e0 = __expf(sc[kt][0] - mx), e1 = __expf(sc[kt][1] - mx), e2 = __expf(sc[kt][2] - mx), e3 = __expf(sc[kt][3] - mx);
        sum += (e0 + e1) + (e2 + e3); pp[kt][0] = pk2(e0, e1); pp[kt][1] = pk2(e2, e3); }
    sum += __shfl_xor(sum, 16); sum += __shfl_xor(sum, 32);
    const float inv = 1.f / sum;
    const bf16* VTh = VT + (size_t)hh * 64 * 520;
#pragma unroll
    for (int dt = 0; dt < 4; ++dt) { f32x4 o = {0.f, 0.f, 0.f, 0.f};
#pragma unroll
        for (int t = 0; t < 8; ++t) { const int k0 = 2 * t, k1 = 2 * t + 1, a0 = k0 / 2, c0 = k0 % 2, a1 = k1 / 2, c1 = k1 % 2;
            const u32x2 vlo = *(const u32x2*)(VTh + (16 * dt + fr) * 520 + a0 * 64 + kst + 16 * c0 + 4 * fq), vhi = *(const u32x2*)(VTh + (16 * dt + fr) * 520 + a1 * 64 + kst + 16 * c1 + 4 * fq);
            o = MFMA16(mk8(vlo.x, vlo.y, vhi.x, vhi.y), mk8(pp[k0][0], pp[k0][1], pp[k1][0], pp[k1][1]), o); }
        const u32x2 gz = *(const u32x2*)(Z + qtok * DIN + 5 * DG + h * 64 + 16 * dt + 4 * fq); u32x2 ov;
        ov.x = pk2(o[0] * inv * silu_f(bflo(gz.x)), o[1] * inv * silu_f(bfhi(gz.x))); ov.y = pk2(o[2] * inv * silu_f(bflo(gz.y)), o[3] * inv * silu_f(bfhi(gz.y)));
        *(u32x2*)(CAT + qtok * DM + 512 + h * 64 + 16 * dt + 4 * fq) = ov; }
    __syncthreads();
}

__device__ __forceinline__ void conv_task(const Params& p_, int l, int task, unsigned char* lds) {
    const Params p = *kparams(); (void)p_;
    const int tid = otid(), lane = tid & 63, wave = tid >> 6;
    float* us = (float*)lds; float* ys = us + 46 * 512;
    const bf16* Z = (const bf16*)(p.ws + WS_Z);
    const int b = task >> 8, t0 = (task & 255) * 16;
    { u32x4 av[6], gv[6];
#pragma unroll
      for (int it = 0; it < 6; ++it) { const int idx = tid + it * NTHR, tt = idx >> 6, cc = (idx & 63) * 8, tok = t0 - 15 + tt;
          av[it] = (u32x4){0u, 0u, 0u, 0u}; gv[it] = av[it];
          if (idx < 46 * 64 && tok >= 0 && tok < SEQ) { const bf16* zr = Z + (size_t)(b * SEQ + tok) * DIN; av[it] = *(const u32x4*)(zr + 10 * DG + cc); gv[it] = *(const u32x4*)(zr + 11 * DG + cc); } }
      asm volatile("" ::: "memory");
#pragma unroll
      for (int it = 0; it < 6; ++it) { const int idx = tid + it * NTHR, tt = idx >> 6, cc = (idx & 63) * 8;
          if (idx < 46 * 64) { const u32x4 a = av[it], g = gv[it]; f32x4 u0, u1;
              u0[0] = bflo(a.x) / (1.f + __expf(-bflo(g.x))); u0[1] = bfhi(a.x) / (1.f + __expf(-bfhi(g.x))); u0[2] = bflo(a.y) / (1.f + __expf(-bflo(g.y))); u0[3] = bfhi(a.y) / (1.f + __expf(-bfhi(g.y)));
              u1[0] = bflo(a.z) / (1.f + __expf(-bflo(g.z))); u1[1] = bfhi(a.z) / (1.f + __expf(-bfhi(g.z))); u1[2] = bflo(a.w) / (1.f + __expf(-bflo(g.w))); u1[3] = bfhi(a.w) / (1.f + __expf(-bfhi(g.w)));
              *(f32x4*)(us + tt * 512 + cc) = u0; *(f32x4*)(us + tt * 512 + cc + 4) = u1; } } }
    float w[31];
#pragma unroll
    for (int k = 0; k < 31; ++k) w[k] = p.conv_w[(size_t)(l * 31 + k) * DG + tid];
    const float cb = p.conv_b[l * DG + tid];
    __syncthreads();
    { float y[16];
#pragma unroll
      for (int t = 0; t < 16; ++t) y[t] = cb;
#pragma unroll
      for (int j = 0; j < 46; ++j) { const float u = us[j * 512 + tid];
#pragma unroll
          for (int t = 0; t < 16; ++t) { const int k = j - t; if (k >= 0 && k < 31) y[t] += w[k] * u; } }
#pragma unroll
      for (int t = 0; t < 16; ++t) ys[t * 512 + tid] = y[t]; }
    __syncthreads();
#pragma unroll
    for (int tw = 0; tw < 2; ++tw) { const int t = wave + 8 * tw; float v[8]; float s = 0.f;
#pragma unroll
        for (int j = 0; j < 8; ++j) { v[j] = ys[t * 512 + lane + 64 * j]; s += v[j]; }
        const float mu = wave_sum(s) * (1.f / 512.f); float q = 0.f;
#pragma unroll
        for (int j = 0; j < 8; ++j) { v[j] -= mu; q += v[j] * v[j]; }
        const float rstd = rsqrtf(wave_sum(q) * (1.f / 512.f) + 1e-6f);
        bf16* orow = (bf16*)(p.ws + WS_CVH) + (size_t)(b * SEQ + t0 + t) * DG;
#pragma unroll
        for (int j = 0; j < 8; ++j) { const int ch = lane + 64 * j; const float y = v[j] * rstd * p.ln_g[l * DG + ch] + p.ln_b[l * DG + ch]; orow[ch] = (bf16)f2bf(silu_f(y)); } }
    __syncthreads();
}

__device__ __forceinline__ void ph_mixA(const Params& p, int l, unsigned char* lds) {
    const int G = gridDim.x, bid = obid();
    for (int t = bid; t < 512 * REP_R1; t += G) ret1_task(p, l, t & 511, lds);
    const int xcd = bid & 7, slot = bid >> 3, nloc = (slot < 16) ? 1 : 3, r0 = (slot < 16) ? slot : 16 + (slot - 16) * 3;
    if (G == 256 && REP_NA == 1) {
        for (int i = 0; i < nloc; ++i) { const int rq = (slot < 16) ? slot : 16 + i * 16 + (slot - 16);
            na2_task(p, l, (xcd >> 2) * 256 + rq * 4 + (xcd & 3), lds); }
    } else for (int t = bid; t < 512 * REP_NA; t += G) na2_task(p, l, t & 511, lds);
    if (G == 256 && REP_CV == 1) {
        for (int i = 0; i < 2; ++i) conv_task(p, l, xcd * 64 + slot * 2 + i, lds);
    } else for (int t = bid; t < 512 * REP_CV; t += G) conv_task(p, l, t & 511, lds);
}

__device__ __forceinline__ void ph_fold(const Params& p_) {
    const Params p = *kparams(); (void)p_;
    const bf16* PQ = (const bf16*)(p.ws + WS_PQT); bf16* PQF = (bf16*)(p.ws + WS_PQF);
    for (int e = obid() * NTHR + otid(); e < NB * DG * 2 * 256; e += gridDim.x * NTHR) {
        const int row = e >> 8, s0 = (e & 255) * 8, pq = row & 1;
        const bf16* src = PQ + (size_t)row * 4096;
        const u32x4 own = *(const u32x4*)(src + s0), low = *(const u32x4*)(src + 4096 - s0 - 8);
        const float top = (s0 == 0) ? 0.f : bf2f(src[4096 - s0]);
        const float sg = pq ? -1.f : 1.f;
        float o[8];
        o[0] = bflo(own.x) + sg * top;            o[1] = bfhi(own.x) + sg * bfhi(low.w);
        o[2] = bflo(own.y) + sg * bflo(low.w);    o[3] = bfhi(own.y) + sg * bfhi(low.z);
        o[4] = bflo(own.z) + sg * bflo(low.z);    o[5] = bfhi(own.z) + sg * bfhi(low.y);
        o[6] = bflo(own.w) + sg * bflo(low.y);    o[7] = bfhi(own.w) + sg * bfhi(low.x);
        if (s0 == 0 && pq) o[0] = 0.f;
        u32x4 w; w.x = pk2(o[0], o[1]); w.y = pk2(o[2], o[3]); w.z = pk2(o[4], o[5]); w.w = pk2(o[6], o[7]);
        *(u32x4*)(PQF + (size_t)row * 2048 + s0) = w;
    }
}
__device__ __forceinline__ void ph_alt(const Params& p_) {
    const Params p = *kparams(); (void)p_;
    const int tid = otid(), lane = tid & 63, wave = tid >> 6; const bf16* PQF = (const bf16*)(p.ws + WS_PQF);
    float* dst = (float*)(p.ws + WS_PART) + (size_t)(2 * 2304 + 2 * 2048) * 512;
    for (int r = obid() * 8 + wave; r < NB * DG; r += gridDim.x * 8) {
        const u32x4* src = (const u32x4*)(PQF + (size_t)r * 4096) + lane; float acc = 0.f;
#pragma unroll
        for (int j = 0; j < 4; ++j) { const u32x4 v = src[64 * j];
            acc += (bflo(v.x) - bfhi(v.x)) + (bflo(v.y) - bfhi(v.y)) + (bflo(v.z) - bfhi(v.z)) + (bflo(v.w) - bfhi(v.w)); }
        acc = wave_sum(acc);
        if (lane == 0) dst[r] = acc;
    }
}
__device__ __forceinline__ void ph_combine(const Params& p_) {
    const Params p = *kparams(); (void)p_;
    const float* Ce = (const float*)(p.ws + WS_PART); const float* So = Ce + (size_t)2 * 2304 * 512;
    bf16* CAT = (bf16*)(p.ws + WS_CAT); const bf16* Z = (const bf16*)(p.ws + WS_Z); const bf16* PQ = (const bf16*)(p.ws + WS_PQT);
    const int nth = gridDim.x * NTHR;
    for (int e0 = obid() * NTHR + otid(); e0 < MTOK * DG / 4; e0 += 2 * nth) {
        f32x4 ce[2], so[2]; u32x2 gz[2]; float pv[2][4]; int rowv[2], c4v[2], kv[2]; bool use_so[2], act[2];
#pragma unroll
        for (int u = 0; u < 2; ++u) { const int e = e0 + u * nth; act[u] = e < MTOK * DG / 4; const int ee = act[u] ? e : e0;
            const int row = ee >> 7, c4 = (ee & 127) * 4, b = row >> 12, k = row & 4095, kk = (k <= 2048) ? k : 4096 - k;
            rowv[u] = row; c4v[u] = c4; kv[u] = k; use_so[u] = (kk != 0 && kk != 2048);
            ce[u] = (kk == 2048) ? *(const f32x4*)(Ce + (size_t)(2 * 2304 + 2 * 2048) * 512 + b * 512 + c4) : *(const f32x4*)(Ce + ((size_t)b * 2304 + kk) * 512 + c4);
            so[u] = *(const f32x4*)(So + ((size_t)b * 2048 + (use_so[u] ? kk : 1)) * 512 + c4);
            gz[u] = *(const u32x2*)(Z + (size_t)row * DIN + DG + c4);
#pragma unroll
            for (int j = 0; j < 4; ++j) pv[u][j] = bf2f(PQ[((size_t)(b * 512 + c4 + j) * 2) * 4096 + 2048]); }
        asm volatile("" ::: "memory");
#pragma unroll
        for (int u = 0; u < 2; ++u) if (act[u]) { f32x4 s = ce[u];
            if (use_so[u]) s = (kv[u] <= 2048) ? s - so[u] : s + so[u];
            const float alt = (kv[u] & 1) ? -1.f : 1.f;
#pragma unroll
            for (int j = 0; j < 4; ++j) s[j] += alt * pv[u][j];
            u32x2 w; w.x = pk2(s[0] * silu_f(bflo(gz[u].x)), s[1] * silu_f(bfhi(gz[u].x))); w.y = pk2(s[2] * silu_f(bflo(gz[u].y)), s[3] * silu_f(bfhi(gz[u].y)));
            *(u32x2*)(CAT + (size_t)rowv[u] * DM + c4v[u]) = w; }
    }
}

#define XB_TMO      128
#define XB_XCNT(j)  (256  + 64 * (j))
#define XB_XSUB(j)  (1280 + 64 * (j))
#define XB_XGEN(j)  (2304 + 64 * (j))
#define XB_TOP      3328
#define XB_TOPGEN   3392
#define XCD_BAR_WORDS 3456
#define XB_SPIN_CAP (1u << 20)
__device__ __forceinline__ unsigned xb_ld(unsigned* p)              { return __hip_atomic_load(p, __ATOMIC_RELAXED, __HIP_MEMORY_SCOPE_AGENT); }
__device__ __forceinline__ unsigned xb_add(unsigned* p, unsigned v) { return __hip_atomic_fetch_add(p, v, __ATOMIC_RELAXED, __HIP_MEMORY_SCOPE_AGENT); }
__device__ __forceinline__ unsigned xb_xcc_id() { return (unsigned)__builtin_amdgcn_s_getreg((3 << 11) | 20) & 0xFu; }
#define XB_SPIN(cond, bar) do { unsigned _sp = 0; while (cond) { __builtin_amdgcn_s_sleep(1); \
    if ((++_sp & 255u) == 0u) { if (xb_ld(&(bar)[XB_TMO])) break; if (_sp > XB_SPIN_CAP) { atomicAdd(&(bar)[XB_TMO], 1u); break; } } } } while (0)
struct XcdBarrier { unsigned* bar; unsigned x; volatile PG8_LAS unsigned* st; };
__device__ __forceinline__ XcdBarrier xcd_barrier_post(unsigned* bar, volatile PG8_LAS unsigned* st) {
    XcdBarrier b; b.bar = bar; b.x = xb_xcc_id(); b.st = st;
    if (otid() == 0) (void)xb_add(&bar[XB_XCNT(b.x)], 1u);
    return b;
}
__device__ __forceinline__ void xcd_barrier_complete(unsigned* bar, unsigned x, unsigned& nloc, unsigned& nx) {
    const unsigned G = gridDim.x * gridDim.y * gridDim.z;
    unsigned sum, cnt, mine, sp = 0u;
    for (;;) {
        sum = 0u; cnt = 0u; mine = 0u;
#pragma unroll
        for (unsigned j = 0; j < 16; ++j) { const unsigned c = xb_ld(&bar[XB_XCNT(j)]); sum += c; cnt += (c > 0u) ? 1u : 0u; mine = (j == x) ? c : mine; }
        if (sum == G) break;
        __builtin_amdgcn_s_sleep(1);
        if ((++sp & 255u) == 0u) { if (xb_ld(&bar[XB_TMO])) break; if (sp > XB_SPIN_CAP) { atomicAdd(&bar[XB_TMO], 1u); break; } }
    }
    nloc = mine > 0u ? mine : 1u; nx = cnt > 0u ? cnt : 1u;
}
__device__ __forceinline__ void xcd_barrier(const XcdBarrier& b) {
    asm volatile("s_waitcnt vmcnt(0)" ::: "memory");
    __syncthreads();
    if (otid() == 0) {
        unsigned* bar = b.bar;
        __builtin_amdgcn_s_waitcnt(0);
        unsigned nloc = b.st[0], nx = b.st[1];
        if (nloc == 0u) { xcd_barrier_complete(bar, b.x, nloc, nx); b.st[0] = nloc; b.st[1] = nx; }
        const unsigned old = xb_add(&bar[XB_XSUB(b.x)], 1u);
        const unsigned gen = old / nloc;
        if (old + 1u == (gen + 1u) * nloc) {
            __builtin_amdgcn_fence(__ATOMIC_RELEASE, "agent");
            asm volatile("s_waitcnt vmcnt(0)" ::: "memory");
            const unsigned og = xb_add(&bar[XB_TOP], 1u);
            const unsigned tg = og / nx;
            if (og + 1u == (tg + 1u) * nx) xb_add(&bar[XB_TOPGEN], 1u);
            else XB_SPIN(xb_ld(&bar[XB_TOPGEN]) == tg, bar);
            __builtin_amdgcn_fence(__ATOMIC_ACQUIRE, "agent");
            xb_add(&bar[XB_XGEN(b.x)], 1u);
            asm volatile("s_waitcnt vmcnt(0)" ::: "memory");
        } else {
            XB_SPIN(xb_ld(&bar[XB_XGEN(b.x)]) == gen, bar);
            __builtin_amdgcn_fence(__ATOMIC_ACQUIRE, "agent");
            asm volatile("s_waitcnt vmcnt(0)" ::: "memory");
        }
    }
    __syncthreads();
}

constexpr int NPH = 14;
__global__ void __launch_bounds__(NTHR) mega(Params p) {
    extern __shared__ __attribute__((aligned(16))) unsigned char lds[];
    cg::grid_group grid = cg::this_grid();
    PG8_LAS unsigned char* ldsl = (PG8_LAS unsigned char*)lds;
    const int lo = p.ph_lo, hi = p.ph_hi;
#define IN(k) (lo <= (k) && (k) < hi)
#define SEAM(k) do { if (IN(k) && IN((k) + 1)) { xcd_barrier(xb); } } while (0)
    bf16* Zb = (bf16*)(kparams()->ws + WS_Z); bf16* CAT = (bf16*)(kparams()->ws + WS_CAT);
    volatile PG8_LAS unsigned* xst = (volatile PG8_LAS unsigned*)(ldsl + LDS_BYTES - 16);
    { const int t0_ = otid(); if (t0_ < 4) xst[t0_] = 0u; }
    __syncthreads();
    XcdBarrier xb = xcd_barrier_post((unsigned*)(kparams()->ws + WS_BAR), xst);
    if (p.ph_lo < 0) grid.sync();
    if (IN(0)) REPEAT(REP_PRO) { ph_prologue(p, lds); __syncthreads(); }
    SEAM(0);
    if (IN(0) && IN(1)) for (int r_ = 1; r_ < REP_SUB; ++r_) xcd_barrier(xb);
#pragma unroll
    for (int l = 0; l < NL; ++l) {
        const int pb = 1 + 6 * l;
        const char* Wl = (const char*)(kparams()->ws + WS_WIN + (size_t)l * WROWS * DM * 2);
        if (IN(pb)) {
            if (l == 0) {
#pragma unroll
                for (int ll = 0; ll < NL; ++ll) {
                    SchedS S = make_sched(kparams()->ws + WS_WCS + (size_t)ll * 1024 * DG * 2, DG, kparams()->ws + WS_WFXB + (size_t)ll * DM * DG * 2, DG, 1024, DM, 32 * ll);
                    EpiZ E{(bf16*)(kparams()->ws + WS_WIN + ((size_t)ll * WROWS + 6656) * DM * 2), DM};
                    pg8::gemm_phase<EpiZ, SchedS, true>(ldsl, pg8::Gemm{DG, DG, DG}, S, E);
                }
            }
            REPEAT(REP_NORM) ph_norm(p, l);
        }
        SEAM(pb);
        if (IN(pb + 1)) REPEAT(REP_Z) {
            SchedZ S; S.o.init(MTOK, 24 * 256, (int)gridDim.x, obid()); S.A = (const char*)(kparams()->ws + WS_U); S.B = Wl; S.late = 0;
            EpiZ2 E{Zb, (bf16*)(kparams()->ws + WS_PQT)};
            pg8::gemm_phase<EpiZ2, SchedZ, true>(ldsl, pg8::Gemm{DM, DM, DM}, S, E);
        }
        SEAM(pb + 1);
        if (IN(pb + 2)) {
            {
                SchedZ S; S.o.init(MTOK, 4 * 256, (int)gridDim.x, obid()); S.A = (const char*)(kparams()->ws + WS_U); S.B = Wl; S.late = 1;
                EpiZ2 E{Zb, (bf16*)(kparams()->ws + WS_PQT)};
                pg8::gemm_phase<EpiZ2, SchedZ, true>(ldsl, pg8::Gemm{DM, DM, DM}, S, E);
            }
            REPEAT(REP_MIX) ph_mixA(p, l, lds);
            ph_fold(p);
        }
        SEAM(pb + 2);
        if (IN(pb + 3)) REPEAT(REP_P3) {
            const int G_ = (int)gridDim.x, b_ = obid(); const bool bal = (G_ == 256);
            {
                SchedDFT S{(const char*)(kparams()->ws + WS_DC), (const char*)(kparams()->ws + WS_PQF), G_, b_};
                EpiPart E{(float*)(kparams()->ws + WS_PART)};
                pg8::gemm_phase<EpiPart, SchedDFT, true>(ldsl, pg8::Gemm{2048, 4096, 2048}, S, E); }
            {
                SchedS S = make_sched(kparams()->ws + WS_CVH, DG, kparams()->ws + WS_WPW + (size_t)l * DG * DG * 2, DG, MTOK, DG, bal ? 192 : 0);
                EpiGate E{CAT, Zb, 1536, 12 * DG};
                pg8::gemm_phase<EpiGate, SchedS, true>(ldsl, pg8::Gemm{DG, DG, DG}, S, E); }
            if (bal && REP_R2 == 1) {
                const int xcd = b_ & 7, slot = b_ >> 3;
                const int nt_ = (slot >= 24) ? 2 : (slot >= 8 ? 3 : 0), k0 = (slot >= 24) ? 48 + (slot - 24) * 2 : (slot - 8) * 3;
                for (int i = 0; i < nt_; ++i) { const int k = k0 + i; ret2_task(p, l, (2 * xcd + (k >> 5)) * 32 + (k & 31), lds); }
            }
            else for (int t = b_; t < 512 * REP_R2; t += G_) ret2_task(p, l, t & 511, lds);
            ph_alt(p);
        }
        SEAM(pb + 3);
        if (IN(pb + 4)) REPEAT(REP_CMB) ph_combine(p);
        SEAM(pb + 4);
        if (IN(pb + 5)) REPEAT(l == 0 ? REP_OUT : 1) {
            SchedS S = make_sched(CAT, DM, kparams()->ws + WS_WOUT + (size_t)l * DM * DM * 2, DM, MTOK, DM);
            EpiRes E{(l == 0) ? kparams()->x : kparams()->out, kparams()->out, (const float*)(kparams()->ws + WS_MOD) + (size_t)l * 2 * 6144 + 4096};
            pg8::gemm_phase<EpiRes, SchedS, true>(ldsl, pg8::Gemm{DM, DM, DM}, S, E);
        }
        SEAM(pb + 5);
    }
    if (IN(NPH - 1)) ph_final(p);
#undef IN
#undef SEAM
}

extern "C" void kernel_launch(void* const* d_in, const int* in_sizes, int n_in, void* d_out, int out_size, void* d_ws, size_t ws_size, hipStream_t stream) {
    static int grid_blocks = 0;
    if (grid_blocks == 0) {
        if (n_in != 17 || ws_size < WS_END) { fprintf(stderr, "kernel_launch: n_in %d ws %zu (need %zu)\n", n_in, ws_size, (size_t)WS_END); grid_blocks = -1; return; }
        int dev = 0, cus = 0, per_cu = 0;
        hipGetDevice(&dev); hipDeviceGetAttribute(&cus, hipDeviceAttributeMultiprocessorCount, dev);
        if (hipFuncSetAttribute((const void*)mega, hipFuncAttributeMaxDynamicSharedMemorySize, LDS_BYTES) != hipSuccess) { fprintf(stderr, "hipFuncSetAttribute failed\n"); grid_blocks = -1; return; }
        if (hipOccupancyMaxActiveBlocksPerMultiprocessor(&per_cu, (const void*)mega, NTHR, LDS_BYTES) != hipSuccess || per_cu < 1) { fprintf(stderr, "occupancy query: %d\n", per_cu); per_cu = 1; }
        (void)hipGetLastError();
        grid_blocks = cus * 1;
    }
    if (grid_blocks < 0) return;
    Params p{};
    p.x = (const float*)d_in[0]; p.c = (const float*)d_in[1]; p.norm_g = (const float*)d_in[2]; p.w_ada = (const float*)d_in[3]; p.b_ada = (const float*)d_in[4];
    p.w_in = (const float*)d_in[5]; p.w_fft = (const float*)d_in[6]; p.na_bias = (const float*)d_in[7]; p.rl_f = (const float*)d_in[8]; p.rl_b = (const float*)d_in[9];
    p.conv_w = (const float*)d_in[10]; p.conv_b = (const float*)d_in[11]; p.ln_g = (const float*)d_in[12]; p.ln_b = (const float*)d_in[13]; p.w_pw = (const float*)d_in[14];
    p.w_out = (const float*)d_in[15]; p.final_g = (const float*)d_in[16];
    p.out = (float*)d_out; p.ws = (unsigned char*)d_ws;
#if ONE_LAUNCH
    if (hipMemsetAsync((char*)d_ws + WS_BAR, 0, 16384, stream) != hipSuccess) { fprintf(stderr, "memset of the barrier words failed\n"); return; }
    p.ph_lo = 0; p.ph_hi = NPH;
    void* args[] = {&p};
    hipError_t e = hipLaunchCooperativeKernel((const void*)mega, dim3(grid_blocks), dim3(NTHR), args, LDS_BYTES, stream);
    if (e != hipSuccess) fprintf(stderr, "cooperative launch failed: %s (grid %d)\n", hipGetErrorString(e), grid_blocks);
#else
    for (int ph = 0; ph < NPH; ++ph) { p.ph_lo = ph; p.ph_hi = ph + 1; hipLaunchKernelGGL(mega, dim3(grid_blocks), dim3(NTHR), LDS_BYTES, stream, p); }
#endif
}
```

```cpp
#include <hip/hip_runtime.h>
#include <hip/hip_cooperative_groups.h>
#include <cstdio>
#include <cstdint>
namespace cg = cooperative_groups;

#ifndef ONE_LAUNCH
#define ONE_LAUNCH 1
#endif

__device__ __forceinline__ int obid() { int b = (int)blockIdx.x; asm volatile("" : "+s"(b)); return b; }
__device__ __forceinline__ int otid() { int t; asm volatile("v_mov_b32 %0, %1" : "=v"(t) : "v"(threadIdx.x)); return t; }
namespace pg8 {
#define PG8_LAS __attribute__((address_space(3)))
typedef unsigned short bf16_t;
typedef short bf16x8 __attribute__((ext_vector_type(8)));
typedef float f32x4 __attribute__((ext_vector_type(4)));
typedef unsigned u32x4 __attribute__((ext_vector_type(4)));
constexpr int BM = 256, BK = 64, HALF = 128, HTB = HALF * BK * 2, STAGE_BYTES = 8 * HTB, NXCD = 8, WGM = 8;

__host__ __device__ __forceinline__ int lds_byte(int r, int c) { const int st = (r >> 4) * 2 + (c >> 5), rr = r & 15, cc = c & 31, ob = rr * 64 + cc * 2; return st * 1024 + (ob ^ (((ob >> 9) & 1) << 5)); }
__host__ __device__ __forceinline__ void stage_rc(int b, int& R, int& C) { const int st = b / 1024, sb = b % 1024, swz = sb ^ (((sb >> 9) & 1) << 5); R = (st >> 1) * 16 + swz / 64; C = (st & 1) * 32 + (swz % 64) / 2; }
__host__ __device__ __forceinline__ int perm32(int rho) { const int n = rho >> 4, i = rho & 15; return 8 * (i >> 2) + 4 * n + (i & 3); }

struct Unit { int pm, pn, aux, pad; const char* A; const char* B; };
struct Gemm { int lda, ldb, K; };

struct StaticOrder {
    int nM, nN, nwg, G, c;
    __host__ __device__ void init(int M, int N, int G_, int c_) { nM = M / BM; nN = N / BM; nwg = nM * nN; G = G_; c = c_; }
    __device__ bool next(int i, Unit& u) const {
        const long L = (long)i * G + c; if (L >= nwg) return false;
        int wgid = __builtin_amdgcn_readfirstlane((int)L); { const int q = nwg / NXCD, r = nwg % NXCD, xcd = wgid % NXCD, off = wgid / NXCD; wgid = (xcd < r ? xcd * (q + 1) : r * (q + 1) + (xcd - r) * q) + off; }
        const int nig = WGM * nN, gid = wgid / nig, fm = gid * WGM, gsz = (nM - fm) < WGM ? (nM - fm) : WGM;
        u.pm = __builtin_amdgcn_readfirstlane(fm + ((wgid % nig) % gsz)); u.pn = __builtin_amdgcn_readfirstlane((wgid % nig) / gsz); return true;
    }
};

__device__ __forceinline__ unsigned cvt_pk_bf16(float lo, float hi) { unsigned r; asm volatile("v_cvt_pk_bf16_f32 %0, %1, %2" : "=v"(r) : "v"(lo), "v"(hi)); return r; }

template <class Epi, class Sched, bool ALIGN_EPI>
__device__ __forceinline__ void gemm_phase(PG8_LAS unsigned char* lds, const Gemm g, const Sched& S, const Epi& E) {
    const int tid = otid(), wid = __builtin_amdgcn_readfirstlane(tid >> 6), lane = tid & 63, wr = wid >> 2, wc = wid & 3, fr = lane & 15, fq = lane >> 4;
    const int K = g.K, nt = K / BK;
    unsigned voffA[2], voffB[2];
#pragma unroll
    for (int i = 0; i < 2; ++i) { int R, C; stage_rc(tid * 16 + i * 8192, R, C); const int Rb = Epi::PERM ? ((R & ~31) + perm32(R & 31)) : R;
        voffA[i] = (unsigned)(R * g.lda + C) * 2u; voffB[i] = (unsigned)(Rb * g.ldb + C) * 2u; }
    const size_t kstep = (size_t)(BK * 2);
    const size_t hA = (size_t)HALF * g.lda * 2, hB = (size_t)HALF * g.ldb * 2;
    const unsigned ldsw = (unsigned)wid * 1024u;
    const int aoff = lds_byte(wr * 64 + fr, fq * 8), boff = lds_byte(wc * 32 + fr, fq * 8);
#define PG8_SA(b, h) (((b) * 2 + (h)) * HTB)
#define PG8_SB(b, h) ((4 + (b) * 2 + (h)) * HTB)
#define PG8_STAGE(bufoff, gbase, voff) do { _Pragma("unroll") for (int _i = 0; _i < 2; ++_i) \
        __builtin_amdgcn_global_load_lds((const unsigned*)((const char*)(gbase) + (voff)[_i]), (PG8_LAS unsigned*)(lds + (bufoff) + ldsw + _i * 8192), 16, 0, 0); } while (0)
#define PG8_LDA(dst, b, h) do { _Pragma("unroll") for (int m = 0; m < 4; ++m) _Pragma("unroll") for (int k = 0; k < 2; ++k) dst[m][k] = *(const PG8_LAS bf16x8*)(lds + PG8_SA(b, h) + aoff + m * 2048 + k * 1024); } while (0)
#define PG8_LDB(dst, b, h) do { _Pragma("unroll") for (int n = 0; n < 2; ++n) _Pragma("unroll") for (int k = 0; k < 2; ++k) dst[n][k] = *(const PG8_LAS bf16x8*)(lds + PG8_SB(b, h) + boff + n * 2048 + k * 1024); } while (0)
#define PG8_MMA(ai, bj, At, Bt) do { __builtin_amdgcn_s_setprio(1); _Pragma("unroll") for (int m = 0; m < 4; ++m) _Pragma("unroll") for (int n = 0; n < 2; ++n) _Pragma("unroll") for (int k = 0; k < 2; ++k) \
        acc[ai][bj][m][n] = __builtin_amdgcn_mfma_f32_16x16x32_bf16(Bt[n][k], At[m][k], acc[ai][bj][m][n], 0, 0, 0); __builtin_amdgcn_s_setprio(0); } while (0)
#define PG8_WAIT_V(n) asm volatile("s_waitcnt vmcnt(" #n ")" ::: "memory")
#define PG8_WAIT_L(n) asm volatile("s_waitcnt lgkmcnt(" #n ")" ::: "memory")
#define PG8_BAR __builtin_amdgcn_s_barrier()
#define PG8_SCHED __builtin_amdgcn_sched_barrier(0)
    Unit cur, nxt; int ui = 0;
    if (!S.next(0, cur)) return;
    f32x4 acc[2][2][4][2];
#pragma unroll
    for (int a = 0; a < 2; ++a)
#pragma unroll
        for (int b = 0; b < 2; ++b)
#pragma unroll
            for (int m = 0; m < 4; ++m)
#pragma unroll
                for (int n = 0; n < 2; ++n) acc[a][b][m][n] = (f32x4){0.f, 0.f, 0.f, 0.f};
    bf16x8 At[4][2], B0[2][2], B1[2][2];
    const char* cA = cur.A; const char* cB = cur.B;
    PG8_STAGE(PG8_SB(0, 0), cB, voffB); PG8_STAGE(PG8_SB(0, 1), cB + hB, voffB); PG8_STAGE(PG8_SA(0, 0), cA, voffA); PG8_STAGE(PG8_SA(0, 1), cA + hA, voffA);
    if (wr == 1) PG8_BAR;
    PG8_WAIT_V(2); PG8_BAR;
    PG8_STAGE(PG8_SB(1, 0), cB + kstep, voffB); PG8_STAGE(PG8_SA(1, 0), cA + kstep, voffA); PG8_STAGE(PG8_SB(1, 1), cB + hB + kstep, voffB);
    PG8_WAIT_V(6); PG8_BAR;
    for (;;) {
        const bool has_next = S.next(ui + 1, nxt);
        const char* nA = has_next ? nxt.A : cA; const char* nB = has_next ? nxt.B : cB;
        for (int t = 0; t < nt; t += 2) {
            const bool last = (t == nt - 2);
            const char* a1 = cA + (size_t)(t + 1) * kstep;
            const char* a2 = last ? nA : cA + (size_t)(t + 2) * kstep; const char* b2 = last ? nB : cB + (size_t)(t + 2) * kstep;
            const char* a3 = a2 + kstep; const char* b3 = b2 + kstep;
            PG8_LDB(B0, 0, 0); PG8_LDB(B1, 0, 1); PG8_SCHED; PG8_LDA(At, 0, 0); PG8_STAGE(PG8_SA(1, 1), a1 + hA, voffA);
            PG8_WAIT_V(8); PG8_WAIT_L(0); PG8_BAR; PG8_MMA(0, 0, At, B0); PG8_MMA(0, 1, At, B1); PG8_BAR; PG8_SCHED;
            PG8_LDA(At, 0, 1); PG8_STAGE(PG8_SB(0, 0), b2, voffB); PG8_STAGE(PG8_SB(0, 1), b2 + hB, voffB); PG8_STAGE(PG8_SA(0, 0), a2, voffA);
            PG8_WAIT_V(8); PG8_WAIT_L(0); PG8_BAR; PG8_MMA(1, 0, At, B0); PG8_MMA(1, 1, At, B1); PG8_BAR; PG8_SCHED;
            PG8_LDB(B0, 1, 0); PG8_LDB(B1, 1, 1); PG8_SCHED; PG8_LDA(At, 1, 0); PG8_STAGE(PG8_SA(0, 1), a2 + hA, voffA);
            PG8_WAIT_V(8); PG8_WAIT_L(0); PG8_BAR; PG8_MMA(0, 0, At, B0); PG8_MMA(0, 1, At, B1); PG8_BAR; PG8_SCHED;
            PG8_LDA(At, 1, 1); PG8_STAGE(PG8_SB(1, 0), b3, voffB); PG8_STAGE(PG8_SB(1, 1), b3 + hB, voffB); PG8_STAGE(PG8_SA(1, 0), a3, voffA);
            PG8_WAIT_V(8); PG8_WAIT_L(0); PG8_BAR; PG8_MMA(1, 0, At, B0); PG8_MMA(1, 1, At, B1); PG8_BAR; PG8_SCHED;
        }
        if constexpr (ALIGN_EPI) { if (wr == 0) PG8_BAR; }
        E(acc, cur, wr, wc, fr, fq);
        if (!has_next) break;
#pragma unroll
        for (int a = 0; a < 2; ++a)
#pragma unroll
            for (int b = 0; b < 2; ++b)
#pragma unroll
                for (int m = 0; m < 4; ++m)
#pragma unroll
                    for (int n = 0; n < 2; ++n) acc[a][b][m][n] = (f32x4){0.f, 0.f, 0.f, 0.f};
        cur = nxt; cA = nA; cB = nB; ++ui;
        if constexpr (ALIGN_EPI) { if (wr == 1) PG8_BAR; }
    }
    PG8_WAIT_V(0);
    if constexpr (!ALIGN_EPI) { if (wr == 0) PG8_BAR; }
    PG8_BAR;
#undef PG8_SA
#undef PG8_SB
#undef PG8_STAGE
#undef PG8_LDA
#undef PG8_LDB
#undef PG8_MMA
#undef PG8_WAIT_V
#undef PG8_WAIT_L
#undef PG8_BAR
#undef PG8_SCHED
}
}

typedef unsigned short bf16;
typedef float f32x4 __attribute__((ext_vector_type(4)));
typedef unsigned u32x4 __attribute__((ext_vector_type(4)));
typedef unsigned u32x2 __attribute__((ext_vector_type(2)));
constexpr int NB = 2, SEQ = 4096, DM = 2048, MTOK = NB * SEQ, DIN = 6656, DG = 512, NL = 2;
constexpr int LDS_BYTES = 147456;
constexpr int NTHR = 512;

constexpr int WROWS = 7680;
constexpr size_t WS_WIN = 0;
constexpr size_t WS_WOUT = WS_WIN + (size_t)NL * WROWS * DM * 2;
constexpr size_t WS_WCS = WS_WOUT + (size_t)NL * DM * DM * 2;
constexpr size_t WS_WFXB = WS_WCS + (size_t)NL * 1024 * DG * 2;
constexpr size_t WS_WPW = WS_WFXB + (size_t)NL * DM * DG * 2;
constexpr size_t WS_DC = WS_WPW + (size_t)NL * DG * DG * 2;
constexpr size_t WS_DS = WS_DC + (size_t)2304 * 2048 * 2;
constexpr size_t WS_PQF = WS_DS + (size_t)2048 * 2048 * 2;
constexpr size_t WS_ROPE = WS_PQF + (size_t)NB * DG * 2 * 2048 * 2;
constexpr size_t WS_MOD = WS_ROPE + (size_t)SEQ * 32 * 8;
constexpr size_t WS_U = WS_MOD + 131072;
constexpr size_t WS_PART = WS_U + (size_t)MTOK * DM * 2;
constexpr size_t WS_Z = WS_U + (size_t)4 * MTOK * DG * 4;
constexpr size_t WS_PQT = WS_Z + (size_t)MTOK * DIN * 2;
constexpr size_t WS_CVH = WS_PQT + (size_t)NB * DG * 2 * SEQ * 2;
constexpr size_t WS_CAT = WS_CVH + (size_t)MTOK * DG * 2;
constexpr size_t WS_KV = WS_CAT + (size_t)MTOK * DM * 2;
constexpr size_t WS_BAR = WS_KV + (size_t)2 * NB * 8 * 32 * 4096 * 4;
constexpr size_t WS_END = WS_BAR + 16384;

struct Params {
    const float* x; const float* c; const float* norm_g; const float* w_ada; const float* b_ada; const float* w_in; const float* w_fft; const float* na_bias;
    const float* rl_f; const float* rl_b; const float* conv_w; const float* conv_b; const float* ln_g; const float* ln_b; const float* w_pw; const float* w_out; const float* final_g;
    float* out; unsigned char* ws; int ph_lo, ph_hi;
};

#if defined(__HIP_DEVICE_COMPILE__)
typedef const __attribute__((address_space(4))) Params* KParams;
__device__ __forceinline__ KParams kparams() { KParams k = (KParams)__builtin_amdgcn_kernarg_segment_ptr(); asm volatile("" : "+s"(k)); return k; }
#else
typedef const Params* KParams;
__device__ __forceinline__ KParams kparams() { return nullptr; }
#endif
__device__ __forceinline__ unsigned f2bf(float f) { unsigned u = __float_as_uint(f); return (u + 0x7fffu + ((u >> 16) & 1u)) >> 16; }
__device__ __forceinline__ unsigned pk2(float lo, float hi) { return f2bf(lo) | (f2bf(hi) << 16); }
__device__ __forceinline__ float bf2f(bf16 b) { return __uint_as_float((unsigned)b << 16); }
__device__ __forceinline__ float bflo(unsigned u) { return __uint_as_float(u << 16); }
__device__ __forceinline__ float bfhi(unsigned u) { return __uint_as_float(u & 0xffff0000u); }
__device__ __forceinline__ float silu_f(float v) { return v / (1.f + __expf(-v)); }
__device__ __forceinline__ float wave_sum(float v) {
#pragma unroll
    for (int o = 1; o < 64; o <<= 1) v += __shfl_xor(v, o);
    return v;
}
__device__ __forceinline__ float wave_max(float v) {
#pragma unroll
    for (int o = 1; o < 64; o <<= 1) v = fmaxf(v, __shfl_xor(v, o));
    return v;
}

struct SchedS {
    pg8::StaticOrder o; const char* A; const char* B; size_t ta, tb;
    __device__ __forceinline__ bool next(int i, pg8::Unit& u) const { if (!o.next(i, u)) return false; u.A = A + (size_t)u.pm * ta; u.B = B + (size_t)u.pn * tb; u.aux = 0; return true; }
};
__device__ __forceinline__ SchedS make_sched(const void* A, int lda, const void* B, int ldb, int M, int N, int shift = 0) {
    SchedS s; s.o.init(M, N, (int)gridDim.x, (int)((obid() + gridDim.x - shift) % gridDim.x)); s.A = (const char*)A; s.B = (const char*)B; s.ta = (size_t)256 * lda * 2; s.tb = (size_t)256 * ldb * 2; return s;
}
struct SchedZ {
    pg8::StaticOrder o; const char* A; const char* B; int late;
    __device__ __forceinline__ bool next(int i, pg8::Unit& u) const { if (!o.next(i, u)) return false; const int jn = u.pn;
        u.pn = late ? (jn < 2 ? 2 + jn : 22 + jn) : (jn < 20 ? jn + 4 : jn + 6);
        u.A = A + (size_t)u.pm * (256 * DM * 2); u.B = B + (size_t)u.pn * (256 * DM * 2); u.aux = 0; return true; }
};
struct SchedDFT {
    const char* DC; const char* PQF; int G, c;
    __device__ __forceinline__ bool next(int i, pg8::Unit& u) const {
        if (c < 0) return false;
        const int L = __builtin_amdgcn_readfirstlane(i * G + c); if (L >= 64) return false;
        const int b = L >> 5, t = L & 31, odd = t >> 4, tt = t & 15; u.pm = tt >> 1; u.pn = tt & 1; u.aux = b * 2 + odd;
        u.A = DC + (size_t)odd * (WS_DS - WS_DC) + (size_t)u.pm * (256 * 2048 * 2);
        u.B = PQF + ((size_t)(b * 512 + u.pn * 256) * 4096 + odd * 2048) * 2; return true;
    }
};

struct EpiZ {
    static constexpr bool PERM = true;
    bf16* O; int ldc;
    __device__ __forceinline__ void operator()(const pg8::f32x4 (&acc)[2][2][4][2], const pg8::Unit& u, int wr, int wc, int fr, int fq) const {
        const int row0 = u.pm * 256 + wr * 64 + fr, col0 = u.pn * 256 + wc * 32 + 8 * fq;
#pragma unroll
        for (int ai = 0; ai < 2; ++ai)
#pragma unroll
            for (int m = 0; m < 4; ++m) { bf16* rowp = O + (size_t)(row0 + ai * 128 + m * 16) * ldc + col0;
#pragma unroll
                for (int bj = 0; bj < 2; ++bj) { const pg8::f32x4 v0 = acc[ai][bj][m][0], v1 = acc[ai][bj][m][1]; u32x4 w;
                    w.x = pg8::cvt_pk_bf16(v0[0], v0[1]); w.y = pg8::cvt_pk_bf16(v0[2], v0[3]); w.z = pg8::cvt_pk_bf16(v1[0], v1[1]); w.w = pg8::cvt_pk_bf16(v1[2], v1[3]);
                    *(u32x4*)(rowp + bj * 128) = w; } }
    }
};
struct EpiZ2 {
    static constexpr bool PERM = true;
    bf16* O; bf16* PQ;
    __device__ __forceinline__ void operator()(const pg8::f32x4 (&acc)[2][2][4][2], const pg8::Unit& u, int wr, int wc, int fr, int fq) const {
        const int row0 = u.pm * 256 + wr * 64 + fr;
        if (u.pn < 26) { const int col0 = u.pn * 256 + wc * 32 + 8 * fq;
#pragma unroll
            for (int ai = 0; ai < 2; ++ai)
#pragma unroll
                for (int m = 0; m < 4; ++m) { bf16* rowp = O + (size_t)(row0 + ai * 128 + m * 16) * DIN + col0;
#pragma unroll
                    for (int bj = 0; bj < 2; ++bj) { const pg8::f32x4 v0 = acc[ai][bj][m][0], v1 = acc[ai][bj][m][1]; u32x4 w;
                        w.x = pg8::cvt_pk_bf16(v0[0], v0[1]); w.y = pg8::cvt_pk_bf16(v0[2], v0[3]); w.z = pg8::cvt_pk_bf16(v1[0], v1[1]); w.w = pg8::cvt_pk_bf16(v1[2], v1[3]);
                        *(u32x4*)(rowp + bj * 128) = w; } }
        } else { const int np0 = (u.pn - 26) * 256 + wc * 32 + 8 * fq;
#pragma unroll
            for (int bj = 0; bj < 2; ++bj) { const int np = np0 + bj * 128, pq = np >> 9, n = np & 511;
#pragma unroll
                for (int ai = 0; ai < 2; ++ai)
#pragma unroll
                    for (int m = 0; m < 4; ++m) { const int row = row0 + ai * 128 + m * 16, b = row >> 12, sq = row & 4095;
                        bf16* dst = PQ + ((size_t)(b * 512 + n) * 2 + pq) * 4096 + sq;
#pragma unroll
                        for (int nn = 0; nn < 2; ++nn)
#pragma unroll
                            for (int j = 0; j < 4; ++j) dst[(size_t)(4 * nn + j) * 8192] = (bf16)f2bf(acc[ai][bj][m][nn][j]); } }
        }
    }
};
struct EpiGate {
    static constexpr bool PERM = true;
    bf16* O; const bf16* Z; int coff, goff;
    __device__ __forceinline__ void operator()(const pg8::f32x4 (&acc)[2][2][4][2], const pg8::Unit& u, int wr, int wc, int fr, int fq) const {
        const int row0 = u.pm * 256 + wr * 64 + fr, col0 = u.pn * 256 + wc * 32 + 8 * fq;
#pragma unroll
        for (int ai = 0; ai < 2; ++ai)
#pragma unroll
            for (int m = 0; m < 4; ++m) { const size_t row = (size_t)(row0 + ai * 128 + m * 16);
#pragma unroll
                for (int bj = 0; bj < 2; ++bj) { const pg8::f32x4 v0 = acc[ai][bj][m][0], v1 = acc[ai][bj][m][1];
                    const u32x4 gz = *(const u32x4*)(Z + row * DIN + goff + col0 + bj * 128); u32x4 w;
                    w.x = pg8::cvt_pk_bf16(v0[0] * silu_f(bflo(gz.x)), v0[1] * silu_f(bfhi(gz.x))); w.y = pg8::cvt_pk_bf16(v0[2] * silu_f(bflo(gz.y)), v0[3] * silu_f(bfhi(gz.y)));
                    w.z = pg8::cvt_pk_bf16(v1[0] * silu_f(bflo(gz.z)), v1[1] * silu_f(bfhi(gz.z))); w.w = pg8::cvt_pk_bf16(v1[2] * silu_f(bflo(gz.w)), v1[3] * silu_f(bfhi(gz.w)));
                    *(u32x4*)(O + row * DM + coff + col0 + bj * 128) = w; } }
    }
};
struct EpiPart {
    static constexpr bool PERM = false;
    float* P;
    __device__ __forceinline__ void operator()(const pg8::f32x4 (&acc)[2][2][4][2], const pg8::Unit& u, int wr, int wc, int fr, int fq) const {
        const int row0 = u.pm * 256 + wr * 64 + fr, col0 = u.pn * 256 + wc * 32 + 4 * fq;
        float* base = (u.aux & 1) ? P + (size_t)2 * 2304 * 512 + (size_t)(u.aux >> 1) * 2048 * 512 : P + (size_t)(u.aux >> 1) * 2304 * 512;
#pragma unroll
        for (int ai = 0; ai < 2; ++ai)
#pragma unroll
            for (int m = 0; m < 4; ++m) { float* rowp = base + (size_t)(row0 + ai * 128 + m * 16) * 512 + col0;
#pragma unroll
                for (int bj = 0; bj < 2; ++bj)
#pragma unroll
                    for (int n = 0; n < 2; ++n) *(pg8::f32x4*)(rowp + bj * 128 + n * 16) = acc[ai][bj][m][n]; }
    }
};
struct EpiRes {
    static constexpr bool PERM = false;
    const float* xin; float* xout; const float* gate;
    __device__ __forceinline__ void operator()(const pg8::f32x4 (&acc)[2][2][4][2], const pg8::Unit& u, int wr, int wc, int fr, int fq) const {
        const int row0 = u.pm * 256 + wr * 64 + fr, col0 = u.pn * 256 + wc * 32 + 4 * fq;
        const float* gp = gate + (size_t)(u.pm >> 4) * 6144 + col0;
        pg8::f32x4 gv[2][2];
#pragma unroll
        for (int bj = 0; bj < 2; ++bj)
#pragma unroll
            for (int n = 0; n < 2; ++n) gv[bj][n] = *(const pg8::f32x4*)(gp + bj * 128 + n * 16);
#pragma unroll
        for (int ai = 0; ai < 2; ++ai)
#pragma unroll
            for (int m = 0; m < 4; ++m) { const size_t ro = (size_t)(row0 + ai * 128 + m * 16) * DM + col0;
#pragma unroll
                for (int bj = 0; bj < 2; ++bj)
#pragma unroll
                    for (int n = 0; n < 2; ++n) { const pg8::f32x4 xi = *(const pg8::f32x4*)(xin + ro + bj * 128 + n * 16);
                        *(pg8::f32x4*)(xout + ro + bj * 128 + n * 16) = xi + gv[bj][n] * acc[ai][bj][m][n]; } }
    }
};

struct TPItem { const float* src; bf16* dst; int N, K; };
__device__ __forceinline__ TPItem tp_decode(const Params& p, int it, int tid) {
    constexpr int T_IN = 32 * 96, T_OUT = 32 * 32, T_S = 64, T_L = T_IN + T_OUT + T_S;
    const int l = it / T_L; int r = it % T_L; const float* W; bf16* WT; int K, N, kb, nb;
    if (r < T_IN) { W = p.w_in + (size_t)l * DM * DIN; WT = (bf16*)(p.ws + WS_WIN) + (size_t)l * WROWS * DM; K = DM; N = DIN; kb = r / 96; nb = 8 + r % 96; }
    else if (r < T_IN + T_OUT) { r -= T_IN; W = p.w_out + (size_t)l * DM * DM; WT = (bf16*)(p.ws + WS_WOUT) + (size_t)l * DM * DM; K = DM; N = DM; kb = r >> 5; nb = r & 31; }
    else { r -= T_IN + T_OUT; W = p.w_pw + (size_t)l * DG * DG; WT = (bf16*)(p.ws + WS_WPW) + (size_t)l * DG * DG; K = DG; N = DG; kb = r >> 3; nb = r & 7; }
    TPItem t; t.N = N; t.K = K;
    t.src = W + (size_t)(kb * 64 + (tid >> 4)) * N + nb * 64 + (tid & 15) * 4;
    t.dst = WT + (size_t)(nb * 64 + (tid >> 3)) * K + kb * 64 + (tid & 7) * 8;
    return t;
}
__device__ __forceinline__ void tp_store(const TPItem& t, int tid, const f32x4& v0, const f32x4& v1, float* scr) {
    { const int kk = tid >> 4, nn = (tid & 15) * 4;
      scr[kk * 65 + nn] = v0[0]; scr[kk * 65 + nn + 1] = v0[1]; scr[kk * 65 + nn + 2] = v0[2]; scr[kk * 65 + nn + 3] = v0[3];
      scr[(kk + 32) * 65 + nn] = v1[0]; scr[(kk + 32) * 65 + nn + 1] = v1[1]; scr[(kk + 32) * 65 + nn + 2] = v1[2]; scr[(kk + 32) * 65 + nn + 3] = v1[3]; }
    __syncthreads();
    { const int n = tid >> 3, kc = (tid & 7) * 8; const float* s = scr + kc * 65 + n; u32x4 o;
      o.x = pk2(s[0], s[65]); o.y = pk2(s[2 * 65], s[3 * 65]); o.z = pk2(s[4 * 65], s[5 * 65]); o.w = pk2(s[6 * 65], s[7 * 65]);
      *(u32x4*)t.dst = o; }
    __syncthreads();
}

__device__ __forceinline__ void ph_prologue(const Params& p_, unsigned char* lds) {
    const Params p = *kparams(); (void)p_;
    const int tid = otid(), lane = tid & 63, wave = tid >> 6, G = gridDim.x, bid = obid();
    float* scr = (float*)lds;
    { constexpr int T_TOT = NL * (32 * 96 + 32 * 32 + 64);
      int it = bid; TPItem cur; f32x4 a0, a1;
      if (it < T_TOT) { cur = tp_decode(p, it, tid); a0 = __builtin_nontemporal_load((const f32x4*)cur.src); a1 = __builtin_nontemporal_load((const f32x4*)(cur.src + (size_t)32 * cur.N)); }
      while (it < T_TOT) { const int nit = it + G; TPItem nxt = cur; f32x4 b0 = a0, b1 = a1;
          if (nit < T_TOT) { nxt = tp_decode(p, nit, tid); b0 = __builtin_nontemporal_load((const f32x4*)nxt.src); b1 = __builtin_nontemporal_load((const f32x4*)(nxt.src + (size_t)32 * nxt.N)); }
          tp_store(cur, tid, a0, a1, scr);
          cur = nxt; a0 = b0; a1 = b1; it = nit; } }
    { bf16* Wfx = (bf16*)(p.ws + WS_WFXB);
      for (int e = bid * NTHR + tid; e < NL * DM * DG / 8; e += G * NTHR) { const int l = e >> 17, r = e & 131071, k = r >> 6, c8 = (r & 63) * 8;
          const float* src = p.w_in + ((size_t)l * DM + k) * DIN + c8; const f32x4 a = *(const f32x4*)src, b4 = *(const f32x4*)(src + 4);
          u32x4 o; o.x = pk2(a[0], a[1]); o.y = pk2(a[2], a[3]); o.z = pk2(b4[0], b4[1]); o.w = pk2(b4[2], b4[3]);
          *(u32x4*)(Wfx + ((size_t)l * DM + k) * DG + c8) = o; } }
    { float* Wl = (float*)lds; float* tr = Wl + 128 * 65; bf16* Wcs = (bf16*)(p.ws + WS_WCS);
      for (int t2 = G - 1 - bid; t2 < 256; t2 += G) {
          const int t = t2 >> 1, ch = t2 & 1, l = t >> 6, pq = (t >> 5) & 1, g = (t >> 3) & 3, n0 = (t & 7) * 64;
#pragma unroll
          for (int i = 0; i < 4; ++i) { const int m = (tid >> 4) + 32 * i, nn = (tid & 15) * 4;
              const f32x4 v = *(const f32x4*)(p.w_fft + ((size_t)l * DG + g * 128 + m) * DG + n0 + nn);
              Wl[m * 65 + nn] = v[0]; Wl[m * 65 + nn + 1] = v[1]; Wl[m * 65 + nn + 2] = v[2]; Wl[m * 65 + nn + 3] = v[3]; }
          if (tid < 128) tr[tid] = pq ? sinpif((float)tid * (1.f / 64.f)) : cospif((float)tid * (1.f / 64.f));
          __syncthreads();
          const int nn = tid >> 3, cc = ch * 64 + (tid & 7) * 8; float acc[8];
#pragma unroll
          for (int i = 0; i < 8; ++i) acc[i] = 0.f;
#pragma unroll 4
          for (int m = 0; m < 128; ++m) { const float w = Wl[m * 65 + nn];
#pragma unroll
              for (int i = 0; i < 8; ++i) acc[i] += tr[((cc + i) * m) & 127] * w; }
          const float nrm = 0.0013810679320049757f;
          u32x4 o0;
          o0.x = pk2(acc[0] * nrm, acc[1] * nrm); o0.y = pk2(acc[2] * nrm, acc[3] * nrm); o0.z = pk2(acc[4] * nrm, acc[5] * nrm); o0.w = pk2(acc[6] * nrm, acc[7] * nrm);
          *(u32x4*)(Wcs + ((size_t)l * 1024 + pq * 512 + n0 + nn) * DG + g * 128 + cc) = o0;
          __syncthreads();
      } }
    __syncthreads();
    float* cosT = (float*)(lds + 32768); float* sinT = (float*)(lds + 49152); float* ca = (float*)(lds + 65536); float* red = (float*)(lds + 81920);
    for (int j = tid; j < 4096; j += NTHR) { cosT[j] = cospif((float)j * (1.f / 2048.f)); sinT[j] = sinpif((float)j * (1.f / 2048.f)); }
    for (int j = tid; j < 4096; j += NTHR) { const float cv = p.c[j]; ca[j] = cv / (1.f + expf(-cv)); }
    __syncthreads();
    { bf16* DC = (bf16*)(p.ws + WS_DC); bf16* DSm = (bf16*)(p.ws + WS_DS);
      for (int r = bid * 2 + (tid >> 8); r < 4352; r += G * 2) { const int is_sin = (r >= 2304) ? 1 : 0, k = is_sin ? r - 2304 : r, s0 = (tid & 255) * 8; float v[8];
#pragma unroll
          for (int j = 0; j < 8; ++j) { const int idx = (k * (s0 + j)) & 4095; v[j] = is_sin ? sinT[idx] : cosT[idx]; }
          u32x4 o; o.x = pk2(v[0], v[1]); o.y = pk2(v[2], v[3]); o.z = pk2(v[4], v[5]); o.w = pk2(v[6], v[7]);
          *(u32x4*)((is_sin ? DSm : DC) + (size_t)k * 2048 + s0) = o; } }
    { float2* rope = (float2*)(p.ws + WS_ROPE);
      for (int e = bid * NTHR + tid; e < 4096 * 32; e += G * NTHR) { const int s = e >> 5, i = e & 31;
          const float inv = (float)pow(10000.0, -(double)i / 32.0); const float ang = (float)s * inv;
          double sn, cs; sincos((double)ang, &sn, &cs); rope[e] = make_float2((float)cs, (float)sn); } }
    float* mod = (float*)(p.ws + WS_MOD);
    for (int t = bid; t < 192; t += G) {
        const int l = t / 96, col = (t % 96) * 64 + lane; const float* W = p.w_ada + (size_t)l * DM * 6144 + col;
        float a0 = 0.f, a1 = 0.f;
        for (int k0 = wave * 256; k0 < wave * 256 + 256; k0 += 32) { float wv[32];
#pragma unroll
            for (int j = 0; j < 32; ++j) wv[j] = __builtin_nontemporal_load(W + (size_t)(k0 + j) * 6144);
            asm volatile("" ::: "memory");
#pragma unroll
            for (int j = 0; j < 32; ++j) { a0 += ca[k0 + j] * wv[j]; a1 += ca[2048 + k0 + j] * wv[j]; } }
        red[(wave * 2 + 0) * 64 + lane] = a0; red[(wave * 2 + 1) * 64 + lane] = a1;
        __syncthreads();
        if (wave < 2) { float s = 0.f;
#pragma unroll
            for (int w = 0; w < 8; ++w) s += red[(w * 2 + wave) * 64 + lane];
            mod[(size_t)(l * 2 + wave) * 6144 + col] = s + p.b_ada[l * 6144 + col]; }
        __syncthreads();
    }
}

__device__ __forceinline__ void ph_norm(const Params& p_, int l, int skip_blocks) {
    const Params p = *kparams(); (void)p_;
    const int tid = otid(), lane = tid & 63, wave = tid >> 6;
    const float* xin = (l == 0) ? p.x : p.out; bf16* h = (bf16*)(p.ws + WS_U); const float* mod = (const float*)(p.ws + WS_MOD);
    const int stride = gridDim.x * 8; const float* g = p.norm_g + l * DM;
    if (stride == 2048) {
        const int nw = (256 - skip_blocks) * 8;
        for (int pi = (obid() - skip_blocks) * 8 + wave; pi >= 0 && pi < 4096; pi += nw) {
            const int row = (pi >> 11) * 4096 + (pi & 2047);
            const f32x4* xr0 = (const f32x4*)(xin + (size_t)row * DM) + lane; const f32x4* xr1 = (const f32x4*)(xin + (size_t)(row + stride) * DM) + lane;
            const float* md = mod + (size_t)(l * 2 + (row >> 12)) * 6144;
            f32x4 v0[8], v1[8], ca[8], cb[8];
#pragma unroll
            for (int j = 0; j < 8; ++j) { v0[j] = xr0[64 * j]; v1[j] = xr1[64 * j]; }
#pragma unroll
            for (int j = 0; j < 8; ++j) { const int col = (64 * j + lane) * 4; ca[j] = *(const f32x4*)(g + col) * (*(const f32x4*)(md + 2048 + col) + 1.f); cb[j] = *(const f32x4*)(md + col); }
            asm volatile("" ::: "memory");
            float s0 = 0.f, s1 = 0.f;
#pragma unroll
            for (int j = 0; j < 8; ++j) { s0 += (v0[j][0] * v0[j][0] + v0[j][1] * v0[j][1]) + (v0[j][2] * v0[j][2] + v0[j][3] * v0[j][3]); s1 += (v1[j][0] * v1[j][0] + v1[j][1] * v1[j][1]) + (v1[j][2] * v1[j][2] + v1[j][3] * v1[j][3]); }
            s0 = wave_sum(s0); s1 = wave_sum(s1);
            const float r0 = rsqrtf(s0 * (1.f / DM) + 1e-6f), r1 = rsqrtf(s1 * (1.f / DM) + 1e-6f);
#pragma unroll
            for (int j = 0; j < 8; ++j) { const int col = (64 * j + lane) * 4;
                const f32x4 o0 = (v0[j] * r0) * ca[j] + cb[j], o1 = (v1[j] * r1) * ca[j] + cb[j]; u32x2 w;
                w.x = pk2(o0[0], o0[1]); w.y = pk2(o0[2], o0[3]); *(u32x2*)(h + (size_t)row * DM + col) = w;
                w.x = pk2(o1[0], o1[1]); w.y = pk2(o1[2], o1[3]); *(u32x2*)(h + (size_t)(row + stride) * DM + col) = w; }
        }
        return;
    }
    for (int row = obid() * 8 + wave; row < MTOK; row += stride) {
        const f32x4* xr = (const f32x4*)(xin + (size_t)row * DM) + lane; f32x4 v[8]; float ss = 0.f;
#pragma unroll
        for (int j = 0; j < 8; ++j) { v[j] = xr[64 * j]; ss += (v[j][0] * v[j][0] + v[j][1] * v[j][1]) + (v[j][2] * v[j][2] + v[j][3] * v[j][3]); }
        ss = wave_sum(ss); const float rstd = rsqrtf(ss * (1.f / DM) + 1e-6f);
        const float* md = mod + (size_t)(l * 2 + (row >> 12)) * 6144;
#pragma unroll
        for (int j = 0; j < 8; ++j) { const int col = (64 * j + lane) * 4;
            const f32x4 g4 = *(const f32x4*)(g + col), sh = *(const f32x4*)(md + col), sc = *(const f32x4*)(md + 2048 + col);
            const f32x4 o = (v[j] * rstd * g4) * (sc + 1.f) + sh; u32x2 w; w.x = pk2(o[0], o[1]); w.y = pk2(o[2], o[3]);
            *(u32x2*)(h + (size_t)row * DM + col) = w; }
    }
}
__device__ __forceinline__ void ph_final(const Params& p_) {
    const Params p = *kparams(); (void)p_;
    const int tid = otid(), lane = tid & 63, wave = tid >> 6;
    const int stride = gridDim.x * 8;
    for (int row = obid() * 8 + wave; row < MTOK; row += 2 * stride) {
        const bool two = (row + stride < MTOK);
        f32x4* xr0 = (f32x4*)(p.out + (size_t)row * DM) + lane; f32x4* xr1 = (f32x4*)(p.out + (size_t)(two ? row + stride : row) * DM) + lane;
        f32x4 v0[8], v1[8], g4[8];
#pragma unroll
        for (int j = 0; j < 8; ++j) { v0[j] = xr0[64 * j]; v1[j] = xr1[64 * j]; g4[j] = *(const f32x4*)(p.final_g + (64 * j + lane) * 4); }
        asm volatile("" ::: "memory");
        float s0 = 0.f, s1 = 0.f;
#pragma unroll
        for (int j = 0; j < 8; ++j) { s0 += (v0[j][0] * v0[j][0] + v0[j][1] * v0[j][1]) + (v0[j][2] * v0[j][2] + v0[j][3] * v0[j][3]); s1 += (v1[j][0] * v1[j][0] + v1[j][1] * v1[j][1]) + (v1[j][2] * v1[j][2] + v1[j][3] * v1[j][3]); }
        s0 = wave_sum(s0); s1 = wave_sum(s1);
        const float r0 = rsqrtf(s0 * (1.f / DM) + 1e-6f), r1 = rsqrtf(s1 * (1.f / DM) + 1e-6f);
#pragma unroll
        for (int j = 0; j < 8; ++j) { xr0[64 * j] = v0[j] * r0 * g4[j]; if (two) xr1[64 * j] = v1[j] * r1 * g4[j]; }
    }
}

#ifndef REP_PRO
#define REP_PRO 1
#endif
#ifndef REP_NORM
#define REP_NORM 1
#endif
#ifndef REP_Z
#define REP_Z 1
#endif
#ifndef REP_MIX
#define REP_MIX 1
#endif
#ifndef REP_P3
#define REP_P3 1
#endif
#ifndef REP_R2
#define REP_R2 1
#endif
#ifndef REP_CMB
#define REP_CMB 1
#endif
#ifndef REP_FFT
#define REP_FFT 1
#endif
#ifndef REP_OUT
#define REP_OUT 1
#endif
#ifndef REP_SUB
#define REP_SUB 1
#endif

#ifndef REP_R1
#define REP_R1 1
#endif
#ifndef REP_NA
#define REP_NA 1
#endif
#ifndef REP_CV
#define REP_CV 1
#endif
#ifndef REP_F1
#define REP_F1 1
#endif
#define REPEAT(n) for (int rep_ = 0; rep_ < (n); ++rep_)
typedef short bf16x8v __attribute__((ext_vector_type(8)));
__device__ __forceinline__ bf16x8v mk8(unsigned a, unsigned b, unsigned c, unsigned d) { u32x4 v = {a, b, c, d}; return __builtin_bit_cast(bf16x8v, v); }
#define MFMA16(a, b, c) __builtin_amdgcn_mfma_f32_16x16x32_bf16(a, b, c, 0, 0, 0)
constexpr int R_QS = 0, R_KS = 18432, R_VT = 36864, R_KTF = 54272, R_KTB = 71680, R_STF = 89088, R_STB = 98304;

template <bool R2>
__device__ __forceinline__ void ret_stage(const Params& p_, int b, int h, int n, unsigned char* lds, float l2f, float l2b) {
    const Params p = *kparams(); (void)p_;
    const int tid = otid(), j = tid >> 2, c4 = tid & 3, s = n * 128 + j;
    const bf16* Z = (const bf16*)(p.ws + WS_Z); const bf16* zr = Z + (size_t)(b * SEQ + s) * DIN;
    const f32x4* rp = (const f32x4*)((const float2*)(p.ws + WS_ROPE) + s * 32 + c4 * 8);
    f32x4 rr[4];
#pragma unroll
    for (int i = 0; i < 4; ++i) rr[i] = rp[i];
    const u32x4 ka = *(const u32x4*)(zr + 7 * DG + h * 64 + c4 * 8), kb = *(const u32x4*)(zr + 7 * DG + h * 64 + 32 + c4 * 8);
    const u32x4 va = *(const u32x4*)(zr + 8 * DG + h * 64 + c4 * 16), vb = *(const u32x4*)(zr + 8 * DG + h * 64 + c4 * 16 + 8);
    u32x4 qa = ka, qb = kb;
    if (R2) { qa = *(const u32x4*)(zr + 6 * DG + h * 64 + c4 * 8); qb = *(const u32x4*)(zr + 6 * DG + h * 64 + 32 + c4 * 8); }
    asm volatile("" ::: "memory");
    float cs[8], sn[8];
#pragma unroll
    for (int i = 0; i < 4; ++i) { const f32x4 r = rr[i]; cs[2 * i] = r[0]; sn[2 * i] = r[1]; cs[2 * i + 1] = r[2]; sn[2 * i + 1] = r[3]; }
    bf16* KS = (bf16*)(lds + R_KS); bf16* VT = (bf16*)(lds + R_VT);
    {
      const unsigned kau[4] = {ka.x, ka.y, ka.z, ka.w}, kbu[4] = {kb.x, kb.y, kb.z, kb.w};
      float k1[8], k2[8];
#pragma unroll
      for (int i = 0; i < 4; ++i) { const float a0 = bflo(kau[i]), a1 = bfhi(kau[i]), b0 = bflo(kbu[i]), b1 = bfhi(kbu[i]);
          k1[2 * i] = a0 * cs[2 * i] - b0 * sn[2 * i]; k2[2 * i] = a0 * sn[2 * i] + b0 * cs[2 * i];
          k1[2 * i + 1] = a1 * cs[2 * i + 1] - b1 * sn[2 * i + 1]; k2[2 * i + 1] = a1 * sn[2 * i + 1] + b1 * cs[2 * i + 1]; }
      u32x4 o1, o2; o1.x = pk2(k1[0], k1[1]); o1.y = pk2(k1[2], k1[3]); o1.z = pk2(k1[4], k1[5]); o1.w = pk2(k1[6], k1[7]);
      o2.x = pk2(k2[0], k2[1]); o2.y = pk2(k2[2], k2[3]); o2.z = pk2(k2[4], k2[5]); o2.w = pk2(k2[6], k2[7]);
      *(u32x4*)(KS + j * 72 + c4 * 8) = o1; *(u32x4*)(KS + j * 72 + 32 + c4 * 8) = o2;
      if (!R2) { bf16* KTF = (bf16*)(lds + R_KTF); bf16* KTB = (bf16*)(lds + R_KTB);
          const float df = exp2f(l2f * (float)(127 - j)), db = exp2f(l2b * (float)j);
#pragma unroll
          for (int i = 0; i < 8; ++i) { KTF[(c4 * 8 + i) * 136 + j] = (bf16)f2bf(k1[i] * df); KTF[(32 + c4 * 8 + i) * 136 + j] = (bf16)f2bf(k2[i] * df);
              KTB[(c4 * 8 + i) * 136 + j] = (bf16)f2bf(k1[i] * db); KTB[(32 + c4 * 8 + i) * 136 + j] = (bf16)f2bf(k2[i] * db); } } }
    {
      const unsigned vu[8] = {va.x, va.y, va.z, va.w, vb.x, vb.y, vb.z, vb.w};
#pragma unroll
      for (int i = 0; i < 8; ++i) { VT[(c4 * 16 + 2 * i) * 136 + j] = (bf16)(vu[i] & 0xffffu); VT[(c4 * 16 + 2 * i + 1) * 136 + j] = (bf16)(vu[i] >> 16); } }
    if (R2) { bf16* QS = (bf16*)(lds + R_QS);
      const unsigned qau[4] = {qa.x, qa.y, qa.z, qa.w}, qbu[4] = {qb.x, qb.y, qb.z, qb.w};
      float q1[8], q2[8];
#pragma unroll
      for (int i = 0; i < 4; ++i) { const float a0 = bflo(qau[i]), a1 = bfhi(qau[i]), b0 = bflo(qbu[i]), b1 = bfhi(qbu[i]);
          q1[2 * i] = (a0 * cs[2 * i] - b0 * sn[2 * i]) * 0.125f; q2[2 * i] = (a0 * sn[2 * i] + b0 * cs[2 * i]) * 0.125f;
          q1[2 * i + 1] = (a1 * cs[2 * i + 1] - b1 * sn[2 * i + 1]) * 0.125f; q2[2 * i + 1] = (a1 * sn[2 * i + 1] + b1 * cs[2 * i + 1]) * 0.125f; }
      u32x4 o1, o2; o1.x = pk2(q1[0], q1[1]); o1.y = pk2(q1[2], q1[3]); o1.z = pk2(q1[4], q1[5]); o1.w = pk2(q1[6], q1[7]);
      o2.x = pk2(q2[0], q2[1]); o2.y = pk2(q2[2], q2[3]); o2.z = pk2(q2[4], q2[5]); o2.w = pk2(q2[6], q2[7]);
      *(u32x4*)(QS + j * 72 + c4 * 8) = o1; *(u32x4*)(QS + j * 72 + 32 + c4 * 8) = o2; }
}

__device__ __forceinline__ void ret1_task(const Params& p_, int l, int task, unsigned char* lds) {
    const Params p = *kparams(); (void)p_;
    const int n = task & 31, h = (task >> 5) & 7, b = task >> 8;
    const float xf = p.rl_f[l * 8 + h], xb = p.rl_b[l * 8 + h];
    const float l2f = -log1pf(expf(-xf)) * 1.4426950408889634f, l2b = -log1pf(expf(-xb)) * 1.4426950408889634f;
    ret_stage<false>(p, b, h, n, lds, l2f, l2b);
    __syncthreads();
    const int tid = otid(), lane = tid & 63, w = tid >> 6, fr = lane & 15, fq = lane >> 4, dir = w >> 2, et = w & 3;
    const bf16* VT = (const bf16*)(lds + R_VT); const bf16* KT = (const bf16*)(lds + (dir ? R_KTB : R_KTF));
    bf16x8v a[4];
#pragma unroll
    for (int ks = 0; ks < 4; ++ks) a[ks] = *(const bf16x8v*)(VT + (16 * et + fr) * 136 + 32 * ks + 8 * fq);
    float* dst = (float*)(p.ws + WS_KV) + ((size_t)((dir * 2 + b) * 8 + h) * 32 + n) * 4096;
#pragma unroll
    for (int dt = 0; dt < 4; ++dt) { f32x4 acc = {0.f, 0.f, 0.f, 0.f};
#pragma unroll
        for (int ks = 0; ks < 4; ++ks) { const bf16x8v bfr = *(const bf16x8v*)(KT + (16 * dt + fr) * 136 + 32 * ks + 8 * fq); acc = MFMA16(a[ks], bfr, acc); }
#pragma unroll
        for (int r = 0; r < 4; ++r) dst[(16 * et + 4 * fq + r) * 64 + 16 * dt + fr] = acc[r]; }
    __syncthreads();
}

__device__ __forceinline__ void ret2_task(const Params& p_, int l, int task, unsigned char* lds) {
    const Params p = *kparams(); (void)p_;
    const int n = task & 31, h = (task >> 5) & 7, b = task >> 8;
    const float xf = p.rl_f[l * 8 + h], xb = p.rl_b[l * 8 + h];
    const float l2f = -log1pf(expf(-xf)) * 1.4426950408889634f, l2b = -log1pf(expf(-xb)) * 1.4426950408889634f;
    ret_stage<true>(p, b, h, n, lds, l2f, l2b);
    const int tid = otid(), lane = tid & 63, w = tid >> 6, fr = lane & 15, fq = lane >> 4;
    {
      const float gfC = exp2f(l2f * 128.f), gbC = exp2f(l2b * 128.f);
      const float* KVf = (const float*)(p.ws + WS_KV) + ((size_t)((0 * 2 + b) * 8 + h) * 32) * 4096 + tid * 8;
      const float* KVb = (const float*)(p.ws + WS_KV) + ((size_t)((1 * 2 + b) * 8 + h) * 32) * 4096 + tid * 8;
      f32x4 f0 = {0.f, 0.f, 0.f, 0.f}, f1 = f0, g0 = f0, g1 = f0;
      { float c0 = 1.f; int m = n - 1;
        for (; m >= 7; m -= 8) { f32x4 xa[8], xb[8];
#pragma unroll
            for (int j = 0; j < 8; ++j) { xa[j] = *(const f32x4*)(KVf + (size_t)(m - j) * 4096); xb[j] = *(const f32x4*)(KVf + (size_t)(m - j) * 4096 + 4); }
            asm volatile("" ::: "memory");
#pragma unroll
            for (int j = 0; j < 8; ++j) { f0 += xa[j] * c0; f1 += xb[j] * c0; c0 *= gfC; } }
        for (; m >= 0; --m) { const f32x4 x0 = *(const f32x4*)(KVf + (size_t)m * 4096), x1 = *(const f32x4*)(KVf + (size_t)m * 4096 + 4); f0 += x0 * c0; f1 += x1 * c0; c0 *= gfC; } }
      { float c0 = 1.f; int m = n + 1;
        for (; m + 7 < 32; m += 8) { f32x4 xa[8], xb[8];
#pragma unroll
            for (int j = 0; j < 8; ++j) { xa[j] = *(const f32x4*)(KVb + (size_t)(m + j) * 4096); xb[j] = *(const f32x4*)(KVb + (size_t)(m + j) * 4096 + 4); }
            asm volatile("" ::: "memory");
#pragma unroll
            for (int j = 0; j < 8; ++j) { g0 += xa[j] * c0; g1 += xb[j] * c0; c0 *= gbC; } }
        for (; m < 32; ++m) { const f32x4 x0 = *(const f32x4*)(KVb + (size_t)m * 4096), x1 = *(const f32x4*)(KVb + (size_t)m * 4096 + 4); g0 += x0 * c0; g1 += x1 * c0; c0 *= gbC; } }
      const int e = tid >> 3, d0 = (tid & 7) * 8; u32x4 o;
      o.x = pk2(f0[0], f0[1]); o.y = pk2(f0[2], f0[3]); o.z = pk2(f1[0], f1[1]); o.w = pk2(f1[2], f1[3]); *(u32x4*)((bf16*)(lds + R_STF) + e * 72 + d0) = o;
      o.x = pk2(g0[0], g0[1]); o.y = pk2(g0[2], g0[3]); o.z = pk2(g1[0], g1[1]); o.w = pk2(g1[2], g1[3]); *(u32x4*)((bf16*)(lds + R_STB) + e * 72 + d0) = o; }
    __syncthreads();
    const bf16* QS = (const bf16*)(lds + R_QS); const bf16* KS = (const bf16*)(lds + R_KS); const bf16* VT = (const bf16*)(lds + R_VT);
    const bf16* STF = (const bf16*)(lds + R_STF); const bf16* STB = (const bf16*)(lds + R_STB);
    bf16x8v qf[2];
#pragma unroll
    for (int ks = 0; ks < 2; ++ks) qf[ks] = *(const bf16x8v*)(QS + (16 * w + fr) * 72 + 32 * ks + 8 * fq);
    const int ai = 16 * w + fr;
    unsigned pp[8][2];
#pragma unroll
    for (int jt = 0; jt < 8; ++jt) { f32x4 acc = {0.f, 0.f, 0.f, 0.f};
#pragma unroll
        for (int ks = 0; ks < 2; ++ks) { const bf16x8v kf = *(const bf16x8v*)(KS + (16 * jt + fr) * 72 + 32 * ks + 8 * fq); acc = MFMA16(kf, qf[ks], acc); }
        float sc[4];
#pragma unroll
        for (int r = 0; r < 4; ++r) { const int aj = 16 * jt + 4 * fq + r; const float wg = (aj <= ai) ? exp2f(l2f * (float)(ai - aj)) : exp2f(l2b * (float)(aj - ai)); sc[r] = acc[r] * wg; }
        pp[jt][0] = pk2(sc[0], sc[1]); pp[jt][1] = pk2(sc[2], sc[3]); }
    const float qdf = exp2f(l2f * (float)(ai + 1)), qdb = exp2f(l2b * (float)(128 - ai));
    f32x4 tot[4]; float ss = 0.f;
#pragma unroll
    for (int et = 0; et < 4; ++et) { f32x4 o = {0.f, 0.f, 0.f, 0.f}, cfa = o, cba = o;
#pragma unroll
        for (int t = 0; t < 4; ++t) { const u32x2 vlo = *(const u32x2*)(VT + (16 * et + fr) * 136 + 32 * t + 4 * fq), vhi = *(const u32x2*)(VT + (16 * et + fr) * 136 + 32 * t + 16 + 4 * fq);
            o = MFMA16(mk8(vlo.x, vlo.y, vhi.x, vhi.y), mk8(pp[2 * t][0], pp[2 * t][1], pp[2 * t + 1][0], pp[2 * t + 1][1]), o); }
#pragma unroll
        for (int ks = 0; ks < 2; ++ks) { const bf16x8v sf = *(const bf16x8v*)(STF + (16 * et + fr) * 72 + 32 * ks + 8 * fq), sb = *(const bf16x8v*)(STB + (16 * et + fr) * 72 + 32 * ks + 8 * fq);
            cfa = MFMA16(sf, qf[ks], cfa); cba = MFMA16(sb, qf[ks], cba); }
        tot[et] = o + cfa * qdf + cba * qdb;
        ss += (tot[et][0] * tot[et][0] + tot[et][1] * tot[et][1]) + (tot[et][2] * tot[et][2] + tot[et][3] * tot[et][3]); }
    ss += __shfl_xor(ss, 16); ss += __shfl_xor(ss, 32);
    const float rs = rsqrtf(ss * (1.f / 64.f) + 1e-6f);
    const size_t tok = (size_t)b * SEQ + n * 128 + ai;
    const bf16* Z = (const bf16*)(p.ws + WS_Z); bf16* CAT = (bf16*)(p.ws + WS_CAT);
#pragma unroll
    for (int et = 0; et < 4; ++et) { const u32x2 gz = *(const u32x2*)(Z + tok * DIN + 9 * DG + h * 64 + 16 * et + 4 * fq); u32x2 o;
        o.x = pk2(tot[et][0] * rs * silu_f(bflo(gz.x)), tot[et][1] * rs * silu_f(bfhi(gz.x))); o.y = pk2(tot[et][2] * rs * silu_f(bflo(gz.y)), tot[et][3] * rs * silu_f(bfhi(gz.y)));
        *(u32x2*)(CAT + tok * DM + 1024 + h * 64 + 16 * et + 4 * fq) = o; }
    __syncthreads();
}

__device__ __forceinline__ void na2_task(const Params& p_, int l, int task, unsigned char* lds) {
    const Params p = *kparams(); (void)p_;
    const int tid = otid(), lane = tid & 63, w = tid >> 6, fr = lane & 15, fq = lane >> 4;
    const int hp = task & 3, rq = (task >> 2) & 63, b = task >> 8;
    const int row_start = min(max(rq - 4, 0), 56);
    const bf16* Z = (const bf16*)(p.ws + WS_Z); bf16* CAT = (bf16*)(p.ws + WS_CAT);
    bf16* VT = (bf16*)lds; float* BI = (float*)(lds + 133120);
    const int hh = w >> 2, h = hp * 2 + hh, qb = w & 3, kst = min(max(16 * qb - 8, 0), 32);
    const int c = 16 * qb + fr; const size_t qtok = (size_t)b * SEQ + rq * 64 + c;
    bf16x8v qf[2], kfr[8][2];
#pragma unroll
    for (int ks = 0; ks < 2; ++ks) qf[ks] = *(const bf16x8v*)(Z + qtok * DIN + 2 * DG + h * 64 + 32 * ks + 8 * fq);
#pragma unroll
    for (int i = 0; i < 8; ++i) { const int a = i / 2, ci = i % 2;
        const size_t ktok = (size_t)b * SEQ + (row_start + a) * 64 + kst + 16 * ci + fr;
#pragma unroll
        for (int ks = 0; ks < 2; ++ks) kfr[i][ks] = *(const bf16x8v*)(Z + ktok * DIN + 3 * DG + h * 64 + 32 * ks + 8 * fq); }
    asm volatile("" ::: "memory");
    for (int i = tid; i < 930; i += NTHR) BI[i] = p.na_bias[(size_t)(l * 8 + hp * 2) * 465 + i];
    { const int pair = lane & 31, chunk = (lane >> 5) + 2 * (w & 3);
      unsigned* VTd = (unsigned*)(VT + (size_t)hh * 64 * 520);
      u32x4 xs[8], ys[8];
#pragma unroll
      for (int a = 0; a < 8; ++a) { const size_t tok = (size_t)b * SEQ + (row_start + a) * 64 + 2 * pair;
          const bf16* src = Z + tok * DIN + 4 * DG + h * 64 + chunk * 8; xs[a] = *(const u32x4*)src; ys[a] = *(const u32x4*)(src + DIN); }
      asm volatile("" ::: "memory");
#pragma unroll
      for (int a = 0; a < 8; ++a) { const unsigned xu[4] = {xs[a].x, xs[a].y, xs[a].z, xs[a].w}, yu[4] = {ys[a].x, ys[a].y, ys[a].z, ys[a].w};
#pragma unroll
          for (int i = 0; i < 4; ++i) { VTd[(chunk * 8 + 2 * i) * 260 + a * 32 + pair] = (xu[i] & 0xffffu) | (yu[i] << 16);
              VTd[(chunk * 8 + 2 * i + 1) * 260 + a * 32 + pair] = (xu[i] >> 16) | (yu[i] & 0xffff0000u); } } }
    __syncthreads();
    const int col_start = min(max(c - 8, 0), 48);
    const float* bi = BI + hh * 465;
    float sc[16][4]; float mx = -1e30f;
#pragma unroll
    for (int hf = 0; hf < 2; ++hf) {
        if (hf == 1) {
#pragma unroll
            for (int i = 0; i < 8; ++i) { const int a = 4 + i / 2, ci = i % 2;
                const size_t ktok = (size_t)b * SEQ + (row_start + a) * 64 + kst + 16 * ci + fr;
#pragma unroll
                for (int ks = 0; ks < 2; ++ks) kfr[i][ks] = *(const bf16x8v*)(Z + ktok * DIN + 3 * DG + h * 64 + 32 * ks + 8 * fq); }
            asm volatile("" ::: "memory");
        }
#pragma unroll
        for (int i = 0; i < 8; ++i) { const int a = 4 * hf + i / 2, ci = i % 2, kt = a * 2 + ci;
            f32x4 acc = {0.f, 0.f, 0.f, 0.f};
#pragma unroll
            for (int ks = 0; ks < 2; ++ks) acc = MFMA16(kfr[i][ks], qf[ks], acc);
            const int dr = row_start + a - rq;
#pragma unroll
            for (int r = 0; r < 4; ++r) { const int kc = kst + 16 * ci + 4 * fq + r, rel = kc - col_start, dc = kc - c;
                float v = acc[r] * 0.125f + bi[(dr + 7) * 31 + min(max(dc + 15, 0), 30)];
                v = (rel >= 0 && rel < 16) ? v : -1e30f; sc[kt][r] = v; mx = fmaxf(mx, v); } }
    }
    mx = fmaxf(mx, __shfl_xor(mx, 16)); mx = fmaxf(mx, __shfl_xor(mx, 32));
    float sum = 0.f; unsigned pp[16][2];
#pragma unroll
    for (int kt = 0; kt < 16; ++kt) { const float e0 = __expf(sc[kt][0] - mx), e1 = __expf(sc[kt][1] - mx), e2 = __expf(sc[kt][2] - mx), e3 = __expf(sc[kt][3] - mx);
        sum += (e0 + e1) + (e2 + e3); pp[kt][0] = pk2(e0, e1); pp[kt][1] = pk2(e2, e3); }
    sum += __shfl_xor(sum, 16); sum += __shfl_xor(sum, 32);
    const float inv = 1.f / sum;
    const bf16* VTh = VT + (size_t)hh * 64 * 520;
#pragma unroll
    for (int dt = 0; dt < 4; ++dt) { f32x4 o = {0.f, 0.f, 0.f, 0.f};
#pragma unroll
        for (int t = 0; t < 8; ++t) { const int k0 = 2 * t, k1 = 2 * t + 1, a0 = k0 / 2, c0 = k0 % 2, a1 = k1 / 2, c1 = k1 % 2;
            const u32x2 vlo = *(const u32x2*)(VTh + (16 * dt + fr) * 520 + a0 * 64 + kst + 16 * c0 + 4 * fq), vhi = *(const u32x2*)(VTh + (16 * dt + fr) * 520 + a1 * 64 + kst + 16 * c1 + 4 * fq);
            o = MFMA16(mk8(vlo.x, vlo.y, vhi.x, vhi.y), mk8(pp[k0][0], pp[k0][1], pp[k1][0], pp[k1][1]), o); }
        const u32x2 gz = *(const u32x2*)(Z + qtok * DIN + 5 * DG + h * 64 + 16 * dt + 4 * fq); u32x2 ov;
        ov.x = pk2(o[0] * inv * silu_f(bflo(gz.x)), o[1] * inv * silu_f(bfhi(gz.x))); ov.y = pk2(o[2] * inv * silu_f(bflo(gz.y)), o[3] * inv * silu_f(bfhi(gz.y)));
        *(u32x2*)(CAT + qtok * DM + 512 + h * 64 + 16 * dt + 4 * fq) = ov; }
    __syncthreads();
}

__device__ __forceinline__ void conv_task(const Params& p_, int l, int task, unsigned char* lds) {
    const Params p = *kparams(); (void)p_;
    const int tid = otid(), lane = tid & 63, wave = tid >> 6;
    float* us = (float*)lds; float* ys = us + 46 * 512;
    const bf16* Z = (const bf16*)(p.ws + WS_Z);
    const int b = task >> 8, t0 = (task & 255) * 16;
    { u32x4 av[6], gv[6];
#pragma unroll
      for (int it = 0; it < 6; ++it) { const int idx = tid + it * NTHR, tt = idx >> 6, cc = (idx & 63) * 8, tok = t0 - 15 + tt;
          av[it] = (u32x4){0u, 0u, 0u, 0u}; gv[it] = av[it];
          if (idx < 46 * 64 && tok >= 0 && tok < SEQ) { const bf16* zr = Z + (size_t)(b * SEQ + tok) * DIN; av[it] = *(const u32x4*)(zr + 10 * DG + cc); gv[it] = *(const u32x4*)(zr + 11 * DG + cc); } }
      asm volatile("" ::: "memory");
#pragma unroll
      for (int it = 0; it < 6; ++it) { const int idx = tid + it * NTHR, tt = idx >> 6, cc = (idx & 63) * 8;
          if (idx < 46 * 64) { const u32x4 a = av[it], g = gv[it]; f32x4 u0, u1;
              u0[0] = bflo(a.x) / (1.f + __expf(-bflo(g.x))); u0[1] = bfhi(a.x) / (1.f + __expf(-bfhi(g.x))); u0[2] = bflo(a.y) / (1.f + __expf(-bflo(g.y))); u0[3] = bfhi(a.y) / (1.f + __expf(-bfhi(g.y)));
              u1[0] = bflo(a.z) / (1.f + __expf(-bflo(g.z))); u1[1] = bfhi(a.z) / (1.f + __expf(-bfhi(g.z))); u1[2] = bflo(a.w) / (1.f + __expf(-bflo(g.w))); u1[3] = bfhi(a.w) / (1.f + __expf(-bfhi(g.w)));
              *(f32x4*)(us + tt * 512 + cc) = u0; *(f32x4*)(us + tt * 512 + cc + 4) = u1; } } }
    float w[31];
#pragma unroll
    for (int k = 0; k < 31; ++k) w[k] = p.conv_w[(size_t)(l * 31 + k) * DG + tid];
    const float cb = p.conv_b[l * DG + tid];
    __syncthreads();
    { float y[16];
#pragma unroll
      for (int t = 0; t < 16; ++t) y[t] = cb;
#pragma unroll
      for (int j = 0; j < 46; ++j) { const float u = us[j * 512 + tid];
#pragma unroll
          for (int t = 0; t < 16; ++t) { const int k = j - t; if (k >= 0 && k < 31) y[t] += w[k] * u; } }
#pragma unroll
      for (int t = 0; t < 16; ++t) ys[t * 512 + tid] = y[t]; }
    __syncthreads();
#pragma unroll
    for (int tw = 0; tw < 2; ++tw) { const int t = wave + 8 * tw; float v[8]; float s = 0.f;
#pragma unroll
        for (int j = 0; j < 8; ++j) { v[j] = ys[t * 512 + lane + 64 * j]; s += v[j]; }
        const float mu = wave_sum(s) * (1.f / 512.f); float q = 0.f;
#pragma unroll
        for (int j = 0; j < 8; ++j) { v[j] -= mu; q += v[j] * v[j]; }
        const float rstd = rsqrtf(wave_sum(q) * (1.f / 512.f) + 1e-6f);
        bf16* orow = (bf16*)(p.ws + WS_CVH) + (size_t)(b * SEQ + t0 + t) * DG;
#pragma unroll
        for (int j = 0; j < 8; ++j) { const int ch = lane + 64 * j; const float y = v[j] * rstd * p.ln_g[l * DG + ch] + p.ln_b[l * DG + ch]; orow[ch] = (bf16)f2bf(silu_f(y)); } }
    __syncthreads();
}

__device__ __forceinline__ void ph_mixA(const Params& p, int l, unsigned char* lds) {
    const int G = gridDim.x, bid = obid();
    for (int t = bid; t < 512 * REP_R1; t += G) ret1_task(p, l, t & 511, lds);
    const int xcd = bid & 7, slot = bid >> 3, nloc = (slot < 16) ? 1 : 3, r0 = (slot < 16) ? slot : 16 + (slot - 16) * 3;
    if (G == 256 && REP_NA == 1) {
        for (int i = 0; i < nloc; ++i) { const int rq = (slot < 16) ? slot : 16 + i * 16 + (slot - 16);
            na2_task(p, l, (xcd >> 2) * 256 + rq * 4 + (xcd & 3), lds); }
    } else for (int t = bid; t < 512 * REP_NA; t += G) na2_task(p, l, t & 511, lds);
    if (G == 256 && REP_CV == 1) {
        for (int i = 0; i < 2; ++i) conv_task(p, l, xcd * 64 + slot * 2 + i, lds);
    } else for (int t = bid; t < 512 * REP_CV; t += G) conv_task(p, l, t & 511, lds);
}

__device__ __forceinline__ void ph_fold(const Params& p_) {
    const Params p = *kparams(); (void)p_;
    const bf16* PQ = (const bf16*)(p.ws + WS_PQT); bf16* PQF = (bf16*)(p.ws + WS_PQF);
    for (int e = obid() * NTHR + otid(); e < NB * DG * 2 * 256; e += gridDim.x * NTHR) {
        const int row = e >> 8, s0 = (e & 255) * 8, pq = row & 1;
        const bf16* src = PQ + (size_t)row * 4096;
        const u32x4 own = *(const u32x4*)(src + s0), low = *(const u32x4*)(src + 4096 - s0 - 8);
        const float top = (s0 == 0) ? 0.f : bf2f(src[4096 - s0]);
        const float sg = pq ? -1.f : 1.f;
        float o[8];
        o[0] = bflo(own.x) + sg * top;            o[1] = bfhi(own.x) + sg * bfhi(low.w);
        o[2] = bflo(own.y) + sg * bflo(low.w);    o[3] = bfhi(own.y) + sg * bfhi(low.z);
        o[4] = bflo(own.z) + sg * bflo(low.z);    o[5] = bfhi(own.z) + sg * bfhi(low.y);
        o[6] = bflo(own.w) + sg * bflo(low.y);    o[7] = bfhi(own.w) + sg * bfhi(low.x);
        if (s0 == 0 && pq) o[0] = 0.f;
        u32x4 w; w.x = pk2(o[0], o[1]); w.y = pk2(o[2], o[3]); w.z = pk2(o[4], o[5]); w.w = pk2(o[6], o[7]);
        *(u32x4*)(PQF + (size_t)row * 2048 + s0) = w;
    }
}
__device__ __forceinline__ void ph_alt(const Params& p_) {
    const Params p = *kparams(); (void)p_;
    const int tid = otid(), lane = tid & 63, wave = tid >> 6; const bf16* PQF = (const bf16*)(p.ws + WS_PQF);
    float* dst = (float*)(p.ws + WS_PART) + (size_t)(2 * 2304 + 2 * 2048) * 512;
    for (int r = obid() * 8 + wave; r < NB * DG; r += gridDim.x * 8) {
        const u32x4* src = (const u32x4*)(PQF + (size_t)r * 4096) + lane; float acc = 0.f;
#pragma unroll
        for (int j = 0; j < 4; ++j) { const u32x4 v = src[64 * j];
            acc += (bflo(v.x) - bfhi(v.x)) + (bflo(v.y) - bfhi(v.y)) + (bflo(v.z) - bfhi(v.z)) + (bflo(v.w) - bfhi(v.w)); }
        acc = wave_sum(acc);
        if (lane == 0) dst[r] = acc;
    }
}
__device__ __forceinline__ void ph_combine(const Params& p_) {
    const Params p = *kparams(); (void)p_;
    const float* Ce = (const float*)(p.ws + WS_PART); const float* So = Ce + (size_t)2 * 2304 * 512;
    bf16* CAT = (bf16*)(p.ws + WS_CAT); const bf16* Z = (const bf16*)(p.ws + WS_Z); const bf16* PQ = (const bf16*)(p.ws + WS_PQT);
    const int nth = gridDim.x * NTHR;
    for (int e0 = obid() * NTHR + otid(); e0 < MTOK * DG / 4; e0 += 2 * nth) {
        f32x4 ce[2], so[2]; u32x2 gz[2]; float pv[2][4]; int rowv[2], c4v[2], kv[2]; bool use_so[2], act[2];
#pragma unroll
        for (int u = 0; u < 2; ++u) { const int e = e0 + u * nth; act[u] = e < MTOK * DG / 4; const int ee = act[u] ? e : e0;
            const int row = ee >> 7, c4 = (ee & 127) * 4, b = row >> 12, k = row & 4095, kk = (k <= 2048) ? k : 4096 - k;
            rowv[u] = row; c4v[u] = c4; kv[u] = k; use_so[u] = (kk != 0 && kk != 2048);
            ce[u] = (kk == 2048) ? *(const f32x4*)(Ce + (size_t)(2 * 2304 + 2 * 2048) * 512 + b * 512 + c4) : *(const f32x4*)(Ce + ((size_t)b * 2304 + kk) * 512 + c4);
            so[u] = *(const f32x4*)(So + ((size_t)b * 2048 + (use_so[u] ? kk : 1)) * 512 + c4);
            gz[u] = *(const u32x2*)(Z + (size_t)row * DIN + DG + c4);
#pragma unroll
            for (int j = 0; j < 4; ++j) pv[u][j] = bf2f(PQ[((size_t)(b * 512 + c4 + j) * 2) * 4096 + 2048]); }
        asm volatile("" ::: "memory");
#pragma unroll
        for (int u = 0; u < 2; ++u) if (act[u]) { f32x4 s = ce[u];
            if (use_so[u]) s = (kv[u] <= 2048) ? s - so[u] : s + so[u];
            const float alt = (kv[u] & 1) ? -1.f : 1.f;
#pragma unroll
            for (int j = 0; j < 4; ++j) s[j] += alt * pv[u][j];
            u32x2 w; w.x = pk2(s[0] * silu_f(bflo(gz[u].x)), s[1] * silu_f(bfhi(gz[u].x))); w.y = pk2(s[2] * silu_f(bflo(gz[u].y)), s[3] * silu_f(bfhi(gz[u].y)));
            *(u32x2*)(CAT + (size_t)rowv[u] * DM + c4v[u]) = w; }
    }
}

#define XB_TMO      128
#define XB_XCNT(j)  (256  + 64 * (j))
#define XB_XSUB(j)  (1280 + 64 * (j))
#define XB_XGEN(j)  (2304 + 64 * (j))
#define XB_TOP      3328
#define XB_TOPGEN   3392
#define XCD_BAR_WORDS 3456
#define XB_SPIN_CAP (1u << 20)
__device__ __forceinline__ unsigned xb_ld(unsigned* p)              { return __hip_atomic_load(p, __ATOMIC_RELAXED, __HIP_MEMORY_SCOPE_AGENT); }
__device__ __forceinline__ unsigned xb_add(unsigned* p, unsigned v) { return __hip_atomic_fetch_add(p, v, __ATOMIC_RELAXED, __HIP_MEMORY_SCOPE_AGENT); }
__device__ __forceinline__ unsigned xb_xcc_id() { return (unsigned)__builtin_amdgcn_s_getreg((3 << 11) | 20) & 0xFu; }
#define XB_SPIN(cond, bar) do { unsigned _sp = 0; while (cond) { __builtin_amdgcn_s_sleep(1); \
    if ((++_sp & 255u) == 0u) { if (xb_ld(&(bar)[XB_TMO])) break; if (_sp > XB_SPIN_CAP) { atomicAdd(&(bar)[XB_TMO], 1u); break; } } } } while (0)
struct XcdBarrier { unsigned* bar; unsigned x; volatile PG8_LAS unsigned* st; };
__device__ __forceinline__ XcdBarrier xcd_barrier_post(unsigned* bar, volatile PG8_LAS unsigned* st) {
    XcdBarrier b; b.bar = bar; b.x = xb_xcc_id(); b.st = st;
    if (otid() == 0) (void)xb_add(&bar[XB_XCNT(b.x)], 1u);
    return b;
}
__device__ __forceinline__ void xcd_barrier_complete(unsigned* bar, unsigned x, unsigned& nloc, unsigned& nx) {
    const unsigned G = gridDim.x * gridDim.y * gridDim.z;
    unsigned sum, cnt, mine, sp = 0u;
    for (;;) {
        sum = 0u; cnt = 0u; mine = 0u;
#pragma unroll
        for (unsigned j = 0; j < 16; ++j) { const unsigned c = xb_ld(&bar[XB_XCNT(j)]); sum += c; cnt += (c > 0u) ? 1u : 0u; mine = (j == x) ? c : mine; }
        if (sum == G) break;
        __builtin_amdgcn_s_sleep(1);
        if ((++sp & 255u) == 0u) { if (xb_ld(&bar[XB_TMO])) break; if (sp > XB_SPIN_CAP) { atomicAdd(&bar[XB_TMO], 1u); break; } }
    }
    nloc = mine > 0u ? mine : 1u; nx = cnt > 0u ? cnt : 1u;
}
__device__ __forceinline__ void xcd_barrier(const XcdBarrier& b) {
    asm volatile("s_waitcnt vmcnt(0)" ::: "memory");
    __syncthreads();
    if (otid() == 0) {
        unsigned* bar = b.bar;
        __builtin_amdgcn_s_waitcnt(0);
        unsigned nloc = b.st[0], nx = b.st[1];
        if (nloc == 0u) { xcd_barrier_complete(bar, b.x, nloc, nx); b.st[0] = nloc; b.st[1] = nx; }
        const unsigned old = xb_add(&bar[XB_XSUB(b.x)], 1u);
        const unsigned gen = old / nloc;
        if (old + 1u == (gen + 1u) * nloc) {
            __builtin_amdgcn_fence(__ATOMIC_RELEASE, "agent");
            asm volatile("s_waitcnt vmcnt(0)" ::: "memory");
            const unsigned og = xb_add(&bar[XB_TOP], 1u);
            const unsigned tg = og / nx;
            if (og + 1u == (tg + 1u) * nx) xb_add(&bar[XB_TOPGEN], 1u);
            else XB_SPIN(xb_ld(&bar[XB_TOPGEN]) == tg, bar);
            __builtin_amdgcn_fence(__ATOMIC_ACQUIRE, "agent");
            xb_add(&bar[XB_XGEN(b.x)], 1u);
            asm volatile("s_waitcnt vmcnt(0)" ::: "memory");
        } else {
            XB_SPIN(xb_ld(&bar[XB_XGEN(b.x)]) == gen, bar);
            __builtin_amdgcn_fence(__ATOMIC_ACQUIRE, "agent");
            asm volatile("s_waitcnt vmcnt(0)" ::: "memory");
        }
    }
    __syncthreads();
}

constexpr int NPH = 14;
__global__ void __launch_bounds__(NTHR) mega(Params p) {
    extern __shared__ __attribute__((aligned(16))) unsigned char lds[];
    cg::grid_group grid = cg::this_grid();
    PG8_LAS unsigned char* ldsl = (PG8_LAS unsigned char*)lds;
    const int lo = p.ph_lo, hi = p.ph_hi;
#define IN(k) (lo <= (k) && (k) < hi)
#define SEAM(k) do { if (IN(k) && IN((k) + 1)) { xcd_barrier(xb); } } while (0)
    bf16* Zb = (bf16*)(kparams()->ws + WS_Z); bf16* CAT = (bf16*)(kparams()->ws + WS_CAT);
    volatile PG8_LAS unsigned* xst = (volatile PG8_LAS unsigned*)(ldsl + LDS_BYTES - 16);
    { const int t0_ = otid(); if (t0_ < 4) xst[t0_] = 0u; }
    __syncthreads();
    XcdBarrier xb = xcd_barrier_post((unsigned*)(kparams()->ws + WS_BAR), xst);
    if (p.ph_lo < 0) grid.sync();
    if (IN(0)) REPEAT(REP_PRO) { ph_prologue(p, lds); __syncthreads(); }
    SEAM(0);
    if (IN(0) && IN(1)) for (int r_ = 1; r_ < REP_SUB; ++r_) xcd_barrier(xb);
#pragma unroll
    for (int l = 0; l < NL; ++l) {
        const int pb = 1 + 6 * l;
        const char* Wl = (const char*)(kparams()->ws + WS_WIN + (size_t)l * WROWS * DM * 2);
        if (IN(pb)) {
            if (l == 0) {
#pragma unroll
                for (int ll = 0; ll < NL; ++ll) {
                    SchedS S = make_sched(kparams()->ws + WS_WCS + (size_t)ll * 1024 * DG * 2, DG, kparams()->ws + WS_WFXB + (size_t)ll * DM * DG * 2, DG, 1024, DM, 32 * ll);
                    EpiZ E{(bf16*)(kparams()->ws + WS_WIN + ((size_t)ll * WROWS + 6656) * DM * 2), DM};
                    pg8::gemm_phase<EpiZ, SchedS, true>(ldsl, pg8::Gemm{DG, DG, DG}, S, E);
                }
            }
            REPEAT(REP_NORM) ph_norm(p, l, (l == 0 && gridDim.x == 256) ? 64 : 0);
        }
        SEAM(pb);
        if (IN(pb + 1)) REPEAT(REP_Z) {
            SchedZ S; S.o.init(MTOK, 24 * 256, (int)gridDim.x, obid()); S.A = (const char*)(kparams()->ws + WS_U); S.B = Wl; S.late = 0;
            EpiZ2 E{Zb, (bf16*)(kparams()->ws + WS_PQT)};
            pg8::gemm_phase<EpiZ2, SchedZ, true>(ldsl, pg8::Gemm{DM, DM, DM}, S, E);
        }
        SEAM(pb + 1);
        if (IN(pb + 2)) {
            {
                SchedZ S; S.o.init(MTOK, 4 * 256, (int)gridDim.x, obid()); S.A = (const char*)(kparams()->ws + WS_U); S.B = Wl; S.late = 1;
                EpiZ2 E{Zb, (bf16*)(kparams()->ws + WS_PQT)};
                pg8::gemm_phase<EpiZ2, SchedZ, true>(ldsl, pg8::Gemm{DM, DM, DM}, S, E);
            }
            REPEAT(REP_MIX) ph_mixA(p, l, lds);
            ph_fold(p);
        }
        SEAM(pb + 2);
        if (IN(pb + 3)) REPEAT(REP_P3) {
            const int G_ = (int)gridDim.x, b_ = obid(); const bool bal = (G_ == 256);
            {
                SchedDFT S{(const char*)(kparams()->ws + WS_DC), (const char*)(kparams()->ws + WS_PQF), G_, b_};
                EpiPart E{(float*)(kparams()->ws + WS_PART)};
                pg8::gemm_phase<EpiPart, SchedDFT, true>(ldsl, pg8::Gemm{2048, 4096, 2048}, S, E); }
            {
                SchedS S = make_sched(kparams()->ws + WS_CVH, DG, kparams()->ws + WS_WPW + (size_t)l * DG * DG * 2, DG, MTOK, DG, bal ? 192 : 0);
                EpiGate E{CAT, Zb, 1536, 12 * DG};
                pg8::gemm_phase<EpiGate, SchedS, true>(ldsl, pg8::Gemm{DG, DG, DG}, S, E); }
            if (bal && REP_R2 == 1) {
                const int xcd = b_ & 7, slot = b_ >> 3;
                const int nt_ = (slot >= 24) ? 2 : (slot >= 8 ? 3 : 0), k0 = (slot >= 24) ? 48 + (slot - 24) * 2 : (slot - 8) * 3;
                for (int i = 0; i < nt_; ++i) { const int k = k0 + i; ret2_task(p, l, (2 * xcd + (k >> 5)) * 32 + (k & 31), lds); }
            }
            else for (int t = b_; t < 512 * REP_R2; t += G_) ret2_task(p, l, t & 511, lds);
            ph_alt(p);
        }
        SEAM(pb + 3);
        if (IN(pb + 4)) REPEAT(REP_CMB) ph_combine(p);
        SEAM(pb + 4);
        if (IN(pb + 5)) REPEAT(l == 0 ? REP_OUT : 1) {
            SchedS S = make_sched(CAT, DM, kparams()->ws + WS_WOUT + (size_t)l * DM * DM * 2, DM, MTOK, DM);
            EpiRes E{(l == 0) ? kparams()->x : kparams()->out, kparams()->out, (const float*)(kparams()->ws + WS_MOD) + (size_t)l * 2 * 6144 + 4096};
            pg8::gemm_phase<EpiRes, SchedS, true>(ldsl, pg8::Gemm{DM, DM, DM}, S, E);
        }
        SEAM(pb + 5);
    }
    if (IN(NPH - 1)) ph_final(p);
#undef IN
#undef SEAM
}

extern "C" void kernel_launch(void* const* d_in, const int* in_sizes, int n_in, void* d_out, int out_size, void* d_ws, size_t ws_size, hipStream_t stream) {
    static int grid_blocks = 0;
    if (grid_blocks == 0) {
        if (n_in != 17 || ws_size < WS_END) { fprintf(stderr, "kernel_launch: n_in %d ws %zu (need %zu)\n", n_in, ws_size, (size_t)WS_END); grid_blocks = -1; return; }
        int dev = 0, cus = 0, per_cu = 0;
        hipGetDevice(&dev); hipDeviceGetAttribute(&cus, hipDeviceAttributeMultiprocessorCount, dev);
        if (hipFuncSetAttribute((const void*)mega, hipFuncAttributeMaxDynamicSharedMemorySize, LDS_BYTES) != hipSuccess) { fprintf(stderr, "hipFuncSetAttribute failed\n"); grid_blocks = -1; return; }
        if (hipOccupancyMaxActiveBlocksPerMultiprocessor(&per_cu, (const void*)mega, NTHR, LDS_BYTES) != hipSuccess || per_cu < 1) { fprintf(stderr, "occupancy query: %d\n", per_cu); per_cu = 1; }
        (void)hipGetLastError();
        grid_blocks = cus * 1;
    }
    if (grid_blocks < 0) return;
    Params p{};
    p.x = (const float*)d_in[0]; p.c = (const float*)d_in[1]; p.norm_g = (const float*)d_in[2]; p.w_ada = (const float*)d_in[3]; p.b_ada = (const float*)d_in[4];
    p.w_in = (const float*)d_in[5]; p.w_fft = (const float*)d_in[6]; p.na_bias = (const float*)d_in[7]; p.rl_f = (const float*)d_in[8]; p.rl_b = (const float*)d_in[9];
    p.conv_w = (const float*)d_in[10]; p.conv_b = (const float*)d_in[11]; p.ln_g = (const float*)d_in[12]; p.ln_b = (const float*)d_in[13]; p.w_pw = (const float*)d_in[14];
    p.w_out = (const float*)d_in[15]; p.final_g = (const float*)d_in[16];
    p.out = (float*)d_out; p.ws = (unsigned char*)d_ws;
#if ONE_LAUNCH
    if (hipMemsetAsync((char*)d_ws + WS_BAR, 0, 16384, stream) != hipSuccess) { fprintf(stderr, "memset of the barrier words failed\n"); return; }
    p.ph_lo = 0; p.ph_hi = NPH;
    void* args[] = {&p};
    hipError_t e = hipLaunchCooperativeKernel((const void*)mega, dim3(grid_blocks), dim3(NTHR), args, LDS_BYTES, stream);
    if (e != hipSuccess) fprintf(stderr, "cooperative launch failed: %s (grid %d)\n", hipGetErrorString(e), grid_blocks);
#else
    for (int ph = 0; ph < NPH; ++ph) { p.ph_lo = ph; p.ph_hi = ph + 1; hipLaunchKernelGGL(mega, dim3(grid_blocks), dim3(NTHR), LDS_BYTES, stream, p); }
#endif
}
```

```cpp
#include <hip/hip_runtime.h>
#include <hip/hip_cooperative_groups.h>
#include <cstdio>
#include <cstdint>
namespace cg = cooperative_groups;

#ifndef ONE_LAUNCH
#define ONE_LAUNCH 1
#endif

__device__ __forceinline__ int obid() { int b = (int)blockIdx.x; asm volatile("" : "+s"(b)); return b; }
__device__ __forceinline__ int otid() { int t; asm volatile("v_mov_b32 %0, %1" : "=v"(t) : "v"(threadIdx.x)); return t; }
namespace pg8 {
#define PG8_LAS __attribute__((address_space(3)))
typedef unsigned short bf16_t;
typedef short bf16x8 __attribute__((ext_vector_type(8)));
typedef float f32x4 __attribute__((ext_vector_type(4)));
typedef unsigned u32x4 __attribute__((ext_vector_type(4)));
constexpr int BM = 256, BK = 64, HALF = 128, HTB = HALF * BK * 2, STAGE_BYTES = 8 * HTB, NXCD = 8, WGM = 8;

__host__ __device__ __forceinline__ int lds_byte(int r, int c) { const int st = (r >> 4) * 2 + (c >> 5), rr = r & 15, cc = c & 31, ob = rr * 64 + cc * 2; return st * 1024 + (ob ^ (((ob >> 9) & 1) << 5)); }
__host__ __device__ __forceinline__ void stage_rc(int b, int& R, int& C) { const int st = b / 1024, sb = b % 1024, swz = sb ^ (((sb >> 9) & 1) << 5); R = (st >> 1) * 16 + swz / 64; C = (st & 1) * 32 + (swz % 64) / 2; }
__host__ __device__ __forceinline__ int perm32(int rho) { const int n = rho >> 4, i = rho & 15; return 8 * (i >> 2) + 4 * n + (i & 3); }

struct Unit { int pm, pn, aux, pad; const char* A; const char* B; };
struct Gemm { int lda, ldb, K; };

struct StaticOrder {
    int nM, nN, nwg, G, c;
    __host__ __device__ void init(int M, int N, int G_, int c_) { nM = M / BM; nN = N / BM; nwg = nM * nN; G = G_; c = c_; }
    __device__ bool next(int i, Unit& u) const {
        const long L = (long)i * G + c; if (L >= nwg) return false;
        int wgid = __builtin_amdgcn_readfirstlane((int)L); { const int q = nwg / NXCD, r = nwg % NXCD, xcd = wgid % NXCD, off = wgid / NXCD; wgid = (xcd < r ? xcd * (q + 1) : r * (q + 1) + (xcd - r) * q) + off; }
        const int nig = WGM * nN, gid = wgid / nig, fm = gid * WGM, gsz = (nM - fm) < WGM ? (nM - fm) : WGM;
        u.pm = __builtin_amdgcn_readfirstlane(fm + ((wgid % nig) % gsz)); u.pn = __builtin_amdgcn_readfirstlane((wgid % nig) / gsz); return true;
    }
};

__device__ __forceinline__ unsigned cvt_pk_bf16(float lo, float hi) { unsigned r; asm volatile("v_cvt_pk_bf16_f32 %0, %1, %2" : "=v"(r) : "v"(lo), "v"(hi)); return r; }

template <class Epi, class Sched, bool ALIGN_EPI>
__device__ __forceinline__ void gemm_phase(PG8_LAS unsigned char* lds, const Gemm g, const Sched& S, const Epi& E) {
    const int tid = otid(), wid = __builtin_amdgcn_readfirstlane(tid >> 6), lane = tid & 63, wr = wid >> 2, wc = wid & 3, fr = lane & 15, fq = lane >> 4;
    const int K = g.K, nt = K / BK;
    unsigned voffA[2], voffB[2];
#pragma unroll
    for (int i = 0; i < 2; ++i) { int R, C; stage_rc(tid * 16 + i * 8192, R, C); const int Rb = Epi::PERM ? ((R & ~31) + perm32(R & 31)) : R;
        voffA[i] = (unsigned)(R * g.lda + C) * 2u; voffB[i] = (unsigned)(Rb * g.ldb + C) * 2u; }
    const size_t kstep = (size_t)(BK * 2);
    const size_t hA = (size_t)HALF * g.lda * 2, hB = (size_t)HALF * g.ldb * 2;
    const unsigned ldsw = (unsigned)wid * 1024u;
    const int aoff = lds_byte(wr * 64 + fr, fq * 8), boff = lds_byte(wc * 32 + fr, fq * 8);
#define PG8_SA(b, h) (((b) * 2 + (h)) * HTB)
#define PG8_SB(b, h) ((4 + (b) * 2 + (h)) * HTB)
#define PG8_STAGE(bufoff, gbase, voff) do { _Pragma("unroll") for (int _i = 0; _i < 2; ++_i) \
        __builtin_amdgcn_global_load_lds((const unsigned*)((const char*)(gbase) + (voff)[_i]), (PG8_LAS unsigned*)(lds + (bufoff) + ldsw + _i * 8192), 16, 0, 0); } while (0)
#define PG8_LDA(dst, b, h) do { _Pragma("unroll") for (int m = 0; m < 4; ++m) _Pragma("unroll") for (int k = 0; k < 2; ++k) dst[m][k] = *(const PG8_LAS bf16x8*)(lds + PG8_SA(b, h) + aoff + m * 2048 + k * 1024); } while (0)
#define PG8_LDB(dst, b, h) do { _Pragma("unroll") for (int n = 0; n < 2; ++n) _Pragma("unroll") for (int k = 0; k < 2; ++k) dst[n][k] = *(const PG8_LAS bf16x8*)(lds + PG8_SB(b, h) + boff + n * 2048 + k * 1024); } while (0)
#define PG8_MMA(ai, bj, At, Bt) do { __builtin_amdgcn_s_setprio(1); _Pragma("unroll") for (int m = 0; m < 4; ++m) _Pragma("unroll") for (int n = 0; n < 2; ++n) _Pragma("unroll") for (int k = 0; k < 2; ++k) \
        acc[ai][bj][m][n] = __builtin_amdgcn_mfma_f32_16x16x32_bf16(Bt[n][k], At[m][k], acc[ai][bj][m][n], 0, 0, 0); __builtin_amdgcn_s_setprio(0); } while (0)
#define PG8_WAIT_V(n) asm volatile("s_waitcnt vmcnt(" #n ")" ::: "memory")
#define PG8_WAIT_L(n) asm volatile("s_waitcnt lgkmcnt(" #n ")" ::: "memory")
#define PG8_BAR __builtin_amdgcn_s_barrier()
#define PG8_SCHED __builtin_amdgcn_sched_barrier(0)
    Unit cur, nxt; int ui = 0;
    if (!S.next(0, cur)) return;
    f32x4 acc[2][2][4][2];
#pragma unroll
    for (int a = 0; a < 2; ++a)
#pragma unroll
        for (int b = 0; b < 2; ++b)
#pragma unroll
            for (int m = 0; m < 4; ++m)
#pragma unroll
                for (int n = 0; n < 2; ++n) acc[a][b][m][n] = (f32x4){0.f, 0.f, 0.f, 0.f};
    bf16x8 At[4][2], B0[2][2], B1[2][2];
    const char* cA = cur.A; const char* cB = cur.B;
    PG8_STAGE(PG8_SB(0, 0), cB, voffB); PG8_STAGE(PG8_SB(0, 1), cB + hB, voffB); PG8_STAGE(PG8_SA(0, 0), cA, voffA); PG8_STAGE(PG8_SA(0, 1), cA + hA, voffA);
    if (wr == 1) PG8_BAR;
    PG8_WAIT_V(2); PG8_BAR;
    PG8_STAGE(PG8_SB(1, 0), cB + kstep, voffB); PG8_STAGE(PG8_SA(1, 0), cA + kstep, voffA); PG8_STAGE(PG8_SB(1, 1), cB + hB + kstep, voffB);
    PG8_WAIT_V(6); PG8_BAR;
    for (;;) {
        const bool has_next = S.next(ui + 1, nxt);
        const char* nA = has_next ? nxt.A : cA; const char* nB = has_next ? nxt.B : cB;
        for (int t = 0; t < nt; t += 2) {
            const bool last = (t == nt - 2);
            const char* a1 = cA + (size_t)(t + 1) * kstep;
            const char* a2 = last ? nA : cA + (size_t)(t + 2) * kstep; const char* b2 = last ? nB : cB + (size_t)(t + 2) * kstep;
            const char* a3 = a2 + kstep; const char* b3 = b2 + kstep;
            PG8_LDB(B0, 0, 0); PG8_LDB(B1, 0, 1); PG8_SCHED; PG8_LDA(At, 0, 0); PG8_STAGE(PG8_SA(1, 1), a1 + hA, voffA);
            PG8_WAIT_V(8); PG8_WAIT_L(0); PG8_BAR; PG8_MMA(0, 0, At, B0); PG8_MMA(0, 1, At, B1); PG8_BAR; PG8_SCHED;
            PG8_LDA(At, 0, 1); PG8_STAGE(PG8_SB(0, 0), b2, voffB); PG8_STAGE(PG8_SB(0, 1), b2 + hB, voffB); PG8_STAGE(PG8_SA(0, 0), a2, voffA);
            PG8_WAIT_V(8); PG8_WAIT_L(0); PG8_BAR; PG8_MMA(1, 0, At, B0); PG8_MMA(1, 1, At, B1); PG8_BAR; PG8_SCHED;
            PG8_LDB(B0, 1, 0); PG8_LDB(B1, 1, 1); PG8_SCHED; PG8_LDA(At, 1, 0); PG8_STAGE(PG8_SA(0, 1), a2 + hA, voffA);
            PG8_WAIT_V(8); PG8_WAIT_L(0); PG8_BAR; PG8_MMA(0, 0, At, B0); PG8_MMA(0, 1, At, B1); PG8_BAR; PG8_SCHED;
            PG8_LDA(At, 1, 1); PG8_STAGE(PG8_SB(1, 0), b3, voffB); PG8_STAGE(PG8_SB(1, 1), b3 + hB, voffB); PG8_STAGE(PG8_SA(1, 0), a3, voffA);
            PG8_WAIT_V(8); PG8_WAIT_L(0); PG8_BAR; PG8_MMA(1, 0, At, B0); PG8_MMA(1, 1, At, B1); PG8_BAR; PG8_SCHED;
        }
        if constexpr (ALIGN_EPI) { if (wr == 0) PG8_BAR; }
        E(acc, cur, wr, wc, fr, fq);
        if (!has_next) break;
#pragma unroll
        for (int a = 0; a < 2; ++a)
#pragma unroll
            for (int b = 0; b < 2; ++b)
#pragma unroll
                for (int m = 0; m < 4; ++m)
#pragma unroll
                    for (int n = 0; n < 2; ++n) acc[a][b][m][n] = (f32x4){0.f, 0.f, 0.f, 0.f};
        cur = nxt; cA = nA; cB = nB; ++ui;
        if constexpr (ALIGN_EPI) { if (wr == 1) PG8_BAR; }
    }
    PG8_WAIT_V(0);
    if constexpr (!ALIGN_EPI) { if (wr == 0) PG8_BAR; }
    PG8_BAR;
#undef PG8_SA
#undef PG8_SB
#undef PG8_STAGE
#undef PG8_LDA
#undef PG8_LDB
#undef PG8_MMA
#undef PG8_WAIT_V
#undef PG8_WAIT_L
#undef PG8_BAR
#undef PG8_SCHED
}
}

typedef unsigned short bf16;
typedef float f32x4 __attribute__((ext_vector_type(4)));
typedef unsigned u32x4 __attribute__((ext_vector_type(4)));
typedef unsigned u32x2 __attribute__((ext_vector_type(2)));
constexpr int NB = 2, SEQ = 4096, DM = 2048, MTOK = NB * SEQ, DIN = 6656, DG = 512, NL = 2;
constexpr int LDS_BYTES = 147456;
constexpr int NTHR = 512;

constexpr int WROWS = 7680;
constexpr size_t WS_WIN = 0;
constexpr size_t WS_WOUT = WS_WIN + (size_t)NL * WROWS * DM * 2;
constexpr size_t WS_WCS = WS_WOUT + (size_t)NL * DM * DM * 2;
constexpr size_t WS_WFXB = WS_WCS + (size_t)NL * 1024 * DG * 2;
constexpr size_t WS_WPW = WS_WFXB + (size_t)NL * DM * DG * 2;
constexpr size_t WS_DC = WS_WPW + (size_t)NL * DG * DG * 2;
constexpr size_t WS_DS = WS_DC + (size_t)2304 * 2048 * 2;
constexpr size_t WS_PQF = WS_DS + (size_t)2048 * 2048 * 2;
constexpr size_t WS_ROPE = WS_PQF + (size_t)NB * DG * 2 * 2048 * 2;
constexpr size_t WS_MOD = WS_ROPE + (size_t)SEQ * 32 * 8;
constexpr size_t WS_U = WS_MOD + 131072;
constexpr size_t WS_PART = WS_U + (size_t)MTOK * DM * 2;
constexpr size_t WS_Z = WS_U + (size_t)4 * MTOK * DG * 4;
constexpr size_t WS_PQT = WS_Z + (size_t)MTOK * DIN * 2;
constexpr size_t WS_CVH = WS_PQT + (size_t)NB * DG * 2 * SEQ * 2;
constexpr size_t WS_CAT = WS_CVH + (size_t)MTOK * DG * 2;
constexpr size_t WS_KV = WS_CAT + (size_t)MTOK * DM * 2;
constexpr size_t WS_BAR = WS_KV + (size_t)2 * NB * 8 * 32 * 4096 * 4;
constexpr size_t WS_END = WS_BAR + 16384;

struct Params {
    const float* x; const float* c; const float* norm_g; const float* w_ada; const float* b_ada; const float* w_in; const float* w_fft; const float* na_bias;
    const float* rl_f; const float* rl_b; const float* conv_w; const float* conv_b; const float* ln_g; const float* ln_b; const float* w_pw; const float* w_out; const float* final_g;
    float* out; unsigned char* ws; int ph_lo, ph_hi;
};

#if defined(__HIP_DEVICE_COMPILE__)
typedef const __attribute__((address_space(4))) Params* KParams;
__device__ __forceinline__ KParams kparams() { KParams k = (KParams)__builtin_amdgcn_kernarg_segment_ptr(); asm volatile("" : "+s"(k)); return k; }
#else
typedef const Params* KParams;
__device__ __forceinline__ KParams kparams() { return nullptr; }
#endif
__device__ __forceinline__ unsigned f2bf(float f) { unsigned u = __float_as_uint(f); return (u + 0x7fffu + ((u >> 16) & 1u)) >> 16; }
__device__ __forceinline__ unsigned pk2(float lo, float hi) { return f2bf(lo) | (f2bf(hi) << 16); }
__device__ __forceinline__ float bf2f(bf16 b) { return __uint_as_float((unsigned)b << 16); }
__device__ __forceinline__ float bflo(unsigned u) { return __uint_as_float(u << 16); }
__device__ __forceinline__ float bfhi(unsigned u) { return __uint_as_float(u & 0xffff0000u); }
__device__ __forceinline__ float silu_f(float v) { return v / (1.f + __expf(-v)); }
__device__ __forceinline__ float wave_sum(float v) {
#pragma unroll
    for (int o = 1; o < 64; o <<= 1) v += __shfl_xor(v, o);
    return v;
}
__device__ __forceinline__ float wave_max(float v) {
#pragma unroll
    for (int o = 1; o < 64; o <<= 1) v = fmaxf(v, __shfl_xor(v, o));
    return v;
}

struct SchedS {
    pg8::StaticOrder o; const char* A; const char* B; size_t ta, tb;
    __device__ __forceinline__ bool next(int i, pg8::Unit& u) const { if (!o.next(i, u)) return false; u.A = A + (size_t)u.pm * ta; u.B = B + (size_t)u.pn * tb; u.aux = 0; return true; }
};
__device__ __forceinline__ SchedS make_sched(const void* A, int lda, const void* B, int ldb, int M, int N, int shift = 0) {
    SchedS s; s.o.init(M, N, (int)gridDim.x, (int)((obid() + gridDim.x - shift) % gridDim.x)); s.A = (const char*)A; s.B = (const char*)B; s.ta = (size_t)256 * lda * 2; s.tb = (size_t)256 * ldb * 2; return s;
}
struct SchedZ {
    pg8::StaticOrder o; const char* A; const char* B; int late;
    __device__ __forceinline__ bool next(int i, pg8::Unit& u) const { if (!o.next(i, u)) return false; const int jn = u.pn;
        u.pn = late ? (jn < 2 ? 2 + jn : 22 + jn) : (jn < 20 ? jn + 4 : jn + 6);
        u.A = A + (size_t)u.pm * (256 * DM * 2); u.B = B + (size_t)u.pn * (256 * DM * 2); u.aux = 0; return true; }
};
struct SchedDFT {
    const char* DC; const char* PQF; int G, c;
    __device__ __forceinline__ bool next(int i, pg8::Unit& u) const {
        if (c < 0) return false;
        const int L = __builtin_amdgcn_readfirstlane(i * G + c); if (L >= 64) return false;
        const int b = L >> 5, t = L & 31, odd = t >> 4, tt = t & 15; u.pm = tt >> 1; u.pn = tt & 1; u.aux = b * 2 + odd;
        u.A = DC + (size_t)odd * (WS_DS - WS_DC) + (size_t)u.pm * (256 * 2048 * 2);
        u.B = PQF + ((size_t)(b * 512 + u.pn * 256) * 4096 + odd * 2048) * 2; return true;
    }
};

struct EpiZ {
    static constexpr bool PERM = true;
    bf16* O; int ldc;
    __device__ __forceinline__ void operator()(const pg8::f32x4 (&acc)[2][2][4][2], const pg8::Unit& u, int wr, int wc, int fr, int fq) const {
        const int row0 = u.pm * 256 + wr * 64 + fr, col0 = u.pn * 256 + wc * 32 + 8 * fq;
#pragma unroll
        for (int ai = 0; ai < 2; ++ai)
#pragma unroll
            for (int m = 0; m < 4; ++m) { bf16* rowp = O + (size_t)(row0 + ai * 128 + m * 16) * ldc + col0;
#pragma unroll
                for (int bj = 0; bj < 2; ++bj) { const pg8::f32x4 v0 = acc[ai][bj][m][0], v1 = acc[ai][bj][m][1]; u32x4 w;
                    w.x = pg8::cvt_pk_bf16(v0[0], v0[1]); w.y = pg8::cvt_pk_bf16(v0[2], v0[3]); w.z = pg8::cvt_pk_bf16(v1[0], v1[1]); w.w = pg8::cvt_pk_bf16(v1[2], v1[3]);
                    *(u32x4*)(rowp + bj * 128) = w; } }
    }
};
struct EpiZ2 {
    static constexpr bool PERM = true;
    bf16* O; bf16* PQ;
    __device__ __forceinline__ void operator()(const pg8::f32x4 (&acc)[2][2][4][2], const pg8::Unit& u, int wr, int wc, int fr, int fq) const {
        const int row0 = u.pm * 256 + wr * 64 + fr;
        if (u.pn < 26) { const int col0 = u.pn * 256 + wc * 32 + 8 * fq;
#pragma unroll
            for (int ai = 0; ai < 2; ++ai)
#pragma unroll
                for (int m = 0; m < 4; ++m) { bf16* rowp = O + (size_t)(row0 + ai * 128 + m * 16) * DIN + col0;
#pragma unroll
                    for (int bj = 0; bj < 2; ++bj) { const pg8::f32x4 v0 = acc[ai][bj][m][0], v1 = acc[ai][bj][m][1]; u32x4 w;
                        w.x = pg8::cvt_pk_bf16(v0[0], v0[1]); w.y = pg8::cvt_pk_bf16(v0[2], v0[3]); w.z = pg8::cvt_pk_bf16(v1[0], v1[1]); w.w = pg8::cvt_pk_bf16(v1[2], v1[3]);
                        *(u32x4*)(rowp + bj * 128) = w; } }
        } else { const int np0 = (u.pn - 26) * 256 + wc * 32 + 8 * fq;
#pragma unroll
            for (int bj = 0; bj < 2; ++bj) { const int np = np0 + bj * 128, pq = np >> 9, n = np & 511;
#pragma unroll
                for (int ai = 0; ai < 2; ++ai)
#pragma unroll
                    for (int m = 0; m < 4; ++m) { const int row = row0 + ai * 128 + m * 16, b = row >> 12, sq = row & 4095;
                        bf16* dst = PQ + ((size_t)(b * 512 + n) * 2 + pq) * 4096 + sq;
#pragma unroll
                        for (int nn = 0; nn < 2; ++nn)
#pragma unroll
                            for (int j = 0; j < 4; ++j) dst[(size_t)(4 * nn + j) * 8192] = (bf16)f2bf(acc[ai][bj][m][nn][j]); } }
        }
    }
};
struct EpiGate {
    static constexpr bool PERM = true;
    bf16* O; const bf16* Z; int coff, goff;
    __device__ __forceinline__ void operator()(const pg8::f32x4 (&acc)[2][2][4][2], const pg8::Unit& u, int wr, int wc, int fr, int fq) const {
        const int row0 = u.pm * 256 + wr * 64 + fr, col0 = u.pn * 256 + wc * 32 + 8 * fq;
#pragma unroll
        for (int ai = 0; ai < 2; ++ai)
#pragma unroll
            for (int m = 0; m < 4; ++m) { const size_t row = (size_t)(row0 + ai * 128 + m * 16);
#pragma unroll
                for (int bj = 0; bj < 2; ++bj) { const pg8::f32x4 v0 = acc[ai][bj][m][0], v1 = acc[ai][bj][m][1];
                    const u32x4 gz = *(const u32x4*)(Z + row * DIN + goff + col0 + bj * 128); u32x4 w;
                    w.x = pg8::cvt_pk_bf16(v0[0] * silu_f(bflo(gz.x)), v0[1] * silu_f(bfhi(gz.x))); w.y = pg8::cvt_pk_bf16(v0[2] * silu_f(bflo(gz.y)), v0[3] * silu_f(bfhi(gz.y)));
                    w.z = pg8::cvt_pk_bf16(v1[0] * silu_f(bflo(gz.z)), v1[1] * silu_f(bfhi(gz.z))); w.w = pg8::cvt_pk_bf16(v1[2] * silu_f(bflo(gz.w)), v1[3] * silu_f(bfhi(gz.w)));
                    *(u32x4*)(O + row * DM + coff + col0 + bj * 128) = w; } }
    }
};
struct EpiPart {
    static constexpr bool PERM = false;
    float* P;
    __device__ __forceinline__ void operator()(const pg8::f32x4 (&acc)[2][2][4][2], const pg8::Unit& u, int wr, int wc, int fr, int fq) const {
        const int row0 = u.pm * 256 + wr * 64 + fr, col0 = u.pn * 256 + wc * 32 + 4 * fq;
        float* base = (u.aux & 1) ? P + (size_t)2 * 2304 * 512 + (size_t)(u.aux >> 1) * 2048 * 512 : P + (size_t)(u.aux >> 1) * 2304 * 512;
#pragma unroll
        for (int ai = 0; ai < 2; ++ai)
#pragma unroll
            for (int m = 0; m < 4; ++m) { float* rowp = base + (size_t)(row0 + ai * 128 + m * 16) * 512 + col0;
#pragma unroll
                for (int bj = 0; bj < 2; ++bj)
#pragma unroll
                    for (int n = 0; n < 2; ++n) *(pg8::f32x4*)(rowp + bj * 128 + n * 16) = acc[ai][bj][m][n]; }
    }
};
struct EpiRes {
    static constexpr bool PERM = false;
    const float* xin; float* xout; const float* gate;
    __device__ __forceinline__ void operator()(const pg8::f32x4 (&acc)[2][2][4][2], const pg8::Unit& u, int wr, int wc, int fr, int fq) const {
        const int row0 = u.pm * 256 + wr * 64 + fr, col0 = u.pn * 256 + wc * 32 + 4 * fq;
        const float* gp = gate + (size_t)(u.pm >> 4) * 6144 + col0;
        pg8::f32x4 gv[2][2];
#pragma unroll
        for (int bj = 0; bj < 2; ++bj)
#pragma unroll
            for (int n = 0; n < 2; ++n) gv[bj][n] = *(const pg8::f32x4*)(gp + bj * 128 + n * 16);
#pragma unroll
        for (int ai = 0; ai < 2; ++ai)
#pragma unroll
            for (int m = 0; m < 4; ++m) { const size_t ro = (size_t)(row0 + ai * 128 + m * 16) * DM + col0;
#pragma unroll
                for (int bj = 0; bj < 2; ++bj)
#pragma unroll
                    for (int n = 0; n < 2; ++n) { const pg8::f32x4 xi = *(const pg8::f32x4*)(xin + ro + bj * 128 + n * 16);
                        *(pg8::f32x4*)(xout + ro + bj * 128 + n * 16) = xi + gv[bj][n] * acc[ai][bj][m][n]; } }
    }
};

struct TPItem { const float* src; bf16* dst; int N, K; };
__device__ __forceinline__ TPItem tp_decode(const Params& p, int it, int tid) {
    constexpr int T_IN = 32 * 96, T_OUT = 32 * 32, T_S = 64, T_L = T_IN + T_OUT + T_S;
    const int l = it / T_L; int r = it % T_L; const float* W; bf16* WT; int K, N, kb, nb;
    if (r < T_IN) { W = p.w_in + (size_t)l * DM * DIN; WT = (bf16*)(p.ws + WS_WIN) + (size_t)l * WROWS * DM; K = DM; N = DIN; kb = r / 96; nb = 8 + r % 96; }
    else if (r < T_IN + T_OUT) { r -= T_IN; W = p.w_out + (size_t)l * DM * DM; WT = (bf16*)(p.ws + WS_WOUT) + (size_t)l * DM * DM; K = DM; N = DM; kb = r >> 5; nb = r & 31; }
    else { r -= T_IN + T_OUT; W = p.w_pw + (size_t)l * DG * DG; WT = (bf16*)(p.ws + WS_WPW) + (size_t)l * DG * DG; K = DG; N = DG; kb = r >> 3; nb = r & 7; }
    TPItem t; t.N = N; t.K = K;
    t.src = W + (size_t)(kb * 64 + (tid >> 4)) * N + nb * 64 + (tid & 15) * 4;
    t.dst = WT + (size_t)(nb * 64 + (tid >> 3)) * K + kb * 64 + (tid & 7) * 8;
    return t;
}
__device__ __forceinline__ void tp_store(const TPItem& t, int tid, const f32x4& v0, const f32x4& v1, float* scr) {
    { const int kk = tid >> 4, nn = (tid & 15) * 4;
      scr[kk * 65 + nn] = v0[0]; scr[kk * 65 + nn + 1] = v0[1]; scr[kk * 65 + nn + 2] = v0[2]; scr[kk * 65 + nn + 3] = v0[3];
      scr[(kk + 32) * 65 + nn] = v1[0]; scr[(kk + 32) * 65 + nn + 1] = v1[1]; scr[(kk + 32) * 65 + nn + 2] = v1[2]; scr[(kk + 32) * 65 + nn + 3] = v1[3]; }
    __syncthreads();
    { const int n = tid >> 3, kc = (tid & 7) * 8; const float* s = scr + kc * 65 + n; u32x4 o;
      o.x = pk2(s[0], s[65]); o.y = pk2(s[2 * 65], s[3 * 65]); o.z = pk2(s[4 * 65], s[5 * 65]); o.w = pk2(s[6 * 65], s[7 * 65]);
      *(u32x4*)t.dst = o; }
    __syncthreads();
}

__device__ __forceinline__ void ph_prologue(const Params& p_, unsigned char* lds) {
    const Params p = *kparams(); (void)p_;
    const int tid = otid(), lane = tid & 63, wave = tid >> 6, G = gridDim.x, bid = obid();
    float* scr = (float*)lds;
    { constexpr int T_TOT = NL * (32 * 96 + 32 * 32 + 64);
      int it = bid; TPItem cur; f32x4 a0, a1;
      if (it < T_TOT) { cur = tp_decode(p, it, tid); a0 = __builtin_nontemporal_load((const f32x4*)cur.src); a1 = __builtin_nontemporal_load((const f32x4*)(cur.src + (size_t)32 * cur.N)); }
      while (it < T_TOT) { const int nit = it + G; TPItem nxt = cur; f32x4 b0 = a0, b1 = a1;
          if (nit < T_TOT) { nxt = tp_decode(p, nit, tid); b0 = __builtin_nontemporal_load((const f32x4*)nxt.src); b1 = __builtin_nontemporal_load((const f32x4*)(nxt.src + (size_t)32 * nxt.N)); }
          tp_store(cur, tid, a0, a1, scr);
          cur = nxt; a0 = b0; a1 = b1; it = nit; } }
    { bf16* Wfx = (bf16*)(p.ws + WS_WFXB);
      for (int e = bid * NTHR + tid; e < NL * DM * DG / 8; e += G * NTHR) { const int l = e >> 17, r = e & 131071, k = r >> 6, c8 = (r & 63) * 8;
          const float* src = p.w_in + ((size_t)l * DM + k) * DIN + c8; const f32x4 a = *(const f32x4*)src, b4 = *(const f32x4*)(src + 4);
          u32x4 o; o.x = pk2(a[0], a[1]); o.y = pk2(a[2], a[3]); o.z = pk2(b4[0], b4[1]); o.w = pk2(b4[2], b4[3]);
          *(u32x4*)(Wfx + ((size_t)l * DM + k) * DG + c8) = o; } }
    { float* Wl = (float*)lds; float* tr = Wl + 128 * 65; bf16* Wcs = (bf16*)(p.ws + WS_WCS);
      for (int t2 = G - 1 - bid; t2 < 256; t2 += G) {
          const int t = t2 >> 1, ch = t2 & 1, l = t >> 6, pq = (t >> 5) & 1, g = (t >> 3) & 3, n0 = (t & 7) * 64;
#pragma unroll
          for (int i = 0; i < 4; ++i) { const int m = (tid >> 4) + 32 * i, nn = (tid & 15) * 4;
              const f32x4 v = *(const f32x4*)(p.w_fft + ((size_t)l * DG + g * 128 + m) * DG + n0 + nn);
              Wl[m * 65 + nn] = v[0]; Wl[m * 65 + nn + 1] = v[1]; Wl[m * 65 + nn + 2] = v[2]; Wl[m * 65 + nn + 3] = v[3]; }
          if (tid < 128) tr[tid] = pq ? sinpif((float)tid * (1.f / 64.f)) : cospif((float)tid * (1.f / 64.f));
          __syncthreads();
          const int nn = tid >> 3, cc = ch * 64 + (tid & 7) * 8; float acc[8];
#pragma unroll
          for (int i = 0; i < 8; ++i) acc[i] = 0.f;
#pragma unroll 4
          for (int m = 0; m < 128; ++m) { const float w = Wl[m * 65 + nn];
#pragma unroll
              for (int i = 0; i < 8; ++i) acc[i] += tr[((cc + i) * m) & 127] * w; }
          const float nrm = 0.0013810679320049757f;
          u32x4 o0;
          o0.x = pk2(acc[0] * nrm, acc[1] * nrm); o0.y = pk2(acc[2] * nrm, acc[3] * nrm); o0.z = pk2(acc[4] * nrm, acc[5] * nrm); o0.w = pk2(acc[6] * nrm, acc[7] * nrm);
          *(u32x4*)(Wcs + ((size_t)l * 1024 + pq * 512 + n0 + nn) * DG + g * 128 + cc) = o0;
          __syncthreads();
      } }
    __syncthreads();
    float* cosT = (float*)(lds + 32768); float* sinT = (float*)(lds + 49152); float* ca = (float*)(lds + 65536); float* red = (float*)(lds + 81920);
    for (int j = tid; j < 4096; j += NTHR) { cosT[j] = cospif((float)j * (1.f / 2048.f)); sinT[j] = sinpif((float)j * (1.f / 2048.f)); }
    for (int j = tid; j < 4096; j += NTHR) { const float cv = p.c[j]; ca[j] = cv / (1.f + expf(-cv)); }
    __syncthreads();
    { bf16* DC = (bf16*)(p.ws + WS_DC); bf16* DSm = (bf16*)(p.ws + WS_DS);
      for (int r = bid * 2 + (tid >> 8); r < 4352; r += G * 2) { const int is_sin = (r >= 2304) ? 1 : 0, k = is_sin ? r - 2304 : r, s0 = (tid & 255) * 8; float v[8];
#pragma unroll
          for (int j = 0; j < 8; ++j) { const int idx = (k * (s0 + j)) & 4095; v[j] = is_sin ? sinT[idx] : cosT[idx]; }
          u32x4 o; o.x = pk2(v[0], v[1]); o.y = pk2(v[2], v[3]); o.z = pk2(v[4], v[5]); o.w = pk2(v[6], v[7]);
          *(u32x4*)((is_sin ? DSm : DC) + (size_t)k * 2048 + s0) = o; } }
    { float2* rope = (float2*)(p.ws + WS_ROPE);
      for (int e = bid * NTHR + tid; e < 4096 * 32; e += G * NTHR) { const int s = e >> 5, i = e & 31;
          const float inv = (float)pow(10000.0, -(double)i / 32.0); const float ang = (float)s * inv;
          double sn, cs; sincos((double)ang, &sn, &cs); rope[e] = make_float2((float)cs, (float)sn); } }
    float* mod = (float*)(p.ws + WS_MOD);
    for (int t = bid; t < 192; t += G) {
        const int l = t / 96, col = (t % 96) * 64 + lane; const float* W = p.w_ada + (size_t)l * DM * 6144 + col;
        float a0 = 0.f, a1 = 0.f;
        for (int k0 = wave * 256; k0 < wave * 256 + 256; k0 += 32) { float wv[32];
#pragma unroll
            for (int j = 0; j < 32; ++j) wv[j] = __builtin_nontemporal_load(W + (size_t)(k0 + j) * 6144);
            asm volatile("" ::: "memory");
#pragma unroll
            for (int j = 0; j < 32; ++j) { a0 += ca[k0 + j] * wv[j]; a1 += ca[2048 + k0 + j] * wv[j]; } }
        red[(wave * 2 + 0) * 64 + lane] = a0; red[(wave * 2 + 1) * 64 + lane] = a1;
        __syncthreads();
        if (wave < 2) { float s = 0.f;
#pragma unroll
            for (int w = 0; w < 8; ++w) s += red[(w * 2 + wave) * 64 + lane];
            mod[(size_t)(l * 2 + wave) * 6144 + col] = s + p.b_ada[l * 6144 + col]; }
        __syncthreads();
    }
}

__device__ __forceinline__ void ph_norm(const Params& p_, int l, int skip_blocks) {
    const Params p = *kparams(); (void)p_;
    const int tid = otid(), lane = tid & 63, wave = tid >> 6;
    const float* xin = (l == 0) ? p.x : p.out; bf16* h = (bf16*)(p.ws + WS_U); const float* mod = (const float*)(p.ws + WS_MOD);
    const int stride = gridDim.x * 8; const float* g = p.norm_g + l * DM;
    if (stride == 2048) {
        const int nw = (256 - skip_blocks) * 8;
        for (int pi = (obid() - skip_blocks) * 8 + wave; pi >= 0 && pi < 4096; pi += nw) {
            const int row = (pi >> 11) * 4096 + (pi & 2047);
            const f32x4* xr0 = (const f32x4*)(xin + (size_t)row * DM) + lane; const f32x4* xr1 = (const f32x4*)(xin + (size_t)(row + stride) * DM) + lane;
            const float* md = mod + (size_t)(l * 2 + (row >> 12)) * 6144;
            f32x4 v0[8], v1[8], ca[8], cb[8];
#pragma unroll
            for (int j = 0; j < 8; ++j) { v0[j] = xr0[64 * j]; v1[j] = xr1[64 * j]; }
#pragma unroll
            for (int j = 0; j < 8; ++j) { const int col = (64 * j + lane) * 4; ca[j] = *(const f32x4*)(g + col) * (*(const f32x4*)(md + 2048 + col) + 1.f); cb[j] = *(const f32x4*)(md + col); }
            asm volatile("" ::: "memory");
            float s0 = 0.f, s1 = 0.f;
#pragma unroll
            for (int j = 0; j < 8; ++j) { s0 += (v0[j][0] * v0[j][0] + v0[j][1] * v0[j][1]) + (v0[j][2] * v0[j][2] + v0[j][3] * v0[j][3]); s1 += (v1[j][0] * v1[j][0] + v1[j][1] * v1[j][1]) + (v1[j][2] * v1[j][2] + v1[j][3] * v1[j][3]); }
            s0 = wave_sum(s0); s1 = wave_sum(s1);
            const float r0 = rsqrtf(s0 * (1.f / DM) + 1e-6f), r1 = rsqrtf(s1 * (1.f / DM) + 1e-6f);
#pragma unroll
            for (int j = 0; j < 8; ++j) { const int col = (64 * j + lane) * 4;
                const f32x4 o0 = (v0[j] * r0) * ca[j] + cb[j], o1 = (v1[j] * r1) * ca[j] + cb[j]; u32x2 w;
                w.x = pk2(o0[0], o0[1]); w.y = pk2(o0[2], o0[3]); *(u32x2*)(h + (size_t)row * DM + col) = w;
                w.x = pk2(o1[0], o1[1]); w.y = pk2(o1[2], o1[3]); *(u32x2*)(h + (size_t)(row + stride) * DM + col) = w; }
        }
        return;
    }
    for (int row = obid() * 8 + wave; row < MTOK; row += stride) {
        const f32x4* xr = (const f32x4*)(xin + (size_t)row * DM) + lane; f32x4 v[8]; float ss = 0.f;
#pragma unroll
        for (int j = 0; j < 8; ++j) { v[j] = xr[64 * j]; ss += (v[j][0] * v[j][0] + v[j][1] * v[j][1]) + (v[j][2] * v[j][2] + v[j][3] * v[j][3]); }
        ss = wave_sum(ss); const float rstd = rsqrtf(ss * (1.f / DM) + 1e-6f);
        const float* md = mod + (size_t)(l * 2 + (row >> 12)) * 6144;
#pragma unroll
        for (int j = 0; j < 8; ++j) { const int col = (64 * j + lane) * 4;
            const f32x4 g4 = *(const f32x4*)(g + col), sh = *(const f32x4*)(md + col), sc = *(const f32x4*)(md + 2048 + col);
            const f32x4 o = (v[j] * rstd * g4) * (sc + 1.f) + sh; u32x2 w; w.x = pk2(o[0], o[1]); w.y = pk2(o[2], o[3]);
            *(u32x2*)(h + (size_t)row * DM + col) = w; }
    }
}
__device__ __forceinline__ void ph_final(const Params& p_) {
    const Params p = *kparams(); (void)p_;
    const int tid = otid(), lane = tid & 63, wave = tid >> 6;
    const int stride = gridDim.x * 8;
    for (int row = obid() * 8 + wave; row < MTOK; row += 2 * stride) {
        const bool two = (row + stride < MTOK);
        f32x4* xr0 = (f32x4*)(p.out + (size_t)row * DM) + lane; f32x4* xr1 = (f32x4*)(p.out + (size_t)(two ? row + stride : row) * DM) + lane;
        f32x4 v0[8], v1[8], g4[8];
#pragma unroll
        for (int j = 0; j < 8; ++j) { v0[j] = xr0[64 * j]; v1[j] = xr1[64 * j]; g4[j] = *(const f32x4*)(p.final_g + (64 * j + lane) * 4); }
        asm volatile("" ::: "memory");
        float s0 = 0.f, s1 = 0.f;
#pragma unroll
        for (int j = 0; j < 8; ++j) { s0 += (v0[j][0] * v0[j][0] + v0[j][1] * v0[j][1]) + (v0[j][2] * v0[j][2] + v0[j][3] * v0[j][3]); s1 += (v1[j][0] * v1[j][0] + v1[j][1] * v1[j][1]) + (v1[j][2] * v1[j][2] + v1[j][3] * v1[j][3]); }
        s0 = wave_sum(s0); s1 = wave_sum(s1);
        const float r0 = rsqrtf(s0 * (1.f / DM) + 1e-6f), r1 = rsqrtf(s1 * (1.f / DM) + 1e-6f);
#pragma unroll
        for (int j = 0; j < 8; ++j) { xr0[64 * j] = v0[j] * r0 * g4[j]; if (two) xr1[64 * j] = v1[j] * r1 * g4[j]; }
    }
}

#ifndef REP_PRO
#define REP_PRO 1
#endif
#ifndef REP_NORM
#define REP_NORM 1
#endif
#ifndef REP_Z
#define REP_Z 1
#endif
#ifndef REP_MIX
#define REP_MIX 1
#endif
#ifndef REP_P3
#define REP_P3 1
#endif
#ifndef REP_R2
#define REP_R2 1
#endif
#ifndef REP_CMB
#define REP_CMB 1
#endif
#ifndef REP_FFT
#define REP_FFT 1
#endif
#ifndef REP_OUT
#define REP_OUT 1
#endif
#ifndef REP_SUB
#define REP_SUB 1
#endif

#ifndef REP_R1
#define REP_R1 1
#endif
#ifndef REP_NA
#define REP_NA 1
#endif
#ifndef REP_CV
#define REP_CV 1
#endif
#ifndef REP_F1
#define REP_F1 1
#endif
#define REPEAT(n) for (int rep_ = 0; rep_ < (n); ++rep_)
typedef short bf16x8v __attribute__((ext_vector_type(8)));
__device__ __forceinline__ bf16x8v mk8(unsigned a, unsigned b, unsigned c, unsigned d) { u32x4 v = {a, b, c, d}; return __builtin_bit_cast(bf16x8v, v); }
#define MFMA16(a, b, c) __builtin_amdgcn_mfma_f32_16x16x32_bf16(a, b, c, 0, 0, 0)
constexpr int R_QS = 0, R_KS = 18432, R_VT = 36864, R_KTF = 54272, R_KTB = 71680, R_STF = 89088, R_STB = 98304;

template <bool R2>
__device__ __forceinline__ void ret_stage(const Params& p_, int b, int h, int n, unsigned char* lds, float l2f, float l2b) {
    const Params p = *kparams(); (void)p_;
    const int tid = otid(), j = tid >> 2, c4 = tid & 3, s = n * 128 + j;
    const bf16* Z = (const bf16*)(p.ws + WS_Z); const bf16* zr = Z + (size_t)(b * SEQ + s) * DIN;
    const f32x4* rp = (const f32x4*)((const float2*)(p.ws + WS_ROPE) + s * 32 + c4 * 8);
    f32x4 rr[4];
#pragma unroll
    for (int i = 0; i < 4; ++i) rr[i] = rp[i];
    const u32x4 ka = *(const u32x4*)(zr + 7 * DG + h * 64 + c4 * 8), kb = *(const u32x4*)(zr + 7 * DG + h * 64 + 32 + c4 * 8);
    const u32x4 va = *(const u32x4*)(zr + 8 * DG + h * 64 + c4 * 16), vb = *(const u32x4*)(zr + 8 * DG + h * 64 + c4 * 16 + 8);
    u32x4 qa = ka, qb = kb;
    if (R2) { qa = *(const u32x4*)(zr + 6 * DG + h * 64 + c4 * 8); qb = *(const u32x4*)(zr + 6 * DG + h * 64 + 32 + c4 * 8); }
    asm volatile("" ::: "memory");
    float cs[8], sn[8];
#pragma unroll
    for (int i = 0; i < 4; ++i) { const f32x4 r = rr[i]; cs[2 * i] = r[0]; sn[2 * i] = r[1]; cs[2 * i + 1] = r[2]; sn[2 * i + 1] = r[3]; }
    bf16* KS = (bf16*)(lds + R_KS); bf16* VT = (bf16*)(lds + R_VT);
    {
      const unsigned kau[4] = {ka.x, ka.y, ka.z, ka.w}, kbu[4] = {kb.x, kb.y, kb.z, kb.w};
      float k1[8], k2[8];
#pragma unroll
      for (int i = 0; i < 4; ++i) { const float a0 = bflo(kau[i]), a1 = bfhi(kau[i]), b0 = bflo(kbu[i]), b1 = bfhi(kbu[i]);
          k1[2 * i] = a0 * cs[2 * i] - b0 * sn[2 * i]; k2[2 * i] = a0 * sn[2 * i] + b0 * cs[2 * i];
          k1[2 * i + 1] = a1 * cs[2 * i + 1] - b1 * sn[2 * i + 1]; k2[2 * i + 1] = a1 * sn[2 * i + 1] + b1 * cs[2 * i + 1]; }
      u32x4 o1, o2; o1.x = pk2(k1[0], k1[1]); o1.y = pk2(k1[2], k1[3]); o1.z = pk2(k1[4], k1[5]); o1.w = pk2(k1[6], k1[7]);
      o2.x = pk2(k2[0], k2[1]); o2.y = pk2(k2[2], k2[3]); o2.z = pk2(k2[4], k2[5]); o2.w = pk2(k2[6], k2[7]);
      *(u32x4*)(KS + j * 72 + c4 * 8) = o1; *(u32x4*)(KS + j * 72 + 32 + c4 * 8) = o2;
      if (!R2) { bf16* KTF = (bf16*)(lds + R_KTF); bf16* KTB = (bf16*)(lds + R_KTB);
          const float df = exp2f(l2f * (float)(127 - j)), db = exp2f(l2b * (float)j);
#pragma unroll
          for (int i = 0; i < 8; ++i) { KTF[(c4 * 8 + i) * 136 + j] = (bf16)f2bf(k1[i] * df); KTF[(32 + c4 * 8 + i) * 136 + j] = (bf16)f2bf(k2[i] * df);
              KTB[(c4 * 8 + i) * 136 + j] = (bf16)f2bf(k1[i] * db); KTB[(32 + c4 * 8 + i) * 136 + j] = (bf16)f2bf(k2[i] * db); } } }
    {
      const unsigned vu[8] = {va.x, va.y, va.z, va.w, vb.x, vb.y, vb.z, vb.w};
#pragma unroll
      for (int i = 0; i < 8; ++i) { VT[(c4 * 16 + 2 * i) * 136 + j] = (bf16)(vu[i] & 0xffffu); VT[(c4 * 16 + 2 * i + 1) * 136 + j] = (bf16)(vu[i] >> 16); } }
    if (R2) { bf16* QS = (bf16*)(lds + R_QS);
      const unsigned qau[4] = {qa.x, qa.y, qa.z, qa.w}, qbu[4] = {qb.x, qb.y, qb.z, qb.w};
      float q1[8], q2[8];
#pragma unroll
      for (int i = 0; i < 4; ++i) { const float a0 = bflo(qau[i]), a1 = bfhi(qau[i]), b0 = bflo(qbu[i]), b1 = bfhi(qbu[i]);
          q1[2 * i] = (a0 * cs[2 * i] - b0 * sn[2 * i]) * 0.125f; q2[2 * i] = (a0 * sn[2 * i] + b0 * cs[2 * i]) * 0.125f;
          q1[2 * i + 1] = (a1 * cs[2 * i + 1] - b1 * sn[2 * i + 1]) * 0.125f; q2[2 * i + 1] = (a1 * sn[2 * i + 1] + b1 * cs[2 * i + 1]) * 0.125f; }
      u32x4 o1, o2; o1.x = pk2(q1[0], q1[1]); o1.y = pk2(q1[2], q1[3]); o1.z = pk2(q1[4], q1[5]); o1.w = pk2(q1[6], q1[7]);
      o2.x = pk2(q2[0], q2[1]); o2.y = pk2(q2[2], q2[3]); o2.z = pk2(q2[4], q2[5]); o2.w = pk2(q2[6], q2[7]);
      *(u32x4*)(QS + j * 72 + c4 * 8) = o1; *(u32x4*)(QS + j * 72 + 32 + c4 * 8) = o2; }
}

__device__ __forceinline__ void ret1_task(const Params& p_, int l, int task, unsigned char* lds) {
    const Params p = *kparams(); (void)p_;
    const int n = task & 31, h = (task >> 5) & 7, b = task >> 8;
    const float xf = p.rl_f[l * 8 + h], xb = p.rl_b[l * 8 + h];
    const float l2f = -log1pf(expf(-xf)) * 1.4426950408889634f, l2b = -log1pf(expf(-xb)) * 1.4426950408889634f;
    ret_stage<false>(p, b, h, n, lds, l2f, l2b);
    __syncthreads();
    const int tid = otid(), lane = tid & 63, w = tid >> 6, fr = lane & 15, fq = lane >> 4, dir = w >> 2, et = w & 3;
    const bf16* VT = (const bf16*)(lds + R_VT); const bf16* KT = (const bf16*)(lds + (dir ? R_KTB : R_KTF));
    bf16x8v a[4];
#pragma unroll
    for (int ks = 0; ks < 4; ++ks) a[ks] = *(const bf16x8v*)(VT + (16 * et + fr) * 136 + 32 * ks + 8 * fq);
    float* dst = (float*)(p.ws + WS_KV) + ((size_t)((dir * 2 + b) * 8 + h) * 32 + n) * 4096;
#pragma unroll
    for (int dt = 0; dt < 4; ++dt) { f32x4 acc = {0.f, 0.f, 0.f, 0.f};
#pragma unroll
        for (int ks = 0; ks < 4; ++ks) { const bf16x8v bfr = *(const bf16x8v*)(KT + (16 * dt + fr) * 136 + 32 * ks + 8 * fq); acc = MFMA16(a[ks], bfr, acc); }
#pragma unroll
        for (int r = 0; r < 4; ++r) dst[(16 * et + 4 * fq + r) * 64 + 16 * dt + fr] = acc[r]; }
    __syncthreads();
}

__device__ __forceinline__ void ret2_task(const Params& p_, int l, int task, unsigned char* lds) {
    const Params p = *kparams(); (void)p_;
    const int n = task & 31, h = (task >> 5) & 7, b = task >> 8;
    const float xf = p.rl_f[l * 8 + h], xb = p.rl_b[l * 8 + h];
    const float l2f = -log1pf(expf(-xf)) * 1.4426950408889634f, l2b = -log1pf(expf(-xb)) * 1.4426950408889634f;
    ret_stage<true>(p, b, h, n, lds, l2f, l2b);
    const int tid = otid(), lane = tid & 63, w = tid >> 6, fr = lane & 15, fq = lane >> 4;
    {
      const float gfC = exp2f(l2f * 128.f), gbC = exp2f(l2b * 128.f);
      const float* KVf = (const float*)(p.ws + WS_KV) + ((size_t)((0 * 2 + b) * 8 + h) * 32) * 4096 + tid * 8;
      const float* KVb = (const float*)(p.ws + WS_KV) + ((size_t)((1 * 2 + b) * 8 + h) * 32) * 4096 + tid * 8;
      f32x4 f0 = {0.f, 0.f, 0.f, 0.f}, f1 = f0, g0 = f0, g1 = f0;
      { float c0 = 1.f; int m = n - 1;
        for (; m >= 7; m -= 8) { f32x4 xa[8], xb[8];
#pragma unroll
            for (int j = 0; j < 8; ++j) { xa[j] = *(const f32x4*)(KVf + (size_t)(m - j) * 4096); xb[j] = *(const f32x4*)(KVf + (size_t)(m - j) * 4096 + 4); }
            asm volatile("" ::: "memory");
#pragma unroll
            for (int j = 0; j < 8; ++j) { f0 += xa[j] * c0; f1 += xb[j] * c0; c0 *= gfC; } }
        for (; m >= 0; --m) { const f32x4 x0 = *(const f32x4*)(KVf + (size_t)m * 4096), x1 = *(const f32x4*)(KVf + (size_t)m * 4096 + 4); f0 += x0 * c0; f1 += x1 * c0; c0 *= gfC; } }
      { float c0 = 1.f; int m = n + 1;
        for (; m + 7 < 32; m += 8) { f32x4 xa[8], xb[8];
#pragma unroll
            for (int j = 0; j < 8; ++j) { xa[j] = *(const f32x4*)(KVb + (size_t)(m + j) * 4096); xb[j] = *(const f32x4*)(KVb + (size_t)(m + j) * 4096 + 4); }
            asm volatile("" ::: "memory");
#pragma unroll
            for (int j = 0; j < 8; ++j) { g0 += xa[j] * c0; g1 += xb[j] * c0; c0 *= gbC; } }
        for (; m < 32; ++m) { const f32x4 x0 = *(const f32x4*)(KVb + (size_t)m * 4096), x1 = *(const f32x4*)(KVb + (size_t)m * 4096 + 4); g0 += x0 * c0; g1 += x1 * c0; c0 *= gbC; } }
      const int e = tid >> 3, d0 = (tid & 7) * 8; u32x4 o;
      o.x = pk2(f0[0], f0[1]); o.y = pk2(f0[2], f0[3]); o.z = pk2(f1[0], f1[1]); o.w = pk2(f1[2], f1[3]); *(u32x4*)((bf16*)(lds + R_STF) + e * 72 + d0) = o;
      o.x = pk2(g0[0], g0[1]); o.y = pk2(g0[2], g0[3]); o.z = pk2(g1[0], g1[1]); o.w = pk2(g1[2], g1[3]); *(u32x4*)((bf16*)(lds + R_STB) + e * 72 + d0) = o; }
    __syncthreads();
    const bf16* QS = (const bf16*)(lds + R_QS); const bf16* KS = (const bf16*)(lds + R_KS); const bf16* VT = (const bf16*)(lds + R_VT);
    const bf16* STF = (const bf16*)(lds + R_STF); const bf16* STB = (const bf16*)(lds + R_STB);
    bf16x8v qf[2];
#pragma unroll
    for (int ks = 0; ks < 2; ++ks) qf[ks] = *(const bf16x8v*)(QS + (16 * w + fr) * 72 + 32 * ks + 8 * fq);
    const int ai = 16 * w + fr;
    unsigned pp[8][2];
#pragma unroll
    for (int jt = 0; jt < 8; ++jt) { f32x4 acc = {0.f, 0.f, 0.f, 0.f};
#pragma unroll
        for (int ks = 0; ks < 2; ++ks) { const bf16x8v kf = *(const bf16x8v*)(KS + (16 * jt + fr) * 72 + 32 * ks + 8 * fq); acc = MFMA16(kf, qf[ks], acc); }
        float sc[4];
#pragma unroll
        for (int r = 0; r < 4; ++r) { const int aj = 16 * jt + 4 * fq + r; const float wg = (aj <= ai) ? exp2f(l2f * (float)(ai - aj)) : exp2f(l2b * (float)(aj - ai)); sc[r] = acc[r] * wg; }
        pp[jt][0] = pk2(sc[0], sc[1]); pp[jt][1] = pk2(sc[2], sc[3]); }
    const float qdf = exp2f(l2f * (float)(ai + 1)), qdb = exp2f(l2b * (float)(128 - ai));
    f32x4 tot[4]; float ss = 0.f;
#pragma unroll
    for (int et = 0; et < 4; ++et) { f32x4 o = {0.f, 0.f, 0.f, 0.f}, cfa = o, cba = o;
#pragma unroll
        for (int t = 0; t < 4; ++t) { const u32x2 vlo = *(const u32x2*)(VT + (16 * et + fr) * 136 + 32 * t + 4 * fq), vhi = *(const u32x2*)(VT + (16 * et + fr) * 136 + 32 * t + 16 + 4 * fq);
            o = MFMA16(mk8(vlo.x, vlo.y, vhi.x, vhi.y), mk8(pp[2 * t][0], pp[2 * t][1], pp[2 * t + 1][0], pp[2 * t + 1][1]), o); }
#pragma unroll
        for (int ks = 0; ks < 2; ++ks) { const bf16x8v sf = *(const bf16x8v*)(STF + (16 * et + fr) * 72 + 32 * ks + 8 * fq), sb = *(const bf16x8v*)(STB + (16 * et + fr) * 72 + 32 * ks + 8 * fq);
            cfa = MFMA16(sf, qf[ks], cfa); cba = MFMA16(sb, qf[ks], cba); }
        tot[et] = o + cfa * qdf + cba * qdb;
        ss += (tot[et][0] * tot[et][0] + tot[et][1] * tot[et][1]) + (tot[et][2] * tot[et][2] + tot[et][3] * tot[et][3]); }
    ss += __shfl_xor(ss, 16); ss += __shfl_xor(ss, 32);
    const float rs = rsqrtf(ss * (1.f / 64.f) + 1e-6f);
    const size_t tok = (size_t)b * SEQ + n * 128 + ai;
    const bf16* Z = (const bf16*)(p.ws + WS_Z); bf16* CAT = (bf16*)(p.ws + WS_CAT);
#pragma unroll
    for (int et = 0; et < 4; ++et) { const u32x2 gz = *(const u32x2*)(Z + tok * DIN + 9 * DG + h * 64 + 16 * et + 4 * fq); u32x2 o;
        o.x = pk2(tot[et][0] * rs * silu_f(bflo(gz.x)), tot[et][1] * rs * silu_f(bfhi(gz.x))); o.y = pk2(tot[et][2] * rs * silu_f(bflo(gz.y)), tot[et][3] * rs * silu_f(bfhi(gz.y)));
        *(u32x2*)(CAT + tok * DM + 1024 + h * 64 + 16 * et + 4 * fq) = o; }
    __syncthreads();
}

__device__ __forceinline__ void na2_task(const Params& p_, int l, int task, unsigned char* lds) {
    const Params p = *kparams(); (void)p_;
    const int tid = otid(), lane = tid & 63, w = tid >> 6, fr = lane & 15, fq = lane >> 4;
    const int hp = task & 3, rq = (task >> 2) & 63, b = task >> 8;
    const int row_start = min(max(rq - 4, 0), 56);
    const bf16* Z = (const bf16*)(p.ws + WS_Z); bf16* CAT = (bf16*)(p.ws + WS_CAT);
    bf16* VT = (bf16*)lds; float* BI = (float*)(lds + 133120);
    const int hh = w >> 2, h = hp * 2 + hh, qb = w & 3, kst = min(max(16 * qb - 8, 0), 32);
    const int c = 16 * qb + fr; const size_t qtok = (size_t)b * SEQ + rq * 64 + c;
    bf16x8v qf[2], kfr[8][2];
#pragma unroll
    for (int ks = 0; ks < 2; ++ks) qf[ks] = *(const bf16x8v*)(Z + qtok * DIN + 2 * DG + h * 64 + 32 * ks + 8 * fq);
#pragma unroll
    for (int i = 0; i < 8; ++i) { const int a = i / 2, ci = i % 2;
        const size_t ktok = (size_t)b * SEQ + (row_start + a) * 64 + kst + 16 * ci + fr;
#pragma unroll
        for (int ks = 0; ks < 2; ++ks) kfr[i][ks] = *(const bf16x8v*)(Z + ktok * DIN + 3 * DG + h * 64 + 32 * ks + 8 * fq); }
    asm volatile("" ::: "memory");
    for (int i = tid; i < 930; i += NTHR) BI[i] = p.na_bias[(size_t)(l * 8 + hp * 2) * 465 + i];
    { const int pair = lane & 31, chunk = (lane >> 5) + 2 * (w & 3);
      unsigned* VTd = (unsigned*)(VT + (size_t)hh * 64 * 520);
      u32x4 xs[8], ys[8];
#pragma unroll
      for (int a = 0; a < 8; ++a) { const size_t tok = (size_t)b * SEQ + (row_start + a) * 64 + 2 * pair;
          const bf16* src = Z + tok * DIN + 4 * DG + h * 64 + chunk * 8; xs[a] = *(const u32x4*)src; ys[a] = *(const u32x4*)(src + DIN); }
      asm volatile("" ::: "memory");
#pragma unroll
      for (int a = 0; a < 8; ++a) { const unsigned xu[4] = {xs[a].x, xs[a].y, xs[a].z, xs[a].w}, yu[4] = {ys[a].x, ys[a].y, ys[a].z, ys[a].w};
#pragma unroll
          for (int i = 0; i < 4; ++i) { VTd[(chunk * 8 + 2 * i) * 260 + a * 32 + pair] = (xu[i] & 0xffffu) | (yu[i] << 16);
              VTd[(chunk * 8 + 2 * i + 1) * 260 + a * 32 + pair] = (xu[i] >> 16) | (yu[i] & 0xffff0000u); } } }
    __syncthreads();
    const int col_start = min(max(c - 8, 0), 48);
    const float* bi = BI + hh * 465;
    float sc[16][4]; float mx = -1e30f;
#pragma unroll
    for (int hf = 0; hf < 2; ++hf) {
        if (hf == 1) {
#pragma unroll
            for (int i = 0; i < 8; ++i) { const int a = 4 + i / 2, ci = i % 2;
                const size_t ktok = (size_t)b * SEQ + (row_start + a) * 64 + kst + 16 * ci + fr;
#pragma unroll
                for (int ks = 0; ks < 2; ++ks) kfr[i][ks] = *(const bf16x8v*)(Z + ktok * DIN + 3 * DG + h * 64 + 32 * ks + 8 * fq); }
            asm volatile("" ::: "memory");
        }
#pragma unroll
        for (int i = 0; i < 8; ++i) { const int a = 4 * hf + i / 2, ci = i % 2, kt = a * 2 + ci;
            f32x4 acc = {0.f, 0.f, 0.f, 0.f};
#pragma unroll
            for (int ks = 0; ks < 2; ++ks) acc = MFMA16(kfr[i][ks], qf[ks], acc);
            const int dr = row_start + a - rq;
#pragma unroll
            for (int r = 0; r < 4; ++r) { const int kc = kst + 16 * ci + 4 * fq + r, rel = kc - col_start, dc = kc - c;
                float v = acc[r] * 0.125f + bi[(dr + 7) * 31 + min(max(dc + 15, 0), 30)];
                v = (rel >= 0 && rel < 16) ? v : -1e30f; sc[kt][r] = v; mx = fmaxf(mx, v); } }
    }
    mx = fmaxf(mx, __shfl_xor(mx, 16)); mx = fmaxf(mx, __shfl_xor(mx, 32));
    float sum = 0.f; unsigned pp[16][2];
#pragma unroll
    for (int kt = 0; kt < 16; ++kt) { const float e0 = __expf(sc[kt][0] - mx), e1 = __expf(sc[kt][1] - mx), e2 = __expf(sc[kt][2] - mx), e3 = __expf(sc[kt][3] - mx);
        sum += (e0 + e1) + (e2 + e3); pp[kt][0] = pk2(e0, e1); pp[kt][1] = pk2(e2, e3); }
    sum += __shfl_xor(sum, 16); sum += __shfl_xor(sum, 32);
    const float inv = 1.f / sum;
    const bf16* VTh = VT + (size_t)hh * 64 * 520;
#pragma unroll
    for (int dt = 0; dt < 4; ++dt) { f32x4 o = {0.f, 0.f, 0.f, 0.f};
#pragma unroll
        for (int t = 0; t < 8; ++t) { const int k0 = 2 * t, k1 = 2 * t + 1, a0 = k0 / 2, c0 = k0 % 2, a1 = k1 / 2, c1 = k1 % 2;
            const u32x2 vlo = *(const u32x2*)(VTh + (16 * dt + fr) * 520 + a0 * 64 + kst + 16 * c0 + 4 * fq), vhi = *(const u32x2*)(VTh + (16 * dt + fr) * 520 + a1 * 64 + kst + 16 * c1 + 4 * fq);
            o = MFMA16(mk8(vlo.x, vlo.y, vhi.x, vhi.y), mk8(pp[k0][0], pp[k0][1], pp[k1][0], pp[k1][1]), o); }
        const u32x2 gz = *(const u32x2*)(Z + qtok * DIN + 5 * DG + h * 64 + 16 * dt + 4 * fq); u32x2 ov;
        ov.x = pk2(o[0] * inv * silu_f(bflo(gz.x)), o[1] * inv * silu_f(bfhi(gz.x))); ov.y = pk2(o[2] * inv * silu_f(bflo(gz.y)), o[3] * inv * silu_f(bfhi(gz.y)));
        *(u32x2*)(CAT + qtok * DM + 512 + h * 64 + 16 * dt + 4 * fq) = ov; }
    __syncthreads();
}

__device__ __forceinline__ void conv_task(const Params& p_, int l, int task, unsigned char* lds) {
    const Params p = *kparams(); (void)p_;
    const int tid = otid(), lane = tid & 63, wave = tid >> 6;
    float* us = (float*)lds; float* ys = us + 46 * 512;
    const bf16* Z = (const bf16*)(p.ws + WS_Z);
    const int b = task >> 8, t0 = (task & 255) * 16;
    { u32x4 av[6], gv[6];
#pragma unroll
      for (int it = 0; it < 6; ++it) { const int idx = tid + it * NTHR, tt = idx >> 6, cc = (idx & 63) * 8, tok = t0 - 15 + tt;
          av[it] = (u32x4){0u, 0u, 0u, 0u}; gv[it] = av[it];
          if (idx < 46 * 64 && tok >= 0 && tok < SEQ) { const bf16* zr = Z + (size_t)(b * SEQ + tok) * DIN; av[it] = *(const u32x4*)(zr + 10 * DG + cc); gv[it] = *(const u32x4*)(zr + 11 * DG + cc); } }
      asm volatile("" ::: "memory");
#pragma unroll
      for (int it = 0; it < 6; ++it) { const int idx = tid + it * NTHR, tt = idx >> 6, cc = (idx & 63) * 8;
          if (idx < 46 * 64) { const u32x4 a = av[it], g = gv[it]; f32x4 u0, u1;
              u0[0] = bflo(a.x) / (1.f + __expf(-bflo(g.x))); u0[1] = bfhi(a.x) / (1.f + __expf(-bfhi(g.x))); u0[2] = bflo(a.y) / (1.f + __expf(-bflo(g.y))); u0[3] = bfhi(a.y) / (1.f + __expf(-bfhi(g.y)));
              u1[0] = bflo(a.z) / (1.f + __expf(-bflo(g.z))); u1[1] = bfhi(a.z) / (1.f + __expf(-bfhi(g.z))); u1[2] = bflo(a.w) / (1.f + __expf(-bflo(g.w))); u1[3] = bfhi(a.w) / (1.f + __expf(-bfhi(g.w)));
              *(f32x4*)(us + tt * 512 + cc) = u0; *(f32x4*)(us + tt * 512 + cc + 4) = u1; } } }
    float w[31];
#pragma unroll
    for (int k = 0; k < 31; ++k) w[k] = p.conv_w[(size_t)(l * 31 + k) * DG + tid];
    const float cb = p.conv_b[l * DG + tid];
    __syncthreads();
    { float y[16];
#pragma unroll
      for (int t = 0; t < 16; ++t) y[t] = cb;
#pragma unroll
      for (int j = 0; j < 46; ++j) { const float u = us[j * 512 + tid];
#pragma unroll
          for (int t = 0; t < 16; ++t) { const int k = j - t; if (k >= 0 && k < 31) y[t] += w[k] * u; } }
#pragma unroll
      for (int t = 0; t < 16; ++t) ys[t * 512 + tid] = y[t]; }
    __syncthreads();
#pragma unroll
    for (int tw = 0; tw < 2; ++tw) { const int t = wave + 8 * tw; float v[8]; float s = 0.f;
#pragma unroll
        for (int j = 0; j < 8; ++j) { v[j] = ys[t * 512 + lane + 64 * j]; s += v[j]; }
        const float mu = wave_sum(s) * (1.f / 512.f); float q = 0.f;
#pragma unroll
        for (int j = 0; j < 8; ++j) { v[j] -= mu; q += v[j] * v[j]; }
        const float rstd = rsqrtf(wave_sum(q) * (1.f / 512.f) + 1e-6f);
        bf16* orow = (bf16*)(p.ws + WS_CVH) + (size_t)(b * SEQ + t0 + t) * DG;
#pragma unroll
        for (int j = 0; j < 8; ++j) { const int ch = lane + 64 * j; const float y = v[j] * rstd * p.ln_g[l * DG + ch] + p.ln_b[l * DG + ch]; orow[ch] = (bf16)f2bf(silu_f(y)); } }
    __syncthreads();
}

__device__ __forceinline__ void ph_mixA(const Params& p, int l, unsigned char* lds) {
    const int G = gridDim.x, bid = obid();
    for (int t = bid; t < 512 * REP_R1; t += G) ret1_task(p, l, t & 511, lds);
    const int xcd = bid & 7, slot = bid >> 3, nloc = (slot < 16) ? 1 : 3, r0 = (slot < 16) ? slot : 16 + (slot - 16) * 3;
    if (G == 256 && REP_NA == 1) {
        for (int i = 0; i < nloc; ++i) { const int rq = (slot < 16) ? slot : 16 + i * 16 + (slot - 16);
            na2_task(p, l, (xcd >> 2) * 256 + rq * 4 + (xcd & 3), lds); }
    } else for (int t = bid; t < 512 * REP_NA; t += G) na2_task(p, l, t & 511, lds);
    if (G == 256 && REP_CV == 1) {
        for (int i = 0; i < 2; ++i) conv_task(p, l, xcd * 64 + i * 32 + slot, lds);
    } else for (int t = bid; t < 512 * REP_CV; t += G) conv_task(p, l, t & 511, lds);
}

__device__ __forceinline__ void ph_fold(const Params& p_) {
    const Params p = *kparams(); (void)p_;
    const bf16* PQ = (const bf16*)(p.ws + WS_PQT); bf16* PQF = (bf16*)(p.ws + WS_PQF);
    for (int e = obid() * NTHR + otid(); e < NB * DG * 2 * 256; e += gridDim.x * NTHR) {
        const int row = e >> 8, s0 = (e & 255) * 8, pq = row & 1;
        const bf16* src = PQ + (size_t)row * 4096;
        const u32x4 own = *(const u32x4*)(src + s0), low = *(const u32x4*)(src + 4096 - s0 - 8);
        const float top = (s0 == 0) ? 0.f : bf2f(src[4096 - s0]);
        const float sg = pq ? -1.f : 1.f;
        float o[8];
        o[0] = bflo(own.x) + sg * top;            o[1] = bfhi(own.x) + sg * bfhi(low.w);
        o[2] = bflo(own.y) + sg * bflo(low.w);    o[3] = bfhi(own.y) + sg * bfhi(low.z);
        o[4] = bflo(own.z) + sg * bflo(low.z);    o[5] = bfhi(own.z) + sg * bfhi(low.y);
        o[6] = bflo(own.w) + sg * bflo(low.y);    o[7] = bfhi(own.w) + sg * bfhi(low.x);
        if (s0 == 0 && pq) o[0] = 0.f;
        u32x4 w; w.x = pk2(o[0], o[1]); w.y = pk2(o[2], o[3]); w.z = pk2(o[4], o[5]); w.w = pk2(o[6], o[7]);
        *(u32x4*)(PQF + (size_t)row * 2048 + s0) = w;
    }
}
__device__ __forceinline__ void ph_alt(const Params& p_) {
    const Params p = *kparams(); (void)p_;
    const int tid = otid(), lane = tid & 63, wave = tid >> 6; const bf16* PQF = (const bf16*)(p.ws + WS_PQF);
    float* dst = (float*)(p.ws + WS_PART) + (size_t)(2 * 2304 + 2 * 2048) * 512;
    for (int r = obid() * 8 + wave; r < NB * DG; r += gridDim.x * 8) {
        const u32x4* src = (const u32x4*)(PQF + (size_t)r * 4096) + lane; float acc = 0.f;
#pragma unroll
        for (int j = 0; j < 4; ++j) { const u32x4 v = src[64 * j];
            acc += (bflo(v.x) - bfhi(v.x)) + (bflo(v.y) - bfhi(v.y)) + (bflo(v.z) - bfhi(v.z)) + (bflo(v.w) - bfhi(v.w)); }
        acc = wave_sum(acc);
        if (lane == 0) dst[r] = acc;
    }
}
__device__ __forceinline__ void ph_combine(const Params& p_) {
    const Params p = *kparams(); (void)p_;
    const float* Ce = (const float*)(p.ws + WS_PART); const float* So = Ce + (size_t)2 * 2304 * 512;
    bf16* CAT = (bf16*)(p.ws + WS_CAT); const bf16* Z = (const bf16*)(p.ws + WS_Z); const bf16* PQ = (const bf16*)(p.ws + WS_PQT);
    const int nth = gridDim.x * NTHR;
    for (int e0 = obid() * NTHR + otid(); e0 < MTOK * DG / 4; e0 += 2 * nth) {
        f32x4 ce[2], so[2]; u32x2 gz[2]; float pv[2][4]; int rowv[2], c4v[2], kv[2]; bool use_so[2], act[2];
#pragma unroll
        for (int u = 0; u < 2; ++u) { const int e = e0 + u * nth; act[u] = e < MTOK * DG / 4; const int ee = act[u] ? e : e0;
            const int row = ee >> 7, c4 = (ee & 127) * 4, b = row >> 12, k = row & 4095, kk = (k <= 2048) ? k : 4096 - k;
            rowv[u] = row; c4v[u] = c4; kv[u] = k; use_so[u] = (kk != 0 && kk != 2048);
            ce[u] = (kk == 2048) ? *(const f32x4*)(Ce + (size_t)(2 * 2304 + 2 * 2048) * 512 + b * 512 + c4) : *(const f32x4*)(Ce + ((size_t)b * 2304 + kk) * 512 + c4);
            so[u] = *(const f32x4*)(So + ((size_t)b * 2048 + (use_so[u] ? kk : 1)) * 512 + c4);
            gz[u] = *(const u32x2*)(Z + (size_t)row * DIN + DG + c4);
#pragma unroll
            for (int j = 0; j < 4; ++j) pv[u][j] = bf2f(PQ[((size_t)(b * 512 + c4 + j) * 2) * 4096 + 2048]); }
        asm volatile("" ::: "memory");
#pragma unroll
        for (int u = 0; u < 2; ++u) if (act[u]) { f32x4 s = ce[u];
            if (use_so[u]) s = (kv[u] <= 2048) ? s - so[u] : s + so[u];
            const float alt = (kv[u] & 1) ? -1.f : 1.f;
#pragma unroll
            for (int j = 0; j < 4; ++j) s[j] += alt * pv[u][j];
            u32x2 w; w.x = pk2(s[0] * silu_f(bflo(gz[u].x)), s[1] * silu_f(bfhi(gz[u].x))); w.y = pk2(s[2] * silu_f(bflo(gz[u].y)), s[3] * silu_f(bfhi(gz[u].y)));
            *(u32x2*)(CAT + (size_t)rowv[u] * DM + c4v[u]) = w; }
    }
}

#define XB_TMO      128
#define XB_XCNT(j)  (256  + 64 * (j))
#define XB_XSUB(j)  (1280 + 64 * (j))
#define XB_XGEN(j)  (2304 + 64 * (j))
#define XB_TOP      3328
#define XB_TOPGEN   3392
#define XCD_BAR_WORDS 3456
#define XB_SPIN_CAP (1u << 20)
__device__ __forceinline__ unsigned xb_ld(unsigned* p)              { return __hip_atomic_load(p, __ATOMIC_RELAXED, __HIP_MEMORY_SCOPE_AGENT); }
__device__ __forceinline__ unsigned xb_add(unsigned* p, unsigned v) { return __hip_atomic_fetch_add(p, v, __ATOMIC_RELAXED, __HIP_MEMORY_SCOPE_AGENT); }
__device__ __forceinline__ unsigned xb_xcc_id() { return (unsigned)__builtin_amdgcn_s_getreg((3 << 11) | 20) & 0xFu; }
#define XB_SPIN(cond, bar) do { unsigned _sp = 0; while (cond) { __builtin_amdgcn_s_sleep(1); \
    if ((++_sp & 255u) == 0u) { if (xb_ld(&(bar)[XB_TMO])) break; if (_sp > XB_SPIN_CAP) { atomicAdd(&(bar)[XB_TMO], 1u); break; } } } } while (0)
struct XcdBarrier { unsigned* bar; unsigned x; volatile PG8_LAS unsigned* st; };
__device__ __forceinline__ XcdBarrier xcd_barrier_post(unsigned* bar, volatile PG8_LAS unsigned* st) {
    XcdBarrier b; b.bar = bar; b.x = xb_xcc_id(); b.st = st;
    if (otid() == 0) (void)xb_add(&bar[XB_XCNT(b.x)], 1u);
    return b;
}
__device__ __forceinline__ void xcd_barrier_complete(unsigned* bar, unsigned x, unsigned& nloc, unsigned& nx) {
    const unsigned G = gridDim.x * gridDim.y * gridDim.z;
    unsigned sum, cnt, mine, sp = 0u;
    for (;;) {
        sum = 0u; cnt = 0u; mine = 0u;
#pragma unroll
        for (unsigned j = 0; j < 16; ++j) { const unsigned c = xb_ld(&bar[XB_XCNT(j)]); sum += c; cnt += (c > 0u) ? 1u : 0u; mine = (j == x) ? c : mine; }
        if (sum == G) break;
        __builtin_amdgcn_s_sleep(1);
        if ((++sp & 255u) == 0u) { if (xb_ld(&bar[XB_TMO])) break; if (sp > XB_SPIN_CAP) { atomicAdd(&bar[XB_TMO], 1u); break; } }
    }
    nloc = mine > 0u ? mine : 1u; nx = cnt > 0u ? cnt : 1u;
}
__device__ __forceinline__ void xcd_barrier(const XcdBarrier& b) {
    asm volatile("s_waitcnt vmcnt(0)" ::: "memory");
    __syncthreads();
    if (otid() == 0) {
        unsigned* bar = b.bar;
        __builtin_amdgcn_s_waitcnt(0);
        unsigned nloc = b.st[0], nx = b.st[1];
        if (nloc == 0u) { xcd_barrier_complete(bar, b.x, nloc, nx); b.st[0] = nloc; b.st[1] = nx; }
        const unsigned old = xb_add(&bar[XB_XSUB(b.x)], 1u);
        const unsigned gen = old / nloc;
        if (old + 1u == (gen + 1u) * nloc) {
            __builtin_amdgcn_fence(__ATOMIC_RELEASE, "agent");
            asm volatile("s_waitcnt vmcnt(0)" ::: "memory");
            const unsigned og = xb_add(&bar[XB_TOP], 1u);
            const unsigned tg = og / nx;
            if (og + 1u == (tg + 1u) * nx) xb_add(&bar[XB_TOPGEN], 1u);
            else XB_SPIN(xb_ld(&bar[XB_TOPGEN]) == tg, bar);
            __builtin_amdgcn_fence(__ATOMIC_ACQUIRE, "agent");
            xb_add(&bar[XB_XGEN(b.x)], 1u);
            asm volatile("s_waitcnt vmcnt(0)" ::: "memory");
        } else {
            XB_SPIN(xb_ld(&bar[XB_XGEN(b.x)]) == gen, bar);
            __builtin_amdgcn_fence(__ATOMIC_ACQUIRE, "agent");
            asm volatile("s_waitcnt vmcnt(0)" ::: "memory");
        }
    }
    __syncthreads();
}

constexpr int NPH = 14;
__global__ void __launch_bounds__(NTHR) mega(Params p) {
    extern __shared__ __attribute__((aligned(16))) unsigned char lds[];
    cg::grid_group grid = cg::this_grid();
    PG8_LAS unsigned char* ldsl = (PG8_LAS unsigned char*)lds;
    const int lo = p.ph_lo, hi = p.ph_hi;
#define IN(k) (lo <= (k) && (k) < hi)
#define SEAM(k) do { if (IN(k) && IN((k) + 1)) { xcd_barrier(xb); } } while (0)
    bf16* Zb = (bf16*)(kparams()->ws + WS_Z); bf16* CAT = (bf16*)(kparams()->ws + WS_CAT);
    volatile PG8_LAS unsigned* xst = (volatile PG8_LAS unsigned*)(ldsl + LDS_BYTES - 16);
    { const int t0_ = otid(); if (t0_ < 4) xst[t0_] = 0u; }
    __syncthreads();
    XcdBarrier xb = xcd_barrier_post((unsigned*)(kparams()->ws + WS_BAR), xst);
    if (p.ph_lo < 0) grid.sync();
    if (IN(0)) REPEAT(REP_PRO) { ph_prologue(p, lds); __syncthreads(); }
    SEAM(0);
    if (IN(0) && IN(1)) for (int r_ = 1; r_ < REP_SUB; ++r_) xcd_barrier(xb);
#pragma unroll
    for (int l = 0; l < NL; ++l) {
        const int pb = 1 + 6 * l;
        const char* Wl = (const char*)(kparams()->ws + WS_WIN + (size_t)l * WROWS * DM * 2);
        if (IN(pb)) {
            if (l == 0) {
#pragma unroll
                for (int ll = 0; ll < NL; ++ll) {
                    SchedS S = make_sched(kparams()->ws + WS_WCS + (size_t)ll * 1024 * DG * 2, DG, kparams()->ws + WS_WFXB + (size_t)ll * DM * DG * 2, DG, 1024, DM, 32 * ll);
                    EpiZ E{(bf16*)(kparams()->ws + WS_WIN + ((size_t)ll * WROWS + 6656) * DM * 2), DM};
                    pg8::gemm_phase<EpiZ, SchedS, true>(ldsl, pg8::Gemm{DG, DG, DG}, S, E);
                }
            }
            REPEAT(REP_NORM) ph_norm(p, l, (l == 0 && gridDim.x == 256) ? 64 : 0);
        }
        SEAM(pb);
        if (IN(pb + 1)) REPEAT(REP_Z) {
            SchedZ S; S.o.init(MTOK, 24 * 256, (int)gridDim.x, obid()); S.A = (const char*)(kparams()->ws + WS_U); S.B = Wl; S.late = 0;
            EpiZ2 E{Zb, (bf16*)(kparams()->ws + WS_PQT)};
            pg8::gemm_phase<EpiZ2, SchedZ, true>(ldsl, pg8::Gemm{DM, DM, DM}, S, E);
        }
        SEAM(pb + 1);
        if (IN(pb + 2)) {
            {
                SchedZ S; S.o.init(MTOK, 4 * 256, (int)gridDim.x, obid()); S.A = (const char*)(kparams()->ws + WS_U); S.B = Wl; S.late = 1;
                EpiZ2 E{Zb, (bf16*)(kparams()->ws + WS_PQT)};
                pg8::gemm_phase<EpiZ2, SchedZ, true>(ldsl, pg8::Gemm{DM, DM, DM}, S, E);
            }
            REPEAT(REP_MIX) ph_mixA(p, l, lds);
            ph_fold(p);
        }
        SEAM(pb + 2);
        if (IN(pb + 3)) REPEAT(REP_P3) {
            const int G_ = (int)gridDim.x, b_ = obid(); const bool bal = (G_ == 256);
            {
                SchedDFT S{(const char*)(kparams()->ws + WS_DC), (const char*)(kparams()->ws + WS_PQF), G_, b_};
                EpiPart E{(float*)(kparams()->ws + WS_PART)};
                pg8::gemm_phase<EpiPart, SchedDFT, true>(ldsl, pg8::Gemm{2048, 4096, 2048}, S, E); }
            {
                SchedS S = make_sched(kparams()->ws + WS_CVH, DG, kparams()->ws + WS_WPW + (size_t)l * DG * DG * 2, DG, MTOK, DG, bal ? 192 : 0);
                EpiGate E{CAT, Zb, 1536, 12 * DG};
                pg8::gemm_phase<EpiGate, SchedS, true>(ldsl, pg8::Gemm{DG, DG, DG}, S, E); }
            if (bal && REP_R2 == 1) {
                const int xcd = b_ & 7, slot = b_ >> 3;
                const int nt_ = (slot >= 24) ? 2 : (slot >= 8 ? 3 : 0), k0 = (slot >= 24) ? 48 + (slot - 24) * 2 : (slot - 8) * 3;
                for (int i = 0; i < nt_; ++i) { const int k = (slot >= 24) ? 48 + i * 8 + (slot - 24) : i * 16 + (slot - 8);
                    ret2_task(p, l, (2 * xcd + (k >> 5)) * 32 + (k & 31), lds); }
            }
            else for (int t = b_; t < 512 * REP_R2; t += G_) ret2_task(p, l, t & 511, lds);
            ph_alt(p);
        }
        SEAM(pb + 3);
        if (IN(pb + 4)) REPEAT(REP_CMB) ph_combine(p);
        SEAM(pb + 4);
        if (IN(pb + 5)) REPEAT(l == 0 ? REP_OUT : 1) {
            SchedS S = make_sched(CAT, DM, kparams()->ws + WS_WOUT + (size_t)l * DM * DM * 2, DM, MTOK, DM);
            EpiRes E{(l == 0) ? kparams()->x : kparams()->out, kparams()->out, (const float*)(kparams()->ws + WS_MOD) + (size_t)l * 2 * 6144 + 4096};
            pg8::gemm_phase<EpiRes, SchedS, true>(ldsl, pg8::Gemm{DM, DM, DM}, S, E);
        }
        SEAM(pb + 5);
    }
    if (IN(NPH - 1)) ph_final(p);
#undef IN
#undef SEAM
}

extern "C" void kernel_launch(void* const* d_in, const int* in_sizes, int n_in, void* d_out, int out_size, void* d_ws, size_t ws_size, hipStream_t stream) {
    static int grid_blocks = 0;
    if (grid_blocks == 0) {
        if (n_in != 17 || ws_size < WS_END) { fprintf(stderr, "kernel_launch: n_in %d ws %zu (need %zu)\n", n_in, ws_size, (size_t)WS_END); grid_blocks = -1; return; }
        int dev = 0, cus = 0, per_cu = 0;
        hipGetDevice(&dev); hipDeviceGetAttribute(&cus, hipDeviceAttributeMultiprocessorCount, dev);
        if (hipFuncSetAttribute((const void*)mega, hipFuncAttributeMaxDynamicSharedMemorySize, LDS_BYTES) != hipSuccess) { fprintf(stderr, "hipFuncSetAttribute failed\n"); grid_blocks = -1; return; }
        if (hipOccupancyMaxActiveBlocksPerMultiprocessor(&per_cu, (const void*)mega, NTHR, LDS_BYTES) != hipSuccess || per_cu < 1) { fprintf(stderr, "occupancy query: %d\n", per_cu); per_cu = 1; }
        (void)hipGetLastError();
        grid_blocks = cus * 1;
    }
    if (grid_blocks < 0) return;
    Params p{};
    p.x = (const float*)d_in[0]; p.c = (const float*)d_in[1]; p.norm_g = (const float*)d_in[2]; p.w_ada = (const float*)d_in[3]; p.b_ada = (const float*)d_in[4];
    p.w_in = (const float*)d_in[5]; p.w_fft = (const float*)d_in[6]; p.na_bias = (const float*)d_in[7]; p.rl_f = (const float*)d_in[8]; p.rl_b = (const float*)d_in[9];
    p.conv_w = (const float*)d_in[10]; p.conv_b = (const float*)d_in[11]; p.ln_g = (const float*)d_in[12]; p.ln_b = (const float*)d_in[13]; p.w_pw = (const float*)d_in[14];
    p.w_out = (const float*)d_in[15]; p.final_g = (const float*)d_in[16];
    p.out = (float*)d_out; p.ws = (unsigned char*)d_ws;
#if ONE_LAUNCH
    if (hipMemsetAsync((char*)d_ws + WS_BAR, 0, 16384, stream) != hipSuccess) { fprintf(stderr, "memset of the barrier words failed\n"); return; }
    p.ph_lo = 0; p.ph_hi = NPH;
    void* args[] = {&p};
    hipError_t e = hipLaunchCooperativeKernel((const void*)mega, dim3(grid_blocks), dim3(NTHR), args, LDS_BYTES, stream);
    if (e != hipSuccess) fprintf(stderr, "cooperative launch failed: %s (grid %d)\n", hipGetErrorString(e), grid_blocks);
#else
    for (int ph = 0; ph < NPH; ++ph) { p.ph_lo = ph; p.ph_hi = ph + 1; hipLaunchKernelGGL(mega, dim3(grid_blocks), dim3(NTHR), LDS_BYTES, stream, p); }
#endif
}
```

```cpp
#include <hip/hip_runtime.h>
#include <hip/hip_cooperative_groups.h>
#include <cstdio>
#include <cstdint>
namespace cg = cooperative_groups;

#ifndef ONE_LAUNCH
#define ONE_LAUNCH 1
#endif

__device__ __forceinline__ int obid() { int b = (int)blockIdx.x; asm volatile("" : "+s"(b)); return b; }
__device__ __forceinline__ int otid() { int t; asm volatile("v_mov_b32 %0, %1" : "=v"(t) : "v"(threadIdx.x)); return t; }
namespace pg8 {
#define PG8_LAS __attribute__((address_space(3)))
typedef unsigned short bf16_t;
typedef short bf16x8 __attribute__((ext_vector_type(8)));
typedef float f32x4 __attribute__((ext_vector_type(4)));
typedef unsigned u32x4 __attribute__((ext_vector_type(4)));
constexpr int BM = 256, BK = 64, HALF = 128, HTB = HALF * BK * 2, STAGE_BYTES = 8 * HTB, NXCD = 8, WGM = 4;

__host__ __device__ __forceinline__ int lds_byte(int r, int c) { const int st = (r >> 4) * 2 + (c >> 5), rr = r & 15, cc = c & 31, ob = rr * 64 + cc * 2; return st * 1024 + (ob ^ (((ob >> 9) & 1) << 5)); }
__host__ __device__ __forceinline__ void stage_rc(int b, int& R, int& C) { const int st = b / 1024, sb = b % 1024, swz = sb ^ (((sb >> 9) & 1) << 5); R = (st >> 1) * 16 + swz / 64; C = (st & 1) * 32 + (swz % 64) / 2; }
__host__ __device__ __forceinline__ int perm32(int rho) { const int n = rho >> 4, i = rho & 15; return 8 * (i >> 2) + 4 * n + (i & 3); }

struct Unit { int pm, pn, aux, pad; const char* A; const char* B; };
struct Gemm { int lda, ldb, K; };

struct StaticOrder {
    int nM, nN, nwg, G, c;
    __host__ __device__ void init(int M, int N, int G_, int c_) { nM = M / BM; nN = N / BM; nwg = nM * nN; G = G_; c = c_; }
    __device__ bool next(int i, Unit& u) const {
        const long L = (long)i * G + c; if (L >= nwg) return false;
        int wgid = __builtin_amdgcn_readfirstlane((int)L); { const int q = nwg / NXCD, r = nwg % NXCD, xcd = wgid % NXCD, off = wgid / NXCD; wgid = (xcd < r ? xcd * (q + 1) : r * (q + 1) + (xcd - r) * q) + off; }
        const int nig = WGM * nN, gid = wgid / nig, fm = gid * WGM, gsz = (nM - fm) < WGM ? (nM - fm) : WGM;
        u.pm = __builtin_amdgcn_readfirstlane(fm + ((wgid % nig) % gsz)); u.pn = __builtin_amdgcn_readfirstlane((wgid % nig) / gsz); return true;
    }
};

__device__ __forceinline__ unsigned cvt_pk_bf16(float lo, float hi) { unsigned r; asm volatile("v_cvt_pk_bf16_f32 %0, %1, %2" : "=v"(r) : "v"(lo), "v"(hi)); return r; }

template <class Epi, class Sched, bool ALIGN_EPI>
__device__ __forceinline__ void gemm_phase(PG8_LAS unsigned char* lds, const Gemm g, const Sched& S, const Epi& E) {
    const int tid = otid(), wid = __builtin_amdgcn_readfirstlane(tid >> 6), lane = tid & 63, wr = wid >> 2, wc = wid & 3, fr = lane & 15, fq = lane >> 4;
    const int K = g.K, nt = K / BK;
    unsigned voffA[2], voffB[2];
#pragma unroll
    for (int i = 0; i < 2; ++i) { int R, C; stage_rc(tid * 16 + i * 8192, R, C); const int Rb = Epi::PERM ? ((R & ~31) + perm32(R & 31)) : R;
        voffA[i] = (unsigned)(R * g.lda + C) * 2u; voffB[i] = (unsigned)(Rb * g.ldb + C) * 2u; }
    const size_t kstep = (size_t)(BK * 2);
    const size_t hA = (size_t)HALF * g.lda * 2, hB = (size_t)HALF * g.ldb * 2;
    const unsigned ldsw = (unsigned)wid * 1024u;
    const int aoff = lds_byte(wr * 64 + fr, fq * 8), boff = lds_byte(wc * 32 + fr, fq * 8);
#define PG8_SA(b, h) (((b) * 2 + (h)) * HTB)
#define PG8_SB(b, h) ((4 + (b) * 2 + (h)) * HTB)
#define PG8_STAGE(bufoff, gbase, voff) do { _Pragma("unroll") for (int _i = 0; _i < 2; ++_i) \
        __builtin_amdgcn_global_load_lds((const unsigned*)((const char*)(gbase) + (voff)[_i]), (PG8_LAS unsigned*)(lds + (bufoff) + ldsw + _i * 8192), 16, 0, 0); } while (0)
#define PG8_LDA(dst, b, h) do { _Pragma("unroll") for (int m = 0; m < 4; ++m) _Pragma("unroll") for (int k = 0; k < 2; ++k) dst[m][k] = *(const PG8_LAS bf16x8*)(lds + PG8_SA(b, h) + aoff + m * 2048 + k * 1024); } while (0)
#define PG8_LDB(dst, b, h) do { _Pragma("unroll") for (int n = 0; n < 2; ++n) _Pragma("unroll") for (int k = 0; k < 2; ++k) dst[n][k] = *(const PG8_LAS bf16x8*)(lds + PG8_SB(b, h) + boff + n * 2048 + k * 1024); } while (0)
#define PG8_MMA(ai, bj, At, Bt) do { __builtin_amdgcn_s_setprio(1); _Pragma("unroll") for (int m = 0; m < 4; ++m) _Pragma("unroll") for (int n = 0; n < 2; ++n) _Pragma("unroll") for (int k = 0; k < 2; ++k) \
        acc[ai][bj][m][n] = __builtin_amdgcn_mfma_f32_16x16x32_bf16(Bt[n][k], At[m][k], acc[ai][bj][m][n], 0, 0, 0); __builtin_amdgcn_s_setprio(0); } while (0)
#define PG8_WAIT_V(n) asm volatile("s_waitcnt vmcnt(" #n ")" ::: "memory")
#define PG8_WAIT_L(n) asm volatile("s_waitcnt lgkmcnt(" #n ")" ::: "memory")
#define PG8_BAR __builtin_amdgcn_s_barrier()
#define PG8_SCHED __builtin_amdgcn_sched_barrier(0)
    Unit cur, nxt; int ui = 0;
    if (!S.next(0, cur)) return;
    f32x4 acc[2][2][4][2];
#pragma unroll
    for (int a = 0; a < 2; ++a)
#pragma unroll
        for (int b = 0; b < 2; ++b)
#pragma unroll
            for (int m = 0; m < 4; ++m)
#pragma unroll
                for (int n = 0; n < 2; ++n) acc[a][b][m][n] = (f32x4){0.f, 0.f, 0.f, 0.f};
    bf16x8 At[4][2], B0[2][2], B1[2][2];
    const char* cA = cur.A; const char* cB = cur.B;
    PG8_STAGE(PG8_SB(0, 0), cB, voffB); PG8_STAGE(PG8_SB(0, 1), cB + hB, voffB); PG8_STAGE(PG8_SA(0, 0), cA, voffA); PG8_STAGE(PG8_SA(0, 1), cA + hA, voffA);
    if (wr == 1) PG8_BAR;
    PG8_WAIT_V(2); PG8_BAR;
    PG8_STAGE(PG8_SB(1, 0), cB + kstep, voffB); PG8_STAGE(PG8_SA(1, 0), cA + kstep, voffA); PG8_STAGE(PG8_SB(1, 1), cB + hB + kstep, voffB);
    PG8_WAIT_V(6); PG8_BAR;
    for (;;) {
        const bool has_next = S.next(ui + 1, nxt);
        const char* nA = has_next ? nxt.A : cA; const char* nB = has_next ? nxt.B : cB;
        for (int t = 0; t < nt; t += 2) {
            const bool last = (t == nt - 2);
            const char* a1 = cA + (size_t)(t + 1) * kstep;
            const char* a2 = last ? nA : cA + (size_t)(t + 2) * kstep; const char* b2 = last ? nB : cB + (size_t)(t + 2) * kstep;
            const char* a3 = a2 + kstep; const char* b3 = b2 + kstep;
            PG8_LDB(B0, 0, 0); PG8_LDB(B1, 0, 1); PG8_SCHED; PG8_LDA(At, 0, 0); PG8_STAGE(PG8_SA(1, 1), a1 + hA, voffA);
            PG8_WAIT_V(8); PG8_WAIT_L(0); PG8_BAR; PG8_MMA(0, 0, At, B0); PG8_MMA(0, 1, At, B1); PG8_BAR; PG8_SCHED;
            PG8_LDA(At, 0, 1); PG8_STAGE(PG8_SB(0, 0), b2, voffB); PG8_STAGE(PG8_SB(0, 1), b2 + hB, voffB); PG8_STAGE(PG8_SA(0, 0), a2, voffA);
            PG8_WAIT_V(8); PG8_WAIT_L(0); PG8_BAR; PG8_MMA(1, 0, At, B0); PG8_MMA(1, 1, At, B1); PG8_BAR; PG8_SCHED;
            PG8_LDB(B0, 1, 0); PG8_LDB(B1, 1, 1); PG8_SCHED; PG8_LDA(At, 1, 0); PG8_STAGE(PG8_SA(0, 1), a2 + hA, voffA);
            PG8_WAIT_V(8); PG8_WAIT_L(0); PG8_BAR; PG8_MMA(0, 0, At, B0); PG8_MMA(0, 1, At, B1); PG8_BAR; PG8_SCHED;
            PG8_LDA(At, 1, 1); PG8_STAGE(PG8_SB(1, 0), b3, voffB); PG8_STAGE(PG8_SB(1, 1), b3 + hB, voffB); PG8_STAGE(PG8_SA(1, 0), a3, voffA);
            PG8_WAIT_V(8); PG8_WAIT_L(0); PG8_BAR; PG8_MMA(1, 0, At, B0); PG8_MMA(1, 1, At, B1); PG8_BAR; PG8_SCHED;
        }
        if constexpr (ALIGN_EPI) { if (wr == 0) PG8_BAR; }
        E(acc, cur, wr, wc, fr, fq);
        if (!has_next) break;
#pragma unroll
        for (int a = 0; a < 2; ++a)
#pragma unroll
            for (int b = 0; b < 2; ++b)
#pragma unroll
                for (int m = 0; m < 4; ++m)
#pragma unroll
                    for (int n = 0; n < 2; ++n) acc[a][b][m][n] = (f32x4){0.f, 0.f, 0.f, 0.f};
        cur = nxt; cA = nA; cB = nB; ++ui;
        if constexpr (ALIGN_EPI) { if (wr == 1) PG8_BAR; }
    }
    PG8_WAIT_V(0);
    if constexpr (!ALIGN_EPI) { if (wr == 0) PG8_BAR; }
    PG8_BAR;
#undef PG8_SA
#undef PG8_SB
#undef PG8_STAGE
#undef PG8_LDA
#undef PG8_LDB
#undef PG8_MMA
#undef PG8_WAIT_V
#undef PG8_WAIT_L
#undef PG8_BAR
#undef PG8_SCHED
}
}

typedef unsigned short bf16;
typedef float f32x4 __attribute__((ext_vector_type(4)));
typedef unsigned u32x4 __attribute__((ext_vector_type(4)));
typedef unsigned u32x2 __attribute__((ext_vector_type(2)));
constexpr int NB = 2, SEQ = 4096, DM = 2048, MTOK = NB * SEQ, DIN = 6656, DG = 512, NL = 2;
constexpr int LDS_BYTES = 147456;
constexpr int NTHR = 512;

constexpr int WROWS = 7680;
constexpr size_t WS_WIN = 0;
constexpr size_t WS_WOUT = WS_WIN + (size_t)NL * WROWS * DM * 2;
constexpr size_t WS_WCS = WS_WOUT + (size_t)NL * DM * DM * 2;
constexpr size_t WS_WFXB = WS_WCS + (size_t)NL * 1024 * DG * 2;
constexpr size_t WS_WPW = WS_WFXB + (size_t)NL * DM * DG * 2;
constexpr size_t WS_DC = WS_WPW + (size_t)NL * DG * DG * 2;
constexpr size_t WS_DS = WS_DC + (size_t)2304 * 2048 * 2;
constexpr size_t WS_PQF = WS_DS + (size_t)2048 * 2048 * 2;
constexpr size_t WS_ROPE = WS_PQF + (size_t)NB * DG * 2 * 2048 * 2;
constexpr size_t WS_MOD = WS_ROPE + (size_t)SEQ * 32 * 8;
constexpr size_t WS_U = WS_MOD + 131072;
constexpr size_t WS_PART = WS_U + (size_t)MTOK * DM * 2;
constexpr size_t WS_Z = WS_U + (size_t)4 * MTOK * DG * 4;
constexpr size_t WS_PQT = WS_Z + (size_t)MTOK * DIN * 2;
constexpr size_t WS_CVH = WS_PQT + (size_t)NB * DG * 2 * SEQ * 2;
constexpr size_t WS_CAT = WS_CVH + (size_t)MTOK * DG * 2;
constexpr size_t WS_KV = WS_CAT + (size_t)MTOK * DM * 2;
constexpr size_t WS_BAR = WS_KV + (size_t)2 * NB * 8 * 32 * 4096 * 4;
constexpr size_t WS_END = WS_BAR + 16384;

struct Params {
    const float* x; const float* c; const float* norm_g; const float* w_ada; const float* b_ada; const float* w_in; const float* w_fft; const float* na_bias;
    const float* rl_f; const float* rl_b; const float* conv_w; const float* conv_b; const float* ln_g; const float* ln_b; const float* w_pw; const float* w_out; const float* final_g;
    float* out; unsigned char* ws; int ph_lo, ph_hi;
};

#if defined(__HIP_DEVICE_COMPILE__)
typedef const __attribute__((address_space(4))) Params* KParams;
__device__ __forceinline__ KParams kparams() { KParams k = (KParams)__builtin_amdgcn_kernarg_segment_ptr(); asm volatile("" : "+s"(k)); return k; }
#else
typedef const Params* KParams;
__device__ __forceinline__ KParams kparams() { return nullptr; }
#endif
__device__ __forceinline__ unsigned f2bf(float f) { unsigned u = __float_as_uint(f); return (u + 0x7fffu + ((u >> 16) & 1u)) >> 16; }
__device__ __forceinline__ unsigned pk2(float lo, float hi) { return f2bf(lo) | (f2bf(hi) << 16); }
__device__ __forceinline__ float bf2f(bf16 b) { return __uint_as_float((unsigned)b << 16); }
__device__ __forceinline__ float bflo(unsigned u) { return __uint_as_float(u << 16); }
__device__ __forceinline__ float bfhi(unsigned u) { return __uint_as_float(u & 0xffff0000u); }
__device__ __forceinline__ float silu_f(float v) { return v / (1.f + __expf(-v)); }
__device__ __forceinline__ float wave_sum(float v) {
#pragma unroll
    for (int o = 1; o < 64; o <<= 1) v += __shfl_xor(v, o);
    return v;
}
__device__ __forceinline__ float wave_max(float v) {
#pragma unroll
    for (int o = 1; o < 64; o <<= 1) v = fmaxf(v, __shfl_xor(v, o));
    return v;
}

struct SchedS {
    pg8::StaticOrder o; const char* A; const char* B; size_t ta, tb;
    __device__ __forceinline__ bool next(int i, pg8::Unit& u) const { if (!o.next(i, u)) return false; u.A = A + (size_t)u.pm * ta; u.B = B + (size_t)u.pn * tb; u.aux = 0; return true; }
};
__device__ __forceinline__ SchedS make_sched(const void* A, int lda, const void* B, int ldb, int M, int N, int shift = 0) {
    SchedS s; s.o.init(M, N, (int)gridDim.x, (int)((obid() + gridDim.x - shift) % gridDim.x)); s.A = (const char*)A; s.B = (const char*)B; s.ta = (size_t)256 * lda * 2; s.tb = (size_t)256 * ldb * 2; return s;
}
struct SchedZ {
    pg8::StaticOrder o; const char* A; const char* B; int late;
    __device__ __forceinline__ bool next(int i, pg8::Unit& u) const { if (!o.next(i, u)) return false; const int jn = u.pn;
        u.pn = late ? (jn < 2 ? 2 + jn : 22 + jn) : (jn < 20 ? jn + 4 : jn + 6);
        u.A = A + (size_t)u.pm * (256 * DM * 2); u.B = B + (size_t)u.pn * (256 * DM * 2); u.aux = 0; return true; }
};
struct SchedDFT {
    const char* DC; const char* PQF; int G, c;
    __device__ __forceinline__ bool next(int i, pg8::Unit& u) const {
        if (c < 0) return false;
        const int L = __builtin_amdgcn_readfirstlane(i * G + c); if (L >= 64) return false;
        const int b = L >> 5, t = L & 31, odd = t >> 4, tt = t & 15; u.pm = tt >> 1; u.pn = tt & 1; u.aux = b * 2 + odd;
        u.A = DC + (size_t)odd * (WS_DS - WS_DC) + (size_t)u.pm * (256 * 2048 * 2);
        u.B = PQF + ((size_t)(b * 512 + u.pn * 256) * 4096 + odd * 2048) * 2; return true;
    }
};

struct EpiZ {
    static constexpr bool PERM = true;
    bf16* O; int ldc;
    __device__ __forceinline__ void operator()(const pg8::f32x4 (&acc)[2][2][4][2], const pg8::Unit& u, int wr, int wc, int fr, int fq) const {
        const int row0 = u.pm * 256 + wr * 64 + fr, col0 = u.pn * 256 + wc * 32 + 8 * fq;
#pragma unroll
        for (int ai = 0; ai < 2; ++ai)
#pragma unroll
            for (int m = 0; m < 4; ++m) { bf16* rowp = O + (size_t)(row0 + ai * 128 + m * 16) * ldc + col0;
#pragma unroll
                for (int bj = 0; bj < 2; ++bj) { const pg8::f32x4 v0 = acc[ai][bj][m][0], v1 = acc[ai][bj][m][1]; u32x4 w;
                    w.x = pg8::cvt_pk_bf16(v0[0], v0[1]); w.y = pg8::cvt_pk_bf16(v0[2], v0[3]); w.z = pg8::cvt_pk_bf16(v1[0], v1[1]); w.w = pg8::cvt_pk_bf16(v1[2], v1[3]);
                    *(u32x4*)(rowp + bj * 128) = w; } }
    }
};
struct EpiZ2 {
    static constexpr bool PERM = true;
    bf16* O; bf16* PQ;
    __device__ __forceinline__ void operator()(const pg8::f32x4 (&acc)[2][2][4][2], const pg8::Unit& u, int wr, int wc, int fr, int fq) const {
        const int row0 = u.pm * 256 + wr * 64 + fr;
        if (u.pn < 26) { const int col0 = u.pn * 256 + wc * 32 + 8 * fq;
#pragma unroll
            for (int ai = 0; ai < 2; ++ai)
#pragma unroll
                for (int m = 0; m < 4; ++m) { bf16* rowp = O + (size_t)(row0 + ai * 128 + m * 16) * DIN + col0;
#pragma unroll
                    for (int bj = 0; bj < 2; ++bj) { const pg8::f32x4 v0 = acc[ai][bj][m][0], v1 = acc[ai][bj][m][1]; u32x4 w;
                        w.x = pg8::cvt_pk_bf16(v0[0], v0[1]); w.y = pg8::cvt_pk_bf16(v0[2], v0[3]); w.z = pg8::cvt_pk_bf16(v1[0], v1[1]); w.w = pg8::cvt_pk_bf16(v1[2], v1[3]);
                        *(u32x4*)(rowp + bj * 128) = w; } }
        } else { const int np0 = (u.pn - 26) * 256 + wc * 32 + 8 * fq;
#pragma unroll
            for (int bj = 0; bj < 2; ++bj) { const int np = np0 + bj * 128, pq = np >> 9, n = np & 511;
#pragma unroll
                for (int ai = 0; ai < 2; ++ai)
#pragma unroll
                    for (int m = 0; m < 4; ++m) { const int row = row0 + ai * 128 + m * 16, b = row >> 12, sq = row & 4095;
                        bf16* dst = PQ + ((size_t)(b * 512 + n) * 2 + pq) * 4096 + sq;
#pragma unroll
                        for (int nn = 0; nn < 2; ++nn)
#pragma unroll
                            for (int j = 0; j < 4; ++j) dst[(size_t)(4 * nn + j) * 8192] = (bf16)f2bf(acc[ai][bj][m][nn][j]); } }
        }
    }
};
struct EpiGate {
    static constexpr bool PERM = true;
    bf16* O; const bf16* Z; int coff, goff;
    __device__ __forceinline__ void operator()(const pg8::f32x4 (&acc)[2][2][4][2], const pg8::Unit& u, int wr, int wc, int fr, int fq) const {
        const int row0 = u.pm * 256 + wr * 64 + fr, col0 = u.pn * 256 + wc * 32 + 8 * fq;
#pragma unroll
        for (int ai = 0; ai < 2; ++ai)
#pragma unroll
            for (int m = 0; m < 4; ++m) { const size_t row = (size_t)(row0 + ai * 128 + m * 16);
#pragma unroll
                for (int bj = 0; bj < 2; ++bj) { const pg8::f32x4 v0 = acc[ai][bj][m][0], v1 = acc[ai][bj][m][1];
                    const u32x4 gz = *(const u32x4*)(Z + row * DIN + goff + col0 + bj * 128); u32x4 w;
                    w.x = pg8::cvt_pk_bf16(v0[0] * silu_f(bflo(gz.x)), v0[1] * silu_f(bfhi(gz.x))); w.y = pg8::cvt_pk_bf16(v0[2] * silu_f(bflo(gz.y)), v0[3] * silu_f(bfhi(gz.y)));
                    w.z = pg8::cvt_pk_bf16(v1[0] * silu_f(bflo(gz.z)), v1[1] * silu_f(bfhi(gz.z))); w.w = pg8::cvt_pk_bf16(v1[2] * silu_f(bflo(gz.w)), v1[3] * silu_f(bfhi(gz.w)));
                    *(u32x4*)(O + row * DM + coff + col0 + bj * 128) = w; } }
    }
};
struct EpiPart {
    static constexpr bool PERM = false;
    float* P;
    __device__ __forceinline__ void operator()(const pg8::f32x4 (&acc)[2][2][4][2], const pg8::Unit& u, int wr, int wc, int fr, int fq) const {
        const int row0 = u.pm * 256 + wr * 64 + fr, col0 = u.pn * 256 + wc * 32 + 4 * fq;
        float* base = (u.aux & 1) ? P + (size_t)2 * 2304 * 512 + (size_t)(u.aux >> 1) * 2048 * 512 : P + (size_t)(u.aux >> 1) * 2304 * 512;
#pragma unroll
        for (int ai = 0; ai < 2; ++ai)
#pragma unroll
            for (int m = 0; m < 4; ++m) { float* rowp = base + (size_t)(row0 + ai * 128 + m * 16) * 512 + col0;
#pragma unroll
                for (int bj = 0; bj < 2; ++bj)
#pragma unroll
                    for (int n = 0; n < 2; ++n) *(pg8::f32x4*)(rowp + bj * 128 + n * 16) = acc[ai][bj][m][n]; }
    }
};
struct EpiRes {
    static constexpr bool PERM = false;
    const float* xin; float* xout; const float* gate;
    __device__ __forceinline__ void operator()(const pg8::f32x4 (&acc)[2][2][4][2], const pg8::Unit& u, int wr, int wc, int fr, int fq) const {
        const int row0 = u.pm * 256 + wr * 64 + fr, col0 = u.pn * 256 + wc * 32 + 4 * fq;
        const float* gp = gate + (size_t)(u.pm >> 4) * 6144 + col0;
        pg8::f32x4 gv[2][2];
#pragma unroll
        for (int bj = 0; bj < 2; ++bj)
#pragma unroll
            for (int n = 0; n < 2; ++n) gv[bj][n] = *(const pg8::f32x4*)(gp + bj * 128 + n * 16);
#pragma unroll
        for (int ai = 0; ai < 2; ++ai)
#pragma unroll
            for (int m = 0; m < 4; ++m) { const size_t ro = (size_t)(row0 + ai * 128 + m * 16) * DM + col0;
#pragma unroll
                for (int bj = 0; bj < 2; ++bj)
#pragma unroll
                    for (int n = 0; n < 2; ++n) { const pg8::f32x4 xi = *(const pg8::f32x4*)(xin + ro + bj * 128 + n * 16);
                        *(pg8::f32x4*)(xout + ro + bj * 128 + n * 16) = xi + gv[bj][n] * acc[ai][bj][m][n]; } }
    }
};

struct TPItem { const float* src; bf16* dst; int N, K; };
__device__ __forceinline__ TPItem tp_decode(const Params& p, int it, int tid) {
    constexpr int T_IN = 32 * 96, T_OUT = 32 * 32, T_S = 64, T_L = T_IN + T_OUT + T_S;
    const int l = it / T_L; int r = it % T_L; const float* W; bf16* WT; int K, N, kb, nb;
    if (r < T_IN) { W = p.w_in + (size_t)l * DM * DIN; WT = (bf16*)(p.ws + WS_WIN) + (size_t)l * WROWS * DM; K = DM; N = DIN; kb = r / 96; nb = 8 + r % 96; }
    else if (r < T_IN + T_OUT) { r -= T_IN; W = p.w_out + (size_t)l * DM * DM; WT = (bf16*)(p.ws + WS_WOUT) + (size_t)l * DM * DM; K = DM; N = DM; kb = r >> 5; nb = r & 31; }
    else { r -= T_IN + T_OUT; W = p.w_pw + (size_t)l * DG * DG; WT = (bf16*)(p.ws + WS_WPW) + (size_t)l * DG * DG; K = DG; N = DG; kb = r >> 3; nb = r & 7; }
    TPItem t; t.N = N; t.K = K;
    t.src = W + (size_t)(kb * 64 + (tid >> 4)) * N + nb * 64 + (tid & 15) * 4;
    t.dst = WT + (size_t)(nb * 64 + (tid >> 3)) * K + kb * 64 + (tid & 7) * 8;
    return t;
}
__device__ __forceinline__ void tp_store(const TPItem& t, int tid, const f32x4& v0, const f32x4& v1, float* scr) {
    { const int kk = tid >> 4, nn = (tid & 15) * 4;
      scr[kk * 65 + nn] = v0[0]; scr[kk * 65 + nn + 1] = v0[1]; scr[kk * 65 + nn + 2] = v0[2]; scr[kk * 65 + nn + 3] = v0[3];
      scr[(kk + 32) * 65 + nn] = v1[0]; scr[(kk + 32) * 65 + nn + 1] = v1[1]; scr[(kk + 32) * 65 + nn + 2] = v1[2]; scr[(kk + 32) * 65 + nn + 3] = v1[3]; }
    __syncthreads();
    { const int n = tid >> 3, kc = (tid & 7) * 8; const float* s = scr + kc * 65 + n; u32x4 o;
      o.x = pk2(s[0], s[65]); o.y = pk2(s[2 * 65], s[3 * 65]); o.z = pk2(s[4 * 65], s[5 * 65]); o.w = pk2(s[6 * 65], s[7 * 65]);
      *(u32x4*)t.dst = o; }
    __syncthreads();
}

__device__ __forceinline__ void ph_prologue(const Params& p_, unsigned char* lds) {
    const Params p = *kparams(); (void)p_;
    const int tid = otid(), lane = tid & 63, wave = tid >> 6, G = gridDim.x, bid = obid();
    float* scr = (float*)lds;
    { constexpr int T_TOT = NL * (32 * 96 + 32 * 32 + 64);
      int it = bid; TPItem cur; f32x4 a0, a1;
      if (it < T_TOT) { cur = tp_decode(p, it, tid); a0 = __builtin_nontemporal_load((const f32x4*)cur.src); a1 = __builtin_nontemporal_load((const f32x4*)(cur.src + (size_t)32 * cur.N)); }
      while (it < T_TOT) { const int nit = it + G; TPItem nxt = cur; f32x4 b0 = a0, b1 = a1;
          if (nit < T_TOT) { nxt = tp_decode(p, nit, tid); b0 = __builtin_nontemporal_load((const f32x4*)nxt.src); b1 = __builtin_nontemporal_load((const f32x4*)(nxt.src + (size_t)32 * nxt.N)); }
          tp_store(cur, tid, a0, a1, scr);
          cur = nxt; a0 = b0; a1 = b1; it = nit; } }
    { bf16* Wfx = (bf16*)(p.ws + WS_WFXB);
      for (int e = bid * NTHR + tid; e < NL * DM * DG / 8; e += G * NTHR) { const int l = e >> 17, r = e & 131071, k = r >> 6, c8 = (r & 63) * 8;
          const float* src = p.w_in + ((size_t)l * DM + k) * DIN + c8; const f32x4 a = *(const f32x4*)src, b4 = *(const f32x4*)(src + 4);
          u32x4 o; o.x = pk2(a[0], a[1]); o.y = pk2(a[2], a[3]); o.z = pk2(b4[0], b4[1]); o.w = pk2(b4[2], b4[3]);
          *(u32x4*)(Wfx + ((size_t)l * DM + k) * DG + c8) = o; } }
    { float* Wl = (float*)lds; float* tr = Wl + 128 * 65; bf16* Wcs = (bf16*)(p.ws + WS_WCS);
      for (int t2 = G - 1 - bid; t2 < 256; t2 += G) {
          const int t = t2 >> 1, ch = t2 & 1, l = t >> 6, pq = (t >> 5) & 1, g = (t >> 3) & 3, n0 = (t & 7) * 64;
#pragma unroll
          for (int i = 0; i < 4; ++i) { const int m = (tid >> 4) + 32 * i, nn = (tid & 15) * 4;
              const f32x4 v = *(const f32x4*)(p.w_fft + ((size_t)l * DG + g * 128 + m) * DG + n0 + nn);
              Wl[m * 65 + nn] = v[0]; Wl[m * 65 + nn + 1] = v[1]; Wl[m * 65 + nn + 2] = v[2]; Wl[m * 65 + nn + 3] = v[3]; }
          if (tid < 128) tr[tid] = pq ? sinpif((float)tid * (1.f / 64.f)) : cospif((float)tid * (1.f / 64.f));
          __syncthreads();
          const int nn = tid >> 3, cc = ch * 64 + (tid & 7) * 8; float acc[8];
#pragma unroll
          for (int i = 0; i < 8; ++i) acc[i] = 0.f;
#pragma unroll 4
          for (int m = 0; m < 128; ++m) { const float w = Wl[m * 65 + nn];
#pragma unroll
              for (int i = 0; i < 8; ++i) acc[i] += tr[((cc + i) * m) & 127] * w; }
          const float nrm = 0.0013810679320049757f;
          u32x4 o0;
          o0.x = pk2(acc[0] * nrm, acc[1] * nrm); o0.y = pk2(acc[2] * nrm, acc[3] * nrm); o0.z = pk2(acc[4] * nrm, acc[5] * nrm); o0.w = pk2(acc[6] * nrm, acc[7] * nrm);
          *(u32x4*)(Wcs + ((size_t)l * 1024 + pq * 512 + n0 + nn) * DG + g * 128 + cc) = o0;
          __syncthreads();
      } }
    __syncthreads();
    float* cosT = (float*)(lds + 32768); float* sinT = (float*)(lds + 49152); float* ca = (float*)(lds + 65536); float* red = (float*)(lds + 81920);
    for (int j = tid; j < 4096; j += NTHR) { cosT[j] = cospif((float)j * (1.f / 2048.f)); sinT[j] = sinpif((float)j * (1.f / 2048.f)); }
    for (int j = tid; j < 4096; j += NTHR) { const float cv = p.c[j]; ca[j] = cv / (1.f + expf(-cv)); }
    __syncthreads();
    { bf16* DC = (bf16*)(p.ws + WS_DC); bf16* DSm = (bf16*)(p.ws + WS_DS);
      for (int r = bid * 2 + (tid >> 8); r < 4352; r += G * 2) { const int is_sin = (r >= 2304) ? 1 : 0, k = is_sin ? r - 2304 : r, s0 = (tid & 255) * 8; float v[8];
#pragma unroll
          for (int j = 0; j < 8; ++j) { const int idx = (k * (s0 + j)) & 4095; v[j] = is_sin ? sinT[idx] : cosT[idx]; }
          u32x4 o; o.x = pk2(v[0], v[1]); o.y = pk2(v[2], v[3]); o.z = pk2(v[4], v[5]); o.w = pk2(v[6], v[7]);
          *(u32x4*)((is_sin ? DSm : DC) + (size_t)k * 2048 + s0) = o; } }
    { float2* rope = (float2*)(p.ws + WS_ROPE);
      for (int e = bid * NTHR + tid; e < 4096 * 32; e += G * NTHR) { const int s = e >> 5, i = e & 31;
          const float inv = (float)pow(10000.0, -(double)i / 32.0); const float ang = (float)s * inv;
          double sn, cs; sincos((double)ang, &sn, &cs); rope[e] = make_float2((float)cs, (float)sn); } }
    float* mod = (float*)(p.ws + WS_MOD);
    for (int t = bid; t < 192; t += G) {
        const int l = t / 96, col = (t % 96) * 64 + lane; const float* W = p.w_ada + (size_t)l * DM * 6144 + col;
        float a0 = 0.f, a1 = 0.f;
        for (int k0 = wave * 256; k0 < wave * 256 + 256; k0 += 32) { float wv[32];
#pragma unroll
            for (int j = 0; j < 32; ++j) wv[j] = __builtin_nontemporal_load(W + (size_t)(k0 + j) * 6144);
            asm volatile("" ::: "memory");
#pragma unroll
            for (int j = 0; j < 32; ++j) { a0 += ca[k0 + j] * wv[j]; a1 += ca[2048 + k0 + j] * wv[j]; } }
        red[(wave * 2 + 0) * 64 + lane] = a0; red[(wave * 2 + 1) * 64 + lane] = a1;
        __syncthreads();
        if (wave < 2) { float s = 0.f;
#pragma unroll
            for (int w = 0; w < 8; ++w) s += red[(w * 2 + wave) * 64 + lane];
            mod[(size_t)(l * 2 + wave) * 6144 + col] = s + p.b_ada[l * 6144 + col]; }
        __syncthreads();
    }
}

__device__ __forceinline__ void ph_norm(const Params& p_, int l, int skip_blocks) {
    const Params p = *kparams(); (void)p_;
    const int tid = otid(), lane = tid & 63, wave = tid >> 6;
    const float* xin = (l == 0) ? p.x : p.out; bf16* h = (bf16*)(p.ws + WS_U); const float* mod = (const float*)(p.ws + WS_MOD);
    const int stride = gridDim.x * 8; const float* g = p.norm_g + l * DM;
    if (stride == 2048) {
        const int nw = (256 - skip_blocks) * 8;
        for (int pi = (obid() - skip_blocks) * 8 + wave; pi >= 0 && pi < 4096; pi += nw) {
            const int row = (pi >> 11) * 4096 + (pi & 2047);
            const f32x4* xr0 = (const f32x4*)(xin + (size_t)row * DM) + lane; const f32x4* xr1 = (const f32x4*)(xin + (size_t)(row + stride) * DM) + lane;
            const float* md = mod + (size_t)(l * 2 + (row >> 12)) * 6144;
            f32x4 v0[8], v1[8], ca[8], cb[8];
#pragma unroll
            for (int j = 0; j < 8; ++j) { v0[j] = xr0[64 * j]; v1[j] = xr1[64 * j]; }
#pragma unroll
            for (int j = 0; j < 8; ++j) { const int col = (64 * j + lane) * 4; ca[j] = *(const f32x4*)(g + col) * (*(const f32x4*)(md + 2048 + col) + 1.f); cb[j] = *(const f32x4*)(md + col); }
            asm volatile("" ::: "memory");
            float s0 = 0.f, s1 = 0.f;
#pragma unroll
            for (int j = 0; j < 8; ++j) { s0 += (v0[j][0] * v0[j][0] + v0[j][1] * v0[j][1]) + (v0[j][2] * v0[j][2] + v0[j][3] * v0[j][3]); s1 += (v1[j][0] * v1[j][0] + v1[j][1] * v1[j][1]) + (v1[j][2] * v1[j][2] + v1[j][3] * v1[j][3]); }
            s0 = wave_sum(s0); s1 = wave_sum(s1);
            const float r0 = rsqrtf(s0 * (1.f / DM) + 1e-6f), r1 = rsqrtf(s1 * (1.f / DM) + 1e-6f);
#pragma unroll
            for (int j = 0; j < 8; ++j) { const int col = (64 * j + lane) * 4;
                const f32x4 o0 = (v0[j] * r0) * ca[j] + cb[j], o1 = (v1[j] * r1) * ca[j] + cb[j]; u32x2 w;
                w.x = pk2(o0[0], o0[1]); w.y = pk2(o0[2], o0[3]); *(u32x2*)(h + (size_t)row * DM + col) = w;
                w.x = pk2(o1[0], o1[1]); w.y = pk2(o1[2], o1[3]); *(u32x2*)(h + (size_t)(row + stride) * DM + col) = w; }
        }
        return;
    }
    for (int row = obid() * 8 + wave; row < MTOK; row += stride) {
        const f32x4* xr = (const f32x4*)(xin + (size_t)row * DM) + lane; f32x4 v[8]; float ss = 0.f;
#pragma unroll
        for (int j = 0; j < 8; ++j) { v[j] = xr[64 * j]; ss += (v[j][0] * v[j][0] + v[j][1] * v[j][1]) + (v[j][2] * v[j][2] + v[j][3] * v[j][3]); }
        ss = wave_sum(ss); const float rstd = rsqrtf(ss * (1.f / DM) + 1e-6f);
        const float* md = mod + (size_t)(l * 2 + (row >> 12)) * 6144;
#pragma unroll
        for (int j = 0; j < 8; ++j) { const int col = (64 * j + lane) * 4;
            const f32x4 g4 = *(const f32x4*)(g + col), sh = *(const f32x4*)(md + col), sc = *(const f32x4*)(md + 2048 + col);
            const f32x4 o = (v[j] * rstd * g4) * (sc + 1.f) + sh; u32x2 w; w.x = pk2(o[0], o[1]); w.y = pk2(o[2], o[3]);
            *(u32x2*)(h + (size_t)row * DM + col) = w; }
    }
}
__device__ __forceinline__ void ph_final(const Params& p_) {
    const Params p = *kparams(); (void)p_;
    const int tid = otid(), lane = tid & 63, wave = tid >> 6;
    const int stride = gridDim.x * 8;
    for (int row = obid() * 8 + wave; row < MTOK; row += 2 * stride) {
        const bool two = (row + stride < MTOK);
        f32x4* xr0 = (f32x4*)(p.out + (size_t)row * DM) + lane; f32x4* xr1 = (f32x4*)(p.out + (size_t)(two ? row + stride : row) * DM) + lane;
        f32x4 v0[8], v1[8], g4[8];
#pragma unroll
        for (int j = 0; j < 8; ++j) { v0[j] = xr0[64 * j]; v1[j] = xr1[64 * j]; g4[j] = *(const f32x4*)(p.final_g + (64 * j + lane) * 4); }
        asm volatile("" ::: "memory");
        float s0 = 0.f, s1 = 0.f;
#pragma unroll
        for (int j = 0; j < 8; ++j) { s0 += (v0[j][0] * v0[j][0] + v0[j][1] * v0[j][1]) + (v0[j][2] * v0[j][2] + v0[j][3] * v0[j][3]); s1 += (v1[j][0] * v1[j][0] + v1[j][1] * v1[j][1]) + (v1[j][2] * v1[j][2] + v1[j][3] * v1[j][3]); }
        s0 = wave_sum(s0); s1 = wave_sum(s1);
        const float r0 = rsqrtf(s0 * (1.f / DM) + 1e-6f), r1 = rsqrtf(s1 * (1.f / DM) + 1e-6f);
#pragma unroll
        for (int j = 0; j < 8; ++j) { xr0[64 * j] = v0[j] * r0 * g4[j]; if (two) xr1[64 * j] = v1[j] * r1 * g4[j]; }
    }
}

#ifndef REP_PRO
#define REP_PRO 1
#endif
#ifndef REP_NORM
#define REP_NORM 1
#endif
#ifndef REP_Z
#define REP_Z 1
#endif
#ifndef REP_MIX
#define REP_MIX 1
#endif
#ifndef REP_P3
#define REP_P3 1
#endif
#ifndef REP_R2
#define REP_R2 1
#endif
#ifndef REP_CMB
#define REP_CMB 1
#endif
#ifndef REP_FFT
#define REP_FFT 1
#endif
#ifndef REP_OUT
#define REP_OUT 1
#endif
#ifndef REP_SUB
#define REP_SUB 1
#endif

#ifndef REP_R1
#define REP_R1 1
#endif
#ifndef REP_NA
#define REP_NA 1
#endif
#ifndef REP_CV
#define REP_CV 1
#endif
#ifndef REP_F1
#define REP_F1 1
#endif
#define REPEAT(n) for (int rep_ = 0; rep_ < (n); ++rep_)
typedef short bf16x8v __attribute__((ext_vector_type(8)));
__device__ __forceinline__ bf16x8v mk8(unsigned a, unsigned b, unsigned c, unsigned d) { u32x4 v = {a, b, c, d}; return __builtin_bit_cast(bf16x8v, v); }
#define MFMA16(a, b, c) __builtin_amdgcn_mfma_f32_16x16x32_bf16(a, b, c, 0, 0, 0)
constexpr int R_QS = 0, R_KS = 18432, R_VT = 36864, R_KTF = 54272, R_KTB = 71680, R_STF = 89088, R_STB = 98304;

template <bool R2>
__device__ __forceinline__ void ret_stage(const Params& p_, int b, int h, int n, unsigned char* lds, float l2f, float l2b) {
    const Params p = *kparams(); (void)p_;
    const int tid = otid(), j = tid >> 2, c4 = tid & 3, s = n * 128 + j;
    const bf16* Z = (const bf16*)(p.ws + WS_Z); const bf16* zr = Z + (size_t)(b * SEQ + s) * DIN;
    const f32x4* rp = (const f32x4*)((const float2*)(p.ws + WS_ROPE) + s * 32 + c4 * 8);
    f32x4 rr[4];
#pragma unroll
    for (int i = 0; i < 4; ++i) rr[i] = rp[i];
    const u32x4 ka = *(const u32x4*)(zr + 7 * DG + h * 64 + c4 * 8), kb = *(const u32x4*)(zr + 7 * DG + h * 64 + 32 + c4 * 8);
    const u32x4 va = *(const u32x4*)(zr + 8 * DG + h * 64 + c4 * 16), vb = *(const u32x4*)(zr + 8 * DG + h * 64 + c4 * 16 + 8);
    u32x4 qa = ka, qb = kb;
    if (R2) { qa = *(const u32x4*)(zr + 6 * DG + h * 64 + c4 * 8); qb = *(const u32x4*)(zr + 6 * DG + h * 64 + 32 + c4 * 8); }
    asm volatile("" ::: "memory");
    float cs[8], sn[8];
#pragma unroll
    for (int i = 0; i < 4; ++i) { const f32x4 r = rr[i]; cs[2 * i] = r[0]; sn[2 * i] = r[1]; cs[2 * i + 1] = r[2]; sn[2 * i + 1] = r[3]; }
    bf16* KS = (bf16*)(lds + R_KS); bf16* VT = (bf16*)(lds + R_VT);
    {
      const unsigned kau[4] = {ka.x, ka.y, ka.z, ka.w}, kbu[4] = {kb.x, kb.y, kb.z, kb.w};
      float k1[8], k2[8];
#pragma unroll
      for (int i = 0; i < 4; ++i) { const float a0 = bflo(kau[i]), a1 = bfhi(kau[i]), b0 = bflo(kbu[i]), b1 = bfhi(kbu[i]);
          k1[2 * i] = a0 * cs[2 * i] - b0 * sn[2 * i]; k2[2 * i] = a0 * sn[2 * i] + b0 * cs[2 * i];
          k1[2 * i + 1] = a1 * cs[2 * i + 1] - b1 * sn[2 * i + 1]; k2[2 * i + 1] = a1 * sn[2 * i + 1] + b1 * cs[2 * i + 1]; }
      u32x4 o1, o2; o1.x = pk2(k1[0], k1[1]); o1.y = pk2(k1[2], k1[3]); o1.z = pk2(k1[4], k1[5]); o1.w = pk2(k1[6], k1[7]);
      o2.x = pk2(k2[0], k2[1]); o2.y = pk2(k2[2], k2[3]); o2.z = pk2(k2[4], k2[5]); o2.w = pk2(k2[6], k2[7]);
      *(u32x4*)(KS + j * 72 + c4 * 8) = o1; *(u32x4*)(KS + j * 72 + 32 + c4 * 8) = o2;
      if (!R2) { bf16* KTF = (bf16*)(lds + R_KTF); bf16* KTB = (bf16*)(lds + R_KTB);
          const float df = exp2f(l2f * (float)(127 - j)), db = exp2f(l2b * (float)j);
#pragma unroll
          for (int i = 0; i < 8; ++i) { KTF[(c4 * 8 + i) * 136 + j] = (bf16)f2bf(k1[i] * df); KTF[(32 + c4 * 8 + i) * 136 + j] = (bf16)f2bf(k2[i] * df);
              KTB[(c4 * 8 + i) * 136 + j] = (bf16)f2bf(k1[i] * db); KTB[(32 + c4 * 8 + i) * 136 + j] = (bf16)f2bf(k2[i] * db); } } }
    {
      const unsigned vu[8] = {va.x, va.y, va.z, va.w, vb.x, vb.y, vb.z, vb.w};
#pragma unroll
      for (int i = 0; i < 8; ++i) { VT[(c4 * 16 + 2 * i) * 136 + j] = (bf16)(vu[i] & 0xffffu); VT[(c4 * 16 + 2 * i + 1) * 136 + j] = (bf16)(vu[i] >> 16); } }
    if (R2) { bf16* QS = (bf16*)(lds + R_QS);
      const unsigned qau[4] = {qa.x, qa.y, qa.z, qa.w}, qbu[4] = {qb.x, qb.y, qb.z, qb.w};
      float q1[8], q2[8];
#pragma unroll
      for (int i = 0; i < 4; ++i) { const float a0 = bflo(qau[i]), a1 = bfhi(qau[i]), b0 = bflo(qbu[i]), b1 = bfhi(qbu[i]);
          q1[2 * i] = (a0 * cs[2 * i] - b0 * sn[2 * i]) * 0.125f; q2[2 * i] = (a0 * sn[2 * i] + b0 * cs[2 * i]) * 0.125f;
          q1[2 * i + 1] = (a1 * cs[2 * i + 1] - b1 * sn[2 * i + 1]) * 0.125f; q2[2 * i + 1] = (a1 * sn[2 * i + 1] + b1 * cs[2 * i + 1]) * 0.125f; }
      u32x4 o1, o2; o1.x = pk2(q1[0], q1[1]); o1.y = pk2(q1[2], q1[3]); o1.z = pk2(q1[4], q1[5]); o1.w = pk2(q1[6], q1[7]);
      o2.x = pk2(q2[0], q2[1]); o2.y = pk2(q2[2], q2[3]); o2.z = pk2(q2[4], q2[5]); o2.w = pk2(q2[6], q2[7]);
      *(u32x4*)(QS + j * 72 + c4 * 8) = o1; *(u32x4*)(QS + j * 72 + 32 + c4 * 8) = o2; }
}

__device__ __forceinline__ void ret1_task(const Params& p_, int l, int task, unsigned char* lds) {
    const Params p = *kparams(); (void)p_;
    const int n = task & 31, h = (task >> 5) & 7, b = task >> 8;
    const float xf = p.rl_f[l * 8 + h], xb = p.rl_b[l * 8 + h];
    const float l2f = -log1pf(expf(-xf)) * 1.4426950408889634f, l2b = -log1pf(expf(-xb)) * 1.4426950408889634f;
    ret_stage<false>(p, b, h, n, lds, l2f, l2b);
    __syncthreads();
    const int tid = otid(), lane = tid & 63, w = tid >> 6, fr = lane & 15, fq = lane >> 4, dir = w >> 2, et = w & 3;
    const bf16* VT = (const bf16*)(lds + R_VT); const bf16* KT = (const bf16*)(lds + (dir ? R_KTB : R_KTF));
    bf16x8v a[4];
#pragma unroll
    for (int ks = 0; ks < 4; ++ks) a[ks] = *(const bf16x8v*)(VT + (16 * et + fr) * 136 + 32 * ks + 8 * fq);
    float* dst = (float*)(p.ws + WS_KV) + ((size_t)((dir * 2 + b) * 8 + h) * 32 + n) * 4096;
#pragma unroll
    for (int dt = 0; dt < 4; ++dt) { f32x4 acc = {0.f, 0.f, 0.f, 0.f};
#pragma unroll
        for (int ks = 0; ks < 4; ++ks) { const bf16x8v bfr = *(const bf16x8v*)(KT + (16 * dt + fr) * 136 + 32 * ks + 8 * fq); acc = MFMA16(a[ks], bfr, acc); }
#pragma unroll
        for (int r = 0; r < 4; ++r) dst[(16 * et + 4 * fq + r) * 64 + 16 * dt + fr] = acc[r]; }
    __syncthreads();
}

__device__ __forceinline__ void ret2_task(const Params& p_, int l, int task, unsigned char* lds) {
    const Params p = *kparams(); (void)p_;
    const int n = task & 31, h = (task >> 5) & 7, b = task >> 8;
    const float xf = p.rl_f[l * 8 + h], xb = p.rl_b[l * 8 + h];
    const float l2f = -log1pf(expf(-xf)) * 1.4426950408889634f, l2b = -log1pf(expf(-xb)) * 1.4426950408889634f;
    ret_stage<true>(p, b, h, n, lds, l2f, l2b);
    const int tid = otid(), lane = tid & 63, w = tid >> 6, fr = lane & 15, fq = lane >> 4;
    {
      const float gfC = exp2f(l2f * 128.f), gbC = exp2f(l2b * 128.f);
      const float* KVf = (const float*)(p.ws + WS_KV) + ((size_t)((0 * 2 + b) * 8 + h) * 32) * 4096 + tid * 8;
      const float* KVb = (const float*)(p.ws + WS_KV) + ((size_t)((1 * 2 + b) * 8 + h) * 32) * 4096 + tid * 8;
      f32x4 f0 = {0.f, 0.f, 0.f, 0.f}, f1 = f0, g0 = f0, g1 = f0;
      { float c0 = 1.f; int m = n - 1;
        for (; m >= 7; m -= 8) { f32x4 xa[8], xb[8];
#pragma unroll
            for (int j = 0; j < 8; ++j) { xa[j] = *(const f32x4*)(KVf + (size_t)(m - j) * 4096); xb[j] = *(const f32x4*)(KVf + (size_t)(m - j) * 4096 + 4); }
            asm volatile("" ::: "memory");
#pragma unroll
            for (int j = 0; j < 8; ++j) { f0 += xa[j] * c0; f1 += xb[j] * c0; c0 *= gfC; } }
        for (; m >= 0; --m) { const f32x4 x0 = *(const f32x4*)(KVf + (size_t)m * 4096), x1 = *(const f32x4*)(KVf + (size_t)m * 4096 + 4); f0 += x0 * c0; f1 += x1 * c0; c0 *= gfC; } }
      { float c0 = 1.f; int m = n + 1;
        for (; m + 7 < 32; m += 8) { f32x4 xa[8], xb[8];
#pragma unroll
            for (int j = 0; j < 8; ++j) { xa[j] = *(const f32x4*)(KVb + (size_t)(m + j) * 4096); xb[j] = *(const f32x4*)(KVb + (size_t)(m + j) * 4096 + 4); }
            asm volatile("" ::: "memory");
#pragma unroll
            for (int j = 0; j < 8; ++j) { g0 += xa[j] * c0; g1 += xb[j] * c0; c0 *= gbC; } }
        for (; m < 32; ++m) { const f32x4 x0 = *(const f32x4*)(KVb + (size_t)m * 4096), x1 = *(const f32x4*)(KVb + (size_t)m * 4096 + 4); g0 += x0 * c0; g1 += x1 * c0; c0 *= gbC; } }
      const int e = tid >> 3, d0 = (tid & 7) * 8; u32x4 o;
      o.x = pk2(f0[0], f0[1]); o.y = pk2(f0[2], f0[3]); o.z = pk2(f1[0], f1[1]); o.w = pk2(f1[2], f1[3]); *(u32x4*)((bf16*)(lds + R_STF) + e * 72 + d0) = o;
      o.x = pk2(g0[0], g0[1]); o.y = pk2(g0[2], g0[3]); o.z = pk2(g1[0], g1[1]); o.w = pk2(g1[2], g1[3]); *(u32x4*)((bf16*)(lds + R_STB) + e * 72 + d0) = o; }
    __syncthreads();
    const bf16* QS = (const bf16*)(lds + R_QS); const bf16* KS = (const bf16*)(lds + R_KS); const bf16* VT = (const bf16*)(lds + R_VT);
    const bf16* STF = (const bf16*)(lds + R_STF); const bf16* STB = (const bf16*)(lds + R_STB);
    bf16x8v qf[2];
#pragma unroll
    for (int ks = 0; ks < 2; ++ks) qf[ks] = *(const bf16x8v*)(QS + (16 * w + fr) * 72 + 32 * ks + 8 * fq);
    const int ai = 16 * w + fr;
    unsigned pp[8][2];
#pragma unroll
    for (int jt = 0; jt < 8; ++jt) { f32x4 acc = {0.f, 0.f, 0.f, 0.f};
#pragma unroll
        for (int ks = 0; ks < 2; ++ks) { const bf16x8v kf = *(const bf16x8v*)(KS + (16 * jt + fr) * 72 + 32 * ks + 8 * fq); acc = MFMA16(kf, qf[ks], acc); }
        float sc[4];
#pragma unroll
        for (int r = 0; r < 4; ++r) { const int aj = 16 * jt + 4 * fq + r; const float wg = (aj <= ai) ? exp2f(l2f * (float)(ai - aj)) : exp2f(l2b * (float)(aj - ai)); sc[r] = acc[r] * wg; }
        pp[jt][0] = pk2(sc[0], sc[1]); pp[jt][1] = pk2(sc[2], sc[3]); }
    const float qdf = exp2f(l2f * (float)(ai + 1)), qdb = exp2f(l2b * (float)(128 - ai));
    f32x4 tot[4]; float ss = 0.f;
#pragma unroll
    for (int et = 0; et < 4; ++et) { f32x4 o = {0.f, 0.f, 0.f, 0.f}, cfa = o, cba = o;
#pragma unroll
        for (int t = 0; t < 4; ++t) { const u32x2 vlo = *(const u32x2*)(VT + (16 * et + fr) * 136 + 32 * t + 4 * fq), vhi = *(const u32x2*)(VT + (16 * et + fr) * 136 + 32 * t + 16 + 4 * fq);
            o = MFMA16(mk8(vlo.x, vlo.y, vhi.x, vhi.y), mk8(pp[2 * t][0], pp[2 * t][1], pp[2 * t + 1][0], pp[2 * t + 1][1]), o); }
#pragma unroll
        for (int ks = 0; ks < 2; ++ks) { const bf16x8v sf = *(const bf16x8v*)(STF + (16 * et + fr) * 72 + 32 * ks + 8 * fq), sb = *(const bf16x8v*)(STB + (16 * et + fr) * 72 + 32 * ks + 8 * fq);
            cfa = MFMA16(sf, qf[ks], cfa); cba = MFMA16(sb, qf[ks], cba); }
        tot[et] = o + cfa * qdf + cba * qdb;
        ss += (tot[et][0] * tot[et][0] + tot[et][1] * tot[et][1]) + (tot[et][2] * tot[et][2] + tot[et][3] * tot[et][3]); }
    ss += __shfl_xor(ss, 16); ss += __shfl_xor(ss, 32);
    const float rs = rsqrtf(ss * (1.f / 64.f) + 1e-6f);
    const size_t tok = (size_t)b * SEQ + n * 128 + ai;
    const bf16* Z = (const bf16*)(p.ws + WS_Z); bf16* CAT = (bf16*)(p.ws + WS_CAT);
#pragma unroll
    for (int et = 0; et < 4; ++et) { const u32x2 gz = *(const u32x2*)(Z + tok * DIN + 9 * DG + h * 64 + 16 * et + 4 * fq); u32x2 o;
        o.x = pk2(tot[et][0] * rs * silu_f(bflo(gz.x)), tot[et][1] * rs * silu_f(bfhi(gz.x))); o.y = pk2(tot[et][2] * rs * silu_f(bflo(gz.y)), tot[et][3] * rs * silu_f(bfhi(gz.y)));
        *(u32x2*)(CAT + tok * DM + 1024 + h * 64 + 16 * et + 4 * fq) = o; }
    __syncthreads();
}

__device__ __forceinline__ void na2_task(const Params& p_, int l, int task, unsigned char* lds) {
    const Params p = *kparams(); (void)p_;
    const int tid = otid(), lane = tid & 63, w = tid >> 6, fr = lane & 15, fq = lane >> 4;
    const int hp = task & 3, rq = (task >> 2) & 63, b = task >> 8;
    const int row_start = min(max(rq - 4, 0), 56);
    const bf16* Z = (const bf16*)(p.ws + WS_Z); bf16* CAT = (bf16*)(p.ws + WS_CAT);
    bf16* VT = (bf16*)lds; float* BI = (float*)(lds + 133120);
    const int hh = w >> 2, h = hp * 2 + hh, qb = w & 3, kst = min(max(16 * qb - 8, 0), 32);
    const int c = 16 * qb + fr; const size_t qtok = (size_t)b * SEQ + rq * 64 + c;
    bf16x8v qf[2], kfr[8][2];
#pragma unroll
    for (int ks = 0; ks < 2; ++ks) qf[ks] = *(const bf16x8v*)(Z + qtok * DIN + 2 * DG + h * 64 + 32 * ks + 8 * fq);
#pragma unroll
    for (int i = 0; i < 8; ++i) { const int a = i / 2, ci = i % 2;
        const size_t ktok = (size_t)b * SEQ + (row_start + a) * 64 + kst + 16 * ci + fr;
#pragma unroll
        for (int ks = 0; ks < 2; ++ks) kfr[i][ks] = *(const bf16x8v*)(Z + ktok * DIN + 3 * DG + h * 64 + 32 * ks + 8 * fq); }
    asm volatile("" ::: "memory");
    for (int i = tid; i < 930; i += NTHR) BI[i] = p.na_bias[(size_t)(l * 8 + hp * 2) * 465 + i];
    { const int pair = lane & 31, chunk = (lane >> 5) + 2 * (w & 3);
      unsigned* VTd = (unsigned*)(VT + (size_t)hh * 64 * 520);
      u32x4 xs[8], ys[8];
#pragma unroll
      for (int a = 0; a < 8; ++a) { const size_t tok = (size_t)b * SEQ + (row_start + a) * 64 + 2 * pair;
          const bf16* src = Z + tok * DIN + 4 * DG + h * 64 + chunk * 8; xs[a] = *(const u32x4*)src; ys[a] = *(const u32x4*)(src + DIN); }
      asm volatile("" ::: "memory");
#pragma unroll
      for (int a = 0; a < 8; ++a) { const unsigned xu[4] = {xs[a].x, xs[a].y, xs[a].z, xs[a].w}, yu[4] = {ys[a].x, ys[a].y, ys[a].z, ys[a].w};
#pragma unroll
          for (int i = 0; i < 4; ++i) { VTd[(chunk * 8 + 2 * i) * 260 + a * 32 + pair] = (xu[i] & 0xffffu) | (yu[i] << 16);
              VTd[(chunk * 8 + 2 * i + 1) * 260 + a * 32 + pair] = (xu[i] >> 16) | (yu[i] & 0xffff0000u); } } }
    __syncthreads();
    const int col_start = min(max(c - 8, 0), 48);
    const float* bi = BI + hh * 465;
    float sc[16][4]; float mx = -1e30f;
#pragma unroll
    for (int hf = 0; hf < 2; ++hf) {
        if (hf == 1) {
#pragma unroll
            for (int i = 0; i < 8; ++i) { const int a = 4 + i / 2, ci = i % 2;
                const size_t ktok = (size_t)b * SEQ + (row_start + a) * 64 + kst + 16 * ci + fr;
#pragma unroll
                for (int ks = 0; ks < 2; ++ks) kfr[i][ks] = *(const bf16x8v*)(Z + ktok * DIN + 3 * DG + h * 64 + 32 * ks + 8 * fq); }
            asm volatile("" ::: "memory");
        }
#pragma unroll
        for (int i = 0; i < 8; ++i) { const int a = 4 * hf + i / 2, ci = i % 2, kt = a * 2 + ci;
            f32x4 acc = {0.f, 0.f, 0.f, 0.f};
#pragma unroll
            for (int ks = 0; ks < 2; ++ks) acc = MFMA16(kfr[i][ks], qf[ks], acc);
            const int dr = row_start + a - rq;
#pragma unroll
            for (int r = 0; r < 4; ++r) { const int kc = kst + 16 * ci + 4 * fq + r, rel = kc - col_start, dc = kc - c;
                float v = acc[r] * 0.125f + bi[(dr + 7) * 31 + min(max(dc + 15, 0), 30)];
                v = (rel >= 0 && rel < 16) ? v : -1e30f; sc[kt][r] = v; mx = fmaxf(mx, v); } }
    }
    mx = fmaxf(mx, __shfl_xor(mx, 16)); mx = fmaxf(mx, __shfl_xor(mx, 32));
    float sum = 0.f; unsigned pp[16][2];
#pragma unroll
    for (int kt = 0; kt < 16; ++kt) { const float e0 = __expf(sc[kt][0] - mx), e1 = __expf(sc[kt][1] - mx), e2 = __expf(sc[kt][2] - mx), e3 = __expf(sc[kt][3] - mx);
        sum += (e0 + e1) + (e2 + e3); pp[kt][0] = pk2(e0, e1); pp[kt][1] = pk2(e2, e3); }
    sum += __shfl_xor(sum, 16); sum += __shfl_xor(sum, 32);
    const float inv = 1.f / sum;
    const bf16* VTh = VT + (size_t)hh * 64 * 520;
#pragma unroll
    for (int dt = 0; dt < 4; ++dt) { f32x4 o = {0.f, 0.f, 0.f, 0.f};
#pragma unroll
        for (int t = 0; t < 8; ++t) { const int k0 = 2 * t, k1 = 2 * t + 1, a0 = k0 / 2, c0 = k0 % 2, a1 = k1 / 2, c1 = k1 % 2;
            const u32x2 vlo = *(const u32x2*)(VTh + (16 * dt + fr) * 520 + a0 * 64 + kst + 16 * c0 + 4 * fq), vhi = *(const u32x2*)(VTh + (16 * dt + fr) * 520 + a1 * 64 + kst + 16 * c1 + 4 * fq);
            o = MFMA16(mk8(vlo.x, vlo.y, vhi.x, vhi.y), mk8(pp[k0][0], pp[k0][1], pp[k1][0], pp[k1][1]), o); }
        const u32x2 gz = *(const u32x2*)(Z + qtok * DIN + 5 * DG + h * 64 + 16 * dt + 4 * fq); u32x2 ov;
        ov.x = pk2(o[0] * inv * silu_f(bflo(gz.x)), o[1] * inv * silu_f(bfhi(gz.x))); ov.y = pk2(o[2] * inv * silu_f(bflo(gz.y)), o[3] * inv * silu_f(bfhi(gz.y)));
        *(u32x2*)(CAT + qtok * DM + 512 + h * 64 + 16 * dt + 4 * fq) = ov; }
    __syncthreads();
}

__device__ __forceinline__ void conv_task(const Params& p_, int l, int task, unsigned char* lds) {
    const Params p = *kparams(); (void)p_;
    const int tid = otid(), lane = tid & 63, wave = tid >> 6;
    float* us = (float*)lds; float* ys = us + 46 * 512;
    const bf16* Z = (const bf16*)(p.ws + WS_Z);
    const int b = task >> 8, t0 = (task & 255) * 16;
    { u32x4 av[6], gv[6];
#pragma unroll
      for (int it = 0; it < 6; ++it) { const int idx = tid + it * NTHR, tt = idx >> 6, cc = (idx & 63) * 8, tok = t0 - 15 + tt;
          av[it] = (u32x4){0u, 0u, 0u, 0u}; gv[it] = av[it];
          if (idx < 46 * 64 && tok >= 0 && tok < SEQ) { const bf16* zr = Z + (size_t)(b * SEQ + tok) * DIN; av[it] = *(const u32x4*)(zr + 10 * DG + cc); gv[it] = *(const u32x4*)(zr + 11 * DG + cc); } }
      asm volatile("" ::: "memory");
#pragma unroll
      for (int it = 0; it < 6; ++it) { const int idx = tid + it * NTHR, tt = idx >> 6, cc = (idx & 63) * 8;
          if (idx < 46 * 64) { const u32x4 a = av[it], g = gv[it]; f32x4 u0, u1;
              u0[0] = bflo(a.x) / (1.f + __expf(-bflo(g.x))); u0[1] = bfhi(a.x) / (1.f + __expf(-bfhi(g.x))); u0[2] = bflo(a.y) / (1.f + __expf(-bflo(g.y))); u0[3] = bfhi(a.y) / (1.f + __expf(-bfhi(g.y)));
              u1[0] = bflo(a.z) / (1.f + __expf(-bflo(g.z))); u1[1] = bfhi(a.z) / (1.f + __expf(-bfhi(g.z))); u1[2] = bflo(a.w) / (1.f + __expf(-bflo(g.w))); u1[3] = bfhi(a.w) / (1.f + __expf(-bfhi(g.w)));
              *(f32x4*)(us + tt * 512 + cc) = u0; *(f32x4*)(us + tt * 512 + cc + 4) = u1; } } }
    float w[31];
#pragma unroll
    for (int k = 0; k < 31; ++k) w[k] = p.conv_w[(size_t)(l * 31 + k) * DG + tid];
    const float cb = p.conv_b[l * DG + tid];
    __syncthreads();
    { float y[16];
#pragma unroll
      for (int t = 0; t < 16; ++t) y[t] = cb;
#pragma unroll
      for (int j = 0; j < 46; ++j) { const float u = us[j * 512 + tid];
#pragma unroll
          for (int t = 0; t < 16; ++t) { const int k = j - t; if (k >= 0 && k < 31) y[t] += w[k] * u; } }
#pragma unroll
      for (int t = 0; t < 16; ++t) ys[t * 512 + tid] = y[t]; }
    __syncthreads();
#pragma unroll
    for (int tw = 0; tw < 2; ++tw) { const int t = wave + 8 * tw; float v[8]; float s = 0.f;
#pragma unroll
        for (int j = 0; j < 8; ++j) { v[j] = ys[t * 512 + lane + 64 * j]; s += v[j]; }
        const float mu = wave_sum(s) * (1.f / 512.f); float q = 0.f;
#pragma unroll
        for (int j = 0; j < 8; ++j) { v[j] -= mu; q += v[j] * v[j]; }
        const float rstd = rsqrtf(wave_sum(q) * (1.f / 512.f) + 1e-6f);
        bf16* orow = (bf16*)(p.ws + WS_CVH) + (size_t)(b * SEQ + t0 + t) * DG;
#pragma unroll
        for (int j = 0; j < 8; ++j) { const int ch = lane + 64 * j; const float y = v[j] * rstd * p.ln_g[l * DG + ch] + p.ln_b[l * DG + ch]; orow[ch] = (bf16)f2bf(silu_f(y)); } }
    __syncthreads();
}

__device__ __forceinline__ void ph_mixA(const Params& p, int l, unsigned char* lds) {
    const int G = gridDim.x, bid = obid();
    for (int t = bid; t < 512 * REP_R1; t += G) ret1_task(p, l, t & 511, lds);
    const int xcd = bid & 7, slot = bid >> 3, nloc = (slot < 16) ? 1 : 3, r0 = (slot < 16) ? slot : 16 + (slot - 16) * 3;
    if (G == 256 && REP_NA == 1) {
        for (int i = 0; i < nloc; ++i) { const int rq = (slot < 16) ? slot : 16 + i * 16 + (slot - 16);
            na2_task(p, l, (xcd >> 2) * 256 + rq * 4 + (xcd & 3), lds); }
    } else for (int t = bid; t < 512 * REP_NA; t += G) na2_task(p, l, t & 511, lds);
    if (G == 256 && REP_CV == 1) {
        for (int i = 0; i < 2; ++i) conv_task(p, l, xcd * 64 + i * 32 + slot, lds);
    } else for (int t = bid; t < 512 * REP_CV; t += G) conv_task(p, l, t & 511, lds);
}

__device__ __forceinline__ void ph_fold(const Params& p_) {
    const Params p = *kparams(); (void)p_;
    const bf16* PQ = (const bf16*)(p.ws + WS_PQT); bf16* PQF = (bf16*)(p.ws + WS_PQF);
    for (int e = obid() * NTHR + otid(); e < NB * DG * 2 * 256; e += gridDim.x * NTHR) {
        const int row = e >> 8, s0 = (e & 255) * 8, pq = row & 1;
        const bf16* src = PQ + (size_t)row * 4096;
        const u32x4 own = *(const u32x4*)(src + s0), low = *(const u32x4*)(src + 4096 - s0 - 8);
        const float top = (s0 == 0) ? 0.f : bf2f(src[4096 - s0]);
        const float sg = pq ? -1.f : 1.f;
        float o[8];
        o[0] = bflo(own.x) + sg * top;            o[1] = bfhi(own.x) + sg * bfhi(low.w);
        o[2] = bflo(own.y) + sg * bflo(low.w);    o[3] = bfhi(own.y) + sg * bfhi(low.z);
        o[4] = bflo(own.z) + sg * bflo(low.z);    o[5] = bfhi(own.z) + sg * bfhi(low.y);
        o[6] = bflo(own.w) + sg * bflo(low.y);    o[7] = bfhi(own.w) + sg * bfhi(low.x);
        if (s0 == 0 && pq) o[0] = 0.f;
        u32x4 w; w.x = pk2(o[0], o[1]); w.y = pk2(o[2], o[3]); w.z = pk2(o[4], o[5]); w.w = pk2(o[6], o[7]);
        *(u32x4*)(PQF + (size_t)row * 2048 + s0) = w;
    }
}
__device__ __forceinline__ void ph_alt(const Params& p_) {
    const Params p = *kparams(); (void)p_;
    const int tid = otid(), lane = tid & 63, wave = tid >> 6; const bf16* PQF = (const bf16*)(p.ws + WS_PQF);
    float* dst = (float*)(p.ws + WS_PART) + (size_t)(2 * 2304 + 2 * 2048) * 512;
    for (int r = obid() * 8 + wave; r < NB * DG; r += gridDim.x * 8) {
        const u32x4* src = (const u32x4*)(PQF + (size_t)r * 4096) + lane; float acc = 0.f;
#pragma unroll
        for (int j = 0; j < 4; ++j) { const u32x4 v = src[64 * j];
            acc += (bflo(v.x) - bfhi(v.x)) + (bflo(v.y) - bfhi(v.y)) + (bflo(v.z) - bfhi(v.z)) + (bflo(v.w) - bfhi(v.w)); }
        acc = wave_sum(acc);
        if (lane == 0) dst[r] = acc;
    }
}
__device__ __forceinline__ void ph_combine(const Params& p_) {
    const Params p = *kparams(); (void)p_;
    const float* Ce = (const float*)(p.ws + WS_PART); const float* So = Ce + (size_t)2 * 2304 * 512;
    bf16* CAT = (bf16*)(p.ws + WS_CAT); const bf16* Z = (const bf16*)(p.ws + WS_Z); const bf16* PQ = (const bf16*)(p.ws + WS_PQT);
    const int nth = gridDim.x * NTHR;
    for (int e0 = obid() * NTHR + otid(); e0 < MTOK * DG / 4; e0 += 2 * nth) {
        f32x4 ce[2], so[2]; u32x2 gz[2]; float pv[2][4]; int rowv[2], c4v[2], kv[2]; bool use_so[2], act[2];
#pragma unroll
        for (int u = 0; u < 2; ++u) { const int e = e0 + u * nth; act[u] = e < MTOK * DG / 4; const int ee = act[u] ? e : e0;
            const int row = ee >> 7, c4 = (ee & 127) * 4, b = row >> 12, k = row & 4095, kk = (k <= 2048) ? k : 4096 - k;
            rowv[u] = row; c4v[u] = c4; kv[u] = k; use_so[u] = (kk != 0 && kk != 2048);
            ce[u] = (kk == 2048) ? *(const f32x4*)(Ce + (size_t)(2 * 2304 + 2 * 2048) * 512 + b * 512 + c4) : *(const f32x4*)(Ce + ((size_t)b * 2304 + kk) * 512 + c4);
            so[u] = *(const f32x4*)(So + ((size_t)b * 2048 + (use_so[u] ? kk : 1)) * 512 + c4);
            gz[u] = *(const u32x2*)(Z + (size_t)row * DIN + DG + c4);
#pragma unroll
            for (int j = 0; j < 4; ++j) pv[u][j] = bf2f(PQ[((size_t)(b * 512 + c4 + j) * 2) * 4096 + 2048]); }
        asm volatile("" ::: "memory");
#pragma unroll
        for (int u = 0; u < 2; ++u) if (act[u]) { f32x4 s = ce[u];
            if (use_so[u]) s = (kv[u] <= 2048) ? s - so[u] : s + so[u];
            const float alt = (kv[u] & 1) ? -1.f : 1.f;
#pragma unroll
            for (int j = 0; j < 4; ++j) s[j] += alt * pv[u][j];
            u32x2 w; w.x = pk2(s[0] * silu_f(bflo(gz[u].x)), s[1] * silu_f(bfhi(gz[u].x))); w.y = pk2(s[2] * silu_f(bflo(gz[u].y)), s[3] * silu_f(bfhi(gz[u].y)));
            *(u32x2*)(CAT + (size_t)rowv[u] * DM + c4v[u]) = w; }
    }
}

#define XB_TMO      128
#define XB_XCNT(j)  (256  + 64 * (j))
#define XB_XSUB(j)  (1280 + 64 * (j))
#define XB_XGEN(j)  (2304 + 64 * (j))
#define XB_TOP      3328
#define XB_TOPGEN   3392
#define XCD_BAR_WORDS 3456
#define XB_SPIN_CAP (1u << 20)
__device__ __forceinline__ unsigned xb_ld(unsigned* p)              { return __hip_atomic_load(p, __ATOMIC_RELAXED, __HIP_MEMORY_SCOPE_AGENT); }
__device__ __forceinline__ unsigned xb_add(unsigned* p, unsigned v) { return __hip_atomic_fetch_add(p, v, __ATOMIC_RELAXED, __HIP_MEMORY_SCOPE_AGENT); }
__device__ __forceinline__ unsigned xb_xcc_id() { return (unsigned)__builtin_amdgcn_s_getreg((3 << 11) | 20) & 0xFu; }
#define XB_SPIN(cond, bar) do { unsigned _sp = 0; while (cond) { __builtin_amdgcn_s_sleep(1); \
    if ((++_sp & 255u) == 0u) { if (xb_ld(&(bar)[XB_TMO])) break; if (_sp > XB_SPIN_CAP) { atomicAdd(&(bar)[XB_TMO], 1u); break; } } } } while (0)
struct XcdBarrier { unsigned* bar; unsigned x; volatile PG8_LAS unsigned* st; };
__device__ __forceinline__ XcdBarrier xcd_barrier_post(unsigned* bar, volatile PG8_LAS unsigned* st) {
    XcdBarrier b; b.bar = bar; b.x = xb_xcc_id(); b.st = st;
    if (otid() == 0) (void)xb_add(&bar[XB_XCNT(b.x)], 1u);
    return b;
}
__device__ __forceinline__ void xcd_barrier_complete(unsigned* bar, unsigned x, unsigned& nloc, unsigned& nx) {
    const unsigned G = gridDim.x * gridDim.y * gridDim.z;
    unsigned sum, cnt, mine, sp = 0u;
    for (;;) {
        sum = 0u; cnt = 0u; mine = 0u;
#pragma unroll
        for (unsigned j = 0; j < 16; ++j) { const unsigned c = xb_ld(&bar[XB_XCNT(j)]); sum += c; cnt += (c > 0u) ? 1u : 0u; mine = (j == x) ? c : mine; }
        if (sum == G) break;
        __builtin_amdgcn_s_sleep(1);
        if ((++sp & 255u) == 0u) { if (xb_ld(&bar[XB_TMO])) break; if (sp > XB_SPIN_CAP) { atomicAdd(&bar[XB_TMO], 1u); break; } }
    }
    nloc = mine > 0u ? mine : 1u; nx = cnt > 0u ? cnt : 1u;
}
__device__ __forceinline__ void xcd_barrier(const XcdBarrier& b) {
    asm volatile("s_waitcnt vmcnt(0)" ::: "memory");
    __syncthreads();
    if (otid() == 0) {
        unsigned* bar = b.bar;
        __builtin_amdgcn_s_waitcnt(0);
        unsigned nloc = b.st[0], nx = b.st[1];
        if (nloc == 0u) { xcd_barrier_complete(bar, b.x, nloc, nx); b.st[0] = nloc; b.st[1] = nx; }
        const unsigned old = xb_add(&bar[XB_XSUB(b.x)], 1u);
        const unsigned gen = old / nloc;
        if (old + 1u == (gen + 1u) * nloc) {
            __builtin_amdgcn_fence(__ATOMIC_RELEASE, "agent");
            asm volatile("s_waitcnt vmcnt(0)" ::: "memory");
            const unsigned og = xb_add(&bar[XB_TOP], 1u);
            const unsigned tg = og / nx;
            if (og + 1u == (tg + 1u) * nx) xb_add(&bar[XB_TOPGEN], 1u);
            else XB_SPIN(xb_ld(&bar[XB_TOPGEN]) == tg, bar);
            __builtin_amdgcn_fence(__ATOMIC_ACQUIRE, "agent");
            xb_add(&bar[XB_XGEN(b.x)], 1u);
            asm volatile("s_waitcnt vmcnt(0)" ::: "memory");
        } else {
            XB_SPIN(xb_ld(&bar[XB_XGEN(b.x)]) == gen, bar);
            __builtin_amdgcn_fence(__ATOMIC_ACQUIRE, "agent");
            asm volatile("s_waitcnt vmcnt(0)" ::: "memory");
        }
    }
    __syncthreads();
}

constexpr int NPH = 14;
__global__ void __launch_bounds__(NTHR) mega(Params p) {
    extern __shared__ __attribute__((aligned(16))) unsigned char lds[];
    cg::grid_group grid = cg::this_grid();
    PG8_LAS unsigned char* ldsl = (PG8_LAS unsigned char*)lds;
    const int lo = p.ph_lo, hi = p.ph_hi;
#define IN(k) (lo <= (k) && (k) < hi)
#define SEAM(k) do { if (IN(k) && IN((k) + 1)) { xcd_barrier(xb); } } while (0)
    bf16* Zb = (bf16*)(kparams()->ws + WS_Z); bf16* CAT = (bf16*)(kparams()->ws + WS_CAT);
    volatile PG8_LAS unsigned* xst = (volatile PG8_LAS unsigned*)(ldsl + LDS_BYTES - 16);
    { const int t0_ = otid(); if (t0_ < 4) xst[t0_] = 0u; }
    __syncthreads();
    XcdBarrier xb = xcd_barrier_post((unsigned*)(kparams()->ws + WS_BAR), xst);
    if (p.ph_lo < 0) grid.sync();
    if (IN(0)) REPEAT(REP_PRO) { ph_prologue(p, lds); __syncthreads(); }
    SEAM(0);
    if (IN(0) && IN(1)) for (int r_ = 1; r_ < REP_SUB; ++r_) xcd_barrier(xb);
#pragma unroll
    for (int l = 0; l < NL; ++l) {
        const int pb = 1 + 6 * l;
        const char* Wl = (const char*)(kparams()->ws + WS_WIN + (size_t)l * WROWS * DM * 2);
        if (IN(pb)) {
            if (l == 0) {
#pragma unroll
                for (int ll = 0; ll < NL; ++ll) {
                    SchedS S = make_sched(kparams()->ws + WS_WCS + (size_t)ll * 1024 * DG * 2, DG, kparams()->ws + WS_WFXB + (size_t)ll * DM * DG * 2, DG, 1024, DM, 32 * ll);
                    EpiZ E{(bf16*)(kparams()->ws + WS_WIN + ((size_t)ll * WROWS + 6656) * DM * 2), DM};
                    pg8::gemm_phase<EpiZ, SchedS, true>(ldsl, pg8::Gemm{DG, DG, DG}, S, E);
                }
            }
            REPEAT(REP_NORM) ph_norm(p, l, (l == 0 && gridDim.x == 256) ? 64 : 0);
        }
        SEAM(pb);
        if (IN(pb + 1)) REPEAT(REP_Z) {
            SchedZ S; S.o.init(MTOK, 24 * 256, (int)gridDim.x, obid()); S.A = (const char*)(kparams()->ws + WS_U); S.B = Wl; S.late = 0;
            EpiZ2 E{Zb, (bf16*)(kparams()->ws + WS_PQT)};
            pg8::gemm_phase<EpiZ2, SchedZ, true>(ldsl, pg8::Gemm{DM, DM, DM}, S, E);
        }
        SEAM(pb + 1);
        if (IN(pb + 2)) {
            {
                SchedZ S; S.o.init(MTOK, 4 * 256, (int)gridDim.x, obid()); S.A = (const char*)(kparams()->ws + WS_U); S.B = Wl; S.late = 1;
                EpiZ2 E{Zb, (bf16*)(kparams()->ws + WS_PQT)};
                pg8::gemm_phase<EpiZ2, SchedZ, true>(ldsl, pg8::Gemm{DM, DM, DM}, S, E);
            }
            REPEAT(REP_MIX) ph_mixA(p, l, lds);
            ph_fold(p);
        }
        SEAM(pb + 2);
        if (IN(pb + 3)) REPEAT(REP_P3) {
            const int G_ = (int)gridDim.x, b_ = obid(); const bool bal = (G_ == 256);
            {
                SchedDFT S{(const char*)(kparams()->ws + WS_DC), (const char*)(kparams()->ws + WS_PQF), G_, b_};
                EpiPart E{(float*)(kparams()->ws + WS_PART)};
                pg8::gemm_phase<EpiPart, SchedDFT, true>(ldsl, pg8::Gemm{2048, 4096, 2048}, S, E); }
            {
                SchedS S = make_sched(kparams()->ws + WS_CVH, DG, kparams()->ws + WS_WPW + (size_t)l * DG * DG * 2, DG, MTOK, DG, bal ? 192 : 0);
                EpiGate E{CAT, Zb, 1536, 12 * DG};
                pg8::gemm_phase<EpiGate, SchedS, true>(ldsl, pg8::Gemm{DG, DG, DG}, S, E); }
            if (bal && REP_R2 == 1) {
                const int xcd = b_ & 7, slot = b_ >> 3;
                const int nt_ = (slot >= 24) ? 2 : (slot >= 8 ? 3 : 0), k0 = (slot >= 24) ? 48 + (slot - 24) * 2 : (slot - 8) * 3;
                for (int i = 0; i < nt_; ++i) { const int k = (slot >= 24) ? 48 + i * 8 + (slot - 24) : i * 16 + (slot - 8);
                    ret2_task(p, l, (2 * xcd + (k >> 5)) * 32 + (k & 31), lds); }
            }
            else for (int t = b_; t < 512 * REP_R2; t += G_) ret2_task(p, l, t & 511, lds);
            ph_alt(p);
        }
        SEAM(pb + 3);
        if (IN(pb + 4)) REPEAT(REP_CMB) ph_combine(p);
        SEAM(pb + 4);
        if (IN(pb + 5)) REPEAT(l == 0 ? REP_OUT : 1) {
            SchedS S = make_sched(CAT, DM, kparams()->ws + WS_WOUT + (size_t)l * DM * DM * 2, DM, MTOK, DM);
            EpiRes E{(l == 0) ? kparams()->x : kparams()->out, kparams()->out, (const float*)(kparams()->ws + WS_MOD) + (size_t)l * 2 * 6144 + 4096};
            pg8::gemm_phase<EpiRes, SchedS, true>(ldsl, pg8::Gemm{DM, DM, DM}, S, E);
        }
        SEAM(pb + 5);
    }
    if (IN(NPH - 1)) ph_final(p);
#undef IN
#undef SEAM
}

extern "C" void kernel_launch(void* const* d_in, const int* in_sizes, int n_in, void* d_out, int out_size, void* d_ws, size_t ws_size, hipStream_t stream) {
    static int grid_blocks = 0;
    if (grid_blocks == 0) {
        if (n_in != 17 || ws_size < WS_END) { fprintf(stderr, "kernel_launch: n_in %d ws %zu (need %zu)\n", n_in, ws_size, (size_t)WS_END); grid_blocks = -1; return; }
        int dev = 0, cus = 0, per_cu = 0;
        hipGetDevice(&dev); hipDeviceGetAttribute(&cus, hipDeviceAttributeMultiprocessorCount, dev);
        if (hipFuncSetAttribute((const void*)mega, hipFuncAttributeMaxDynamicSharedMemorySize, LDS_BYTES) != hipSuccess) { fprintf(stderr, "hipFuncSetAttribute failed\n"); grid_blocks = -1; return; }
        if (hipOccupancyMaxActiveBlocksPerMultiprocessor(&per_cu, (const void*)mega, NTHR, LDS_BYTES) != hipSuccess || per_cu < 1) { fprintf(stderr, "occupancy query: %d\n", per_cu); per_cu = 1; }
        (void)hipGetLastError();
        grid_blocks = cus * 1;
    }
    if (grid_blocks < 0) return;
    Params p{};
    p.x = (const float*)d_in[0]; p.c = (const float*)d_in[1]; p.norm_g = (const float*)d_in[2]; p.w_ada = (const float*)d_in[3]; p.b_ada = (const float*)d_in[4];
    p.w_in = (const float*)d_in[5]; p.w_fft = (const float*)d_in[6]; p.na_bias = (const float*)d_in[7]; p.rl_f = (const float*)d_in[8]; p.rl_b = (const float*)d_in[9];
    p.conv_w = (const float*)d_in[10]; p.conv_b = (const float*)d_in[11]; p.ln_g = (const float*)d_in[12]; p.ln_b = (const float*)d_in[13]; p.w_pw = (const float*)d_in[14];
    p.w_out = (const float*)d_in[15]; p.final_g = (const float*)d_in[16];
    p.out = (float*)d_out; p.ws = (unsigned char*)d_ws;
#if ONE_LAUNCH
    if (hipMemsetAsync((char*)d_ws + WS_BAR, 0, 16384, stream) != hipSuccess) { fprintf(stderr, "memset of the barrier words failed\n"); return; }
    p.ph_lo = 0; p.ph_hi = NPH;
    void* args[] = {&p};
    hipError_t e = hipLaunchCooperativeKernel((const void*)mega, dim3(grid_blocks), dim3(NTHR), args, LDS_BYTES, stream);
    if (e != hipSuccess) fprintf(stderr, "cooperative launch failed: %s (grid %d)\n", hipGetErrorString(e), grid_blocks);
#else
    for (int ph = 0; ph < NPH; ++ph) { p.ph_lo = ph; p.ph_hi = ph + 1; hipLaunchKernelGGL(mega, dim3(grid_blocks), dim3(NTHR), LDS_BYTES, stream, p); }
#endif
}
```

```cpp
#include <hip/hip_runtime.h>
#include <hip/hip_cooperative_groups.h>
#include <cstdio>
#include <cstdint>
namespace cg = cooperative_groups;

#ifndef ONE_LAUNCH
#define ONE_LAUNCH 1
#endif

__device__ __forceinline__ int obid() { int b = (int)blockIdx.x; asm volatile("" : "+s"(b)); return b; }
__device__ __forceinline__ int otid() { int t; asm volatile("v_mov_b32 %0, %1" : "=v"(t) : "v"(threadIdx.x)); return t; }
namespace pg8 {
#define PG8_LAS __attribute__((address_space(3)))
typedef unsigned short bf16_t;
typedef short bf16x8 __attribute__((ext_vector_type(8)));
typedef float f32x4 __attribute__((ext_vector_type(4)));
typedef unsigned u32x4 __attribute__((ext_vector_type(4)));
constexpr int BM = 256, BK = 64, HALF = 128, HTB = HALF * BK * 2, STAGE_BYTES = 8 * HTB, NXCD = 8, WGM = 2;

__host__ __device__ __forceinline__ int lds_byte(int r, int c) { const int st = (r >> 4) * 2 + (c >> 5), rr = r & 15, cc = c & 31, ob = rr * 64 + cc * 2; return st * 1024 + (ob ^ (((ob >> 9) & 1) << 5)); }
__host__ __device__ __forceinline__ void stage_rc(int b, int& R, int& C) { const int st = b / 1024, sb = b % 1024, swz = sb ^ (((sb >> 9) & 1) << 5); R = (st >> 1) * 16 + swz / 64; C = (st & 1) * 32 + (swz % 64) / 2; }
__host__ __device__ __forceinline__ int perm32(int rho) { const int n = rho >> 4, i = rho & 15; return 8 * (i >> 2) + 4 * n + (i & 3); }

struct Unit { int pm, pn, aux, pad; const char* A; const char* B; };
struct Gemm { int lda, ldb, K; };

struct StaticOrder {
    int nM, nN, nwg, G, c;
    __host__ __device__ void init(int M, int N, int G_, int c_) { nM = M / BM; nN = N / BM; nwg = nM * nN; G = G_; c = c_; }
    __device__ bool next(int i, Unit& u) const {
        const long L = (long)i * G + c; if (L >= nwg) return false;
        int wgid = __builtin_amdgcn_readfirstlane((int)L); { const int q = nwg / NXCD, r = nwg % NXCD, xcd = wgid % NXCD, off = wgid / NXCD; wgid = (xcd < r ? xcd * (q + 1) : r * (q + 1) + (xcd - r) * q) + off; }
        const int nig = WGM * nN, gid = wgid / nig, fm = gid * WGM, gsz = (nM - fm) < WGM ? (nM - fm) : WGM;
        u.pm = __builtin_amdgcn_readfirstlane(fm + ((wgid % nig) % gsz)); u.pn = __builtin_amdgcn_readfirstlane((wgid % nig) / gsz); return true;
    }
};

__device__ __forceinline__ unsigned cvt_pk_bf16(float lo, float hi) { unsigned r; asm volatile("v_cvt_pk_bf16_f32 %0, %1, %2" : "=v"(r) : "v"(lo), "v"(hi)); return r; }

template <class Epi, class Sched, bool ALIGN_EPI>
__device__ __forceinline__ void gemm_phase(PG8_LAS unsigned char* lds, const Gemm g, const Sched& S, const Epi& E) {
    const int tid = otid(), wid = __builtin_amdgcn_readfirstlane(tid >> 6), lane = tid & 63, wr = wid >> 2, wc = wid & 3, fr = lane & 15, fq = lane >> 4;
    const int K = g.K, nt = K / BK;
    unsigned voffA[2], voffB[2];
#pragma unroll
    for (int i = 0; i < 2; ++i) { int R, C; stage_rc(tid * 16 + i * 8192, R, C); const int Rb = Epi::PERM ? ((R & ~31) + perm32(R & 31)) : R;
        voffA[i] = (unsigned)(R * g.lda + C) * 2u; voffB[i] = (unsigned)(Rb * g.ldb + C) * 2u; }
    const size_t kstep = (size_t)(BK * 2);
    const size_t hA = (size_t)HALF * g.lda * 2, hB = (size_t)HALF * g.ldb * 2;
    const unsigned ldsw = (unsigned)wid * 1024u;
    const int aoff = lds_byte(wr * 64 + fr, fq * 8), boff = lds_byte(wc * 32 + fr, fq * 8);
#define PG8_SA(b, h) (((b) * 2 + (h)) * HTB)
#define PG8_SB(b, h) ((4 + (b) * 2 + (h)) * HTB)
#define PG8_STAGE(bufoff, gbase, voff) do { _Pragma("unroll") for (int _i = 0; _i < 2; ++_i) \
        __builtin_amdgcn_global_load_lds((const unsigned*)((const char*)(gbase) + (voff)[_i]), (PG8_LAS unsigned*)(lds + (bufoff) + ldsw + _i * 8192), 16, 0, 0); } while (0)
#define PG8_LDA(dst, b, h) do { _Pragma("unroll") for (int m = 0; m < 4; ++m) _Pragma("unroll") for (int k = 0; k < 2; ++k) dst[m][k] = *(const PG8_LAS bf16x8*)(lds + PG8_SA(b, h) + aoff + m * 2048 + k * 1024); } while (0)
#define PG8_LDB(dst, b, h) do { _Pragma("unroll") for (int n = 0; n < 2; ++n) _Pragma("unroll") for (int k = 0; k < 2; ++k) dst[n][k] = *(const PG8_LAS bf16x8*)(lds + PG8_SB(b, h) + boff + n * 2048 + k * 1024); } while (0)
#define PG8_MMA(ai, bj, At, Bt) do { __builtin_amdgcn_s_setprio(1); _Pragma("unroll") for (int m = 0; m < 4; ++m) _Pragma("unroll") for (int n = 0; n < 2; ++n) _Pragma("unroll") for (int k = 0; k < 2; ++k) \
        acc[ai][bj][m][n] = __builtin_amdgcn_mfma_f32_16x16x32_bf16(Bt[n][k], At[m][k], acc[ai][bj][m][n], 0, 0, 0); __builtin_amdgcn_s_setprio(0); } while (0)
#define PG8_WAIT_V(n) asm volatile("s_waitcnt vmcnt(" #n ")" ::: "memory")
#define PG8_WAIT_L(n) asm volatile("s_waitcnt lgkmcnt(" #n ")" ::: "memory")
#define PG8_BAR __builtin_amdgcn_s_barrier()
#define PG8_SCHED __builtin_amdgcn_sched_barrier(0)
    Unit cur, nxt; int ui = 0;
    if (!S.next(0, cur)) return;
    f32x4 acc[2][2][4][2];
#pragma unroll
    for (int a = 0; a < 2; ++a)
#pragma unroll
        for (int b = 0; b < 2; ++b)
#pragma unroll
            for (int m = 0; m < 4; ++m)
#pragma unroll
                for (int n = 0; n < 2; ++n) acc[a][b][m][n] = (f32x4){0.f, 0.f, 0.f, 0.f};
    bf16x8 At[4][2], B0[2][2], B1[2][2];
    const char* cA = cur.A; const char* cB = cur.B;
    PG8_STAGE(PG8_SB(0, 0), cB, voffB); PG8_STAGE(PG8_SB(0, 1), cB + hB, voffB); PG8_STAGE(PG8_SA(0, 0), cA, voffA); PG8_STAGE(PG8_SA(0, 1), cA + hA, voffA);
    if (wr == 1) PG8_BAR;
    PG8_WAIT_V(2); PG8_BAR;
    PG8_STAGE(PG8_SB(1, 0), cB + kstep, voffB); PG8_STAGE(PG8_SA(1, 0), cA + kstep, voffA); PG8_STAGE(PG8_SB(1, 1), cB + hB + kstep, voffB);
    PG8_WAIT_V(6); PG8_BAR;
    for (;;) {
        const bool has_next = S.next(ui + 1, nxt);
        const char* nA = has_next ? nxt.A : cA; const char* nB = has_next ? nxt.B : cB;
        for (int t = 0; t < nt; t += 2) {
            const bool last = (t == nt - 2);
            const char* a1 = cA + (size_t)(t + 1) * kstep;
            const char* a2 = last ? nA : cA + (size_t)(t + 2) * kstep; const char* b2 = last ? nB : cB + (size_t)(t + 2) * kstep;
            const char* a3 = a2 + kstep; const char* b3 = b2 + kstep;
            PG8_LDB(B0, 0, 0); PG8_LDB(B1, 0, 1); PG8_SCHED; PG8_LDA(At, 0, 0); PG8_STAGE(PG8_SA(1, 1), a1 + hA, voffA);
            PG8_WAIT_V(8); PG8_WAIT_L(0); PG8_BAR; PG8_MMA(0, 0, At, B0); PG8_MMA(0, 1, At, B1); PG8_BAR; PG8_SCHED;
            PG8_LDA(At, 0, 1); PG8_STAGE(PG8_SB(0, 0), b2, voffB); PG8_STAGE(PG8_SB(0, 1), b2 + hB, voffB); PG8_STAGE(PG8_SA(0, 0), a2, voffA);
            PG8_WAIT_V(8); PG8_WAIT_L(0); PG8_BAR; PG8_MMA(1, 0, At, B0); PG8_MMA(1, 1, At, B1); PG8_BAR; PG8_SCHED;
            PG8_LDB(B0, 1, 0); PG8_LDB(B1, 1, 1); PG8_SCHED; PG8_LDA(At, 1, 0); PG8_STAGE(PG8_SA(0, 1), a2 + hA, voffA);
            PG8_WAIT_V(8); PG8_WAIT_L(0); PG8_BAR; PG8_MMA(0, 0, At, B0); PG8_MMA(0, 1, At, B1); PG8_BAR; PG8_SCHED;
            PG8_LDA(At, 1, 1); PG8_STAGE(PG8_SB(1, 0), b3, voffB); PG8_STAGE(PG8_SB(1, 1), b3 + hB, voffB); PG8_STAGE(PG8_SA(1, 0), a3, voffA);
            PG8_WAIT_V(8); PG8_WAIT_L(0); PG8_BAR; PG8_MMA(1, 0, At, B0); PG8_MMA(1, 1, At, B1); PG8_BAR; PG8_SCHED;
        }
        if constexpr (ALIGN_EPI) { if (wr == 0) PG8_BAR; }
        E(acc, cur, wr, wc, fr, fq);
        if (!has_next) break;
#pragma unroll
        for (int a = 0; a < 2; ++a)
#pragma unroll
            for (int b = 0; b < 2; ++b)
#pragma unroll
                for (int m = 0; m < 4; ++m)
#pragma unroll
                    for (int n = 0; n < 2; ++n) acc[a][b][m][n] = (f32x4){0.f, 0.f, 0.f, 0.f};
        cur = nxt; cA = nA; cB = nB; ++ui;
        if constexpr (ALIGN_EPI) { if (wr == 1) PG8_BAR; }
    }
    PG8_WAIT_V(0);
    if constexpr (!ALIGN_EPI) { if (wr == 0) PG8_BAR; }
    PG8_BAR;
#undef PG8_SA
#undef PG8_SB
#undef PG8_STAGE
#undef PG8_LDA
#undef PG8_LDB
#undef PG8_MMA
#undef PG8_WAIT_V
#undef PG8_WAIT_L
#undef PG8_BAR
#undef PG8_SCHED
}
}

typedef unsigned short bf16;
typedef float f32x4 __attribute__((ext_vector_type(4)));
typedef unsigned u32x4 __attribute__((ext_vector_type(4)));
typedef unsigned u32x2 __attribute__((ext_vector_type(2)));
constexpr int NB = 2, SEQ = 4096, DM = 2048, MTOK = NB * SEQ, DIN = 6656, DG = 512, NL = 2;
constexpr int LDS_BYTES = 147456;
constexpr int NTHR = 512;

constexpr int WROWS = 7680;
constexpr size_t WS_WIN = 0;
constexpr size_t WS_WOUT = WS_WIN + (size_t)NL * WROWS * DM * 2;
constexpr size_t WS_WCS = WS_WOUT + (size_t)NL * DM * DM * 2;
constexpr size_t WS_WFXB = WS_WCS + (size_t)NL * 1024 * DG * 2;
constexpr size_t WS_WPW = WS_WFXB + (size_t)NL * DM * DG * 2;
constexpr size_t WS_DC = WS_WPW + (size_t)NL * DG * DG * 2;
constexpr size_t WS_DS = WS_DC + (size_t)2304 * 2048 * 2;
constexpr size_t WS_PQF = WS_DS + (size_t)2048 * 2048 * 2;
constexpr size_t WS_ROPE = WS_PQF + (size_t)NB * DG * 2 * 2048 * 2;
constexpr size_t WS_MOD = WS_ROPE + (size_t)SEQ * 32 * 8;
constexpr size_t WS_U = WS_MOD + 131072;
constexpr size_t WS_PART = WS_U + (size_t)MTOK * DM * 2;
constexpr size_t WS_Z = WS_U + (size_t)4 * MTOK * DG * 4;
constexpr size_t WS_PQT = WS_Z + (size_t)MTOK * DIN * 2;
constexpr size_t WS_CVH = WS_PQT + (size_t)NB * DG * 2 * SEQ * 2;
constexpr size_t WS_CAT = WS_CVH + (size_t)MTOK * DG * 2;
constexpr size_t WS_KV = WS_CAT + (size_t)MTOK * DM * 2;
constexpr size_t WS_BAR = WS_KV + (size_t)2 * NB * 8 * 32 * 4096 * 4;
constexpr size_t WS_END = WS_BAR + 16384;

struct Params {
    const float* x; const float* c; const float* norm_g; const float* w_ada; const float* b_ada; const float* w_in; const float* w_fft; const float* na_bias;
    const float* rl_f; const float* rl_b; const float* conv_w; const float* conv_b; const float* ln_g; const float* ln_b; const float* w_pw; const float* w_out; const float* final_g;
    float* out; unsigned char* ws; int ph_lo, ph_hi;
};

#if defined(__HIP_DEVICE_COMPILE__)
typedef const __attribute__((address_space(4))) Params* KParams;
__device__ __forceinline__ KParams kparams() { KParams k = (KParams)__builtin_amdgcn_kernarg_segment_ptr(); asm volatile("" : "+s"(k)); return k; }
#else
typedef const Params* KParams;
__device__ __forceinline__ KParams kparams() { return nullptr; }
#endif
__device__ __forceinline__ unsigned f2bf(float f) { unsigned u = __float_as_uint(f); return (u + 0x7fffu + ((u >> 16) & 1u)) >> 16; }
__device__ __forceinline__ unsigned pk2(float lo, float hi) { return f2bf(lo) | (f2bf(hi) << 16); }
__device__ __forceinline__ float bf2f(bf16 b) { return __uint_as_float((unsigned)b << 16); }
__device__ __forceinline__ float bflo(unsigned u) { return __uint_as_float(u << 16); }
__device__ __forceinline__ float bfhi(unsigned u) { return __uint_as_float(u & 0xffff0000u); }
__device__ __forceinline__ float silu_f(float v) { return v / (1.f + __expf(-v)); }
__device__ __forceinline__ float wave_sum(float v) {
#pragma unroll
    for (int o = 1; o < 64; o <<= 1) v += __shfl_xor(v, o);
    return v;
}
__device__ __forceinline__ float wave_max(float v) {
#pragma unroll
    for (int o = 1; o < 64; o <<= 1) v = fmaxf(v, __shfl_xor(v, o));
    return v;
}

struct SchedS {
    pg8::StaticOrder o; const char* A; const char* B; size_t ta, tb;
    __device__ __forceinline__ bool next(int i, pg8::Unit& u) const { if (!o.next(i, u)) return false; u.A = A + (size_t)u.pm * ta; u.B = B + (size_t)u.pn * tb; u.aux = 0; return true; }
};
__device__ __forceinline__ SchedS make_sched(const void* A, int lda, const void* B, int ldb, int M, int N, int shift = 0) {
    SchedS s; s.o.init(M, N, (int)gridDim.x, (int)((obid() + gridDim.x - shift) % gridDim.x)); s.A = (const char*)A; s.B = (const char*)B; s.ta = (size_t)256 * lda * 2; s.tb = (size_t)256 * ldb * 2; return s;
}
struct SchedZ {
    pg8::StaticOrder o; const char* A; const char* B; int late;
    __device__ __forceinline__ bool next(int i, pg8::Unit& u) const { if (!o.next(i, u)) return false; const int jn = u.pn;
        u.pn = late ? (jn < 2 ? 2 + jn : 22 + jn) : (jn < 20 ? jn + 4 : jn + 6);
        u.A = A + (size_t)u.pm * (256 * DM * 2); u.B = B + (size_t)u.pn * (256 * DM * 2); u.aux = 0; return true; }
};
struct SchedDFT {
    const char* DC; const char* PQF; int G, c;
    __device__ __forceinline__ bool next(int i, pg8::Unit& u) const {
        if (c < 0) return false;
        const int L = __builtin_amdgcn_readfirstlane(i * G + c); if (L >= 64) return false;
        const int b = L >> 5, t = L & 31, odd = t >> 4, tt = t & 15; u.pm = tt >> 1; u.pn = tt & 1; u.aux = b * 2 + odd;
        u.A = DC + (size_t)odd * (WS_DS - WS_DC) + (size_t)u.pm * (256 * 2048 * 2);
        u.B = PQF + ((size_t)(b * 512 + u.pn * 256) * 4096 + odd * 2048) * 2; return true;
    }
};

struct EpiZ {
    static constexpr bool PERM = true;
    bf16* O; int ldc;
    __device__ __forceinline__ void operator()(const pg8::f32x4 (&acc)[2][2][4][2], const pg8::Unit& u, int wr, int wc, int fr, int fq) const {
        const int row0 = u.pm * 256 + wr * 64 + fr, col0 = u.pn * 256 + wc * 32 + 8 * fq;
#pragma unroll
        for (int ai = 0; ai < 2; ++ai)
#pragma unroll
            for (int m = 0; m < 4; ++m) { bf16* rowp = O + (size_t)(row0 + ai * 128 + m * 16) * ldc + col0;
#pragma unroll
                for (int bj = 0; bj < 2; ++bj) { const pg8::f32x4 v0 = acc[ai][bj][m][0], v1 = acc[ai][bj][m][1]; u32x4 w;
                    w.x = pg8::cvt_pk_bf16(v0[0], v0[1]); w.y = pg8::cvt_pk_bf16(v0[2], v0[3]); w.z = pg8::cvt_pk_bf16(v1[0], v1[1]); w.w = pg8::cvt_pk_bf16(v1[2], v1[3]);
                    *(u32x4*)(rowp + bj * 128) = w; } }
    }
};
struct EpiZ2 {
    static constexpr bool PERM = true;
    bf16* O; bf16* PQ;
    __device__ __forceinline__ void operator()(const pg8::f32x4 (&acc)[2][2][4][2], const pg8::Unit& u, int wr, int wc, int fr, int fq) const {
        const int row0 = u.pm * 256 + wr * 64 + fr;
        if (u.pn < 26) { const int col0 = u.pn * 256 + wc * 32 + 8 * fq;
#pragma unroll
            for (int ai = 0; ai < 2; ++ai)
#pragma unroll
                for (int m = 0; m < 4; ++m) { bf16* rowp = O + (size_t)(row0 + ai * 128 + m * 16) * DIN + col0;
#pragma unroll
                    for (int bj = 0; bj < 2; ++bj) { const pg8::f32x4 v0 = acc[ai][bj][m][0], v1 = acc[ai][bj][m][1]; u32x4 w;
                        w.x = pg8::cvt_pk_bf16(v0[0], v0[1]); w.y = pg8::cvt_pk_bf16(v0[2], v0[3]); w.z = pg8::cvt_pk_bf16(v1[0], v1[1]); w.w = pg8::cvt_pk_bf16(v1[2], v1[3]);
                        *(u32x4*)(rowp + bj * 128) = w; } }
        } else { const int np0 = (u.pn - 26) * 256 + wc * 32 + 8 * fq;
#pragma unroll
            for (int bj = 0; bj < 2; ++bj) { const int np = np0 + bj * 128, pq = np >> 9, n = np & 511;
#pragma unroll
                for (int ai = 0; ai < 2; ++ai)
#pragma unroll
                    for (int m = 0; m < 4; ++m) { const int row = row0 + ai * 128 + m * 16, b = row >> 12, sq = row & 4095;
                        bf16* dst = PQ + ((size_t)(b * 512 + n) * 2 + pq) * 4096 + sq;
#pragma unroll
                        for (int nn = 0; nn < 2; ++nn)
#pragma unroll
                            for (int j = 0; j < 4; ++j) dst[(size_t)(4 * nn + j) * 8192] = (bf16)f2bf(acc[ai][bj][m][nn][j]); } }
        }
    }
};
struct EpiGate {
    static constexpr bool PERM = true;
    bf16* O; const bf16* Z; int coff, goff;
    __device__ __forceinline__ void operator()(const pg8::f32x4 (&acc)[2][2][4][2], const pg8::Unit& u, int wr, int wc, int fr, int fq) const {
        const int row0 = u.pm * 256 + wr * 64 + fr, col0 = u.pn * 256 + wc * 32 + 8 * fq;
#pragma unroll
        for (int ai = 0; ai < 2; ++ai)
#pragma unroll
            for (int m = 0; m < 4; ++m) { const size_t row = (size_t)(row0 + ai * 128 + m * 16);
#pragma unroll
                for (int bj = 0; bj < 2; ++bj) { const pg8::f32x4 v0 = acc[ai][bj][m][0], v1 = acc[ai][bj][m][1];
                    const u32x4 gz = *(const u32x4*)(Z + row * DIN + goff + col0 + bj * 128); u32x4 w;
                    w.x = pg8::cvt_pk_bf16(v0[0] * silu_f(bflo(gz.x)), v0[1] * silu_f(bfhi(gz.x))); w.y = pg8::cvt_pk_bf16(v0[2] * silu_f(bflo(gz.y)), v0[3] * silu_f(bfhi(gz.y)));
                    w.z = pg8::cvt_pk_bf16(v1[0] * silu_f(bflo(gz.z)), v1[1] * silu_f(bfhi(gz.z))); w.w = pg8::cvt_pk_bf16(v1[2] * silu_f(bflo(gz.w)), v1[3] * silu_f(bfhi(gz.w)));
                    *(u32x4*)(O + row * DM + coff + col0 + bj * 128) = w; } }
    }
};
struct EpiPart {
    static constexpr bool PERM = false;
    float* P;
    __device__ __forceinline__ void operator()(const pg8::f32x4 (&acc)[2][2][4][2], const pg8::Unit& u, int wr, int wc, int fr, int fq) const {
        const int row0 = u.pm * 256 + wr * 64 + fr, col0 = u.pn * 256 + wc * 32 + 4 * fq;
        float* base = (u.aux & 1) ? P + (size_t)2 * 2304 * 512 + (size_t)(u.aux >> 1) * 2048 * 512 : P + (size_t)(u.aux >> 1) * 2304 * 512;
#pragma unroll
        for (int ai = 0; ai < 2; ++ai)
#pragma unroll
            for (int m = 0; m < 4; ++m) { float* rowp = base + (size_t)(row0 + ai * 128 + m * 16) * 512 + col0;
#pragma unroll
                for (int bj = 0; bj < 2; ++bj)
#pragma unroll
                    for (int n = 0; n < 2; ++n) *(pg8::f32x4*)(rowp + bj * 128 + n * 16) = acc[ai][bj][m][n]; }
    }
};
struct EpiRes {
    static constexpr bool PERM = false;
    const float* xin; float* xout; const float* gate;
    __device__ __forceinline__ void operator()(const pg8::f32x4 (&acc)[2][2][4][2], const pg8::Unit& u, int wr, int wc, int fr, int fq) const {
        const int row0 = u.pm * 256 + wr * 64 + fr, col0 = u.pn * 256 + wc * 32 + 4 * fq;
        const float* gp = gate + (size_t)(u.pm >> 4) * 6144 + col0;
        pg8::f32x4 gv[2][2];
#pragma unroll
        for (int bj = 0; bj < 2; ++bj)
#pragma unroll
            for (int n = 0; n < 2; ++n) gv[bj][n] = *(const pg8::f32x4*)(gp + bj * 128 + n * 16);
#pragma unroll
        for (int ai = 0; ai < 2; ++ai)
#pragma unroll
            for (int m = 0; m < 4; ++m) { const size_t ro = (size_t)(row0 + ai * 128 + m * 16) * DM + col0;
#pragma unroll
                for (int bj = 0; bj < 2; ++bj)
#pragma unroll
                    for (int n = 0; n < 2; ++n) { const pg8::f32x4 xi = *(const pg8::f32x4*)(xin + ro + bj * 128 + n * 16);
                        *(pg8::f32x4*)(xout + ro + bj * 128 + n * 16) = xi + gv[bj][n] * acc[ai][bj][m][n]; } }
    }
};

struct TPItem { const float* src; bf16* dst; int N, K; };
__device__ __forceinline__ TPItem tp_decode(const Params& p, int it, int tid) {
    constexpr int T_IN = 32 * 96, T_OUT = 32 * 32, T_S = 64, T_L = T_IN + T_OUT + T_S;
    const int l = it / T_L; int r = it % T_L; const float* W; bf16* WT; int K, N, kb, nb;
    if (r < T_IN) { W = p.w_in + (size_t)l * DM * DIN; WT = (bf16*)(p.ws + WS_WIN) + (size_t)l * WROWS * DM; K = DM; N = DIN; kb = r / 96; nb = 8 + r % 96; }
    else if (r < T_IN + T_OUT) { r -= T_IN; W = p.w_out + (size_t)l * DM * DM; WT = (bf16*)(p.ws + WS_WOUT) + (size_t)l * DM * DM; K = DM; N = DM; kb = r >> 5; nb = r & 31; }
    else { r -= T_IN + T_OUT; W = p.w_pw + (size_t)l * DG * DG; WT = (bf16*)(p.ws + WS_WPW) + (size_t)l * DG * DG; K = DG; N = DG; kb = r >> 3; nb = r & 7; }
    TPItem t; t.N = N; t.K = K;
    t.src = W + (size_t)(kb * 64 + (tid >> 4)) * N + nb * 64 + (tid & 15) * 4;
    t.dst = WT + (size_t)(nb * 64 + (tid >> 3)) * K + kb * 64 + (tid & 7) * 8;
    return t;
}
__device__ __forceinline__ void tp_store(const TPItem& t, int tid, const f32x4& v0, const f32x4& v1, float* scr) {
    { const int kk = tid >> 4, nn = (tid & 15) * 4;
      scr[kk * 65 + nn] = v0[0]; scr[kk * 65 + nn + 1] = v0[1]; scr[kk * 65 + nn + 2] = v0[2]; scr[kk * 65 + nn + 3] = v0[3];
      scr[(kk + 32) * 65 + nn] = v1[0]; scr[(kk + 32) * 65 + nn + 1] = v1[1]; scr[(kk + 32) * 65 + nn + 2] = v1[2]; scr[(kk + 32) * 65 + nn + 3] = v1[3]; }
    __syncthreads();
    { const int n = tid >> 3, kc = (tid & 7) * 8; const float* s = scr + kc * 65 + n; u32x4 o;
      o.x = pk2(s[0], s[65]); o.y = pk2(s[2 * 65], s[3 * 65]); o.z = pk2(s[4 * 65], s[5 * 65]); o.w = pk2(s[6 * 65], s[7 * 65]);
      *(u32x4*)t.dst = o; }
    __syncthreads();
}

__device__ __forceinline__ void ph_prologue(const Params& p_, unsigned char* lds) {
    const Params p = *kparams(); (void)p_;
    const int tid = otid(), lane = tid & 63, wave = tid >> 6, G = gridDim.x, bid = obid();
    float* scr = (float*)lds;
    { constexpr int T_TOT = NL * (32 * 96 + 32 * 32 + 64);
      int it = bid; TPItem cur; f32x4 a0, a1;
      if (it < T_TOT) { cur = tp_decode(p, it, tid); a0 = __builtin_nontemporal_load((const f32x4*)cur.src); a1 = __builtin_nontemporal_load((const f32x4*)(cur.src + (size_t)32 * cur.N)); }
      while (it < T_TOT) { const int nit = it + G; TPItem nxt = cur; f32x4 b0 = a0, b1 = a1;
          if (nit < T_TOT) { nxt = tp_decode(p, nit, tid); b0 = __builtin_nontemporal_load((const f32x4*)nxt.src); b1 = __builtin_nontemporal_load((const f32x4*)(nxt.src + (size_t)32 * nxt.N)); }
          tp_store(cur, tid, a0, a1, scr);
          cur = nxt; a0 = b0; a1 = b1; it = nit; } }
    { bf16* Wfx = (bf16*)(p.ws + WS_WFXB);
      for (int e = bid * NTHR + tid; e < NL * DM * DG / 8; e += G * NTHR) { const int l = e >> 17, r = e & 131071, k = r >> 6, c8 = (r & 63) * 8;
          const float* src = p.w_in + ((size_t)l * DM + k) * DIN + c8; const f32x4 a = *(const f32x4*)src, b4 = *(const f32x4*)(src + 4);
          u32x4 o; o.x = pk2(a[0], a[1]); o.y = pk2(a[2], a[3]); o.z = pk2(b4[0], b4[1]); o.w = pk2(b4[2], b4[3]);
          *(u32x4*)(Wfx + ((size_t)l * DM + k) * DG + c8) = o; } }
    { float* Wl = (float*)lds; float* tr = Wl + 128 * 65; bf16* Wcs = (bf16*)(p.ws + WS_WCS);
      for (int t2 = G - 1 - bid; t2 < 256; t2 += G) {
          const int t = t2 >> 1, ch = t2 & 1, l = t >> 6, pq = (t >> 5) & 1, g = (t >> 3) & 3, n0 = (t & 7) * 64;
#pragma unroll
          for (int i = 0; i < 4; ++i) { const int m = (tid >> 4) + 32 * i, nn = (tid & 15) * 4;
              const f32x4 v = *(const f32x4*)(p.w_fft + ((size_t)l * DG + g * 128 + m) * DG + n0 + nn);
              Wl[m * 65 + nn] = v[0]; Wl[m * 65 + nn + 1] = v[1]; Wl[m * 65 + nn + 2] = v[2]; Wl[m * 65 + nn + 3] = v[3]; }
          if (tid < 128) tr[tid] = pq ? sinpif((float)tid * (1.f / 64.f)) : cospif((float)tid * (1.f / 64.f));
          __syncthreads();
          const int nn = tid >> 3, cc = ch * 64 + (tid & 7) * 8; float acc[8];
#pragma unroll
          for (int i = 0; i < 8; ++i) acc[i] = 0.f;
#pragma unroll 4
          for (int m = 0; m < 128; ++m) { const float w = Wl[m * 65 + nn];
#pragma unroll
              for (int i = 0; i < 8; ++i) acc[i] += tr[((cc + i) * m) & 127] * w; }
          const float nrm = 0.0013810679320049757f;
          u32x4 o0;
          o0.x = pk2(acc[0] * nrm, acc[1] * nrm); o0.y = pk2(acc[2] * nrm, acc[3] * nrm); o0.z = pk2(acc[4] * nrm, acc[5] * nrm); o0.w = pk2(acc[6] * nrm, acc[7] * nrm);
          *(u32x4*)(Wcs + ((size_t)l * 1024 + pq * 512 + n0 + nn) * DG + g * 128 + cc) = o0;
          __syncthreads();
      } }
    __syncthreads();
    float* cosT = (float*)(lds + 32768); float* sinT = (float*)(lds + 49152); float* ca = (float*)(lds + 65536); float* red = (float*)(lds + 81920);
    for (int j = tid; j < 4096; j += NTHR) { cosT[j] = cospif((float)j * (1.f / 2048.f)); sinT[j] = sinpif((float)j * (1.f / 2048.f)); }
    for (int j = tid; j < 4096; j += NTHR) { const float cv = p.c[j]; ca[j] = cv / (1.f + expf(-cv)); }
    __syncthreads();
    { bf16* DC = (bf16*)(p.ws + WS_DC); bf16* DSm = (bf16*)(p.ws + WS_DS);
      for (int r = bid * 2 + (tid >> 8); r < 4352; r += G * 2) { const int is_sin = (r >= 2304) ? 1 : 0, k = is_sin ? r - 2304 : r, s0 = (tid & 255) * 8; float v[8];
#pragma unroll
          for (int j = 0; j < 8; ++j) { const int idx = (k * (s0 + j)) & 4095; v[j] = is_sin ? sinT[idx] : cosT[idx]; }
          u32x4 o; o.x = pk2(v[0], v[1]); o.y = pk2(v[2], v[3]); o.z = pk2(v[4], v[5]); o.w = pk2(v[6], v[7]);
          *(u32x4*)((is_sin ? DSm : DC) + (size_t)k * 2048 + s0) = o; } }
    { float2* rope = (float2*)(p.ws + WS_ROPE);
      for (int e = bid * NTHR + tid; e < 4096 * 32; e += G * NTHR) { const int s = e >> 5, i = e & 31;
          const float inv = (float)pow(10000.0, -(double)i / 32.0); const float ang = (float)s * inv;
          double sn, cs; sincos((double)ang, &sn, &cs); rope[e] = make_float2((float)cs, (float)sn); } }
    float* mod = (float*)(p.ws + WS_MOD);
    for (int t = bid; t < 192; t += G) {
        const int l = t / 96, col = (t % 96) * 64 + lane; const float* W = p.w_ada + (size_t)l * DM * 6144 + col;
        float a0 = 0.f, a1 = 0.f;
        for (int k0 = wave * 256; k0 < wave * 256 + 256; k0 += 32) { float wv[32];
#pragma unroll
            for (int j = 0; j < 32; ++j) wv[j] = __builtin_nontemporal_load(W + (size_t)(k0 + j) * 6144);
            asm volatile("" ::: "memory");
#pragma unroll
            for (int j = 0; j < 32; ++j) { a0 += ca[k0 + j] * wv[j]; a1 += ca[2048 + k0 + j] * wv[j]; } }
        red[(wave * 2 + 0) * 64 + lane] = a0; red[(wave * 2 + 1) * 64 + lane] = a1;
        __syncthreads();
        if (wave < 2) { float s = 0.f;
#pragma unroll
            for (int w = 0; w < 8; ++w) s += red[(w * 2 + wave) * 64 + lane];
            mod[(size_t)(l * 2 + wave) * 6144 + col] = s + p.b_ada[l * 6144 + col]; }
        __syncthreads();
    }
}

__device__ __forceinline__ void ph_norm(const Params& p_, int l, int skip_blocks) {
    const Params p = *kparams(); (void)p_;
    const int tid = otid(), lane = tid & 63, wave = tid >> 6;
    const float* xin = (l == 0) ? p.x : p.out; bf16* h = (bf16*)(p.ws + WS_U); const float* mod = (const float*)(p.ws + WS_MOD);
    const int stride = gridDim.x * 8; const float* g = p.norm_g + l * DM;
    if (stride == 2048) {
        const int nw = (256 - skip_blocks) * 8;
        for (int pi = (obid() - skip_blocks) * 8 + wave; pi >= 0 && pi < 4096; pi += nw) {
            const int row = (pi >> 11) * 4096 + (pi & 2047);
            const f32x4* xr0 = (const f32x4*)(xin + (size_t)row * DM) + lane; const f32x4* xr1 = (const f32x4*)(xin + (size_t)(row + stride) * DM) + lane;
            const float* md = mod + (size_t)(l * 2 + (row >> 12)) * 6144;
            f32x4 v0[8], v1[8], ca[8], cb[8];
#pragma unroll
            for (int j = 0; j < 8; ++j) { v0[j] = xr0[64 * j]; v1[j] = xr1[64 * j]; }
#pragma unroll
            for (int j = 0; j < 8; ++j) { const int col = (64 * j + lane) * 4; ca[j] = *(const f32x4*)(g + col) * (*(const f32x4*)(md + 2048 + col) + 1.f); cb[j] = *(const f32x4*)(md + col); }
            asm volatile("" ::: "memory");
            float s0 = 0.f, s1 = 0.f;
#pragma unroll
            for (int j = 0; j < 8; ++j) { s0 += (v0[j][0] * v0[j][0] + v0[j][1] * v0[j][1]) + (v0[j][2] * v0[j][2] + v0[j][3] * v0[j][3]); s1 += (v1[j][0] * v1[j][0] + v1[j][1] * v1[j][1]) + (v1[j][2] * v1[j][2] + v1[j][3] * v1[j][3]); }
            s0 = wave_sum(s0); s1 = wave_sum(s1);
            const float r0 = rsqrtf(s0 * (1.f / DM) + 1e-6f), r1 = rsqrtf(s1 * (1.f / DM) + 1e-6f);
#pragma unroll
            for (int j = 0; j < 8; ++j) { const int col = (64 * j + lane) * 4;
                const f32x4 o0 = (v0[j] * r0) * ca[j] + cb[j], o1 = (v1[j] * r1) * ca[j] + cb[j]; u32x2 w;
                w.x = pk2(o0[0], o0[1]); w.y = pk2(o0[2], o0[3]); *(u32x2*)(h + (size_t)row * DM + col) = w;
                w.x = pk2(o1[0], o1[1]); w.y = pk2(o1[2], o1[3]); *(u32x2*)(h + (size_t)(row + stride) * DM + col) = w; }
        }
        return;
    }
    for (int row = obid() * 8 + wave; row < MTOK; row += stride) {
        const f32x4* xr = (const f32x4*)(xin + (size_t)row * DM) + lane; f32x4 v[8]; float ss = 0.f;
#pragma unroll
        for (int j = 0; j < 8; ++j) { v[j] = xr[64 * j]; ss += (v[j][0] * v[j][0] + v[j][1] * v[j][1]) + (v[j][2] * v[j][2] + v[j][3] * v[j][3]); }
        ss = wave_sum(ss); const float rstd = rsqrtf(ss * (1.f / DM) + 1e-6f);
        const float* md = mod + (size_t)(l * 2 + (row >> 12)) * 6144;
#pragma unroll
        for (int j = 0; j < 8; ++j) { const int col = (64 * j + lane) * 4;
            const f32x4 g4 = *(const f32x4*)(g + col), sh = *(const f32x4*)(md + col), sc = *(const f32x4*)(md + 2048 + col);
            const f32x4 o = (v[j] * rstd * g4) * (sc + 1.f) + sh; u32x2 w; w.x = pk2(o[0], o[1]); w.y = pk2(o[2], o[3]);
            *(u32x2*)(h + (size_t)row * DM + col) = w; }
    }
}
__device__ __forceinline__ void ph_final(const Params& p_) {
    const Params p = *kparams(); (void)p_;
    const int tid = otid(), lane = tid & 63, wave = tid >> 6;
    const int stride = gridDim.x * 8;
    for (int row = obid() * 8 + wave; row < MTOK; row += 2 * stride) {
        const bool two = (row + stride < MTOK);
        f32x4* xr0 = (f32x4*)(p.out + (size_t)row * DM) + lane; f32x4* xr1 = (f32x4*)(p.out + (size_t)(two ? row + stride : row) * DM) + lane;
        f32x4 v0[8], v1[8], g4[8];
#pragma unroll
        for (int j = 0; j < 8; ++j) { v0[j] = xr0[64 * j]; v1[j] = xr1[64 * j]; g4[j] = *(const f32x4*)(p.final_g + (64 * j + lane) * 4); }
        asm volatile("" ::: "memory");
        float s0 = 0.f, s1 = 0.f;
#pragma unroll
        for (int j = 0; j < 8; ++j) { s0 += (v0[j][0] * v0[j][0] + v0[j][1] * v0[j][1]) + (v0[j][2] * v0[j][2] + v0[j][3] * v0[j][3]); s1 += (v1[j][0] * v1[j][0] + v1[j][1] * v1[j][1]) + (v1[j][2] * v1[j][2] + v1[j][3] * v1[j][3]); }
        s0 = wave_sum(s0); s1 = wave_sum(s1);
        const float r0 = rsqrtf(s0 * (1.f / DM) + 1e-6f), r1 = rsqrtf(s1 * (1.f / DM) + 1e-6f);
#pragma unroll
        for (int j = 0; j < 8; ++j) { xr0[64 * j] = v0[j] * r0 * g4[j]; if (two) xr1[64 * j] = v1[j] * r1 * g4[j]; }
    }
}

#ifndef REP_PRO
#define REP_PRO 1
#endif
#ifndef REP_NORM
#define REP_NORM 1
#endif
#ifndef REP_Z
#define REP_Z 1
#endif
#ifndef REP_MIX
#define REP_MIX 1
#endif
#ifndef REP_P3
#define REP_P3 1
#endif
#ifndef REP_R2
#define REP_R2 1
#endif
#ifndef REP_CMB
#define REP_CMB 1
#endif
#ifndef REP_FFT
#define REP_FFT 1
#endif
#ifndef REP_OUT
#define REP_OUT 1
#endif
#ifndef REP_SUB
#define REP_SUB 1
#endif

#ifndef REP_R1
#define REP_R1 1
#endif
#ifndef REP_NA
#define REP_NA 1
#endif
#ifndef REP_CV
#define REP_CV 1
#endif
#ifndef REP_F1
#define REP_F1 1
#endif
#define REPEAT(n) for (int rep_ = 0; rep_ < (n); ++rep_)
typedef short bf16x8v __attribute__((ext_vector_type(8)));
__device__ __forceinline__ bf16x8v mk8(unsigned a, unsigned b, unsigned c, unsigned d) { u32x4 v = {a, b, c, d}; return __builtin_bit_cast(bf16x8v, v); }
#define MFMA16(a, b, c) __builtin_amdgcn_mfma_f32_16x16x32_bf16(a, b, c, 0, 0, 0)
constexpr int R_QS = 0, R_KS = 18432, R_VT = 36864, R_KTF = 54272, R_KTB = 71680, R_STF = 89088, R_STB = 98304;

template <bool R2>
__device__ __forceinline__ void ret_stage(const Params& p_, int b, int h, int n, unsigned char* lds, float l2f, float l2b) {
    const Params p = *kparams(); (void)p_;
    const int tid = otid(), j = tid >> 2, c4 = tid & 3, s = n * 128 + j;
    const bf16* Z = (const bf16*)(p.ws + WS_Z); const bf16* zr = Z + (size_t)(b * SEQ + s) * DIN;
    const f32x4* rp = (const f32x4*)((const float2*)(p.ws + WS_ROPE) + s * 32 + c4 * 8);
    f32x4 rr[4];
#pragma unroll
    for (int i = 0; i < 4; ++i) rr[i] = rp[i];
    const u32x4 ka = *(const u32x4*)(zr + 7 * DG + h * 64 + c4 * 8), kb = *(const u32x4*)(zr + 7 * DG + h * 64 + 32 + c4 * 8);
    const u32x4 va = *(const u32x4*)(zr + 8 * DG + h * 64 + c4 * 16), vb = *(const u32x4*)(zr + 8 * DG + h * 64 + c4 * 16 + 8);
    u32x4 qa = ka, qb = kb;
    if (R2) { qa = *(const u32x4*)(zr + 6 * DG + h * 64 + c4 * 8); qb = *(const u32x4*)(zr + 6 * DG + h * 64 + 32 + c4 * 8); }
    asm volatile("" ::: "memory");
    float cs[8], sn[8];
#pragma unroll
    for (int i = 0; i < 4; ++i) { const f32x4 r = rr[i]; cs[2 * i] = r[0]; sn[2 * i] = r[1]; cs[2 * i + 1] = r[2]; sn[2 * i + 1] = r[3]; }
    bf16* KS = (bf16*)(lds + R_KS); bf16* VT = (bf16*)(lds + R_VT);
    {
      const unsigned kau[4] = {ka.x, ka.y, ka.z, ka.w}, kbu[4] = {kb.x, kb.y, kb.z, kb.w};
      float k1[8], k2[8];
#pragma unroll
      for (int i = 0; i < 4; ++i) { const float a0 = bflo(kau[i]), a1 = bfhi(kau[i]), b0 = bflo(kbu[i]), b1 = bfhi(kbu[i]);
          k1[2 * i] = a0 * cs[2 * i] - b0 * sn[2 * i]; k2[2 * i] = a0 * sn[2 * i] + b0 * cs[2 * i];
          k1[2 * i + 1] = a1 * cs[2 * i + 1] - b1 * sn[2 * i + 1]; k2[2 * i + 1] = a1 * sn[2 * i + 1] + b1 * cs[2 * i + 1]; }
      u32x4 o1, o2; o1.x = pk2(k1[0], k1[1]); o1.y = pk2(k1[2], k1[3]); o1.z = pk2(k1[4], k1[5]); o1.w = pk2(k1[6], k1[7]);
      o2.x = pk2(k2[0], k2[1]); o2.y = pk2(k2[2], k2[3]); o2.z = pk2(k2[4], k2[5]); o2.w = pk2(k2[6], k2[7]);
      *(u32x4*)(KS + j * 72 + c4 * 8) = o1; *(u32x4*)(KS + j * 72 + 32 + c4 * 8) = o2;
      if (!R2) { bf16* KTF = (bf16*)(lds + R_KTF); bf16* KTB = (bf16*)(lds + R_KTB);
          const float df = exp2f(l2f * (float)(127 - j)), db = exp2f(l2b * (float)j);
#pragma unroll
          for (int i = 0; i < 8; ++i) { KTF[(c4 * 8 + i) * 136 + j] = (bf16)f2bf(k1[i] * df); KTF[(32 + c4 * 8 + i) * 136 + j] = (bf16)f2bf(k2[i] * df);
              KTB[(c4 * 8 + i) * 136 + j] = (bf16)f2bf(k1[i] * db); KTB[(32 + c4 * 8 + i) * 136 + j] = (bf16)f2bf(k2[i] * db); } } }
    {
      const unsigned vu[8] = {va.x, va.y, va.z, va.w, vb.x, vb.y, vb.z, vb.w};
#pragma unroll
      for (int i = 0; i < 8; ++i) { VT[(c4 * 16 + 2 * i) * 136 + j] = (bf16)(vu[i] & 0xffffu); VT[(c4 * 16 + 2 * i + 1) * 136 + j] = (bf16)(vu[i] >> 16); } }
    if (R2) { bf16* QS = (bf16*)(lds + R_QS);
      const unsigned qau[4] = {qa.x, qa.y, qa.z, qa.w}, qbu[4] = {qb.x, qb.y, qb.z, qb.w};
      float q1[8], q2[8];
#pragma unroll
      for (int i = 0; i < 4; ++i) { const float a0 = bflo(qau[i]), a1 = bfhi(qau[i]), b0 = bflo(qbu[i]), b1 = bfhi(qbu[i]);
          q1[2 * i] = (a0 * cs[2 * i] - b0 * sn[2 * i]) * 0.125f; q2[2 * i] = (a0 * sn[2 * i] + b0 * cs[2 * i]) * 0.125f;
          q1[2 * i + 1] = (a1 * cs[2 * i + 1] - b1 * sn[2 * i + 1]) * 0.125f; q2[2 * i + 1] = (a1 * sn[2 * i + 1] + b1 * cs[2 * i + 1]) * 0.125f; }
      u32x4 o1, o2; o1.x = pk2(q1[0], q1[1]); o1.y = pk2(q1[2], q1[3]); o1.z = pk2(q1[4], q1[5]); o1.w = pk2(q1[6], q1[7]);
      o2.x = pk2(q2[0], q2[1]); o2.y = pk2(q2[2], q2[3]); o2.z = pk2(q2[4], q2[5]); o2.w = pk2(q2[6], q2[7]);
      *(u32x4*)(QS + j * 72 + c4 * 8) = o1; *(u32x4*)(QS + j * 72 + 32 + c4 * 8) = o2; }
}

__device__ __forceinline__ void ret1_task(const Params& p_, int l, int task, unsigned char* lds) {
    const Params p = *kparams(); (void)p_;
    const int n = task & 31, h = (task >> 5) & 7, b = task >> 8;
    const float xf = p.rl_f[l * 8 + h], xb = p.rl_b[l * 8 + h];
    const float l2f = -log1pf(expf(-xf)) * 1.4426950408889634f, l2b = -log1pf(expf(-xb)) * 1.4426950408889634f;
    ret_stage<false>(p, b, h, n, lds, l2f, l2b);
    __syncthreads();
    const int tid = otid(), lane = tid & 63, w = tid >> 6, fr = lane & 15, fq = lane >> 4, dir = w >> 2, et = w & 3;
    const bf16* VT = (const bf16*)(lds + R_VT); const bf16* KT = (const bf16*)(lds + (dir ? R_KTB : R_KTF));
    bf16x8v a[4];
#pragma unroll
    for (int ks = 0; ks < 4; ++ks) a[ks] = *(const bf16x8v*)(VT + (16 * et + fr) * 136 + 32 * ks + 8 * fq);
    float* dst = (float*)(p.ws + WS_KV) + ((size_t)((dir * 2 + b) * 8 + h) * 32 + n) * 4096;
#pragma unroll
    for (int dt = 0; dt < 4; ++dt) { f32x4 acc = {0.f, 0.f, 0.f, 0.f};
#pragma unroll
        for (int ks = 0; ks < 4; ++ks) { const bf16x8v bfr = *(const bf16x8v*)(KT + (16 * dt + fr) * 136 + 32 * ks + 8 * fq); acc = MFMA16(a[ks], bfr, acc); }
#pragma unroll
        for (int r = 0; r < 4; ++r) dst[(16 * et + 4 * fq + r) * 64 + 16 * dt + fr] = acc[r]; }
    __syncthreads();
}

__device__ __forceinline__ void ret2_task(const Params& p_, int l, int task, unsigned char* lds) {
    const Params p = *kparams(); (void)p_;
    const int n = task & 31, h = (task >> 5) & 7, b = task >> 8;
    const float xf = p.rl_f[l * 8 + h], xb = p.rl_b[l * 8 + h];
    const float l2f = -log1pf(expf(-xf)) * 1.4426950408889634f, l2b = -log1pf(expf(-xb)) * 1.4426950408889634f;
    ret_stage<true>(p, b, h, n, lds, l2f, l2b);
    const int tid = otid(), lane = tid & 63, w = tid >> 6, fr = lane & 15, fq = lane >> 4;
    {
      const float gfC = exp2f(l2f * 128.f), gbC = exp2f(l2b * 128.f);
      const float* KVf = (const float*)(p.ws + WS_KV) + ((size_t)((0 * 2 + b) * 8 + h) * 32) * 4096 + tid * 8;
      const float* KVb = (const float*)(p.ws + WS_KV) + ((size_t)((1 * 2 + b) * 8 + h) * 32) * 4096 + tid * 8;
      f32x4 f0 = {0.f, 0.f, 0.f, 0.f}, f1 = f0, g0 = f0, g1 = f0;
      { float c0 = 1.f; int m = n - 1;
        for (; m >= 7; m -= 8) { f32x4 xa[8], xb[8];
#pragma unroll
            for (int j = 0; j < 8; ++j) { xa[j] = *(const f32x4*)(KVf + (size_t)(m - j) * 4096); xb[j] = *(const f32x4*)(KVf + (size_t)(m - j) * 4096 + 4); }
            asm volatile("" ::: "memory");
#pragma unroll
            for (int j = 0; j < 8; ++j) { f0 += xa[j] * c0; f1 += xb[j] * c0; c0 *= gfC; } }
        for (; m >= 0; --m) { const f32x4 x0 = *(const f32x4*)(KVf + (size_t)m * 4096), x1 = *(const f32x4*)(KVf + (size_t)m * 4096 + 4); f0 += x0 * c0; f1 += x1 * c0; c0 *= gfC; } }
      { float c0 = 1.f; int m = n + 1;
        for (; m + 7 < 32; m += 8) { f32x4 xa[8], xb[8];
#pragma unroll
            for (int j = 0; j < 8; ++j) { xa[j] = *(const f32x4*)(KVb + (size_t)(m + j) * 4096); xb[j] = *(const f32x4*)(KVb + (size_t)(m + j) * 4096 + 4); }
            asm volatile("" ::: "memory");
#pragma unroll
            for (int j = 0; j < 8; ++j) { g0 += xa[j] * c0; g1 += xb[j] * c0; c0 *= gbC; } }
        for (; m < 32; ++m) { const f32x4 x0 = *(const f32x4*)(KVb + (size_t)m * 4096), x1 = *(const f32x4*)(KVb + (size_t)m * 4096 + 4); g0 += x0 * c0; g1 += x1 * c0; c0 *= gbC; } }
      const int e = tid >> 3, d0 = (tid & 7) * 8; u32x4 o;
      o.x = pk2(f0[0], f0[1]); o.y = pk2(f0[2], f0[3]); o.z = pk2(f1[0], f1[1]); o.w = pk2(f1[2], f1[3]); *(u32x4*)((bf16*)(lds + R_STF) + e * 72 + d0) = o;
      o.x = pk2(g0[0], g0[1]); o.y = pk2(g0[2], g0[3]); o.z = pk2(g1[0], g1[1]); o.w = pk2(g1[2], g1[3]); *(u32x4*)((bf16*)(lds + R_STB) + e * 72 + d0) = o; }
    __syncthreads();
    const bf16* QS = (const bf16*)(lds + R_QS); const bf16* KS = (const bf16*)(lds + R_KS); const bf16* VT = (const bf16*)(lds + R_VT);
    const bf16* STF = (const bf16*)(lds + R_STF); const bf16* STB = (const bf16*)(lds + R_STB);
    bf16x8v qf[2];
#pragma unroll
    for (int ks = 0; ks < 2; ++ks) qf[ks] = *(const bf16x8v*)(QS + (16 * w + fr) * 72 + 32 * ks + 8 * fq);
    const int ai = 16 * w + fr;
    unsigned pp[8][2];
#pragma unroll
    for (int jt = 0; jt < 8; ++jt) { f32x4 acc = {0.f, 0.f, 0.f, 0.f};
#pragma unroll
        for (int ks = 0; ks < 2; ++ks) { const bf16x8v kf = *(const bf16x8v*)(KS + (16 * jt + fr) * 72 + 32 * ks + 8 * fq); acc = MFMA16(kf, qf[ks], acc); }
        float sc[4];
#pragma unroll
        for (int r = 0; r < 4; ++r) { const int aj = 16 * jt + 4 * fq + r; const float wg = (aj <= ai) ? exp2f(l2f * (float)(ai - aj)) : exp2f(l2b * (float)(aj - ai)); sc[r] = acc[r] * wg; }
        pp[jt][0] = pk2(sc[0], sc[1]); pp[jt][1] = pk2(sc[2], sc[3]); }
    const float qdf = exp2f(l2f * (float)(ai + 1)), qdb = exp2f(l2b * (float)(128 - ai));
    f32x4 tot[4]; float ss = 0.f;
#pragma unroll
    for (int et = 0; et < 4; ++et) { f32x4 o = {0.f, 0.f, 0.f, 0.f}, cfa = o, cba = o;
#pragma unroll
        for (int t = 0; t < 4; ++t) { const u32x2 vlo = *(const u32x2*)(VT + (16 * et + fr) * 136 + 32 * t + 4 * fq), vhi = *(const u32x2*)(VT + (16 * et + fr) * 136 + 32 * t + 16 + 4 * fq);
            o = MFMA16(mk8(vlo.x, vlo.y, vhi.x, vhi.y), mk8(pp[2 * t][0], pp[2 * t][1], pp[2 * t + 1][0], pp[2 * t + 1][1]), o); }
#pragma unroll
        for (int ks = 0; ks < 2; ++ks) { const bf16x8v sf = *(const bf16x8v*)(STF + (16 * et + fr) * 72 + 32 * ks + 8 * fq), sb = *(const bf16x8v*)(STB + (16 * et + fr) * 72 + 32 * ks + 8 * fq);
            cfa = MFMA16(sf, qf[ks], cfa); cba = MFMA16(sb, qf[ks], cba); }
        tot[et] = o + cfa * qdf + cba * qdb;
        ss += (tot[et][0] * tot[et][0] + tot[et][1] * tot[et][1]) + (tot[et][2] * tot[et][2] + tot[et][3] * tot[et][3]); }
    ss += __shfl_xor(ss, 16); ss += __shfl_xor(ss, 32);
    const float rs = rsqrtf(ss * (1.f / 64.f) + 1e-6f);
    const size_t tok = (size_t)b * SEQ + n * 128 + ai;
    const bf16* Z = (const bf16*)(p.ws + WS_Z); bf16* CAT = (bf16*)(p.ws + WS_CAT);
#pragma unroll
    for (int et = 0; et < 4; ++et) { const u32x2 gz = *(const u32x2*)(Z + tok * DIN + 9 * DG + h * 64 + 16 * et + 4 * fq); u32x2 o;
        o.x = pk2(tot[et][0] * rs * silu_f(bflo(gz.x)), tot[et][1] * rs * silu_f(bfhi(gz.x))); o.y = pk2(tot[et][2] * rs * silu_f(bflo(gz.y)), tot[et][3] * rs * silu_f(bfhi(gz.y)));
        *(u32x2*)(CAT + tok * DM + 1024 + h * 64 + 16 * et + 4 * fq) = o; }
    __syncthreads();
}

__device__ __forceinline__ void na2_task(const Params& p_, int l, int task, unsigned char* lds) {
    const Params p = *kparams(); (void)p_;
    const int tid = otid(), lane = tid & 63, w = tid >> 6, fr = lane & 15, fq = lane >> 4;
    const int hp = task & 3, rq = (task >> 2) & 63, b = task >> 8;
    const int row_start = min(max(rq - 4, 0), 56);
    const bf16* Z = (const bf16*)(p.ws + WS_Z); bf16* CAT = (bf16*)(p.ws + WS_CAT);
    bf16* VT = (bf16*)lds; float* BI = (float*)(lds + 133120);
    const int hh = w >> 2, h = hp * 2 + hh, qb = w & 3, kst = min(max(16 * qb - 8, 0), 32);
    const int c = 16 * qb + fr; const size_t qtok = (size_t)b * SEQ + rq * 64 + c;
    bf16x8v qf[2], kfr[8][2];
#pragma unroll
    for (int ks = 0; ks < 2; ++ks) qf[ks] = *(const bf16x8v*)(Z + qtok * DIN + 2 * DG + h * 64 + 32 * ks + 8 * fq);
#pragma unroll
    for (int i = 0; i < 8; ++i) { const int a = i / 2, ci = i % 2;
        const size_t ktok = (size_t)b * SEQ + (row_start + a) * 64 + kst + 16 * ci + fr;
#pragma unroll
        for (int ks = 0; ks < 2; ++ks) kfr[i][ks] = *(const bf16x8v*)(Z + ktok * DIN + 3 * DG + h * 64 + 32 * ks + 8 * fq); }
    asm volatile("" ::: "memory");
    for (int i = tid; i < 930; i += NTHR) BI[i] = p.na_bias[(size_t)(l * 8 + hp * 2) * 465 + i];
    { const int pair = lane & 31, chunk = (lane >> 5) + 2 * (w & 3);
      unsigned* VTd = (unsigned*)(VT + (size_t)hh * 64 * 520);
      u32x4 xs[8], ys[8];
#pragma unroll
      for (int a = 0; a < 8; ++a) { const size_t tok = (size_t)b * SEQ + (row_start + a) * 64 + 2 * pair;
          const bf16* src = Z + tok * DIN + 4 * DG + h * 64 + chunk * 8; xs[a] = *(const u32x4*)src; ys[a] = *(const u32x4*)(src + DIN); }
      asm volatile("" ::: "memory");
#pragma unroll
      for (int a = 0; a < 8; ++a) { const unsigned xu[4] = {xs[a].x, xs[a].y, xs[a].z, xs[a].w}, yu[4] = {ys[a].x, ys[a].y, ys[a].z, ys[a].w};
#pragma unroll
          for (int i = 0; i < 4; ++i) { VTd[(chunk * 8 + 2 * i) * 260 + a * 32 + pair] = (xu[i] & 0xffffu) | (yu[i] << 16);
              VTd[(chunk * 8 + 2 * i + 1) * 260 + a * 32 + pair] = (xu[i] >> 16) | (yu[i] & 0xffff0000u); } } }
    __syncthreads();
    const int col_start = min(max(c - 8, 0), 48);
    const float* bi = BI + hh * 465;
    float sc[16][4]; float mx = -1e30f;
#pragma unroll
    for (int hf = 0; hf < 2; ++hf) {
        if (hf == 1) {
#pragma unroll
            for (int i = 0; i < 8; ++i) { const int a = 4 + i / 2, ci = i % 2;
                const size_t ktok = (size_t)b * SEQ + (row_start + a) * 64 + kst + 16 * ci + fr;
#pragma unroll
                for (int ks = 0; ks < 2; ++ks) kfr[i][ks] = *(const bf16x8v*)(Z + ktok * DIN + 3 * DG + h * 64 + 32 * ks + 8 * fq); }
            asm volatile("" ::: "memory");
        }
#pragma unroll
        for (int i = 0; i < 8; ++i) { const int a = 4 * hf + i / 2, ci = i % 2, kt = a * 2 + ci;
            f32x4 acc = {0.f, 0.f, 0.f, 0.f};
#pragma unroll
            for (int ks = 0; ks < 2; ++ks) acc = MFMA16(kfr[i][ks], qf[ks], acc);
            const int dr = row_start + a - rq;
#pragma unroll
            for (int r = 0; r < 4; ++r) { const int kc = kst + 16 * ci + 4 * fq + r, rel = kc - col_start, dc = kc - c;
                float v = acc[r] * 0.125f + bi[(dr + 7) * 31 + min(max(dc + 15, 0), 30)];
                v = (rel >= 0 && rel < 16) ? v : -1e30f; sc[kt][r] = v; mx = fmaxf(mx, v); } }
    }
    mx = fmaxf(mx, __shfl_xor(mx, 16)); mx = fmaxf(mx, __shfl_xor(mx, 32));
    float sum = 0.f; unsigned pp[16][2];
#pragma unroll
    for (int kt = 0; kt < 16; ++kt) { const float e0 = __expf(sc[kt][0] - mx), e1 = __expf(sc[kt][1] - mx), e2 = __expf(sc[kt][2] - mx), e3 = __expf(sc[kt][3] - mx);
        sum += (e0 + e1) + (e2 + e3); pp[kt][0] = pk2(e0, e1); pp[kt][1] = pk2(e2, e3); }
    sum += __shfl_xor(sum, 16); sum += __shfl_xor(sum, 32);
    const float inv = 1.f / sum;
    const bf16* VTh = VT + (size_t)hh * 64 * 520;
#pragma unroll
    for (int dt = 0; dt < 4; ++dt) { f32x4 o = {0.f, 0.f, 0.f, 0.f};
#pragma unroll
        for (int t = 0; t < 8; ++t) { const int k0 = 2 * t, k1 = 2 * t + 1, a0 = k0 / 2, c0 = k0 % 2, a1 = k1 / 2, c1 = k1 % 2;
            const u32x2 vlo = *(const u32x2*)(VTh + (16 * dt + fr) * 520 + a0 * 64 + kst + 16 * c0 + 4 * fq), vhi = *(const u32x2*)(VTh + (16 * dt + fr) * 520 + a1 * 64 + kst + 16 * c1 + 4 * fq);
            o = MFMA16(mk8(vlo.x, vlo.y, vhi.x, vhi.y), mk8(pp[k0][0], pp[k0][1], pp[k1][0], pp[k1][1]), o); }
        const u32x2 gz = *(const u32x2*)(Z + qtok * DIN + 5 * DG + h * 64 + 16 * dt + 4 * fq); u32x2 ov;
        ov.x = pk2(o[0] * inv * silu_f(bflo(gz.x)), o[1] * inv * silu_f(bfhi(gz.x))); ov.y = pk2(o[2] * inv * silu_f(bflo(gz.y)), o[3] * inv * silu_f(bfhi(gz.y)));
        *(u32x2*)(CAT + qtok * DM + 512 + h * 64 + 16 * dt + 4 * fq) = ov; }
    __syncthreads();
}

__device__ __forceinline__ void conv_task(const Params& p_, int l, int task, unsigned char* lds) {
    const Params p = *kparams(); (void)p_;
    const int tid = otid(), lane = tid & 63, wave = tid >> 6;
    float* us = (float*)lds; float* ys = us + 46 * 512;
    const bf16* Z = (const bf16*)(p.ws + WS_Z);
    const int b = task >> 8, t0 = (task & 255) * 16;
    { u32x4 av[6], gv[6];
#pragma unroll
      for (int it = 0; it < 6; ++it) { const int idx = tid + it * NTHR, tt = idx >> 6, cc = (idx & 63) * 8, tok = t0 - 15 + tt;
          av[it] = (u32x4){0u, 0u, 0u, 0u}; gv[it] = av[it];
          if (idx < 46 * 64 && tok >= 0 && tok < SEQ) { const bf16* zr = Z + (size_t)(b * SEQ + tok) * DIN; av[it] = *(const u32x4*)(zr + 10 * DG + cc); gv[it] = *(const u32x4*)(zr + 11 * DG + cc); } }
      asm volatile("" ::: "memory");
#pragma unroll
      for (int it = 0; it < 6; ++it) { const int idx = tid + it * NTHR, tt = idx >> 6, cc = (idx & 63) * 8;
          if (idx < 46 * 64) { const u32x4 a = av[it], g = gv[it]; f32x4 u0, u1;
              u0[0] = bflo(a.x) / (1.f + __expf(-bflo(g.x))); u0[1] = bfhi(a.x) / (1.f + __expf(-bfhi(g.x))); u0[2] = bflo(a.y) / (1.f + __expf(-bflo(g.y))); u0[3] = bfhi(a.y) / (1.f + __expf(-bfhi(g.y)));
              u1[0] = bflo(a.z) / (1.f + __expf(-bflo(g.z))); u1[1] = bfhi(a.z) / (1.f + __expf(-bfhi(g.z))); u1[2] = bflo(a.w) / (1.f + __expf(-bflo(g.w))); u1[3] = bfhi(a.w) / (1.f + __expf(-bfhi(g.w)));
              *(f32x4*)(us + tt * 512 + cc) = u0; *(f32x4*)(us + tt * 512 + cc + 4) = u1; } } }
    float w[31];
#pragma unroll
    for (int k = 0; k < 31; ++k) w[k] = p.conv_w[(size_t)(l * 31 + k) * DG + tid];
    const float cb = p.conv_b[l * DG + tid];
    __syncthreads();
    { float y[16];
#pragma unroll
      for (int t = 0; t < 16; ++t) y[t] = cb;
#pragma unroll
      for (int j = 0; j < 46; ++j) { const float u = us[j * 512 + tid];
#pragma unroll
          for (int t = 0; t < 16; ++t) { const int k = j - t; if (k >= 0 && k < 31) y[t] += w[k] * u; } }
#pragma unroll
      for (int t = 0; t < 16; ++t) ys[t * 512 + tid] = y[t]; }
    __syncthreads();
#pragma unroll
    for (int tw = 0; tw < 2; ++tw) { const int t = wave + 8 * tw; float v[8]; float s = 0.f;
#pragma unroll
        for (int j = 0; j < 8; ++j) { v[j] = ys[t * 512 + lane + 64 * j]; s += v[j]; }
        const float mu = wave_sum(s) * (1.f / 512.f); float q = 0.f;
#pragma unroll
        for (int j = 0; j < 8; ++j) { v[j] -= mu; q += v[j] * v[j]; }
        const float rstd = rsqrtf(wave_sum(q) * (1.f / 512.f) + 1e-6f);
        bf16* orow = (bf16*)(p.ws + WS_CVH) + (size_t)(b * SEQ + t0 + t) * DG;
#pragma unroll
        for (int j = 0; j < 8; ++j) { const int ch = lane + 64 * j; const float y = v[j] * rstd * p.ln_g[l * DG + ch] + p.ln_b[l * DG + ch]; orow[ch] = (bf16)f2bf(silu_f(y)); } }
    __syncthreads();
}

__device__ __forceinline__ void ph_mixA(const Params& p, int l, unsigned char* lds) {
    const int G = gridDim.x, bid = obid();
    for (int t = bid; t < 512 * REP_R1; t += G) ret1_task(p, l, t & 511, lds);
    const int xcd = bid & 7, slot = bid >> 3, nloc = (slot < 16) ? 1 : 3, r0 = (slot < 16) ? slot : 16 + (slot - 16) * 3;
    if (G == 256 && REP_NA == 1) {
        for (int i = 0; i < nloc; ++i) { const int rq = (slot < 16) ? slot : 16 + i * 16 + (slot - 16);
            na2_task(p, l, (xcd >> 2) * 256 + rq * 4 + (xcd & 3), lds); }
    } else for (int t = bid; t < 512 * REP_NA; t += G) na2_task(p, l, t & 511, lds);
    if (G == 256 && REP_CV == 1) {
        for (int i = 0; i < 2; ++i) conv_task(p, l, xcd * 64 + i * 32 + slot, lds);
    } else for (int t = bid; t < 512 * REP_CV; t += G) conv_task(p, l, t & 511, lds);
}

__device__ __forceinline__ void ph_fold(const Params& p_) {
    const Params p = *kparams(); (void)p_;
    const bf16* PQ = (const bf16*)(p.ws + WS_PQT); bf16* PQF = (bf16*)(p.ws + WS_PQF);
    for (int e = obid() * NTHR + otid(); e < NB * DG * 2 * 256; e += gridDim.x * NTHR) {
        const int row = e >> 8, s0 = (e & 255) * 8, pq = row & 1;
        const bf16* src = PQ + (size_t)row * 4096;
        const u32x4 own = *(const u32x4*)(src + s0), low = *(const u32x4*)(src + 4096 - s0 - 8);
        const float top = (s0 == 0) ? 0.f : bf2f(src[4096 - s0]);
        const float sg = pq ? -1.f : 1.f;
        float o[8];
        o[0] = bflo(own.x) + sg * top;            o[1] = bfhi(own.x) + sg * bfhi(low.w);
        o[2] = bflo(own.y) + sg * bflo(low.w);    o[3] = bfhi(own.y) + sg * bfhi(low.z);
        o[4] = bflo(own.z) + sg * bflo(low.z);    o[5] = bfhi(own.z) + sg * bfhi(low.y);
        o[6] = bflo(own.w) + sg * bflo(low.y);    o[7] = bfhi(own.w) + sg * bfhi(low.x);
        if (s0 == 0 && pq) o[0] = 0.f;
        u32x4 w; w.x = pk2(o[0], o[1]); w.y = pk2(o[2], o[3]); w.z = pk2(o[4], o[5]); w.w = pk2(o[6], o[7]);
        *(u32x4*)(PQF + (size_t)row * 2048 + s0) = w;
    }
}
__device__ __forceinline__ void ph_alt(const Params& p_) {
    const Params p = *kparams(); (void)p_;
    const int tid = otid(), lane = tid & 63, wave = tid >> 6; const bf16* PQF = (const bf16*)(p.ws + WS_PQF);
    float* dst = (float*)(p.ws + WS_PART) + (size_t)(2 * 2304 + 2 * 2048) * 512;
    for (int r = obid() * 8 + wave; r < NB * DG; r += gridDim.x * 8) {
        const u32x4* src = (const u32x4*)(PQF + (size_t)r * 4096) + lane; float acc = 0.f;
#pragma unroll
        for (int j = 0; j < 4; ++j) { const u32x4 v = src[64 * j];
            acc += (bflo(v.x) - bfhi(v.x)) + (bflo(v.y) - bfhi(v.y)) + (bflo(v.z) - bfhi(v.z)) + (bflo(v.w) - bfhi(v.w)); }
        acc = wave_sum(acc);
        if (lane == 0) dst[r] = acc;
    }
}
__device__ __forceinline__ void ph_combine(const Params& p_) {
    const Params p = *kparams(); (void)p_;
    const float* Ce = (const float*)(p.ws + WS_PART); const float* So = Ce + (size_t)2 * 2304 * 512;
    bf16* CAT = (bf16*)(p.ws + WS_CAT); const bf16* Z = (const bf16*)(p.ws + WS_Z); const bf16* PQ = (const bf16*)(p.ws + WS_PQT);
    const int nth = gridDim.x * NTHR;
    for (int e0 = obid() * NTHR + otid(); e0 < MTOK * DG / 4; e0 += 2 * nth) {
        f32x4 ce[2], so[2]; u32x2 gz[2]; float pv[2][4]; int rowv[2], c4v[2], kv[2]; bool use_so[2], act[2];
#pragma unroll
        for (int u = 0; u < 2; ++u) { const int e = e0 + u * nth; act[u] = e < MTOK * DG / 4; const int ee = act[u] ? e : e0;
            const int row = ee >> 7, c4 = (ee & 127) * 4, b = row >> 12, k = row & 4095, kk = (k <= 2048) ? k : 4096 - k;
            rowv[u] = row; c4v[u] = c4; kv[u] = k; use_so[u] = (kk != 0 && kk != 2048);
            ce[u] = (kk == 2048) ? *(const f32x4*)(Ce + (size_t)(2 * 2304 + 2 * 2048) * 512 + b * 512 + c4) : *(const f32x4*)(Ce + ((size_t)b * 2304 + kk) * 512 + c4);
            so[u] = *(const f32x4*)(So + ((size_t)b * 2048 + (use_so[u] ? kk : 1)) * 512 + c4);
            gz[u] = *(const u32x2*)(Z + (size_t)row * DIN + DG + c4);
#pragma unroll
            for (int j = 0; j < 4; ++j) pv[u][j] = bf2f(PQ[((size_t)(b * 512 + c4 + j) * 2) * 4096 + 2048]); }
        asm volatile("" ::: "memory");
#pragma unroll
        for (int u = 0; u < 2; ++u) if (act[u]) { f32x4 s = ce[u];
            if (use_so[u]) s = (kv[u] <= 2048) ? s - so[u] : s + so[u];
            const float alt = (kv[u] & 1) ? -1.f : 1.f;
#pragma unroll
            for (int j = 0; j < 4; ++j) s[j] += alt * pv[u][j];
            u32x2 w; w.x = pk2(s[0] * silu_f(bflo(gz[u].x)), s[1] * silu_f(bfhi(gz[u].x))); w.y = pk2(s[2] * silu_f(bflo(gz[u].y)), s[3] * silu_f(bfhi(gz[u].y)));
            *(u32x2*)(CAT + (size_t)rowv[u] * DM + c4v[u]) = w; }
    }
}

#define XB_TMO      128
#define XB_XCNT(j)  (256  + 64 * (j))
#define XB_XSUB(j)  (1280 + 64 * (j))
#define XB_XGEN(j)  (2304 + 64 * (j))
#define XB_TOP      3328
#define XB_TOPGEN   3392
#define XCD_BAR_WORDS 3456
#define XB_SPIN_CAP (1u << 20)
__device__ __forceinline__ unsigned xb_ld(unsigned* p)              { return __hip_atomic_load(p, __ATOMIC_RELAXED, __HIP_MEMORY_SCOPE_AGENT); }
__device__ __forceinline__ unsigned xb_add(unsigned* p, unsigned v) { return __hip_atomic_fetch_add(p, v, __ATOMIC_RELAXED, __HIP_MEMORY_SCOPE_AGENT); }
__device__ __forceinline__ unsigned xb_xcc_id() { return (unsigned)__builtin_amdgcn_s_getreg((3 << 11) | 20) & 0xFu; }
#define XB_SPIN(cond, bar) do { unsigned _sp = 0; while (cond) { __builtin_amdgcn_s_sleep(1); \
    if ((++_sp & 255u) == 0u) { if (xb_ld(&(bar)[XB_TMO])) break; if (_sp > XB_SPIN_CAP) { atomicAdd(&(bar)[XB_TMO], 1u); break; } } } } while (0)
struct XcdBarrier { unsigned* bar; unsigned x; volatile PG8_LAS unsigned* st; };
__device__ __forceinline__ XcdBarrier xcd_barrier_post(unsigned* bar, volatile PG8_LAS unsigned* st) {
    XcdBarrier b; b.bar = bar; b.x = xb_xcc_id(); b.st = st;
    if (otid() == 0) (void)xb_add(&bar[XB_XCNT(b.x)], 1u);
    return b;
}
__device__ __forceinline__ void xcd_barrier_complete(unsigned* bar, unsigned x, unsigned& nloc, unsigned& nx) {
    const unsigned G = gridDim.x * gridDim.y * gridDim.z;
    unsigned sum, cnt, mine, sp = 0u;
    for (;;) {
        sum = 0u; cnt = 0u; mine = 0u;
#pragma unroll
        for (unsigned j = 0; j < 16; ++j) { const unsigned c = xb_ld(&bar[XB_XCNT(j)]); sum += c; cnt += (c > 0u) ? 1u : 0u; mine = (j == x) ? c : mine; }
        if (sum == G) break;
        __builtin_amdgcn_s_sleep(1);
        if ((++sp & 255u) == 0u) { if (xb_ld(&bar[XB_TMO])) break; if (sp > XB_SPIN_CAP) { atomicAdd(&bar[XB_TMO], 1u); break; } }
    }
    nloc = mine > 0u ? mine : 1u; nx = cnt > 0u ? cnt : 1u;
}
__device__ __forceinline__ void xcd_barrier(const XcdBarrier& b) {
    asm volatile("s_waitcnt vmcnt(0)" ::: "memory");
    __syncthreads();
    if (otid() == 0) {
        unsigned* bar = b.bar;
        __builtin_amdgcn_s_waitcnt(0);
        unsigned nloc = b.st[0], nx = b.st[1];
        if (nloc == 0u) { xcd_barrier_complete(bar, b.x, nloc, nx); b.st[0] = nloc; b.st[1] = nx; }
        const unsigned old = xb_add(&bar[XB_XSUB(b.x)], 1u);
        const unsigned gen = old / nloc;
        if (old + 1u == (gen + 1u) * nloc) {
            __builtin_amdgcn_fence(__ATOMIC_RELEASE, "agent");
            asm volatile("s_waitcnt vmcnt(0)" ::: "memory");
            const unsigned og = xb_add(&bar[XB_TOP], 1u);
            const unsigned tg = og / nx;
            if (og + 1u == (tg + 1u) * nx) xb_add(&bar[XB_TOPGEN], 1u);
            else XB_SPIN(xb_ld(&bar[XB_TOPGEN]) == tg, bar);
            __builtin_amdgcn_fence(__ATOMIC_ACQUIRE, "agent");
            xb_add(&bar[XB_XGEN(b.x)], 1u);
            asm volatile("s_waitcnt vmcnt(0)" ::: "memory");
        } else {
            XB_SPIN(xb_ld(&bar[XB_XGEN(b.x)]) == gen, bar);
            __builtin_amdgcn_fence(__ATOMIC_ACQUIRE, "agent");
            asm volatile("s_waitcnt vmcnt(0)" ::: "memory");
        }
    }
    __syncthreads();
}

constexpr int NPH = 14;
__global__ void __launch_bounds__(NTHR) mega(Params p) {
    extern __shared__ __attribute__((aligned(16))) unsigned char lds[];
    cg::grid_group grid = cg::this_grid();
    PG8_LAS unsigned char* ldsl = (PG8_LAS unsigned char*)lds;
    const int lo = p.ph_lo, hi = p.ph_hi;
#define IN(k) (lo <= (k) && (k) < hi)
#define SEAM(k) do { if (IN(k) && IN((k) + 1)) { xcd_barrier(xb); } } while (0)
    bf16* Zb = (bf16*)(kparams()->ws + WS_Z); bf16* CAT = (bf16*)(kparams()->ws + WS_CAT);
    volatile PG8_LAS unsigned* xst = (volatile PG8_LAS unsigned*)(ldsl + LDS_BYTES - 16);
    { const int t0_ = otid(); if (t0_ < 4) xst[t0_] = 0u; }
    __syncthreads();
    XcdBarrier xb = xcd_barrier_post((unsigned*)(kparams()->ws + WS_BAR), xst);
    if (p.ph_lo < 0) grid.sync();
    if (IN(0)) REPEAT(REP_PRO) { ph_prologue(p, lds); __syncthreads(); }
    SEAM(0);
    if (IN(0) && IN(1)) for (int r_ = 1; r_ < REP_SUB; ++r_) xcd_barrier(xb);
#pragma unroll
    for (int l = 0; l < NL; ++l) {
        const int pb = 1 + 6 * l;
        const char* Wl = (const char*)(kparams()->ws + WS_WIN + (size_t)l * WROWS * DM * 2);
        if (IN(pb)) {
            if (l == 0) {
#pragma unroll
                for (int ll = 0; ll < NL; ++ll) {
                    SchedS S = make_sched(kparams()->ws + WS_WCS + (size_t)ll * 1024 * DG * 2, DG, kparams()->ws + WS_WFXB + (size_t)ll * DM * DG * 2, DG, 1024, DM, 32 * ll);
                    EpiZ E{(bf16*)(kparams()->ws + WS_WIN + ((size_t)ll * WROWS + 6656) * DM * 2), DM};
                    pg8::gemm_phase<EpiZ, SchedS, true>(ldsl, pg8::Gemm{DG, DG, DG}, S, E);
                }
            }
            REPEAT(REP_NORM) ph_norm(p, l, (l == 0 && gridDim.x == 256) ? 64 : 0);
        }
        SEAM(pb);
        if (IN(pb + 1)) REPEAT(REP_Z) {
            SchedZ S; S.o.init(MTOK, 24 * 256, (int)gridDim.x, obid()); S.A = (const char*)(kparams()->ws + WS_U); S.B = Wl; S.late = 0;
            EpiZ2 E{Zb, (bf16*)(kparams()->ws + WS_PQT)};
            pg8::gemm_phase<EpiZ2, SchedZ, true>(ldsl, pg8::Gemm{DM, DM, DM}, S, E);
        }
        SEAM(pb + 1);
        if (IN(pb + 2)) {
            {
                SchedZ S; S.o.init(MTOK, 4 * 256, (int)gridDim.x, obid()); S.A = (const char*)(kparams()->ws + WS_U); S.B = Wl; S.late = 1;
                EpiZ2 E{Zb, (bf16*)(kparams()->ws + WS_PQT)};
                pg8::gemm_phase<EpiZ2, SchedZ, true>(ldsl, pg8::Gemm{DM, DM, DM}, S, E);
            }
            REPEAT(REP_MIX) ph_mixA(p, l, lds);
            ph_fold(p);
        }
        SEAM(pb + 2);
        if (IN(pb + 3)) REPEAT(REP_P3) {
            const int G_ = (int)gridDim.x, b_ = obid(); const bool bal = (G_ == 256);
            {
                SchedDFT S{(const char*)(kparams()->ws + WS_DC), (const char*)(kparams()->ws + WS_PQF), G_, b_};
                EpiPart E{(float*)(kparams()->ws + WS_PART)};
                pg8::gemm_phase<EpiPart, SchedDFT, true>(ldsl, pg8::Gemm{2048, 4096, 2048}, S, E); }
            {
                SchedS S = make_sched(kparams()->ws + WS_CVH, DG, kparams()->ws + WS_WPW + (size_t)l * DG * DG * 2, DG, MTOK, DG, bal ? 192 : 0);
                EpiGate E{CAT, Zb, 1536, 12 * DG};
                pg8::gemm_phase<EpiGate, SchedS, true>(ldsl, pg8::Gemm{DG, DG, DG}, S, E); }
            if (bal && REP_R2 == 1) {
                const int xcd = b_ & 7, slot = b_ >> 3;
                const int nt_ = (slot >= 24) ? 2 : (slot >= 8 ? 3 : 0), k0 = (slot >= 24) ? 48 + (slot - 24) * 2 : (slot - 8) * 3;
                for (int i = 0; i < nt_; ++i) { const int k = (slot >= 24) ? 48 + i * 8 + (slot - 24) : i * 16 + (slot - 8);
                    ret2_task(p, l, (2 * xcd + (k >> 5)) * 32 + (k & 31), lds); }
            }
            else for (int t = b_; t < 512 * REP_R2; t += G_) ret2_task(p, l, t & 511, lds);
            ph_alt(p);
        }
        SEAM(pb + 3);
        if (IN(pb + 4)) REPEAT(REP_CMB) ph_combine(p);
        SEAM(pb + 4);
        if (IN(pb + 5)) REPEAT(l == 0 ? REP_OUT : 1) {
            SchedS S = make_sched(CAT, DM, kparams()->ws + WS_WOUT + (size_t)l * DM * DM * 2, DM, MTOK, DM);
            EpiRes E{(l == 0) ? kparams()->x : kparams()->out, kparams()->out, (const float*)(kparams()->ws + WS_MOD) + (size_t)l * 2 * 6144 + 4096};
            pg8::gemm_phase<EpiRes, SchedS, true>(ldsl, pg8::Gemm{DM, DM, DM}, S, E);
        }
        SEAM(pb + 5);
    }
    if (IN(NPH - 1)) ph_final(p);
#undef IN
#undef SEAM
}

extern "C" void kernel_launch(void* const* d_in, const int* in_sizes, int n_in, void* d_out, int out_size, void* d_ws, size_t ws_size, hipStream_t stream) {
    static int grid_blocks = 0;
    if (grid_blocks == 0) {
        if (n_in != 17 || ws_size < WS_END) { fprintf(stderr, "kernel_launch: n_in %d ws %zu (need %zu)\n", n_in, ws_size, (size_t)WS_END); grid_blocks = -1; return; }
        int dev = 0, cus = 0, per_cu = 0;
        hipGetDevice(&dev); hipDeviceGetAttribute(&cus, hipDeviceAttributeMultiprocessorCount, dev);
        if (hipFuncSetAttribute((const void*)mega, hipFuncAttributeMaxDynamicSharedMemorySize, LDS_BYTES) != hipSuccess) { fprintf(stderr, "hipFuncSetAttribute failed\n"); grid_blocks = -1; return; }
        if (hipOccupancyMaxActiveBlocksPerMultiprocessor(&per_cu, (const void*)mega, NTHR, LDS_BYTES) != hipSuccess || per_cu < 1) { fprintf(stderr, "occupancy query: %d\n", per_cu); per_cu = 1; }
        (void)hipGetLastError();
        grid_blocks = cus * 1;
    }
    if (grid_blocks < 0) return;
    Params p{};
    p.x = (const float*)d_in[0]; p.c = (const float*)d_in[1]; p.norm_g = (const float*)d_in[2]; p.w_ada = (const float*)d_in[3]; p.b_ada = (const float*)d_in[4];
    p.w_in = (const float*)d_in[5]; p.w_fft = (const float*)d_in[6]; p.na_bias = (const float*)d_in[7]; p.rl_f = (const float*)d_in[8]; p.rl_b = (const float*)d_in[9];
    p.conv_w = (const float*)d_in[10]; p.conv_b = (const float*)d_in[11]; p.ln_g = (const float*)d_in[12]; p.ln_b = (const float*)d_in[13]; p.w_pw = (const float*)d_in[14];
    p.w_out = (const float*)d_in[15]; p.final_g = (const float*)d_in[16];
    p.out = (float*)d_out; p.ws = (unsigned char*)d_ws;
#if ONE_LAUNCH
    if (hipMemsetAsync((char*)d_ws + WS_BAR, 0, 16384, stream) != hipSuccess) { fprintf(stderr, "memset of the barrier words failed\n"); return; }
    p.ph_lo = 0; p.ph_hi = NPH;
    void* args[] = {&p};
    hipError_t e = hipLaunchCooperativeKernel((const void*)mega, dim3(grid_blocks), dim3(NTHR), args, LDS_BYTES, stream);
    if (e != hipSuccess) fprintf(stderr, "cooperative launch failed: %s (grid %d)\n", hipGetErrorString(e), grid_blocks);
#else
    for (int ph = 0; ph < NPH; ++ph) { p.ph_lo = ph; p.ph_hi = ph + 1; hipLaunchKernelGGL(mega, dim3(grid_blocks), dim3(NTHR), LDS_BYTES, stream, p); }
#endif
}
```

```cpp
#include <hip/hip_runtime.h>
#include <hip/hip_cooperative_groups.h>
#include <cstdio>
#include <cstdint>
namespace cg = cooperative_groups;

#ifndef ONE_LAUNCH
#define ONE_LAUNCH 1
#endif

__device__ __forceinline__ int obid() { int b = (int)blockIdx.x; asm volatile("" : "+s"(b)); return b; }
__device__ __forceinline__ int otid() { int t; asm volatile("v_mov_b32 %0, %1" : "=v"(t) : "v"(threadIdx.x)); return t; }
namespace pg8 {
#define PG8_LAS __attribute__((address_space(3)))
typedef unsigned short bf16_t;
typedef short bf16x8 __attribute__((ext_vector_type(8)));
typedef float f32x4 __attribute__((ext_vector_type(4)));
typedef unsigned u32x4 __attribute__((ext_vector_type(4)));
constexpr int BM = 256, BK = 64, HALF = 128, HTB = HALF * BK * 2, STAGE_BYTES = 8 * HTB, NXCD = 8, WGM = 3;

__host__ __device__ __forceinline__ int lds_byte(int r, int c) { const int st = (r >> 4) * 2 + (c >> 5), rr = r & 15, cc = c & 31, ob = rr * 64 + cc * 2; return st * 1024 + (ob ^ (((ob >> 9) & 1) << 5)); }
__host__ __device__ __forceinline__ void stage_rc(int b, int& R, int& C) { const int st = b / 1024, sb = b % 1024, swz = sb ^ (((sb >> 9) & 1) << 5); R = (st >> 1) * 16 + swz / 64; C = (st & 1) * 32 + (swz % 64) / 2; }
__host__ __device__ __forceinline__ int perm32(int rho) { const int n = rho >> 4, i = rho & 15; return 8 * (i >> 2) + 4 * n + (i & 3); }

struct Unit { int pm, pn, aux, pad; const char* A; const char* B; };
struct Gemm { int lda, ldb, K; };

struct StaticOrder {
    int nM, nN, nwg, G, c;
    __host__ __device__ void init(int M, int N, int G_, int c_) { nM = M / BM; nN = N / BM; nwg = nM * nN; G = G_; c = c_; }
    __device__ bool next(int i, Unit& u) const {
        const long L = (long)i * G + c; if (L >= nwg) return false;
        int wgid = __builtin_amdgcn_readfirstlane((int)L); { const int q = nwg / NXCD, r = nwg % NXCD, xcd = wgid % NXCD, off = wgid / NXCD; wgid = (xcd < r ? xcd * (q + 1) : r * (q + 1) + (xcd - r) * q) + off; }
        const int nig = WGM * nN, gid = wgid / nig, fm = gid * WGM, gsz = (nM - fm) < WGM ? (nM - fm) : WGM;
        u.pm = __builtin_amdgcn_readfirstlane(fm + ((wgid % nig) % gsz)); u.pn = __builtin_amdgcn_readfirstlane((wgid % nig) / gsz); return true;
    }
};

__device__ __forceinline__ unsigned cvt_pk_bf16(float lo, float hi) { unsigned r; asm volatile("v_cvt_pk_bf16_f32 %0, %1, %2" : "=v"(r) : "v"(lo), "v"(hi)); return r; }

template <class Epi, class Sched, bool ALIGN_EPI>
__device__ __forceinline__ void gemm_phase(PG8_LAS unsigned char* lds, const Gemm g, const Sched& S, const Epi& E) {
    const int tid = otid(), wid = __builtin_amdgcn_readfirstlane(tid >> 6), lane = tid & 63, wr = wid >> 2, wc = wid & 3, fr = lane & 15, fq = lane >> 4;
    const int K = g.K, nt = K / BK;
    unsigned voffA[2], voffB[2];
#pragma unroll
    for (int i = 0; i < 2; ++i) { int R, C; stage_rc(tid * 16 + i * 8192, R, C); const int Rb = Epi::PERM ? ((R & ~31) + perm32(R & 31)) : R;
        voffA[i] = (unsigned)(R * g.lda + C) * 2u; voffB[i] = (unsigned)(Rb * g.ldb + C) * 2u; }
    const size_t kstep = (size_t)(BK * 2);
    const size_t hA = (size_t)HALF * g.lda * 2, hB = (size_t)HALF * g.ldb * 2;
    const unsigned ldsw = (unsigned)wid * 1024u;
    const int aoff = lds_byte(wr * 64 + fr, fq * 8), boff = lds_byte(wc * 32 + fr, fq * 8);
#define PG8_SA(b, h) (((b) * 2 + (h)) * HTB)
#define PG8_SB(b, h) ((4 + (b) * 2 + (h)) * HTB)
#define PG8_STAGE(bufoff, gbase, voff) do { _Pragma("unroll") for (int _i = 0; _i < 2; ++_i) \
        __builtin_amdgcn_global_load_lds((const unsigned*)((const char*)(gbase) + (voff)[_i]), (PG8_LAS unsigned*)(lds + (bufoff) + ldsw + _i * 8192), 16, 0, 0); } while (0)
#define PG8_LDA(dst, b, h) do { _Pragma("unroll") for (int m = 0; m < 4; ++m) _Pragma("unroll") for (int k = 0; k < 2; ++k) dst[m][k] = *(const PG8_LAS bf16x8*)(lds + PG8_SA(b, h) + aoff + m * 2048 + k * 1024); } while (0)
#define PG8_LDB(dst, b, h) do { _Pragma("unroll") for (int n = 0; n < 2; ++n) _Pragma("unroll") for (int k = 0; k < 2; ++k) dst[n][k] = *(const PG8_LAS bf16x8*)(lds + PG8_SB(b, h) + boff + n * 2048 + k * 1024); } while (0)
#define PG8_MMA(ai, bj, At, Bt) do { __builtin_amdgcn_s_setprio(1); _Pragma("unroll") for (int m = 0; m < 4; ++m) _Pragma("unroll") for (int n = 0; n < 2; ++n) _Pragma("unroll") for (int k = 0; k < 2; ++k) \
        acc[ai][bj][m][n] = __builtin_amdgcn_mfma_f32_16x16x32_bf16(Bt[n][k], At[m][k], acc[ai][bj][m][n], 0, 0, 0); __builtin_amdgcn_s_setprio(0); } while (0)
#define PG8_WAIT_V(n) asm volatile("s_waitcnt vmcnt(" #n ")" ::: "memory")
#define PG8_WAIT_L(n) asm volatile("s_waitcnt lgkmcnt(" #n ")" ::: "memory")
#define PG8_BAR __builtin_amdgcn_s_barrier()
#define PG8_SCHED __builtin_amdgcn_sched_barrier(0)
    Unit cur, nxt; int ui = 0;
    if (!S.next(0, cur)) return;
    f32x4 acc[2][2][4][2];
#pragma unroll
    for (int a = 0; a < 2; ++a)
#pragma unroll
        for (int b = 0; b < 2; ++b)
#pragma unroll
            for (int m = 0; m < 4; ++m)
#pragma unroll
                for (int n = 0; n < 2; ++n) acc[a][b][m][n] = (f32x4){0.f, 0.f, 0.f, 0.f};
    bf16x8 At[4][2], B0[2][2], B1[2][2];
    const char* cA = cur.A; const char* cB = cur.B;
    PG8_STAGE(PG8_SB(0, 0), cB, voffB); PG8_STAGE(PG8_SB(0, 1), cB + hB, voffB); PG8_STAGE(PG8_SA(0, 0), cA, voffA); PG8_STAGE(PG8_SA(0, 1), cA + hA, voffA);
    if (wr == 1) PG8_BAR;
    PG8_WAIT_V(2); PG8_BAR;
    PG8_STAGE(PG8_SB(1, 0), cB + kstep, voffB); PG8_STAGE(PG8_SA(1, 0), cA + kstep, voffA); PG8_STAGE(PG8_SB(1, 1), cB + hB + kstep, voffB);
    PG8_WAIT_V(6); PG8_BAR;
    for (;;) {
        const bool has_next = S.next(ui + 1, nxt);
        const char* nA = has_next ? nxt.A : cA; const char* nB = has_next ? nxt.B : cB;
        for (int t = 0; t < nt; t += 2) {
            const bool last = (t == nt - 2);
            const char* a1 = cA + (size_t)(t + 1) * kstep;
            const char* a2 = last ? nA : cA + (size_t)(t + 2) * kstep; const char* b2 = last ? nB : cB + (size_t)(t + 2) * kstep;
            const char* a3 = a2 + kstep; const char* b3 = b2 + kstep;
            PG8_LDB(B0, 0, 0); PG8_LDB(B1, 0, 1); PG8_SCHED; PG8_LDA(At, 0, 0); PG8_STAGE(PG8_SA(1, 1), a1 + hA, voffA);
            PG8_WAIT_V(8); PG8_WAIT_L(0); PG8_BAR; PG8_MMA(0, 0, At, B0); PG8_MMA(0, 1, At, B1); PG8_BAR; PG8_SCHED;
            PG8_LDA(At, 0, 1); PG8_STAGE(PG8_SB(0, 0), b2, voffB); PG8_STAGE(PG8_SB(0, 1), b2 + hB, voffB); PG8_STAGE(PG8_SA(0, 0), a2, voffA);
            PG8_WAIT_V(8); PG8_WAIT_L(0); PG8_BAR; PG8_MMA(1, 0, At, B0); PG8_MMA(1, 1, At, B1); PG8_BAR; PG8_SCHED;
            PG8_LDB(B0, 1, 0); PG8_LDB(B1, 1, 1); PG8_SCHED; PG8_LDA(At, 1, 0); PG8_STAGE(PG8_SA(0, 1), a2 + hA, voffA);
            PG8_WAIT_V(8); PG8_WAIT_L(0); PG8_BAR; PG8_MMA(0, 0, At, B0); PG8_MMA(0, 1, At, B1); PG8_BAR; PG8_SCHED;
            PG8_LDA(At, 1, 1); PG8_STAGE(PG8_SB(1, 0), b3, voffB); PG8_STAGE(PG8_SB(1, 1), b3 + hB, voffB); PG8_STAGE(PG8_SA(1, 0), a3, voffA);
            PG8_WAIT_V(8); PG8_WAIT_L(0); PG8_BAR; PG8_MMA(1, 0, At, B0); PG8_MMA(1, 1, At, B1); PG8_BAR; PG8_SCHED;
        }
        if constexpr (ALIGN_EPI) { if (wr == 0) PG8_BAR; }
        E(acc, cur, wr, wc, fr, fq);
        if (!has_next) break;
#pragma unroll
        for (int a = 0; a < 2; ++a)
#pragma unroll
            for (int b = 0; b < 2; ++b)
#pragma unroll
                for (int m = 0; m < 4; ++m)
#pragma unroll
                    for (int n = 0; n < 2; ++n) acc[a][b][m][n] = (f32x4){0.f, 0.f, 0.f, 0.f};
        cur = nxt; cA = nA; cB = nB; ++ui;
        if constexpr (ALIGN_EPI) { if (wr == 1) PG8_BAR; }
    }
    PG8_WAIT_V(0);
    if constexpr (!ALIGN_EPI) { if (wr == 0) PG8_BAR; }
    PG8_BAR;
#undef PG8_SA
#undef PG8_SB
#undef PG8_STAGE
#undef PG8_LDA
#undef PG8_LDB
#undef PG8_MMA
#undef PG8_WAIT_V
#undef PG8_WAIT_L
#undef PG8_BAR
#undef PG8_SCHED
}
}

typedef unsigned short bf16;
typedef float f32x4 __attribute__((ext_vector_type(4)));
typedef unsigned u32x4 __attribute__((ext_vector_type(4)));
typedef unsigned u32x2 __attribute__((ext_vector_type(2)));
constexpr int NB = 2, SEQ = 4096, DM = 2048, MTOK = NB * SEQ, DIN = 6656, DG = 512, NL = 2;
constexpr int LDS_BYTES = 147456;
constexpr int NTHR = 512;

constexpr int WROWS = 7680;
constexpr size_t WS_WIN = 0;
constexpr size_t WS_WOUT = WS_WIN + (size_t)NL * WROWS * DM * 2;
constexpr size_t WS_WCS = WS_WOUT + (size_t)NL * DM * DM * 2;
constexpr size_t WS_WFXB = WS_WCS + (size_t)NL * 1024 * DG * 2;
constexpr size_t WS_WPW = WS_WFXB + (size_t)NL * DM * DG * 2;
constexpr size_t WS_DC = WS_WPW + (size_t)NL * DG * DG * 2;
constexpr size_t WS_DS = WS_DC + (size_t)2304 * 2048 * 2;
constexpr size_t WS_PQF = WS_DS + (size_t)2048 * 2048 * 2;
constexpr size_t WS_ROPE = WS_PQF + (size_t)NB * DG * 2 * 2048 * 2;
constexpr size_t WS_MOD = WS_ROPE + (size_t)SEQ * 32 * 8;
constexpr size_t WS_U = WS_MOD + 131072;
constexpr size_t WS_PART = WS_U + (size_t)MTOK * DM * 2;
constexpr size_t WS_Z = WS_U + (size_t)4 * MTOK * DG * 4;
constexpr size_t WS_PQT = WS_Z + (size_t)MTOK * DIN * 2;
constexpr size_t WS_CVH = WS_PQT + (size_t)NB * DG * 2 * SEQ * 2;
constexpr size_t WS_CAT = WS_CVH + (size_t)MTOK * DG * 2;
constexpr size_t WS_KV = WS_CAT + (size_t)MTOK * DM * 2;
constexpr size_t WS_BAR = WS_KV + (size_t)2 * NB * 8 * 32 * 4096 * 4;
constexpr size_t WS_END = WS_BAR + 16384;

struct Params {
    const float* x; const float* c; const float* norm_g; const float* w_ada; const float* b_ada; const float* w_in; const float* w_fft; const float* na_bias;
    const float* rl_f; const float* rl_b; const float* conv_w; const float* conv_b; const float* ln_g; const float* ln_b; const float* w_pw; const float* w_out; const float* final_g;
    float* out; unsigned char* ws; int ph_lo, ph_hi;
};

#if defined(__HIP_DEVICE_COMPILE__)
typedef const __attribute__((address_space(4))) Params* KParams;
__device__ __forceinline__ KParams kparams() { KParams k = (KParams)__builtin_amdgcn_kernarg_segment_ptr(); asm volatile("" : "+s"(k)); return k; }
#else
typedef const Params* KParams;
__device__ __forceinline__ KParams kparams() { return nullptr; }
#endif
__device__ __forceinline__ unsigned f2bf(float f) { unsigned u = __float_as_uint(f); return (u + 0x7fffu + ((u >> 16) & 1u)) >> 16; }
__device__ __forceinline__ unsigned pk2(float lo, float hi) { return f2bf(lo) | (f2bf(hi) << 16); }
__device__ __forceinline__ float bf2f(bf16 b) { return __uint_as_float((unsigned)b << 16); }
__device__ __forceinline__ float bflo(unsigned u) { return __uint_as_float(u << 16); }
__device__ __forceinline__ float bfhi(unsigned u) { return __uint_as_float(u & 0xffff0000u); }
__device__ __forceinline__ float silu_f(float v) { return v / (1.f + __expf(-v)); }
__device__ __forceinline__ float wave_sum(float v) {
#pragma unroll
    for (int o = 1; o < 64; o <<= 1) v += __shfl_xor(v, o);
    return v;
}
__device__ __forceinline__ float wave_max(float v) {
#pragma unroll
    for (int o = 1; o < 64; o <<= 1) v = fmaxf(v, __shfl_xor(v, o));
    return v;
}

struct SchedS {
    pg8::StaticOrder o; const char* A; const char* B; size_t ta, tb;
    __device__ __forceinline__ bool next(int i, pg8::Unit& u) const { if (!o.next(i, u)) return false; u.A = A + (size_t)u.pm * ta; u.B = B + (size_t)u.pn * tb; u.aux = 0; return true; }
};
__device__ __forceinline__ SchedS make_sched(const void* A, int lda, const void* B, int ldb, int M, int N, int shift = 0) {
    SchedS s; s.o.init(M, N, (int)gridDim.x, (int)((obid() + gridDim.x - shift) % gridDim.x)); s.A = (const char*)A; s.B = (const char*)B; s.ta = (size_t)256 * lda * 2; s.tb = (size_t)256 * ldb * 2; return s;
}
struct SchedZ {
    pg8::StaticOrder o; const char* A; const char* B; int late;
    __device__ __forceinline__ bool next(int i, pg8::Unit& u) const { if (!o.next(i, u)) return false; const int jn = u.pn;
        u.pn = late ? (jn < 2 ? 2 + jn : 22 + jn) : (jn < 20 ? jn + 4 : jn + 6);
        u.A = A + (size_t)u.pm * (256 * DM * 2); u.B = B + (size_t)u.pn * (256 * DM * 2); u.aux = 0; return true; }
};
struct SchedDFT {
    const char* DC; const char* PQF; int G, c;
    __device__ __forceinline__ bool next(int i, pg8::Unit& u) const {
        if (c < 0) return false;
        const int L = __builtin_amdgcn_readfirstlane(i * G + c); if (L >= 64) return false;
        const int b = L >> 5, t = L & 31, odd = t >> 4, tt = t & 15; u.pm = tt >> 1; u.pn = tt & 1; u.aux = b * 2 + odd;
        u.A = DC + (size_t)odd * (WS_DS - WS_DC) + (size_t)u.pm * (256 * 2048 * 2);
        u.B = PQF + ((size_t)(b * 512 + u.pn * 256) * 4096 + odd * 2048) * 2; return true;
    }
};

struct EpiZ {
    static constexpr bool PERM = true;
    bf16* O; int ldc;
    __device__ __forceinline__ void operator()(const pg8::f32x4 (&acc)[2][2][4][2], const pg8::Unit& u, int wr, int wc, int fr, int fq) const {
        const int row0 = u.pm * 256 + wr * 64 + fr, col0 = u.pn * 256 + wc * 32 + 8 * fq;
#pragma unroll
        for (int ai = 0; ai < 2; ++ai)
#pragma unroll
            for (int m = 0; m < 4; ++m) { bf16* rowp = O + (size_t)(row0 + ai * 128 + m * 16) * ldc + col0;
#pragma unroll
                for (int bj = 0; bj < 2; ++bj) { const pg8::f32x4 v0 = acc[ai][bj][m][0], v1 = acc[ai][bj][m][1]; u32x4 w;
                    w.x = pg8::cvt_pk_bf16(v0[0], v0[1]); w.y = pg8::cvt_pk_bf16(v0[2], v0[3]); w.z = pg8::cvt_pk_bf16(v1[0], v1[1]); w.w = pg8::cvt_pk_bf16(v1[2], v1[3]);
                    *(u32x4*)(rowp + bj * 128) = w; } }
    }
};
struct EpiZ2 {
    static constexpr bool PERM = true;
    bf16* O; bf16* PQ;
    __device__ __forceinline__ void operator()(const pg8::f32x4 (&acc)[2][2][4][2], const pg8::Unit& u, int wr, int wc, int fr, int fq) const {
        const int row0 = u.pm * 256 + wr * 64 + fr;
        if (u.pn < 26) { const int col0 = u.pn * 256 + wc * 32 + 8 * fq;
#pragma unroll
            for (int ai = 0; ai < 2; ++ai)
#pragma unroll
                for (int m = 0; m < 4; ++m) { bf16* rowp = O + (size_t)(row0 + ai * 128 + m * 16) * DIN + col0;
#pragma unroll
                    for (int bj = 0; bj < 2; ++bj) { const pg8::f32x4 v0 = acc[ai][bj][m][0], v1 = acc[ai][bj][m][1]; u32x4 w;
                        w.x = pg8::cvt_pk_bf16(v0[0], v0[1]); w.y = pg8::cvt_pk_bf16(v0[2], v0[3]); w.z = pg8::cvt_pk_bf16(v1[0], v1[1]); w.w = pg8::cvt_pk_bf16(v1[2], v1[3]);
                        *(u32x4*)(rowp + bj * 128) = w; } }
        } else { const int np0 = (u.pn - 26) * 256 + wc * 32 + 8 * fq;
#pragma unroll
            for (int bj = 0; bj < 2; ++bj) { const int np = np0 + bj * 128, pq = np >> 9, n = np & 511;
#pragma unroll
                for (int ai = 0; ai < 2; ++ai)
#pragma unroll
                    for (int m = 0; m < 4; ++m) { const int row = row0 + ai * 128 + m * 16, b = row >> 12, sq = row & 4095;
                        bf16* dst = PQ + ((size_t)(b * 512 + n) * 2 + pq) * 4096 + sq;
#pragma unroll
                        for (int nn = 0; nn < 2; ++nn)
#pragma unroll
                            for (int j = 0; j < 4; ++j) dst[(size_t)(4 * nn + j) * 8192] = (bf16)f2bf(acc[ai][bj][m][nn][j]); } }
        }
    }
};
struct EpiGate {
    static constexpr bool PERM = true;
    bf16* O; const bf16* Z; int coff, goff;
    __device__ __forceinline__ void operator()(const pg8::f32x4 (&acc)[2][2][4][2], const pg8::Unit& u, int wr, int wc, int fr, int fq) const {
        const int row0 = u.pm * 256 + wr * 64 + fr, col0 = u.pn * 256 + wc * 32 + 8 * fq;
#pragma unroll
        for (int ai = 0; ai < 2; ++ai)
#pragma unroll
            for (int m = 0; m < 4; ++m) { const size_t row = (size_t)(row0 + ai * 128 + m * 16);
#pragma unroll
                for (int bj = 0; bj < 2; ++bj) { const pg8::f32x4 v0 = acc[ai][bj][m][0], v1 = acc[ai][bj][m][1];
                    const u32x4 gz = *(const u32x4*)(Z + row * DIN + goff + col0 + bj * 128); u32x4 w;
                    w.x = pg8::cvt_pk_bf16(v0[0] * silu_f(bflo(gz.x)), v0[1] * silu_f(bfhi(gz.x))); w.y = pg8::cvt_pk_bf16(v0[2] * silu_f(bflo(gz.y)), v0[3] * silu_f(bfhi(gz.y)));
                    w.z = pg8::cvt_pk_bf16(v1[0] * silu_f(bflo(gz.z)), v1[1] * silu_f(bfhi(gz.z))); w.w = pg8::cvt_pk_bf16(v1[2] * silu_f(bflo(gz.w)), v1[3] * silu_f(bfhi(gz.w)));
                    *(u32x4*)(O + row * DM + coff + col0 + bj * 128) = w; } }
    }
};
struct EpiPart {
    static constexpr bool PERM = false;
    float* P;
    __device__ __forceinline__ void operator()(const pg8::f32x4 (&acc)[2][2][4][2], const pg8::Unit& u, int wr, int wc, int fr, int fq) const {
        const int row0 = u.pm * 256 + wr * 64 + fr, col0 = u.pn * 256 + wc * 32 + 4 * fq;
        float* base = (u.aux & 1) ? P + (size_t)2 * 2304 * 512 + (size_t)(u.aux >> 1) * 2048 * 512 : P + (size_t)(u.aux >> 1) * 2304 * 512;
#pragma unroll
        for (int ai = 0; ai < 2; ++ai)
#pragma unroll
            for (int m = 0; m < 4; ++m) { float* rowp = base + (size_t)(row0 + ai * 128 + m * 16) * 512 + col0;
#pragma unroll
                for (int bj = 0; bj < 2; ++bj)
#pragma unroll
                    for (int n = 0; n < 2; ++n) *(pg8::f32x4*)(rowp + bj * 128 + n * 16) = acc[ai][bj][m][n]; }
    }
};
struct EpiRes {
    static constexpr bool PERM = false;
    const float* xin; float* xout; const float* gate;
    __device__ __forceinline__ void operator()(const pg8::f32x4 (&acc)[2][2][4][2], const pg8::Unit& u, int wr, int wc, int fr, int fq) const {
        const int row0 = u.pm * 256 + wr * 64 + fr, col0 = u.pn * 256 + wc * 32 + 4 * fq;
        const float* gp = gate + (size_t)(u.pm >> 4) * 6144 + col0;
        pg8::f32x4 gv[2][2];
#pragma unroll
        for (int bj = 0; bj < 2; ++bj)
#pragma unroll
            for (int n = 0; n < 2; ++n) gv[bj][n] = *(const pg8::f32x4*)(gp + bj * 128 + n * 16);
#pragma unroll
        for (int ai = 0; ai < 2; ++ai)
#pragma unroll
            for (int m = 0; m < 4; ++m) { const size_t ro = (size_t)(row0 + ai * 128 + m * 16) * DM + col0;
#pragma unroll
                for (int bj = 0; bj < 2; ++bj)
#pragma unroll
                    for (int n = 0; n < 2; ++n) { const pg8::f32x4 xi = *(const pg8::f32x4*)(xin + ro + bj * 128 + n * 16);
                        *(pg8::f32x4*)(xout + ro + bj * 128 + n * 16) = xi + gv[bj][n] * acc[ai][bj][m][n]; } }
    }
};

struct TPItem { const float* src; bf16* dst; int N, K; };
__device__ __forceinline__ TPItem tp_decode(const Params& p, int it, int tid) {
    constexpr int T_IN = 32 * 96, T_OUT = 32 * 32, T_S = 64, T_L = T_IN + T_OUT + T_S;
    const int l = it / T_L; int r = it % T_L; const float* W; bf16* WT; int K, N, kb, nb;
    if (r < T_IN) { W = p.w_in + (size_t)l * DM * DIN; WT = (bf16*)(p.ws + WS_WIN) + (size_t)l * WROWS * DM; K = DM; N = DIN; kb = r / 96; nb = 8 + r % 96; }
    else if (r < T_IN + T_OUT) { r -= T_IN; W = p.w_out + (size_t)l * DM * DM; WT = (bf16*)(p.ws + WS_WOUT) + (size_t)l * DM * DM; K = DM; N = DM; kb = r >> 5; nb = r & 31; }
    else { r -= T_IN + T_OUT; W = p.w_pw + (size_t)l * DG * DG; WT = (bf16*)(p.ws + WS_WPW) + (size_t)l * DG * DG; K = DG; N = DG; kb = r >> 3; nb = r & 7; }
    TPItem t; t.N = N; t.K = K;
    t.src = W + (size_t)(kb * 64 + (tid >> 4)) * N + nb * 64 + (tid & 15) * 4;
    t.dst = WT + (size_t)(nb * 64 + (tid >> 3)) * K + kb * 64 + (tid & 7) * 8;
    return t;
}
__device__ __forceinline__ void tp_store(const TPItem& t, int tid, const f32x4& v0, const f32x4& v1, float* scr) {
    { const int kk = tid >> 4, nn = (tid & 15) * 4;
      scr[kk * 65 + nn] = v0[0]; scr[kk * 65 + nn + 1] = v0[1]; scr[kk * 65 + nn + 2] = v0[2]; scr[kk * 65 + nn + 3] = v0[3];
      scr[(kk + 32) * 65 + nn] = v1[0]; scr[(kk + 32) * 65 + nn + 1] = v1[1]; scr[(kk + 32) * 65 + nn + 2] = v1[2]; scr[(kk + 32) * 65 + nn + 3] = v1[3]; }
    __syncthreads();
    { const int n = tid >> 3, kc = (tid & 7) * 8; const float* s = scr + kc * 65 + n; u32x4 o;
      o.x = pk2(s[0], s[65]); o.y = pk2(s[2 * 65], s[3 * 65]); o.z = pk2(s[4 * 65], s[5 * 65]); o.w = pk2(s[6 * 65], s[7 * 65]);
      *(u32x4*)t.dst = o; }
    __syncthreads();
}

__device__ __forceinline__ void ph_prologue(const Params& p_, unsigned char* lds) {
    const Params p = *kparams(); (void)p_;
    const int tid = otid(), lane = tid & 63, wave = tid >> 6, G = gridDim.x, bid = obid();
    float* scr = (float*)lds;
    { constexpr int T_TOT = NL * (32 * 96 + 32 * 32 + 64);
      int it = bid; TPItem cur; f32x4 a0, a1;
      if (it < T_TOT) { cur = tp_decode(p, it, tid); a0 = __builtin_nontemporal_load((const f32x4*)cur.src); a1 = __builtin_nontemporal_load((const f32x4*)(cur.src + (size_t)32 * cur.N)); }
      while (it < T_TOT) { const int nit = it + G; TPItem nxt = cur; f32x4 b0 = a0, b1 = a1;
          if (nit < T_TOT) { nxt = tp_decode(p, nit, tid); b0 = __builtin_nontemporal_load((const f32x4*)nxt.src); b1 = __builtin_nontemporal_load((const f32x4*)(nxt.src + (size_t)32 * nxt.N)); }
          tp_store(cur, tid, a0, a1, scr);
          cur = nxt; a0 = b0; a1 = b1; it = nit; } }
    { bf16* Wfx = (bf16*)(p.ws + WS_WFXB);
      for (int e = bid * NTHR + tid; e < NL * DM * DG / 8; e += G * NTHR) { const int l = e >> 17, r = e & 131071, k = r >> 6, c8 = (r & 63) * 8;
          const float* src = p.w_in + ((size_t)l * DM + k) * DIN + c8; const f32x4 a = *(const f32x4*)src, b4 = *(const f32x4*)(src + 4);
          u32x4 o; o.x = pk2(a[0], a[1]); o.y = pk2(a[2], a[3]); o.z = pk2(b4[0], b4[1]); o.w = pk2(b4[2], b4[3]);
          *(u32x4*)(Wfx + ((size_t)l * DM + k) * DG + c8) = o; } }
    { float* Wl = (float*)lds; float* tr = Wl + 128 * 65; bf16* Wcs = (bf16*)(p.ws + WS_WCS);
      for (int t2 = G - 1 - bid; t2 < 256; t2 += G) {
          const int t = t2 >> 1, ch = t2 & 1, l = t >> 6, pq = (t >> 5) & 1, g = (t >> 3) & 3, n0 = (t & 7) * 64;
#pragma unroll
          for (int i = 0; i < 4; ++i) { const int m = (tid >> 4) + 32 * i, nn = (tid & 15) * 4;
              const f32x4 v = *(const f32x4*)(p.w_fft + ((size_t)l * DG + g * 128 + m) * DG + n0 + nn);
              Wl[m * 65 + nn] = v[0]; Wl[m * 65 + nn + 1] = v[1]; Wl[m * 65 + nn + 2] = v[2]; Wl[m * 65 + nn + 3] = v[3]; }
          if (tid < 128) tr[tid] = pq ? sinpif((float)tid * (1.f / 64.f)) : cospif((float)tid * (1.f / 64.f));
          __syncthreads();
          const int nn = tid >> 3, cc = ch * 64 + (tid & 7) * 8; float acc[8];
#pragma unroll
          for (int i = 0; i < 8; ++i) acc[i] = 0.f;
#pragma unroll 4
          for (int m = 0; m < 128; ++m) { const float w = Wl[m * 65 + nn];
#pragma unroll
              for (int i = 0; i < 8; ++i) acc[i] += tr[((cc + i) * m) & 127] * w; }
          const float nrm = 0.0013810679320049757f;
          u32x4 o0;
          o0.x = pk2(acc[0] * nrm, acc[1] * nrm); o0.y = pk2(acc[2] * nrm, acc[3] * nrm); o0.z = pk2(acc[4] * nrm, acc[5] * nrm); o0.w = pk2(acc[6] * nrm, acc[7] * nrm);
          *(u32x4*)(Wcs + ((size_t)l * 1024 + pq * 512 + n0 + nn) * DG + g * 128 + cc) = o0;
          __syncthreads();
      } }
    __syncthreads();
    float* cosT = (float*)(lds + 32768); float* sinT = (float*)(lds + 49152); float* ca = (float*)(lds + 65536); float* red = (float*)(lds + 81920);
    for (int j = tid; j < 4096; j += NTHR) { cosT[j] = cospif((float)j * (1.f / 2048.f)); sinT[j] = sinpif((float)j * (1.f / 2048.f)); }
    for (int j = tid; j < 4096; j += NTHR) { const float cv = p.c[j]; ca[j] = cv / (1.f + expf(-cv)); }
    __syncthreads();
    { bf16* DC = (bf16*)(p.ws + WS_DC); bf16* DSm = (bf16*)(p.ws + WS_DS);
      for (int r = bid * 2 + (tid >> 8); r < 4352; r += G * 2) { const int is_sin = (r >= 2304) ? 1 : 0, k = is_sin ? r - 2304 : r, s0 = (tid & 255) * 8; float v[8];
#pragma unroll
          for (int j = 0; j < 8; ++j) { const int idx = (k * (s0 + j)) & 4095; v[j] = is_sin ? sinT[idx] : cosT[idx]; }
          u32x4 o; o.x = pk2(v[0], v[1]); o.y = pk2(v[2], v[3]); o.z = pk2(v[4], v[5]); o.w = pk2(v[6], v[7]);
          *(u32x4*)((is_sin ? DSm : DC) + (size_t)k * 2048 + s0) = o; } }
    { float2* rope = (float2*)(p.ws + WS_ROPE);
      for (int e = bid * NTHR + tid; e < 4096 * 32; e += G * NTHR) { const int s = e >> 5, i = e & 31;
          const float inv = (float)pow(10000.0, -(double)i / 32.0); const float ang = (float)s * inv;
          double sn, cs; sincos((double)ang, &sn, &cs); rope[e] = make_float2((float)cs, (float)sn); } }
    float* mod = (float*)(p.ws + WS_MOD);
    for (int t = bid; t < 192; t += G) {
        const int l = t / 96, col = (t % 96) * 64 + lane; const float* W = p.w_ada + (size_t)l * DM * 6144 + col;
        float a0 = 0.f, a1 = 0.f;
        for (int k0 = wave * 256; k0 < wave * 256 + 256; k0 += 32) { float wv[32];
#pragma unroll
            for (int j = 0; j < 32; ++j) wv[j] = __builtin_nontemporal_load(W + (size_t)(k0 + j) * 6144);
            asm volatile("" ::: "memory");
#pragma unroll
            for (int j = 0; j < 32; ++j) { a0 += ca[k0 + j] * wv[j]; a1 += ca[2048 + k0 + j] * wv[j]; } }
        red[(wave * 2 + 0) * 64 + lane] = a0; red[(wave * 2 + 1) * 64 + lane] = a1;
        __syncthreads();
        if (wave < 2) { float s = 0.f;
#pragma unroll
            for (int w = 0; w < 8; ++w) s += red[(w * 2 + wave) * 64 + lane];
            mod[(size_t)(l * 2 + wave) * 6144 + col] = s + p.b_ada[l * 6144 + col]; }
        __syncthreads();
    }
}

__device__ __forceinline__ void ph_norm(const Params& p_, int l, int skip_blocks) {
    const Params p = *kparams(); (void)p_;
    const int tid = otid(), lane = tid & 63, wave = tid >> 6;
    const float* xin = (l == 0) ? p.x : p.out; bf16* h = (bf16*)(p.ws + WS_U); const float* mod = (const float*)(p.ws + WS_MOD);
    const int stride = gridDim.x * 8; const float* g = p.norm_g + l * DM;
    if (stride == 2048) {
        const int nw = (256 - skip_blocks) * 8;
        for (int pi = (obid() - skip_blocks) * 8 + wave; pi >= 0 && pi < 4096; pi += nw) {
            const int row = (pi >> 11) * 4096 + (pi & 2047);
            const f32x4* xr0 = (const f32x4*)(xin + (size_t)row * DM) + lane; const f32x4* xr1 = (const f32x4*)(xin + (size_t)(row + stride) * DM) + lane;
            const float* md = mod + (size_t)(l * 2 + (row >> 12)) * 6144;
            f32x4 v0[8], v1[8], ca[8], cb[8];
#pragma unroll
            for (int j = 0; j < 8; ++j) { v0[j] = xr0[64 * j]; v1[j] = xr1[64 * j]; }
#pragma unroll
            for (int j = 0; j < 8; ++j) { const int col = (64 * j + lane) * 4; ca[j] = *(const f32x4*)(g + col) * (*(const f32x4*)(md + 2048 + col) + 1.f); cb[j] = *(const f32x4*)(md + col); }
            asm volatile("" ::: "memory");
            float s0 = 0.f, s1 = 0.f;
#pragma unroll
            for (int j = 0; j < 8; ++j) { s0 += (v0[j][0] * v0[j][0] + v0[j][1] * v0[j][1]) + (v0[j][2] * v0[j][2] + v0[j][3] * v0[j][3]); s1 += (v1[j][0] * v1[j][0] + v1[j][1] * v1[j][1]) + (v1[j][2] * v1[j][2] + v1[j][3] * v1[j][3]); }
            s0 = wave_sum(s0); s1 = wave_sum(s1);
            const float r0 = rsqrtf(s0 * (1.f / DM) + 1e-6f), r1 = rsqrtf(s1 * (1.f / DM) + 1e-6f);
#pragma unroll
            for (int j = 0; j < 8; ++j) { const int col = (64 * j + lane) * 4;
                const f32x4 o0 = (v0[j] * r0) * ca[j] + cb[j], o1 = (v1[j] * r1) * ca[j] + cb[j]; u32x2 w;
                w.x = pk2(o0[0], o0[1]); w.y = pk2(o0[2], o0[3]); *(u32x2*)(h + (size_t)row * DM + col) = w;
                w.x = pk2(o1[0], o1[1]); w.y = pk2(o1[2], o1[3]); *(u32x2*)(h + (size_t)(row + stride) * DM + col) = w; }
        }
        return;
    }
    for (int row = obid() * 8 + wave; row < MTOK; row += stride) {
        const f32x4* xr = (const f32x4*)(xin + (size_t)row * DM) + lane; f32x4 v[8]; float ss = 0.f;
#pragma unroll
        for (int j = 0; j < 8; ++j) { v[j] = xr[64 * j]; ss += (v[j][0] * v[j][0] + v[j][1] * v[j][1]) + (v[j][2] * v[j][2] + v[j][3] * v[j][3]); }
        ss = wave_sum(ss); const float rstd = rsqrtf(ss * (1.f / DM) + 1e-6f);
        const float* md = mod + (size_t)(l * 2 + (row >> 12)) * 6144;
#pragma unroll
        for (int j = 0; j < 8; ++j) { const int col = (64 * j + lane) * 4;
            const f32x4 g4 = *(const f32x4*)(g + col), sh = *(const f32x4*)(md + col), sc = *(const f32x4*)(md + 2048 + col);
            const f32x4 o = (v[j] * rstd * g4) * (sc + 1.f) + sh; u32x2 w; w.x = pk2(o[0], o[1]); w.y = pk2(o[2], o[3]);
            *(u32x2*)(h + (size_t)row * DM + col) = w; }
    }
}
__device__ __forceinline__ void ph_final(const Params& p_) {
    const Params p = *kparams(); (void)p_;
    const int tid = otid(), lane = tid & 63, wave = tid >> 6;
    const int stride = gridDim.x * 8;
    for (int row = obid() * 8 + wave; row < MTOK; row += 2 * stride) {
        const bool two = (row + stride < MTOK);
        f32x4* xr0 = (f32x4*)(p.out + (size_t)row * DM) + lane; f32x4* xr1 = (f32x4*)(p.out + (size_t)(two ? row + stride : row) * DM) + lane;
        f32x4 v0[8], v1[8], g4[8];
#pragma unroll
        for (int j = 0; j < 8; ++j) { v0[j] = xr0[64 * j]; v1[j] = xr1[64 * j]; g4[j] = *(const f32x4*)(p.final_g + (64 * j + lane) * 4); }
        asm volatile("" ::: "memory");
        float s0 = 0.f, s1 = 0.f;
#pragma unroll
        for (int j = 0; j < 8; ++j) { s0 += (v0[j][0] * v0[j][0] + v0[j][1] * v0[j][1]) + (v0[j][2] * v0[j][2] + v0[j][3] * v0[j][3]); s1 += (v1[j][0] * v1[j][0] + v1[j][1] * v1[j][1]) + (v1[j][2] * v1[j][2] + v1[j][3] * v1[j][3]); }
        s0 = wave_sum(s0); s1 = wave_sum(s1);
        const float r0 = rsqrtf(s0 * (1.f / DM) + 1e-6f), r1 = rsqrtf(s1 * (1.f / DM) + 1e-6f);
#pragma unroll
        for (int j = 0; j < 8; ++j) { xr0[64 * j] = v0[j] * r0 * g4[j]; if (two) xr1[64 * j] = v1[j] * r1 * g4[j]; }
    }
}

#ifndef REP_PRO
#define REP_PRO 1
#endif
#ifndef REP_NORM
#define REP_NORM 1
#endif
#ifndef REP_Z
#define REP_Z 1
#endif
#ifndef REP_MIX
#define REP_MIX 1
#endif
#ifndef REP_P3
#define REP_P3 1
#endif
#ifndef REP_R2
#define REP_R2 1
#endif
#ifndef REP_CMB
#define REP_CMB 1
#endif
#ifndef REP_FFT
#define REP_FFT 1
#endif
#ifndef REP_OUT
#define REP_OUT 1
#endif
#ifndef REP_SUB
#define REP_SUB 1
#endif

#ifndef REP_R1
#define REP_R1 1
#endif
#ifndef REP_NA
#define REP_NA 1
#endif
#ifndef REP_CV
#define REP_CV 1
#endif
#ifndef REP_F1
#define REP_F1 1
#endif
#define REPEAT(n) for (int rep_ = 0; rep_ < (n); ++rep_)
typedef short bf16x8v __attribute__((ext_vector_type(8)));
__device__ __forceinline__ bf16x8v mk8(unsigned a, unsigned b, unsigned c, unsigned d) { u32x4 v = {a, b, c, d}; return __builtin_bit_cast(bf16x8v, v); }
#define MFMA16(a, b, c) __builtin_amdgcn_mfma_f32_16x16x32_bf16(a, b, c, 0, 0, 0)
constexpr int R_QS = 0, R_KS = 18432, R_VT = 36864, R_KTF = 54272, R_KTB = 71680, R_STF = 89088, R_STB = 98304;

template <bool R2>
__device__ __forceinline__ void ret_stage(const Params& p_, int b, int h, int n, unsigned char* lds, float l2f, float l2b) {
    const Params p = *kparams(); (void)p_;
    const int tid = otid(), j = tid >> 2, c4 = tid & 3, s = n * 128 + j;
    const bf16* Z = (const bf16*)(p.ws + WS_Z); const bf16* zr = Z + (size_t)(b * SEQ + s) * DIN;
    const f32x4* rp = (const f32x4*)((const float2*)(p.ws + WS_ROPE) + s * 32 + c4 * 8);
    f32x4 rr[4];
#pragma unroll
    for (int i = 0; i < 4; ++i) rr[i] = rp[i];
    const u32x4 ka = *(const u32x4*)(zr + 7 * DG + h * 64 + c4 * 8), kb = *(const u32x4*)(zr + 7 * DG + h * 64 + 32 + c4 * 8);
    const u32x4 va = *(const u32x4*)(zr + 8 * DG + h * 64 + c4 * 16), vb = *(const u32x4*)(zr + 8 * DG + h * 64 + c4 * 16 + 8);
    u32x4 qa = ka, qb = kb;
    if (R2) { qa = *(const u32x4*)(zr + 6 * DG + h * 64 + c4 * 8); qb = *(const u32x4*)(zr + 6 * DG + h * 64 + 32 + c4 * 8); }
    asm volatile("" ::: "memory");
    float cs[8], sn[8];
#pragma unroll
    for (int i = 0; i < 4; ++i) { const f32x4 r = rr[i]; cs[2 * i] = r[0]; sn[2 * i] = r[1]; cs[2 * i + 1] = r[2]; sn[2 * i + 1] = r[3]; }
    bf16* KS = (bf16*)(lds + R_KS); bf16* VT = (bf16*)(lds + R_VT);
    {
      const unsigned kau[4] = {ka.x, ka.y, ka.z, ka.w}, kbu[4] = {kb.x, kb.y, kb.z, kb.w};
      float k1[8], k2[8];
#pragma unroll
      for (int i = 0; i < 4; ++i) { const float a0 = bflo(kau[i]), a1 = bfhi(kau[i]), b0 = bflo(kbu[i]), b1 = bfhi(kbu[i]);
          k1[2 * i] = a0 * cs[2 * i] - b0 * sn[2 * i]; k2[2 * i] = a0 * sn[2 * i] + b0 * cs[2 * i];
          k1[2 * i + 1] = a1 * cs[2 * i + 1] - b1 * sn[2 * i + 1]; k2[2 * i + 1] = a1 * sn[2 * i + 1] + b1 * cs[2 * i + 1]; }
      u32x4 o1, o2; o1.x = pk2(k1[0], k1[1]); o1.y = pk2(k1[2], k1[3]); o1.z = pk2(k1[4], k1[5]); o1.w = pk2(k1[6], k1[7]);
      o2.x = pk2(k2[0], k2[1]); o2.y = pk2(k2[2], k2[3]); o2.z = pk2(k2[4], k2[5]); o2.w = pk2(k2[6], k2[7]);
      *(u32x4*)(KS + j * 72 + c4 * 8) = o1; *(u32x4*)(KS + j * 72 + 32 + c4 * 8) = o2;
      if (!R2) { bf16* KTF = (bf16*)(lds + R_KTF); bf16* KTB = (bf16*)(lds + R_KTB);
          const float df = exp2f(l2f * (float)(127 - j)), db = exp2f(l2b * (float)j);
#pragma unroll
          for (int i = 0; i < 8; ++i) { KTF[(c4 * 8 + i) * 136 + j] = (bf16)f2bf(k1[i] * df); KTF[(32 + c4 * 8 + i) * 136 + j] = (bf16)f2bf(k2[i] * df);
              KTB[(c4 * 8 + i) * 136 + j] = (bf16)f2bf(k1[i] * db); KTB[(32 + c4 * 8 + i) * 136 + j] = (bf16)f2bf(k2[i] * db); } } }
    {
      const unsigned vu[8] = {va.x, va.y, va.z, va.w, vb.x, vb.y, vb.z, vb.w};
#pragma unroll
      for (int i = 0; i < 8; ++i) { VT[(c4 * 16 + 2 * i) * 136 + j] = (bf16)(vu[i] & 0xffffu); VT[(c4 * 16 + 2 * i + 1) * 136 + j] = (bf16)(vu[i] >> 16); } }
    if (R2) { bf16* QS = (bf16*)(lds + R_QS);
      const unsigned qau[4] = {qa.x, qa.y, qa.z, qa.w}, qbu[4] = {qb.x, qb.y, qb.z, qb.w};
      float q1[8], q2[8];
#pragma unroll
      for (int i = 0; i < 4; ++i) { const float a0 = bflo(qau[i]), a1 = bfhi(qau[i]), b0 = bflo(qbu[i]), b1 = bfhi(qbu[i]);
          q1[2 * i] = (a0 * cs[2 * i] - b0 * sn[2 * i]) * 0.125f; q2[2 * i] = (a0 * sn[2 * i] + b0 * cs[2 * i]) * 0.125f;
          q1[2 * i + 1] = (a1 * cs[2 * i + 1] - b1 * sn[2 * i + 1]) * 0.125f; q2[2 * i + 1] = (a1 * sn[2 * i + 1] + b1 * cs[2 * i + 1]) * 0.125f; }
      u32x4 o1, o2; o1.x = pk2(q1[0], q1[1]); o1.y = pk2(q1[2], q1[3]); o1.z = pk2(q1[4], q1[5]); o1.w = pk2(q1[6], q1[7]);
      o2.x = pk2(q2[0], q2[1]); o2.y = pk2(q2[2], q2[3]); o2.z = pk2(q2[4], q2[5]); o2.w = pk2(q2[6], q2[7]);
      *(u32x4*)(QS + j * 72 + c4 * 8) = o1; *(u32x4*)(QS + j * 72 + 32 + c4 * 8) = o2; }
}

__device__ __forceinline__ void ret1_task(const Params& p_, int l, int task, unsigned char* lds) {
    const Params p = *kparams(); (void)p_;
    const int n = task & 31, h = (task >> 5) & 7, b = task >> 8;
    const float xf = p.rl_f[l * 8 + h], xb = p.rl_b[l * 8 + h];
    const float l2f = -log1pf(expf(-xf)) * 1.4426950408889634f, l2b = -log1pf(expf(-xb)) * 1.4426950408889634f;
    ret_stage<false>(p, b, h, n, lds, l2f, l2b);
    __syncthreads();
    const int tid = otid(), lane = tid & 63, w = tid >> 6, fr = lane & 15, fq = lane >> 4, dir = w >> 2, et = w & 3;
    const bf16* VT = (const bf16*)(lds + R_VT); const bf16* KT = (const bf16*)(lds + (dir ? R_KTB : R_KTF));
    bf16x8v a[4];
#pragma unroll
    for (int ks = 0; ks < 4; ++ks) a[ks] = *(const bf16x8v*)(VT + (16 * et + fr) * 136 + 32 * ks + 8 * fq);
    float* dst = (float*)(p.ws + WS_KV) + ((size_t)((dir * 2 + b) * 8 + h) * 32 + n) * 4096;
#pragma unroll
    for (int dt = 0; dt < 4; ++dt) { f32x4 acc = {0.f, 0.f, 0.f, 0.f};
#pragma unroll
        for (int ks = 0; ks < 4; ++ks) { const bf16x8v bfr = *(const bf16x8v*)(KT + (16 * dt + fr) * 136 + 32 * ks + 8 * fq); acc = MFMA16(a[ks], bfr, acc); }
#pragma unroll
        for (int r = 0; r < 4; ++r) dst[(16 * et + 4 * fq + r) * 64 + 16 * dt + fr] = acc[r]; }
    __syncthreads();
}

__device__ __forceinline__ void ret2_task(const Params& p_, int l, int task, unsigned char* lds) {
    const Params p = *kparams(); (void)p_;
    const int n = task & 31, h = (task >> 5) & 7, b = task >> 8;
    const float xf = p.rl_f[l * 8 + h], xb = p.rl_b[l * 8 + h];
    const float l2f = -log1pf(expf(-xf)) * 1.4426950408889634f, l2b = -log1pf(expf(-xb)) * 1.4426950408889634f;
    ret_stage<true>(p, b, h, n, lds, l2f, l2b);
    const int tid = otid(), lane = tid & 63, w = tid >> 6, fr = lane & 15, fq = lane >> 4;
    {
      const float gfC = exp2f(l2f * 128.f), gbC = exp2f(l2b * 128.f);
      const float* KVf = (const float*)(p.ws + WS_KV) + ((size_t)((0 * 2 + b) * 8 + h) * 32) * 4096 + tid * 8;
      const float* KVb = (const float*)(p.ws + WS_KV) + ((size_t)((1 * 2 + b) * 8 + h) * 32) * 4096 + tid * 8;
      f32x4 f0 = {0.f, 0.f, 0.f, 0.f}, f1 = f0, g0 = f0, g1 = f0;
      { float c0 = 1.f; int m = n - 1;
        for (; m >= 7; m -= 8) { f32x4 xa[8], xb[8];
#pragma unroll
            for (int j = 0; j < 8; ++j) { xa[j] = *(const f32x4*)(KVf + (size_t)(m - j) * 4096); xb[j] = *(const f32x4*)(KVf + (size_t)(m - j) * 4096 + 4); }
            asm volatile("" ::: "memory");
#pragma unroll
            for (int j = 0; j < 8; ++j) { f0 += xa[j] * c0; f1 += xb[j] * c0; c0 *= gfC; } }
        for (; m >= 0; --m) { const f32x4 x0 = *(const f32x4*)(KVf + (size_t)m * 4096), x1 = *(const f32x4*)(KVf + (size_t)m * 4096 + 4); f0 += x0 * c0; f1 += x1 * c0; c0 *= gfC; } }
      { float c0 = 1.f; int m = n + 1;
        for (; m + 7 < 32; m += 8) { f32x4 xa[8], xb[8];
#pragma unroll
            for (int j = 0; j < 8; ++j) { xa[j] = *(const f32x4*)(KVb + (size_t)(m + j) * 4096); xb[j] = *(const f32x4*)(KVb + (size_t)(m + j) * 4096 + 4); }
            asm volatile("" ::: "memory");
#pragma unroll
            for (int j = 0; j < 8; ++j) { g0 += xa[j] * c0; g1 += xb[j] * c0; c0 *= gbC; } }
        for (; m < 32; ++m) { const f32x4 x0 = *(const f32x4*)(KVb + (size_t)m * 4096), x1 = *(const f32x4*)(KVb + (size_t)m * 4096 + 4); g0 += x0 * c0; g1 += x1 * c0; c0 *= gbC; } }
      const int e = tid >> 3, d0 = (tid & 7) * 8; u32x4 o;
      o.x = pk2(f0[0], f0[1]); o.y = pk2(f0[2], f0[3]); o.z = pk2(f1[0], f1[1]); o.w = pk2(f1[2], f1[3]); *(u32x4*)((bf16*)(lds + R_STF) + e * 72 + d0) = o;
      o.x = pk2(g0[0], g0[1]); o.y = pk2(g0[2], g0[3]); o.z = pk2(g1[0], g1[1]); o.w = pk2(g1[2], g1[3]); *(u32x4*)((bf16*)(lds + R_STB) + e * 72 + d0) = o; }
    __syncthreads();
    const bf16* QS = (const bf16*)(lds + R_QS); const bf16* KS = (const bf16*)(lds + R_KS); const bf16* VT = (const bf16*)(lds + R_VT);
    const bf16* STF = (const bf16*)(lds + R_STF); const bf16* STB = (const bf16*)(lds + R_STB);
    bf16x8v qf[2];
#pragma unroll
    for (int ks = 0; ks < 2; ++ks) qf[ks] = *(const bf16x8v*)(QS + (16 * w + fr) * 72 + 32 * ks + 8 * fq);
    const int ai = 16 * w + fr;
    unsigned pp[8][2];
#pragma unroll
    for (int jt = 0; jt < 8; ++jt) { f32x4 acc = {0.f, 0.f, 0.f, 0.f};
#pragma unroll
        for (int ks = 0; ks < 2; ++ks) { const bf16x8v kf = *(const bf16x8v*)(KS + (16 * jt + fr) * 72 + 32 * ks + 8 * fq); acc = MFMA16(kf, qf[ks], acc); }
        float sc[4];
#pragma unroll
        for (int r = 0; r < 4; ++r) { const int aj = 16 * jt + 4 * fq + r; const float wg = (aj <= ai) ? exp2f(l2f * (float)(ai - aj)) : exp2f(l2b * (float)(aj - ai)); sc[r] = acc[r] * wg; }
        pp[jt][0] = pk2(sc[0], sc[1]); pp[jt][1] = pk2(sc[2], sc[3]); }
    const float qdf = exp2f(l2f * (float)(ai + 1)), qdb = exp2f(l2b * (float)(128 - ai));
    f32x4 tot[4]; float ss = 0.f;
#pragma unroll
    for (int et = 0; et < 4; ++et) { f32x4 o = {0.f, 0.f, 0.f, 0.f}, cfa = o, cba = o;
#pragma unroll
        for (int t = 0; t < 4; ++t) { const u32x2 vlo = *(const u32x2*)(VT + (16 * et + fr) * 136 + 32 * t + 4 * fq), vhi = *(const u32x2*)(VT + (16 * et + fr) * 136 + 32 * t + 16 + 4 * fq);
            o = MFMA16(mk8(vlo.x, vlo.y, vhi.x, vhi.y), mk8(pp[2 * t][0], pp[2 * t][1], pp[2 * t + 1][0], pp[2 * t + 1][1]), o); }
#pragma unroll
        for (int ks = 0; ks < 2; ++ks) { const bf16x8v sf = *(const bf16x8v*)(STF + (16 * et + fr) * 72 + 32 * ks + 8 * fq), sb = *(const bf16x8v*)(STB + (16 * et + fr) * 72 + 32 * ks + 8 * fq);
            cfa = MFMA16(sf, qf[ks], cfa); cba = MFMA16(sb, qf[ks], cba); }
        tot[et] = o + cfa * qdf + cba * qdb;
        ss += (tot[et][0] * tot[et][0] + tot[et][1] * tot[et][1]) + (tot[et][2] * tot[et][2] + tot[et][3] * tot[et][3]); }
    ss += __shfl_xor(ss, 16); ss += __shfl_xor(ss, 32);
    const float rs = rsqrtf(ss * (1.f / 64.f) + 1e-6f);
    const size_t tok = (size_t)b * SEQ + n * 128 + ai;
    const bf16* Z = (const bf16*)(p.ws + WS_Z); bf16* CAT = (bf16*)(p.ws + WS_CAT);
#pragma unroll
    for (int et = 0; et < 4; ++et) { const u32x2 gz = *(const u32x2*)(Z + tok * DIN + 9 * DG + h * 64 + 16 * et + 4 * fq); u32x2 o;
        o.x = pk2(tot[et][0] * rs * silu_f(bflo(gz.x)), tot[et][1] * rs * silu_f(bfhi(gz.x))); o.y = pk2(tot[et][2] * rs * silu_f(bflo(gz.y)), tot[et][3] * rs * silu_f(bfhi(gz.y)));
        *(u32x2*)(CAT + tok * DM + 1024 + h * 64 + 16 * et + 4 * fq) = o; }
    __syncthreads();
}

__device__ __forceinline__ void na2_task(const Params& p_, int l, int task, unsigned char* lds) {
    const Params p = *kparams(); (void)p_;
    const int tid = otid(), lane = tid & 63, w = tid >> 6, fr = lane & 15, fq = lane >> 4;
    const int hp = task & 3, rq = (task >> 2) & 63, b = task >> 8;
    const int row_start = min(max(rq - 4, 0), 56);
    const bf16* Z = (const bf16*)(p.ws + WS_Z); bf16* CAT = (bf16*)(p.ws + WS_CAT);
    bf16* VT = (bf16*)lds; float* BI = (float*)(lds + 133120);
    const int hh = w >> 2, h = hp * 2 + hh, qb = w & 3, kst = min(max(16 * qb - 8, 0), 32);
    const int c = 16 * qb + fr; const size_t qtok = (size_t)b * SEQ + rq * 64 + c;
    bf16x8v qf[2], kfr[8][2];
#pragma unroll
    for (int ks = 0; ks < 2; ++ks) qf[ks] = *(const bf16x8v*)(Z + qtok * DIN + 2 * DG + h * 64 + 32 * ks + 8 * fq);
#pragma unroll
    for (int i = 0; i < 8; ++i) { const int a = i / 2, ci = i % 2;
        const size_t ktok = (size_t)b * SEQ + (row_start + a) * 64 + kst + 16 * ci + fr;
#pragma unroll
        for (int ks = 0; ks < 2; ++ks) kfr[i][ks] = *(const bf16x8v*)(Z + ktok * DIN + 3 * DG + h * 64 + 32 * ks + 8 * fq); }
    asm volatile("" ::: "memory");
    for (int i = tid; i < 930; i += NTHR) BI[i] = p.na_bias[(size_t)(l * 8 + hp * 2) * 465 + i];
    { const int pair = lane & 31, chunk = (lane >> 5) + 2 * (w & 3);
      unsigned* VTd = (unsigned*)(VT + (size_t)hh * 64 * 520);
      u32x4 xs[8], ys[8];
#pragma unroll
      for (int a = 0; a < 8; ++a) { const size_t tok = (size_t)b * SEQ + (row_start + a) * 64 + 2 * pair;
          const bf16* src = Z + tok * DIN + 4 * DG + h * 64 + chunk * 8; xs[a] = *(const u32x4*)src; ys[a] = *(const u32x4*)(src + DIN); }
      asm volatile("" ::: "memory");
#pragma unroll
      for (int a = 0; a < 8; ++a) { const unsigned xu[4] = {xs[a].x, xs[a].y, xs[a].z, xs[a].w}, yu[4] = {ys[a].x, ys[a].y, ys[a].z, ys[a].w};
#pragma unroll
          for (int i = 0; i < 4; ++i) { VTd[(chunk * 8 + 2 * i) * 260 + a * 32 + pair] = (xu[i] & 0xffffu) | (yu[i] << 16);
              VTd[(chunk * 8 + 2 * i + 1) * 260 + a * 32 + pair] = (xu[i] >> 16) | (yu[i] & 0xffff0000u); } } }
    __syncthreads();
    const int col_start = min(max(c - 8, 0), 48);
    const float* bi = BI + hh * 465;
    float sc[16][4]; float mx = -1e30f;
#pragma unroll
    for (int hf = 0; hf < 2; ++hf) {
        if (hf == 1) {
#pragma unroll
            for (int i = 0; i < 8; ++i) { const int a = 4 + i / 2, ci = i % 2;
                const size_t ktok = (size_t)b * SEQ + (row_start + a) * 64 + kst + 16 * ci + fr;
#pragma unroll
                for (int ks = 0; ks < 2; ++ks) kfr[i][ks] = *(const bf16x8v*)(Z + ktok * DIN + 3 * DG + h * 64 + 32 * ks + 8 * fq); }
            asm volatile("" ::: "memory");
        }
#pragma unroll
        for (int i = 0; i < 8; ++i) { const int a = 4 * hf + i / 2, ci = i % 2, kt = a * 2 + ci;
            f32x4 acc = {0.f, 0.f, 0.f, 0.f};
#pragma unroll
            for (int ks = 0; ks < 2; ++ks) acc = MFMA16(kfr[i][ks], qf[ks], acc);
            const int dr = row_start + a - rq;
#pragma unroll
            for (int r = 0; r < 4; ++r) { const int kc = kst + 16 * ci + 4 * fq + r, rel = kc - col_start, dc = kc - c;
                float v = acc[r] * 0.125f + bi[(dr + 7) * 31 + min(max(dc + 15, 0), 30)];
                v = (rel >= 0 && rel < 16) ? v : -1e30f; sc[kt][r] = v; mx = fmaxf(mx, v); } }
    }
    mx = fmaxf(mx, __shfl_xor(mx, 16)); mx = fmaxf(mx, __shfl_xor(mx, 32));
    float sum = 0.f; unsigned pp[16][2];
#pragma unroll
    for (int kt = 0; kt < 16; ++kt) { const float e0 = __expf(sc[kt][0] - mx), e1 = __expf(sc[kt][1] - mx), e2 = __expf(sc[kt][2] - mx), e3 = __expf(sc[kt][3] - mx);
        sum += (e0 + e1) + (e2 + e3); pp[kt][0] = pk2(e0, e1); pp[kt][1] = pk2(e2, e3); }
    sum += __shfl_xor(sum, 16); sum += __shfl_xor(sum, 32);
    const float inv = 1.f / sum;
    const bf16* VTh = VT + (size_t)hh * 64 * 520;
#pragma unroll
    for (int dt = 0; dt < 4; ++dt) { f32x4 o = {0.f, 0.f, 0.f, 0.f};
#pragma unroll
        for (int t = 0; t < 8; ++t) { const int k0 = 2 * t, k1 = 2 * t + 1, a0 = k0 / 2, c0 = k0 % 2, a1 = k1 / 2, c1 = k1 % 2;
            const u32x2 vlo = *(const u32x2*)(VTh + (16 * dt + fr) * 520 + a0 * 64 + kst + 16 * c0 + 4 * fq), vhi = *(const u32x2*)(VTh + (16 * dt + fr) * 520 + a1 * 64 + kst + 16 * c1 + 4 * fq);
            o = MFMA16(mk8(vlo.x, vlo.y, vhi.x, vhi.y), mk8(pp[k0][0], pp[k0][1], pp[k1][0], pp[k1][1]), o); }
        const u32x2 gz = *(const u32x2*)(Z + qtok * DIN + 5 * DG + h * 64 + 16 * dt + 4 * fq); u32x2 ov;
        ov.x = pk2(o[0] * inv * silu_f(bflo(gz.x)), o[1] * inv * silu_f(bfhi(gz.x))); ov.y = pk2(o[2] * inv * silu_f(bflo(gz.y)), o[3] * inv * silu_f(bfhi(gz.y)));
        *(u32x2*)(CAT + qtok * DM + 512 + h * 64 + 16 * dt + 4 * fq) = ov; }
    __syncthreads();
}

__device__ __forceinline__ void conv_task(const Params& p_, int l, int task, unsigned char* lds) {
    const Params p = *kparams(); (void)p_;
    const int tid = otid(), lane = tid & 63, wave = tid >> 6;
    float* us = (float*)lds; float* ys = us + 46 * 512;
    const bf16* Z = (const bf16*)(p.ws + WS_Z);
    const int b = task >> 8, t0 = (task & 255) * 16;
    { u32x4 av[6], gv[6];
#pragma unroll
      for (int it = 0; it < 6; ++it) { const int idx = tid + it * NTHR, tt = idx >> 6, cc = (idx & 63) * 8, tok = t0 - 15 + tt;
          av[it] = (u32x4){0u, 0u, 0u, 0u}; gv[it] = av[it];
          if (idx < 46 * 64 && tok >= 0 && tok < SEQ) { const bf16* zr = Z + (size_t)(b * SEQ + tok) * DIN; av[it] = *(const u32x4*)(zr + 10 * DG + cc); gv[it] = *(const u32x4*)(zr + 11 * DG + cc); } }
      asm volatile("" ::: "memory");
#pragma unroll
      for (int it = 0; it < 6; ++it) { const int idx = tid + it * NTHR, tt = idx >> 6, cc = (idx & 63) * 8;
          if (idx < 46 * 64) { const u32x4 a = av[it], g = gv[it]; f32x4 u0, u1;
              u0[0] = bflo(a.x) / (1.f + __expf(-bflo(g.x))); u0[1] = bfhi(a.x) / (1.f + __expf(-bfhi(g.x))); u0[2] = bflo(a.y) / (1.f + __expf(-bflo(g.y))); u0[3] = bfhi(a.y) / (1.f + __expf(-bfhi(g.y)));
              u1[0] = bflo(a.z) / (1.f + __expf(-bflo(g.z))); u1[1] = bfhi(a.z) / (1.f + __expf(-bfhi(g.z))); u1[2] = bflo(a.w) / (1.f + __expf(-bflo(g.w))); u1[3] = bfhi(a.w) / (1.f + __expf(-bfhi(g.w)));
              *(f32x4*)(us + tt * 512 + cc) = u0; *(f32x4*)(us + tt * 512 + cc + 4) = u1; } } }
    float w[31];
#pragma unroll
    for (int k = 0; k < 31; ++k) w[k] = p.conv_w[(size_t)(l * 31 + k) * DG + tid];
    const float cb = p.conv_b[l * DG + tid];
    __syncthreads();
    { float y[16];
#pragma unroll
      for (int t = 0; t < 16; ++t) y[t] = cb;
#pragma unroll
      for (int j = 0; j < 46; ++j) { const float u = us[j * 512 + tid];
#pragma unroll
          for (int t = 0; t < 16; ++t) { const int k = j - t; if (k >= 0 && k < 31) y[t] += w[k] * u; } }
#pragma unroll
      for (int t = 0; t < 16; ++t) ys[t * 512 + tid] = y[t]; }
    __syncthreads();
#pragma unroll
    for (int tw = 0; tw < 2; ++tw) { const int t = wave + 8 * tw; float v[8]; float s = 0.f;
#pragma unroll
        for (int j = 0; j < 8; ++j) { v[j] = ys[t * 512 + lane + 64 * j]; s += v[j]; }
        const float mu = wave_sum(s) * (1.f / 512.f); float q = 0.f;
#pragma unroll
        for (int j = 0; j < 8; ++j) { v[j] -= mu; q += v[j] * v[j]; }
        const float rstd = rsqrtf(wave_sum(q) * (1.f / 512.f) + 1e-6f);
        bf16* orow = (bf16*)(p.ws + WS_CVH) + (size_t)(b * SEQ + t0 + t) * DG;
#pragma unroll
        for (int j = 0; j < 8; ++j) { const int ch = lane + 64 * j; const float y = v[j] * rstd * p.ln_g[l * DG + ch] + p.ln_b[l * DG + ch]; orow[ch] = (bf16)f2bf(silu_f(y)); } }
    __syncthreads();
}

__device__ __forceinline__ void ph_mixA(const Params& p, int l, unsigned char* lds) {
    const int G = gridDim.x, bid = obid();
    for (int t = bid; t < 512 * REP_R1; t += G) ret1_task(p, l, t & 511, lds);
    const int xcd = bid & 7, slot = bid >> 3, nloc = (slot < 16) ? 1 : 3, r0 = (slot < 16) ? slot : 16 + (slot - 16) * 3;
    if (G == 256 && REP_NA == 1) {
        for (int i = 0; i < nloc; ++i) { const int rq = (slot < 16) ? slot : 16 + i * 16 + (slot - 16);
            na2_task(p, l, (xcd >> 2) * 256 + rq * 4 + (xcd & 3), lds); }
    } else for (int t = bid; t < 512 * REP_NA; t += G) na2_task(p, l, t & 511, lds);
    if (G == 256 && REP_CV == 1) {
        for (int i = 0; i < 2; ++i) conv_task(p, l, xcd * 64 + i * 32 + slot, lds);
    } else for (int t = bid; t < 512 * REP_CV; t += G) conv_task(p, l, t & 511, lds);
}

__device__ __forceinline__ void ph_fold(const Params& p_) {
    const Params p = *kparams(); (void)p_;
    const bf16* PQ = (const bf16*)(p.ws + WS_PQT); bf16* PQF = (bf16*)(p.ws + WS_PQF);
    for (int e = obid() * NTHR + otid(); e < NB * DG * 2 * 256; e += gridDim.x * NTHR) {
        const int row = e >> 8, s0 = (e & 255) * 8, pq = row & 1;
        const bf16* src = PQ + (size_t)row * 4096;
        const u32x4 own = *(const u32x4*)(src + s0), low = *(const u32x4*)(src + 4096 - s0 - 8);
        const float top = (s0 == 0) ? 0.f : bf2f(src[4096 - s0]);
        const float sg = pq ? -1.f : 1.f;
        float o[8];
        o[0] = bflo(own.x) + sg * top;            o[1] = bfhi(own.x) + sg * bfhi(low.w);
        o[2] = bflo(own.y) + sg * bflo(low.w);    o[3] = bfhi(own.y) + sg * bfhi(low.z);
        o[4] = bflo(own.z) + sg * bflo(low.z);    o[5] = bfhi(own.z) + sg * bfhi(low.y);
        o[6] = bflo(own.w) + sg * bflo(low.y);    o[7] = bfhi(own.w) + sg * bfhi(low.x);
        if (s0 == 0 && pq) o[0] = 0.f;
        u32x4 w; w.x = pk2(o[0], o[1]); w.y = pk2(o[2], o[3]); w.z = pk2(o[4], o[5]); w.w = pk2(o[6], o[7]);
        *(u32x4*)(PQF + (size_t)row * 2048 + s0) = w;
    }
}
__device__ __forceinline__ void ph_alt(const Params& p_) {
    const Params p = *kparams(); (void)p_;
    const int tid = otid(), lane = tid & 63, wave = tid >> 6; const bf16* PQF = (const bf16*)(p.ws + WS_PQF);
    float* dst = (float*)(p.ws + WS_PART) + (size_t)(2 * 2304 + 2 * 2048) * 512;
    for (int r = obid() * 8 + wave; r < NB * DG; r += gridDim.x * 8) {
        const u32x4* src = (const u32x4*)(PQF + (size_t)r * 4096) + lane; float acc = 0.f;
#pragma unroll
        for (int j = 0; j < 4; ++j) { const u32x4 v = src[64 * j];
            acc += (bflo(v.x) - bfhi(v.x)) + (bflo(v.y) - bfhi(v.y)) + (bflo(v.z) - bfhi(v.z)) + (bflo(v.w) - bfhi(v.w)); }
        acc = wave_sum(acc);
        if (lane == 0) dst[r] = acc;
    }
}
__device__ __forceinline__ void ph_combine(const Params& p_) {
    const Params p = *kparams(); (void)p_;
    const float* Ce = (const float*)(p.ws + WS_PART); const float* So = Ce + (size_t)2 * 2304 * 512;
    bf16* CAT = (bf16*)(p.ws + WS_CAT); const bf16* Z = (const bf16*)(p.ws + WS_Z); const bf16* PQ = (const bf16*)(p.ws + WS_PQT);
    const int nth = gridDim.x * NTHR;
    for (int e0 = obid() * NTHR + otid(); e0 < MTOK * DG / 4; e0 += 2 * nth) {
        f32x4 ce[2], so[2]; u32x2 gz[2]; float pv[2][4]; int rowv[2], c4v[2], kv[2]; bool use_so[2], act[2];
#pragma unroll
        for (int u = 0; u < 2; ++u) { const int e = e0 + u * nth; act[u] = e < MTOK * DG / 4; const int ee = act[u] ? e : e0;
            const int row = ee >> 7, c4 = (ee & 127) * 4, b = row >> 12, k = row & 4095, kk = (k <= 2048) ? k : 4096 - k;
            rowv[u] = row; c4v[u] = c4; kv[u] = k; use_so[u] = (kk != 0 && kk != 2048);
            ce[u] = (kk == 2048) ? *(const f32x4*)(Ce + (size_t)(2 * 2304 + 2 * 2048) * 512 + b * 512 + c4) : *(const f32x4*)(Ce + ((size_t)b * 2304 + kk) * 512 + c4);
            so[u] = *(const f32x4*)(So + ((size_t)b * 2048 + (use_so[u] ? kk : 1)) * 512 + c4);
            gz[u] = *(const u32x2*)(Z + (size_t)row * DIN + DG + c4);
#pragma unroll
            for (int j = 0; j < 4; ++j) pv[u][j] = bf2f(PQ[((size_t)(b * 512 + c4 + j) * 2) * 4096 + 2048]); }
        asm volatile("" ::: "memory");
#pragma unroll
        for (int u = 0; u < 2; ++u) if (act[u]) { f32x4 s = ce[u];
            if (use_so[u]) s = (kv[u] <= 2048) ? s - so[u] : s + so[u];
            const float alt = (kv[u] & 1) ? -1.f : 1.f;
#pragma unroll
            for (int j = 0; j < 4; ++j) s[j] += alt * pv[u][j];
            u32x2 w; w.x = pk2(s[0] * silu_f(bflo(gz[u].x)), s[1] * silu_f(bfhi(gz[u].x))); w.y = pk2(s[2] * silu_f(bflo(gz[u].y)), s[3] * silu_f(bfhi(gz[u].y)));
            *(u32x2*)(CAT + (size_t)rowv[u] * DM + c4v[u]) = w; }
    }
}

#define XB_TMO      128
#define XB_XCNT(j)  (256  + 64 * (j))
#define XB_XSUB(j)  (1280 + 64 * (j))
#define XB_XGEN(j)  (2304 + 64 * (j))
#define XB_TOP      3328
#define XB_TOPGEN   3392
#define XCD_BAR_WORDS 3456
#define XB_SPIN_CAP (1u << 20)
__device__ __forceinline__ unsigned xb_ld(unsigned* p)              { return __hip_atomic_load(p, __ATOMIC_RELAXED, __HIP_MEMORY_SCOPE_AGENT); }
__device__ __forceinline__ unsigned xb_add(unsigned* p, unsigned v) { return __hip_atomic_fetch_add(p, v, __ATOMIC_RELAXED, __HIP_MEMORY_SCOPE_AGENT); }
__device__ __forceinline__ unsigned xb_xcc_id() { return (unsigned)__builtin_amdgcn_s_getreg((3 << 11) | 20) & 0xFu; }
#define XB_SPIN(cond, bar) do { unsigned _sp = 0; while (cond) { __builtin_amdgcn_s_sleep(1); \
    if ((++_sp & 255u) == 0u) { if (xb_ld(&(bar)[XB_TMO])) break; if (_sp > XB_SPIN_CAP) { atomicAdd(&(bar)[XB_TMO], 1u); break; } } } } while (0)
struct XcdBarrier { unsigned* bar; unsigned x; volatile PG8_LAS unsigned* st; };
__device__ __forceinline__ XcdBarrier xcd_barrier_post(unsigned* bar, volatile PG8_LAS unsigned* st) {
    XcdBarrier b; b.bar = bar; b.x = xb_xcc_id(); b.st = st;
    if (otid() == 0) (void)xb_add(&bar[XB_XCNT(b.x)], 1u);
    return b;
}
__device__ __forceinline__ void xcd_barrier_complete(unsigned* bar, unsigned x, unsigned& nloc, unsigned& nx) {
    const unsigned G = gridDim.x * gridDim.y * gridDim.z;
    unsigned sum, cnt, mine, sp = 0u;
    for (;;) {
        sum = 0u; cnt = 0u; mine = 0u;
#pragma unroll
        for (unsigned j = 0; j < 16; ++j) { const unsigned c = xb_ld(&bar[XB_XCNT(j)]); sum += c; cnt += (c > 0u) ? 1u : 0u; mine = (j == x) ? c : mine; }
        if (sum == G) break;
        __builtin_amdgcn_s_sleep(1);
        if ((++sp & 255u) == 0u) { if (xb_ld(&bar[XB_TMO])) break; if (sp > XB_SPIN_CAP) { atomicAdd(&bar[XB_TMO], 1u); break; } }
    }
    nloc = mine > 0u ? mine : 1u; nx = cnt > 0u ? cnt : 1u;
}
__device__ __forceinline__ void xcd_barrier(const XcdBarrier& b) {
    asm volatile("s_waitcnt vmcnt(0)" ::: "memory");
    __syncthreads();
    if (otid() == 0) {
        unsigned* bar = b.bar;
        __builtin_amdgcn_s_waitcnt(0);
        unsigned nloc = b.st[0], nx = b.st[1];
        if (nloc == 0u) { xcd_barrier_complete(bar, b.x, nloc, nx); b.st[0] = nloc; b.st[1] = nx; }
        const unsigned old = xb_add(&bar[XB_XSUB(b.x)], 1u);
        const unsigned gen = old / nloc;
        if (old + 1u == (gen + 1u) * nloc) {
            __builtin_amdgcn_fence(__ATOMIC_RELEASE, "agent");
            asm volatile("s_waitcnt vmcnt(0)" ::: "memory");
            const unsigned og = xb_add(&bar[XB_TOP], 1u);
            const unsigned tg = og / nx;
            if (og + 1u == (tg + 1u) * nx) xb_add(&bar[XB_TOPGEN], 1u);
            else XB_SPIN(xb_ld(&bar[XB_TOPGEN]) == tg, bar);
            __builtin_amdgcn_fence(__ATOMIC_ACQUIRE, "agent");
            xb_add(&bar[XB_XGEN(b.x)], 1u);
            asm volatile("s_waitcnt vmcnt(0)" ::: "memory");
        } else {
            XB_SPIN(xb_ld(&bar[XB_XGEN(b.x)]) == gen, bar);
            __builtin_amdgcn_fence(__ATOMIC_ACQUIRE, "agent");
            asm volatile("s_waitcnt vmcnt(0)" ::: "memory");
        }
    }
    __syncthreads();
}

constexpr int NPH = 14;
__global__ void __launch_bounds__(NTHR) mega(Params p) {
    extern __shared__ __attribute__((aligned(16))) unsigned char lds[];
    cg::grid_group grid = cg::this_grid();
    PG8_LAS unsigned char* ldsl = (PG8_LAS unsigned char*)lds;
    const int lo = p.ph_lo, hi = p.ph_hi;
#define IN(k) (lo <= (k) && (k) < hi)
#define SEAM(k) do { if (IN(k) && IN((k) + 1)) { xcd_barrier(xb); } } while (0)
    bf16* Zb = (bf16*)(kparams()->ws + WS_Z); bf16* CAT = (bf16*)(kparams()->ws + WS_CAT);
    volatile PG8_LAS unsigned* xst = (volatile PG8_LAS unsigned*)(ldsl + LDS_BYTES - 16);
    { const int t0_ = otid(); if (t0_ < 4) xst[t0_] = 0u; }
    __syncthreads();
    XcdBarrier xb = xcd_barrier_post((unsigned*)(kparams()->ws + WS_BAR), xst);
    if (p.ph_lo < 0) grid.sync();
    if (IN(0)) REPEAT(REP_PRO) { ph_prologue(p, lds); __syncthreads(); }
    SEAM(0);
    if (IN(0) && IN(1)) for (int r_ = 1; r_ < REP_SUB; ++r_) xcd_barrier(xb);
#pragma unroll
    for (int l = 0; l < NL; ++l) {
        const int pb = 1 + 6 * l;
        const char* Wl = (const char*)(kparams()->ws + WS_WIN + (size_t)l * WROWS * DM * 2);
        if (IN(pb)) {
            if (l == 0) {
#pragma unroll
                for (int ll = 0; ll < NL; ++ll) {
                    SchedS S = make_sched(kparams()->ws + WS_WCS + (size_t)ll * 1024 * DG * 2, DG, kparams()->ws + WS_WFXB + (size_t)ll * DM * DG * 2, DG, 1024, DM, 32 * ll);
                    EpiZ E{(bf16*)(kparams()->ws + WS_WIN + ((size_t)ll * WROWS + 6656) * DM * 2), DM};
                    pg8::gemm_phase<EpiZ, SchedS, true>(ldsl, pg8::Gemm{DG, DG, DG}, S, E);
                }
            }
            REPEAT(REP_NORM) ph_norm(p, l, (l == 0 && gridDim.x == 256) ? 64 : 0);
        }
        SEAM(pb);
        if (IN(pb + 1)) REPEAT(REP_Z) {
            SchedZ S; S.o.init(MTOK, 24 * 256, (int)gridDim.x, obid()); S.A = (const char*)(kparams()->ws + WS_U); S.B = Wl; S.late = 0;
            EpiZ2 E{Zb, (bf16*)(kparams()->ws + WS_PQT)};
            pg8::gemm_phase<EpiZ2, SchedZ, true>(ldsl, pg8::Gemm{DM, DM, DM}, S, E);
        }
        SEAM(pb + 1);
        if (IN(pb + 2)) {
            {
                SchedZ S; S.o.init(MTOK, 4 * 256, (int)gridDim.x, obid()); S.A = (const char*)(kparams()->ws + WS_U); S.B = Wl; S.late = 1;
                EpiZ2 E{Zb, (bf16*)(kparams()->ws + WS_PQT)};
                pg8::gemm_phase<EpiZ2, SchedZ, true>(ldsl, pg8::Gemm{DM, DM, DM}, S, E);
            }
            REPEAT(REP_MIX) ph_mixA(p, l, lds);
            ph_fold(p);
        }
        SEAM(pb + 2);
        if (IN(pb + 3)) REPEAT(REP_P3) {
            const int G_ = (int)gridDim.x, b_ = obid(); const bool bal = (G_ == 256);
            {
                SchedDFT S{(const char*)(kparams()->ws + WS_DC), (const char*)(kparams()->ws + WS_PQF), G_, b_};
                EpiPart E{(float*)(kparams()->ws + WS_PART)};
                pg8::gemm_phase<EpiPart, SchedDFT, true>(ldsl, pg8::Gemm{2048, 4096, 2048}, S, E); }
            {
                SchedS S = make_sched(kparams()->ws + WS_CVH, DG, kparams()->ws + WS_WPW + (size_t)l * DG * DG * 2, DG, MTOK, DG, bal ? 192 : 0);
                EpiGate E{CAT, Zb, 1536, 12 * DG};
                pg8::gemm_phase<EpiGate, SchedS, true>(ldsl, pg8::Gemm{DG, DG, DG}, S, E); }
            if (bal && REP_R2 == 1) {
                const int xcd = b_ & 7, slot = b_ >> 3;
                const int nt_ = (slot >= 24) ? 2 : (slot >= 8 ? 3 : 0), k0 = (slot >= 24) ? 48 + (slot - 24) * 2 : (slot - 8) * 3;
                for (int i = 0; i < nt_; ++i) { const int k = (slot >= 24) ? 48 + i * 8 + (slot - 24) : i * 16 + (slot - 8);
                    ret2_task(p, l, (2 * xcd + (k >> 5)) * 32 + (k & 31), lds); }
            }
            else for (int t = b_; t < 512 * REP_R2; t += G_) ret2_task(p, l, t & 511, lds);
            ph_alt(p);
        }
        SEAM(pb + 3);
        if (IN(pb + 4)) REPEAT(REP_CMB) ph_combine(p);
        SEAM(pb + 4);
        if (IN(pb + 5)) REPEAT(l == 0 ? REP_OUT : 1) {
            SchedS S = make_sched(CAT, DM, kparams()->ws + WS_WOUT + (size_t)l * DM * DM * 2, DM, MTOK, DM);
            EpiRes E{(l == 0) ? kparams()->x : kparams()->out, kparams()->out, (const float*)(kparams()->ws + WS_MOD) + (size_t)l * 2 * 6144 + 4096};
            pg8::gemm_phase<EpiRes, SchedS, true>(ldsl, pg8::Gemm{DM, DM, DM}, S, E);
        }
        SEAM(pb + 5);
    }
    if (IN(NPH - 1)) ph_final(p);
#undef IN
#undef SEAM
}

extern "C" void kernel_launch(void* const* d_in, const int* in_sizes, int n_in, void* d_out, int out_size, void* d_ws, size_t ws_size, hipStream_t stream) {
    static int grid_blocks = 0;
    if (grid_blocks == 0) {
        if (n_in != 17 || ws_size < WS_END) { fprintf(stderr, "kernel_launch: n_in %d ws %zu (need %zu)\n", n_in, ws_size, (size_t)WS_END); grid_blocks = -1; return; }
        int dev = 0, cus = 0, per_cu = 0;
        hipGetDevice(&dev); hipDeviceGetAttribute(&cus, hipDeviceAttributeMultiprocessorCount, dev);
        if (hipFuncSetAttribute((const void*)mega, hipFuncAttributeMaxDynamicSharedMemorySize, LDS_BYTES) != hipSuccess) { fprintf(stderr, "hipFuncSetAttribute failed\n"); grid_blocks = -1; return; }
        if (hipOccupancyMaxActiveBlocksPerMultiprocessor(&per_cu, (const void*)mega, NTHR, LDS_BYTES) != hipSuccess || per_cu < 1) { fprintf(stderr, "occupancy query: %d\n", per_cu); per_cu = 1; }
        (void)hipGetLastError();
        grid_blocks = cus * 1;
    }
    if (grid_blocks < 0) return;
    Params p{};
    p.x = (const float*)d_in[0]; p.c = (const float*)d_in[1]; p.norm_g = (const float*)d_in[2]; p.w_ada = (const float*)d_in[3]; p.b_ada = (const float*)d_in[4];
    p.w_in = (const float*)d_in[5]; p.w_fft = (const float*)d_in[6]; p.na_bias = (const float*)d_in[7]; p.rl_f = (const float*)d_in[8]; p.rl_b = (const float*)d_in[9];
    p.conv_w = (const float*)d_in[10]; p.conv_b = (const float*)d_in[11]; p.ln_g = (const float*)d_in[12]; p.ln_b = (const float*)d_in[13]; p.w_pw = (const float*)d_in[14];
    p.w_out = (const float*)d_in[15]; p.final_g = (const float*)d_in[16];
    p.out = (float*)d_out; p.ws = (unsigned char*)d_ws;
#if ONE_LAUNCH
    if (hipMemsetAsync((char*)d_ws + WS_BAR, 0, 16384, stream) != hipSuccess) { fprintf(stderr, "memset of the barrier words failed\n"); return; }
    p.ph_lo = 0; p.ph_hi = NPH;
    void* args[] = {&p};
    hipError_t e = hipLaunchCooperativeKernel((const void*)mega, dim3(grid_blocks), dim3(NTHR), args, LDS_BYTES, stream);
    if (e != hipSuccess) fprintf(stderr, "cooperative launch failed: %s (grid %d)\n", hipGetErrorString(e), grid_blocks);
#else
    for (int ph = 0; ph < NPH; ++ph) { p.ph_lo = ph; p.ph_hi = ph + 1; hipLaunchKernelGGL(mega, dim3(grid_blocks), dim3(NTHR), LDS_BYTES, stream, p); }
#endif
}
```
